# Optimizing an MI355X kernel written in HIP

```python
import math
import jax
import jax.numpy as jnp
from jax import lax
import numpy as np

D_MODEL = 4096
BATCH = 2
SEQ = 8192
DEPTH = 2

EPS = 1e-6
SSD_W = 2048
SSD_HEAD_DIM = 64
SSD_HEADS = SSD_W // SSD_HEAD_DIM
SSD_GROUPS = 8
SSD_STATE = 128
SSD_CONV = 4
SSD_CHUNK = 128
SSD_CONV_DIM = SSD_W + 2 * SSD_GROUPS * SSD_STATE
SWA_W = 1024
SWA_HEAD_DIM = 64
SWA_HEADS = SWA_W // SWA_HEAD_DIM
SWA_KV_HEADS = 4
WINDOW = 128
REL_BUCKETS = 32
REL_MAX_DIST = 128
GLA_W = 1024
GLA_HEADS = 4
GLA_DV = GLA_W // GLA_HEADS
GLA_DK = GLA_DV // 2
GLA_K_TOT = GLA_HEADS * GLA_DK
GLA_RANK = 16
GLA_TAU = 16.0
GLA_CHUNK = 64
D_MIX = SSD_W + SWA_W + GLA_W
D_FF = 11008
FFN_CONV = 3
SPLIT_SIZES = (SSD_W, SSD_CONV_DIM, SSD_HEADS,
               SWA_W, SWA_KV_HEADS * SWA_HEAD_DIM, SWA_KV_HEADS * SWA_HEAD_DIM,
               GLA_K_TOT, GLA_K_TOT, GLA_W, GLA_W, GLA_RANK)
D_IN = sum(SPLIT_SIZES)

kernel_name = "hybrid_ssd_swa_gla_convffn"


def rmsnorm(x, w):
    xf = x.astype(jnp.float32)
    y = xf * lax.rsqrt(jnp.mean(xf * xf, axis=-1, keepdims=True) + EPS)
    return (y * w.astype(jnp.float32)).astype(x.dtype)


def causal_dwconv(x, w, b):
    K = w.shape[0]
    S = x.shape[1]
    xp = jnp.pad(x, ((0, 0), (K - 1, 0), (0, 0)))
    y = b
    for i in range(K):
        y = y + xp[:, i:i + S] * w[i]
    return y


def t5_bucket(dist):
    max_exact = REL_BUCKETS // 2
    d = jnp.maximum(dist.astype(jnp.float32), 1.0)
    large = max_exact + (jnp.log(d / max_exact) / math.log(REL_MAX_DIST / max_exact)
                         * (REL_BUCKETS - max_exact)).astype(jnp.int32)
    large = jnp.minimum(large, REL_BUCKETS - 1)
    return jnp.where(dist < max_exact, dist, large)


def t5_window_bias(rel_bias):
    qi = jnp.arange(WINDOW)[:, None]
    kj = jnp.arange(2 * WINDOW)[None, :]
    dist = jnp.clip(qi + WINDOW - kj, 0, WINDOW - 1)
    b = rel_bias[t5_bucket(dist)]
    b = jnp.transpose(b, (2, 0, 1))
    return b.reshape(SWA_KV_HEADS, SWA_HEADS // SWA_KV_HEADS, WINDOW, 2 * WINDOW).astype(jnp.float32)


def ssd_chunked(x, dt, A, Bm, Cm):
    b, s, h, p = x.shape
    g, n = Bm.shape[2], Bm.shape[3]
    r = h // g
    L = SSD_CHUNK
    c = s // L
    xd = (x * dt[..., None]).reshape(b, c, L, g, r, p)
    a_cs = jnp.cumsum((dt * A).reshape(b, c, L, g, r), axis=2)
    Bc = Bm.reshape(b, c, L, g, n)
    Cc = Cm.reshape(b, c, L, g, n)
    tril = jnp.tril(jnp.ones((L, L), bool))
    seg = a_cs[:, :, :, None] - a_cs[:, :, None, :]
    decay = jnp.exp(jnp.where(tril[:, :, None, None], seg, -jnp.inf))
    cb = jnp.einsum('bclgn,bcsgn->bclsg', Cc, Bc)
    y_diag = jnp.einsum('bclsgr,bcsgrp->bclgrp', cb[..., None] * decay, xd)
    decay_to_end = jnp.exp(a_cs[:, :, -1:] - a_cs)
    states = jnp.einsum('bcsgn,bcsgrp->bcgrpn', Bc, xd * decay_to_end[..., None])
    chunk_decay = jnp.exp(a_cs[:, :, -1])

    def step(hs, inp):
        st, dec = inp
        return hs * dec[..., None, None] + st, hs

    h0 = jnp.zeros((b, g, r, p, n), jnp.float32)
    _, prev = lax.scan(step, h0, (jnp.moveaxis(states, 1, 0), jnp.moveaxis(chunk_decay, 1, 0)))
    prev = jnp.moveaxis(prev, 0, 1)
    y_off = jnp.einsum('bclgn,bcgrpn->bclgrp', Cc, prev) * jnp.exp(a_cs)[..., None]
    return (y_diag + y_off).reshape(b, s, h, p)


def ssd_mixer(z, xbc, dt_raw, conv_w, conv_b, dt_bias, a_log, d_skip, norm_w):
    Bsz, S, _ = z.shape
    f32 = jnp.float32
    xbc = jax.nn.silu(causal_dwconv(xbc, conv_w, conv_b))
    xs, Bm, Cm = jnp.split(xbc, [SSD_W, SSD_W + SSD_GROUPS * SSD_STATE], axis=-1)
    xs = xs.astype(f32).reshape(Bsz, S, SSD_HEADS, SSD_HEAD_DIM)
    Bm = Bm.astype(f32).reshape(Bsz, S, SSD_GROUPS, SSD_STATE)
    Cm = Cm.astype(f32).reshape(Bsz, S, SSD_GROUPS, SSD_STATE)
    dt = jax.nn.softplus(dt_raw.astype(f32) + dt_bias.astype(f32))
    A = -jnp.exp(a_log.astype(f32))
    y = ssd_chunked(xs, dt, A, Bm, Cm) + xs * d_skip.astype(f32)[:, None]
    y = y.reshape(Bsz, S, SSD_W) * jax.nn.silu(z.astype(f32))
    yg = y.reshape(Bsz, S, SSD_GROUPS, SSD_W // SSD_GROUPS)
    yg = yg * lax.rsqrt(jnp.mean(yg * yg, axis=-1, keepdims=True) + EPS)
    return (yg.reshape(Bsz, S, SSD_W) * norm_w.astype(f32)).astype(z.dtype)


def swa_mixer(q, k, v, sinks, bias, norm_w):
    Bsz, S, _ = q.shape
    W = WINDOW
    nb = S // W
    G = SWA_HEADS // SWA_KV_HEADS
    f32 = jnp.float32
    qb = q.reshape(Bsz, nb, W, SWA_KV_HEADS, G, SWA_HEAD_DIM)
    k = k.reshape(Bsz, S, SWA_KV_HEADS, SWA_HEAD_DIM)
    v = v.reshape(Bsz, S, SWA_KV_HEADS, SWA_HEAD_DIM)

    def band(t):
        prev = jnp.pad(t, ((0, 0), (W, 0), (0, 0), (0, 0)))[:, :S]
        shp = (Bsz, nb, W, SWA_KV_HEADS, SWA_HEAD_DIM)
        return jnp.concatenate([prev.reshape(shp), t.reshape(shp)], axis=2)

    kb, vb = band(k), band(v)
    s = jnp.einsum('bnqhgd,bnkhd->bnhgqk', qb, kb).astype(f32) * (SWA_HEAD_DIM ** -0.5) + bias
    qi = jnp.arange(W)[:, None]
    kj = jnp.arange(2 * W)[None, :]
    dist = qi + W - kj
    valid = (dist >= 0) & (dist < W)
    valid_blk = jnp.where((jnp.arange(nb) == 0)[:, None, None], valid & (kj >= W), valid)
    s = jnp.where(valid_blk[None, :, None, None], s, -jnp.inf)
    sk = sinks.astype(f32).reshape(SWA_KV_HEADS, G)[None, None, :, :, None, None]
    m = jnp.maximum(jnp.max(s, axis=-1, keepdims=True), sk)
    p = jnp.exp(s - m)
    p = p / (jnp.sum(p, axis=-1, keepdims=True) + jnp.exp(sk - m))
    o = jnp.einsum('bnhgqk,bnkhd->bnqhgd', p.astype(v.dtype), vb).reshape(Bsz, S, SWA_W)
    return rmsnorm(o, norm_w)


def gla_mixer(q, k, v, g_out, g_lr, w_gate, b_gate, norm_w):
    Bsz, S, _ = q.shape
    L = GLA_CHUNK
    c = S // L
    f32 = jnp.float32
    log_a = jax.nn.log_sigmoid(g_lr.astype(f32) @ w_gate.astype(f32) + b_gate.astype(f32)) / GLA_TAU
    shp_k = (Bsz, c, L, GLA_HEADS, GLA_DK)
    q = q.astype(f32).reshape(shp_k) * (GLA_DK ** -0.5)
    k = k.astype(f32).reshape(shp_k)
    v = v.astype(f32).reshape(Bsz, c, L, GLA_HEADS, GLA_DV)
    b_cum = jnp.cumsum(log_a.reshape(shp_k), axis=2)
    q_dec = q * jnp.exp(b_cum)
    k_inv = k * jnp.exp(-b_cum)
    causal = jnp.tril(jnp.ones((L, L), bool))
    att = jnp.where(causal, jnp.einsum('bclhk,bcshk->bchls', q_dec, k_inv), 0.0)
    o = jnp.einsum('bchls,bcshv->bclhv', att, v)
    k_end = k * jnp.exp(b_cum[:, :, -1:] - b_cum)
    states = jnp.einsum('bcshk,bcshv->bchkv', k_end, v)
    decay = jnp.exp(b_cum[:, :, -1])

    def step(st_c, inp):
        st, dec = inp
        return st_c * dec[..., None] + st, st_c

    s0 = jnp.zeros((Bsz, GLA_HEADS, GLA_DK, GLA_DV), f32)
    _, prev = lax.scan(step, s0, (jnp.moveaxis(states, 1, 0), jnp.moveaxis(decay, 1, 0)))
    prev = jnp.moveaxis(prev, 0, 1)
    o = o + jnp.einsum('bclhk,bchkv->bclhv', q_dec, prev)
    o = o.reshape(Bsz, S, GLA_HEADS, GLA_DV)
    o = o * lax.rsqrt(jnp.mean(o * o, axis=-1, keepdims=True) + EPS) * norm_w.astype(f32)
    o = o.reshape(Bsz, S, GLA_W) * jax.nn.silu(g_out.astype(f32))
    return o.astype(g_out.dtype)


def setup_inputs(seed: int = 0) -> dict:
    key = jax.random.key(seed)
    ks = jax.random.split(key, 24)
    f32 = jnp.float32
    Ld = DEPTH

    def nrm(k, shape, scale):
        return jax.random.normal(k, shape, f32) * scale

    def gain(k, shape):
        return 1.0 + 0.02 * jax.random.normal(k, shape, f32)

    dt0 = jnp.exp(jax.random.uniform(ks[5], (Ld, SSD_HEADS), f32, math.log(1e-3), math.log(1e-1)))
    dt_bias = dt0 + jnp.log(-jnp.expm1(-dt0))
    a_log = jnp.log(jax.random.uniform(ks[6], (Ld, SSD_HEADS), f32, 1.0, 16.0))
    return {
        "x": nrm(ks[0], (BATCH, SEQ, D_MODEL), 1.0),
        "attn_norm": gain(ks[1], (Ld, D_MODEL)),
        "w_in": nrm(ks[2], (Ld, D_MODEL, D_IN), D_MODEL ** -0.5),
        "ssd_conv_w": nrm(ks[3], (Ld, SSD_CONV, SSD_CONV_DIM), SSD_CONV ** -0.5),
        "ssd_conv_b": nrm(ks[4], (Ld, SSD_CONV_DIM), 0.02),
        "ssd_dt_bias": dt_bias,
        "ssd_a_log": a_log,
        "ssd_d": 1.0 + 0.1 * jax.random.normal(ks[7], (Ld, SSD_HEADS), f32),
        "ssd_norm": gain(ks[8], (Ld, SSD_W)),
        "swa_sinks": nrm(ks[9], (Ld, SWA_HEADS), 1.0),
        "swa_norm": gain(ks[10], (Ld, SWA_W)),
        "gla_w_gate": nrm(ks[11], (Ld, GLA_RANK, GLA_K_TOT), GLA_RANK ** -0.5),
        "gla_b_gate": nrm(ks[12], (Ld, GLA_K_TOT), 0.5),
        "gla_norm": gain(ks[13], (Ld, GLA_DV)),
        "w_out": nrm(ks[14], (Ld, D_MIX, D_MODEL), D_MIX ** -0.5),
        "ffn_norm": gain(ks[15], (Ld, D_MODEL)),
        "w_gate": nrm(ks[16], (Ld, D_MODEL, D_FF), D_MODEL ** -0.5),
        "w_up": nrm(ks[17], (Ld, D_MODEL, D_FF), D_MODEL ** -0.5),
        "ffn_conv_w": nrm(ks[18], (Ld, FFN_CONV, D_FF), FFN_CONV ** -0.5),
        "ffn_conv_b": nrm(ks[19], (Ld, D_FF), 0.02),
        "w_down": nrm(ks[20], (Ld, D_FF, D_MODEL), D_FF ** -0.5),
        "rel_bias": nrm(ks[21], (REL_BUCKETS, SWA_HEADS), 0.5),
        "final_norm": gain(ks[22], (D_MODEL,)),
    }


def reference(x, attn_norm, w_in, ssd_conv_w, ssd_conv_b, ssd_dt_bias, ssd_a_log, ssd_d, ssd_norm,
              swa_sinks, swa_norm, gla_w_gate, gla_b_gate, gla_norm, w_out, ffn_norm, w_gate, w_up,
              ffn_conv_w, ffn_conv_b, w_down, rel_bias, final_norm):
    bias = t5_window_bias(rel_bias)
    split_at = [int(i) for i in np.cumsum(SPLIT_SIZES)[:-1]]
    for l in range(DEPTH):
        h = rmsnorm(x, attn_norm[l])
        proj = h @ w_in[l]
        (z, xbc, dt_raw, sq, sk, sv, gq, gk, gv, gg, glr) = jnp.split(proj, split_at, axis=-1)
        y_a = ssd_mixer(z, xbc, dt_raw, ssd_conv_w[l], ssd_conv_b[l], ssd_dt_bias[l],
                        ssd_a_log[l], ssd_d[l], ssd_norm[l])
        y_b = swa_mixer(sq, sk, sv, swa_sinks[l], bias, swa_norm[l])
        y_c = gla_mixer(gq, gk, gv, gg, glr, gla_w_gate[l], gla_b_gate[l], gla_norm[l])
        x = x + jnp.concatenate([y_a, y_b, y_c], axis=-1) @ w_out[l]
        h = rmsnorm(x, ffn_norm[l])
        gate = causal_dwconv(h @ w_gate[l], ffn_conv_w[l], ffn_conv_b[l])
        x = x + (jax.nn.silu(gate) * (h @ w_up[l])) @ w_down[l]
    return rmsnorm(x, final_norm)
```

```cpp
#include <hip/hip_runtime.h>
#include <cstdio>
#include <cstdint>
namespace pg8 {
#define PG8_LAS __attribute__((address_space(3)))
typedef unsigned short bf16_t;
typedef short bf16x8 __attribute__((ext_vector_type(8)));
typedef float f32x4 __attribute__((ext_vector_type(4)));
typedef unsigned u32x4 __attribute__((ext_vector_type(4)));
constexpr int BM = 256, BK = 64, HALF = 128, HTB = HALF * BK * 2  , STAGE_BYTES = 8 * HTB, NXCD = 8, WGM = 8;

__host__ __device__ __forceinline__ int lds_byte(int r, int c) { const int st = (r >> 4) * 2 + (c >> 5), rr = r & 15, cc = c & 31, ob = rr * 64 + cc * 2; return st * 1024 + (ob ^ (((ob >> 9) & 1) << 5)); }
__host__ __device__ __forceinline__ void stage_rc(int b, int& R, int& C) { const int st = b / 1024, sb = b % 1024, swz = sb ^ (((sb >> 9) & 1) << 5); R = (st >> 1) * 16 + swz / 64; C = (st & 1) * 32 + (swz % 64) / 2; }
__host__ __device__ __forceinline__ int perm32(int rho) { const int n = rho >> 4, i = rho & 15; return 8 * (i >> 2) + 4 * n + (i & 3); }

struct Unit { int pm, pn; };
struct Gemm { const bf16_t* A; const bf16_t* Bt; int M, N, K; };

struct StaticOrder {
    int nM, nN, nwg, G, c;
    __host__ __device__ void init(int M, int N, int G_, int c_) { nM = M / BM; nN = N / BM; nwg = nM * nN; G = G_; c = c_; }
    __host__ __device__ bool next(int i, Unit& u) const {
        const long L = (long)i * G + c; if (L >= nwg) return false;
        int wgid = (int)L; { const int q = nwg / NXCD, r = nwg % NXCD, xcd = wgid % NXCD, off = wgid / NXCD; wgid = (xcd < r ? xcd * (q + 1) : r * (q + 1) + (xcd - r) * q) + off; }
        const int nig = WGM * nN, gid = wgid / nig, fm = gid * WGM, gsz = (nM - fm) < WGM ? (nM - fm) : WGM;
        u.pm = fm + ((wgid % nig) % gsz); u.pn = (wgid % nig) / gsz; return true;
    }
    __device__ __forceinline__ void a_ready(const Unit&) const {}
    __device__ __forceinline__ void done(const Unit&) const {}
};

__device__ __forceinline__ unsigned cvt_pk_bf16(float lo, float hi) { unsigned r; asm volatile("v_cvt_pk_bf16_f32 %0, %1, %2" : "=v"(r) : "v"(lo), "v"(hi)); return r; }

struct EpiBf16 {
    static constexpr bool PERM = true, AFTER_DRAIN = false;
    bf16_t* O; int ldc;
    __device__ __forceinline__ void operator()(const f32x4 (&acc)[2][2][4][2], const Unit& u, int wr, int wc, int fr, int fq) const {
        const int row0 = u.pm * BM + wr * 64 + fr; const int col0 = u.pn * BM + wc * 32 + 8 * fq;
#pragma unroll
        for (int ai = 0; ai < 2; ++ai)
#pragma unroll
            for (int m = 0; m < 4; ++m) { bf16_t* rowp = O + (size_t)(row0 + ai * HALF + m * 16) * ldc + col0;
#pragma unroll
                for (int bj = 0; bj < 2; ++bj) { const f32x4 v0 = acc[ai][bj][m][0], v1 = acc[ai][bj][m][1];
                    u32x4 w; w.x = cvt_pk_bf16(v0[0], v0[1]); w.y = cvt_pk_bf16(v0[2], v0[3]); w.z = cvt_pk_bf16(v1[0], v1[1]); w.w = cvt_pk_bf16(v1[2], v1[3]);
                    *(u32x4*)(rowp + bj * HALF) = w; } }
    }
};
struct EpiRes {
    static constexpr bool PERM = false, AFTER_DRAIN = false;
    const float* base; float* out; int ldc;
    __device__ __forceinline__ void operator()(const f32x4 (&acc)[2][2][4][2], const Unit& u, int wr, int wc, int fr, int fq) const {
        const int row0 = u.pm * BM + wr * 64 + fr, col0 = u.pn * BM + wc * 32 + 4 * fq;
#pragma unroll
        for (int ai = 0; ai < 2; ++ai)
#pragma unroll
            for (int m = 0; m < 4; ++m) { const size_t off = (size_t)(row0 + ai * HALF + m * 16) * ldc + col0;
#pragma unroll
                for (int bj = 0; bj < 2; ++bj)
#pragma unroll
                    for (int n = 0; n < 2; ++n) { const f32x4 bs = *(const f32x4*)(base + off + bj * HALF + n * 16); *(f32x4*)(out + off + bj * HALF + n * 16) = bs + acc[ai][bj][m][n]; } }
    }
};
template <class Epi, class Sched, bool ALIGN_EPI = false, bool SP2 = false>
__device__ __forceinline__ void gemm_phase(PG8_LAS unsigned char* lds, const Gemm g, const Sched& S, const Epi& E) {
    const int tid = threadIdx.x, wid = __builtin_amdgcn_readfirstlane(tid >> 6), lane = tid & 63, wr = wid >> 2, wc = wid & 3, fr = lane & 15, fq = lane >> 4;
    const int K = g.K, nt = K / BK;
    unsigned voffA[2], voffB[2];
#pragma unroll
    for (int i = 0; i < 2; ++i) { int R, C; stage_rc(tid * 16 + i * 8192, R, C); const int Rb = Epi::PERM ? ((R & ~31) + perm32(R & 31)) : R;
        voffA[i] = (unsigned)(R * K + C) * 2u; voffB[i] = (unsigned)(Rb * K + C) * 2u; }
    const size_t kstep = (size_t)(BK * 2);
    const size_t hstep = (size_t)HALF * K * 2;
    const size_t tstep = 2 * hstep;
    const unsigned ldsw = (unsigned)wid * 1024u;
    const int aoff = lds_byte(wr * 64 + fr, fq * 8), boff = lds_byte(wc * 32 + fr, fq * 8);
#define PG8_SA(b, h) (((b) * 2 + (h)) * HTB)
#define PG8_SB(b, h) ((4 + (b) * 2 + (h)) * HTB)
#define PG8_STAGE(bufoff, gbase, voff) do { _Pragma("unroll") for (int _i = 0; _i < 2; ++_i) \
        __builtin_amdgcn_global_load_lds((const unsigned*)((const char*)(gbase) + (voff)[_i]), (PG8_LAS unsigned*)(lds + (bufoff) + ldsw + _i * 8192), 16, 0, 0); } while (0)
#define PG8_LDA(dst, b, h) do { _Pragma("unroll") for (int m = 0; m < 4; ++m) _Pragma("unroll") for (int k = 0; k < 2; ++k) dst[m][k] = *(const PG8_LAS bf16x8*)(lds + PG8_SA(b, h) + aoff + m * 2048 + k * 1024); } while (0)
#define PG8_LDB(dst, b, h) do { _Pragma("unroll") for (int n = 0; n < 2; ++n) _Pragma("unroll") for (int k = 0; k < 2; ++k) dst[n][k] = *(const PG8_LAS bf16x8*)(lds + PG8_SB(b, h) + boff + n * 2048 + k * 1024); } while (0)
#define PG8_MMA(ai, bj, At, Bt) do { __builtin_amdgcn_s_setprio(1); _Pragma("unroll") for (int m = 0; m < 4; ++m) _Pragma("unroll") for (int n = 0; n < 2; ++n) _Pragma("unroll") for (int k = 0; k < 2; ++k) \
        acc[ai][bj][m][n] = __builtin_amdgcn_mfma_f32_16x16x32_bf16(Bt[n][k], At[m][k], acc[ai][bj][m][n], 0, 0, 0); __builtin_amdgcn_s_setprio(0); } while (0)
#define PG8_WAIT_V(n) asm volatile("s_waitcnt vmcnt(" #n ")" ::: "memory")
#define PG8_WAIT_L(n) asm volatile("s_waitcnt lgkmcnt(" #n ")" ::: "memory")
#define PG8_BAR __builtin_amdgcn_s_barrier()
#define PG8_SCHED __builtin_amdgcn_sched_barrier(0)
    Unit cur, nxt; int ui = 0;
    if (!S.next(0, cur)) return;
    f32x4 acc[2][2][4][2];
#pragma unroll
    for (int a = 0; a < 2; ++a)
#pragma unroll
        for (int b = 0; b < 2; ++b)
#pragma unroll
            for (int m = 0; m < 4; ++m)
#pragma unroll
                for (int n = 0; n < 2; ++n) acc[a][b][m][n] = (f32x4){0.f, 0.f, 0.f, 0.f};
    bf16x8 At[4][2], B0[2][2], B1[2][2];
    const char* cA = (const char*)g.A + (size_t)cur.pm * tstep; const char* cB = (const char*)g.Bt + (size_t)cur.pn * tstep;
    S.a_ready(cur);
    if constexpr (SP2) {
        PG8_STAGE(PG8_SB(0, 0), cB, voffB); PG8_STAGE(PG8_SB(0, 1), cB + hstep, voffB); PG8_STAGE(PG8_SA(0, 0), cA, voffA); PG8_STAGE(PG8_SA(0, 1), cA + hstep, voffA);
        if (wr == 1) PG8_BAR;
        PG8_WAIT_V(2); PG8_BAR;
        PG8_STAGE(PG8_SB(1, 0), cB + kstep, voffB); PG8_STAGE(PG8_SA(1, 0), cA + kstep, voffA); PG8_STAGE(PG8_SB(1, 1), cB + hstep + kstep, voffB);
        PG8_WAIT_V(6); PG8_BAR;
    } else {
        PG8_STAGE(PG8_SB(0, 0), cB, voffB); PG8_STAGE(PG8_SA(0, 0), cA, voffA); PG8_STAGE(PG8_SB(0, 1), cB + hstep, voffB); PG8_STAGE(PG8_SA(0, 1), cA + hstep, voffA);
        if (wr == 1) PG8_BAR;
        PG8_WAIT_V(4); PG8_BAR;
        PG8_STAGE(PG8_SB(1, 0), cB + kstep, voffB); PG8_STAGE(PG8_SA(1, 0), cA + kstep, voffA); PG8_STAGE(PG8_SB(1, 1), cB + hstep + kstep, voffB);
        PG8_WAIT_V(6); PG8_BAR;
    }
    for (;;) {
        const bool has_next = S.next(ui + 1, nxt);
        const char* nA = has_next ? (const char*)g.A + (size_t)nxt.pm * tstep : cA; const char* nB = has_next ? (const char*)g.Bt + (size_t)nxt.pn * tstep : cB;
        for (int t = 0; t < nt; t += 2) {
            const bool last = (t == nt - 2);
            const char* a1 = cA + (size_t)(t + 1) * kstep;
            const char* a2 = last ? nA : cA + (size_t)(t + 2) * kstep; const char* b2 = last ? nB : cB + (size_t)(t + 2) * kstep;
            const char* a3 = a2 + kstep; const char* b3 = b2 + kstep;
            if (last && has_next) S.a_ready(nxt);
            if constexpr (SP2) {
            PG8_LDB(B0, 0, 0); PG8_LDB(B1, 0, 1); PG8_SCHED; PG8_LDA(At, 0, 0); PG8_STAGE(PG8_SA(1, 1), a1 + hstep, voffA);
            PG8_WAIT_V(8); PG8_WAIT_L(0); PG8_BAR; PG8_MMA(0, 0, At, B0); PG8_MMA(0, 1, At, B1); PG8_BAR; PG8_SCHED;
            PG8_LDA(At, 0, 1); PG8_STAGE(PG8_SB(0, 0), b2, voffB); PG8_STAGE(PG8_SB(0, 1), b2 + hstep, voffB); PG8_STAGE(PG8_SA(0, 0), a2, voffA);
            PG8_WAIT_V(8); PG8_WAIT_L(0); PG8_BAR; PG8_MMA(1, 0, At, B0); PG8_MMA(1, 1, At, B1); PG8_BAR; PG8_SCHED;
            PG8_LDB(B0, 1, 0); PG8_LDB(B1, 1, 1); PG8_SCHED; PG8_LDA(At, 1, 0); PG8_STAGE(PG8_SA(0, 1), a2 + hstep, voffA);
            PG8_WAIT_V(8); PG8_WAIT_L(0); PG8_BAR; PG8_MMA(0, 0, At, B0); PG8_MMA(0, 1, At, B1); PG8_BAR; PG8_SCHED;
            PG8_LDA(At, 1, 1); PG8_STAGE(PG8_SB(1, 0), b3, voffB); PG8_STAGE(PG8_SB(1, 1), b3 + hstep, voffB); PG8_STAGE(PG8_SA(1, 0), a3, voffA);
            PG8_WAIT_V(8); PG8_WAIT_L(0); PG8_BAR; PG8_MMA(1, 0, At, B0); PG8_MMA(1, 1, At, B1); PG8_BAR; PG8_SCHED;
            } else {
            PG8_LDB(B0, 0, 0); PG8_SCHED; PG8_LDA(At, 0, 0); PG8_STAGE(PG8_SA(1, 1), a1 + hstep, voffA);
            PG8_WAIT_L(8); PG8_BAR; PG8_WAIT_L(0); PG8_MMA(0, 0, At, B0); PG8_BAR; PG8_SCHED;
            PG8_LDB(B1, 0, 1); PG8_STAGE(PG8_SB(0, 0), b2, voffB);
            PG8_BAR; PG8_WAIT_L(0); PG8_MMA(0, 1, At, B1); PG8_BAR;
            PG8_LDA(At, 0, 1); PG8_STAGE(PG8_SA(0, 0), a2, voffA);
            PG8_BAR; PG8_WAIT_L(0); PG8_MMA(1, 0, At, B0); PG8_BAR; PG8_SCHED;
            PG8_STAGE(PG8_SB(0, 1), b2 + hstep, voffB);
            PG8_WAIT_V(6); PG8_BAR; PG8_MMA(1, 1, At, B1); PG8_BAR;
            PG8_LDB(B0, 1, 0); PG8_SCHED; PG8_LDA(At, 1, 0); PG8_STAGE(PG8_SA(0, 1), a2 + hstep, voffA);
            PG8_WAIT_L(8); PG8_BAR; PG8_WAIT_L(0); PG8_MMA(0, 0, At, B0); PG8_BAR; PG8_SCHED;
            PG8_LDB(B1, 1, 1); PG8_STAGE(PG8_SB(1, 0), b3, voffB);
            PG8_BAR; PG8_WAIT_L(0); PG8_MMA(0, 1, At, B1); PG8_BAR;
            PG8_LDA(At, 1, 1); PG8_STAGE(PG8_SA(1, 0), a3, voffA);
            PG8_BAR; PG8_WAIT_L(0); PG8_MMA(1, 0, At, B0); PG8_BAR; PG8_SCHED;
            PG8_STAGE(PG8_SB(1, 1), b3 + hstep, voffB);
            PG8_WAIT_V(6); PG8_BAR; PG8_MMA(1, 1, At, B1); PG8_BAR;
            }
        }
        if constexpr (ALIGN_EPI) { if (wr == 0) PG8_BAR; }
        if constexpr (!Epi::AFTER_DRAIN) { E(acc, cur, wr, wc, fr, fq); S.done(cur); }
        if (!has_next) break;
#pragma unroll
        for (int a = 0; a < 2; ++a)
#pragma unroll
            for (int b = 0; b < 2; ++b)
#pragma unroll
                for (int m = 0; m < 4; ++m)
#pragma unroll
                    for (int n = 0; n < 2; ++n) acc[a][b][m][n] = (f32x4){0.f, 0.f, 0.f, 0.f};
        cur = nxt; cA = nA; cB = nB; ++ui;
        if constexpr (ALIGN_EPI) { if (wr == 1) PG8_BAR; }
    }
    PG8_WAIT_V(0);
    if constexpr (!ALIGN_EPI) { if (wr == 0) PG8_BAR; }
    PG8_BAR;
    if constexpr (Epi::AFTER_DRAIN) { E.fused(acc, cur, wr, wc, fr, fq, lds, wid, lane); S.done(cur); }
#undef PG8_SA
#undef PG8_SB
#undef PG8_STAGE
#undef PG8_LDA
#undef PG8_LDB
#undef PG8_MMA
#undef PG8_WAIT_V
#undef PG8_WAIT_L
#undef PG8_BAR
#undef PG8_SCHED
}
}

constexpr int NWAVES = 8, NTHR = NWAVES * 64;
constexpr int BATCH = 2, SEQ = 8192, M = BATCH * SEQ, DM = 4096, DEPTH = 2;
constexpr int SSD_W = 2048, SSD_H = 32, SSD_CD = 4096;
constexpr int SWA_W = 1024, SWA_H = 16;
constexpr int GLA_W = 1024, GLA_KT = 512;
constexpr int DFF = 11008, DIN = 10800, DINP = 11008, DGU = 2 * DFF;
constexpr float EPS = 1e-6f;
constexpr int C_Z = 0, C_XBC = 2048, C_DT = 6144, C_SQ = 6176, C_SK = 7200, C_SV = 7456, C_GQ = 7712, C_GK = 8224, C_GV = 8736, C_GG = 9760, C_GLR = 10784;
enum { I_X = 0, I_ATTN_NORM, I_W_IN, I_SSD_CONV_W, I_SSD_CONV_B, I_SSD_DT_BIAS, I_SSD_A_LOG, I_SSD_D, I_SSD_NORM, I_SWA_SINKS, I_SWA_NORM, I_GLA_W_GATE, I_GLA_B_GATE, I_GLA_NORM,
       I_W_OUT, I_FFN_NORM, I_W_GATE, I_W_UP, I_FFN_CONV_W, I_FFN_CONV_B, I_W_DOWN, I_REL_BIAS, I_FINAL_NORM, N_IN };

constexpr size_t MiB = 1u << 20;
constexpr size_t WS_CTL = 0, CTL_ZERO_BYTES = 1 * MiB;
constexpr size_t WS_WIN = 1 * MiB;
constexpr size_t WS_WOUT = 87 * MiB;
constexpr size_t WS_WGU = 119 * MiB;
constexpr size_t WS_WDN = 291 * MiB;
constexpr size_t WS_H = 377 * MiB;
constexpr size_t WS_R = 505 * MiB;
constexpr size_t WS_PROJ = WS_R;
constexpr size_t WS_YSSD = WS_R + 344 * MiB;
constexpr size_t WS_OSWA = WS_R + 472 * MiB;
constexpr size_t WS_OGLA = WS_R + 536 * MiB;
constexpr size_t WS_Y = WS_R + 600 * MiB;
constexpr size_t WS_GU = WS_R;
constexpr size_t WS_ACT = WS_R + 688 * MiB;
constexpr size_t WS_END = WS_R + 1032 * MiB;
static_assert(DEPTH == 2 && (size_t)DINP * DM * 2 == 86 * MiB && (size_t)DGU * DM * 2 == 172 * MiB && (size_t)M * DINP * 2 == 344 * MiB && (size_t)M * DGU * 2 == 688 * MiB, "ws map");
constexpr int CW_BAR = 4096;

constexpr int RING_BYTES = 131072;
constexpr int MISC_OFF = RING_BYTES + 320;
constexpr int LDS_BYTES = 147456;

#define GAS __attribute__((address_space(1)))
#define LAS __attribute__((address_space(3)))
typedef unsigned short bf16;
typedef unsigned v4u __attribute__((ext_vector_type(4)));
typedef unsigned v2u __attribute__((ext_vector_type(2)));
typedef float f32x4 __attribute__((ext_vector_type(4)));
typedef GAS unsigned gu32;
#define RLX_AGENT __ATOMIC_RELAXED, __HIP_MEMORY_SCOPE_AGENT
#define LDS_WAIT() asm volatile("s_waitcnt lgkmcnt(0)" ::: "memory")
__device__ __forceinline__ unsigned f2bf(float f) { unsigned u = __builtin_bit_cast(unsigned, f); return (u + 0x7fffu + ((u >> 16) & 1u)) >> 16; }
__device__ __forceinline__ unsigned pk2(float lo, float hi) { return f2bf(lo) | (f2bf(hi) << 16); }
__device__ __forceinline__ float bflo(unsigned w) { return __uint_as_float(w << 16); }
__device__ __forceinline__ float bfhi(unsigned w) { return __uint_as_float(w & 0xffff0000u); }
__device__ __forceinline__ float bf1(bf16 h) { return __uint_as_float((unsigned)h << 16); }
__device__ __forceinline__ float silu_f(float x) { return x / (1.f + __expf(-x)); }
__device__ __forceinline__ float wave_sum(float v) {
#pragma unroll
    for (int o = 1; o < 64; o <<= 1) v += __shfl_xor(v, o);
    return v;
}
template <int CTRL> __device__ __forceinline__ float dpp_f(float v) { return __int_as_float(__builtin_amdgcn_update_dpp(0, __float_as_int(v), CTRL, 0xf, 0xf, false)); }
__device__ __forceinline__ float row16_sum(float v) { v += dpp_f<0xB1>(v); v += dpp_f<0x4E>(v); v += dpp_f<0x124>(v); v += dpp_f<0x128>(v); return v; }
__device__ __forceinline__ float pair_sum(float v) { return v + dpp_f<0xB1>(v); }
#define XB_TMO      128
#define XB_XCNT(j)  (256  + 64 * (j))
#define XB_XSUB(j)  (1280 + 64 * (j))
#define XB_XGEN(j)  (2304 + 64 * (j))
#define XB_TOP      3328
#define XB_TOPGEN   3392
#define XCD_BAR_WORDS 3456
#define XB_SPIN_CAP (1u << 18)

__device__ __forceinline__ unsigned xb_ld(unsigned* p)              { return __hip_atomic_load(p, __ATOMIC_RELAXED, __HIP_MEMORY_SCOPE_AGENT); }
__device__ __forceinline__ unsigned xb_add(unsigned* p, unsigned v) { return __hip_atomic_fetch_add(p, v, __ATOMIC_RELAXED, __HIP_MEMORY_SCOPE_AGENT); }
__device__ __forceinline__ unsigned xb_xcc_id() { return (unsigned)__builtin_amdgcn_s_getreg((3 << 11) | 20) & 0xFu; }
#define XB_SPIN(cond, bar) do { unsigned _sp = 0; while (cond) { __builtin_amdgcn_s_sleep(1); \
    if ((++_sp & 255u) == 0u) { if (xb_ld(&(bar)[XB_TMO])) break; if (_sp > XB_SPIN_CAP) { atomicAdd(&(bar)[XB_TMO], 1u); break; } } } } while (0)

struct XcdBarrier {
    unsigned* bar; unsigned x;
    volatile LAS unsigned* st;
};

__device__ __forceinline__ XcdBarrier xcd_barrier_post(unsigned* bar, volatile LAS unsigned* st) {
    XcdBarrier b; b.bar = bar; b.x = xb_xcc_id(); b.st = st;
    if (threadIdx.x == 0) (void)xb_add(&bar[XB_XCNT(b.x)], 1u);
    return b;
}
__device__ __forceinline__ void xcd_barrier_complete(unsigned* bar, unsigned x, unsigned& nloc, unsigned& nx) {
    const unsigned G = gridDim.x * gridDim.y * gridDim.z;
    unsigned sum, cnt, mine, sp = 0u;
    for (;;) {
        sum = 0u; cnt = 0u; mine = 0u;
#pragma unroll
        for (unsigned j = 0; j < 16; ++j) { const unsigned c = xb_ld(&bar[XB_XCNT(j)]); sum += c; cnt += (c > 0u) ? 1u : 0u; mine = (j == x) ? c : mine; }
        if (sum == G) break;
        __builtin_amdgcn_s_sleep(1);
        if ((++sp & 255u) == 0u) { if (xb_ld(&bar[XB_TMO])) break; if (sp > XB_SPIN_CAP) { atomicAdd(&bar[XB_TMO], 1u); break; } }
    }
    nloc = mine > 0u ? mine : 1u; nx = cnt > 0u ? cnt : 1u;
}

__device__ __forceinline__ void xcd_barrier(const XcdBarrier& b) {
    asm volatile("s_waitcnt vmcnt(0)" ::: "memory");
    __syncthreads();
    if (threadIdx.x == 0) {
        unsigned* bar = b.bar;
        __builtin_amdgcn_s_waitcnt(0);
        unsigned nloc = b.st[0], nx = b.st[1];
        if (nloc == 0u) { xcd_barrier_complete(bar, b.x, nloc, nx); b.st[0] = nloc; b.st[1] = nx; }
        const unsigned old = xb_add(&bar[XB_XSUB(b.x)], 1u);
        const unsigned gen = old / nloc;
        if (old + 1u == (gen + 1u) * nloc) {
            __builtin_amdgcn_fence(__ATOMIC_RELEASE, "agent");
            asm volatile("s_waitcnt vmcnt(0)" ::: "memory");
            const unsigned og = xb_add(&bar[XB_TOP], 1u);
            const unsigned tg = og / nx;
            if (og + 1u == (tg + 1u) * nx) xb_add(&bar[XB_TOPGEN], 1u);
            else XB_SPIN(xb_ld(&bar[XB_TOPGEN]) == tg, bar);
            __builtin_amdgcn_fence(__ATOMIC_ACQUIRE, "agent");
            xb_add(&bar[XB_XGEN(b.x)], 1u);
            asm volatile("s_waitcnt vmcnt(0)" ::: "memory");
        } else {
            XB_SPIN(xb_ld(&bar[XB_XGEN(b.x)]) == gen, bar);
            __builtin_amdgcn_fence(__ATOMIC_ACQUIRE, "agent");
            asm volatile("s_waitcnt vmcnt(0)" ::: "memory");
        }
    }
    __syncthreads();
}

struct Args { const float* in[N_IN]; float* out; unsigned char* ws; int ph_lo, ph_hi, li, pad; };
struct Ctx {
    LAS unsigned char* lds;
    int tid, lane, wave, G, bid;
    const float* const* in; float* out; unsigned char* ws;
};
__device__ const unsigned char T5_BUCKET[128] = {0, 1, 2, 3, 4, 5, 6, 7, 8, 9, 10, 11, 12, 13, 14, 15, 16, 16, 16, 17, 17, 18, 18, 18, 19, 19, 19, 20, 20, 20, 20, 21, 21, 21, 21, 22, 22, 22, 22, 22, 23, 23, 23, 23, 23, 23, 24, 24, 24, 24, 24, 24, 25, 25, 25, 25, 25, 25, 25, 26, 26, 26, 26, 26, 26, 26, 26, 27, 27, 27, 27, 27, 27, 27, 27, 27, 27, 28, 28, 28, 28, 28, 28, 28, 28, 28, 28, 29, 29, 29, 29, 29, 29, 29, 29, 29, 29, 29, 29, 30, 30, 30, 30, 30, 30, 30, 30, 30, 30, 30, 30, 30, 30, 31, 31, 31, 31, 31, 31, 31, 31, 31, 31, 31, 31, 31, 31, 31};

__device__ __forceinline__ void transpose_item(const float* W, int K, int N, bf16* WT, int row_off, LAS float* scr, int kb, int nb, int lane) {
    const int k0 = 64 * kb, n0 = 32 * nb; const int nn = n0 + (lane & 31); const bool nv = nn < N;
#pragma unroll 8
    for (int i = 0; i < 32; ++i) { const int kk = 2 * i + (lane >> 5); scr[kk * 33 + (lane & 31)] = nv ? W[(size_t)(k0 + kk) * N + nn] : 0.f; }
    LDS_WAIT(); asm volatile("" ::: "memory");
    const int c = lane & 7;
#pragma unroll
    for (int j = 0; j < 4; ++j) { const int n = (lane >> 3) + 8 * j; const LAS float* s = scr + (8 * c) * 33 + n;
        v4u o; o.x = pk2(s[0 * 33], s[1 * 33]); o.y = pk2(s[2 * 33], s[3 * 33]); o.z = pk2(s[4 * 33], s[5 * 33]); o.w = pk2(s[6 * 33], s[7 * 33]);
        *(GAS v4u*)(WT + (size_t)(row_off + n0 + n) * K + k0 + 8 * c) = o; }
    LDS_WAIT(); asm volatile("" ::: "memory");
}
__device__ __forceinline__ void convert_weights(Ctx& C, int l) {
    LAS float* scr = (LAS float*)(C.lds + C.wave * 16384);
    const int gw = C.bid * NWAVES + C.wave, NGW = C.G * NWAVES;
    constexpr int I_IN = 64 * 344, I_OUT = 64 * 128, I_G = 64 * 344, I_D = 172 * 128;
    constexpr int NITEMS = I_IN + I_OUT + 2 * I_G + I_D;
    const float* w_in = C.in[I_W_IN] + (size_t)l * DM * DIN; const float* w_out = C.in[I_W_OUT] + (size_t)l * DM * DM;
    const float* w_gate = C.in[I_W_GATE] + (size_t)l * DM * DFF; const float* w_up = C.in[I_W_UP] + (size_t)l * DM * DFF; const float* w_dn = C.in[I_W_DOWN] + (size_t)l * DFF * DM;
    bf16* WIN = (bf16*)(C.ws + WS_WIN); bf16* WOUT = (bf16*)(C.ws + WS_WOUT); bf16* WGU = (bf16*)(C.ws + WS_WGU); bf16* WDN = (bf16*)(C.ws + WS_WDN);
    for (int it = gw; it < NITEMS; it += NGW) {
        int r = it;
        if (r < I_IN) { transpose_item(w_in, DM, DIN, WIN, 0, scr, r / 344, r % 344, C.lane); continue; } r -= I_IN;
        if (r < I_OUT) { transpose_item(w_out, DM, DM, WOUT, 0, scr, r / 128, r % 128, C.lane); continue; } r -= I_OUT;
        if (r < I_G) { transpose_item(w_gate, DM, DFF, WGU, 0, scr, r / 344, r % 344, C.lane); continue; } r -= I_G;
        if (r < I_G) { transpose_item(w_up, DM, DFF, WGU, DFF, scr, r / 344, r % 344, C.lane); continue; } r -= I_G;
        transpose_item(w_dn, DFF, DM, WDN, 0, scr, r / 128, r % 128, C.lane);
    }
}
__device__ __forceinline__ void rmsnorm_row_bf16(const float* xrow, const float* w, bf16* orow, int lane) {
    const GAS f32x4* xr = (const GAS f32x4*)xrow + lane; const GAS f32x4* wr = (const GAS f32x4*)w + lane;
    f32x4 v[16]; float ss = 0.f;
#pragma unroll
    for (int j = 0; j < 16; ++j) { v[j] = xr[64 * j]; ss += (v[j].x * v[j].x + v[j].y * v[j].y) + (v[j].z * v[j].z + v[j].w * v[j].w); }
    const float rstd = 1.f / sqrtf(wave_sum(ss) * (1.f / DM) + EPS);
    GAS v2u* o8 = (GAS v2u*)orow + lane;
#pragma unroll
    for (int j = 0; j < 16; ++j) { const f32x4 g = wr[64 * j]; v2u o; o.x = pk2(v[j].x * rstd * g.x, v[j].y * rstd * g.y); o.y = pk2(v[j].z * rstd * g.z, v[j].w * rstd * g.w); o8[64 * j] = o; }
}
__device__ __forceinline__ void rmsnorm_phase(Ctx& C, const float* X, const float* w, bf16* H) {
    const int gw = C.bid * NWAVES + C.wave, NGW = C.G * NWAVES;
    for (int m = gw; m < M; m += NGW) rmsnorm_row_bf16(X + (size_t)m * DM, w, H + (size_t)m * DM, C.lane);
}
__device__ __forceinline__ void final_norm_phase(Ctx& C, float* X, const float* w) {
    const int gw = C.bid * NWAVES + C.wave, NGW = C.G * NWAVES;
    for (int m = gw; m < M; m += NGW) {
        GAS f32x4* xr = (GAS f32x4*)(X + (size_t)m * DM) + C.lane; const GAS f32x4* wr = (const GAS f32x4*)w + C.lane;
        f32x4 v[16]; float ss = 0.f;
#pragma unroll
        for (int j = 0; j < 16; ++j) { v[j] = xr[64 * j]; ss += (v[j].x * v[j].x + v[j].y * v[j].y) + (v[j].z * v[j].z + v[j].w * v[j].w); }
        const float rstd = 1.f / sqrtf(wave_sum(ss) * (1.f / DM) + EPS);
#pragma unroll
        for (int j = 0; j < 16; ++j) { const f32x4 g = wr[64 * j]; xr[64 * j] = v[j] * rstd * g; }
    }
}

constexpr int SSD_TC = 32;
constexpr int SSD_ROW = 288;
__device__ __forceinline__ int ssd_xcol(int h, int half, int g, int cg) { return cg < 4 ? (h * 64 + half * 32 + 8 * cg) : (cg < 20 ? (2048 + g * 128 + 8 * (cg - 4)) : (3072 + g * 128 + 8 * (cg - 20))); }
__device__ __forceinline__ void ssd_unit(Ctx& C, int l, int unit) {
    const int b = unit >> 6, h = (unit >> 1) & 31, half = unit & 1, g = h >> 2;
    const int tid = C.tid;
    LAS float* L = (LAS float*)C.lds;
    LAS float* cw = L;
    LAS float* cb = L + 1152;
    LAS float* S = L + 2048;
    LAS float* dts = L + 2048 + 32 * SSD_ROW;
    LAS float* dAs = dts + 32;
    LAS float* ys = dAs + 32;
    const bf16* PROJ = (const bf16*)(C.ws + WS_PROJ); float* YSSD = (float*)(C.ws + WS_YSSD);
    const float* conv_w = C.in[I_SSD_CONV_W] + (size_t)l * 4 * SSD_CD; const float* conv_b = C.in[I_SSD_CONV_B] + (size_t)l * SSD_CD;
    const float dt_bias = C.in[I_SSD_DT_BIAS][l * SSD_H + h]; const float Ah = -expf(C.in[I_SSD_A_LOG][l * SSD_H + h]); const float Dh = C.in[I_SSD_D][l * SSD_H + h];
    __syncthreads();
    if (tid < SSD_ROW) { const int xc = ssd_xcol(h, half, g, tid >> 3) + (tid & 7); cb[tid] = conv_b[xc];
#pragma unroll
        for (int i = 0; i < 4; ++i) cw[i * SSD_ROW + tid] = conv_w[i * SSD_CD + xc]; }
    int pt[3], pcg[3]; bool pv[3]; size_t pcol[3];
#pragma unroll
    for (int it = 0; it < 3; ++it) { const int idx = tid + NTHR * it; pv[it] = idx < SSD_TC * 36; pt[it] = pv[it] ? idx / 36 : 0; pcg[it] = pv[it] ? idx % 36 : 0; pcol[it] = (size_t)(C_XBC + ssd_xcol(h, half, g, pcg[it])); }
    const int pp = tid >> 4, ng = tid & 15;
    float hst[8];
#pragma unroll
    for (int j = 0; j < 8; ++j) hst[j] = 0.f;
    v4u raw[3][4]; unsigned dtraw = 0;
    const bf16* Pb = PROJ + (size_t)b * SEQ * DINP;
#define SSD_PREFETCH(t0) do { _Pragma("unroll") for (int it = 0; it < 3; ++it) _Pragma("unroll") for (int i = 0; i < 4; ++i) { const int s = (t0) + pt[it] - 3 + i; \
        raw[it][i] = (pv[it] && s >= 0) ? *(const GAS v4u*)(Pb + (size_t)s * DINP + pcol[it]) : (v4u){0u, 0u, 0u, 0u}; } \
        if (tid < SSD_TC) dtraw = Pb[(size_t)((t0) + tid) * DINP + C_DT + h]; } while (0)
    SSD_PREFETCH(0);
    __syncthreads();
    for (int t0 = 0; t0 < SEQ; t0 += SSD_TC) {
#pragma unroll
        for (int it = 0; it < 3; ++it) if (pv[it]) {
            const int c0 = 8 * pcg[it]; float a[8];
            { const f32x4 b0 = *(const LAS f32x4*)(cb + c0), b1 = *(const LAS f32x4*)(cb + c0 + 4); a[0] = b0.x; a[1] = b0.y; a[2] = b0.z; a[3] = b0.w; a[4] = b1.x; a[5] = b1.y; a[6] = b1.z; a[7] = b1.w; }
#pragma unroll
            for (int i = 0; i < 4; ++i) { const f32x4 w0 = *(const LAS f32x4*)(cw + i * SSD_ROW + c0), w1 = *(const LAS f32x4*)(cw + i * SSD_ROW + c0 + 4); const v4u r = raw[it][i];
                a[0] += w0.x * bflo(r.x); a[1] += w0.y * bfhi(r.x); a[2] += w0.z * bflo(r.y); a[3] += w0.w * bfhi(r.y);
                a[4] += w1.x * bflo(r.z); a[5] += w1.y * bfhi(r.z); a[6] += w1.z * bflo(r.w); a[7] += w1.w * bfhi(r.w); }
            f32x4 o0, o1; o0.x = silu_f(a[0]); o0.y = silu_f(a[1]); o0.z = silu_f(a[2]); o0.w = silu_f(a[3]); o1.x = silu_f(a[4]); o1.y = silu_f(a[5]); o1.z = silu_f(a[6]); o1.w = silu_f(a[7]);
            *(LAS f32x4*)(S + pt[it] * SSD_ROW + c0) = o0; *(LAS f32x4*)(S + pt[it] * SSD_ROW + c0 + 4) = o1;
        }
        if (tid < SSD_TC) { const float xr = bf1((bf16)dtraw) + dt_bias; const float dt = xr > 20.f ? xr : log1pf(expf(xr)); dts[tid] = dt; dAs[tid] = expf(dt * Ah); }
        __syncthreads();
        if (t0 + SSD_TC < SEQ) SSD_PREFETCH(t0 + SSD_TC);
#pragma unroll 4
        for (int i = 0; i < SSD_TC; ++i) {
            const LAS float* R = S + i * SSD_ROW;
            const float dt = dts[i], dA = dAs[i], xv = R[pp], xdt = xv * dt;
            float yp = 0.f;
#pragma unroll
            for (int jj = 0; jj < 2; ++jj) { const f32x4 Bv = *(const LAS f32x4*)(R + 32 + 4 * ng + 64 * jj), Cv = *(const LAS f32x4*)(R + 160 + 4 * ng + 64 * jj);
                hst[jj * 4 + 0] = hst[jj * 4 + 0] * dA + xdt * Bv.x; yp += hst[jj * 4 + 0] * Cv.x;
                hst[jj * 4 + 1] = hst[jj * 4 + 1] * dA + xdt * Bv.y; yp += hst[jj * 4 + 1] * Cv.y;
                hst[jj * 4 + 2] = hst[jj * 4 + 2] * dA + xdt * Bv.z; yp += hst[jj * 4 + 2] * Cv.z;
                hst[jj * 4 + 3] = hst[jj * 4 + 3] * dA + xdt * Bv.w; yp += hst[jj * 4 + 3] * Cv.w; }
            yp = row16_sum(yp);
            if (ng == 0) ys[i * 32 + pp] = yp + xv * Dh;
        }
        __syncthreads();
#pragma unroll
        for (int k = 0; k < 2; ++k) { const int idx = tid + NTHR * k, t = idx >> 5, p = idx & 31; YSSD[(size_t)(b * SEQ + t0 + t) * SSD_W + h * 64 + half * 32 + p] = ys[idx]; }
    }
#undef SSD_PREFETCH
    __syncthreads();
}

constexpr int GLA_TC = 32;
constexpr int GLA_ROW = 416;
__device__ __forceinline__ void gla_unit(Ctx& C, int l, int unit) {
    const int b = unit >> 5, h = (unit >> 3) & 3, e = unit & 7;
    const int tid = C.tid;
    LAS float* L = (LAS float*)C.lds;
    LAS float* wg = L;
    LAS float* bg = L + 2048;
    LAS float* S = L + 2304;
    LAS float* os = S + GLA_TC * GLA_ROW;
    const bf16* PROJ = (const bf16*)(C.ws + WS_PROJ); float* OGLA = (float*)(C.ws + WS_OGLA);
    const float* w_gate = C.in[I_GLA_W_GATE] + (size_t)l * 16 * GLA_KT; const float* b_gate = C.in[I_GLA_B_GATE] + (size_t)l * GLA_KT;
    __syncthreads();
    for (int i = tid; i < 16 * 128; i += NTHR) wg[i] = w_gate[(i >> 7) * GLA_KT + h * 128 + (i & 127)];
    if (tid < 128) bg[tid] = b_gate[h * 128 + tid];
    int pt[3], pcg[3]; bool pv[3]; size_t pcol[3];
#pragma unroll
    for (int it = 0; it < 3; ++it) { const int idx = tid + NTHR * it; pv[it] = idx < GLA_TC * 36; pt[it] = pv[it] ? idx / 36 : 0; pcg[it] = pv[it] ? idx % 36 : 0;
        const int cg = pcg[it]; pcol[it] = (size_t)(cg < 16 ? (C_GQ + h * 128 + 8 * cg) : (cg < 32 ? (C_GK + h * 128 + 8 * (cg - 16)) : (C_GV + h * 256 + e * 32 + 8 * (cg - 32)))); }
    const int vv = tid >> 4, kg = tid & 15;
    float st[8];
#pragma unroll
    for (int j = 0; j < 8; ++j) st[j] = 0.f;
    v4u raw[3]; v4u rg0, rg1;
    const bf16* Pb = PROJ + (size_t)b * SEQ * DINP;
#define GLA_PREFETCH(t0) do { _Pragma("unroll") for (int it = 0; it < 3; ++it) raw[it] = pv[it] ? *(const GAS v4u*)(Pb + (size_t)((t0) + pt[it]) * DINP + pcol[it]) : (v4u){0u, 0u, 0u, 0u}; \
        { const bf16* gp = Pb + (size_t)((t0) + (tid >> 4)) * DINP + C_GLR; rg0 = *(const GAS v4u*)gp; rg1 = *(const GAS v4u*)(gp + 8); } } while (0)
    GLA_PREFETCH(0);
    for (int t0 = 0; t0 < SEQ; t0 += GLA_TC) {
        __syncthreads();
#pragma unroll
        for (int it = 0; it < 3; ++it) if (pv[it]) {
            const int cg = pcg[it]; const float sc = cg < 16 ? 0.08838834764831845f : 1.f;
            const int dst = cg < 16 ? (128 + 8 * cg) : (cg < 32 ? (256 + 8 * (cg - 16)) : (384 + 8 * (cg - 32)));
            const v4u r = raw[it]; f32x4 o0, o1;
            o0.x = bflo(r.x) * sc; o0.y = bfhi(r.x) * sc; o0.z = bflo(r.y) * sc; o0.w = bfhi(r.y) * sc; o1.x = bflo(r.z) * sc; o1.y = bfhi(r.z) * sc; o1.z = bflo(r.w) * sc; o1.w = bfhi(r.w) * sc;
            *(LAS f32x4*)(S + pt[it] * GLA_ROW + dst) = o0; *(LAS f32x4*)(S + pt[it] * GLA_ROW + dst + 4) = o1;
        }
        {
            float gl[16];
            gl[0] = bflo(rg0.x); gl[1] = bfhi(rg0.x); gl[2] = bflo(rg0.y); gl[3] = bfhi(rg0.y); gl[4] = bflo(rg0.z); gl[5] = bfhi(rg0.z); gl[6] = bflo(rg0.w); gl[7] = bfhi(rg0.w);
            gl[8] = bflo(rg1.x); gl[9] = bfhi(rg1.x); gl[10] = bflo(rg1.y); gl[11] = bfhi(rg1.y); gl[12] = bflo(rg1.z); gl[13] = bfhi(rg1.z); gl[14] = bflo(rg1.w); gl[15] = bfhi(rg1.w);
            float z[8];
            { const f32x4 b0 = *(const LAS f32x4*)(bg + 8 * kg), b1 = *(const LAS f32x4*)(bg + 8 * kg + 4); z[0] = b0.x; z[1] = b0.y; z[2] = b0.z; z[3] = b0.w; z[4] = b1.x; z[5] = b1.y; z[6] = b1.z; z[7] = b1.w; }
#pragma unroll
            for (int r = 0; r < 16; ++r) { const f32x4 w0 = *(const LAS f32x4*)(wg + r * 128 + 8 * kg), w1 = *(const LAS f32x4*)(wg + r * 128 + 8 * kg + 4);
                z[0] += gl[r] * w0.x; z[1] += gl[r] * w0.y; z[2] += gl[r] * w0.z; z[3] += gl[r] * w0.w; z[4] += gl[r] * w1.x; z[5] += gl[r] * w1.y; z[6] += gl[r] * w1.z; z[7] += gl[r] * w1.w; }
            float av[8];
#pragma unroll
            for (int j = 0; j < 8; ++j) { const float ls = fminf(z[j], 0.f) - log1pf(expf(-fabsf(z[j]))); av[j] = expf(ls * 0.0625f); }
            *(LAS f32x4*)(S + (tid >> 4) * GLA_ROW + 8 * kg) = (f32x4){av[0], av[1], av[2], av[3]}; *(LAS f32x4*)(S + (tid >> 4) * GLA_ROW + 8 * kg + 4) = (f32x4){av[4], av[5], av[6], av[7]};
        }
        __syncthreads();
        if (t0 + GLA_TC < SEQ) GLA_PREFETCH(t0 + GLA_TC);
#pragma unroll 4
        for (int i = 0; i < GLA_TC; ++i) {
            const LAS float* R = S + i * GLA_ROW;
            const float vval = R[384 + vv]; float op = 0.f;
#pragma unroll
            for (int jj = 0; jj < 2; ++jj) { const f32x4 av = *(const LAS f32x4*)(R + 4 * kg + 64 * jj), qv = *(const LAS f32x4*)(R + 128 + 4 * kg + 64 * jj), kv = *(const LAS f32x4*)(R + 256 + 4 * kg + 64 * jj);
                st[jj * 4 + 0] = st[jj * 4 + 0] * av.x + kv.x * vval; op += qv.x * st[jj * 4 + 0];
                st[jj * 4 + 1] = st[jj * 4 + 1] * av.y + kv.y * vval; op += qv.y * st[jj * 4 + 1];
                st[jj * 4 + 2] = st[jj * 4 + 2] * av.z + kv.z * vval; op += qv.z * st[jj * 4 + 2];
                st[jj * 4 + 3] = st[jj * 4 + 3] * av.w + kv.w * vval; op += qv.w * st[jj * 4 + 3]; }
            op = row16_sum(op);
            if (kg == 0) os[i * 32 + vv] = op;
        }
        __syncthreads();
#pragma unroll
        for (int k = 0; k < 2; ++k) { const int idx = tid + NTHR * k, t = idx >> 5, v = idx & 31; OGLA[(size_t)(b * SEQ + t0 + t) * GLA_W + h * 256 + e * 32 + v] = os[idx]; }
    }
#undef GLA_PREFETCH
    __syncthreads();
}

__device__ __forceinline__ void swa_unit(Ctx& C, int l, int unit) {
    const int qb = unit & 127, kvh = (unit >> 7) & 3, b = unit >> 9;
    const int tid = C.tid, pair = tid >> 1, g = pair >> 6, qi = pair & 63, dh = tid & 1, q0 = qb * 64, head = kvh * 4 + g;
    LAS float* L = (LAS float*)C.lds;
    LAS float* Ks = L;
    LAS float* Vs = L + 192 * 64;
    LAS float* bias = L + 2 * 192 * 64;
    const bf16* PROJ = (const bf16*)(C.ws + WS_PROJ); float* OSWA = (float*)(C.ws + WS_OSWA);
    const bf16* Pb = PROJ + (size_t)b * SEQ * DINP;
    __syncthreads();
    { const int gg = tid >> 7, dist = tid & 127; bias[tid] = C.in[I_REL_BIAS][T5_BUCKET[dist] * SWA_H + kvh * 4 + gg]; }
#pragma unroll
    for (int it = 0; it < 6; ++it) { const int idx = tid + NTHR * it; const int kv = idx / 1536, r = idx % 1536, j = r >> 3, cg = r & 7; const int s = q0 - 128 + j;
        v4u w = (v4u){0u, 0u, 0u, 0u};
        if (s >= 0) w = *(const GAS v4u*)(Pb + (size_t)s * DINP + (kv ? C_SV : C_SK) + kvh * 64 + 8 * cg);
        LAS float* d = (kv ? Vs : Ks) + j * 64 + 8 * cg;
        *(LAS f32x4*)d = (f32x4){bflo(w.x), bfhi(w.x), bflo(w.y), bfhi(w.y)}; *(LAS f32x4*)(d + 4) = (f32x4){bflo(w.z), bfhi(w.z), bflo(w.w), bfhi(w.w)}; }
    float q[32], acc[32];
    { const bf16* qp = Pb + (size_t)(q0 + qi) * DINP + C_SQ + head * 64 + dh * 32;
#pragma unroll
      for (int k = 0; k < 4; ++k) { const v4u w = *(const GAS v4u*)(qp + 8 * k);
          q[8 * k + 0] = bflo(w.x) * 0.125f; q[8 * k + 1] = bfhi(w.x) * 0.125f; q[8 * k + 2] = bflo(w.y) * 0.125f; q[8 * k + 3] = bfhi(w.y) * 0.125f;
          q[8 * k + 4] = bflo(w.z) * 0.125f; q[8 * k + 5] = bfhi(w.z) * 0.125f; q[8 * k + 6] = bflo(w.w) * 0.125f; q[8 * k + 7] = bfhi(w.w) * 0.125f; } }
#pragma unroll
    for (int d = 0; d < 32; ++d) acc[d] = 0.f;
    const float sink = C.in[I_SWA_SINKS][l * SWA_H + head];
    float m = sink, lsum = 0.f;
    __syncthreads();
    const int qi0 = __builtin_amdgcn_readfirstlane(qi) & ~31;
    const int jlo = qi0 + 1, jhi = qi0 + 31 + 128;
    for (int j = jlo; j <= jhi; ++j) {
        const int dist = qi + 128 - j; const bool valid = (dist >= 0) && (dist < 128) && (q0 - 128 + j >= 0);
        const LAS float* kr = Ks + j * 64 + dh * 32; float dot = 0.f;
#pragma unroll
        for (int k = 0; k < 8; ++k) { const f32x4 kk = *(const LAS f32x4*)(kr + 4 * k); dot += q[4 * k] * kk.x + q[4 * k + 1] * kk.y + q[4 * k + 2] * kk.z + q[4 * k + 3] * kk.w; }
        dot = pair_sum(dot);
        const float sc = dot + bias[g * 128 + (dist & 127)];
        const float mn = valid ? fmaxf(m, sc) : m;
        const float corr = __expf(m - mn), p = valid ? __expf(sc - mn) : 0.f;
        m = mn; lsum = lsum * corr + p;
        const LAS float* vr = Vs + j * 64 + dh * 32;
#pragma unroll
        for (int k = 0; k < 8; ++k) { const f32x4 vv = *(const LAS f32x4*)(vr + 4 * k);
            acc[4 * k] = acc[4 * k] * corr + p * vv.x; acc[4 * k + 1] = acc[4 * k + 1] * corr + p * vv.y; acc[4 * k + 2] = acc[4 * k + 2] * corr + p * vv.z; acc[4 * k + 3] = acc[4 * k + 3] * corr + p * vv.w; }
    }
    const float inv = 1.f / (lsum + __expf(sink - m));
    float* op = OSWA + (size_t)(b * SEQ + q0 + qi) * SWA_W + head * 64 + dh * 32;
#pragma unroll
    for (int k = 0; k < 8; ++k) *(GAS f32x4*)(op + 4 * k) = (f32x4){acc[4 * k] * inv, acc[4 * k + 1] * inv, acc[4 * k + 2] * inv, acc[4 * k + 3] * inv};
}

constexpr int N_SSD_UNITS = BATCH * SSD_H * 2, N_GLA_UNITS = BATCH * 4 * 8, N_SWA_UNITS = BATCH * 4 * (SEQ / 64);
__device__ __forceinline__ void mixer_phase(Ctx& C, int l) {
    const int G = C.G, bid = C.bid;
    if (G >= N_SSD_UNITS + N_GLA_UNITS + 1) {
        if (bid < N_SSD_UNITS) ssd_unit(C, l, bid);
        else if (bid < N_SSD_UNITS + N_GLA_UNITS) gla_unit(C, l, bid - N_SSD_UNITS);
        else for (int u = bid - (N_SSD_UNITS + N_GLA_UNITS); u < N_SWA_UNITS; u += G - (N_SSD_UNITS + N_GLA_UNITS)) swa_unit(C, l, u);
    } else {
        for (int u = bid; u < N_SSD_UNITS; u += G) ssd_unit(C, l, u);
        for (int u = bid; u < N_GLA_UNITS; u += G) gla_unit(C, l, u);
        for (int u = bid; u < N_SWA_UNITS; u += G) swa_unit(C, l, u);
    }
}

__device__ __forceinline__ void finalize_phase(Ctx& C, int l) {
    const int gw = C.bid * NWAVES + C.wave, NGW = C.G * NWAVES, lane = C.lane;
    const bf16* PROJ = (const bf16*)(C.ws + WS_PROJ); const float* YSSD = (const float*)(C.ws + WS_YSSD); const float* OSWA = (const float*)(C.ws + WS_OSWA); const float* OGLA = (const float*)(C.ws + WS_OGLA);
    bf16* Y = (bf16*)(C.ws + WS_Y);
    const float* ssd_norm = C.in[I_SSD_NORM] + (size_t)l * SSD_W; const float* swa_norm = C.in[I_SWA_NORM] + (size_t)l * SWA_W; const float* gla_norm = C.in[I_GLA_NORM] + (size_t)l * 256;
    for (int m = gw; m < M; m += NGW) {
        const bf16* pr = PROJ + (size_t)m * DINP; bf16* yr = Y + (size_t)m * DM;
#pragma unroll 2
        for (int grp = 0; grp < 8; ++grp) { const int c = 256 * grp + 4 * lane;
            const f32x4 y = *(const GAS f32x4*)(YSSD + (size_t)m * SSD_W + c); const v2u zz = *(const GAS v2u*)(pr + C_Z + c); const f32x4 w = *(const GAS f32x4*)(ssd_norm + c);
            f32x4 v; v.x = y.x * silu_f(bflo(zz.x)); v.y = y.y * silu_f(bfhi(zz.x)); v.z = y.z * silu_f(bflo(zz.y)); v.w = y.w * silu_f(bfhi(zz.y));
            const float ss = wave_sum((v.x * v.x + v.y * v.y) + (v.z * v.z + v.w * v.w)); const float rstd = 1.f / sqrtf(ss * (1.f / 256.f) + EPS);
            v2u o; o.x = pk2(v.x * rstd * w.x, v.y * rstd * w.y); o.y = pk2(v.z * rstd * w.z, v.w * rstd * w.w); *(GAS v2u*)(yr + c) = o; }
        { f32x4 v[4]; float ss = 0.f;
#pragma unroll
          for (int j = 0; j < 4; ++j) { v[j] = *(const GAS f32x4*)(OSWA + (size_t)m * SWA_W + 256 * j + 4 * lane); ss += (v[j].x * v[j].x + v[j].y * v[j].y) + (v[j].z * v[j].z + v[j].w * v[j].w); }
          const float rstd = 1.f / sqrtf(wave_sum(ss) * (1.f / 1024.f) + EPS);
#pragma unroll
          for (int j = 0; j < 4; ++j) { const int c = 256 * j + 4 * lane; const f32x4 w = *(const GAS f32x4*)(swa_norm + c);
              v2u o; o.x = pk2(v[j].x * rstd * w.x, v[j].y * rstd * w.y); o.y = pk2(v[j].z * rstd * w.z, v[j].w * rstd * w.w); *(GAS v2u*)(yr + 2048 + c) = o; } }
#pragma unroll 2
        for (int hd = 0; hd < 4; ++hd) { const int c = 256 * hd + 4 * lane;
            const f32x4 v = *(const GAS f32x4*)(OGLA + (size_t)m * GLA_W + c); const v2u gg = *(const GAS v2u*)(pr + C_GG + c); const f32x4 w = *(const GAS f32x4*)(gla_norm + 4 * lane);
            const float ss = wave_sum((v.x * v.x + v.y * v.y) + (v.z * v.z + v.w * v.w)); const float rstd = 1.f / sqrtf(ss * (1.f / 256.f) + EPS);
            v2u o; o.x = pk2(v.x * rstd * w.x * silu_f(bflo(gg.x)), v.y * rstd * w.y * silu_f(bfhi(gg.x))); o.y = pk2(v.z * rstd * w.z * silu_f(bflo(gg.y)), v.w * rstd * w.w * silu_f(bfhi(gg.y))); *(GAS v2u*)(yr + 3072 + c) = o; }
    }
}

__device__ __forceinline__ void act_phase(Ctx& C, int l) {
    const bf16* GU = (const bf16*)(C.ws + WS_GU); bf16* ACT = (bf16*)(C.ws + WS_ACT);
    const float* cw = C.in[I_FFN_CONV_W] + (size_t)l * 3 * DFF; const float* cb = C.in[I_FFN_CONV_B] + (size_t)l * DFF;
    constexpr int NCG = DFF / 8, NRB = M / 32; constexpr long NIT = (long)NCG * NRB;
    for (long it = (long)C.bid * NTHR + C.tid; it < NIT; it += (long)C.G * NTHR) {
        const int cg = (int)(it % NCG), rb = (int)(it / NCG), c0 = 8 * cg, r0 = 32 * rb;
        float w0[8], w1[8], w2[8], bb[8];
#pragma unroll
        for (int e = 0; e < 8; ++e) { w0[e] = cw[c0 + e]; w1[e] = cw[DFF + c0 + e]; w2[e] = cw[2 * DFF + c0 + e]; bb[e] = cb[c0 + e]; }
        float g1[8], g2[8];
        const bool first = (r0 % SEQ) == 0;
        { v4u a = (v4u){0u, 0u, 0u, 0u}, b2 = (v4u){0u, 0u, 0u, 0u};
          if (!first) { a = *(const GAS v4u*)(GU + (size_t)(r0 - 1) * DGU + c0); b2 = *(const GAS v4u*)(GU + (size_t)(r0 - 2) * DGU + c0); }
          g1[0] = bflo(a.x); g1[1] = bfhi(a.x); g1[2] = bflo(a.y); g1[3] = bfhi(a.y); g1[4] = bflo(a.z); g1[5] = bfhi(a.z); g1[6] = bflo(a.w); g1[7] = bfhi(a.w);
          g2[0] = bflo(b2.x); g2[1] = bfhi(b2.x); g2[2] = bflo(b2.y); g2[3] = bfhi(b2.y); g2[4] = bflo(b2.z); g2[5] = bfhi(b2.z); g2[6] = bflo(b2.w); g2[7] = bfhi(b2.w); }
#pragma unroll 4
        for (int r = 0; r < 32; ++r) {
            const v4u gw_ = *(const GAS v4u*)(GU + (size_t)(r0 + r) * DGU + c0), uw = *(const GAS v4u*)(GU + (size_t)(r0 + r) * DGU + DFF + c0);
            float g0[8], u[8], o[8];
            g0[0] = bflo(gw_.x); g0[1] = bfhi(gw_.x); g0[2] = bflo(gw_.y); g0[3] = bfhi(gw_.y); g0[4] = bflo(gw_.z); g0[5] = bfhi(gw_.z); g0[6] = bflo(gw_.w); g0[7] = bfhi(gw_.w);
            u[0] = bflo(uw.x); u[1] = bfhi(uw.x); u[2] = bflo(uw.y); u[3] = bfhi(uw.y); u[4] = bflo(uw.z); u[5] = bfhi(uw.z); u[6] = bflo(uw.w); u[7] = bfhi(uw.w);
#pragma unroll
            for (int e = 0; e < 8; ++e) { const float gc = bb[e] + w0[e] * g2[e] + w1[e] * g1[e] + w2[e] * g0[e]; o[e] = silu_f(gc) * u[e]; g2[e] = g1[e]; g1[e] = g0[e]; }
            v4u ow; ow.x = pk2(o[0], o[1]); ow.y = pk2(o[2], o[3]); ow.z = pk2(o[4], o[5]); ow.w = pk2(o[6], o[7]);
            *(GAS v4u*)(ACT + (size_t)(r0 + r) * DFF + c0) = ow;
        }
    }
}

constexpr int PH_PER_LAYER = 9, PH_FINAL = DEPTH * PH_PER_LAYER, N_PHASES = PH_FINAL + 1;
#ifndef MK_ONE_LAUNCH
#define MK_ONE_LAUNCH 0
#endif
__global__ void __launch_bounds__(NTHR, 2) fwd_kernel(Args args) {
    extern __shared__ __attribute__((aligned(16))) unsigned char lds[];
    Ctx C;
    C.lds = (LAS unsigned char*)lds;
    C.tid = threadIdx.x; C.lane = C.tid & 63; C.wave = __builtin_amdgcn_readfirstlane(C.tid >> 6);
    C.G = gridDim.x; C.bid = blockIdx.x;
    C.in = args.in; C.out = args.out; C.ws = args.ws;
    volatile LAS unsigned* MISC = (volatile LAS unsigned*)(C.lds + MISC_OFF);
    for (int u = C.tid; u < (LDS_BYTES - RING_BYTES) / 4; u += NTHR) ((LAS unsigned*)(C.lds + RING_BYTES))[u] = 0u;
    __syncthreads();
    gu32* ctl = (gu32*)(args.ws + WS_CTL);
    XcdBarrier bar = xcd_barrier_post((unsigned*)(ctl + CW_BAR) + args.li * XCD_BAR_WORDS, MISC + 8);
    const int lo = args.ph_lo, hi = args.ph_hi;
#define IN(k) (lo <= (k) && (k) < hi)
#define SEAM(k) do { if (IN(k) && IN((k) + 1)) xcd_barrier(bar); } while (0)
    float* xres = args.out;
    bf16* H = (bf16*)(args.ws + WS_H);
#define LAYER_BODY(l) do { \
        const int pb = l * PH_PER_LAYER; \
        const float* xin = (l == 0) ? args.in[I_X] : (const float*)xres; \
        if (IN(pb + 0)) { convert_weights(C, l); rmsnorm_phase(C, xin, args.in[I_ATTN_NORM] + (size_t)l * DM, H); } \
        SEAM(pb + 0); \
        if (IN(pb + 1)) { \
            pg8::Gemm g{H, (const bf16*)(args.ws + WS_WIN), M, DINP, DM}; pg8::StaticOrder S; S.init(M, DINP, C.G, C.bid); \
            pg8::EpiBf16 E{(bf16*)(args.ws + WS_PROJ), DINP}; \
            pg8::gemm_phase<pg8::EpiBf16, pg8::StaticOrder, true, true>(C.lds, g, S, E); \
        } \
        SEAM(pb + 1); \
        if (IN(pb + 2)) mixer_phase(C, l); \
        SEAM(pb + 2); \
        if (IN(pb + 3)) finalize_phase(C, l); \
        SEAM(pb + 3); \
        if (IN(pb + 4)) { \
            pg8::Gemm g{(const bf16*)(args.ws + WS_Y), (const bf16*)(args.ws + WS_WOUT), M, DM, DM}; pg8::StaticOrder S; S.init(M, DM, C.G, C.bid); \
            pg8::EpiRes E{xin, xres, DM}; \
            pg8::gemm_phase<pg8::EpiRes, pg8::StaticOrder, true, true>(C.lds, g, S, E); \
        } \
        SEAM(pb + 4); \
        if (IN(pb + 5)) rmsnorm_phase(C, xres, args.in[I_FFN_NORM] + (size_t)l * DM, H); \
        SEAM(pb + 5); \
        if (IN(pb + 6)) { \
            pg8::Gemm g{H, (const bf16*)(args.ws + WS_WGU), M, DGU, DM}; pg8::StaticOrder S; S.init(M, DGU, C.G, C.bid); \
            pg8::EpiBf16 E{(bf16*)(args.ws + WS_GU), DGU}; \
            pg8::gemm_phase<pg8::EpiBf16, pg8::StaticOrder, true, true>(C.lds, g, S, E); \
        } \
        SEAM(pb + 6); \
        if (IN(pb + 7)) act_phase(C, l); \
        SEAM(pb + 7); \
        if (IN(pb + 8)) { \
            pg8::Gemm g{(const bf16*)(args.ws + WS_ACT), (const bf16*)(args.ws + WS_WDN), M, DM, DFF}; pg8::StaticOrder S; S.init(M, DM, C.G, C.bid); \
            pg8::EpiRes E{xres, xres, DM}; \
            pg8::gemm_phase<pg8::EpiRes, pg8::StaticOrder, true, true>(C.lds, g, S, E); \
        } \
        SEAM(pb + 8); \
     \
    } while (0)
    LAYER_BODY(0);
    LAYER_BODY(1);
#undef LAYER_BODY
    if (IN(PH_FINAL)) final_norm_phase(C, xres, args.in[I_FINAL_NORM]);
#undef IN
#undef SEAM
}

extern "C" void kernel_launch(void* const* d_in, const int* in_sizes, int n_in, void* d_out, int out_size, void* d_ws, size_t ws_size, hipStream_t stream) {
    static int grid = 0;
    if (grid == 0) {
        if (n_in != N_IN || out_size != M * DM || ws_size < WS_END) { fprintf(stderr, "kernel_launch: unexpected shapes (n_in %d, out %d, ws %zu < %zu)\n", n_in, out_size, ws_size, (size_t)WS_END); grid = -1; return; }
        int dev = 0, cus = 0, per_cu = 0;
        if (hipGetDevice(&dev) != hipSuccess || hipDeviceGetAttribute(&cus, hipDeviceAttributeMultiprocessorCount, dev) != hipSuccess) { grid = -1; return; }
        if (hipFuncSetAttribute((const void*)fwd_kernel, hipFuncAttributeMaxDynamicSharedMemorySize, LDS_BYTES) != hipSuccess) { fprintf(stderr, "kernel_launch: hipFuncSetAttribute failed\n"); grid = -1; return; }
        if (hipOccupancyMaxActiveBlocksPerMultiprocessor(&per_cu, (const void*)fwd_kernel, NTHR, LDS_BYTES) != hipSuccess || per_cu < 1) { fprintf(stderr, "kernel_launch: occupancy query says %d\n", per_cu); (void)hipGetLastError(); grid = -1; return; }
        grid = cus;
    }
    if (grid < 0) return;
    if (hipMemsetAsync((char*)d_ws + WS_CTL, 0, CTL_ZERO_BYTES, stream) != hipSuccess) return;
    Args a{};
    for (int i = 0; i < N_IN; ++i) a.in[i] = (const float*)d_in[i];
    a.out = (float*)d_out; a.ws = (unsigned char*)d_ws; a.pad = 0;
#if MK_ONE_LAUNCH
    a.ph_lo = 0; a.ph_hi = N_PHASES; a.li = 0;
    hipLaunchKernelGGL(fwd_kernel, dim3(grid), dim3(NTHR), LDS_BYTES, stream, a);
#else
    for (int p = 0; p < N_PHASES; ++p) { a.ph_lo = p; a.ph_hi = p + 1; a.li = p;
        hipLaunchKernelGGL(fwd_kernel, dim3(grid), dim3(NTHR), LDS_BYTES, stream, a); }
#endif
}
```

```cpp
#include <hip/hip_runtime.h>
#include <cstdio>
#include <cstdint>
namespace pg8 {
#define PG8_LAS __attribute__((address_space(3)))
typedef unsigned short bf16_t;
typedef short bf16x8 __attribute__((ext_vector_type(8)));
typedef float f32x4 __attribute__((ext_vector_type(4)));
typedef unsigned u32x4 __attribute__((ext_vector_type(4)));
constexpr int BM = 256, BK = 64, HALF = 128, HTB = HALF * BK * 2  , STAGE_BYTES = 8 * HTB, NXCD = 8, WGM = 8;

__host__ __device__ __forceinline__ int lds_byte(int r, int c) { const int st = (r >> 4) * 2 + (c >> 5), rr = r & 15, cc = c & 31, ob = rr * 64 + cc * 2; return st * 1024 + (ob ^ (((ob >> 9) & 1) << 5)); }
__host__ __device__ __forceinline__ void stage_rc(int b, int& R, int& C) { const int st = b / 1024, sb = b % 1024, swz = sb ^ (((sb >> 9) & 1) << 5); R = (st >> 1) * 16 + swz / 64; C = (st & 1) * 32 + (swz % 64) / 2; }
__host__ __device__ __forceinline__ int perm32(int rho) { const int n = rho >> 4, i = rho & 15; return 8 * (i >> 2) + 4 * n + (i & 3); }

struct Unit { int pm, pn; };
struct Gemm { const bf16_t* A; const bf16_t* Bt; int M, N, K; };

struct StaticOrder {
    int nM, nN, nwg, G, c;
    __host__ __device__ void init(int M, int N, int G_, int c_) { nM = M / BM; nN = N / BM; nwg = nM * nN; G = G_; c = c_; }
    __host__ __device__ bool next(int i, Unit& u) const {
        const long L = (long)i * G + c; if (L >= nwg) return false;
        int wgid = (int)L; { const int q = nwg / NXCD, r = nwg % NXCD, xcd = wgid % NXCD, off = wgid / NXCD; wgid = (xcd < r ? xcd * (q + 1) : r * (q + 1) + (xcd - r) * q) + off; }
        const int nig = WGM * nN, gid = wgid / nig, fm = gid * WGM, gsz = (nM - fm) < WGM ? (nM - fm) : WGM;
        u.pm = fm + ((wgid % nig) % gsz); u.pn = (wgid % nig) / gsz; return true;
    }
    __device__ __forceinline__ void a_ready(const Unit&) const {}
    __device__ __forceinline__ void done(const Unit&) const {}
};

__device__ __forceinline__ unsigned cvt_pk_bf16(float lo, float hi) { unsigned r; asm volatile("v_cvt_pk_bf16_f32 %0, %1, %2" : "=v"(r) : "v"(lo), "v"(hi)); return r; }

struct EpiBf16 {
    static constexpr bool PERM = true, AFTER_DRAIN = false;
    bf16_t* O; int ldc;
    __device__ __forceinline__ void operator()(const f32x4 (&acc)[2][2][4][2], const Unit& u, int wr, int wc, int fr, int fq) const {
        const int row0 = u.pm * BM + wr * 64 + fr; const int col0 = u.pn * BM + wc * 32 + 8 * fq;
#pragma unroll
        for (int ai = 0; ai < 2; ++ai)
#pragma unroll
            for (int m = 0; m < 4; ++m) { bf16_t* rowp = O + (size_t)(row0 + ai * HALF + m * 16) * ldc + col0;
#pragma unroll
                for (int bj = 0; bj < 2; ++bj) { const f32x4 v0 = acc[ai][bj][m][0], v1 = acc[ai][bj][m][1];
                    u32x4 w; w.x = cvt_pk_bf16(v0[0], v0[1]); w.y = cvt_pk_bf16(v0[2], v0[3]); w.z = cvt_pk_bf16(v1[0], v1[1]); w.w = cvt_pk_bf16(v1[2], v1[3]);
                    *(u32x4*)(rowp + bj * HALF) = w; } }
    }
};
struct EpiRes {
    static constexpr bool PERM = false, AFTER_DRAIN = false;
    const float* base; float* out; int ldc;
    __device__ __forceinline__ void operator()(const f32x4 (&acc)[2][2][4][2], const Unit& u, int wr, int wc, int fr, int fq) const {
        const int row0 = u.pm * BM + wr * 64 + fr, col0 = u.pn * BM + wc * 32 + 4 * fq;
#pragma unroll
        for (int ai = 0; ai < 2; ++ai)
#pragma unroll
            for (int m = 0; m < 4; ++m) { const size_t off = (size_t)(row0 + ai * HALF + m * 16) * ldc + col0;
#pragma unroll
                for (int bj = 0; bj < 2; ++bj)
#pragma unroll
                    for (int n = 0; n < 2; ++n) { const f32x4 bs = *(const f32x4*)(base + off + bj * HALF + n * 16); *(f32x4*)(out + off + bj * HALF + n * 16) = bs + acc[ai][bj][m][n]; } }
    }
};
template <class Epi, class Sched, bool ALIGN_EPI = false, bool SP2 = false>
__device__ __forceinline__ void gemm_phase(PG8_LAS unsigned char* lds, const Gemm g, const Sched& S, const Epi& E) {
    const int tid = threadIdx.x, wid = __builtin_amdgcn_readfirstlane(tid >> 6), lane = tid & 63, wr = wid >> 2, wc = wid & 3, fr = lane & 15, fq = lane >> 4;
    const int K = g.K, nt = K / BK;
    unsigned voffA[2], voffB[2];
#pragma unroll
    for (int i = 0; i < 2; ++i) { int R, C; stage_rc(tid * 16 + i * 8192, R, C); const int Rb = Epi::PERM ? ((R & ~31) + perm32(R & 31)) : R;
        voffA[i] = (unsigned)(R * K + C) * 2u; voffB[i] = (unsigned)(Rb * K + C) * 2u; }
    const size_t kstep = (size_t)(BK * 2);
    const size_t hstep = (size_t)HALF * K * 2;
    const size_t tstep = 2 * hstep;
    const unsigned ldsw = (unsigned)wid * 1024u;
    const int aoff = lds_byte(wr * 64 + fr, fq * 8), boff = lds_byte(wc * 32 + fr, fq * 8);
#define PG8_SA(b, h) (((b) * 2 + (h)) * HTB)
#define PG8_SB(b, h) ((4 + (b) * 2 + (h)) * HTB)
#define PG8_STAGE(bufoff, gbase, voff) do { _Pragma("unroll") for (int _i = 0; _i < 2; ++_i) \
        __builtin_amdgcn_global_load_lds((const unsigned*)((const char*)(gbase) + (voff)[_i]), (PG8_LAS unsigned*)(lds + (bufoff) + ldsw + _i * 8192), 16, 0, 0); } while (0)
#define PG8_LDA(dst, b, h) do { _Pragma("unroll") for (int m = 0; m < 4; ++m) _Pragma("unroll") for (int k = 0; k < 2; ++k) dst[m][k] = *(const PG8_LAS bf16x8*)(lds + PG8_SA(b, h) + aoff + m * 2048 + k * 1024); } while (0)
#define PG8_LDB(dst, b, h) do { _Pragma("unroll") for (int n = 0; n < 2; ++n) _Pragma("unroll") for (int k = 0; k < 2; ++k) dst[n][k] = *(const PG8_LAS bf16x8*)(lds + PG8_SB(b, h) + boff + n * 2048 + k * 1024); } while (0)
#define PG8_MMA(ai, bj, At, Bt) do { __builtin_amdgcn_s_setprio(1); _Pragma("unroll") for (int m = 0; m < 4; ++m) _Pragma("unroll") for (int n = 0; n < 2; ++n) _Pragma("unroll") for (int k = 0; k < 2; ++k) \
        acc[ai][bj][m][n] = __builtin_amdgcn_mfma_f32_16x16x32_bf16(Bt[n][k], At[m][k], acc[ai][bj][m][n], 0, 0, 0); __builtin_amdgcn_s_setprio(0); } while (0)
#define PG8_WAIT_V(n) asm volatile("s_waitcnt vmcnt(" #n ")" ::: "memory")
#define PG8_WAIT_L(n) asm volatile("s_waitcnt lgkmcnt(" #n ")" ::: "memory")
#define PG8_BAR __builtin_amdgcn_s_barrier()
#define PG8_SCHED __builtin_amdgcn_sched_barrier(0)
    Unit cur, nxt; int ui = 0;
    if (!S.next(0, cur)) return;
    f32x4 acc[2][2][4][2];
#pragma unroll
    for (int a = 0; a < 2; ++a)
#pragma unroll
        for (int b = 0; b < 2; ++b)
#pragma unroll
            for (int m = 0; m < 4; ++m)
#pragma unroll
                for (int n = 0; n < 2; ++n) acc[a][b][m][n] = (f32x4){0.f, 0.f, 0.f, 0.f};
    bf16x8 At[4][2], B0[2][2], B1[2][2];
    const char* cA = (const char*)g.A + (size_t)cur.pm * tstep; const char* cB = (const char*)g.Bt + (size_t)cur.pn * tstep;
    S.a_ready(cur);
    if constexpr (SP2) {
        PG8_STAGE(PG8_SB(0, 0), cB, voffB); PG8_STAGE(PG8_SB(0, 1), cB + hstep, voffB); PG8_STAGE(PG8_SA(0, 0), cA, voffA); PG8_STAGE(PG8_SA(0, 1), cA + hstep, voffA);
        if (wr == 1) PG8_BAR;
        PG8_WAIT_V(2); PG8_BAR;
        PG8_STAGE(PG8_SB(1, 0), cB + kstep, voffB); PG8_STAGE(PG8_SA(1, 0), cA + kstep, voffA); PG8_STAGE(PG8_SB(1, 1), cB + hstep + kstep, voffB);
        PG8_WAIT_V(6); PG8_BAR;
    } else {
        PG8_STAGE(PG8_SB(0, 0), cB, voffB); PG8_STAGE(PG8_SA(0, 0), cA, voffA); PG8_STAGE(PG8_SB(0, 1), cB + hstep, voffB); PG8_STAGE(PG8_SA(0, 1), cA + hstep, voffA);
        if (wr == 1) PG8_BAR;
        PG8_WAIT_V(4); PG8_BAR;
        PG8_STAGE(PG8_SB(1, 0), cB + kstep, voffB); PG8_STAGE(PG8_SA(1, 0), cA + kstep, voffA); PG8_STAGE(PG8_SB(1, 1), cB + hstep + kstep, voffB);
        PG8_WAIT_V(6); PG8_BAR;
    }
    for (;;) {
        const bool has_next = S.next(ui + 1, nxt);
        const char* nA = has_next ? (const char*)g.A + (size_t)nxt.pm * tstep : cA; const char* nB = has_next ? (const char*)g.Bt + (size_t)nxt.pn * tstep : cB;
        for (int t = 0; t < nt; t += 2) {
            const bool last = (t == nt - 2);
            const char* a1 = cA + (size_t)(t + 1) * kstep;
            const char* a2 = last ? nA : cA + (size_t)(t + 2) * kstep; const char* b2 = last ? nB : cB + (size_t)(t + 2) * kstep;
            const char* a3 = a2 + kstep; const char* b3 = b2 + kstep;
            if (last && has_next) S.a_ready(nxt);
            if constexpr (SP2) {
            PG8_LDB(B0, 0, 0); PG8_LDB(B1, 0, 1); PG8_SCHED; PG8_LDA(At, 0, 0); PG8_STAGE(PG8_SA(1, 1), a1 + hstep, voffA);
            PG8_WAIT_V(8); PG8_WAIT_L(0); PG8_BAR; PG8_MMA(0, 0, At, B0); PG8_MMA(0, 1, At, B1); PG8_BAR; PG8_SCHED;
            PG8_LDA(At, 0, 1); PG8_STAGE(PG8_SB(0, 0), b2, voffB); PG8_STAGE(PG8_SB(0, 1), b2 + hstep, voffB); PG8_STAGE(PG8_SA(0, 0), a2, voffA);
            PG8_WAIT_V(8); PG8_WAIT_L(0); PG8_BAR; PG8_MMA(1, 0, At, B0); PG8_MMA(1, 1, At, B1); PG8_BAR; PG8_SCHED;
            PG8_LDB(B0, 1, 0); PG8_LDB(B1, 1, 1); PG8_SCHED; PG8_LDA(At, 1, 0); PG8_STAGE(PG8_SA(0, 1), a2 + hstep, voffA);
            PG8_WAIT_V(8); PG8_WAIT_L(0); PG8_BAR; PG8_MMA(0, 0, At, B0); PG8_MMA(0, 1, At, B1); PG8_BAR; PG8_SCHED;
            PG8_LDA(At, 1, 1); PG8_STAGE(PG8_SB(1, 0), b3, voffB); PG8_STAGE(PG8_SB(1, 1), b3 + hstep, voffB); PG8_STAGE(PG8_SA(1, 0), a3, voffA);
            PG8_WAIT_V(8); PG8_WAIT_L(0); PG8_BAR; PG8_MMA(1, 0, At, B0); PG8_MMA(1, 1, At, B1); PG8_BAR; PG8_SCHED;
            } else {
            PG8_LDB(B0, 0, 0); PG8_SCHED; PG8_LDA(At, 0, 0); PG8_STAGE(PG8_SA(1, 1), a1 + hstep, voffA);
            PG8_WAIT_L(8); PG8_BAR; PG8_WAIT_L(0); PG8_MMA(0, 0, At, B0); PG8_BAR; PG8_SCHED;
            PG8_LDB(B1, 0, 1); PG8_STAGE(PG8_SB(0, 0), b2, voffB);
            PG8_BAR; PG8_WAIT_L(0); PG8_MMA(0, 1, At, B1); PG8_BAR;
            PG8_LDA(At, 0, 1); PG8_STAGE(PG8_SA(0, 0), a2, voffA);
            PG8_BAR; PG8_WAIT_L(0); PG8_MMA(1, 0, At, B0); PG8_BAR; PG8_SCHED;
            PG8_STAGE(PG8_SB(0, 1), b2 + hstep, voffB);
            PG8_WAIT_V(6); PG8_BAR; PG8_MMA(1, 1, At, B1); PG8_BAR;
            PG8_LDB(B0, 1, 0); PG8_SCHED; PG8_LDA(At, 1, 0); PG8_STAGE(PG8_SA(0, 1), a2 + hstep, voffA);
            PG8_WAIT_L(8); PG8_BAR; PG8_WAIT_L(0); PG8_MMA(0, 0, At, B0); PG8_BAR; PG8_SCHED;
            PG8_LDB(B1, 1, 1); PG8_STAGE(PG8_SB(1, 0), b3, voffB);
            PG8_BAR; PG8_WAIT_L(0); PG8_MMA(0, 1, At, B1); PG8_BAR;
            PG8_LDA(At, 1, 1); PG8_STAGE(PG8_SA(1, 0), a3, voffA);
            PG8_BAR; PG8_WAIT_L(0); PG8_MMA(1, 0, At, B0); PG8_BAR; PG8_SCHED;
            PG8_STAGE(PG8_SB(1, 1), b3 + hstep, voffB);
            PG8_WAIT_V(6); PG8_BAR; PG8_MMA(1, 1, At, B1); PG8_BAR;
            }
        }
        if constexpr (ALIGN_EPI) { if (wr == 0) PG8_BAR; }
        if constexpr (!Epi::AFTER_DRAIN) { E(acc, cur, wr, wc, fr, fq); S.done(cur); }
        if (!has_next) break;
#pragma unroll
        for (int a = 0; a < 2; ++a)
#pragma unroll
            for (int b = 0; b < 2; ++b)
#pragma unroll
                for (int m = 0; m < 4; ++m)
#pragma unroll
                    for (int n = 0; n < 2; ++n) acc[a][b][m][n] = (f32x4){0.f, 0.f, 0.f, 0.f};
        cur = nxt; cA = nA; cB = nB; ++ui;
        if constexpr (ALIGN_EPI) { if (wr == 1) PG8_BAR; }
    }
    PG8_WAIT_V(0);
    if constexpr (!ALIGN_EPI) { if (wr == 0) PG8_BAR; }
    PG8_BAR;
    if constexpr (Epi::AFTER_DRAIN) { E.fused(acc, cur, wr, wc, fr, fq, lds, wid, lane); S.done(cur); }
#undef PG8_SA
#undef PG8_SB
#undef PG8_STAGE
#undef PG8_LDA
#undef PG8_LDB
#undef PG8_MMA
#undef PG8_WAIT_V
#undef PG8_WAIT_L
#undef PG8_BAR
#undef PG8_SCHED
}
}

constexpr int NWAVES = 8, NTHR = NWAVES * 64;
constexpr int BATCH = 2, SEQ = 8192, M = BATCH * SEQ, DM = 4096, DEPTH = 2;
constexpr int SSD_W = 2048, SSD_H = 32, SSD_CD = 4096;
constexpr int SWA_W = 1024, SWA_H = 16;
constexpr int GLA_W = 1024, GLA_KT = 512;
constexpr int DFF = 11008, DIN = 10800, DINP = 11008, DGU = 2 * DFF;
constexpr float EPS = 1e-6f;
constexpr int C_Z = 0, C_XBC = 2048, C_DT = 6144, C_SQ = 6176, C_SK = 7200, C_SV = 7456, C_GQ = 7712, C_GK = 8224, C_GV = 8736, C_GG = 9760, C_GLR = 10784;
enum { I_X = 0, I_ATTN_NORM, I_W_IN, I_SSD_CONV_W, I_SSD_CONV_B, I_SSD_DT_BIAS, I_SSD_A_LOG, I_SSD_D, I_SSD_NORM, I_SWA_SINKS, I_SWA_NORM, I_GLA_W_GATE, I_GLA_B_GATE, I_GLA_NORM,
       I_W_OUT, I_FFN_NORM, I_W_GATE, I_W_UP, I_FFN_CONV_W, I_FFN_CONV_B, I_W_DOWN, I_REL_BIAS, I_FINAL_NORM, N_IN };

constexpr size_t MiB = 1u << 20;
constexpr size_t WS_CTL = 0, CTL_ZERO_BYTES = 1 * MiB;
constexpr size_t WS_WIN = 1 * MiB;
constexpr size_t WS_WOUT = 87 * MiB;
constexpr size_t WS_WGU = 119 * MiB;
constexpr size_t WS_WDN = 291 * MiB;
constexpr size_t WS_H = 377 * MiB;
constexpr size_t WS_R = 505 * MiB;
constexpr size_t WS_PROJ = WS_R;
constexpr size_t WS_YSSD = WS_R + 344 * MiB;
constexpr size_t WS_OSWA = WS_R + 472 * MiB;
constexpr size_t WS_OGLA = WS_R + 536 * MiB;
constexpr size_t WS_Y = WS_R + 600 * MiB;
constexpr size_t WS_GU = WS_R;
constexpr size_t WS_ACT = WS_R + 688 * MiB;
constexpr size_t WS_END = WS_R + 1032 * MiB;
static_assert(DEPTH == 2 && (size_t)DINP * DM * 2 == 86 * MiB && (size_t)DGU * DM * 2 == 172 * MiB && (size_t)M * DINP * 2 == 344 * MiB && (size_t)M * DGU * 2 == 688 * MiB, "ws map");
constexpr int CW_BAR = 4096;

constexpr int RING_BYTES = 131072;
constexpr int MISC_OFF = RING_BYTES + 320;
constexpr int LDS_BYTES = 147456;

#define GAS __attribute__((address_space(1)))
#define LAS __attribute__((address_space(3)))
typedef unsigned short bf16;
typedef unsigned v4u __attribute__((ext_vector_type(4)));
typedef unsigned v2u __attribute__((ext_vector_type(2)));
typedef float f32x4 __attribute__((ext_vector_type(4)));
typedef GAS unsigned gu32;
#define RLX_AGENT __ATOMIC_RELAXED, __HIP_MEMORY_SCOPE_AGENT
#define LDS_WAIT() asm volatile("s_waitcnt lgkmcnt(0)" ::: "memory")
__device__ __forceinline__ unsigned f2bf(float f) { unsigned u = __builtin_bit_cast(unsigned, f); return (u + 0x7fffu + ((u >> 16) & 1u)) >> 16; }
__device__ __forceinline__ unsigned pk2(float lo, float hi) { return f2bf(lo) | (f2bf(hi) << 16); }
__device__ __forceinline__ float bflo(unsigned w) { return __uint_as_float(w << 16); }
__device__ __forceinline__ float bfhi(unsigned w) { return __uint_as_float(w & 0xffff0000u); }
__device__ __forceinline__ float bf1(bf16 h) { return __uint_as_float((unsigned)h << 16); }
__device__ __forceinline__ float silu_f(float x) { return x / (1.f + __expf(-x)); }
__device__ __forceinline__ float wave_sum(float v) {
#pragma unroll
    for (int o = 1; o < 64; o <<= 1) v += __shfl_xor(v, o);
    return v;
}
template <int CTRL> __device__ __forceinline__ float dpp_f(float v) { return __int_as_float(__builtin_amdgcn_update_dpp(0, __float_as_int(v), CTRL, 0xf, 0xf, false)); }
__device__ __forceinline__ float row16_sum(float v) { v += dpp_f<0xB1>(v); v += dpp_f<0x4E>(v); v += dpp_f<0x124>(v); v += dpp_f<0x128>(v); return v; }
__device__ __forceinline__ float pair_sum(float v) { return v + dpp_f<0xB1>(v); }
#define XB_TMO      128
#define XB_XCNT(j)  (256  + 64 * (j))
#define XB_XSUB(j)  (1280 + 64 * (j))
#define XB_XGEN(j)  (2304 + 64 * (j))
#define XB_TOP      3328
#define XB_TOPGEN   3392
#define XCD_BAR_WORDS 3456
#define XB_SPIN_CAP (1u << 18)

__device__ __forceinline__ unsigned xb_ld(unsigned* p)              { return __hip_atomic_load(p, __ATOMIC_RELAXED, __HIP_MEMORY_SCOPE_AGENT); }
__device__ __forceinline__ unsigned xb_add(unsigned* p, unsigned v) { return __hip_atomic_fetch_add(p, v, __ATOMIC_RELAXED, __HIP_MEMORY_SCOPE_AGENT); }
__device__ __forceinline__ unsigned xb_xcc_id() { return (unsigned)__builtin_amdgcn_s_getreg((3 << 11) | 20) & 0xFu; }
#define XB_SPIN(cond, bar) do { unsigned _sp = 0; while (cond) { __builtin_amdgcn_s_sleep(1); \
    if ((++_sp & 255u) == 0u) { if (xb_ld(&(bar)[XB_TMO])) break; if (_sp > XB_SPIN_CAP) { atomicAdd(&(bar)[XB_TMO], 1u); break; } } } } while (0)

struct XcdBarrier {
    unsigned* bar; unsigned x;
    volatile LAS unsigned* st;
};

__device__ __forceinline__ XcdBarrier xcd_barrier_post(unsigned* bar, volatile LAS unsigned* st) {
    XcdBarrier b; b.bar = bar; b.x = xb_xcc_id(); b.st = st;
    if (threadIdx.x == 0) (void)xb_add(&bar[XB_XCNT(b.x)], 1u);
    return b;
}
__device__ __forceinline__ void xcd_barrier_complete(unsigned* bar, unsigned x, unsigned& nloc, unsigned& nx) {
    const unsigned G = gridDim.x * gridDim.y * gridDim.z;
    unsigned sum, cnt, mine, sp = 0u;
    for (;;) {
        sum = 0u; cnt = 0u; mine = 0u;
#pragma unroll
        for (unsigned j = 0; j < 16; ++j) { const unsigned c = xb_ld(&bar[XB_XCNT(j)]); sum += c; cnt += (c > 0u) ? 1u : 0u; mine = (j == x) ? c : mine; }
        if (sum == G) break;
        __builtin_amdgcn_s_sleep(1);
        if ((++sp & 255u) == 0u) { if (xb_ld(&bar[XB_TMO])) break; if (sp > XB_SPIN_CAP) { atomicAdd(&bar[XB_TMO], 1u); break; } }
    }
    nloc = mine > 0u ? mine : 1u; nx = cnt > 0u ? cnt : 1u;
}

__device__ __forceinline__ void xcd_barrier(const XcdBarrier& b) {
    asm volatile("s_waitcnt vmcnt(0)" ::: "memory");
    __syncthreads();
    if (threadIdx.x == 0) {
        unsigned* bar = b.bar;
        __builtin_amdgcn_s_waitcnt(0);
        unsigned nloc = b.st[0], nx = b.st[1];
        if (nloc == 0u) { xcd_barrier_complete(bar, b.x, nloc, nx); b.st[0] = nloc; b.st[1] = nx; }
        const unsigned old = xb_add(&bar[XB_XSUB(b.x)], 1u);
        const unsigned gen = old / nloc;
        if (old + 1u == (gen + 1u) * nloc) {
            __builtin_amdgcn_fence(__ATOMIC_RELEASE, "agent");
            asm volatile("s_waitcnt vmcnt(0)" ::: "memory");
            const unsigned og = xb_add(&bar[XB_TOP], 1u);
            const unsigned tg = og / nx;
            if (og + 1u == (tg + 1u) * nx) xb_add(&bar[XB_TOPGEN], 1u);
            else XB_SPIN(xb_ld(&bar[XB_TOPGEN]) == tg, bar);
            __builtin_amdgcn_fence(__ATOMIC_ACQUIRE, "agent");
            xb_add(&bar[XB_XGEN(b.x)], 1u);
            asm volatile("s_waitcnt vmcnt(0)" ::: "memory");
        } else {
            XB_SPIN(xb_ld(&bar[XB_XGEN(b.x)]) == gen, bar);
            __builtin_amdgcn_fence(__ATOMIC_ACQUIRE, "agent");
            asm volatile("s_waitcnt vmcnt(0)" ::: "memory");
        }
    }
    __syncthreads();
}

struct Args { const float* in[N_IN]; float* out; unsigned char* ws; int ph_lo, ph_hi, li, pad; };
struct Ctx {
    LAS unsigned char* lds;
    int tid, lane, wave, G, bid;
    const float* const* in; float* out; unsigned char* ws;
};
__device__ const unsigned char T5_BUCKET[128] = {0, 1, 2, 3, 4, 5, 6, 7, 8, 9, 10, 11, 12, 13, 14, 15, 16, 16, 16, 17, 17, 18, 18, 18, 19, 19, 19, 20, 20, 20, 20, 21, 21, 21, 21, 22, 22, 22, 22, 22, 23, 23, 23, 23, 23, 23, 24, 24, 24, 24, 24, 24, 25, 25, 25, 25, 25, 25, 25, 26, 26, 26, 26, 26, 26, 26, 26, 27, 27, 27, 27, 27, 27, 27, 27, 27, 27, 28, 28, 28, 28, 28, 28, 28, 28, 28, 28, 29, 29, 29, 29, 29, 29, 29, 29, 29, 29, 29, 29, 30, 30, 30, 30, 30, 30, 30, 30, 30, 30, 30, 30, 30, 30, 31, 31, 31, 31, 31, 31, 31, 31, 31, 31, 31, 31, 31, 31, 31};

__device__ __forceinline__ void transpose_item(const float* W, int K, int N, bf16* WT, int row_off, LAS float* scr, int kb, int nb, int lane) {
    const int k0 = 64 * kb, n0 = 32 * nb; const int nn = n0 + (lane & 31); const bool nv = nn < N;
#pragma unroll 8
    for (int i = 0; i < 32; ++i) { const int kk = 2 * i + (lane >> 5); scr[kk * 33 + (lane & 31)] = nv ? W[(size_t)(k0 + kk) * N + nn] : 0.f; }
    LDS_WAIT(); asm volatile("" ::: "memory");
    const int c = lane & 7;
#pragma unroll
    for (int j = 0; j < 4; ++j) { const int n = (lane >> 3) + 8 * j; const LAS float* s = scr + (8 * c) * 33 + n;
        v4u o; o.x = pk2(s[0 * 33], s[1 * 33]); o.y = pk2(s[2 * 33], s[3 * 33]); o.z = pk2(s[4 * 33], s[5 * 33]); o.w = pk2(s[6 * 33], s[7 * 33]);
        *(GAS v4u*)(WT + (size_t)(row_off + n0 + n) * K + k0 + 8 * c) = o; }
    LDS_WAIT(); asm volatile("" ::: "memory");
}
__device__ __forceinline__ void convert_weights(Ctx& C, int l) {
    LAS float* scr = (LAS float*)(C.lds + C.wave * 16384);
    const int gw = C.bid * NWAVES + C.wave, NGW = C.G * NWAVES;
    constexpr int I_IN = 64 * 344, I_OUT = 64 * 128, I_G = 64 * 344, I_D = 172 * 128;
    constexpr int NITEMS = I_IN + I_OUT + 2 * I_G + I_D;
    const float* w_in = C.in[I_W_IN] + (size_t)l * DM * DIN; const float* w_out = C.in[I_W_OUT] + (size_t)l * DM * DM;
    const float* w_gate = C.in[I_W_GATE] + (size_t)l * DM * DFF; const float* w_up = C.in[I_W_UP] + (size_t)l * DM * DFF; const float* w_dn = C.in[I_W_DOWN] + (size_t)l * DFF * DM;
    bf16* WIN = (bf16*)(C.ws + WS_WIN); bf16* WOUT = (bf16*)(C.ws + WS_WOUT); bf16* WGU = (bf16*)(C.ws + WS_WGU); bf16* WDN = (bf16*)(C.ws + WS_WDN);
    for (int it = gw; it < NITEMS; it += NGW) {
        int r = it;
        if (r < I_IN) { transpose_item(w_in, DM, DIN, WIN, 0, scr, r / 344, r % 344, C.lane); continue; } r -= I_IN;
        if (r < I_OUT) { transpose_item(w_out, DM, DM, WOUT, 0, scr, r / 128, r % 128, C.lane); continue; } r -= I_OUT;
        if (r < I_G) { transpose_item(w_gate, DM, DFF, WGU, 0, scr, r / 344, r % 344, C.lane); continue; } r -= I_G;
        if (r < I_G) { transpose_item(w_up, DM, DFF, WGU, DFF, scr, r / 344, r % 344, C.lane); continue; } r -= I_G;
        transpose_item(w_dn, DFF, DM, WDN, 0, scr, r / 128, r % 128, C.lane);
    }
}
__device__ __forceinline__ void rmsnorm_row_bf16(const float* xrow, const float* w, bf16* orow, int lane) {
    const GAS f32x4* xr = (const GAS f32x4*)xrow + lane; const GAS f32x4* wr = (const GAS f32x4*)w + lane;
    f32x4 v[16]; float ss = 0.f;
#pragma unroll
    for (int j = 0; j < 16; ++j) { v[j] = xr[64 * j]; ss += (v[j].x * v[j].x + v[j].y * v[j].y) + (v[j].z * v[j].z + v[j].w * v[j].w); }
    const float rstd = 1.f / sqrtf(wave_sum(ss) * (1.f / DM) + EPS);
    GAS v2u* o8 = (GAS v2u*)orow + lane;
#pragma unroll
    for (int j = 0; j < 16; ++j) { const f32x4 g = wr[64 * j]; v2u o; o.x = pk2(v[j].x * rstd * g.x, v[j].y * rstd * g.y); o.y = pk2(v[j].z * rstd * g.z, v[j].w * rstd * g.w); o8[64 * j] = o; }
}
__device__ __forceinline__ void rmsnorm_phase(Ctx& C, const float* X, const float* w, bf16* H) {
    const int gw = C.bid * NWAVES + C.wave, NGW = C.G * NWAVES;
    for (int m = gw; m < M; m += NGW) rmsnorm_row_bf16(X + (size_t)m * DM, w, H + (size_t)m * DM, C.lane);
}
__device__ __forceinline__ void final_norm_phase(Ctx& C, float* X, const float* w) {
    const int gw = C.bid * NWAVES + C.wave, NGW = C.G * NWAVES;
    for (int m = gw; m < M; m += NGW) {
        GAS f32x4* xr = (GAS f32x4*)(X + (size_t)m * DM) + C.lane; const GAS f32x4* wr = (const GAS f32x4*)w + C.lane;
        f32x4 v[16]; float ss = 0.f;
#pragma unroll
        for (int j = 0; j < 16; ++j) { v[j] = xr[64 * j]; ss += (v[j].x * v[j].x + v[j].y * v[j].y) + (v[j].z * v[j].z + v[j].w * v[j].w); }
        const float rstd = 1.f / sqrtf(wave_sum(ss) * (1.f / DM) + EPS);
#pragma unroll
        for (int j = 0; j < 16; ++j) { const f32x4 g = wr[64 * j]; xr[64 * j] = v[j] * rstd * g; }
    }
}

constexpr int SSD_TC = 32;
constexpr int SSD_ROW = 288;
__device__ __forceinline__ int ssd_xcol(int h, int half, int g, int cg) { return cg < 4 ? (h * 64 + half * 32 + 8 * cg) : (cg < 20 ? (2048 + g * 128 + 8 * (cg - 4)) : (3072 + g * 128 + 8 * (cg - 20))); }
__device__ __forceinline__ void ssd_unit(Ctx& C, int l, int unit) {
    const int b = unit >> 6, h = (unit >> 1) & 31, half = unit & 1, g = h >> 2;
    const int tid = C.tid;
    LAS float* L = (LAS float*)C.lds;
    LAS float* cw = L;
    LAS float* cb = L + 1152;
    LAS float* S = L + 2048;
    LAS float* dts = L + 2048 + 32 * SSD_ROW;
    LAS float* dAs = dts + 32;
    LAS float* ys = dAs + 32;
    const bf16* PROJ = (const bf16*)(C.ws + WS_PROJ); float* YSSD = (float*)(C.ws + WS_YSSD);
    const float* conv_w = C.in[I_SSD_CONV_W] + (size_t)l * 4 * SSD_CD; const float* conv_b = C.in[I_SSD_CONV_B] + (size_t)l * SSD_CD;
    const float dt_bias = C.in[I_SSD_DT_BIAS][l * SSD_H + h]; const float Ah = -expf(C.in[I_SSD_A_LOG][l * SSD_H + h]); const float Dh = C.in[I_SSD_D][l * SSD_H + h];
    __syncthreads();
    if (tid < SSD_ROW) { const int xc = ssd_xcol(h, half, g, tid >> 3) + (tid & 7); cb[tid] = conv_b[xc];
#pragma unroll
        for (int i = 0; i < 4; ++i) cw[i * SSD_ROW + tid] = conv_w[i * SSD_CD + xc]; }
    int pt[3], pcg[3]; bool pv[3]; size_t pcol[3];
#pragma unroll
    for (int it = 0; it < 3; ++it) { const int idx = tid + NTHR * it; pv[it] = idx < SSD_TC * 36; pt[it] = pv[it] ? idx / 36 : 0; pcg[it] = pv[it] ? idx % 36 : 0; pcol[it] = (size_t)(C_XBC + ssd_xcol(h, half, g, pcg[it])); }
    const int pp = tid >> 4, ng = tid & 15;
    float hst[8];
#pragma unroll
    for (int j = 0; j < 8; ++j) hst[j] = 0.f;
    v4u raw[3][4]; unsigned dtraw = 0;
    const bf16* Pb = PROJ + (size_t)b * SEQ * DINP;
#define SSD_PREFETCH(t0) do { _Pragma("unroll") for (int it = 0; it < 3; ++it) _Pragma("unroll") for (int i = 0; i < 4; ++i) { const int s = (t0) + pt[it] - 3 + i; \
        raw[it][i] = (pv[it] && s >= 0) ? *(const GAS v4u*)(Pb + (size_t)s * DINP + pcol[it]) : (v4u){0u, 0u, 0u, 0u}; } \
        if (tid < SSD_TC) dtraw = Pb[(size_t)((t0) + tid) * DINP + C_DT + h]; } while (0)
    SSD_PREFETCH(0);
    __syncthreads();
    for (int t0 = 0; t0 < SEQ; t0 += SSD_TC) {
#pragma unroll
        for (int it = 0; it < 3; ++it) if (pv[it]) {
            const int c0 = 8 * pcg[it]; float a[8];
            { const f32x4 b0 = *(const LAS f32x4*)(cb + c0), b1 = *(const LAS f32x4*)(cb + c0 + 4); a[0] = b0.x; a[1] = b0.y; a[2] = b0.z; a[3] = b0.w; a[4] = b1.x; a[5] = b1.y; a[6] = b1.z; a[7] = b1.w; }
#pragma unroll
            for (int i = 0; i < 4; ++i) { const f32x4 w0 = *(const LAS f32x4*)(cw + i * SSD_ROW + c0), w1 = *(const LAS f32x4*)(cw + i * SSD_ROW + c0 + 4); const v4u r = raw[it][i];
                a[0] += w0.x * bflo(r.x); a[1] += w0.y * bfhi(r.x); a[2] += w0.z * bflo(r.y); a[3] += w0.w * bfhi(r.y);
                a[4] += w1.x * bflo(r.z); a[5] += w1.y * bfhi(r.z); a[6] += w1.z * bflo(r.w); a[7] += w1.w * bfhi(r.w); }
            f32x4 o0, o1; o0.x = silu_f(a[0]); o0.y = silu_f(a[1]); o0.z = silu_f(a[2]); o0.w = silu_f(a[3]); o1.x = silu_f(a[4]); o1.y = silu_f(a[5]); o1.z = silu_f(a[6]); o1.w = silu_f(a[7]);
            *(LAS f32x4*)(S + pt[it] * SSD_ROW + c0) = o0; *(LAS f32x4*)(S + pt[it] * SSD_ROW + c0 + 4) = o1;
        }
        if (tid < SSD_TC) { const float xr = bf1((bf16)dtraw) + dt_bias; const float dt = xr > 20.f ? xr : log1pf(expf(xr)); dts[tid] = dt; dAs[tid] = expf(dt * Ah); }
        __syncthreads();
        if (t0 + SSD_TC < SEQ) SSD_PREFETCH(t0 + SSD_TC);
#pragma unroll 4
        for (int i = 0; i < SSD_TC; ++i) {
            const LAS float* R = S + i * SSD_ROW;
            const float dt = dts[i], dA = dAs[i], xv = R[pp], xdt = xv * dt;
            float yp = 0.f;
#pragma unroll
            for (int jj = 0; jj < 2; ++jj) { const f32x4 Bv = *(const LAS f32x4*)(R + 32 + 4 * ng + 64 * jj), Cv = *(const LAS f32x4*)(R + 160 + 4 * ng + 64 * jj);
                hst[jj * 4 + 0] = hst[jj * 4 + 0] * dA + xdt * Bv.x; yp += hst[jj * 4 + 0] * Cv.x;
                hst[jj * 4 + 1] = hst[jj * 4 + 1] * dA + xdt * Bv.y; yp += hst[jj * 4 + 1] * Cv.y;
                hst[jj * 4 + 2] = hst[jj * 4 + 2] * dA + xdt * Bv.z; yp += hst[jj * 4 + 2] * Cv.z;
                hst[jj * 4 + 3] = hst[jj * 4 + 3] * dA + xdt * Bv.w; yp += hst[jj * 4 + 3] * Cv.w; }
            yp = row16_sum(yp);
            if (ng == 0) ys[i * 32 + pp] = yp + xv * Dh;
        }
        __syncthreads();
#pragma unroll
        for (int k = 0; k < 2; ++k) { const int idx = tid + NTHR * k, t = idx >> 5, p = idx & 31; YSSD[(size_t)(b * SEQ + t0 + t) * SSD_W + h * 64 + half * 32 + p] = ys[idx]; }
    }
#undef SSD_PREFETCH
    __syncthreads();
}

constexpr int GLA_TC = 32;
constexpr int GLA_ROW = 416;
__device__ __forceinline__ void gla_unit(Ctx& C, int l, int unit) {
    const int b = unit >> 5, h = (unit >> 3) & 3, e = unit & 7;
    const int tid = C.tid;
    LAS float* L = (LAS float*)C.lds;
    LAS float* wg = L;
    LAS float* bg = L + 2048;
    LAS float* S = L + 2304;
    LAS float* os = S + GLA_TC * GLA_ROW;
    const bf16* PROJ = (const bf16*)(C.ws + WS_PROJ); float* OGLA = (float*)(C.ws + WS_OGLA);
    const float* w_gate = C.in[I_GLA_W_GATE] + (size_t)l * 16 * GLA_KT; const float* b_gate = C.in[I_GLA_B_GATE] + (size_t)l * GLA_KT;
    __syncthreads();
    for (int i = tid; i < 16 * 128; i += NTHR) wg[i] = w_gate[(i >> 7) * GLA_KT + h * 128 + (i & 127)];
    if (tid < 128) bg[tid] = b_gate[h * 128 + tid];
    int pt[3], pcg[3]; bool pv[3]; size_t pcol[3];
#pragma unroll
    for (int it = 0; it < 3; ++it) { const int idx = tid + NTHR * it; pv[it] = idx < GLA_TC * 36; pt[it] = pv[it] ? idx / 36 : 0; pcg[it] = pv[it] ? idx % 36 : 0;
        const int cg = pcg[it]; pcol[it] = (size_t)(cg < 16 ? (C_GQ + h * 128 + 8 * cg) : (cg < 32 ? (C_GK + h * 128 + 8 * (cg - 16)) : (C_GV + h * 256 + e * 32 + 8 * (cg - 32)))); }
    const int vv = tid >> 4, kg = tid & 15;
    float st[8];
#pragma unroll
    for (int j = 0; j < 8; ++j) st[j] = 0.f;
    v4u raw[3]; v4u rg0, rg1;
    const bf16* Pb = PROJ + (size_t)b * SEQ * DINP;
#define GLA_PREFETCH(t0) do { _Pragma("unroll") for (int it = 0; it < 3; ++it) raw[it] = pv[it] ? *(const GAS v4u*)(Pb + (size_t)((t0) + pt[it]) * DINP + pcol[it]) : (v4u){0u, 0u, 0u, 0u}; \
        { const bf16* gp = Pb + (size_t)((t0) + (tid >> 4)) * DINP + C_GLR; rg0 = *(const GAS v4u*)gp; rg1 = *(const GAS v4u*)(gp + 8); } } while (0)
    GLA_PREFETCH(0);
    for (int t0 = 0; t0 < SEQ; t0 += GLA_TC) {
        __syncthreads();
#pragma unroll
        for (int it = 0; it < 3; ++it) if (pv[it]) {
            const int cg = pcg[it]; const float sc = cg < 16 ? 0.08838834764831845f : 1.f;
            const int dst = cg < 16 ? (128 + 8 * cg) : (cg < 32 ? (256 + 8 * (cg - 16)) : (384 + 8 * (cg - 32)));
            const v4u r = raw[it]; f32x4 o0, o1;
            o0.x = bflo(r.x) * sc; o0.y = bfhi(r.x) * sc; o0.z = bflo(r.y) * sc; o0.w = bfhi(r.y) * sc; o1.x = bflo(r.z) * sc; o1.y = bfhi(r.z) * sc; o1.z = bflo(r.w) * sc; o1.w = bfhi(r.w) * sc;
            *(LAS f32x4*)(S + pt[it] * GLA_ROW + dst) = o0; *(LAS f32x4*)(S + pt[it] * GLA_ROW + dst + 4) = o1;
        }
        {
            float gl[16];
            gl[0] = bflo(rg0.x); gl[1] = bfhi(rg0.x); gl[2] = bflo(rg0.y); gl[3] = bfhi(rg0.y); gl[4] = bflo(rg0.z); gl[5] = bfhi(rg0.z); gl[6] = bflo(rg0.w); gl[7] = bfhi(rg0.w);
            gl[8] = bflo(rg1.x); gl[9] = bfhi(rg1.x); gl[10] = bflo(rg1.y); gl[11] = bfhi(rg1.y); gl[12] = bflo(rg1.z); gl[13] = bfhi(rg1.z); gl[14] = bflo(rg1.w); gl[15] = bfhi(rg1.w);
            float z[8];
            { const f32x4 b0 = *(const LAS f32x4*)(bg + 8 * kg), b1 = *(const LAS f32x4*)(bg + 8 * kg + 4); z[0] = b0.x; z[1] = b0.y; z[2] = b0.z; z[3] = b0.w; z[4] = b1.x; z[5] = b1.y; z[6] = b1.z; z[7] = b1.w; }
#pragma unroll
            for (int r = 0; r < 16; ++r) { const f32x4 w0 = *(const LAS f32x4*)(wg + r * 128 + 8 * kg), w1 = *(const LAS f32x4*)(wg + r * 128 + 8 * kg + 4);
                z[0] += gl[r] * w0.x; z[1] += gl[r] * w0.y; z[2] += gl[r] * w0.z; z[3] += gl[r] * w0.w; z[4] += gl[r] * w1.x; z[5] += gl[r] * w1.y; z[6] += gl[r] * w1.z; z[7] += gl[r] * w1.w; }
            float av[8];
#pragma unroll
            for (int j = 0; j < 8; ++j) { const float ls = fminf(z[j], 0.f) - log1pf(expf(-fabsf(z[j]))); av[j] = expf(ls * 0.0625f); }
            *(LAS f32x4*)(S + (tid >> 4) * GLA_ROW + 8 * kg) = (f32x4){av[0], av[1], av[2], av[3]}; *(LAS f32x4*)(S + (tid >> 4) * GLA_ROW + 8 * kg + 4) = (f32x4){av[4], av[5], av[6], av[7]};
        }
        __syncthreads();
        if (t0 + GLA_TC < SEQ) GLA_PREFETCH(t0 + GLA_TC);
#pragma unroll 4
        for (int i = 0; i < GLA_TC; ++i) {
            const LAS float* R = S + i * GLA_ROW;
            const float vval = R[384 + vv]; float op = 0.f;
#pragma unroll
            for (int jj = 0; jj < 2; ++jj) { const f32x4 av = *(const LAS f32x4*)(R + 4 * kg + 64 * jj), qv = *(const LAS f32x4*)(R + 128 + 4 * kg + 64 * jj), kv = *(const LAS f32x4*)(R + 256 + 4 * kg + 64 * jj);
                st[jj * 4 + 0] = st[jj * 4 + 0] * av.x + kv.x * vval; op += qv.x * st[jj * 4 + 0];
                st[jj * 4 + 1] = st[jj * 4 + 1] * av.y + kv.y * vval; op += qv.y * st[jj * 4 + 1];
                st[jj * 4 + 2] = st[jj * 4 + 2] * av.z + kv.z * vval; op += qv.z * st[jj * 4 + 2];
                st[jj * 4 + 3] = st[jj * 4 + 3] * av.w + kv.w * vval; op += qv.w * st[jj * 4 + 3]; }
            op = row16_sum(op);
            if (kg == 0) os[i * 32 + vv] = op;
        }
        __syncthreads();
#pragma unroll
        for (int k = 0; k < 2; ++k) { const int idx = tid + NTHR * k, t = idx >> 5, v = idx & 31; OGLA[(size_t)(b * SEQ + t0 + t) * GLA_W + h * 256 + e * 32 + v] = os[idx]; }
    }
#undef GLA_PREFETCH
    __syncthreads();
}

__device__ __forceinline__ void swa_unit(Ctx& C, int l, int unit) {
    const int qb = unit & 127, kvh = (unit >> 7) & 3, b = unit >> 9;
    const int tid = C.tid, pair = tid >> 1, g = pair >> 6, qi = pair & 63, dh = tid & 1, q0 = qb * 64, head = kvh * 4 + g;
    LAS float* L = (LAS float*)C.lds;
    LAS float* Ks = L;
    LAS float* Vs = L + 192 * 64;
    LAS float* bias = L + 2 * 192 * 64;
    const bf16* PROJ = (const bf16*)(C.ws + WS_PROJ); float* OSWA = (float*)(C.ws + WS_OSWA);
    const bf16* Pb = PROJ + (size_t)b * SEQ * DINP;
    __syncthreads();
    { const int gg = tid >> 7, dist = tid & 127; bias[tid] = C.in[I_REL_BIAS][T5_BUCKET[dist] * SWA_H + kvh * 4 + gg]; }
#pragma unroll
    for (int it = 0; it < 6; ++it) { const int idx = tid + NTHR * it; const int kv = idx / 1536, r = idx % 1536, j = r >> 3, cg = r & 7; const int s = q0 - 128 + j;
        v4u w = (v4u){0u, 0u, 0u, 0u};
        if (s >= 0) w = *(const GAS v4u*)(Pb + (size_t)s * DINP + (kv ? C_SV : C_SK) + kvh * 64 + 8 * cg);
        LAS float* d = (kv ? Vs : Ks) + j * 64 + 8 * cg;
        *(LAS f32x4*)d = (f32x4){bflo(w.x), bfhi(w.x), bflo(w.y), bfhi(w.y)}; *(LAS f32x4*)(d + 4) = (f32x4){bflo(w.z), bfhi(w.z), bflo(w.w), bfhi(w.w)}; }
    float q[32], acc[32];
    { const bf16* qp = Pb + (size_t)(q0 + qi) * DINP + C_SQ + head * 64 + dh * 32;
#pragma unroll
      for (int k = 0; k < 4; ++k) { const v4u w = *(const GAS v4u*)(qp + 8 * k);
          q[8 * k + 0] = bflo(w.x) * 0.125f; q[8 * k + 1] = bfhi(w.x) * 0.125f; q[8 * k + 2] = bflo(w.y) * 0.125f; q[8 * k + 3] = bfhi(w.y) * 0.125f;
          q[8 * k + 4] = bflo(w.z) * 0.125f; q[8 * k + 5] = bfhi(w.z) * 0.125f; q[8 * k + 6] = bflo(w.w) * 0.125f; q[8 * k + 7] = bfhi(w.w) * 0.125f; } }
#pragma unroll
    for (int d = 0; d < 32; ++d) acc[d] = 0.f;
    const float sink = C.in[I_SWA_SINKS][l * SWA_H + head];
    float m = sink, lsum = 0.f;
    __syncthreads();
    const int qi0 = __builtin_amdgcn_readfirstlane(qi) & ~31;
    const int jlo = qi0 + 1, jhi = qi0 + 31 + 128;
    for (int j = jlo; j <= jhi; ++j) {
        const int dist = qi + 128 - j; const bool valid = (dist >= 0) && (dist < 128) && (q0 - 128 + j >= 0);
        const LAS float* kr = Ks + j * 64 + dh * 32; float dot = 0.f;
#pragma unroll
        for (int k = 0; k < 8; ++k) { const f32x4 kk = *(const LAS f32x4*)(kr + 4 * k); dot += q[4 * k] * kk.x + q[4 * k + 1] * kk.y + q[4 * k + 2] * kk.z + q[4 * k + 3] * kk.w; }
        dot = pair_sum(dot);
        const float sc = dot + bias[g * 128 + (dist & 127)];
        const float mn = valid ? fmaxf(m, sc) : m;
        const float corr = __expf(m - mn), p = valid ? __expf(sc - mn) : 0.f;
        m = mn; lsum = lsum * corr + p;
        const LAS float* vr = Vs + j * 64 + dh * 32;
#pragma unroll
        for (int k = 0; k < 8; ++k) { const f32x4 vv = *(const LAS f32x4*)(vr + 4 * k);
            acc[4 * k] = acc[4 * k] * corr + p * vv.x; acc[4 * k + 1] = acc[4 * k + 1] * corr + p * vv.y; acc[4 * k + 2] = acc[4 * k + 2] * corr + p * vv.z; acc[4 * k + 3] = acc[4 * k + 3] * corr + p * vv.w; }
    }
    const float inv = 1.f / (lsum + __expf(sink - m));
    float* op = OSWA + (size_t)(b * SEQ + q0 + qi) * SWA_W + head * 64 + dh * 32;
#pragma unroll
    for (int k = 0; k < 8; ++k) *(GAS f32x4*)(op + 4 * k) = (f32x4){acc[4 * k] * inv, acc[4 * k + 1] * inv, acc[4 * k + 2] * inv, acc[4 * k + 3] * inv};
}

constexpr int N_SSD_UNITS = BATCH * SSD_H * 2, N_GLA_UNITS = BATCH * 4 * 8, N_SWA_UNITS = BATCH * 4 * (SEQ / 64);
__device__ __forceinline__ void mixer_phase(Ctx& C, int l) {
    const int G = C.G, bid = C.bid;
    if (G >= N_SSD_UNITS + N_GLA_UNITS + 1) {
        if (bid < N_SSD_UNITS) ssd_unit(C, l, bid);
        else if (bid < N_SSD_UNITS + N_GLA_UNITS) gla_unit(C, l, bid - N_SSD_UNITS);
        else for (int u = bid - (N_SSD_UNITS + N_GLA_UNITS); u < N_SWA_UNITS; u += G - (N_SSD_UNITS + N_GLA_UNITS)) swa_unit(C, l, u);
    } else {
        for (int u = bid; u < N_SSD_UNITS; u += G) ssd_unit(C, l, u);
        for (int u = bid; u < N_GLA_UNITS; u += G) gla_unit(C, l, u);
        for (int u = bid; u < N_SWA_UNITS; u += G) swa_unit(C, l, u);
    }
}

__device__ __forceinline__ void finalize_phase(Ctx& C, int l) {
    const int gw = C.bid * NWAVES + C.wave, NGW = C.G * NWAVES, lane = C.lane;
    const bf16* PROJ = (const bf16*)(C.ws + WS_PROJ); const float* YSSD = (const float*)(C.ws + WS_YSSD); const float* OSWA = (const float*)(C.ws + WS_OSWA); const float* OGLA = (const float*)(C.ws + WS_OGLA);
    bf16* Y = (bf16*)(C.ws + WS_Y);
    const float* ssd_norm = C.in[I_SSD_NORM] + (size_t)l * SSD_W; const float* swa_norm = C.in[I_SWA_NORM] + (size_t)l * SWA_W; const float* gla_norm = C.in[I_GLA_NORM] + (size_t)l * 256;
    for (int m = gw; m < M; m += NGW) {
        const bf16* pr = PROJ + (size_t)m * DINP; bf16* yr = Y + (size_t)m * DM;
#pragma unroll 2
        for (int grp = 0; grp < 8; ++grp) { const int c = 256 * grp + 4 * lane;
            const f32x4 y = *(const GAS f32x4*)(YSSD + (size_t)m * SSD_W + c); const v2u zz = *(const GAS v2u*)(pr + C_Z + c); const f32x4 w = *(const GAS f32x4*)(ssd_norm + c);
            f32x4 v; v.x = y.x * silu_f(bflo(zz.x)); v.y = y.y * silu_f(bfhi(zz.x)); v.z = y.z * silu_f(bflo(zz.y)); v.w = y.w * silu_f(bfhi(zz.y));
            const float ss = wave_sum((v.x * v.x + v.y * v.y) + (v.z * v.z + v.w * v.w)); const float rstd = 1.f / sqrtf(ss * (1.f / 256.f) + EPS);
            v2u o; o.x = pk2(v.x * rstd * w.x, v.y * rstd * w.y); o.y = pk2(v.z * rstd * w.z, v.w * rstd * w.w); *(GAS v2u*)(yr + c) = o; }
        { f32x4 v[4]; float ss = 0.f;
#pragma unroll
          for (int j = 0; j < 4; ++j) { v[j] = *(const GAS f32x4*)(OSWA + (size_t)m * SWA_W + 256 * j + 4 * lane); ss += (v[j].x * v[j].x + v[j].y * v[j].y) + (v[j].z * v[j].z + v[j].w * v[j].w); }
          const float rstd = 1.f / sqrtf(wave_sum(ss) * (1.f / 1024.f) + EPS);
#pragma unroll
          for (int j = 0; j < 4; ++j) { const int c = 256 * j + 4 * lane; const f32x4 w = *(const GAS f32x4*)(swa_norm + c);
              v2u o; o.x = pk2(v[j].x * rstd * w.x, v[j].y * rstd * w.y); o.y = pk2(v[j].z * rstd * w.z, v[j].w * rstd * w.w); *(GAS v2u*)(yr + 2048 + c) = o; } }
#pragma unroll 2
        for (int hd = 0; hd < 4; ++hd) { const int c = 256 * hd + 4 * lane;
            const f32x4 v = *(const GAS f32x4*)(OGLA + (size_t)m * GLA_W + c); const v2u gg = *(const GAS v2u*)(pr + C_GG + c); const f32x4 w = *(const GAS f32x4*)(gla_norm + 4 * lane);
            const float ss = wave_sum((v.x * v.x + v.y * v.y) + (v.z * v.z + v.w * v.w)); const float rstd = 1.f / sqrtf(ss * (1.f / 256.f) + EPS);
            v2u o; o.x = pk2(v.x * rstd * w.x * silu_f(bflo(gg.x)), v.y * rstd * w.y * silu_f(bfhi(gg.x))); o.y = pk2(v.z * rstd * w.z * silu_f(bflo(gg.y)), v.w * rstd * w.w * silu_f(bfhi(gg.y))); *(GAS v2u*)(yr + 3072 + c) = o; }
    }
}

__device__ __forceinline__ void act_phase(Ctx& C, int l) {
    const bf16* GU = (const bf16*)(C.ws + WS_GU); bf16* ACT = (bf16*)(C.ws + WS_ACT);
    const float* cw = C.in[I_FFN_CONV_W] + (size_t)l * 3 * DFF; const float* cb = C.in[I_FFN_CONV_B] + (size_t)l * DFF;
    constexpr int NCG = DFF / 8, NRB = M / 32; constexpr long NIT = (long)NCG * NRB;
    for (long it = (long)C.bid * NTHR + C.tid; it < NIT; it += (long)C.G * NTHR) {
        const int cg = (int)(it % NCG), rb = (int)(it / NCG), c0 = 8 * cg, r0 = 32 * rb;
        float w0[8], w1[8], w2[8], bb[8];
#pragma unroll
        for (int e = 0; e < 8; ++e) { w0[e] = cw[c0 + e]; w1[e] = cw[DFF + c0 + e]; w2[e] = cw[2 * DFF + c0 + e]; bb[e] = cb[c0 + e]; }
        float g1[8], g2[8];
        const bool first = (r0 % SEQ) == 0;
        { v4u a = (v4u){0u, 0u, 0u, 0u}, b2 = (v4u){0u, 0u, 0u, 0u};
          if (!first) { a = *(const GAS v4u*)(GU + (size_t)(r0 - 1) * DGU + c0); b2 = *(const GAS v4u*)(GU + (size_t)(r0 - 2) * DGU + c0); }
          g1[0] = bflo(a.x); g1[1] = bfhi(a.x); g1[2] = bflo(a.y); g1[3] = bfhi(a.y); g1[4] = bflo(a.z); g1[5] = bfhi(a.z); g1[6] = bflo(a.w); g1[7] = bfhi(a.w);
          g2[0] = bflo(b2.x); g2[1] = bfhi(b2.x); g2[2] = bflo(b2.y); g2[3] = bfhi(b2.y); g2[4] = bflo(b2.z); g2[5] = bfhi(b2.z); g2[6] = bflo(b2.w); g2[7] = bfhi(b2.w); }
#pragma unroll 4
        for (int r = 0; r < 32; ++r) {
            const v4u gw_ = *(const GAS v4u*)(GU + (size_t)(r0 + r) * DGU + c0), uw = *(const GAS v4u*)(GU + (size_t)(r0 + r) * DGU + DFF + c0);
            float g0[8], u[8], o[8];
            g0[0] = bflo(gw_.x); g0[1] = bfhi(gw_.x); g0[2] = bflo(gw_.y); g0[3] = bfhi(gw_.y); g0[4] = bflo(gw_.z); g0[5] = bfhi(gw_.z); g0[6] = bflo(gw_.w); g0[7] = bfhi(gw_.w);
            u[0] = bflo(uw.x); u[1] = bfhi(uw.x); u[2] = bflo(uw.y); u[3] = bfhi(uw.y); u[4] = bflo(uw.z); u[5] = bfhi(uw.z); u[6] = bflo(uw.w); u[7] = bfhi(uw.w);
#pragma unroll
            for (int e = 0; e < 8; ++e) { const float gc = bb[e] + w0[e] * g2[e] + w1[e] * g1[e] + w2[e] * g0[e]; o[e] = silu_f(gc) * u[e]; g2[e] = g1[e]; g1[e] = g0[e]; }
            v4u ow; ow.x = pk2(o[0], o[1]); ow.y = pk2(o[2], o[3]); ow.z = pk2(o[4], o[5]); ow.w = pk2(o[6], o[7]);
            *(GAS v4u*)(ACT + (size_t)(r0 + r) * DFF + c0) = ow;
        }
    }
}

constexpr int PH_PER_LAYER = 9, PH_FINAL = DEPTH * PH_PER_LAYER, N_PHASES = PH_FINAL + 1;
#ifndef MK_ONE_LAUNCH
#define MK_ONE_LAUNCH 1
#endif
__global__ void __launch_bounds__(NTHR, 2) fwd_kernel(Args args) {
    extern __shared__ __attribute__((aligned(16))) unsigned char lds[];
    Ctx C;
    C.lds = (LAS unsigned char*)lds;
    C.tid = threadIdx.x; C.lane = C.tid & 63; C.wave = __builtin_amdgcn_readfirstlane(C.tid >> 6);
    C.G = gridDim.x; C.bid = blockIdx.x;
    C.in = args.in; C.out = args.out; C.ws = args.ws;
    volatile LAS unsigned* MISC = (volatile LAS unsigned*)(C.lds + MISC_OFF);
    for (int u = C.tid; u < (LDS_BYTES - RING_BYTES) / 4; u += NTHR) ((LAS unsigned*)(C.lds + RING_BYTES))[u] = 0u;
    __syncthreads();
    gu32* ctl = (gu32*)(args.ws + WS_CTL);
    XcdBarrier bar = xcd_barrier_post((unsigned*)(ctl + CW_BAR) + args.li * XCD_BAR_WORDS, MISC + 8);
    const int lo = args.ph_lo, hi = args.ph_hi;
#define IN(k) (lo <= (k) && (k) < hi)
#define SEAM(k) do { if (IN(k) && IN((k) + 1)) xcd_barrier(bar); } while (0)
    float* xres = args.out;
    bf16* H = (bf16*)(args.ws + WS_H);
#define LAYER_BODY(l) do { \
        const int pb = l * PH_PER_LAYER; \
        const float* xin = (l == 0) ? args.in[I_X] : (const float*)xres; \
        if (IN(pb + 0)) { convert_weights(C, l); rmsnorm_phase(C, xin, args.in[I_ATTN_NORM] + (size_t)l * DM, H); } \
        SEAM(pb + 0); \
        if (IN(pb + 1)) { \
            pg8::Gemm g{H, (const bf16*)(args.ws + WS_WIN), M, DINP, DM}; pg8::StaticOrder S; S.init(M, DINP, C.G, C.bid); \
            pg8::EpiBf16 E{(bf16*)(args.ws + WS_PROJ), DINP}; \
            pg8::gemm_phase<pg8::EpiBf16, pg8::StaticOrder, true, true>(C.lds, g, S, E); \
        } \
        SEAM(pb + 1); \
        if (IN(pb + 2)) mixer_phase(C, l); \
        SEAM(pb + 2); \
        if (IN(pb + 3)) finalize_phase(C, l); \
        SEAM(pb + 3); \
        if (IN(pb + 4)) { \
            pg8::Gemm g{(const bf16*)(args.ws + WS_Y), (const bf16*)(args.ws + WS_WOUT), M, DM, DM}; pg8::StaticOrder S; S.init(M, DM, C.G, C.bid); \
            pg8::EpiRes E{xin, xres, DM}; \
            pg8::gemm_phase<pg8::EpiRes, pg8::StaticOrder, true, true>(C.lds, g, S, E); \
        } \
        SEAM(pb + 4); \
        if (IN(pb + 5)) rmsnorm_phase(C, xres, args.in[I_FFN_NORM] + (size_t)l * DM, H); \
        SEAM(pb + 5); \
        if (IN(pb + 6)) { \
            pg8::Gemm g{H, (const bf16*)(args.ws + WS_WGU), M, DGU, DM}; pg8::StaticOrder S; S.init(M, DGU, C.G, C.bid); \
            pg8::EpiBf16 E{(bf16*)(args.ws + WS_GU), DGU}; \
            pg8::gemm_phase<pg8::EpiBf16, pg8::StaticOrder, true, true>(C.lds, g, S, E); \
        } \
        SEAM(pb + 6); \
        if (IN(pb + 7)) act_phase(C, l); \
        SEAM(pb + 7); \
        if (IN(pb + 8)) { \
            pg8::Gemm g{(const bf16*)(args.ws + WS_ACT), (const bf16*)(args.ws + WS_WDN), M, DM, DFF}; pg8::StaticOrder S; S.init(M, DM, C.G, C.bid); \
            pg8::EpiRes E{xres, xres, DM}; \
            pg8::gemm_phase<pg8::EpiRes, pg8::StaticOrder, true, true>(C.lds, g, S, E); \
        } \
        SEAM(pb + 8); \
     \
    } while (0)
    LAYER_BODY(0);
    LAYER_BODY(1);
#undef LAYER_BODY
    if (IN(PH_FINAL)) final_norm_phase(C, xres, args.in[I_FINAL_NORM]);
#undef IN
#undef SEAM
}

extern "C" void kernel_launch(void* const* d_in, const int* in_sizes, int n_in, void* d_out, int out_size, void* d_ws, size_t ws_size, hipStream_t stream) {
    static int grid = 0;
    if (grid == 0) {
        if (n_in != N_IN || out_size != M * DM || ws_size < WS_END) { fprintf(stderr, "kernel_launch: unexpected shapes (n_in %d, out %d, ws %zu < %zu)\n", n_in, out_size, ws_size, (size_t)WS_END); grid = -1; return; }
        int dev = 0, cus = 0, per_cu = 0;
        if (hipGetDevice(&dev) != hipSuccess || hipDeviceGetAttribute(&cus, hipDeviceAttributeMultiprocessorCount, dev) != hipSuccess) { grid = -1; return; }
        if (hipFuncSetAttribute((const void*)fwd_kernel, hipFuncAttributeMaxDynamicSharedMemorySize, LDS_BYTES) != hipSuccess) { fprintf(stderr, "kernel_launch: hipFuncSetAttribute failed\n"); grid = -1; return; }
        if (hipOccupancyMaxActiveBlocksPerMultiprocessor(&per_cu, (const void*)fwd_kernel, NTHR, LDS_BYTES) != hipSuccess || per_cu < 1) { fprintf(stderr, "kernel_launch: occupancy query says %d\n", per_cu); (void)hipGetLastError(); grid = -1; return; }
        grid = cus;
    }
    if (grid < 0) return;
    if (hipMemsetAsync((char*)d_ws + WS_CTL, 0, CTL_ZERO_BYTES, stream) != hipSuccess) return;
    Args a{};
    for (int i = 0; i < N_IN; ++i) a.in[i] = (const float*)d_in[i];
    a.out = (float*)d_out; a.ws = (unsigned char*)d_ws; a.pad = 0;
#if MK_ONE_LAUNCH
    a.ph_lo = 0; a.ph_hi = N_PHASES; a.li = 0;
    hipLaunchKernelGGL(fwd_kernel, dim3(grid), dim3(NTHR), LDS_BYTES, stream, a);
#else
    for (int p = 0; p < N_PHASES; ++p) { a.ph_lo = p; a.ph_hi = p + 1; a.li = p;
        hipLaunchKernelGGL(fwd_kernel, dim3(grid), dim3(NTHR), LDS_BYTES, stream, a); }
#endif
}
```

```cpp
#include <hip/hip_runtime.h>
#include <cstdio>
#include <cstdint>
namespace pg8 {
#define PG8_LAS __attribute__((address_space(3)))
typedef unsigned short bf16_t;
typedef short bf16x8 __attribute__((ext_vector_type(8)));
typedef float f32x4 __attribute__((ext_vector_type(4)));
typedef unsigned u32x4 __attribute__((ext_vector_type(4)));
constexpr int BM = 256, BK = 64, HALF = 128, HTB = HALF * BK * 2  , STAGE_BYTES = 8 * HTB, NXCD = 8, WGM = 8;

__host__ __device__ __forceinline__ int lds_byte(int r, int c) { const int st = (r >> 4) * 2 + (c >> 5), rr = r & 15, cc = c & 31, ob = rr * 64 + cc * 2; return st * 1024 + (ob ^ (((ob >> 9) & 1) << 5)); }
__host__ __device__ __forceinline__ void stage_rc(int b, int& R, int& C) { const int st = b / 1024, sb = b % 1024, swz = sb ^ (((sb >> 9) & 1) << 5); R = (st >> 1) * 16 + swz / 64; C = (st & 1) * 32 + (swz % 64) / 2; }
__host__ __device__ __forceinline__ int perm32(int rho) { const int n = rho >> 4, i = rho & 15; return 8 * (i >> 2) + 4 * n + (i & 3); }

struct Unit { int pm, pn; };
struct Gemm { const bf16_t* A; const bf16_t* Bt; int M, N, K; };

struct StaticOrder {
    int nM, nN, nwg, G, c;
    __host__ __device__ void init(int M, int N, int G_, int c_) { nM = M / BM; nN = N / BM; nwg = nM * nN; G = G_; c = c_; }
    __host__ __device__ bool next(int i, Unit& u) const {
        const long L = (long)i * G + c; if (L >= nwg) return false;
        int wgid = (int)L; { const int q = nwg / NXCD, r = nwg % NXCD, xcd = wgid % NXCD, off = wgid / NXCD; wgid = (xcd < r ? xcd * (q + 1) : r * (q + 1) + (xcd - r) * q) + off; }
        const int nig = WGM * nN, gid = wgid / nig, fm = gid * WGM, gsz = (nM - fm) < WGM ? (nM - fm) : WGM;
        u.pm = fm + ((wgid % nig) % gsz); u.pn = (wgid % nig) / gsz; return true;
    }
    __device__ __forceinline__ void a_ready(const Unit&) const {}
    __device__ __forceinline__ void done(const Unit&) const {}
};

__device__ __forceinline__ unsigned cvt_pk_bf16(float lo, float hi) { unsigned r; asm volatile("v_cvt_pk_bf16_f32 %0, %1, %2" : "=v"(r) : "v"(lo), "v"(hi)); return r; }

struct EpiBf16 {
    static constexpr bool PERM = true, AFTER_DRAIN = false;
    bf16_t* O; int ldc;
    __device__ __forceinline__ void operator()(const f32x4 (&acc)[2][2][4][2], const Unit& u, int wr, int wc, int fr, int fq) const {
        const int row0 = u.pm * BM + wr * 64 + fr; const int col0 = u.pn * BM + wc * 32 + 8 * fq;
#pragma unroll
        for (int ai = 0; ai < 2; ++ai)
#pragma unroll
            for (int m = 0; m < 4; ++m) { bf16_t* rowp = O + (size_t)(row0 + ai * HALF + m * 16) * ldc + col0;
#pragma unroll
                for (int bj = 0; bj < 2; ++bj) { const f32x4 v0 = acc[ai][bj][m][0], v1 = acc[ai][bj][m][1];
                    u32x4 w; w.x = cvt_pk_bf16(v0[0], v0[1]); w.y = cvt_pk_bf16(v0[2], v0[3]); w.z = cvt_pk_bf16(v1[0], v1[1]); w.w = cvt_pk_bf16(v1[2], v1[3]);
                    *(u32x4*)(rowp + bj * HALF) = w; } }
    }
};
struct EpiRes {
    static constexpr bool PERM = false, AFTER_DRAIN = false;
    const float* base; float* out; int ldc;
    __device__ __forceinline__ void operator()(const f32x4 (&acc)[2][2][4][2], const Unit& u, int wr, int wc, int fr, int fq) const {
        const int row0 = u.pm * BM + wr * 64 + fr, col0 = u.pn * BM + wc * 32 + 4 * fq;
#pragma unroll
        for (int ai = 0; ai < 2; ++ai)
#pragma unroll
            for (int m = 0; m < 4; ++m) { const size_t off = (size_t)(row0 + ai * HALF + m * 16) * ldc + col0;
#pragma unroll
                for (int bj = 0; bj < 2; ++bj)
#pragma unroll
                    for (int n = 0; n < 2; ++n) { const f32x4 bs = *(const f32x4*)(base + off + bj * HALF + n * 16); *(f32x4*)(out + off + bj * HALF + n * 16) = bs + acc[ai][bj][m][n]; } }
    }
};
template <class Epi, class Sched, bool ALIGN_EPI = false, bool SP2 = false>
__device__ __forceinline__ void gemm_phase(PG8_LAS unsigned char* lds, const Gemm g, const Sched& S, const Epi& E) {
    const int tid = threadIdx.x, wid = __builtin_amdgcn_readfirstlane(tid >> 6), lane = tid & 63, wr = wid >> 2, wc = wid & 3, fr = lane & 15, fq = lane >> 4;
    const int K = g.K, nt = K / BK;
    unsigned voffA[2], voffB[2];
#pragma unroll
    for (int i = 0; i < 2; ++i) { int R, C; stage_rc(tid * 16 + i * 8192, R, C); const int Rb = Epi::PERM ? ((R & ~31) + perm32(R & 31)) : R;
        voffA[i] = (unsigned)(R * K + C) * 2u; voffB[i] = (unsigned)(Rb * K + C) * 2u; }
    const size_t kstep = (size_t)(BK * 2);
    const size_t hstep = (size_t)HALF * K * 2;
    const size_t tstep = 2 * hstep;
    const unsigned ldsw = (unsigned)wid * 1024u;
    const int aoff = lds_byte(wr * 64 + fr, fq * 8), boff = lds_byte(wc * 32 + fr, fq * 8);
#define PG8_SA(b, h) (((b) * 2 + (h)) * HTB)
#define PG8_SB(b, h) ((4 + (b) * 2 + (h)) * HTB)
#define PG8_STAGE(bufoff, gbase, voff) do { _Pragma("unroll") for (int _i = 0; _i < 2; ++_i) \
        __builtin_amdgcn_global_load_lds((const unsigned*)((const char*)(gbase) + (voff)[_i]), (PG8_LAS unsigned*)(lds + (bufoff) + ldsw + _i * 8192), 16, 0, 0); } while (0)
#define PG8_LDA(dst, b, h) do { _Pragma("unroll") for (int m = 0; m < 4; ++m) _Pragma("unroll") for (int k = 0; k < 2; ++k) dst[m][k] = *(const PG8_LAS bf16x8*)(lds + PG8_SA(b, h) + aoff + m * 2048 + k * 1024); } while (0)
#define PG8_LDB(dst, b, h) do { _Pragma("unroll") for (int n = 0; n < 2; ++n) _Pragma("unroll") for (int k = 0; k < 2; ++k) dst[n][k] = *(const PG8_LAS bf16x8*)(lds + PG8_SB(b, h) + boff + n * 2048 + k * 1024); } while (0)
#define PG8_MMA(ai, bj, At, Bt) do { __builtin_amdgcn_s_setprio(1); _Pragma("unroll") for (int m = 0; m < 4; ++m) _Pragma("unroll") for (int n = 0; n < 2; ++n) _Pragma("unroll") for (int k = 0; k < 2; ++k) \
        acc[ai][bj][m][n] = __builtin_amdgcn_mfma_f32_16x16x32_bf16(Bt[n][k], At[m][k], acc[ai][bj][m][n], 0, 0, 0); __builtin_amdgcn_s_setprio(0); } while (0)
#define PG8_WAIT_V(n) asm volatile("s_waitcnt vmcnt(" #n ")" ::: "memory")
#define PG8_WAIT_L(n) asm volatile("s_waitcnt lgkmcnt(" #n ")" ::: "memory")
#define PG8_BAR __builtin_amdgcn_s_barrier()
#define PG8_SCHED __builtin_amdgcn_sched_barrier(0)
    Unit cur, nxt; int ui = 0;
    if (!S.next(0, cur)) return;
    f32x4 acc[2][2][4][2];
#pragma unroll
    for (int a = 0; a < 2; ++a)
#pragma unroll
        for (int b = 0; b < 2; ++b)
#pragma unroll
            for (int m = 0; m < 4; ++m)
#pragma unroll
                for (int n = 0; n < 2; ++n) acc[a][b][m][n] = (f32x4){0.f, 0.f, 0.f, 0.f};
    bf16x8 At[4][2], B0[2][2], B1[2][2];
    const char* cA = (const char*)g.A + (size_t)cur.pm * tstep; const char* cB = (const char*)g.Bt + (size_t)cur.pn * tstep;
    S.a_ready(cur);
    if constexpr (SP2) {
        PG8_STAGE(PG8_SB(0, 0), cB, voffB); PG8_STAGE(PG8_SB(0, 1), cB + hstep, voffB); PG8_STAGE(PG8_SA(0, 0), cA, voffA); PG8_STAGE(PG8_SA(0, 1), cA + hstep, voffA);
        if (wr == 1) PG8_BAR;
        PG8_WAIT_V(2); PG8_BAR;
        PG8_STAGE(PG8_SB(1, 0), cB + kstep, voffB); PG8_STAGE(PG8_SA(1, 0), cA + kstep, voffA); PG8_STAGE(PG8_SB(1, 1), cB + hstep + kstep, voffB);
        PG8_WAIT_V(6); PG8_BAR;
    } else {
        PG8_STAGE(PG8_SB(0, 0), cB, voffB); PG8_STAGE(PG8_SA(0, 0), cA, voffA); PG8_STAGE(PG8_SB(0, 1), cB + hstep, voffB); PG8_STAGE(PG8_SA(0, 1), cA + hstep, voffA);
        if (wr == 1) PG8_BAR;
        PG8_WAIT_V(4); PG8_BAR;
        PG8_STAGE(PG8_SB(1, 0), cB + kstep, voffB); PG8_STAGE(PG8_SA(1, 0), cA + kstep, voffA); PG8_STAGE(PG8_SB(1, 1), cB + hstep + kstep, voffB);
        PG8_WAIT_V(6); PG8_BAR;
    }
    for (;;) {
        const bool has_next = S.next(ui + 1, nxt);
        const char* nA = has_next ? (const char*)g.A + (size_t)nxt.pm * tstep : cA; const char* nB = has_next ? (const char*)g.Bt + (size_t)nxt.pn * tstep : cB;
        for (int t = 0; t < nt; t += 2) {
            const bool last = (t == nt - 2);
            const char* a1 = cA + (size_t)(t + 1) * kstep;
            const char* a2 = last ? nA : cA + (size_t)(t + 2) * kstep; const char* b2 = last ? nB : cB + (size_t)(t + 2) * kstep;
            const char* a3 = a2 + kstep; const char* b3 = b2 + kstep;
            if (last && has_next) S.a_ready(nxt);
            if constexpr (SP2) {
            PG8_LDB(B0, 0, 0); PG8_LDB(B1, 0, 1); PG8_SCHED; PG8_LDA(At, 0, 0); PG8_STAGE(PG8_SA(1, 1), a1 + hstep, voffA);
            PG8_WAIT_V(8); PG8_WAIT_L(0); PG8_BAR; PG8_MMA(0, 0, At, B0); PG8_MMA(0, 1, At, B1); PG8_BAR; PG8_SCHED;
            PG8_LDA(At, 0, 1); PG8_STAGE(PG8_SB(0, 0), b2, voffB); PG8_STAGE(PG8_SB(0, 1), b2 + hstep, voffB); PG8_STAGE(PG8_SA(0, 0), a2, voffA);
            PG8_WAIT_V(8); PG8_WAIT_L(0); PG8_BAR; PG8_MMA(1, 0, At, B0); PG8_MMA(1, 1, At, B1); PG8_BAR; PG8_SCHED;
            PG8_LDB(B0, 1, 0); PG8_LDB(B1, 1, 1); PG8_SCHED; PG8_LDA(At, 1, 0); PG8_STAGE(PG8_SA(0, 1), a2 + hstep, voffA);
            PG8_WAIT_V(8); PG8_WAIT_L(0); PG8_BAR; PG8_MMA(0, 0, At, B0); PG8_MMA(0, 1, At, B1); PG8_BAR; PG8_SCHED;
            PG8_LDA(At, 1, 1); PG8_STAGE(PG8_SB(1, 0), b3, voffB); PG8_STAGE(PG8_SB(1, 1), b3 + hstep, voffB); PG8_STAGE(PG8_SA(1, 0), a3, voffA);
            PG8_WAIT_V(8); PG8_WAIT_L(0); PG8_BAR; PG8_MMA(1, 0, At, B0); PG8_MMA(1, 1, At, B1); PG8_BAR; PG8_SCHED;
            } else {
            PG8_LDB(B0, 0, 0); PG8_SCHED; PG8_LDA(At, 0, 0); PG8_STAGE(PG8_SA(1, 1), a1 + hstep, voffA);
            PG8_WAIT_L(8); PG8_BAR; PG8_WAIT_L(0); PG8_MMA(0, 0, At, B0); PG8_BAR; PG8_SCHED;
            PG8_LDB(B1, 0, 1); PG8_STAGE(PG8_SB(0, 0), b2, voffB);
            PG8_BAR; PG8_WAIT_L(0); PG8_MMA(0, 1, At, B1); PG8_BAR;
            PG8_LDA(At, 0, 1); PG8_STAGE(PG8_SA(0, 0), a2, voffA);
            PG8_BAR; PG8_WAIT_L(0); PG8_MMA(1, 0, At, B0); PG8_BAR; PG8_SCHED;
            PG8_STAGE(PG8_SB(0, 1), b2 + hstep, voffB);
            PG8_WAIT_V(6); PG8_BAR; PG8_MMA(1, 1, At, B1); PG8_BAR;
            PG8_LDB(B0, 1, 0); PG8_SCHED; PG8_LDA(At, 1, 0); PG8_STAGE(PG8_SA(0, 1), a2 + hstep, voffA);
            PG8_WAIT_L(8); PG8_BAR; PG8_WAIT_L(0); PG8_MMA(0, 0, At, B0); PG8_BAR; PG8_SCHED;
            PG8_LDB(B1, 1, 1); PG8_STAGE(PG8_SB(1, 0), b3, voffB);
            PG8_BAR; PG8_WAIT_L(0); PG8_MMA(0, 1, At, B1); PG8_BAR;
            PG8_LDA(At, 1, 1); PG8_STAGE(PG8_SA(1, 0), a3, voffA);
            PG8_BAR; PG8_WAIT_L(0); PG8_MMA(1, 0, At, B0); PG8_BAR; PG8_SCHED;
            PG8_STAGE(PG8_SB(1, 1), b3 + hstep, voffB);
            PG8_WAIT_V(6); PG8_BAR; PG8_MMA(1, 1, At, B1); PG8_BAR;
            }
        }
        if constexpr (ALIGN_EPI) { if (wr == 0) PG8_BAR; }
        if constexpr (!Epi::AFTER_DRAIN) { E(acc, cur, wr, wc, fr, fq); S.done(cur); }
        if (!has_next) break;
#pragma unroll
        for (int a = 0; a < 2; ++a)
#pragma unroll
            for (int b = 0; b < 2; ++b)
#pragma unroll
                for (int m = 0; m < 4; ++m)
#pragma unroll
                    for (int n = 0; n < 2; ++n) acc[a][b][m][n] = (f32x4){0.f, 0.f, 0.f, 0.f};
        cur = nxt; cA = nA; cB = nB; ++ui;
        if constexpr (ALIGN_EPI) { if (wr == 1) PG8_BAR; }
    }
    PG8_WAIT_V(0);
    if constexpr (!ALIGN_EPI) { if (wr == 0) PG8_BAR; }
    PG8_BAR;
    if constexpr (Epi::AFTER_DRAIN) { E.fused(acc, cur, wr, wc, fr, fq, lds, wid, lane); S.done(cur); }
#undef PG8_SA
#undef PG8_SB
#undef PG8_STAGE
#undef PG8_LDA
#undef PG8_LDB
#undef PG8_MMA
#undef PG8_WAIT_V
#undef PG8_WAIT_L
#undef PG8_BAR
#undef PG8_SCHED
}
}

constexpr int NWAVES = 8, NTHR = NWAVES * 64;
constexpr int BATCH = 2, SEQ = 8192, M = BATCH * SEQ, DM = 4096, DEPTH = 2;
constexpr int SSD_W = 2048, SSD_H = 32, SSD_CD = 4096;
constexpr int SWA_W = 1024, SWA_H = 16;
constexpr int GLA_W = 1024, GLA_KT = 512;
constexpr int DFF = 11008, DIN = 10800, DINP = 11008, DGU = 2 * DFF;
constexpr float EPS = 1e-6f;
constexpr int C_Z = 0, C_XBC = 2048, C_DT = 6144, C_SQ = 6176, C_SK = 7200, C_SV = 7456, C_GQ = 7712, C_GK = 8224, C_GV = 8736, C_GG = 9760, C_GLR = 10784;
enum { I_X = 0, I_ATTN_NORM, I_W_IN, I_SSD_CONV_W, I_SSD_CONV_B, I_SSD_DT_BIAS, I_SSD_A_LOG, I_SSD_D, I_SSD_NORM, I_SWA_SINKS, I_SWA_NORM, I_GLA_W_GATE, I_GLA_B_GATE, I_GLA_NORM,
       I_W_OUT, I_FFN_NORM, I_W_GATE, I_W_UP, I_FFN_CONV_W, I_FFN_CONV_B, I_W_DOWN, I_REL_BIAS, I_FINAL_NORM, N_IN };

constexpr size_t MiB = 1u << 20;
constexpr size_t WS_CTL = 0, CTL_ZERO_BYTES = 1 * MiB;
constexpr size_t WS_WIN = 1 * MiB;
constexpr size_t WS_WOUT = 87 * MiB;
constexpr size_t WS_WGU = 119 * MiB;
constexpr size_t WS_WDN = 291 * MiB;
constexpr size_t WS_H = 377 * MiB;
constexpr size_t WS_R = 505 * MiB;
constexpr size_t WS_PROJ = WS_R;
constexpr size_t WS_YSSD = WS_R + 344 * MiB;
constexpr size_t WS_OSWA = WS_R + 472 * MiB;
constexpr size_t WS_OGLA = WS_R + 536 * MiB;
constexpr size_t WS_Y = WS_R + 600 * MiB;
constexpr size_t WS_GU = WS_R;
constexpr size_t WS_ACT = WS_R + 688 * MiB;
constexpr size_t WS_END = WS_R + 1032 * MiB;
static_assert(DEPTH == 2 && (size_t)DINP * DM * 2 == 86 * MiB && (size_t)DGU * DM * 2 == 172 * MiB && (size_t)M * DINP * 2 == 344 * MiB && (size_t)M * DGU * 2 == 688 * MiB, "ws map");
constexpr int CW_BAR = 4096;

constexpr int RING_BYTES = 131072;
constexpr int MISC_OFF = RING_BYTES + 320;
constexpr int LDS_BYTES = 147456;

#define GAS __attribute__((address_space(1)))
#define LAS __attribute__((address_space(3)))
typedef unsigned short bf16;
typedef unsigned v4u __attribute__((ext_vector_type(4)));
typedef unsigned v2u __attribute__((ext_vector_type(2)));
typedef float f32x4 __attribute__((ext_vector_type(4)));
typedef GAS unsigned gu32;
#define RLX_AGENT __ATOMIC_RELAXED, __HIP_MEMORY_SCOPE_AGENT
#define LDS_WAIT() asm volatile("s_waitcnt lgkmcnt(0)" ::: "memory")
__device__ __forceinline__ unsigned f2bf(float f) { unsigned u = __builtin_bit_cast(unsigned, f); return (u + 0x7fffu + ((u >> 16) & 1u)) >> 16; }
__device__ __forceinline__ unsigned pk2(float lo, float hi) { return f2bf(lo) | (f2bf(hi) << 16); }
__device__ __forceinline__ float bflo(unsigned w) { return __uint_as_float(w << 16); }
__device__ __forceinline__ float bfhi(unsigned w) { return __uint_as_float(w & 0xffff0000u); }
__device__ __forceinline__ float bf1(bf16 h) { return __uint_as_float((unsigned)h << 16); }
__device__ __forceinline__ float silu_f(float x) { return x / (1.f + __expf(-x)); }
__device__ __forceinline__ float wave_sum(float v) {
#pragma unroll
    for (int o = 1; o < 64; o <<= 1) v += __shfl_xor(v, o);
    return v;
}
template <int CTRL> __device__ __forceinline__ float dpp_f(float v) { return __int_as_float(__builtin_amdgcn_update_dpp(0, __float_as_int(v), CTRL, 0xf, 0xf, false)); }
__device__ __forceinline__ float row16_sum(float v) { v += dpp_f<0xB1>(v); v += dpp_f<0x4E>(v); v += dpp_f<0x124>(v); v += dpp_f<0x128>(v); return v; }
__device__ __forceinline__ float pair_sum(float v) { return v + dpp_f<0xB1>(v); }
#define XB_TMO      128
#define XB_XCNT(j)  (256  + 64 * (j))
#define XB_XSUB(j)  (1280 + 64 * (j))
#define XB_XGEN(j)  (2304 + 64 * (j))
#define XB_TOP      3328
#define XB_TOPGEN   3392
#define XCD_BAR_WORDS 3456
#define XB_SPIN_CAP (1u << 18)

__device__ __forceinline__ unsigned xb_ld(unsigned* p)              { return __hip_atomic_load(p, __ATOMIC_RELAXED, __HIP_MEMORY_SCOPE_AGENT); }
__device__ __forceinline__ unsigned xb_add(unsigned* p, unsigned v) { return __hip_atomic_fetch_add(p, v, __ATOMIC_RELAXED, __HIP_MEMORY_SCOPE_AGENT); }
__device__ __forceinline__ unsigned xb_xcc_id() { return (unsigned)__builtin_amdgcn_s_getreg((3 << 11) | 20) & 0xFu; }
#define XB_SPIN(cond, bar) do { unsigned _sp = 0; while (cond) { __builtin_amdgcn_s_sleep(1); \
    if ((++_sp & 255u) == 0u) { if (xb_ld(&(bar)[XB_TMO])) break; if (_sp > XB_SPIN_CAP) { atomicAdd(&(bar)[XB_TMO], 1u); break; } } } } while (0)

struct XcdBarrier {
    unsigned* bar; unsigned x;
    volatile LAS unsigned* st;
};

__device__ __forceinline__ XcdBarrier xcd_barrier_post(unsigned* bar, volatile LAS unsigned* st) {
    XcdBarrier b; b.bar = bar; b.x = xb_xcc_id(); b.st = st;
    if (threadIdx.x == 0) (void)xb_add(&bar[XB_XCNT(b.x)], 1u);
    return b;
}
__device__ __forceinline__ void xcd_barrier_complete(unsigned* bar, unsigned x, unsigned& nloc, unsigned& nx) {
    const unsigned G = gridDim.x * gridDim.y * gridDim.z;
    unsigned sum, cnt, mine, sp = 0u;
    for (;;) {
        sum = 0u; cnt = 0u; mine = 0u;
#pragma unroll
        for (unsigned j = 0; j < 16; ++j) { const unsigned c = xb_ld(&bar[XB_XCNT(j)]); sum += c; cnt += (c > 0u) ? 1u : 0u; mine = (j == x) ? c : mine; }
        if (sum == G) break;
        __builtin_amdgcn_s_sleep(1);
        if ((++sp & 255u) == 0u) { if (xb_ld(&bar[XB_TMO])) break; if (sp > XB_SPIN_CAP) { atomicAdd(&bar[XB_TMO], 1u); break; } }
    }
    nloc = mine > 0u ? mine : 1u; nx = cnt > 0u ? cnt : 1u;
}

__device__ __forceinline__ void xcd_barrier(const XcdBarrier& b) {
    asm volatile("s_waitcnt vmcnt(0)" ::: "memory");
    __syncthreads();
    if (threadIdx.x == 0) {
        unsigned* bar = b.bar;
        __builtin_amdgcn_s_waitcnt(0);
        unsigned nloc = b.st[0], nx = b.st[1];
        if (nloc == 0u) { xcd_barrier_complete(bar, b.x, nloc, nx); b.st[0] = nloc; b.st[1] = nx; }
        const unsigned old = xb_add(&bar[XB_XSUB(b.x)], 1u);
        const unsigned gen = old / nloc;
        if (old + 1u == (gen + 1u) * nloc) {
            __builtin_amdgcn_fence(__ATOMIC_RELEASE, "agent");
            asm volatile("s_waitcnt vmcnt(0)" ::: "memory");
            const unsigned og = xb_add(&bar[XB_TOP], 1u);
            const unsigned tg = og / nx;
            if (og + 1u == (tg + 1u) * nx) xb_add(&bar[XB_TOPGEN], 1u);
            else XB_SPIN(xb_ld(&bar[XB_TOPGEN]) == tg, bar);
            __builtin_amdgcn_fence(__ATOMIC_ACQUIRE, "agent");
            xb_add(&bar[XB_XGEN(b.x)], 1u);
            asm volatile("s_waitcnt vmcnt(0)" ::: "memory");
        } else {
            XB_SPIN(xb_ld(&bar[XB_XGEN(b.x)]) == gen, bar);
            __builtin_amdgcn_fence(__ATOMIC_ACQUIRE, "agent");
            asm volatile("s_waitcnt vmcnt(0)" ::: "memory");
        }
    }
    __syncthreads();
}

struct Args { const float* in[N_IN]; float* out; unsigned char* ws; int ph_lo, ph_hi, li, pad; };
struct Ctx {
    LAS unsigned char* lds;
    int tid, lane, wave, G, bid;
    const float* const* in; float* out; unsigned char* ws;
};
__device__ const unsigned char T5_BUCKET[128] = {0, 1, 2, 3, 4, 5, 6, 7, 8, 9, 10, 11, 12, 13, 14, 15, 16, 16, 16, 17, 17, 18, 18, 18, 19, 19, 19, 20, 20, 20, 20, 21, 21, 21, 21, 22, 22, 22, 22, 22, 23, 23, 23, 23, 23, 23, 24, 24, 24, 24, 24, 24, 25, 25, 25, 25, 25, 25, 25, 26, 26, 26, 26, 26, 26, 26, 26, 27, 27, 27, 27, 27, 27, 27, 27, 27, 27, 28, 28, 28, 28, 28, 28, 28, 28, 28, 28, 29, 29, 29, 29, 29, 29, 29, 29, 29, 29, 29, 29, 30, 30, 30, 30, 30, 30, 30, 30, 30, 30, 30, 30, 30, 30, 31, 31, 31, 31, 31, 31, 31, 31, 31, 31, 31, 31, 31, 31, 31};

__device__ __forceinline__ void transpose_item(const float* W, int K, int N, bf16* WT, int row_off, LAS float* scr, int kb, int nb, int lane) {
    const int k0 = 64 * kb, n0 = 32 * nb; const int nn = n0 + (lane & 31); const bool nv = nn < N;
#pragma unroll 8
    for (int i = 0; i < 32; ++i) { const int kk = 2 * i + (lane >> 5); scr[kk * 33 + (lane & 31)] = nv ? W[(size_t)(k0 + kk) * N + nn] : 0.f; }
    LDS_WAIT(); asm volatile("" ::: "memory");
    const int c = lane & 7;
#pragma unroll
    for (int j = 0; j < 4; ++j) { const int n = (lane >> 3) + 8 * j; const LAS float* s = scr + (8 * c) * 33 + n;
        v4u o; o.x = pk2(s[0 * 33], s[1 * 33]); o.y = pk2(s[2 * 33], s[3 * 33]); o.z = pk2(s[4 * 33], s[5 * 33]); o.w = pk2(s[6 * 33], s[7 * 33]);
        *(GAS v4u*)(WT + (size_t)(row_off + n0 + n) * K + k0 + 8 * c) = o; }
    LDS_WAIT(); asm volatile("" ::: "memory");
}
__device__ __forceinline__ void convert_weights(Ctx& C, int l) {
    LAS float* scr = (LAS float*)(C.lds + C.wave * 16384);
    const int gw = C.bid * NWAVES + C.wave, NGW = C.G * NWAVES;
    constexpr int I_IN = 64 * 344, I_OUT = 64 * 128, I_G = 64 * 344, I_D = 172 * 128;
    constexpr int NITEMS = I_IN + I_OUT + 2 * I_G + I_D;
    const float* w_in = C.in[I_W_IN] + (size_t)l * DM * DIN; const float* w_out = C.in[I_W_OUT] + (size_t)l * DM * DM;
    const float* w_gate = C.in[I_W_GATE] + (size_t)l * DM * DFF; const float* w_up = C.in[I_W_UP] + (size_t)l * DM * DFF; const float* w_dn = C.in[I_W_DOWN] + (size_t)l * DFF * DM;
    bf16* WIN = (bf16*)(C.ws + WS_WIN); bf16* WOUT = (bf16*)(C.ws + WS_WOUT); bf16* WGU = (bf16*)(C.ws + WS_WGU); bf16* WDN = (bf16*)(C.ws + WS_WDN);
    for (int it = gw; it < NITEMS; it += NGW) {
        int r = it;
        if (r < I_IN) { transpose_item(w_in, DM, DIN, WIN, 0, scr, r / 344, r % 344, C.lane); continue; } r -= I_IN;
        if (r < I_OUT) { transpose_item(w_out, DM, DM, WOUT, 0, scr, r / 128, r % 128, C.lane); continue; } r -= I_OUT;
        if (r < I_G) { transpose_item(w_gate, DM, DFF, WGU, 0, scr, r / 344, r % 344, C.lane); continue; } r -= I_G;
        if (r < I_G) { transpose_item(w_up, DM, DFF, WGU, DFF, scr, r / 344, r % 344, C.lane); continue; } r -= I_G;
        transpose_item(w_dn, DFF, DM, WDN, 0, scr, r / 128, r % 128, C.lane);
    }
}
__device__ __forceinline__ void rmsnorm_row_bf16(const float* xrow, const float* w, bf16* orow, int lane) {
    const GAS f32x4* xr = (const GAS f32x4*)xrow + lane; const GAS f32x4* wr = (const GAS f32x4*)w + lane;
    f32x4 v[16]; float ss = 0.f;
#pragma unroll
    for (int j = 0; j < 16; ++j) { v[j] = xr[64 * j]; ss += (v[j].x * v[j].x + v[j].y * v[j].y) + (v[j].z * v[j].z + v[j].w * v[j].w); }
    const float rstd = 1.f / sqrtf(wave_sum(ss) * (1.f / DM) + EPS);
    GAS v2u* o8 = (GAS v2u*)orow + lane;
#pragma unroll
    for (int j = 0; j < 16; ++j) { const f32x4 g = wr[64 * j]; v2u o; o.x = pk2(v[j].x * rstd * g.x, v[j].y * rstd * g.y); o.y = pk2(v[j].z * rstd * g.z, v[j].w * rstd * g.w); o8[64 * j] = o; }
}
__device__ __forceinline__ void rmsnorm_phase(Ctx& C, const float* X, const float* w, bf16* H) {
    const int gw = C.bid * NWAVES + C.wave, NGW = C.G * NWAVES;
    for (int m = gw; m < M; m += NGW) rmsnorm_row_bf16(X + (size_t)m * DM, w, H + (size_t)m * DM, C.lane);
}
__device__ __forceinline__ void final_norm_phase(Ctx& C, float* X, const float* w) {
    const int gw = C.bid * NWAVES + C.wave, NGW = C.G * NWAVES;
    for (int m = gw; m < M; m += NGW) {
        GAS f32x4* xr = (GAS f32x4*)(X + (size_t)m * DM) + C.lane; const GAS f32x4* wr = (const GAS f32x4*)w + C.lane;
        f32x4 v[16]; float ss = 0.f;
#pragma unroll
        for (int j = 0; j < 16; ++j) { v[j] = xr[64 * j]; ss += (v[j].x * v[j].x + v[j].y * v[j].y) + (v[j].z * v[j].z + v[j].w * v[j].w); }
        const float rstd = 1.f / sqrtf(wave_sum(ss) * (1.f / DM) + EPS);
#pragma unroll
        for (int j = 0; j < 16; ++j) { const f32x4 g = wr[64 * j]; xr[64 * j] = v[j] * rstd * g; }
    }
}

constexpr int SSD_TC = 32;
constexpr int SSD_ROW = 288;
__device__ __forceinline__ int ssd_xcol(int h, int half, int g, int cg) { return cg < 4 ? (h * 64 + half * 32 + 8 * cg) : (cg < 20 ? (2048 + g * 128 + 8 * (cg - 4)) : (3072 + g * 128 + 8 * (cg - 20))); }
__device__ __forceinline__ void ssd_unit(Ctx& C, int l, int unit) {
    const int b = unit >> 6, h = (unit >> 1) & 31, half = unit & 1, g = h >> 2;
    const int tid = C.tid;
    LAS float* L = (LAS float*)C.lds;
    LAS float* cw = L;
    LAS float* cb = L + 1152;
    LAS float* S = L + 2048;
    LAS float* dts = L + 2048 + 32 * SSD_ROW;
    LAS float* dAs = dts + 32;
    LAS float* ys = dAs + 32;
    const bf16* PROJ = (const bf16*)(C.ws + WS_PROJ); float* YSSD = (float*)(C.ws + WS_YSSD);
    const float* conv_w = C.in[I_SSD_CONV_W] + (size_t)l * 4 * SSD_CD; const float* conv_b = C.in[I_SSD_CONV_B] + (size_t)l * SSD_CD;
    const float dt_bias = C.in[I_SSD_DT_BIAS][l * SSD_H + h]; const float Ah = -expf(C.in[I_SSD_A_LOG][l * SSD_H + h]); const float Dh = C.in[I_SSD_D][l * SSD_H + h];
    __syncthreads();
    if (tid < SSD_ROW) { const int xc = ssd_xcol(h, half, g, tid >> 3) + (tid & 7); cb[tid] = conv_b[xc];
#pragma unroll
        for (int i = 0; i < 4; ++i) cw[i * SSD_ROW + tid] = conv_w[i * SSD_CD + xc]; }
    int pt[3], pcg[3]; bool pv[3]; size_t pcol[3];
#pragma unroll
    for (int it = 0; it < 3; ++it) { const int idx = tid + NTHR * it; pv[it] = idx < SSD_TC * 36; pt[it] = pv[it] ? idx / 36 : 0; pcg[it] = pv[it] ? idx % 36 : 0; pcol[it] = (size_t)(C_XBC + ssd_xcol(h, half, g, pcg[it])); }
    const int pp = tid >> 4, ng = tid & 15;
    float hst[8];
#pragma unroll
    for (int j = 0; j < 8; ++j) hst[j] = 0.f;
    v4u raw[3][4]; unsigned dtraw = 0;
    const bf16* Pb = PROJ + (size_t)b * SEQ * DINP;
#define SSD_PREFETCH(t0) do { _Pragma("unroll") for (int it = 0; it < 3; ++it) _Pragma("unroll") for (int i = 0; i < 4; ++i) { const int s = (t0) + pt[it] - 3 + i; \
        raw[it][i] = (pv[it] && s >= 0) ? *(const GAS v4u*)(Pb + (size_t)s * DINP + pcol[it]) : (v4u){0u, 0u, 0u, 0u}; } \
        if (tid < SSD_TC) dtraw = Pb[(size_t)((t0) + tid) * DINP + C_DT + h]; } while (0)
    SSD_PREFETCH(0);
    __syncthreads();
    for (int t0 = 0; t0 < SEQ; t0 += SSD_TC) {
#pragma unroll
        for (int it = 0; it < 3; ++it) if (pv[it]) {
            const int c0 = 8 * pcg[it]; float a[8];
            { const f32x4 b0 = *(const LAS f32x4*)(cb + c0), b1 = *(const LAS f32x4*)(cb + c0 + 4); a[0] = b0.x; a[1] = b0.y; a[2] = b0.z; a[3] = b0.w; a[4] = b1.x; a[5] = b1.y; a[6] = b1.z; a[7] = b1.w; }
#pragma unroll
            for (int i = 0; i < 4; ++i) { const f32x4 w0 = *(const LAS f32x4*)(cw + i * SSD_ROW + c0), w1 = *(const LAS f32x4*)(cw + i * SSD_ROW + c0 + 4); const v4u r = raw[it][i];
                a[0] += w0.x * bflo(r.x); a[1] += w0.y * bfhi(r.x); a[2] += w0.z * bflo(r.y); a[3] += w0.w * bfhi(r.y);
                a[4] += w1.x * bflo(r.z); a[5] += w1.y * bfhi(r.z); a[6] += w1.z * bflo(r.w); a[7] += w1.w * bfhi(r.w); }
            f32x4 o0, o1; o0.x = silu_f(a[0]); o0.y = silu_f(a[1]); o0.z = silu_f(a[2]); o0.w = silu_f(a[3]); o1.x = silu_f(a[4]); o1.y = silu_f(a[5]); o1.z = silu_f(a[6]); o1.w = silu_f(a[7]);
            *(LAS f32x4*)(S + pt[it] * SSD_ROW + c0) = o0; *(LAS f32x4*)(S + pt[it] * SSD_ROW + c0 + 4) = o1;
        }
        if (tid < SSD_TC) { const float xr = bf1((bf16)dtraw) + dt_bias; const float dt = xr > 20.f ? xr : log1pf(expf(xr)); dts[tid] = dt; dAs[tid] = expf(dt * Ah); }
        __syncthreads();
        if (t0 + SSD_TC < SEQ) SSD_PREFETCH(t0 + SSD_TC);
#pragma unroll 4
        for (int i = 0; i < SSD_TC; ++i) {
            const LAS float* R = S + i * SSD_ROW;
            const float dt = dts[i], dA = dAs[i], xv = R[pp], xdt = xv * dt;
            float yp = 0.f;
#pragma unroll
            for (int jj = 0; jj < 2; ++jj) { const f32x4 Bv = *(const LAS f32x4*)(R + 32 + 4 * ng + 64 * jj), Cv = *(const LAS f32x4*)(R + 160 + 4 * ng + 64 * jj);
                hst[jj * 4 + 0] = hst[jj * 4 + 0] * dA + xdt * Bv.x; yp += hst[jj * 4 + 0] * Cv.x;
                hst[jj * 4 + 1] = hst[jj * 4 + 1] * dA + xdt * Bv.y; yp += hst[jj * 4 + 1] * Cv.y;
                hst[jj * 4 + 2] = hst[jj * 4 + 2] * dA + xdt * Bv.z; yp += hst[jj * 4 + 2] * Cv.z;
                hst[jj * 4 + 3] = hst[jj * 4 + 3] * dA + xdt * Bv.w; yp += hst[jj * 4 + 3] * Cv.w; }
            yp = row16_sum(yp);
            if (ng == 0) ys[i * 32 + pp] = yp + xv * Dh;
        }
        __syncthreads();
#pragma unroll
        for (int k = 0; k < 2; ++k) { const int idx = tid + NTHR * k, t = idx >> 5, p = idx & 31; YSSD[(size_t)(b * SEQ + t0 + t) * SSD_W + h * 64 + half * 32 + p] = ys[idx]; }
    }
#undef SSD_PREFETCH
    __syncthreads();
}

constexpr int GLA_TC = 32;
constexpr int GLA_ROW = 416;
__device__ __forceinline__ void gla_unit(Ctx& C, int l, int unit) {
    const int b = unit >> 5, h = (unit >> 3) & 3, e = unit & 7;
    const int tid = C.tid;
    LAS float* L = (LAS float*)C.lds;
    LAS float* wg = L;
    LAS float* bg = L + 2048;
    LAS float* S = L + 2304;
    LAS float* os = S + GLA_TC * GLA_ROW;
    const bf16* PROJ = (const bf16*)(C.ws + WS_PROJ); float* OGLA = (float*)(C.ws + WS_OGLA);
    const float* w_gate = C.in[I_GLA_W_GATE] + (size_t)l * 16 * GLA_KT; const float* b_gate = C.in[I_GLA_B_GATE] + (size_t)l * GLA_KT;
    __syncthreads();
    for (int i = tid; i < 16 * 128; i += NTHR) wg[i] = w_gate[(i >> 7) * GLA_KT + h * 128 + (i & 127)];
    if (tid < 128) bg[tid] = b_gate[h * 128 + tid];
    int pt[3], pcg[3]; bool pv[3]; size_t pcol[3];
#pragma unroll
    for (int it = 0; it < 3; ++it) { const int idx = tid + NTHR * it; pv[it] = idx < GLA_TC * 36; pt[it] = pv[it] ? idx / 36 : 0; pcg[it] = pv[it] ? idx % 36 : 0;
        const int cg = pcg[it]; pcol[it] = (size_t)(cg < 16 ? (C_GQ + h * 128 + 8 * cg) : (cg < 32 ? (C_GK + h * 128 + 8 * (cg - 16)) : (C_GV + h * 256 + e * 32 + 8 * (cg - 32)))); }
    const int vv = tid >> 4, kg = tid & 15;
    float st[8];
#pragma unroll
    for (int j = 0; j < 8; ++j) st[j] = 0.f;
    v4u raw[3]; v4u rg0, rg1;
    const bf16* Pb = PROJ + (size_t)b * SEQ * DINP;
#define GLA_PREFETCH(t0) do { _Pragma("unroll") for (int it = 0; it < 3; ++it) raw[it] = pv[it] ? *(const GAS v4u*)(Pb + (size_t)((t0) + pt[it]) * DINP + pcol[it]) : (v4u){0u, 0u, 0u, 0u}; \
        { const bf16* gp = Pb + (size_t)((t0) + (tid >> 4)) * DINP + C_GLR; rg0 = *(const GAS v4u*)gp; rg1 = *(const GAS v4u*)(gp + 8); } } while (0)
    GLA_PREFETCH(0);
    for (int t0 = 0; t0 < SEQ; t0 += GLA_TC) {
        __syncthreads();
#pragma unroll
        for (int it = 0; it < 3; ++it) if (pv[it]) {
            const int cg = pcg[it]; const float sc = cg < 16 ? 0.08838834764831845f : 1.f;
            const int dst = cg < 16 ? (128 + 8 * cg) : (cg < 32 ? (256 + 8 * (cg - 16)) : (384 + 8 * (cg - 32)));
            const v4u r = raw[it]; f32x4 o0, o1;
            o0.x = bflo(r.x) * sc; o0.y = bfhi(r.x) * sc; o0.z = bflo(r.y) * sc; o0.w = bfhi(r.y) * sc; o1.x = bflo(r.z) * sc; o1.y = bfhi(r.z) * sc; o1.z = bflo(r.w) * sc; o1.w = bfhi(r.w) * sc;
            *(LAS f32x4*)(S + pt[it] * GLA_ROW + dst) = o0; *(LAS f32x4*)(S + pt[it] * GLA_ROW + dst + 4) = o1;
        }
        {
            float gl[16];
            gl[0] = bflo(rg0.x); gl[1] = bfhi(rg0.x); gl[2] = bflo(rg0.y); gl[3] = bfhi(rg0.y); gl[4] = bflo(rg0.z); gl[5] = bfhi(rg0.z); gl[6] = bflo(rg0.w); gl[7] = bfhi(rg0.w);
            gl[8] = bflo(rg1.x); gl[9] = bfhi(rg1.x); gl[10] = bflo(rg1.y); gl[11] = bfhi(rg1.y); gl[12] = bflo(rg1.z); gl[13] = bfhi(rg1.z); gl[14] = bflo(rg1.w); gl[15] = bfhi(rg1.w);
            float z[8];
            { const f32x4 b0 = *(const LAS f32x4*)(bg + 8 * kg), b1 = *(const LAS f32x4*)(bg + 8 * kg + 4); z[0] = b0.x; z[1] = b0.y; z[2] = b0.z; z[3] = b0.w; z[4] = b1.x; z[5] = b1.y; z[6] = b1.z; z[7] = b1.w; }
#pragma unroll
            for (int r = 0; r < 16; ++r) { const f32x4 w0 = *(const LAS f32x4*)(wg + r * 128 + 8 * kg), w1 = *(const LAS f32x4*)(wg + r * 128 + 8 * kg + 4);
                z[0] += gl[r] * w0.x; z[1] += gl[r] * w0.y; z[2] += gl[r] * w0.z; z[3] += gl[r] * w0.w; z[4] += gl[r] * w1.x; z[5] += gl[r] * w1.y; z[6] += gl[r] * w1.z; z[7] += gl[r] * w1.w; }
            float av[8];
#pragma unroll
            for (int j = 0; j < 8; ++j) { const float ls = fminf(z[j], 0.f) - log1pf(expf(-fabsf(z[j]))); av[j] = expf(ls * 0.0625f); }
            *(LAS f32x4*)(S + (tid >> 4) * GLA_ROW + 8 * kg) = (f32x4){av[0], av[1], av[2], av[3]}; *(LAS f32x4*)(S + (tid >> 4) * GLA_ROW + 8 * kg + 4) = (f32x4){av[4], av[5], av[6], av[7]};
        }
        __syncthreads();
        if (t0 + GLA_TC < SEQ) GLA_PREFETCH(t0 + GLA_TC);
#pragma unroll 4
        for (int i = 0; i < GLA_TC; ++i) {
            const LAS float* R = S + i * GLA_ROW;
            const float vval = R[384 + vv]; float op = 0.f;
#pragma unroll
            for (int jj = 0; jj < 2; ++jj) { const f32x4 av = *(const LAS f32x4*)(R + 4 * kg + 64 * jj), qv = *(const LAS f32x4*)(R + 128 + 4 * kg + 64 * jj), kv = *(const LAS f32x4*)(R + 256 + 4 * kg + 64 * jj);
                st[jj * 4 + 0] = st[jj * 4 + 0] * av.x + kv.x * vval; op += qv.x * st[jj * 4 + 0];
                st[jj * 4 + 1] = st[jj * 4 + 1] * av.y + kv.y * vval; op += qv.y * st[jj * 4 + 1];
                st[jj * 4 + 2] = st[jj * 4 + 2] * av.z + kv.z * vval; op += qv.z * st[jj * 4 + 2];
                st[jj * 4 + 3] = st[jj * 4 + 3] * av.w + kv.w * vval; op += qv.w * st[jj * 4 + 3]; }
            op = row16_sum(op);
            if (kg == 0) os[i * 32 + vv] = op;
        }
        __syncthreads();
#pragma unroll
        for (int k = 0; k < 2; ++k) { const int idx = tid + NTHR * k, t = idx >> 5, v = idx & 31; OGLA[(size_t)(b * SEQ + t0 + t) * GLA_W + h * 256 + e * 32 + v] = os[idx]; }
    }
#undef GLA_PREFETCH
    __syncthreads();
}

__device__ __forceinline__ void swa_unit(Ctx& C, int l, int unit) {
    const int qb = unit & 127, kvh = (unit >> 7) & 3, b = unit >> 9;
    const int tid = C.tid, pair = tid >> 1, g = pair >> 6, qi = pair & 63, dh = tid & 1, q0 = qb * 64, head = kvh * 4 + g;
    LAS float* L = (LAS float*)C.lds;
    LAS float* Ks = L;
    LAS float* Vs = L + 192 * 64;
    LAS float* bias = L + 2 * 192 * 64;
    const bf16* PROJ = (const bf16*)(C.ws + WS_PROJ); float* OSWA = (float*)(C.ws + WS_OSWA);
    const bf16* Pb = PROJ + (size_t)b * SEQ * DINP;
    __syncthreads();
    { const int gg = tid >> 7, dist = tid & 127; bias[tid] = C.in[I_REL_BIAS][T5_BUCKET[dist] * SWA_H + kvh * 4 + gg]; }
#pragma unroll
    for (int it = 0; it < 6; ++it) { const int idx = tid + NTHR * it; const int kv = idx / 1536, r = idx % 1536, j = r >> 3, cg = r & 7; const int s = q0 - 128 + j;
        v4u w = (v4u){0u, 0u, 0u, 0u};
        if (s >= 0) w = *(const GAS v4u*)(Pb + (size_t)s * DINP + (kv ? C_SV : C_SK) + kvh * 64 + 8 * cg);
        LAS float* d = (kv ? Vs : Ks) + j * 64 + 8 * cg;
        *(LAS f32x4*)d = (f32x4){bflo(w.x), bfhi(w.x), bflo(w.y), bfhi(w.y)}; *(LAS f32x4*)(d + 4) = (f32x4){bflo(w.z), bfhi(w.z), bflo(w.w), bfhi(w.w)}; }
    float q[32], acc[32];
    { const bf16* qp = Pb + (size_t)(q0 + qi) * DINP + C_SQ + head * 64 + dh * 32;
#pragma unroll
      for (int k = 0; k < 4; ++k) { const v4u w = *(const GAS v4u*)(qp + 8 * k);
          q[8 * k + 0] = bflo(w.x) * 0.125f; q[8 * k + 1] = bfhi(w.x) * 0.125f; q[8 * k + 2] = bflo(w.y) * 0.125f; q[8 * k + 3] = bfhi(w.y) * 0.125f;
          q[8 * k + 4] = bflo(w.z) * 0.125f; q[8 * k + 5] = bfhi(w.z) * 0.125f; q[8 * k + 6] = bflo(w.w) * 0.125f; q[8 * k + 7] = bfhi(w.w) * 0.125f; } }
#pragma unroll
    for (int d = 0; d < 32; ++d) acc[d] = 0.f;
    const float sink = C.in[I_SWA_SINKS][l * SWA_H + head];
    float m = sink, lsum = 0.f;
    __syncthreads();
    const int qi0 = __builtin_amdgcn_readfirstlane(qi) & ~31;
    const int jlo = qi0 + 1, jhi = qi0 + 31 + 128;
    for (int j = jlo; j <= jhi; ++j) {
        const int dist = qi + 128 - j; const bool valid = (dist >= 0) && (dist < 128) && (q0 - 128 + j >= 0);
        const LAS float* kr = Ks + j * 64 + dh * 32; float dot = 0.f;
#pragma unroll
        for (int k = 0; k < 8; ++k) { const f32x4 kk = *(const LAS f32x4*)(kr + 4 * k); dot += q[4 * k] * kk.x + q[4 * k + 1] * kk.y + q[4 * k + 2] * kk.z + q[4 * k + 3] * kk.w; }
        dot = pair_sum(dot);
        const float sc = dot + bias[g * 128 + (dist & 127)];
        const float mn = valid ? fmaxf(m, sc) : m;
        const float corr = __expf(m - mn), p = valid ? __expf(sc - mn) : 0.f;
        m = mn; lsum = lsum * corr + p;
        const LAS float* vr = Vs + j * 64 + dh * 32;
#pragma unroll
        for (int k = 0; k < 8; ++k) { const f32x4 vv = *(const LAS f32x4*)(vr + 4 * k);
            acc[4 * k] = acc[4 * k] * corr + p * vv.x; acc[4 * k + 1] = acc[4 * k + 1] * corr + p * vv.y; acc[4 * k + 2] = acc[4 * k + 2] * corr + p * vv.z; acc[4 * k + 3] = acc[4 * k + 3] * corr + p * vv.w; }
    }
    const float inv = 1.f / (lsum + __expf(sink - m));
    float* op = OSWA + (size_t)(b * SEQ + q0 + qi) * SWA_W + head * 64 + dh * 32;
#pragma unroll
    for (int k = 0; k < 8; ++k) *(GAS f32x4*)(op + 4 * k) = (f32x4){acc[4 * k] * inv, acc[4 * k + 1] * inv, acc[4 * k + 2] * inv, acc[4 * k + 3] * inv};
}


typedef short bf16x8 __attribute__((ext_vector_type(8)));
typedef short s16x4 __attribute__((ext_vector_type(4)));
__device__ __forceinline__ f32x4 mfma16(bf16x8 a, bf16x8 b, f32x4 c) { return __builtin_amdgcn_mfma_f32_16x16x32_bf16(a, b, c, 0, 0, 0); }
__device__ __forceinline__ bf16x8 pack8(f32x4 lo, f32x4 hi) { v4u w; w.x = pg8::cvt_pk_bf16(lo.x, lo.y); w.y = pg8::cvt_pk_bf16(lo.z, lo.w); w.z = pg8::cvt_pk_bf16(hi.x, hi.y); w.w = pg8::cvt_pk_bf16(hi.z, hi.w); return __builtin_bit_cast(bf16x8, w); }
__device__ __forceinline__ bf16x8 gfrag(const bf16* Mx, size_t ld, int row0, int k0, int lane) { return *(const GAS bf16x8*)(Mx + (size_t)(row0 + (lane & 15)) * ld + k0 + 8 * (lane >> 4)); }
__device__ __forceinline__ bf16x8 trfrag(const LAS unsigned char* img, int stride, int r0, int r1, int col0, int lane) {
    const int q = (lane & 15) >> 2, p = lane & 3;
    const s16x4 a = __builtin_amdgcn_ds_read_tr16_b64_v4i16((LAS s16x4*)(img + (r0 + q) * stride + (col0 + 4 * p) * 2));
    const s16x4 b = __builtin_amdgcn_ds_read_tr16_b64_v4i16((LAS s16x4*)(img + (r1 + q) * stride + (col0 + 4 * p) * 2));
    return __builtin_shufflevector(a, b, 0, 1, 2, 3, 4, 5, 6, 7);
}
__device__ __forceinline__ float xsum4(float v) { v += __shfl_xor(v, 16); v += __shfl_xor(v, 32); return v; }
__device__ __forceinline__ float xmax4(float v) { v = fmaxf(v, __shfl_xor(v, 16)); v = fmaxf(v, __shfl_xor(v, 32)); return v; }

constexpr int SWA_VSTRIDE = 144;
constexpr int SWA_V_BYTES = 192 * SWA_VSTRIDE;
__device__ __forceinline__ void swa_unit_mfma(Ctx& C, int l, int unit) {
    const int b = unit >> 7, qb = unit & 127, q0 = qb * 64;
    const int tid = C.tid, lane = C.lane, w = C.wave, c = lane & 15, hq = lane >> 4;
    LAS unsigned char* Vimg = C.lds;
    LAS float* tb = (LAS float*)(C.lds + 30720);
    LAS float* ssqx = (LAS float*)(C.lds + 30720 + 12288);
    const bf16* PROJ = (const bf16*)(C.ws + WS_PROJ); float* OSWA = (float*)(C.ws + WS_OSWA); bf16* Y = (bf16*)(C.ws + WS_Y);
    const bf16* Pb = PROJ + (size_t)b * SEQ * DINP;
    __syncthreads();
    for (int i = tid; i < 16 * 192; i += NTHR) { const int hd = i / 192, x = i % 192, dist = x - 32; tb[i] = (dist >= 0 && dist < 128) ? C.in[I_REL_BIAS][T5_BUCKET[dist] * SWA_H + hd] : 0.f; }
    if (tid < 16 * 9) *(LAS v4u*)(Vimg + (192 + tid / 9) * SWA_VSTRIDE + 16 * (tid % 9)) = (v4u){0u, 0u, 0u, 0u};
    const int g = w >> 1, qhalf = w & 1;
    float ssq0 = 0.f, ssq1 = 0.f;
    for (int kvh = 0; kvh < 4; ++kvh) {
        const int head = kvh * 4 + g;
        __syncthreads();
#pragma unroll
        for (int it = 0; it < 3; ++it) { const int idx = tid + NTHR * it, j = idx >> 3, cg = idx & 7; int s = q0 - 128 + j; s = s < 0 ? 0 : s;
            const v4u v = *(const GAS v4u*)(Pb + (size_t)s * DINP + C_SV + kvh * 64 + 8 * cg); *(LAS v4u*)(Vimg + j * SWA_VSTRIDE + 16 * cg) = v; }
        __syncthreads();
        const float sink = C.in[I_SWA_SINKS][l * SWA_H + head];
#pragma nounroll
        for (int qt = 0; qt < 2; ++qt) {
            const int j0 = 32 * qhalf + 16 * qt;
            const bf16x8 qf0 = gfrag(Pb + C_SQ + head * 64, DINP, q0 + j0, 0, lane), qf1 = gfrag(Pb + C_SQ + head * 64, DINP, q0 + j0, 32, lane);
            f32x4 sacc[10];
#pragma unroll
            for (int kt = 0; kt < 10; ++kt) {
                int srow = q0 - 128 + j0 + 16 * kt + c; srow = srow < 0 ? 0 : srow; srow = srow > q0 + 63 ? q0 + 63 : srow;
                const bf16* kp = Pb + (size_t)srow * DINP + C_SK + kvh * 64 + 8 * hq;
                const bf16x8 k0 = *(const GAS bf16x8*)kp, k1 = *(const GAS bf16x8*)(kp + 32);
                f32x4 a = (f32x4){0.f, 0.f, 0.f, 0.f}; a = mfma16(k0, qf0, a); a = mfma16(k1, qf1, a); sacc[kt] = a;
            }
            float mx = sink;
#pragma unroll
            for (int kt = 0; kt < 10; ++kt)
#pragma unroll
                for (int r = 0; r < 4; ++r) { const int dist = c + 128 - 16 * kt - 4 * hq - r; const int s = q0 - 128 + j0 + 16 * kt + 4 * hq + r;
                    const bool valid = (dist >= 0) && (dist < 128) && (s >= 0);
                    const float sc = valid ? sacc[kt][r] * 0.125f + tb[head * 192 + dist + 32] : -1e30f;
                    sacc[kt][r] = sc; mx = fmaxf(mx, sc); }
            mx = xmax4(mx); float sum = 0.f;
#pragma unroll
            for (int kt = 0; kt < 10; ++kt)
#pragma unroll
                for (int r = 0; r < 4; ++r) { const float p = __expf(sacc[kt][r] - mx); sacc[kt][r] = p; sum += p; }
            sum = xsum4(sum); const float inv = 1.f / (sum + __expf(sink - mx));
            f32x4 oacc[4];
#pragma unroll
            for (int dt = 0; dt < 4; ++dt) oacc[dt] = (f32x4){0.f, 0.f, 0.f, 0.f};
#pragma unroll
            for (int ks = 0; ks < 5; ++ks) { const bf16x8 pf = pack8(sacc[2 * ks], sacc[2 * ks + 1]);
#pragma unroll
                for (int dt = 0; dt < 4; ++dt) oacc[dt] = mfma16(trfrag(Vimg, SWA_VSTRIDE, j0 + 32 * ks + 4 * hq, j0 + 32 * ks + 16 + 4 * hq, 16 * dt, lane), pf, oacc[dt]); }
            float sq = 0.f; float* op = OSWA + (size_t)(b * SEQ + q0 + j0 + c) * SWA_W + head * 64 + 4 * hq;
#pragma unroll
            for (int dt = 0; dt < 4; ++dt) { const f32x4 o = oacc[dt] * inv; sq += (o.x * o.x + o.y * o.y) + (o.z * o.z + o.w * o.w); *(GAS f32x4*)(op + 16 * dt) = o; }
            if (qt == 0) ssq0 += sq; else ssq1 += sq;
        }
    }
    ssq0 = xsum4(ssq0); ssq1 = xsum4(ssq1);
    if (hq == 0) { ssqx[w * 32 + c] = ssq0; ssqx[w * 32 + 16 + c] = ssq1; }
    asm volatile("s_waitcnt vmcnt(0)" ::: "memory");
    __syncthreads();
    const float* swa_norm = C.in[I_SWA_NORM] + (size_t)l * SWA_W;
#pragma nounroll
    for (int qt = 0; qt < 2; ++qt) { const int qi = 16 * qt + c;
        const float tot = ssqx[(qhalf + 0) * 32 + qi] + ssqx[(qhalf + 2) * 32 + qi] + ssqx[(qhalf + 4) * 32 + qi] + ssqx[(qhalf + 6) * 32 + qi];
        const float rstd = 1.f / sqrtf(tot * (1.f / 1024.f) + EPS);
        const size_t row = (size_t)(b * SEQ + q0 + 32 * qhalf + qi);
#pragma unroll
        for (int kvh = 0; kvh < 4; ++kvh)
#pragma unroll
            for (int dt = 0; dt < 4; ++dt) { const int col = (kvh * 4 + g) * 64 + 16 * dt + 4 * hq; const f32x4 o = *(const GAS f32x4*)(OSWA + row * SWA_W + col); const f32x4 gn = *(const GAS f32x4*)(swa_norm + col);
                v2u ow; ow.x = pk2(o.x * rstd * gn.x, o.y * rstd * gn.y); ow.y = pk2(o.z * rstd * gn.z, o.w * rstd * gn.w); *(GAS v2u*)(Y + row * DM + 2048 + col) = ow; } }
}

constexpr int N_SSD_UNITS = BATCH * SSD_H * 2, N_GLA_UNITS = BATCH * 4 * 8, N_SWA_UNITS = BATCH * (SEQ / 64);
__device__ __forceinline__ void mixer_phase(Ctx& C, int l) {
    const int G = C.G, bid = C.bid;
    if (G >= N_SSD_UNITS + N_GLA_UNITS + 1) {
        if (bid < N_SSD_UNITS) ssd_unit(C, l, bid);
        else if (bid < N_SSD_UNITS + N_GLA_UNITS) gla_unit(C, l, bid - N_SSD_UNITS);
        else for (int u = bid - (N_SSD_UNITS + N_GLA_UNITS); u < N_SWA_UNITS; u += G - (N_SSD_UNITS + N_GLA_UNITS)) swa_unit_mfma(C, l, u);
    } else {
        for (int u = bid; u < N_SSD_UNITS; u += G) ssd_unit(C, l, u);
        for (int u = bid; u < N_GLA_UNITS; u += G) gla_unit(C, l, u);
        for (int u = bid; u < N_SWA_UNITS; u += G) swa_unit_mfma(C, l, u);
    }
}

__device__ __forceinline__ void finalize_phase(Ctx& C, int l) {
    const int gw = C.bid * NWAVES + C.wave, NGW = C.G * NWAVES, lane = C.lane;
    const bf16* PROJ = (const bf16*)(C.ws + WS_PROJ); const float* YSSD = (const float*)(C.ws + WS_YSSD); const float* OSWA = (const float*)(C.ws + WS_OSWA); const float* OGLA = (const float*)(C.ws + WS_OGLA);
    bf16* Y = (bf16*)(C.ws + WS_Y);
    const float* ssd_norm = C.in[I_SSD_NORM] + (size_t)l * SSD_W; const float* swa_norm = C.in[I_SWA_NORM] + (size_t)l * SWA_W; const float* gla_norm = C.in[I_GLA_NORM] + (size_t)l * 256;
    for (int m = gw; m < M; m += NGW) {
        const bf16* pr = PROJ + (size_t)m * DINP; bf16* yr = Y + (size_t)m * DM;
#pragma unroll 2
        for (int grp = 0; grp < 8; ++grp) { const int c = 256 * grp + 4 * lane;
            const f32x4 y = *(const GAS f32x4*)(YSSD + (size_t)m * SSD_W + c); const v2u zz = *(const GAS v2u*)(pr + C_Z + c); const f32x4 w = *(const GAS f32x4*)(ssd_norm + c);
            f32x4 v; v.x = y.x * silu_f(bflo(zz.x)); v.y = y.y * silu_f(bfhi(zz.x)); v.z = y.z * silu_f(bflo(zz.y)); v.w = y.w * silu_f(bfhi(zz.y));
            const float ss = wave_sum((v.x * v.x + v.y * v.y) + (v.z * v.z + v.w * v.w)); const float rstd = 1.f / sqrtf(ss * (1.f / 256.f) + EPS);
            v2u o; o.x = pk2(v.x * rstd * w.x, v.y * rstd * w.y); o.y = pk2(v.z * rstd * w.z, v.w * rstd * w.w); *(GAS v2u*)(yr + c) = o; }
#pragma unroll 2
        for (int hd = 0; hd < 4; ++hd) { const int c = 256 * hd + 4 * lane;
            const f32x4 v = *(const GAS f32x4*)(OGLA + (size_t)m * GLA_W + c); const v2u gg = *(const GAS v2u*)(pr + C_GG + c); const f32x4 w = *(const GAS f32x4*)(gla_norm + 4 * lane);
            const float ss = wave_sum((v.x * v.x + v.y * v.y) + (v.z * v.z + v.w * v.w)); const float rstd = 1.f / sqrtf(ss * (1.f / 256.f) + EPS);
            v2u o; o.x = pk2(v.x * rstd * w.x * silu_f(bflo(gg.x)), v.y * rstd * w.y * silu_f(bfhi(gg.x))); o.y = pk2(v.z * rstd * w.z * silu_f(bflo(gg.y)), v.w * rstd * w.w * silu_f(bfhi(gg.y))); *(GAS v2u*)(yr + 3072 + c) = o; }
    }
}

__device__ __forceinline__ void act_phase(Ctx& C, int l) {
    const bf16* GU = (const bf16*)(C.ws + WS_GU); bf16* ACT = (bf16*)(C.ws + WS_ACT);
    const float* cw = C.in[I_FFN_CONV_W] + (size_t)l * 3 * DFF; const float* cb = C.in[I_FFN_CONV_B] + (size_t)l * DFF;
    constexpr int NCG = DFF / 8, NRB = M / 32; constexpr long NIT = (long)NCG * NRB;
    for (long it = (long)C.bid * NTHR + C.tid; it < NIT; it += (long)C.G * NTHR) {
        const int cg = (int)(it % NCG), rb = (int)(it / NCG), c0 = 8 * cg, r0 = 32 * rb;
        float w0[8], w1[8], w2[8], bb[8];
#pragma unroll
        for (int e = 0; e < 8; ++e) { w0[e] = cw[c0 + e]; w1[e] = cw[DFF + c0 + e]; w2[e] = cw[2 * DFF + c0 + e]; bb[e] = cb[c0 + e]; }
        float g1[8], g2[8];
        const bool first = (r0 % SEQ) == 0;
        { v4u a = (v4u){0u, 0u, 0u, 0u}, b2 = (v4u){0u, 0u, 0u, 0u};
          if (!first) { a = *(const GAS v4u*)(GU + (size_t)(r0 - 1) * DGU + c0); b2 = *(const GAS v4u*)(GU + (size_t)(r0 - 2) * DGU + c0); }
          g1[0] = bflo(a.x); g1[1] = bfhi(a.x); g1[2] = bflo(a.y); g1[3] = bfhi(a.y); g1[4] = bflo(a.z); g1[5] = bfhi(a.z); g1[6] = bflo(a.w); g1[7] = bfhi(a.w);
          g2[0] = bflo(b2.x); g2[1] = bfhi(b2.x); g2[2] = bflo(b2.y); g2[3] = bfhi(b2.y); g2[4] = bflo(b2.z); g2[5] = bfhi(b2.z); g2[6] = bflo(b2.w); g2[7] = bfhi(b2.w); }
#pragma unroll 4
        for (int r = 0; r < 32; ++r) {
            const v4u gw_ = *(const GAS v4u*)(GU + (size_t)(r0 + r) * DGU + c0), uw = *(const GAS v4u*)(GU + (size_t)(r0 + r) * DGU + DFF + c0);
            float g0[8], u[8], o[8];
            g0[0] = bflo(gw_.x); g0[1] = bfhi(gw_.x); g0[2] = bflo(gw_.y); g0[3] = bfhi(gw_.y); g0[4] = bflo(gw_.z); g0[5] = bfhi(gw_.z); g0[6] = bflo(gw_.w); g0[7] = bfhi(gw_.w);
            u[0] = bflo(uw.x); u[1] = bfhi(uw.x); u[2] = bflo(uw.y); u[3] = bfhi(uw.y); u[4] = bflo(uw.z); u[5] = bfhi(uw.z); u[6] = bflo(uw.w); u[7] = bfhi(uw.w);
#pragma unroll
            for (int e = 0; e < 8; ++e) { const float gc = bb[e] + w0[e] * g2[e] + w1[e] * g1[e] + w2[e] * g0[e]; o[e] = silu_f(gc) * u[e]; g2[e] = g1[e]; g1[e] = g0[e]; }
            v4u ow; ow.x = pk2(o[0], o[1]); ow.y = pk2(o[2], o[3]); ow.z = pk2(o[4], o[5]); ow.w = pk2(o[6], o[7]);
            *(GAS v4u*)(ACT + (size_t)(r0 + r) * DFF + c0) = ow;
        }
    }
}

constexpr int PH_PER_LAYER = 9, PH_FINAL = DEPTH * PH_PER_LAYER, N_PHASES = PH_FINAL + 1;
#ifndef MK_ONE_LAUNCH
#define MK_ONE_LAUNCH 1
#endif
__global__ void __launch_bounds__(NTHR, 2) fwd_kernel(Args args) {
    extern __shared__ __attribute__((aligned(16))) unsigned char lds[];
    Ctx C;
    C.lds = (LAS unsigned char*)lds;
    C.tid = threadIdx.x; C.lane = C.tid & 63; C.wave = __builtin_amdgcn_readfirstlane(C.tid >> 6);
    C.G = gridDim.x; C.bid = blockIdx.x;
    C.in = args.in; C.out = args.out; C.ws = args.ws;
    volatile LAS unsigned* MISC = (volatile LAS unsigned*)(C.lds + MISC_OFF);
    for (int u = C.tid; u < (LDS_BYTES - RING_BYTES) / 4; u += NTHR) ((LAS unsigned*)(C.lds + RING_BYTES))[u] = 0u;
    __syncthreads();
    gu32* ctl = (gu32*)(args.ws + WS_CTL);
    XcdBarrier bar = xcd_barrier_post((unsigned*)(ctl + CW_BAR) + args.li * XCD_BAR_WORDS, MISC + 8);
    const int lo = args.ph_lo, hi = args.ph_hi;
#define IN(k) (lo <= (k) && (k) < hi)
#define SEAM(k) do { if (IN(k) && IN((k) + 1)) xcd_barrier(bar); } while (0)
    float* xres = args.out;
    bf16* H = (bf16*)(args.ws + WS_H);
#define LAYER_BODY(l) do { \
        const int pb = l * PH_PER_LAYER; \
        const float* xin = (l == 0) ? args.in[I_X] : (const float*)xres; \
        if (IN(pb + 0)) { convert_weights(C, l); rmsnorm_phase(C, xin, args.in[I_ATTN_NORM] + (size_t)l * DM, H); } \
        SEAM(pb + 0); \
        if (IN(pb + 1)) { \
            pg8::Gemm g{H, (const bf16*)(args.ws + WS_WIN), M, DINP, DM}; pg8::StaticOrder S; S.init(M, DINP, C.G, C.bid); \
            pg8::EpiBf16 E{(bf16*)(args.ws + WS_PROJ), DINP}; \
            pg8::gemm_phase<pg8::EpiBf16, pg8::StaticOrder, true, true>(C.lds, g, S, E); \
        } \
        SEAM(pb + 1); \
        if (IN(pb + 2)) mixer_phase(C, l); \
        SEAM(pb + 2); \
        if (IN(pb + 3)) finalize_phase(C, l); \
        SEAM(pb + 3); \
        if (IN(pb + 4)) { \
            pg8::Gemm g{(const bf16*)(args.ws + WS_Y), (const bf16*)(args.ws + WS_WOUT), M, DM, DM}; pg8::StaticOrder S; S.init(M, DM, C.G, C.bid); \
            pg8::EpiRes E{xin, xres, DM}; \
            pg8::gemm_phase<pg8::EpiRes, pg8::StaticOrder, true, true>(C.lds, g, S, E); \
        } \
        SEAM(pb + 4); \
        if (IN(pb + 5)) rmsnorm_phase(C, xres, args.in[I_FFN_NORM] + (size_t)l * DM, H); \
        SEAM(pb + 5); \
        if (IN(pb + 6)) { \
            pg8::Gemm g{H, (const bf16*)(args.ws + WS_WGU), M, DGU, DM}; pg8::StaticOrder S; S.init(M, DGU, C.G, C.bid); \
            pg8::EpiBf16 E{(bf16*)(args.ws + WS_GU), DGU}; \
            pg8::gemm_phase<pg8::EpiBf16, pg8::StaticOrder, true, true>(C.lds, g, S, E); \
        } \
        SEAM(pb + 6); \
        if (IN(pb + 7)) act_phase(C, l); \
        SEAM(pb + 7); \
        if (IN(pb + 8)) { \
            pg8::Gemm g{(const bf16*)(args.ws + WS_ACT), (const bf16*)(args.ws + WS_WDN), M, DM, DFF}; pg8::StaticOrder S; S.init(M, DM, C.G, C.bid); \
            pg8::EpiRes E{xres, xres, DM}; \
            pg8::gemm_phase<pg8::EpiRes, pg8::StaticOrder, true, true>(C.lds, g, S, E); \
        } \
        SEAM(pb + 8); \
     \
    } while (0)
    LAYER_BODY(0);
    LAYER_BODY(1);
#undef LAYER_BODY
    if (IN(PH_FINAL)) final_norm_phase(C, xres, args.in[I_FINAL_NORM]);
#undef IN
#undef SEAM
}

extern "C" void kernel_launch(void* const* d_in, const int* in_sizes, int n_in, void* d_out, int out_size, void* d_ws, size_t ws_size, hipStream_t stream) {
    static int grid = 0;
    if (grid == 0) {
        if (n_in != N_IN || out_size != M * DM || ws_size < WS_END) { fprintf(stderr, "kernel_launch: unexpected shapes (n_in %d, out %d, ws %zu < %zu)\n", n_in, out_size, ws_size, (size_t)WS_END); grid = -1; return; }
        int dev = 0, cus = 0, per_cu = 0;
        if (hipGetDevice(&dev) != hipSuccess || hipDeviceGetAttribute(&cus, hipDeviceAttributeMultiprocessorCount, dev) != hipSuccess) { grid = -1; return; }
        if (hipFuncSetAttribute((const void*)fwd_kernel, hipFuncAttributeMaxDynamicSharedMemorySize, LDS_BYTES) != hipSuccess) { fprintf(stderr, "kernel_launch: hipFuncSetAttribute failed\n"); grid = -1; return; }
        if (hipOccupancyMaxActiveBlocksPerMultiprocessor(&per_cu, (const void*)fwd_kernel, NTHR, LDS_BYTES) != hipSuccess || per_cu < 1) { fprintf(stderr, "kernel_launch: occupancy query says %d\n", per_cu); (void)hipGetLastError(); grid = -1; return; }
        grid = cus;
    }
    if (grid < 0) return;
    if (hipMemsetAsync((char*)d_ws + WS_CTL, 0, CTL_ZERO_BYTES, stream) != hipSuccess) return;
    Args a{};
    for (int i = 0; i < N_IN; ++i) a.in[i] = (const float*)d_in[i];
    a.out = (float*)d_out; a.ws = (unsigned char*)d_ws; a.pad = 0;
#if MK_ONE_LAUNCH
    a.ph_lo = 0; a.ph_hi = N_PHASES; a.li = 0;
    hipLaunchKernelGGL(fwd_kernel, dim3(grid), dim3(NTHR), LDS_BYTES, stream, a);
#else
    for (int p = 0; p < N_PHASES; ++p) { a.ph_lo = p; a.ph_hi = p + 1; a.li = p;
        hipLaunchKernelGGL(fwd_kernel, dim3(grid), dim3(NTHR), LDS_BYTES, stream, a); }
#endif
}
```

```cpp
#include <hip/hip_runtime.h>
#include <cstdio>
#include <cstdint>
namespace pg8 {
#define PG8_LAS __attribute__((address_space(3)))
typedef unsigned short bf16_t;
typedef short bf16x8 __attribute__((ext_vector_type(8)));
typedef float f32x4 __attribute__((ext_vector_type(4)));
typedef unsigned u32x4 __attribute__((ext_vector_type(4)));
constexpr int BM = 256, BK = 64, HALF = 128, HTB = HALF * BK * 2  , STAGE_BYTES = 8 * HTB, NXCD = 8, WGM = 8;

__host__ __device__ __forceinline__ int lds_byte(int r, int c) { const int st = (r >> 4) * 2 + (c >> 5), rr = r & 15, cc = c & 31, ob = rr * 64 + cc * 2; return st * 1024 + (ob ^ (((ob >> 9) & 1) << 5)); }
__host__ __device__ __forceinline__ void stage_rc(int b, int& R, int& C) { const int st = b / 1024, sb = b % 1024, swz = sb ^ (((sb >> 9) & 1) << 5); R = (st >> 1) * 16 + swz / 64; C = (st & 1) * 32 + (swz % 64) / 2; }
__host__ __device__ __forceinline__ int perm32(int rho) { const int n = rho >> 4, i = rho & 15; return 8 * (i >> 2) + 4 * n + (i & 3); }

struct Unit { int pm, pn; };
struct Gemm { const bf16_t* A; const bf16_t* Bt; int M, N, K; };

struct StaticOrder {
    int nM, nN, nwg, G, c;
    __host__ __device__ void init(int M, int N, int G_, int c_) { nM = M / BM; nN = N / BM; nwg = nM * nN; G = G_; c = c_; }
    __host__ __device__ bool next(int i, Unit& u) const {
        const long L = (long)i * G + c; if (L >= nwg) return false;
        int wgid = (int)L; { const int q = nwg / NXCD, r = nwg % NXCD, xcd = wgid % NXCD, off = wgid / NXCD; wgid = (xcd < r ? xcd * (q + 1) : r * (q + 1) + (xcd - r) * q) + off; }
        const int nig = WGM * nN, gid = wgid / nig, fm = gid * WGM, gsz = (nM - fm) < WGM ? (nM - fm) : WGM;
        u.pm = fm + ((wgid % nig) % gsz); u.pn = (wgid % nig) / gsz; return true;
    }
    __device__ __forceinline__ void a_ready(const Unit&) const {}
    __device__ __forceinline__ void done(const Unit&) const {}
};

__device__ __forceinline__ unsigned cvt_pk_bf16(float lo, float hi) { unsigned r; asm volatile("v_cvt_pk_bf16_f32 %0, %1, %2" : "=v"(r) : "v"(lo), "v"(hi)); return r; }

struct EpiBf16 {
    static constexpr bool PERM = true, AFTER_DRAIN = false;
    bf16_t* O; int ldc;
    __device__ __forceinline__ void operator()(const f32x4 (&acc)[2][2][4][2], const Unit& u, int wr, int wc, int fr, int fq) const {
        const int row0 = u.pm * BM + wr * 64 + fr; const int col0 = u.pn * BM + wc * 32 + 8 * fq;
#pragma unroll
        for (int ai = 0; ai < 2; ++ai)
#pragma unroll
            for (int m = 0; m < 4; ++m) { bf16_t* rowp = O + (size_t)(row0 + ai * HALF + m * 16) * ldc + col0;
#pragma unroll
                for (int bj = 0; bj < 2; ++bj) { const f32x4 v0 = acc[ai][bj][m][0], v1 = acc[ai][bj][m][1];
                    u32x4 w; w.x = cvt_pk_bf16(v0[0], v0[1]); w.y = cvt_pk_bf16(v0[2], v0[3]); w.z = cvt_pk_bf16(v1[0], v1[1]); w.w = cvt_pk_bf16(v1[2], v1[3]);
                    *(u32x4*)(rowp + bj * HALF) = w; } }
    }
};
struct EpiRes {
    static constexpr bool PERM = false, AFTER_DRAIN = false;
    const float* base; float* out; int ldc;
    __device__ __forceinline__ void operator()(const f32x4 (&acc)[2][2][4][2], const Unit& u, int wr, int wc, int fr, int fq) const {
        const int row0 = u.pm * BM + wr * 64 + fr, col0 = u.pn * BM + wc * 32 + 4 * fq;
#pragma unroll
        for (int ai = 0; ai < 2; ++ai)
#pragma unroll
            for (int m = 0; m < 4; ++m) { const size_t off = (size_t)(row0 + ai * HALF + m * 16) * ldc + col0;
#pragma unroll
                for (int bj = 0; bj < 2; ++bj)
#pragma unroll
                    for (int n = 0; n < 2; ++n) { const f32x4 bs = *(const f32x4*)(base + off + bj * HALF + n * 16); *(f32x4*)(out + off + bj * HALF + n * 16) = bs + acc[ai][bj][m][n]; } }
    }
};
template <class Epi, class Sched, bool ALIGN_EPI = false, bool SP2 = false>
__device__ __forceinline__ void gemm_phase(PG8_LAS unsigned char* lds, const Gemm g, const Sched& S, const Epi& E) {
    const int tid = threadIdx.x, wid = __builtin_amdgcn_readfirstlane(tid >> 6), lane = tid & 63, wr = wid >> 2, wc = wid & 3, fr = lane & 15, fq = lane >> 4;
    const int K = g.K, nt = K / BK;
    unsigned voffA[2], voffB[2];
#pragma unroll
    for (int i = 0; i < 2; ++i) { int R, C; stage_rc(tid * 16 + i * 8192, R, C); const int Rb = Epi::PERM ? ((R & ~31) + perm32(R & 31)) : R;
        voffA[i] = (unsigned)(R * K + C) * 2u; voffB[i] = (unsigned)(Rb * K + C) * 2u; }
    const size_t kstep = (size_t)(BK * 2);
    const size_t hstep = (size_t)HALF * K * 2;
    const size_t tstep = 2 * hstep;
    const unsigned ldsw = (unsigned)wid * 1024u;
    const int aoff = lds_byte(wr * 64 + fr, fq * 8), boff = lds_byte(wc * 32 + fr, fq * 8);
#define PG8_SA(b, h) (((b) * 2 + (h)) * HTB)
#define PG8_SB(b, h) ((4 + (b) * 2 + (h)) * HTB)
#define PG8_STAGE(bufoff, gbase, voff) do { _Pragma("unroll") for (int _i = 0; _i < 2; ++_i) \
        __builtin_amdgcn_global_load_lds((const unsigned*)((const char*)(gbase) + (voff)[_i]), (PG8_LAS unsigned*)(lds + (bufoff) + ldsw + _i * 8192), 16, 0, 0); } while (0)
#define PG8_LDA(dst, b, h) do { _Pragma("unroll") for (int m = 0; m < 4; ++m) _Pragma("unroll") for (int k = 0; k < 2; ++k) dst[m][k] = *(const PG8_LAS bf16x8*)(lds + PG8_SA(b, h) + aoff + m * 2048 + k * 1024); } while (0)
#define PG8_LDB(dst, b, h) do { _Pragma("unroll") for (int n = 0; n < 2; ++n) _Pragma("unroll") for (int k = 0; k < 2; ++k) dst[n][k] = *(const PG8_LAS bf16x8*)(lds + PG8_SB(b, h) + boff + n * 2048 + k * 1024); } while (0)
#define PG8_MMA(ai, bj, At, Bt) do { __builtin_amdgcn_s_setprio(1); _Pragma("unroll") for (int m = 0; m < 4; ++m) _Pragma("unroll") for (int n = 0; n < 2; ++n) _Pragma("unroll") for (int k = 0; k < 2; ++k) \
        acc[ai][bj][m][n] = __builtin_amdgcn_mfma_f32_16x16x32_bf16(Bt[n][k], At[m][k], acc[ai][bj][m][n], 0, 0, 0); __builtin_amdgcn_s_setprio(0); } while (0)
#define PG8_WAIT_V(n) asm volatile("s_waitcnt vmcnt(" #n ")" ::: "memory")
#define PG8_WAIT_L(n) asm volatile("s_waitcnt lgkmcnt(" #n ")" ::: "memory")
#define PG8_BAR __builtin_amdgcn_s_barrier()
#define PG8_SCHED __builtin_amdgcn_sched_barrier(0)
    Unit cur, nxt; int ui = 0;
    if (!S.next(0, cur)) return;
    f32x4 acc[2][2][4][2];
#pragma unroll
    for (int a = 0; a < 2; ++a)
#pragma unroll
        for (int b = 0; b < 2; ++b)
#pragma unroll
            for (int m = 0; m < 4; ++m)
#pragma unroll
                for (int n = 0; n < 2; ++n) acc[a][b][m][n] = (f32x4){0.f, 0.f, 0.f, 0.f};
    bf16x8 At[4][2], B0[2][2], B1[2][2];
    const char* cA = (const char*)g.A + (size_t)cur.pm * tstep; const char* cB = (const char*)g.Bt + (size_t)cur.pn * tstep;
    S.a_ready(cur);
    if constexpr (SP2) {
        PG8_STAGE(PG8_SB(0, 0), cB, voffB); PG8_STAGE(PG8_SB(0, 1), cB + hstep, voffB); PG8_STAGE(PG8_SA(0, 0), cA, voffA); PG8_STAGE(PG8_SA(0, 1), cA + hstep, voffA);
        if (wr == 1) PG8_BAR;
        PG8_WAIT_V(2); PG8_BAR;
        PG8_STAGE(PG8_SB(1, 0), cB + kstep, voffB); PG8_STAGE(PG8_SA(1, 0), cA + kstep, voffA); PG8_STAGE(PG8_SB(1, 1), cB + hstep + kstep, voffB);
        PG8_WAIT_V(6); PG8_BAR;
    } else {
        PG8_STAGE(PG8_SB(0, 0), cB, voffB); PG8_STAGE(PG8_SA(0, 0), cA, voffA); PG8_STAGE(PG8_SB(0, 1), cB + hstep, voffB); PG8_STAGE(PG8_SA(0, 1), cA + hstep, voffA);
        if (wr == 1) PG8_BAR;
        PG8_WAIT_V(4); PG8_BAR;
        PG8_STAGE(PG8_SB(1, 0), cB + kstep, voffB); PG8_STAGE(PG8_SA(1, 0), cA + kstep, voffA); PG8_STAGE(PG8_SB(1, 1), cB + hstep + kstep, voffB);
        PG8_WAIT_V(6); PG8_BAR;
    }
    for (;;) {
        const bool has_next = S.next(ui + 1, nxt);
        const char* nA = has_next ? (const char*)g.A + (size_t)nxt.pm * tstep : cA; const char* nB = has_next ? (const char*)g.Bt + (size_t)nxt.pn * tstep : cB;
        for (int t = 0; t < nt; t += 2) {
            const bool last = (t == nt - 2);
            const char* a1 = cA + (size_t)(t + 1) * kstep;
            const char* a2 = last ? nA : cA + (size_t)(t + 2) * kstep; const char* b2 = last ? nB : cB + (size_t)(t + 2) * kstep;
            const char* a3 = a2 + kstep; const char* b3 = b2 + kstep;
            if (last && has_next) S.a_ready(nxt);
            if constexpr (SP2) {
            PG8_LDB(B0, 0, 0); PG8_LDB(B1, 0, 1); PG8_SCHED; PG8_LDA(At, 0, 0); PG8_STAGE(PG8_SA(1, 1), a1 + hstep, voffA);
            PG8_WAIT_V(8); PG8_WAIT_L(0); PG8_BAR; PG8_MMA(0, 0, At, B0); PG8_MMA(0, 1, At, B1); PG8_BAR; PG8_SCHED;
            PG8_LDA(At, 0, 1); PG8_STAGE(PG8_SB(0, 0), b2, voffB); PG8_STAGE(PG8_SB(0, 1), b2 + hstep, voffB); PG8_STAGE(PG8_SA(0, 0), a2, voffA);
            PG8_WAIT_V(8); PG8_WAIT_L(0); PG8_BAR; PG8_MMA(1, 0, At, B0); PG8_MMA(1, 1, At, B1); PG8_BAR; PG8_SCHED;
            PG8_LDB(B0, 1, 0); PG8_LDB(B1, 1, 1); PG8_SCHED; PG8_LDA(At, 1, 0); PG8_STAGE(PG8_SA(0, 1), a2 + hstep, voffA);
            PG8_WAIT_V(8); PG8_WAIT_L(0); PG8_BAR; PG8_MMA(0, 0, At, B0); PG8_MMA(0, 1, At, B1); PG8_BAR; PG8_SCHED;
            PG8_LDA(At, 1, 1); PG8_STAGE(PG8_SB(1, 0), b3, voffB); PG8_STAGE(PG8_SB(1, 1), b3 + hstep, voffB); PG8_STAGE(PG8_SA(1, 0), a3, voffA);
            PG8_WAIT_V(8); PG8_WAIT_L(0); PG8_BAR; PG8_MMA(1, 0, At, B0); PG8_MMA(1, 1, At, B1); PG8_BAR; PG8_SCHED;
            } else {
            PG8_LDB(B0, 0, 0); PG8_SCHED; PG8_LDA(At, 0, 0); PG8_STAGE(PG8_SA(1, 1), a1 + hstep, voffA);
            PG8_WAIT_L(8); PG8_BAR; PG8_WAIT_L(0); PG8_MMA(0, 0, At, B0); PG8_BAR; PG8_SCHED;
            PG8_LDB(B1, 0, 1); PG8_STAGE(PG8_SB(0, 0), b2, voffB);
            PG8_BAR; PG8_WAIT_L(0); PG8_MMA(0, 1, At, B1); PG8_BAR;
            PG8_LDA(At, 0, 1); PG8_STAGE(PG8_SA(0, 0), a2, voffA);
            PG8_BAR; PG8_WAIT_L(0); PG8_MMA(1, 0, At, B0); PG8_BAR; PG8_SCHED;
            PG8_STAGE(PG8_SB(0, 1), b2 + hstep, voffB);
            PG8_WAIT_V(6); PG8_BAR; PG8_MMA(1, 1, At, B1); PG8_BAR;
            PG8_LDB(B0, 1, 0); PG8_SCHED; PG8_LDA(At, 1, 0); PG8_STAGE(PG8_SA(0, 1), a2 + hstep, voffA);
            PG8_WAIT_L(8); PG8_BAR; PG8_WAIT_L(0); PG8_MMA(0, 0, At, B0); PG8_BAR; PG8_SCHED;
            PG8_LDB(B1, 1, 1); PG8_STAGE(PG8_SB(1, 0), b3, voffB);
            PG8_BAR; PG8_WAIT_L(0); PG8_MMA(0, 1, At, B1); PG8_BAR;
            PG8_LDA(At, 1, 1); PG8_STAGE(PG8_SA(1, 0), a3, voffA);
            PG8_BAR; PG8_WAIT_L(0); PG8_MMA(1, 0, At, B0); PG8_BAR; PG8_SCHED;
            PG8_STAGE(PG8_SB(1, 1), b3 + hstep, voffB);
            PG8_WAIT_V(6); PG8_BAR; PG8_MMA(1, 1, At, B1); PG8_BAR;
            }
        }
        if constexpr (ALIGN_EPI) { if (wr == 0) PG8_BAR; }
        if constexpr (!Epi::AFTER_DRAIN) { E(acc, cur, wr, wc, fr, fq); S.done(cur); }
        if (!has_next) break;
#pragma unroll
        for (int a = 0; a < 2; ++a)
#pragma unroll
            for (int b = 0; b < 2; ++b)
#pragma unroll
                for (int m = 0; m < 4; ++m)
#pragma unroll
                    for (int n = 0; n < 2; ++n) acc[a][b][m][n] = (f32x4){0.f, 0.f, 0.f, 0.f};
        cur = nxt; cA = nA; cB = nB; ++ui;
        if constexpr (ALIGN_EPI) { if (wr == 1) PG8_BAR; }
    }
    PG8_WAIT_V(0);
    if constexpr (!ALIGN_EPI) { if (wr == 0) PG8_BAR; }
    PG8_BAR;
    if constexpr (Epi::AFTER_DRAIN) { E.fused(acc, cur, wr, wc, fr, fq, lds, wid, lane); S.done(cur); }
#undef PG8_SA
#undef PG8_SB
#undef PG8_STAGE
#undef PG8_LDA
#undef PG8_LDB
#undef PG8_MMA
#undef PG8_WAIT_V
#undef PG8_WAIT_L
#undef PG8_BAR
#undef PG8_SCHED
}
}

constexpr int NWAVES = 8, NTHR = NWAVES * 64;
constexpr int BATCH = 2, SEQ = 8192, M = BATCH * SEQ, DM = 4096, DEPTH = 2;
constexpr int SSD_W = 2048, SSD_H = 32, SSD_CD = 4096;
constexpr int SWA_W = 1024, SWA_H = 16;
constexpr int GLA_W = 1024, GLA_KT = 512;
constexpr int DFF = 11008, DIN = 10800, DINP = 11008, DGU = 2 * DFF;
constexpr float EPS = 1e-6f;
constexpr int C_Z = 0, C_XBC = 2048, C_DT = 6144, C_SQ = 6176, C_SK = 7200, C_SV = 7456, C_GQ = 7712, C_GK = 8224, C_GV = 8736, C_GG = 9760, C_GLR = 10784;
enum { I_X = 0, I_ATTN_NORM, I_W_IN, I_SSD_CONV_W, I_SSD_CONV_B, I_SSD_DT_BIAS, I_SSD_A_LOG, I_SSD_D, I_SSD_NORM, I_SWA_SINKS, I_SWA_NORM, I_GLA_W_GATE, I_GLA_B_GATE, I_GLA_NORM,
       I_W_OUT, I_FFN_NORM, I_W_GATE, I_W_UP, I_FFN_CONV_W, I_FFN_CONV_B, I_W_DOWN, I_REL_BIAS, I_FINAL_NORM, N_IN };

constexpr size_t MiB = 1u << 20;
constexpr size_t WS_CTL = 0, CTL_ZERO_BYTES = 1 * MiB;
constexpr size_t WS_WIN = 1 * MiB;
constexpr size_t WS_WOUT = 87 * MiB;
constexpr size_t WS_WGU = 119 * MiB;
constexpr size_t WS_WDN = 291 * MiB;
constexpr size_t WS_H = 377 * MiB;
constexpr size_t WS_R = 505 * MiB;
constexpr size_t WS_PROJ = WS_R;
constexpr size_t WS_XBC = WS_R + 344 * MiB;
constexpr size_t WS_QD = WS_R + 472 * MiB;
constexpr size_t WS_KI = WS_R + 488 * MiB;
constexpr size_t WS_DT = WS_R + 520 * MiB;
constexpr size_t WS_ACS = WS_R + 522 * MiB;
constexpr size_t WS_DEC = WS_R + 524 * MiB;
constexpr size_t WS_GDEC = WS_R + 525 * MiB;
constexpr size_t WS_ST = WS_R + 528 * MiB;
constexpr size_t WS_PV = WS_R + 656 * MiB;
constexpr size_t WS_GST = WS_R + 720 * MiB;
constexpr size_t WS_GPV = WS_R + 848 * MiB;
constexpr size_t WS_OSWA = WS_R + 912 * MiB;
constexpr size_t WS_Y = WS_R + 976 * MiB;
constexpr size_t WS_GU = WS_R;
constexpr size_t WS_ACT = WS_R + 688 * MiB;
constexpr size_t WS_END = WS_R + 1104 * MiB;
static_assert(DEPTH == 2 && (size_t)DINP * DM * 2 == 86 * MiB && (size_t)DGU * DM * 2 == 172 * MiB && (size_t)M * DINP * 2 == 344 * MiB && (size_t)M * DGU * 2 == 688 * MiB, "ws map");
constexpr int CW_BAR = 4096;

constexpr int RING_BYTES = 131072;
constexpr int MISC_OFF = RING_BYTES + 320;
constexpr int LDS_BYTES = 147456;

#define GAS __attribute__((address_space(1)))
#define LAS __attribute__((address_space(3)))
typedef unsigned short bf16;
typedef unsigned v4u __attribute__((ext_vector_type(4)));
typedef unsigned v2u __attribute__((ext_vector_type(2)));
typedef float f32x4 __attribute__((ext_vector_type(4)));
typedef GAS unsigned gu32;
#define RLX_AGENT __ATOMIC_RELAXED, __HIP_MEMORY_SCOPE_AGENT
#define LDS_WAIT() asm volatile("s_waitcnt lgkmcnt(0)" ::: "memory")
__device__ __forceinline__ unsigned f2bf(float f) { unsigned u = __builtin_bit_cast(unsigned, f); return (u + 0x7fffu + ((u >> 16) & 1u)) >> 16; }
__device__ __forceinline__ unsigned pk2(float lo, float hi) { return f2bf(lo) | (f2bf(hi) << 16); }
__device__ __forceinline__ float bflo(unsigned w) { return __uint_as_float(w << 16); }
__device__ __forceinline__ float bfhi(unsigned w) { return __uint_as_float(w & 0xffff0000u); }
__device__ __forceinline__ float bf1(bf16 h) { return __uint_as_float((unsigned)h << 16); }
__device__ __forceinline__ float silu_f(float x) { return x / (1.f + __expf(-x)); }
__device__ __forceinline__ float wave_sum(float v) {
#pragma unroll
    for (int o = 1; o < 64; o <<= 1) v += __shfl_xor(v, o);
    return v;
}
template <int CTRL> __device__ __forceinline__ float dpp_f(float v) { return __int_as_float(__builtin_amdgcn_update_dpp(0, __float_as_int(v), CTRL, 0xf, 0xf, false)); }
__device__ __forceinline__ float row16_sum(float v) { v += dpp_f<0xB1>(v); v += dpp_f<0x4E>(v); v += dpp_f<0x124>(v); v += dpp_f<0x128>(v); return v; }
__device__ __forceinline__ float pair_sum(float v) { return v + dpp_f<0xB1>(v); }
#define XB_TMO      128
#define XB_XCNT(j)  (256  + 64 * (j))
#define XB_XSUB(j)  (1280 + 64 * (j))
#define XB_XGEN(j)  (2304 + 64 * (j))
#define XB_TOP      3328
#define XB_TOPGEN   3392
#define XCD_BAR_WORDS 3456
#define XB_SPIN_CAP (1u << 18)

__device__ __forceinline__ unsigned xb_ld(unsigned* p)              { return __hip_atomic_load(p, __ATOMIC_RELAXED, __HIP_MEMORY_SCOPE_AGENT); }
__device__ __forceinline__ unsigned xb_add(unsigned* p, unsigned v) { return __hip_atomic_fetch_add(p, v, __ATOMIC_RELAXED, __HIP_MEMORY_SCOPE_AGENT); }
__device__ __forceinline__ unsigned xb_xcc_id() { return (unsigned)__builtin_amdgcn_s_getreg((3 << 11) | 20) & 0xFu; }
#define XB_SPIN(cond, bar) do { unsigned _sp = 0; while (cond) { __builtin_amdgcn_s_sleep(1); \
    if ((++_sp & 255u) == 0u) { if (xb_ld(&(bar)[XB_TMO])) break; if (_sp > XB_SPIN_CAP) { atomicAdd(&(bar)[XB_TMO], 1u); break; } } } } while (0)

struct XcdBarrier {
    unsigned* bar; unsigned x;
    volatile LAS unsigned* st;
};

__device__ __forceinline__ XcdBarrier xcd_barrier_post(unsigned* bar, volatile LAS unsigned* st) {
    XcdBarrier b; b.bar = bar; b.x = xb_xcc_id(); b.st = st;
    if (threadIdx.x == 0) (void)xb_add(&bar[XB_XCNT(b.x)], 1u);
    return b;
}
__device__ __forceinline__ void xcd_barrier_complete(unsigned* bar, unsigned x, unsigned& nloc, unsigned& nx) {
    const unsigned G = gridDim.x * gridDim.y * gridDim.z;
    unsigned sum, cnt, mine, sp = 0u;
    for (;;) {
        sum = 0u; cnt = 0u; mine = 0u;
#pragma unroll
        for (unsigned j = 0; j < 16; ++j) { const unsigned c = xb_ld(&bar[XB_XCNT(j)]); sum += c; cnt += (c > 0u) ? 1u : 0u; mine = (j == x) ? c : mine; }
        if (sum == G) break;
        __builtin_amdgcn_s_sleep(1);
        if ((++sp & 255u) == 0u) { if (xb_ld(&bar[XB_TMO])) break; if (sp > XB_SPIN_CAP) { atomicAdd(&bar[XB_TMO], 1u); break; } }
    }
    nloc = mine > 0u ? mine : 1u; nx = cnt > 0u ? cnt : 1u;
}

__device__ __forceinline__ void xcd_barrier(const XcdBarrier& b) {
    asm volatile("s_waitcnt vmcnt(0)" ::: "memory");
    __syncthreads();
    if (threadIdx.x == 0) {
        unsigned* bar = b.bar;
        __builtin_amdgcn_s_waitcnt(0);
        unsigned nloc = b.st[0], nx = b.st[1];
        if (nloc == 0u) { xcd_barrier_complete(bar, b.x, nloc, nx); b.st[0] = nloc; b.st[1] = nx; }
        const unsigned old = xb_add(&bar[XB_XSUB(b.x)], 1u);
        const unsigned gen = old / nloc;
        if (old + 1u == (gen + 1u) * nloc) {
            __builtin_amdgcn_fence(__ATOMIC_RELEASE, "agent");
            asm volatile("s_waitcnt vmcnt(0)" ::: "memory");
            const unsigned og = xb_add(&bar[XB_TOP], 1u);
            const unsigned tg = og / nx;
            if (og + 1u == (tg + 1u) * nx) xb_add(&bar[XB_TOPGEN], 1u);
            else XB_SPIN(xb_ld(&bar[XB_TOPGEN]) == tg, bar);
            __builtin_amdgcn_fence(__ATOMIC_ACQUIRE, "agent");
            xb_add(&bar[XB_XGEN(b.x)], 1u);
            asm volatile("s_waitcnt vmcnt(0)" ::: "memory");
        } else {
            XB_SPIN(xb_ld(&bar[XB_XGEN(b.x)]) == gen, bar);
            __builtin_amdgcn_fence(__ATOMIC_ACQUIRE, "agent");
            asm volatile("s_waitcnt vmcnt(0)" ::: "memory");
        }
    }
    __syncthreads();
}

struct Args { const float* in[N_IN]; float* out; unsigned char* ws; int ph_lo, ph_hi, li, pad; };
struct Ctx {
    LAS unsigned char* lds;
    int tid, lane, wave, G, bid;
    const float* const* in; float* out; unsigned char* ws;
};
__device__ const unsigned char T5_BUCKET[128] = {0, 1, 2, 3, 4, 5, 6, 7, 8, 9, 10, 11, 12, 13, 14, 15, 16, 16, 16, 17, 17, 18, 18, 18, 19, 19, 19, 20, 20, 20, 20, 21, 21, 21, 21, 22, 22, 22, 22, 22, 23, 23, 23, 23, 23, 23, 24, 24, 24, 24, 24, 24, 25, 25, 25, 25, 25, 25, 25, 26, 26, 26, 26, 26, 26, 26, 26, 27, 27, 27, 27, 27, 27, 27, 27, 27, 27, 28, 28, 28, 28, 28, 28, 28, 28, 28, 28, 29, 29, 29, 29, 29, 29, 29, 29, 29, 29, 29, 29, 30, 30, 30, 30, 30, 30, 30, 30, 30, 30, 30, 30, 30, 30, 31, 31, 31, 31, 31, 31, 31, 31, 31, 31, 31, 31, 31, 31, 31};

__device__ __forceinline__ void transpose_item(const float* W, int K, int N, bf16* WT, int row_off, LAS float* scr, int kb, int nb, int lane) {
    const int k0 = 64 * kb, n0 = 32 * nb; const int nn = n0 + (lane & 31); const bool nv = nn < N;
#pragma unroll 8
    for (int i = 0; i < 32; ++i) { const int kk = 2 * i + (lane >> 5); scr[kk * 33 + (lane & 31)] = nv ? W[(size_t)(k0 + kk) * N + nn] : 0.f; }
    LDS_WAIT(); asm volatile("" ::: "memory");
    const int c = lane & 7;
#pragma unroll
    for (int j = 0; j < 4; ++j) { const int n = (lane >> 3) + 8 * j; const LAS float* s = scr + (8 * c) * 33 + n;
        v4u o; o.x = pk2(s[0 * 33], s[1 * 33]); o.y = pk2(s[2 * 33], s[3 * 33]); o.z = pk2(s[4 * 33], s[5 * 33]); o.w = pk2(s[6 * 33], s[7 * 33]);
        *(GAS v4u*)(WT + (size_t)(row_off + n0 + n) * K + k0 + 8 * c) = o; }
    LDS_WAIT(); asm volatile("" ::: "memory");
}
__device__ __forceinline__ void convert_weights(Ctx& C, int l) {
    LAS float* scr = (LAS float*)(C.lds + C.wave * 16384);
    const int gw = C.bid * NWAVES + C.wave, NGW = C.G * NWAVES;
    constexpr int I_IN = 64 * 344, I_OUT = 64 * 128, I_G = 64 * 344, I_D = 172 * 128;
    constexpr int NITEMS = I_IN + I_OUT + 2 * I_G + I_D;
    const float* w_in = C.in[I_W_IN] + (size_t)l * DM * DIN; const float* w_out = C.in[I_W_OUT] + (size_t)l * DM * DM;
    const float* w_gate = C.in[I_W_GATE] + (size_t)l * DM * DFF; const float* w_up = C.in[I_W_UP] + (size_t)l * DM * DFF; const float* w_dn = C.in[I_W_DOWN] + (size_t)l * DFF * DM;
    bf16* WIN = (bf16*)(C.ws + WS_WIN); bf16* WOUT = (bf16*)(C.ws + WS_WOUT); bf16* WGU = (bf16*)(C.ws + WS_WGU); bf16* WDN = (bf16*)(C.ws + WS_WDN);
    for (int it = gw; it < NITEMS; it += NGW) {
        int r = it;
        if (r < I_IN) { transpose_item(w_in, DM, DIN, WIN, 0, scr, r / 344, r % 344, C.lane); continue; } r -= I_IN;
        if (r < I_OUT) { transpose_item(w_out, DM, DM, WOUT, 0, scr, r / 128, r % 128, C.lane); continue; } r -= I_OUT;
        if (r < I_G) { transpose_item(w_gate, DM, DFF, WGU, 0, scr, r / 344, r % 344, C.lane); continue; } r -= I_G;
        if (r < I_G) { transpose_item(w_up, DM, DFF, WGU, DFF, scr, r / 344, r % 344, C.lane); continue; } r -= I_G;
        transpose_item(w_dn, DFF, DM, WDN, 0, scr, r / 128, r % 128, C.lane);
    }
}
__device__ __forceinline__ void rmsnorm_row_bf16(const float* xrow, const float* w, bf16* orow, int lane) {
    const GAS f32x4* xr = (const GAS f32x4*)xrow + lane; const GAS f32x4* wr = (const GAS f32x4*)w + lane;
    f32x4 v[16]; float ss = 0.f;
#pragma unroll
    for (int j = 0; j < 16; ++j) { v[j] = xr[64 * j]; ss += (v[j].x * v[j].x + v[j].y * v[j].y) + (v[j].z * v[j].z + v[j].w * v[j].w); }
    const float rstd = 1.f / sqrtf(wave_sum(ss) * (1.f / DM) + EPS);
    GAS v2u* o8 = (GAS v2u*)orow + lane;
#pragma unroll
    for (int j = 0; j < 16; ++j) { const f32x4 g = wr[64 * j]; v2u o; o.x = pk2(v[j].x * rstd * g.x, v[j].y * rstd * g.y); o.y = pk2(v[j].z * rstd * g.z, v[j].w * rstd * g.w); o8[64 * j] = o; }
}
__device__ __forceinline__ void rmsnorm_phase(Ctx& C, const float* X, const float* w, bf16* H) {
    const int gw = C.bid * NWAVES + C.wave, NGW = C.G * NWAVES;
    for (int m = gw; m < M; m += NGW) rmsnorm_row_bf16(X + (size_t)m * DM, w, H + (size_t)m * DM, C.lane);
}
__device__ __forceinline__ void final_norm_phase(Ctx& C, float* X, const float* w) {
    const int gw = C.bid * NWAVES + C.wave, NGW = C.G * NWAVES;
    for (int m = gw; m < M; m += NGW) {
        GAS f32x4* xr = (GAS f32x4*)(X + (size_t)m * DM) + C.lane; const GAS f32x4* wr = (const GAS f32x4*)w + C.lane;
        f32x4 v[16]; float ss = 0.f;
#pragma unroll
        for (int j = 0; j < 16; ++j) { v[j] = xr[64 * j]; ss += (v[j].x * v[j].x + v[j].y * v[j].y) + (v[j].z * v[j].z + v[j].w * v[j].w); }
        const float rstd = 1.f / sqrtf(wave_sum(ss) * (1.f / DM) + EPS);
#pragma unroll
        for (int j = 0; j < 16; ++j) { const f32x4 g = wr[64 * j]; xr[64 * j] = v[j] * rstd * g; }
    }
}

typedef short bf16x8 __attribute__((ext_vector_type(8)));
typedef short s16x4 __attribute__((ext_vector_type(4)));
__device__ __forceinline__ f32x4 mfma16(bf16x8 a, bf16x8 b, f32x4 c) { return __builtin_amdgcn_mfma_f32_16x16x32_bf16(a, b, c, 0, 0, 0); }
__device__ __forceinline__ bf16x8 pack8(f32x4 lo, f32x4 hi) { v4u w; w.x = pg8::cvt_pk_bf16(lo.x, lo.y); w.y = pg8::cvt_pk_bf16(lo.z, lo.w); w.z = pg8::cvt_pk_bf16(hi.x, hi.y); w.w = pg8::cvt_pk_bf16(hi.z, hi.w); return __builtin_bit_cast(bf16x8, w); }
__device__ __forceinline__ bf16x8 gfrag(const bf16* Mx, size_t ld, int row0, int k0, int lane) { return *(const GAS bf16x8*)(Mx + (size_t)(row0 + (lane & 15)) * ld + k0 + 8 * (lane >> 4)); }
__device__ __forceinline__ bf16x8 trfrag(const LAS unsigned char* img, int stride, int r0, int r1, int col0, int lane) {
    const int q = (lane & 15) >> 2, p = lane & 3;
    const s16x4 a = __builtin_amdgcn_ds_read_tr16_b64_v4i16((LAS s16x4*)(img + (r0 + q) * stride + (col0 + 4 * p) * 2));
    const s16x4 b = __builtin_amdgcn_ds_read_tr16_b64_v4i16((LAS s16x4*)(img + (r1 + q) * stride + (col0 + 4 * p) * 2));
    return __builtin_shufflevector(a, b, 0, 1, 2, 3, 4, 5, 6, 7);
}
__device__ __forceinline__ float xsum4(float v) { v += __shfl_xor(v, 16); v += __shfl_xor(v, 32); return v; }
__device__ __forceinline__ float xmax4(float v) { v = fmaxf(v, __shfl_xor(v, 16)); v = fmaxf(v, __shfl_xor(v, 32)); return v; }

constexpr int SWA_VSTRIDE = 144;
constexpr int SWA_V_BYTES = 192 * SWA_VSTRIDE;
__device__ __forceinline__ void swa_unit_mfma(Ctx& C, int l, int unit) {
    const int b = unit >> 7, qb = unit & 127, q0 = qb * 64;
    const int tid = C.tid, lane = C.lane, w = C.wave, c = lane & 15, hq = lane >> 4;
    LAS unsigned char* Vimg = C.lds;
    LAS float* tb = (LAS float*)(C.lds + 30720);
    LAS float* ssqx = (LAS float*)(C.lds + 30720 + 12288);
    const bf16* PROJ = (const bf16*)(C.ws + WS_PROJ); float* OSWA = (float*)(C.ws + WS_OSWA); bf16* Y = (bf16*)(C.ws + WS_Y);
    const bf16* Pb = PROJ + (size_t)b * SEQ * DINP;
    __syncthreads();
    for (int i = tid; i < 16 * 192; i += NTHR) { const int hd = i / 192, x = i % 192, dist = x - 32; tb[i] = (dist >= 0 && dist < 128) ? C.in[I_REL_BIAS][T5_BUCKET[dist] * SWA_H + hd] : 0.f; }
    if (tid < 16 * 9) *(LAS v4u*)(Vimg + (192 + tid / 9) * SWA_VSTRIDE + 16 * (tid % 9)) = (v4u){0u, 0u, 0u, 0u};
    const int g = w >> 1, qhalf = w & 1;
    float ssq0 = 0.f, ssq1 = 0.f;
    for (int kvh = 0; kvh < 4; ++kvh) {
        const int head = kvh * 4 + g;
        __syncthreads();
#pragma unroll
        for (int it = 0; it < 3; ++it) { const int idx = tid + NTHR * it, j = idx >> 3, cg = idx & 7; int s = q0 - 128 + j; s = s < 0 ? 0 : s;
            const v4u v = *(const GAS v4u*)(Pb + (size_t)s * DINP + C_SV + kvh * 64 + 8 * cg); *(LAS v4u*)(Vimg + j * SWA_VSTRIDE + 16 * cg) = v; }
        __syncthreads();
        const float sink = C.in[I_SWA_SINKS][l * SWA_H + head];
#pragma nounroll
        for (int qt = 0; qt < 2; ++qt) {
            const int j0 = 32 * qhalf + 16 * qt;
            const bf16x8 qf0 = gfrag(Pb + C_SQ + head * 64, DINP, q0 + j0, 0, lane), qf1 = gfrag(Pb + C_SQ + head * 64, DINP, q0 + j0, 32, lane);
            f32x4 sacc[10];
#pragma unroll
            for (int kt = 0; kt < 10; ++kt) {
                int srow = q0 - 128 + j0 + 16 * kt + c; srow = srow < 0 ? 0 : srow; srow = srow > q0 + 63 ? q0 + 63 : srow;
                const bf16* kp = Pb + (size_t)srow * DINP + C_SK + kvh * 64 + 8 * hq;
                const bf16x8 k0 = *(const GAS bf16x8*)kp, k1 = *(const GAS bf16x8*)(kp + 32);
                f32x4 a = (f32x4){0.f, 0.f, 0.f, 0.f}; a = mfma16(k0, qf0, a); a = mfma16(k1, qf1, a); sacc[kt] = a;
            }
            float mx = sink;
#pragma unroll
            for (int kt = 0; kt < 10; ++kt)
#pragma unroll
                for (int r = 0; r < 4; ++r) { const int dist = c + 128 - 16 * kt - 4 * hq - r; const int s = q0 - 128 + j0 + 16 * kt + 4 * hq + r;
                    const bool valid = (dist >= 0) && (dist < 128) && (s >= 0);
                    const float sc = valid ? sacc[kt][r] * 0.125f + tb[head * 192 + dist + 32] : -1e30f;
                    sacc[kt][r] = sc; mx = fmaxf(mx, sc); }
            mx = xmax4(mx); float sum = 0.f;
#pragma unroll
            for (int kt = 0; kt < 10; ++kt)
#pragma unroll
                for (int r = 0; r < 4; ++r) { const float p = __expf(sacc[kt][r] - mx); sacc[kt][r] = p; sum += p; }
            sum = xsum4(sum); const float inv = 1.f / (sum + __expf(sink - mx));
            f32x4 oacc[4];
#pragma unroll
            for (int dt = 0; dt < 4; ++dt) oacc[dt] = (f32x4){0.f, 0.f, 0.f, 0.f};
#pragma unroll
            for (int ks = 0; ks < 5; ++ks) { const bf16x8 pf = pack8(sacc[2 * ks], sacc[2 * ks + 1]);
#pragma unroll
                for (int dt = 0; dt < 4; ++dt) oacc[dt] = mfma16(trfrag(Vimg, SWA_VSTRIDE, j0 + 32 * ks + 4 * hq, j0 + 32 * ks + 16 + 4 * hq, 16 * dt, lane), pf, oacc[dt]); }
            float sq = 0.f; float* op = OSWA + (size_t)(b * SEQ + q0 + j0 + c) * SWA_W + head * 64 + 4 * hq;
#pragma unroll
            for (int dt = 0; dt < 4; ++dt) { const f32x4 o = oacc[dt] * inv; sq += (o.x * o.x + o.y * o.y) + (o.z * o.z + o.w * o.w); *(GAS f32x4*)(op + 16 * dt) = o; }
            if (qt == 0) ssq0 += sq; else ssq1 += sq;
        }
    }
    ssq0 = xsum4(ssq0); ssq1 = xsum4(ssq1);
    if (hq == 0) { ssqx[w * 32 + c] = ssq0; ssqx[w * 32 + 16 + c] = ssq1; }
    asm volatile("s_waitcnt vmcnt(0)" ::: "memory");
    __syncthreads();
    const float* swa_norm = C.in[I_SWA_NORM] + (size_t)l * SWA_W;
#pragma nounroll
    for (int qt = 0; qt < 2; ++qt) { const int qi = 16 * qt + c;
        const float tot = ssqx[(qhalf + 0) * 32 + qi] + ssqx[(qhalf + 2) * 32 + qi] + ssqx[(qhalf + 4) * 32 + qi] + ssqx[(qhalf + 6) * 32 + qi];
        const float rstd = 1.f / sqrtf(tot * (1.f / 1024.f) + EPS);
        const size_t row = (size_t)(b * SEQ + q0 + 32 * qhalf + qi);
#pragma unroll
        for (int kvh = 0; kvh < 4; ++kvh)
#pragma unroll
            for (int dt = 0; dt < 4; ++dt) { const int col = (kvh * 4 + g) * 64 + 16 * dt + 4 * hq; const f32x4 o = *(const GAS f32x4*)(OSWA + row * SWA_W + col); const f32x4 gn = *(const GAS f32x4*)(swa_norm + col);
                v2u ow; ow.x = pk2(o.x * rstd * gn.x, o.y * rstd * gn.y); ow.y = pk2(o.z * rstd * gn.z, o.w * rstd * gn.w); *(GAS v2u*)(Y + row * DM + 2048 + col) = ow; } }
}

constexpr int N_SWA_UNITS = BATCH * (SEQ / 64);

constexpr int SSD_L = 128, SSD_NC = SEQ / SSD_L, GLA_L = 64, GLA_NC = SEQ / GLA_L;
constexpr int N_SSD_CU = BATCH * SSD_NC * 8, N_GLA_CU = BATCH * GLA_NC * 4;
constexpr int XI_STRIDE = 528, BI_STRIDE = 272;

__device__ __forceinline__ void prep_phase(Ctx& C, int l) {
    const bf16* PROJ = (const bf16*)(C.ws + WS_PROJ); bf16* XBC = (bf16*)(C.ws + WS_XBC);
    const int tid = C.tid, lane = C.lane;
    { const int gw = C.bid * NWAVES + C.wave;
      if ((gw & 15) == 0 && (gw >> 4) < BATCH * SSD_NC && lane < SSD_H) {
          const int bc = gw >> 4; const size_t row0 = (size_t)bc * SSD_L;
          float* DT = (float*)(C.ws + WS_DT); float* ACS = (float*)(C.ws + WS_ACS); float* DEC = (float*)(C.ws + WS_DEC);
          const float dtb = C.in[I_SSD_DT_BIAS][l * SSD_H + lane], Ah = -expf(C.in[I_SSD_A_LOG][l * SSD_H + lane]);
          float cs = 0.f;
#pragma unroll 8
          for (int s = 0; s < SSD_L; ++s) { const float xr = bf1(PROJ[(row0 + s) * DINP + C_DT + lane]) + dtb; const float dt = xr > 20.f ? xr : log1pf(expf(xr)); cs += dt * Ah;
              DT[(row0 + s) * SSD_H + lane] = dt; ACS[(row0 + s) * SSD_H + lane] = cs; }
          DEC[bc * SSD_H + lane] = expf(cs);
      } }
    { const float* conv_w = C.in[I_SSD_CONV_W] + (size_t)l * 4 * SSD_CD; const float* conv_b = C.in[I_SSD_CONV_B] + (size_t)l * SSD_CD;
      constexpr int NIT = (M / 16) * 512;
      for (int it = C.bid * NTHR + tid; it < NIT; it += C.G * NTHR) {
          const int cg = it & 511, rb = it >> 9, c0 = 8 * cg, t0 = 16 * rb;
          float wv[4][8], bb[8];
#pragma unroll
          for (int i = 0; i < 4; ++i) { const f32x4 a = *(const GAS f32x4*)(conv_w + i * SSD_CD + c0), b2 = *(const GAS f32x4*)(conv_w + i * SSD_CD + c0 + 4);
              wv[i][0] = a.x; wv[i][1] = a.y; wv[i][2] = a.z; wv[i][3] = a.w; wv[i][4] = b2.x; wv[i][5] = b2.y; wv[i][6] = b2.z; wv[i][7] = b2.w; }
          { const f32x4 a = *(const GAS f32x4*)(conv_b + c0), b2 = *(const GAS f32x4*)(conv_b + c0 + 4); bb[0] = a.x; bb[1] = a.y; bb[2] = a.z; bb[3] = a.w; bb[4] = b2.x; bb[5] = b2.y; bb[6] = b2.z; bb[7] = b2.w; }
          float x0[8], x1[8], x2[8];
          const bool first = (t0 % SEQ) == 0;
          { v4u r0 = (v4u){0u, 0u, 0u, 0u}, r1 = r0, r2 = r0;
            if (!first) { r0 = *(const GAS v4u*)(PROJ + (size_t)(t0 - 3) * DINP + C_XBC + c0); r1 = *(const GAS v4u*)(PROJ + (size_t)(t0 - 2) * DINP + C_XBC + c0); r2 = *(const GAS v4u*)(PROJ + (size_t)(t0 - 1) * DINP + C_XBC + c0); }
            x0[0] = bflo(r0.x); x0[1] = bfhi(r0.x); x0[2] = bflo(r0.y); x0[3] = bfhi(r0.y); x0[4] = bflo(r0.z); x0[5] = bfhi(r0.z); x0[6] = bflo(r0.w); x0[7] = bfhi(r0.w);
            x1[0] = bflo(r1.x); x1[1] = bfhi(r1.x); x1[2] = bflo(r1.y); x1[3] = bfhi(r1.y); x1[4] = bflo(r1.z); x1[5] = bfhi(r1.z); x1[6] = bflo(r1.w); x1[7] = bfhi(r1.w);
            x2[0] = bflo(r2.x); x2[1] = bfhi(r2.x); x2[2] = bflo(r2.y); x2[3] = bfhi(r2.y); x2[4] = bflo(r2.z); x2[5] = bfhi(r2.z); x2[6] = bflo(r2.w); x2[7] = bfhi(r2.w); }
#pragma unroll 4
          for (int r = 0; r < 16; ++r) {
              const v4u rw = *(const GAS v4u*)(PROJ + (size_t)(t0 + r) * DINP + C_XBC + c0);
              float x3[8], o[8];
              x3[0] = bflo(rw.x); x3[1] = bfhi(rw.x); x3[2] = bflo(rw.y); x3[3] = bfhi(rw.y); x3[4] = bflo(rw.z); x3[5] = bfhi(rw.z); x3[6] = bflo(rw.w); x3[7] = bfhi(rw.w);
#pragma unroll
              for (int e = 0; e < 8; ++e) { const float a = bb[e] + wv[0][e] * x0[e] + wv[1][e] * x1[e] + wv[2][e] * x2[e] + wv[3][e] * x3[e]; o[e] = silu_f(a); x0[e] = x1[e]; x1[e] = x2[e]; x2[e] = x3[e]; }
              v4u ow; ow.x = pk2(o[0], o[1]); ow.y = pk2(o[2], o[3]); ow.z = pk2(o[4], o[5]); ow.w = pk2(o[6], o[7]);
              *(GAS v4u*)(XBC + (size_t)(t0 + r) * SSD_CD + c0) = ow;
          }
      } }
    { LAS float* glr = (LAS float*)C.lds;
      bf16* QD = (bf16*)(C.ws + WS_QD); bf16* KI = (bf16*)(C.ws + WS_KI); float* GDEC = (float*)(C.ws + WS_GDEC);
      const float* w_gate = C.in[I_GLA_W_GATE] + (size_t)l * 16 * GLA_KT; const float bgv = C.in[I_GLA_B_GATE][l * GLA_KT + tid];
      float wg[16];
#pragma unroll
      for (int r = 0; r < 16; ++r) wg[r] = w_gate[r * GLA_KT + tid];
      for (int ck = C.bid; ck < BATCH * GLA_NC; ck += C.G) {
          const size_t row0 = (size_t)ck * GLA_L;
          __syncthreads();
          if (tid < 128) { const int t = tid >> 1, hf = tid & 1; const v4u r = *(const GAS v4u*)(PROJ + (row0 + t) * DINP + C_GLR + 8 * hf);
              *(LAS f32x4*)(glr + t * 16 + 8 * hf) = (f32x4){bflo(r.x), bfhi(r.x), bflo(r.y), bfhi(r.y)}; *(LAS f32x4*)(glr + t * 16 + 8 * hf + 4) = (f32x4){bflo(r.z), bfhi(r.z), bflo(r.w), bfhi(r.w)}; }
          __syncthreads();
          float cum = 0.f;
#pragma unroll 8
          for (int t = 0; t < GLA_L; ++t) {
              const float qv = bf1(PROJ[(row0 + t) * DINP + C_GQ + tid]), kv = bf1(PROJ[(row0 + t) * DINP + C_GK + tid]);
              float z = bgv;
#pragma unroll
              for (int r4 = 0; r4 < 4; ++r4) { const f32x4 gv = *(const LAS f32x4*)(glr + t * 16 + 4 * r4); z += gv.x * wg[4 * r4] + gv.y * wg[4 * r4 + 1] + gv.z * wg[4 * r4 + 2] + gv.w * wg[4 * r4 + 3]; }
              const float ls = fminf(z, 0.f) - log1pf(expf(-fabsf(z))); cum += ls * 0.0625f;
              const float e = expf(cum);
              QD[(row0 + t) * GLA_KT + tid] = (bf16)f2bf(qv * 0.08838834764831845f * e); KI[(row0 + t) * GLA_KT + tid] = (bf16)f2bf(kv / e);
          }
          GDEC[(size_t)ck * GLA_KT + tid] = expf(cum);
      } }
}

__device__ __forceinline__ void gla_c1_unit(Ctx& C, int unit) {
    const int h = unit & 3, ck = unit >> 2; const size_t row0 = (size_t)ck * GLA_L;
    const int tid = C.tid, lane = C.lane, w = C.wave, c = lane & 15, hq = lane >> 4;
    LAS unsigned char* KEimg = C.lds; LAS unsigned char* Vimg = C.lds + 64 * BI_STRIDE;
    const bf16* PROJ = (const bf16*)(C.ws + WS_PROJ); const bf16* KI = (const bf16*)(C.ws + WS_KI); const float* GDEC = (const float*)(C.ws + WS_GDEC); float* GST = (float*)(C.ws + WS_GST);
    __syncthreads();
    { const int cg = tid & 15; const f32x4 d0 = *(const GAS f32x4*)(GDEC + (size_t)ck * GLA_KT + h * 128 + 8 * cg), d1 = *(const GAS f32x4*)(GDEC + (size_t)ck * GLA_KT + h * 128 + 8 * cg + 4);
#pragma unroll
      for (int it = 0; it < 2; ++it) { const int t = (tid + NTHR * it) >> 4; const v4u r = *(const GAS v4u*)(KI + (row0 + t) * GLA_KT + h * 128 + 8 * cg);
          v4u o; o.x = pk2(bflo(r.x) * d0.x, bfhi(r.x) * d0.y); o.y = pk2(bflo(r.y) * d0.z, bfhi(r.y) * d0.w); o.z = pk2(bflo(r.z) * d1.x, bfhi(r.z) * d1.y); o.w = pk2(bflo(r.w) * d1.z, bfhi(r.w) * d1.w);
          *(LAS v4u*)(KEimg + t * BI_STRIDE + 16 * cg) = o; } }
#pragma unroll
    for (int it = 0; it < 4; ++it) { const int idx = tid + NTHR * it, t = idx >> 5, cg = idx & 31; *(LAS v4u*)(Vimg + t * XI_STRIDE + 16 * cg) = *(const GAS v4u*)(PROJ + (row0 + t) * DINP + C_GV + h * 256 + 8 * cg); }
    __syncthreads();
    f32x4 acc[16];
#pragma unroll
    for (int nt = 0; nt < 16; ++nt) acc[nt] = (f32x4){0.f, 0.f, 0.f, 0.f};
#pragma unroll
    for (int ks = 0; ks < 2; ++ks) { const bf16x8 af = trfrag(KEimg, BI_STRIDE, 32 * ks + 8 * hq, 32 * ks + 8 * hq + 4, 16 * w, lane);
#pragma unroll
        for (int nt = 0; nt < 16; ++nt) acc[nt] = mfma16(af, trfrag(Vimg, XI_STRIDE, 32 * ks + 8 * hq, 32 * ks + 8 * hq + 4, 16 * nt, lane), acc[nt]); }
    float* gp = GST + (size_t)unit * 32768 + 16 * w + 4 * hq;
#pragma unroll
    for (int nt = 0; nt < 16; ++nt) *(GAS f32x4*)(gp + (size_t)(16 * nt + c) * 128) = acc[nt];
}

__device__ __forceinline__ void scan_phase(Ctx& C) {
    const float* GST = (const float*)(C.ws + WS_GST); bf16* GPV = (bf16*)(C.ws + WS_GPV); const float* GDEC = (const float*)(C.ws + WS_GDEC);
    const float* ST = (const float*)(C.ws + WS_ST); bf16* PV = (bf16*)(C.ws + WS_PV); const float* DEC = (const float*)(C.ws + WS_DEC);
    constexpr int N_G = BATCH * 4 * 256 * 32, N_S = BATCH * SSD_H * 64 * 32;
    for (int it = C.bid * NTHR + C.tid; it < N_G + N_S; it += C.G * NTHR) {
        if (it < N_S) {
            const int n4 = it & 31, p = (it >> 5) & 63, h = (it >> 11) & 31, b = it >> 16;
            f32x4 run = (f32x4){0.f, 0.f, 0.f, 0.f};
#pragma unroll 8
            for (int c = 0; c < SSD_NC; ++c) { const size_t u = (size_t)(b * SSD_NC + c) * SSD_H + h; const size_t off = u * 8192 + p * 128 + 4 * n4;
                const f32x4 x = *(const GAS f32x4*)(ST + off); const float d = DEC[u];
                v2u o; o.x = pk2(run.x, run.y); o.y = pk2(run.z, run.w); *(GAS v2u*)(PV + off) = o;
                run = run * d + x; }
        } else {
            const int i2 = it - N_S; const int k4 = i2 & 31, v = (i2 >> 5) & 255, h = (i2 >> 13) & 3, b = i2 >> 15;
            f32x4 run = (f32x4){0.f, 0.f, 0.f, 0.f};
#pragma unroll 8
            for (int c = 0; c < GLA_NC; ++c) { const size_t ck = (size_t)(b * GLA_NC + c); const size_t off = (ck * 4 + h) * 32768 + v * 128 + 4 * k4;
                const f32x4 x = *(const GAS f32x4*)(GST + off); const f32x4 d = *(const GAS f32x4*)(GDEC + ck * GLA_KT + h * 128 + 4 * k4);
                v2u o; o.x = pk2(run.x, run.y); o.y = pk2(run.z, run.w); *(GAS v2u*)(GPV + off) = o;
                run = run * d + x; }
        }
    }
}

__device__ __forceinline__ void gla_c3_unit(Ctx& C, int l, int unit) {
    const int h = unit & 3, ck = unit >> 2; const size_t row0 = (size_t)ck * GLA_L;
    const int tid = C.tid, lane = C.lane, w = C.wave, c = lane & 15, hq = lane >> 4;
    LAS unsigned char* Vimg = C.lds; LAS float* xch = (LAS float*)(C.lds + 64 * XI_STRIDE);
    const bf16* PROJ = (const bf16*)(C.ws + WS_PROJ); const bf16* QD = (const bf16*)(C.ws + WS_QD); const bf16* KI = (const bf16*)(C.ws + WS_KI); const bf16* GPV = (const bf16*)(C.ws + WS_GPV); bf16* Y = (bf16*)(C.ws + WS_Y);
    __syncthreads();
#pragma unroll
    for (int it = 0; it < 4; ++it) { const int idx = tid + NTHR * it, t = idx >> 5, cg = idx & 31; *(LAS v4u*)(Vimg + t * XI_STRIDE + 16 * cg) = *(const GAS v4u*)(PROJ + (row0 + t) * DINP + C_GV + h * 256 + 8 * cg); }
    const int lt = w >> 1, vh = w & 1;
    bf16x8 qf[4];
#pragma unroll
    for (int ks = 0; ks < 4; ++ks) qf[ks] = gfrag(QD + row0 * GLA_KT + h * 128, GLA_KT, 16 * lt, 32 * ks, lane);
    f32x4 att[4];
#pragma unroll
    for (int st = 0; st < 4; ++st) { f32x4 a = (f32x4){0.f, 0.f, 0.f, 0.f};
        if (st <= lt) {
#pragma unroll
            for (int ks = 0; ks < 4; ++ks) a = mfma16(gfrag(KI + row0 * GLA_KT + h * 128, GLA_KT, 16 * st, 32 * ks, lane), qf[ks], a);
#pragma unroll
            for (int r = 0; r < 4; ++r) if (16 * st + 4 * hq + r > 16 * lt + c) a[r] = 0.f;
        }
        att[st] = a; }
    __syncthreads();
    f32x4 oacc[8];
#pragma unroll
    for (int vt = 0; vt < 8; ++vt) oacc[vt] = (f32x4){0.f, 0.f, 0.f, 0.f};
    const bf16* gpv = GPV + (size_t)unit * 32768;
#pragma unroll
    for (int ks = 0; ks < 4; ++ks)
#pragma unroll
        for (int vt = 0; vt < 8; ++vt) oacc[vt] = mfma16(gfrag(gpv, 128, 16 * (8 * vh + vt), 32 * ks, lane), qf[ks], oacc[vt]);
#pragma unroll
    for (int ks2 = 0; ks2 < 2; ++ks2) { const bf16x8 pf = pack8(att[2 * ks2], att[2 * ks2 + 1]);
#pragma unroll
        for (int vt = 0; vt < 8; ++vt) oacc[vt] = mfma16(trfrag(Vimg, XI_STRIDE, 32 * ks2 + 4 * hq, 32 * ks2 + 16 + 4 * hq, 16 * (8 * vh + vt), lane), pf, oacc[vt]); }
    float ssq = 0.f;
#pragma unroll
    for (int vt = 0; vt < 8; ++vt) ssq += (oacc[vt].x * oacc[vt].x + oacc[vt].y * oacc[vt].y) + (oacc[vt].z * oacc[vt].z + oacc[vt].w * oacc[vt].w);
    ssq = xsum4(ssq);
    if (hq == 0) xch[w * 16 + c] = ssq;
    __syncthreads();
    const float rstd = 1.f / sqrtf((xch[w * 16 + c] + xch[(w ^ 1) * 16 + c]) * (1.f / 256.f) + EPS);
    const float* gla_norm = C.in[I_GLA_NORM] + (size_t)l * 256;
    const size_t row = row0 + 16 * lt + c;
#pragma unroll
    for (int vt = 0; vt < 8; ++vt) { const int v0 = 16 * (8 * vh + vt) + 4 * hq; const f32x4 gn = *(const GAS f32x4*)(gla_norm + v0); const v2u gg = *(const GAS v2u*)(PROJ + row * DINP + C_GG + h * 256 + v0);
        const f32x4 o = oacc[vt]; v2u ow; ow.x = pk2(o.x * rstd * gn.x * silu_f(bflo(gg.x)), o.y * rstd * gn.y * silu_f(bfhi(gg.x))); ow.y = pk2(o.z * rstd * gn.z * silu_f(bflo(gg.y)), o.w * rstd * gn.w * silu_f(bfhi(gg.y)));
        *(GAS v2u*)(Y + row * DM + 3072 + h * 256 + v0) = ow; }
}

__device__ __forceinline__ void ssd_c1_unit(Ctx& C, int unit) {
    const int g = unit & 7, bc = unit >> 3; const size_t row0 = (size_t)bc * SSD_L;
    const int tid = C.tid, lane = C.lane, w = C.wave, c = lane & 15, hq = lane >> 4;
    LAS float* acs = (LAS float*)C.lds; LAS float* dts = acs + 512;
    LAS unsigned char* XWimg = C.lds + 4096; LAS unsigned char* Bimg = C.lds + 4096 + 128 * XI_STRIDE;
    const bf16* XBC = (const bf16*)(C.ws + WS_XBC); const float* DT = (const float*)(C.ws + WS_DT); const float* ACS = (const float*)(C.ws + WS_ACS); float* ST = (float*)(C.ws + WS_ST);
    __syncthreads();
    { const int t = tid >> 2, hh = tid & 3; acs[tid] = ACS[(row0 + t) * SSD_H + 4 * g + hh]; dts[tid] = DT[(row0 + t) * SSD_H + 4 * g + hh]; }
    __syncthreads();
#pragma unroll
    for (int it = 0; it < 8; ++it) { const int idx = tid + NTHR * it, t = idx >> 5, cg = idx & 31, hh = cg >> 3; const float wgt = __expf(acs[127 * 4 + hh] - acs[t * 4 + hh]) * dts[t * 4 + hh];
        const v4u r = *(const GAS v4u*)(XBC + (row0 + t) * SSD_CD + g * 256 + 8 * cg);
        v4u o; o.x = pk2(bflo(r.x) * wgt, bfhi(r.x) * wgt); o.y = pk2(bflo(r.y) * wgt, bfhi(r.y) * wgt); o.z = pk2(bflo(r.z) * wgt, bfhi(r.z) * wgt); o.w = pk2(bflo(r.w) * wgt, bfhi(r.w) * wgt);
        *(LAS v4u*)(XWimg + t * XI_STRIDE + 16 * cg) = o; }
#pragma unroll
    for (int it = 0; it < 4; ++it) { const int idx = tid + NTHR * it, t = idx >> 4, cg = idx & 15; *(LAS v4u*)(Bimg + t * BI_STRIDE + 16 * cg) = *(const GAS v4u*)(XBC + (row0 + t) * SSD_CD + 2048 + g * 128 + 8 * cg); }
    __syncthreads();
    const int hh = w >> 1, ph = w & 1;
    f32x4 acc[8][2];
#pragma unroll
    for (int mt = 0; mt < 8; ++mt) { acc[mt][0] = (f32x4){0.f, 0.f, 0.f, 0.f}; acc[mt][1] = (f32x4){0.f, 0.f, 0.f, 0.f}; }
#pragma unroll
    for (int ks = 0; ks < 4; ++ks) { const int r0 = 32 * ks + 8 * hq;
        const bf16x8 x0 = trfrag(XWimg, XI_STRIDE, r0, r0 + 4, hh * 64 + 32 * ph, lane), x1 = trfrag(XWimg, XI_STRIDE, r0, r0 + 4, hh * 64 + 32 * ph + 16, lane);
#pragma unroll
        for (int mt = 0; mt < 8; ++mt) { const bf16x8 bf = trfrag(Bimg, BI_STRIDE, r0, r0 + 4, 16 * mt, lane); acc[mt][0] = mfma16(bf, x0, acc[mt][0]); acc[mt][1] = mfma16(bf, x1, acc[mt][1]); } }
    float* sp = ST + ((size_t)bc * SSD_H + 4 * g + hh) * 8192 + 4 * hq;
#pragma unroll
    for (int mt = 0; mt < 8; ++mt)
#pragma unroll
        for (int pt = 0; pt < 2; ++pt) *(GAS f32x4*)(sp + (size_t)(32 * ph + 16 * pt + c) * 128 + 16 * mt) = acc[mt][pt];
}

__device__ __forceinline__ void ssd_c3_unit(Ctx& C, int l, int unit) {
    const int g = unit & 7, bc = unit >> 3; const size_t row0 = (size_t)bc * SSD_L;
    const int tid = C.tid, lane = C.lane, w = C.wave, c = lane & 15, hq = lane >> 4;
    LAS float* acs = (LAS float*)C.lds; LAS float* dts = acs + 512;
    LAS unsigned char* Ximg = C.lds + 4096;
    const bf16* PROJ = (const bf16*)(C.ws + WS_PROJ); const bf16* XBC = (const bf16*)(C.ws + WS_XBC); const float* DT = (const float*)(C.ws + WS_DT); const float* ACS = (const float*)(C.ws + WS_ACS);
    const bf16* PV = (const bf16*)(C.ws + WS_PV); bf16* Y = (bf16*)(C.ws + WS_Y);
    __syncthreads();
    { const int t = tid >> 2, hh = tid & 3; acs[tid] = ACS[(row0 + t) * SSD_H + 4 * g + hh]; dts[tid] = DT[(row0 + t) * SSD_H + 4 * g + hh]; }
#pragma unroll
    for (int it = 0; it < 8; ++it) { const int idx = tid + NTHR * it, t = idx >> 5, cg = idx & 31; *(LAS v4u*)(Ximg + t * XI_STRIDE + 16 * cg) = *(const GAS v4u*)(XBC + (row0 + t) * SSD_CD + g * 256 + 8 * cg); }
    bf16x8 cf[4];
#pragma unroll
    for (int ks = 0; ks < 4; ++ks) cf[ks] = gfrag(XBC + row0 * SSD_CD + 3072 + g * 128, SSD_CD, 16 * w, 32 * ks, lane);
    f32x4 cb[8];
#pragma unroll
    for (int st = 0; st < 8; ++st) { f32x4 a = (f32x4){0.f, 0.f, 0.f, 0.f};
        if (st <= w) {
#pragma unroll
            for (int ks = 0; ks < 4; ++ks) a = mfma16(gfrag(XBC + row0 * SSD_CD + 2048 + g * 128, SSD_CD, 16 * st, 32 * ks, lane), cf[ks], a);
        }
        cb[st] = a; }
    __syncthreads();
    const int tl = 16 * w + c; const size_t row = row0 + tl;
    float* YT = (float*)(C.ws + WS_ST) + row * SSD_W + g * 256;
    float ssq = 0.f;
#pragma nounroll
    for (int hh = 0; hh < 4; ++hh) {
        const float acs_l = acs[tl * 4 + hh], el = __expf(acs_l);
        const bf16* pv = PV + ((size_t)bc * SSD_H + 4 * g + hh) * 8192;
        f32x4 ya[4];
#pragma unroll
        for (int pt = 0; pt < 4; ++pt) ya[pt] = (f32x4){0.f, 0.f, 0.f, 0.f};
#pragma unroll
        for (int ks = 0; ks < 4; ++ks)
#pragma unroll
            for (int pt = 0; pt < 4; ++pt) ya[pt] = mfma16(gfrag(pv, 128, 16 * pt, 32 * ks, lane), cf[ks], ya[pt]);
#pragma unroll
        for (int pt = 0; pt < 4; ++pt) ya[pt] = ya[pt] * el;
#pragma unroll
        for (int ks2 = 0; ks2 < 4; ++ks2) {
            if (2 * ks2 <= w) {
                f32x4 lm[2];
#pragma unroll
                for (int t2 = 0; t2 < 2; ++t2)
#pragma unroll
                    for (int r = 0; r < 4; ++r) { const int s = 32 * ks2 + 16 * t2 + 4 * hq + r; const float d = fminf(acs_l - acs[s * 4 + hh], 0.f);
                        lm[t2][r] = (s <= tl) ? cb[2 * ks2 + t2][r] * __expf(d) * dts[s * 4 + hh] : 0.f; }
                const bf16x8 pf = pack8(lm[0], lm[1]);
#pragma unroll
                for (int pt = 0; pt < 4; ++pt) ya[pt] = mfma16(trfrag(Ximg, XI_STRIDE, 32 * ks2 + 4 * hq, 32 * ks2 + 16 + 4 * hq, hh * 64 + 16 * pt, lane), pf, ya[pt]);
            }
        }
        const float Dh = C.in[I_SSD_D][l * SSD_H + 4 * g + hh];
#pragma unroll
        for (int pt = 0; pt < 4; ++pt) { const int col = hh * 64 + 16 * pt + 4 * hq; const v2u xw = *(const LAS v2u*)(Ximg + tl * XI_STRIDE + col * 2); const v2u zz = *(const GAS v2u*)(PROJ + row * DINP + C_Z + g * 256 + col);
            f32x4 v; v.x = (ya[pt].x + Dh * bflo(xw.x)) * silu_f(bflo(zz.x)); v.y = (ya[pt].y + Dh * bfhi(xw.x)) * silu_f(bfhi(zz.x)); v.z = (ya[pt].z + Dh * bflo(xw.y)) * silu_f(bflo(zz.y)); v.w = (ya[pt].w + Dh * bfhi(xw.y)) * silu_f(bfhi(zz.y));
            *(GAS f32x4*)(YT + col) = v; ssq += (v.x * v.x + v.y * v.y) + (v.z * v.z + v.w * v.w); }
    }
    ssq = xsum4(ssq);
    const float rstd = 1.f / sqrtf(ssq * (1.f / 256.f) + EPS);
    const float* ssd_norm = C.in[I_SSD_NORM] + (size_t)l * SSD_W + g * 256;
    asm volatile("s_waitcnt vmcnt(0)" ::: "memory");
#pragma unroll 4
    for (int i = 0; i < 16; ++i) { const int col = 16 * i + 4 * hq; const f32x4 gn = *(const GAS f32x4*)(ssd_norm + col); const f32x4 v = *(const GAS f32x4*)(YT + col);
        v2u ow; ow.x = pk2(v.x * rstd * gn.x, v.y * rstd * gn.y); ow.y = pk2(v.z * rstd * gn.z, v.w * rstd * gn.w); *(GAS v2u*)(Y + row * DM + g * 256 + col) = ow; }
}

__device__ __forceinline__ void mix_c1_phase(Ctx& C, int l) {
    for (int u = C.bid; u < N_SSD_CU; u += C.G) ssd_c1_unit(C, u);
    for (int u = C.bid; u < N_GLA_CU; u += C.G) gla_c1_unit(C, u);
    for (int u = C.bid; u < N_SWA_UNITS; u += C.G) swa_unit_mfma(C, l, u);
}
__device__ __forceinline__ void mix_c3_phase(Ctx& C, int l) {
    for (int u = C.bid; u < N_SSD_CU; u += C.G) ssd_c3_unit(C, l, u);
    for (int u = C.bid; u < N_GLA_CU; u += C.G) gla_c3_unit(C, l, u);
}

__device__ __forceinline__ void act_phase(Ctx& C, int l) {
    const bf16* GU = (const bf16*)(C.ws + WS_GU); bf16* ACT = (bf16*)(C.ws + WS_ACT);
    const float* cw = C.in[I_FFN_CONV_W] + (size_t)l * 3 * DFF; const float* cb = C.in[I_FFN_CONV_B] + (size_t)l * DFF;
    constexpr int NCG = DFF / 8, NRB = M / 32; constexpr long NIT = (long)NCG * NRB;
    for (long it = (long)C.bid * NTHR + C.tid; it < NIT; it += (long)C.G * NTHR) {
        const int cg = (int)(it % NCG), rb = (int)(it / NCG), c0 = 8 * cg, r0 = 32 * rb;
        float w0[8], w1[8], w2[8], bb[8];
#pragma unroll
        for (int e = 0; e < 8; ++e) { w0[e] = cw[c0 + e]; w1[e] = cw[DFF + c0 + e]; w2[e] = cw[2 * DFF + c0 + e]; bb[e] = cb[c0 + e]; }
        float g1[8], g2[8];
        const bool first = (r0 % SEQ) == 0;
        { v4u a = (v4u){0u, 0u, 0u, 0u}, b2 = (v4u){0u, 0u, 0u, 0u};
          if (!first) { a = *(const GAS v4u*)(GU + (size_t)(r0 - 1) * DGU + c0); b2 = *(const GAS v4u*)(GU + (size_t)(r0 - 2) * DGU + c0); }
          g1[0] = bflo(a.x); g1[1] = bfhi(a.x); g1[2] = bflo(a.y); g1[3] = bfhi(a.y); g1[4] = bflo(a.z); g1[5] = bfhi(a.z); g1[6] = bflo(a.w); g1[7] = bfhi(a.w);
          g2[0] = bflo(b2.x); g2[1] = bfhi(b2.x); g2[2] = bflo(b2.y); g2[3] = bfhi(b2.y); g2[4] = bflo(b2.z); g2[5] = bfhi(b2.z); g2[6] = bflo(b2.w); g2[7] = bfhi(b2.w); }
#pragma unroll 4
        for (int r = 0; r < 32; ++r) {
            const v4u gw_ = *(const GAS v4u*)(GU + (size_t)(r0 + r) * DGU + c0), uw = *(const GAS v4u*)(GU + (size_t)(r0 + r) * DGU + DFF + c0);
            float g0[8], u[8], o[8];
            g0[0] = bflo(gw_.x); g0[1] = bfhi(gw_.x); g0[2] = bflo(gw_.y); g0[3] = bfhi(gw_.y); g0[4] = bflo(gw_.z); g0[5] = bfhi(gw_.z); g0[6] = bflo(gw_.w); g0[7] = bfhi(gw_.w);
            u[0] = bflo(uw.x); u[1] = bfhi(uw.x); u[2] = bflo(uw.y); u[3] = bfhi(uw.y); u[4] = bflo(uw.z); u[5] = bfhi(uw.z); u[6] = bflo(uw.w); u[7] = bfhi(uw.w);
#pragma unroll
            for (int e = 0; e < 8; ++e) { const float gc = bb[e] + w0[e] * g2[e] + w1[e] * g1[e] + w2[e] * g0[e]; o[e] = silu_f(gc) * u[e]; g2[e] = g1[e]; g1[e] = g0[e]; }
            v4u ow; ow.x = pk2(o[0], o[1]); ow.y = pk2(o[2], o[3]); ow.z = pk2(o[4], o[5]); ow.w = pk2(o[6], o[7]);
            *(GAS v4u*)(ACT + (size_t)(r0 + r) * DFF + c0) = ow;
        }
    }
}

constexpr int PH_PER_LAYER = 11, PH_FINAL = DEPTH * PH_PER_LAYER, N_PHASES = PH_FINAL + 1;
#ifndef MK_ONE_LAUNCH
#define MK_ONE_LAUNCH 1
#endif
__global__ void __launch_bounds__(NTHR, 2) fwd_kernel(Args args) {
    extern __shared__ __attribute__((aligned(16))) unsigned char lds[];
    Ctx C;
    C.lds = (LAS unsigned char*)lds;
    C.tid = threadIdx.x; C.lane = C.tid & 63; C.wave = __builtin_amdgcn_readfirstlane(C.tid >> 6);
    C.G = gridDim.x; C.bid = blockIdx.x;
    C.in = args.in; C.out = args.out; C.ws = args.ws;
    volatile LAS unsigned* MISC = (volatile LAS unsigned*)(C.lds + MISC_OFF);
    for (int u = C.tid; u < (LDS_BYTES - RING_BYTES) / 4; u += NTHR) ((LAS unsigned*)(C.lds + RING_BYTES))[u] = 0u;
    __syncthreads();
    gu32* ctl = (gu32*)(args.ws + WS_CTL);
    XcdBarrier bar = xcd_barrier_post((unsigned*)(ctl + CW_BAR) + args.li * XCD_BAR_WORDS, MISC + 8);
    const int lo = args.ph_lo, hi = args.ph_hi;
#define IN(k) (lo <= (k) && (k) < hi)
#define SEAM(k) do { if (IN(k) && IN((k) + 1)) xcd_barrier(bar); } while (0)
    float* xres = args.out;
    bf16* H = (bf16*)(args.ws + WS_H);
#define LAYER_BODY(l) do { \
        const int pb = l * PH_PER_LAYER; \
        const float* xin = (l == 0) ? args.in[I_X] : (const float*)xres; \
        if (IN(pb + 0)) { convert_weights(C, l); rmsnorm_phase(C, xin, args.in[I_ATTN_NORM] + (size_t)l * DM, H); } \
        SEAM(pb + 0); \
        if (IN(pb + 1)) { \
            pg8::Gemm g{H, (const bf16*)(args.ws + WS_WIN), M, DINP, DM}; pg8::StaticOrder S; S.init(M, DINP, C.G, C.bid); \
            pg8::EpiBf16 E{(bf16*)(args.ws + WS_PROJ), DINP}; \
            pg8::gemm_phase<pg8::EpiBf16, pg8::StaticOrder, true, true>(C.lds, g, S, E); \
        } \
        SEAM(pb + 1); \
        if (IN(pb + 2)) prep_phase(C, l); \
        SEAM(pb + 2); \
        if (IN(pb + 3)) mix_c1_phase(C, l); \
        SEAM(pb + 3); \
        if (IN(pb + 4)) scan_phase(C); \
        SEAM(pb + 4); \
        if (IN(pb + 5)) mix_c3_phase(C, l); \
        SEAM(pb + 5); \
        if (IN(pb + 6)) { \
            pg8::Gemm g{(const bf16*)(args.ws + WS_Y), (const bf16*)(args.ws + WS_WOUT), M, DM, DM}; pg8::StaticOrder S; S.init(M, DM, C.G, C.bid); \
            pg8::EpiRes E{xin, xres, DM}; \
            pg8::gemm_phase<pg8::EpiRes, pg8::StaticOrder, true, true>(C.lds, g, S, E); \
        } \
        SEAM(pb + 6); \
        if (IN(pb + 7)) rmsnorm_phase(C, xres, args.in[I_FFN_NORM] + (size_t)l * DM, H); \
        SEAM(pb + 7); \
        if (IN(pb + 8)) { \
            pg8::Gemm g{H, (const bf16*)(args.ws + WS_WGU), M, DGU, DM}; pg8::StaticOrder S; S.init(M, DGU, C.G, C.bid); \
            pg8::EpiBf16 E{(bf16*)(args.ws + WS_GU), DGU}; \
            pg8::gemm_phase<pg8::EpiBf16, pg8::StaticOrder, true, true>(C.lds, g, S, E); \
        } \
        SEAM(pb + 8); \
        if (IN(pb + 9)) act_phase(C, l); \
        SEAM(pb + 9); \
        if (IN(pb + 10)) { \
            pg8::Gemm g{(const bf16*)(args.ws + WS_ACT), (const bf16*)(args.ws + WS_WDN), M, DM, DFF}; pg8::StaticOrder S; S.init(M, DM, C.G, C.bid); \
            pg8::EpiRes E{xres, xres, DM}; \
            pg8::gemm_phase<pg8::EpiRes, pg8::StaticOrder, true, true>(C.lds, g, S, E); \
        } \
        SEAM(pb + 10); \
     \
    } while (0)
    LAYER_BODY(0);
    LAYER_BODY(1);
#undef LAYER_BODY
    if (IN(PH_FINAL)) final_norm_phase(C, xres, args.in[I_FINAL_NORM]);
#undef IN
#undef SEAM
}

extern "C" void kernel_launch(void* const* d_in, const int* in_sizes, int n_in, void* d_out, int out_size, void* d_ws, size_t ws_size, hipStream_t stream) {
    static int grid = 0;
    if (grid == 0) {
        if (n_in != N_IN || out_size != M * DM || ws_size < WS_END) { fprintf(stderr, "kernel_launch: unexpected shapes (n_in %d, out %d, ws %zu < %zu)\n", n_in, out_size, ws_size, (size_t)WS_END); grid = -1; return; }
        int dev = 0, cus = 0, per_cu = 0;
        if (hipGetDevice(&dev) != hipSuccess || hipDeviceGetAttribute(&cus, hipDeviceAttributeMultiprocessorCount, dev) != hipSuccess) { grid = -1; return; }
        if (hipFuncSetAttribute((const void*)fwd_kernel, hipFuncAttributeMaxDynamicSharedMemorySize, LDS_BYTES) != hipSuccess) { fprintf(stderr, "kernel_launch: hipFuncSetAttribute failed\n"); grid = -1; return; }
        if (hipOccupancyMaxActiveBlocksPerMultiprocessor(&per_cu, (const void*)fwd_kernel, NTHR, LDS_BYTES) != hipSuccess || per_cu < 1) { fprintf(stderr, "kernel_launch: occupancy query says %d\n", per_cu); (void)hipGetLastError(); grid = -1; return; }
        grid = cus;
    }
    if (grid < 0) return;
    if (hipMemsetAsync((char*)d_ws + WS_CTL, 0, CTL_ZERO_BYTES, stream) != hipSuccess) return;
    Args a{};
    for (int i = 0; i < N_IN; ++i) a.in[i] = (const float*)d_in[i];
    a.out = (float*)d_out; a.ws = (unsigned char*)d_ws; a.pad = 0;
#if MK_ONE_LAUNCH
    a.ph_lo = 0; a.ph_hi = N_PHASES; a.li = 0;
    hipLaunchKernelGGL(fwd_kernel, dim3(grid), dim3(NTHR), LDS_BYTES, stream, a);
#else
    for (int p = 0; p < N_PHASES; ++p) { a.ph_lo = p; a.ph_hi = p + 1; a.li = p;
        hipLaunchKernelGGL(fwd_kernel, dim3(grid), dim3(NTHR), LDS_BYTES, stream, a); }
#endif
}
```

```cpp
#include <hip/hip_runtime.h>
#include <cstdio>
#include <cstdint>
namespace pg8 {
#define PG8_LAS __attribute__((address_space(3)))
typedef unsigned short bf16_t;
typedef short bf16x8 __attribute__((ext_vector_type(8)));
typedef float f32x4 __attribute__((ext_vector_type(4)));
typedef unsigned u32x4 __attribute__((ext_vector_type(4)));
constexpr int BM = 256, BK = 64, HALF = 128, HTB = HALF * BK * 2  , STAGE_BYTES = 8 * HTB, NXCD = 8, WGM = 8;

__host__ __device__ __forceinline__ int lds_byte(int r, int c) { const int st = (r >> 4) * 2 + (c >> 5), rr = r & 15, cc = c & 31, ob = rr * 64 + cc * 2; return st * 1024 + (ob ^ (((ob >> 9) & 1) << 5)); }
__host__ __device__ __forceinline__ void stage_rc(int b, int& R, int& C) { const int st = b / 1024, sb = b % 1024, swz = sb ^ (((sb >> 9) & 1) << 5); R = (st >> 1) * 16 + swz / 64; C = (st & 1) * 32 + (swz % 64) / 2; }
__host__ __device__ __forceinline__ int perm32(int rho) { const int n = rho >> 4, i = rho & 15; return 8 * (i >> 2) + 4 * n + (i & 3); }

struct Unit { int pm, pn; };
struct Gemm { const bf16_t* A; const bf16_t* Bt; int M, N, K; };

struct StaticOrder {
    int nM, nN, nwg, G, c;
    __host__ __device__ void init(int M, int N, int G_, int c_) { nM = M / BM; nN = N / BM; nwg = nM * nN; G = G_; c = c_; }
    __host__ __device__ bool next(int i, Unit& u) const {
        const long L = (long)i * G + c; if (L >= nwg) return false;
        int wgid = (int)L; { const int q = nwg / NXCD, r = nwg % NXCD, xcd = wgid % NXCD, off = wgid / NXCD; wgid = (xcd < r ? xcd * (q + 1) : r * (q + 1) + (xcd - r) * q) + off; }
        const int nig = WGM * nN, gid = wgid / nig, fm = gid * WGM, gsz = (nM - fm) < WGM ? (nM - fm) : WGM;
        u.pm = fm + ((wgid % nig) % gsz); u.pn = (wgid % nig) / gsz; return true;
    }
    __device__ __forceinline__ void a_ready(const Unit&) const {}
    __device__ __forceinline__ void done(const Unit&) const {}
};

__device__ __forceinline__ unsigned cvt_pk_bf16(float lo, float hi) { unsigned r; asm volatile("v_cvt_pk_bf16_f32 %0, %1, %2" : "=v"(r) : "v"(lo), "v"(hi)); return r; }

struct EpiBf16 {
    static constexpr bool PERM = true, AFTER_DRAIN = false;
    bf16_t* O; int ldc;
    __device__ __forceinline__ void operator()(const f32x4 (&acc)[2][2][4][2], const Unit& u, int wr, int wc, int fr, int fq) const {
        const int row0 = u.pm * BM + wr * 64 + fr; const int col0 = u.pn * BM + wc * 32 + 8 * fq;
#pragma unroll
        for (int ai = 0; ai < 2; ++ai)
#pragma unroll
            for (int m = 0; m < 4; ++m) { bf16_t* rowp = O + (size_t)(row0 + ai * HALF + m * 16) * ldc + col0;
#pragma unroll
                for (int bj = 0; bj < 2; ++bj) { const f32x4 v0 = acc[ai][bj][m][0], v1 = acc[ai][bj][m][1];
                    u32x4 w; w.x = cvt_pk_bf16(v0[0], v0[1]); w.y = cvt_pk_bf16(v0[2], v0[3]); w.z = cvt_pk_bf16(v1[0], v1[1]); w.w = cvt_pk_bf16(v1[2], v1[3]);
                    *(u32x4*)(rowp + bj * HALF) = w; } }
    }
};
template <int CTRL> __device__ __forceinline__ float dpp_old(float old, float v) { return __int_as_float(__builtin_amdgcn_update_dpp(__float_as_int(old), __float_as_int(v), CTRL, 0xf, 0xf, false)); }
struct EpiGateUp {
    static constexpr bool PERM = true, AFTER_DRAIN = false;
    bf16_t* ACT; const float* cw; const float* cb; float* HTG; float* HTU; float* HBG; int dff;
    __device__ __forceinline__ void operator()(const f32x4 (&acc)[2][2][4][2], const Unit& u, int wr, int wc, int fr, int fq) const {
        const int j0 = u.pn * 128 + wc * 32 + 8 * fq;
        float w0[8], w1[8], w2[8], bb[8];
#pragma unroll
        for (int h = 0; h < 2; ++h) { const f32x4 a = *(const f32x4*)(cw + j0 + 4 * h), b = *(const f32x4*)(cw + dff + j0 + 4 * h), c = *(const f32x4*)(cw + 2 * dff + j0 + 4 * h), d = *(const f32x4*)(cb + j0 + 4 * h);
#pragma unroll
            for (int e = 0; e < 4; ++e) { w0[4 * h + e] = a[e]; w1[4 * h + e] = b[e]; w2[4 * h + e] = c[e]; bb[4 * h + e] = d[e]; } }
#pragma unroll
        for (int ai = 0; ai < 2; ++ai) {
            const int rowb = u.pm * BM + ai * HALF + wr * 64; const size_t blk = (size_t)(rowb >> 6);
#pragma unroll
            for (int m = 0; m < 4; ++m) {
                const int row = rowb + 16 * m + fr; float o[8];
#pragma unroll
                for (int n = 0; n < 2; ++n)
#pragma unroll
                    for (int e = 0; e < 4; ++e) { const int k = 4 * n + e; const float g0 = acc[ai][0][m][n][e], up = acc[ai][1][m][n][e]; const float gp = m > 0 ? acc[ai][0][m > 0 ? m - 1 : 0][n][e] : 0.f;
                        const float g1 = dpp_old<0x111>(dpp_old<0x121>(0.f, gp), g0), g2 = dpp_old<0x112>(dpp_old<0x122>(0.f, gp), g0);
                        const float gc = bb[k] + w0[k] * g2 + w1[k] * g1 + w2[k] * g0; o[k] = gc / (1.f + __expf(-gc)) * up; }
                u32x4 w; w.x = cvt_pk_bf16(o[0], o[1]); w.y = cvt_pk_bf16(o[2], o[3]); w.z = cvt_pk_bf16(o[4], o[5]); w.w = cvt_pk_bf16(o[6], o[7]);
                *(u32x4*)(ACT + (size_t)row * dff + j0) = w;
                if (m == 0 && fr < 2) { float* pg = HTG + (blk * 2 + fr) * dff + j0; float* pu = HTU + (blk * 2 + fr) * dff + j0;
                    *(f32x4*)pg = acc[ai][0][0][0]; *(f32x4*)(pg + 4) = acc[ai][0][0][1]; *(f32x4*)pu = acc[ai][1][0][0]; *(f32x4*)(pu + 4) = acc[ai][1][0][1]; }
                if (m == 3 && fr >= 14) { float* pg = HBG + (blk * 2 + (fr - 14)) * dff + j0; *(f32x4*)pg = acc[ai][0][3][0]; *(f32x4*)(pg + 4) = acc[ai][0][3][1]; }
            }
        }
    }
};
struct EpiRes {
    static constexpr bool PERM = false, AFTER_DRAIN = false;
    const float* base; float* out; int ldc;
    __device__ __forceinline__ void operator()(const f32x4 (&acc)[2][2][4][2], const Unit& u, int wr, int wc, int fr, int fq) const {
        const int row0 = u.pm * BM + wr * 64 + fr, col0 = u.pn * BM + wc * 32 + 4 * fq;
#pragma unroll
        for (int ai = 0; ai < 2; ++ai)
#pragma unroll
            for (int m = 0; m < 4; ++m) { const size_t off = (size_t)(row0 + ai * HALF + m * 16) * ldc + col0;
#pragma unroll
                for (int bj = 0; bj < 2; ++bj)
#pragma unroll
                    for (int n = 0; n < 2; ++n) { const f32x4 bs = *(const f32x4*)(base + off + bj * HALF + n * 16); *(f32x4*)(out + off + bj * HALF + n * 16) = bs + acc[ai][bj][m][n]; } }
    }
};
template <class Epi, class Sched, bool ALIGN_EPI = false, bool SP2 = false>
__device__ __forceinline__ void gemm_phase(PG8_LAS unsigned char* lds, const Gemm g, const Sched& S, const Epi& E) {
    const int tid = threadIdx.x, wid = __builtin_amdgcn_readfirstlane(tid >> 6), lane = tid & 63, wr = wid >> 2, wc = wid & 3, fr = lane & 15, fq = lane >> 4;
    const int K = g.K, nt = K / BK;
    unsigned voffA[2], voffB[2];
#pragma unroll
    for (int i = 0; i < 2; ++i) { int R, C; stage_rc(tid * 16 + i * 8192, R, C); const int Rb = Epi::PERM ? ((R & ~31) + perm32(R & 31)) : R;
        voffA[i] = (unsigned)(R * K + C) * 2u; voffB[i] = (unsigned)(Rb * K + C) * 2u; }
    const size_t kstep = (size_t)(BK * 2);
    const size_t hstep = (size_t)HALF * K * 2;
    const size_t tstep = 2 * hstep;
    const unsigned ldsw = (unsigned)wid * 1024u;
    const int aoff = lds_byte(wr * 64 + fr, fq * 8), boff = lds_byte(wc * 32 + fr, fq * 8);
#define PG8_SA(b, h) (((b) * 2 + (h)) * HTB)
#define PG8_SB(b, h) ((4 + (b) * 2 + (h)) * HTB)
#define PG8_STAGE(bufoff, gbase, voff) do { _Pragma("unroll") for (int _i = 0; _i < 2; ++_i) \
        __builtin_amdgcn_global_load_lds((const unsigned*)((const char*)(gbase) + (voff)[_i]), (PG8_LAS unsigned*)(lds + (bufoff) + ldsw + _i * 8192), 16, 0, 0); } while (0)
#define PG8_LDA(dst, b, h) do { _Pragma("unroll") for (int m = 0; m < 4; ++m) _Pragma("unroll") for (int k = 0; k < 2; ++k) dst[m][k] = *(const PG8_LAS bf16x8*)(lds + PG8_SA(b, h) + aoff + m * 2048 + k * 1024); } while (0)
#define PG8_LDB(dst, b, h) do { _Pragma("unroll") for (int n = 0; n < 2; ++n) _Pragma("unroll") for (int k = 0; k < 2; ++k) dst[n][k] = *(const PG8_LAS bf16x8*)(lds + PG8_SB(b, h) + boff + n * 2048 + k * 1024); } while (0)
#define PG8_MMA(ai, bj, At, Bt) do { __builtin_amdgcn_s_setprio(1); _Pragma("unroll") for (int m = 0; m < 4; ++m) _Pragma("unroll") for (int n = 0; n < 2; ++n) _Pragma("unroll") for (int k = 0; k < 2; ++k) \
        acc[ai][bj][m][n] = __builtin_amdgcn_mfma_f32_16x16x32_bf16(Bt[n][k], At[m][k], acc[ai][bj][m][n], 0, 0, 0); __builtin_amdgcn_s_setprio(0); } while (0)
#define PG8_WAIT_V(n) asm volatile("s_waitcnt vmcnt(" #n ")" ::: "memory")
#define PG8_WAIT_L(n) asm volatile("s_waitcnt lgkmcnt(" #n ")" ::: "memory")
#define PG8_BAR __builtin_amdgcn_s_barrier()
#define PG8_SCHED __builtin_amdgcn_sched_barrier(0)
    Unit cur, nxt; int ui = 0;
    if (!S.next(0, cur)) return;
    f32x4 acc[2][2][4][2];
#pragma unroll
    for (int a = 0; a < 2; ++a)
#pragma unroll
        for (int b = 0; b < 2; ++b)
#pragma unroll
            for (int m = 0; m < 4; ++m)
#pragma unroll
                for (int n = 0; n < 2; ++n) acc[a][b][m][n] = (f32x4){0.f, 0.f, 0.f, 0.f};
    bf16x8 At[4][2], B0[2][2], B1[2][2];
    const char* cA = (const char*)g.A + (size_t)cur.pm * tstep; const char* cB = (const char*)g.Bt + (size_t)cur.pn * tstep;
    S.a_ready(cur);
    if constexpr (SP2) {
        PG8_STAGE(PG8_SB(0, 0), cB, voffB); PG8_STAGE(PG8_SB(0, 1), cB + hstep, voffB); PG8_STAGE(PG8_SA(0, 0), cA, voffA); PG8_STAGE(PG8_SA(0, 1), cA + hstep, voffA);
        if (wr == 1) PG8_BAR;
        PG8_WAIT_V(2); PG8_BAR;
        PG8_STAGE(PG8_SB(1, 0), cB + kstep, voffB); PG8_STAGE(PG8_SA(1, 0), cA + kstep, voffA); PG8_STAGE(PG8_SB(1, 1), cB + hstep + kstep, voffB);
        PG8_WAIT_V(6); PG8_BAR;
    } else {
        PG8_STAGE(PG8_SB(0, 0), cB, voffB); PG8_STAGE(PG8_SA(0, 0), cA, voffA); PG8_STAGE(PG8_SB(0, 1), cB + hstep, voffB); PG8_STAGE(PG8_SA(0, 1), cA + hstep, voffA);
        if (wr == 1) PG8_BAR;
        PG8_WAIT_V(4); PG8_BAR;
        PG8_STAGE(PG8_SB(1, 0), cB + kstep, voffB); PG8_STAGE(PG8_SA(1, 0), cA + kstep, voffA); PG8_STAGE(PG8_SB(1, 1), cB + hstep + kstep, voffB);
        PG8_WAIT_V(6); PG8_BAR;
    }
    for (;;) {
        const bool has_next = S.next(ui + 1, nxt);
        const char* nA = has_next ? (const char*)g.A + (size_t)nxt.pm * tstep : cA; const char* nB = has_next ? (const char*)g.Bt + (size_t)nxt.pn * tstep : cB;
        for (int t = 0; t < nt; t += 2) {
            const bool last = (t == nt - 2);
            const char* a1 = cA + (size_t)(t + 1) * kstep;
            const char* a2 = last ? nA : cA + (size_t)(t + 2) * kstep; const char* b2 = last ? nB : cB + (size_t)(t + 2) * kstep;
            const char* a3 = a2 + kstep; const char* b3 = b2 + kstep;
            if (last && has_next) S.a_ready(nxt);
            if constexpr (SP2) {
            PG8_LDB(B0, 0, 0); PG8_LDB(B1, 0, 1); PG8_SCHED; PG8_LDA(At, 0, 0); PG8_STAGE(PG8_SA(1, 1), a1 + hstep, voffA);
            PG8_WAIT_V(8); PG8_WAIT_L(0); PG8_BAR; PG8_MMA(0, 0, At, B0); PG8_MMA(0, 1, At, B1); PG8_BAR; PG8_SCHED;
            PG8_LDA(At, 0, 1); PG8_STAGE(PG8_SB(0, 0), b2, voffB); PG8_STAGE(PG8_SB(0, 1), b2 + hstep, voffB); PG8_STAGE(PG8_SA(0, 0), a2, voffA);
            PG8_WAIT_V(8); PG8_WAIT_L(0); PG8_BAR; PG8_MMA(1, 0, At, B0); PG8_MMA(1, 1, At, B1); PG8_BAR; PG8_SCHED;
            PG8_LDB(B0, 1, 0); PG8_LDB(B1, 1, 1); PG8_SCHED; PG8_LDA(At, 1, 0); PG8_STAGE(PG8_SA(0, 1), a2 + hstep, voffA);
            PG8_WAIT_V(8); PG8_WAIT_L(0); PG8_BAR; PG8_MMA(0, 0, At, B0); PG8_MMA(0, 1, At, B1); PG8_BAR; PG8_SCHED;
            PG8_LDA(At, 1, 1); PG8_STAGE(PG8_SB(1, 0), b3, voffB); PG8_STAGE(PG8_SB(1, 1), b3 + hstep, voffB); PG8_STAGE(PG8_SA(1, 0), a3, voffA);
            PG8_WAIT_V(8); PG8_WAIT_L(0); PG8_BAR; PG8_MMA(1, 0, At, B0); PG8_MMA(1, 1, At, B1); PG8_BAR; PG8_SCHED;
            } else {
            PG8_LDB(B0, 0, 0); PG8_SCHED; PG8_LDA(At, 0, 0); PG8_STAGE(PG8_SA(1, 1), a1 + hstep, voffA);
            PG8_WAIT_L(8); PG8_BAR; PG8_WAIT_L(0); PG8_MMA(0, 0, At, B0); PG8_BAR; PG8_SCHED;
            PG8_LDB(B1, 0, 1); PG8_STAGE(PG8_SB(0, 0), b2, voffB);
            PG8_BAR; PG8_WAIT_L(0); PG8_MMA(0, 1, At, B1); PG8_BAR;
            PG8_LDA(At, 0, 1); PG8_STAGE(PG8_SA(0, 0), a2, voffA);
            PG8_BAR; PG8_WAIT_L(0); PG8_MMA(1, 0, At, B0); PG8_BAR; PG8_SCHED;
            PG8_STAGE(PG8_SB(0, 1), b2 + hstep, voffB);
            PG8_WAIT_V(6); PG8_BAR; PG8_MMA(1, 1, At, B1); PG8_BAR;
            PG8_LDB(B0, 1, 0); PG8_SCHED; PG8_LDA(At, 1, 0); PG8_STAGE(PG8_SA(0, 1), a2 + hstep, voffA);
            PG8_WAIT_L(8); PG8_BAR; PG8_WAIT_L(0); PG8_MMA(0, 0, At, B0); PG8_BAR; PG8_SCHED;
            PG8_LDB(B1, 1, 1); PG8_STAGE(PG8_SB(1, 0), b3, voffB);
            PG8_BAR; PG8_WAIT_L(0); PG8_MMA(0, 1, At, B1); PG8_BAR;
            PG8_LDA(At, 1, 1); PG8_STAGE(PG8_SA(1, 0), a3, voffA);
            PG8_BAR; PG8_WAIT_L(0); PG8_MMA(1, 0, At, B0); PG8_BAR; PG8_SCHED;
            PG8_STAGE(PG8_SB(1, 1), b3 + hstep, voffB);
            PG8_WAIT_V(6); PG8_BAR; PG8_MMA(1, 1, At, B1); PG8_BAR;
            }
        }
        if constexpr (ALIGN_EPI) { if (wr == 0) PG8_BAR; }
        if constexpr (!Epi::AFTER_DRAIN) { E(acc, cur, wr, wc, fr, fq); S.done(cur); }
        if (!has_next) break;
#pragma unroll
        for (int a = 0; a < 2; ++a)
#pragma unroll
            for (int b = 0; b < 2; ++b)
#pragma unroll
                for (int m = 0; m < 4; ++m)
#pragma unroll
                    for (int n = 0; n < 2; ++n) acc[a][b][m][n] = (f32x4){0.f, 0.f, 0.f, 0.f};
        cur = nxt; cA = nA; cB = nB; ++ui;
        if constexpr (ALIGN_EPI) { if (wr == 1) PG8_BAR; }
    }
    PG8_WAIT_V(0);
    if constexpr (!ALIGN_EPI) { if (wr == 0) PG8_BAR; }
    PG8_BAR;
    if constexpr (Epi::AFTER_DRAIN) { E.fused(acc, cur, wr, wc, fr, fq, lds, wid, lane); S.done(cur); }
#undef PG8_SA
#undef PG8_SB
#undef PG8_STAGE
#undef PG8_LDA
#undef PG8_LDB
#undef PG8_MMA
#undef PG8_WAIT_V
#undef PG8_WAIT_L
#undef PG8_BAR
#undef PG8_SCHED
}
}

constexpr int NWAVES = 8, NTHR = NWAVES * 64;
constexpr int BATCH = 2, SEQ = 8192, M = BATCH * SEQ, DM = 4096, DEPTH = 2;
constexpr int SSD_W = 2048, SSD_H = 32, SSD_CD = 4096;
constexpr int SWA_W = 1024, SWA_H = 16;
constexpr int GLA_W = 1024, GLA_KT = 512;
constexpr int DFF = 11008, DIN = 10800, DINP = 11008, DGU = 2 * DFF;
constexpr float EPS = 1e-6f;
constexpr int C_Z = 0, C_XBC = 2048, C_DT = 6144, C_SQ = 6176, C_SK = 7200, C_SV = 7456, C_GQ = 7712, C_GK = 8224, C_GV = 8736, C_GG = 9760, C_GLR = 10784;
enum { I_X = 0, I_ATTN_NORM, I_W_IN, I_SSD_CONV_W, I_SSD_CONV_B, I_SSD_DT_BIAS, I_SSD_A_LOG, I_SSD_D, I_SSD_NORM, I_SWA_SINKS, I_SWA_NORM, I_GLA_W_GATE, I_GLA_B_GATE, I_GLA_NORM,
       I_W_OUT, I_FFN_NORM, I_W_GATE, I_W_UP, I_FFN_CONV_W, I_FFN_CONV_B, I_W_DOWN, I_REL_BIAS, I_FINAL_NORM, N_IN };

constexpr size_t MiB = 1u << 20;
constexpr size_t WS_CTL = 0, CTL_ZERO_BYTES = 1 * MiB;
constexpr size_t WS_WIN = 1 * MiB;
constexpr size_t WS_WOUT = 87 * MiB;
constexpr size_t WS_WGU = 119 * MiB;
constexpr size_t WS_WDN = 291 * MiB;
constexpr size_t WS_H = 377 * MiB;
constexpr size_t WS_R = 505 * MiB;
constexpr size_t WS_PROJ = WS_R;
constexpr size_t WS_XBC = WS_R + 344 * MiB;
constexpr size_t WS_QD = WS_R + 472 * MiB;
constexpr size_t WS_KI = WS_R + 488 * MiB;
constexpr size_t WS_DT = WS_R + 520 * MiB;
constexpr size_t WS_ACS = WS_R + 522 * MiB;
constexpr size_t WS_DEC = WS_R + 524 * MiB;
constexpr size_t WS_GDEC = WS_R + 525 * MiB;
constexpr size_t WS_ST = WS_R + 528 * MiB;
constexpr size_t WS_PV = WS_R + 656 * MiB;
constexpr size_t WS_GST = WS_R + 720 * MiB;
constexpr size_t WS_GPV = WS_R + 848 * MiB;
constexpr size_t WS_OSWA = WS_R + 912 * MiB;
constexpr size_t WS_Y = WS_R + 976 * MiB;
constexpr size_t WS_ACT = WS_R + 688 * MiB;
constexpr size_t WS_HTG = WS_R + 1032 * MiB, WS_HTU = WS_R + 1054 * MiB, WS_HBG = WS_R + 1076 * MiB;
constexpr size_t WS_END = WS_R + 1104 * MiB;
static_assert(DEPTH == 2 && (size_t)DINP * DM * 2 == 86 * MiB && (size_t)DGU * DM * 2 == 172 * MiB && (size_t)M * DINP * 2 == 344 * MiB , "ws map");
constexpr int CW_BAR = 4096;

constexpr int RING_BYTES = 131072;
constexpr int MISC_OFF = RING_BYTES + 320;
constexpr int LDS_BYTES = 147456;

#define GAS __attribute__((address_space(1)))
#define LAS __attribute__((address_space(3)))
typedef unsigned short bf16;
typedef unsigned v4u __attribute__((ext_vector_type(4)));
typedef unsigned v2u __attribute__((ext_vector_type(2)));
typedef float f32x4 __attribute__((ext_vector_type(4)));
typedef GAS unsigned gu32;
#define RLX_AGENT __ATOMIC_RELAXED, __HIP_MEMORY_SCOPE_AGENT
#define LDS_WAIT() asm volatile("s_waitcnt lgkmcnt(0)" ::: "memory")
__device__ __forceinline__ unsigned f2bf(float f) { unsigned u = __builtin_bit_cast(unsigned, f); return (u + 0x7fffu + ((u >> 16) & 1u)) >> 16; }
__device__ __forceinline__ unsigned pk2(float lo, float hi) { return f2bf(lo) | (f2bf(hi) << 16); }
__device__ __forceinline__ float bflo(unsigned w) { return __uint_as_float(w << 16); }
__device__ __forceinline__ float bfhi(unsigned w) { return __uint_as_float(w & 0xffff0000u); }
__device__ __forceinline__ float bf1(bf16 h) { return __uint_as_float((unsigned)h << 16); }
__device__ __forceinline__ float silu_f(float x) { return x / (1.f + __expf(-x)); }
__device__ __forceinline__ float wave_sum(float v) {
#pragma unroll
    for (int o = 1; o < 64; o <<= 1) v += __shfl_xor(v, o);
    return v;
}
template <int CTRL> __device__ __forceinline__ float dpp_f(float v) { return __int_as_float(__builtin_amdgcn_update_dpp(0, __float_as_int(v), CTRL, 0xf, 0xf, false)); }
__device__ __forceinline__ float row16_sum(float v) { v += dpp_f<0xB1>(v); v += dpp_f<0x4E>(v); v += dpp_f<0x124>(v); v += dpp_f<0x128>(v); return v; }
__device__ __forceinline__ float pair_sum(float v) { return v + dpp_f<0xB1>(v); }
#define XB_TMO      128
#define XB_XCNT(j)  (256  + 64 * (j))
#define XB_XSUB(j)  (1280 + 64 * (j))
#define XB_XGEN(j)  (2304 + 64 * (j))
#define XB_TOP      3328
#define XB_TOPGEN   3392
#define XCD_BAR_WORDS 3456
#define XB_SPIN_CAP (1u << 18)

__device__ __forceinline__ unsigned xb_ld(unsigned* p)              { return __hip_atomic_load(p, __ATOMIC_RELAXED, __HIP_MEMORY_SCOPE_AGENT); }
__device__ __forceinline__ unsigned xb_add(unsigned* p, unsigned v) { return __hip_atomic_fetch_add(p, v, __ATOMIC_RELAXED, __HIP_MEMORY_SCOPE_AGENT); }
__device__ __forceinline__ unsigned xb_xcc_id() { return (unsigned)__builtin_amdgcn_s_getreg((3 << 11) | 20) & 0xFu; }
#define XB_SPIN(cond, bar) do { unsigned _sp = 0; while (cond) { __builtin_amdgcn_s_sleep(1); \
    if ((++_sp & 255u) == 0u) { if (xb_ld(&(bar)[XB_TMO])) break; if (_sp > XB_SPIN_CAP) { atomicAdd(&(bar)[XB_TMO], 1u); break; } } } } while (0)

struct XcdBarrier {
    unsigned* bar; unsigned x;
    volatile LAS unsigned* st;
};

__device__ __forceinline__ XcdBarrier xcd_barrier_post(unsigned* bar, volatile LAS unsigned* st) {
    XcdBarrier b; b.bar = bar; b.x = xb_xcc_id(); b.st = st;
    if (threadIdx.x == 0) (void)xb_add(&bar[XB_XCNT(b.x)], 1u);
    return b;
}
__device__ __forceinline__ void xcd_barrier_complete(unsigned* bar, unsigned x, unsigned& nloc, unsigned& nx) {
    const unsigned G = gridDim.x * gridDim.y * gridDim.z;
    unsigned sum, cnt, mine, sp = 0u;
    for (;;) {
        sum = 0u; cnt = 0u; mine = 0u;
#pragma unroll
        for (unsigned j = 0; j < 16; ++j) { const unsigned c = xb_ld(&bar[XB_XCNT(j)]); sum += c; cnt += (c > 0u) ? 1u : 0u; mine = (j == x) ? c : mine; }
        if (sum == G) break;
        __builtin_amdgcn_s_sleep(1);
        if ((++sp & 255u) == 0u) { if (xb_ld(&bar[XB_TMO])) break; if (sp > XB_SPIN_CAP) { atomicAdd(&bar[XB_TMO], 1u); break; } }
    }
    nloc = mine > 0u ? mine : 1u; nx = cnt > 0u ? cnt : 1u;
}

__device__ __forceinline__ void xcd_barrier(const XcdBarrier& b) {
    asm volatile("s_waitcnt vmcnt(0)" ::: "memory");
    __syncthreads();
    if (threadIdx.x == 0) {
        unsigned* bar = b.bar;
        __builtin_amdgcn_s_waitcnt(0);
        unsigned nloc = b.st[0], nx = b.st[1];
        if (nloc == 0u) { xcd_barrier_complete(bar, b.x, nloc, nx); b.st[0] = nloc; b.st[1] = nx; }
        const unsigned old = xb_add(&bar[XB_XSUB(b.x)], 1u);
        const unsigned gen = old / nloc;
        if (old + 1u == (gen + 1u) * nloc) {
            __builtin_amdgcn_fence(__ATOMIC_RELEASE, "agent");
            asm volatile("s_waitcnt vmcnt(0)" ::: "memory");
            const unsigned og = xb_add(&bar[XB_TOP], 1u);
            const unsigned tg = og / nx;
            if (og + 1u == (tg + 1u) * nx) xb_add(&bar[XB_TOPGEN], 1u);
            else XB_SPIN(xb_ld(&bar[XB_TOPGEN]) == tg, bar);
            __builtin_amdgcn_fence(__ATOMIC_ACQUIRE, "agent");
            xb_add(&bar[XB_XGEN(b.x)], 1u);
            asm volatile("s_waitcnt vmcnt(0)" ::: "memory");
        } else {
            XB_SPIN(xb_ld(&bar[XB_XGEN(b.x)]) == gen, bar);
            __builtin_amdgcn_fence(__ATOMIC_ACQUIRE, "agent");
            asm volatile("s_waitcnt vmcnt(0)" ::: "memory");
        }
    }
    __syncthreads();
}

struct Args { const float* in[N_IN]; float* out; unsigned char* ws; int ph_lo, ph_hi, li, pad; };
struct Ctx {
    LAS unsigned char* lds;
    int tid, lane, wave, G, bid;
    const float* const* in; float* out; unsigned char* ws;
};
__device__ const unsigned char T5_BUCKET[128] = {0, 1, 2, 3, 4, 5, 6, 7, 8, 9, 10, 11, 12, 13, 14, 15, 16, 16, 16, 17, 17, 18, 18, 18, 19, 19, 19, 20, 20, 20, 20, 21, 21, 21, 21, 22, 22, 22, 22, 22, 23, 23, 23, 23, 23, 23, 24, 24, 24, 24, 24, 24, 25, 25, 25, 25, 25, 25, 25, 26, 26, 26, 26, 26, 26, 26, 26, 27, 27, 27, 27, 27, 27, 27, 27, 27, 27, 28, 28, 28, 28, 28, 28, 28, 28, 28, 28, 29, 29, 29, 29, 29, 29, 29, 29, 29, 29, 29, 29, 30, 30, 30, 30, 30, 30, 30, 30, 30, 30, 30, 30, 30, 30, 31, 31, 31, 31, 31, 31, 31, 31, 31, 31, 31, 31, 31, 31, 31};

struct TItem { const float* src; bf16* dst; int N, K, nvalid; };
__device__ __forceinline__ TItem titem_decode(Ctx& C, int l, int it) {
    constexpr int I_IN = 64 * 344, I_OUT = 64 * 128, I_G = 64 * 344;
    TItem t; int r = it, kb, nb;
    if (r < I_IN) { kb = r / 344; nb = r % 344; t.N = DIN; t.K = DM; t.src = C.in[I_W_IN] + (size_t)l * DM * DIN; t.dst = (bf16*)(C.ws + WS_WIN) + (size_t)(32 * nb) * DM; }
    else if ((r -= I_IN) < I_OUT) { kb = r / 128; nb = r % 128; t.N = DM; t.K = DM; t.src = C.in[I_W_OUT] + (size_t)l * DM * DM; t.dst = (bf16*)(C.ws + WS_WOUT) + (size_t)(32 * nb) * DM; }
    else if ((r -= I_OUT) < I_G) { kb = r / 344; nb = r % 344; t.N = DFF; t.K = DM; t.src = C.in[I_W_GATE] + (size_t)l * DM * DFF; t.dst = (bf16*)(C.ws + WS_WGU) + (size_t)(256 * (nb >> 2) + 32 * (nb & 3)) * DM; }
    else if ((r -= I_G) < I_G) { kb = r / 344; nb = r % 344; t.N = DFF; t.K = DM; t.src = C.in[I_W_UP] + (size_t)l * DM * DFF; t.dst = (bf16*)(C.ws + WS_WGU) + (size_t)(256 * (nb >> 2) + 128 + 32 * (nb & 3)) * DM; }
    else { r -= I_G; kb = r / 128; nb = r % 128; t.N = DM; t.K = DFF; t.src = C.in[I_W_DOWN] + (size_t)l * DFF * DM; t.dst = (bf16*)(C.ws + WS_WDN) + (size_t)(32 * nb) * DFF; }
    t.src += (size_t)(64 * kb) * t.N + 32 * nb; t.dst += 64 * kb;
    const int rem = t.N - 32 * nb; t.nvalid = rem >= 32 ? 32 : (rem > 0 ? rem : 0);
    return t;
}
__device__ __forceinline__ void titem_load(const TItem& t, float (&v)[32], int lane) {
    const bool nv = (lane & 31) < t.nvalid; const float* p = t.src + (size_t)(lane >> 5) * t.N + (lane & 31);
#pragma unroll
    for (int i = 0; i < 32; ++i) v[i] = nv ? p[(size_t)(2 * i) * t.N] : 0.f;
}
__device__ __forceinline__ void titem_store(const TItem& t, const float (&v)[32], LAS float* scr, int lane) {
#pragma unroll
    for (int i = 0; i < 32; ++i) scr[(2 * i + (lane >> 5)) * 33 + (lane & 31)] = v[i];
    LDS_WAIT(); asm volatile("" ::: "memory");
    const int c = lane & 7;
#pragma unroll
    for (int j = 0; j < 4; ++j) { const int n = (lane >> 3) + 8 * j; const LAS float* s = scr + (8 * c) * 33 + n;
        v4u o; o.x = pk2(s[0 * 33], s[1 * 33]); o.y = pk2(s[2 * 33], s[3 * 33]); o.z = pk2(s[4 * 33], s[5 * 33]); o.w = pk2(s[6 * 33], s[7 * 33]);
        *(GAS v4u*)(t.dst + (size_t)n * t.K + 8 * c) = o; }
    LDS_WAIT(); asm volatile("" ::: "memory");
}
__device__ __forceinline__ void convert_weights(Ctx& C, int l) {
    LAS float* scr = (LAS float*)(C.lds + C.wave * 16384);
    const int gw = C.bid * NWAVES + C.wave, NGW = C.G * NWAVES;
    constexpr int NITEMS = 64 * 344 * 3 + 64 * 128 + 172 * 128;
    int it = gw; if (it >= NITEMS) return;
    TItem cur = titem_decode(C, l, it); float va[32], vb[32];
    titem_load(cur, va, C.lane);
    for (;;) {
        int nx = it + NGW; TItem tn = cur; const bool hn = nx < NITEMS;
        if (hn) { tn = titem_decode(C, l, nx); titem_load(tn, vb, C.lane); }
        titem_store(cur, va, scr, C.lane);
        if (!hn) break;
        nx += NGW; const bool hn2 = nx < NITEMS; TItem t2 = tn;
        if (hn2) { t2 = titem_decode(C, l, nx); titem_load(t2, va, C.lane); }
        titem_store(tn, vb, scr, C.lane);
        if (!hn2) break;
        cur = t2; it = nx;
    }
}
__device__ __forceinline__ void rmsnorm_row_bf16(const float* xrow, const float* w, bf16* orow, int lane) {
    const GAS f32x4* xr = (const GAS f32x4*)xrow + lane; const GAS f32x4* wr = (const GAS f32x4*)w + lane;
    f32x4 v[16]; float ss = 0.f;
#pragma unroll
    for (int j = 0; j < 16; ++j) { v[j] = xr[64 * j]; ss += (v[j].x * v[j].x + v[j].y * v[j].y) + (v[j].z * v[j].z + v[j].w * v[j].w); }
    const float rstd = 1.f / sqrtf(wave_sum(ss) * (1.f / DM) + EPS);
    GAS v2u* o8 = (GAS v2u*)orow + lane;
#pragma unroll
    for (int j = 0; j < 16; ++j) { const f32x4 g = wr[64 * j]; v2u o; o.x = pk2(v[j].x * rstd * g.x, v[j].y * rstd * g.y); o.y = pk2(v[j].z * rstd * g.z, v[j].w * rstd * g.w); o8[64 * j] = o; }
}
__device__ __forceinline__ void rmsnorm_phase(Ctx& C, const float* X, const float* w, bf16* H) {
    const int gw = C.bid * NWAVES + C.wave, NGW = C.G * NWAVES;
    for (int m = gw; m < M; m += NGW) rmsnorm_row_bf16(X + (size_t)m * DM, w, H + (size_t)m * DM, C.lane);
}
__device__ __forceinline__ void final_norm_phase(Ctx& C, float* X, const float* w) {
    const int gw = C.bid * NWAVES + C.wave, NGW = C.G * NWAVES;
    for (int m = gw; m < M; m += NGW) {
        GAS f32x4* xr = (GAS f32x4*)(X + (size_t)m * DM) + C.lane; const GAS f32x4* wr = (const GAS f32x4*)w + C.lane;
        f32x4 v[16]; float ss = 0.f;
#pragma unroll
        for (int j = 0; j < 16; ++j) { v[j] = xr[64 * j]; ss += (v[j].x * v[j].x + v[j].y * v[j].y) + (v[j].z * v[j].z + v[j].w * v[j].w); }
        const float rstd = 1.f / sqrtf(wave_sum(ss) * (1.f / DM) + EPS);
#pragma unroll
        for (int j = 0; j < 16; ++j) { const f32x4 g = wr[64 * j]; xr[64 * j] = v[j] * rstd * g; }
    }
}

typedef short bf16x8 __attribute__((ext_vector_type(8)));
typedef short s16x4 __attribute__((ext_vector_type(4)));
__device__ __forceinline__ f32x4 mfma16(bf16x8 a, bf16x8 b, f32x4 c) { return __builtin_amdgcn_mfma_f32_16x16x32_bf16(a, b, c, 0, 0, 0); }
__device__ __forceinline__ bf16x8 pack8(f32x4 lo, f32x4 hi) { v4u w; w.x = pg8::cvt_pk_bf16(lo.x, lo.y); w.y = pg8::cvt_pk_bf16(lo.z, lo.w); w.z = pg8::cvt_pk_bf16(hi.x, hi.y); w.w = pg8::cvt_pk_bf16(hi.z, hi.w); return __builtin_bit_cast(bf16x8, w); }
__device__ __forceinline__ bf16x8 gfrag(const bf16* Mx, size_t ld, int row0, int k0, int lane) { return *(const GAS bf16x8*)(Mx + (size_t)(row0 + (lane & 15)) * ld + k0 + 8 * (lane >> 4)); }
__device__ __forceinline__ bf16x8 trfrag(const LAS unsigned char* img, int stride, int r0, int r1, int col0, int lane) {
    const int q = (lane & 15) >> 2, p = lane & 3;
    const s16x4 a = __builtin_amdgcn_ds_read_tr16_b64_v4i16((LAS s16x4*)(img + (r0 + q) * stride + (col0 + 4 * p) * 2));
    const s16x4 b = __builtin_amdgcn_ds_read_tr16_b64_v4i16((LAS s16x4*)(img + (r1 + q) * stride + (col0 + 4 * p) * 2));
    return __builtin_shufflevector(a, b, 0, 1, 2, 3, 4, 5, 6, 7);
}
__device__ __forceinline__ float xsum4(float v) { v += __shfl_xor(v, 16); v += __shfl_xor(v, 32); return v; }
__device__ __forceinline__ float xmax4(float v) { v = fmaxf(v, __shfl_xor(v, 16)); v = fmaxf(v, __shfl_xor(v, 32)); return v; }

constexpr int SWA_VSTRIDE = 144;
constexpr int SWA_V_BYTES = 192 * SWA_VSTRIDE;
__device__ __forceinline__ void swa_unit_mfma(Ctx& C, int l, int unit) {
    const int b = unit >> 7, qb = unit & 127, q0 = qb * 64;
    const int tid = C.tid, lane = C.lane, w = C.wave, c = lane & 15, hq = lane >> 4;
    LAS unsigned char* Vimg = C.lds;
    LAS float* tb = (LAS float*)(C.lds + 30720);
    LAS float* ssqx = (LAS float*)(C.lds + 30720 + 12288);
    const bf16* PROJ = (const bf16*)(C.ws + WS_PROJ); float* OSWA = (float*)(C.ws + WS_OSWA); bf16* Y = (bf16*)(C.ws + WS_Y);
    const bf16* Pb = PROJ + (size_t)b * SEQ * DINP;
    __syncthreads();
    for (int i = tid; i < 16 * 192; i += NTHR) { const int hd = i / 192, x = i % 192, dist = x - 32; tb[i] = (dist >= 0 && dist < 128) ? C.in[I_REL_BIAS][T5_BUCKET[dist] * SWA_H + hd] : 0.f; }
    if (tid < 16 * 9) *(LAS v4u*)(Vimg + (192 + tid / 9) * SWA_VSTRIDE + 16 * (tid % 9)) = (v4u){0u, 0u, 0u, 0u};
    const int g = w >> 1, qhalf = w & 1;
    float ssq0 = 0.f, ssq1 = 0.f;
    for (int kvh = 0; kvh < 4; ++kvh) {
        const int head = kvh * 4 + g;
        __syncthreads();
#pragma unroll
        for (int it = 0; it < 3; ++it) { const int idx = tid + NTHR * it, j = idx >> 3, cg = idx & 7; int s = q0 - 128 + j; s = s < 0 ? 0 : s;
            const v4u v = *(const GAS v4u*)(Pb + (size_t)s * DINP + C_SV + kvh * 64 + 8 * cg); *(LAS v4u*)(Vimg + j * SWA_VSTRIDE + 16 * cg) = v; }
        __syncthreads();
        const float sink = C.in[I_SWA_SINKS][l * SWA_H + head];
#pragma nounroll
        for (int qt = 0; qt < 2; ++qt) {
            const int j0 = 32 * qhalf + 16 * qt;
            const bf16x8 qf0 = gfrag(Pb + C_SQ + head * 64, DINP, q0 + j0, 0, lane), qf1 = gfrag(Pb + C_SQ + head * 64, DINP, q0 + j0, 32, lane);
            f32x4 sacc[10];
#pragma unroll
            for (int kt = 0; kt < 10; ++kt) {
                int srow = q0 - 128 + j0 + 16 * kt + c; srow = srow < 0 ? 0 : srow; srow = srow > q0 + 63 ? q0 + 63 : srow;
                const bf16* kp = Pb + (size_t)srow * DINP + C_SK + kvh * 64 + 8 * hq;
                const bf16x8 k0 = *(const GAS bf16x8*)kp, k1 = *(const GAS bf16x8*)(kp + 32);
                f32x4 a = (f32x4){0.f, 0.f, 0.f, 0.f}; a = mfma16(k0, qf0, a); a = mfma16(k1, qf1, a); sacc[kt] = a;
            }
            float mx = sink;
#pragma unroll
            for (int kt = 0; kt < 10; ++kt)
#pragma unroll
                for (int r = 0; r < 4; ++r) { const int dist = c + 128 - 16 * kt - 4 * hq - r; const int s = q0 - 128 + j0 + 16 * kt + 4 * hq + r;
                    const bool valid = (dist >= 0) && (dist < 128) && (s >= 0);
                    const float sc = valid ? sacc[kt][r] * 0.125f + tb[head * 192 + dist + 32] : -1e30f;
                    sacc[kt][r] = sc; mx = fmaxf(mx, sc); }
            mx = xmax4(mx); float sum = 0.f;
#pragma unroll
            for (int kt = 0; kt < 10; ++kt)
#pragma unroll
                for (int r = 0; r < 4; ++r) { const float p = __expf(sacc[kt][r] - mx); sacc[kt][r] = p; sum += p; }
            sum = xsum4(sum); const float inv = 1.f / (sum + __expf(sink - mx));
            f32x4 oacc[4];
#pragma unroll
            for (int dt = 0; dt < 4; ++dt) oacc[dt] = (f32x4){0.f, 0.f, 0.f, 0.f};
#pragma unroll
            for (int ks = 0; ks < 5; ++ks) { const bf16x8 pf = pack8(sacc[2 * ks], sacc[2 * ks + 1]);
#pragma unroll
                for (int dt = 0; dt < 4; ++dt) oacc[dt] = mfma16(trfrag(Vimg, SWA_VSTRIDE, j0 + 32 * ks + 4 * hq, j0 + 32 * ks + 16 + 4 * hq, 16 * dt, lane), pf, oacc[dt]); }
            float sq = 0.f; float* op = OSWA + (size_t)(b * SEQ + q0 + j0 + c) * SWA_W + head * 64 + 4 * hq;
#pragma unroll
            for (int dt = 0; dt < 4; ++dt) { const f32x4 o = oacc[dt] * inv; sq += (o.x * o.x + o.y * o.y) + (o.z * o.z + o.w * o.w); *(GAS f32x4*)(op + 16 * dt) = o; }
            if (qt == 0) ssq0 += sq; else ssq1 += sq;
        }
    }
    ssq0 = xsum4(ssq0); ssq1 = xsum4(ssq1);
    if (hq == 0) { ssqx[w * 32 + c] = ssq0; ssqx[w * 32 + 16 + c] = ssq1; }
    asm volatile("s_waitcnt vmcnt(0)" ::: "memory");
    __syncthreads();
    const float* swa_norm = C.in[I_SWA_NORM] + (size_t)l * SWA_W;
#pragma nounroll
    for (int qt = 0; qt < 2; ++qt) { const int qi = 16 * qt + c;
        const float tot = ssqx[(qhalf + 0) * 32 + qi] + ssqx[(qhalf + 2) * 32 + qi] + ssqx[(qhalf + 4) * 32 + qi] + ssqx[(qhalf + 6) * 32 + qi];
        const float rstd = 1.f / sqrtf(tot * (1.f / 1024.f) + EPS);
        const size_t row = (size_t)(b * SEQ + q0 + 32 * qhalf + qi);
#pragma unroll
        for (int kvh = 0; kvh < 4; ++kvh)
#pragma unroll
            for (int dt = 0; dt < 4; ++dt) { const int col = (kvh * 4 + g) * 64 + 16 * dt + 4 * hq; const f32x4 o = *(const GAS f32x4*)(OSWA + row * SWA_W + col); const f32x4 gn = *(const GAS f32x4*)(swa_norm + col);
                v2u ow; ow.x = pk2(o.x * rstd * gn.x, o.y * rstd * gn.y); ow.y = pk2(o.z * rstd * gn.z, o.w * rstd * gn.w); *(GAS v2u*)(Y + row * DM + 2048 + col) = ow; } }
}

constexpr int N_SWA_UNITS = BATCH * (SEQ / 64);

constexpr int SSD_L = 128, SSD_NC = SEQ / SSD_L, GLA_L = 64, GLA_NC = SEQ / GLA_L;
constexpr int N_SSD_CU = BATCH * SSD_NC * 8, N_GLA_CU = BATCH * GLA_NC * 4;
constexpr int XI_STRIDE = 528, BI_STRIDE = 272;

__device__ __forceinline__ void prep_phase(Ctx& C, int l) {
    const bf16* PROJ = (const bf16*)(C.ws + WS_PROJ); bf16* XBC = (bf16*)(C.ws + WS_XBC);
    const int tid = C.tid, lane = C.lane;
    { const int gw = C.bid * NWAVES + C.wave;
      if ((gw & 15) == 0 && (gw >> 4) < BATCH * SSD_NC && lane < SSD_H) {
          const int bc = gw >> 4; const size_t row0 = (size_t)bc * SSD_L;
          float* DT = (float*)(C.ws + WS_DT); float* ACS = (float*)(C.ws + WS_ACS); float* DEC = (float*)(C.ws + WS_DEC);
          const float dtb = C.in[I_SSD_DT_BIAS][l * SSD_H + lane], Ah = -expf(C.in[I_SSD_A_LOG][l * SSD_H + lane]);
          float cs = 0.f;
#pragma unroll 8
          for (int s = 0; s < SSD_L; ++s) { const float xr = bf1(PROJ[(row0 + s) * DINP + C_DT + lane]) + dtb; const float dt = xr > 20.f ? xr : log1pf(expf(xr)); cs += dt * Ah;
              DT[(row0 + s) * SSD_H + lane] = dt; ACS[(row0 + s) * SSD_H + lane] = cs; }
          DEC[bc * SSD_H + lane] = expf(cs);
      } }
    { const float* conv_w = C.in[I_SSD_CONV_W] + (size_t)l * 4 * SSD_CD; const float* conv_b = C.in[I_SSD_CONV_B] + (size_t)l * SSD_CD;
      constexpr int NIT = (M / 16) * 512;
      for (int it = C.bid * NTHR + tid; it < NIT; it += C.G * NTHR) {
          const int cg = it & 511, rb = it >> 9, c0 = 8 * cg, t0 = 16 * rb;
          float wv[4][8], bb[8];
#pragma unroll
          for (int i = 0; i < 4; ++i) { const f32x4 a = *(const GAS f32x4*)(conv_w + i * SSD_CD + c0), b2 = *(const GAS f32x4*)(conv_w + i * SSD_CD + c0 + 4);
              wv[i][0] = a.x; wv[i][1] = a.y; wv[i][2] = a.z; wv[i][3] = a.w; wv[i][4] = b2.x; wv[i][5] = b2.y; wv[i][6] = b2.z; wv[i][7] = b2.w; }
          { const f32x4 a = *(const GAS f32x4*)(conv_b + c0), b2 = *(const GAS f32x4*)(conv_b + c0 + 4); bb[0] = a.x; bb[1] = a.y; bb[2] = a.z; bb[3] = a.w; bb[4] = b2.x; bb[5] = b2.y; bb[6] = b2.z; bb[7] = b2.w; }
          float x0[8], x1[8], x2[8];
          const bool first = (t0 % SEQ) == 0;
          { v4u r0 = (v4u){0u, 0u, 0u, 0u}, r1 = r0, r2 = r0;
            if (!first) { r0 = *(const GAS v4u*)(PROJ + (size_t)(t0 - 3) * DINP + C_XBC + c0); r1 = *(const GAS v4u*)(PROJ + (size_t)(t0 - 2) * DINP + C_XBC + c0); r2 = *(const GAS v4u*)(PROJ + (size_t)(t0 - 1) * DINP + C_XBC + c0); }
            x0[0] = bflo(r0.x); x0[1] = bfhi(r0.x); x0[2] = bflo(r0.y); x0[3] = bfhi(r0.y); x0[4] = bflo(r0.z); x0[5] = bfhi(r0.z); x0[6] = bflo(r0.w); x0[7] = bfhi(r0.w);
            x1[0] = bflo(r1.x); x1[1] = bfhi(r1.x); x1[2] = bflo(r1.y); x1[3] = bfhi(r1.y); x1[4] = bflo(r1.z); x1[5] = bfhi(r1.z); x1[6] = bflo(r1.w); x1[7] = bfhi(r1.w);
            x2[0] = bflo(r2.x); x2[1] = bfhi(r2.x); x2[2] = bflo(r2.y); x2[3] = bfhi(r2.y); x2[4] = bflo(r2.z); x2[5] = bfhi(r2.z); x2[6] = bflo(r2.w); x2[7] = bfhi(r2.w); }
#pragma unroll 4
          for (int r = 0; r < 16; ++r) {
              const v4u rw = *(const GAS v4u*)(PROJ + (size_t)(t0 + r) * DINP + C_XBC + c0);
              float x3[8], o[8];
              x3[0] = bflo(rw.x); x3[1] = bfhi(rw.x); x3[2] = bflo(rw.y); x3[3] = bfhi(rw.y); x3[4] = bflo(rw.z); x3[5] = bfhi(rw.z); x3[6] = bflo(rw.w); x3[7] = bfhi(rw.w);
#pragma unroll
              for (int e = 0; e < 8; ++e) { const float a = bb[e] + wv[0][e] * x0[e] + wv[1][e] * x1[e] + wv[2][e] * x2[e] + wv[3][e] * x3[e]; o[e] = silu_f(a); x0[e] = x1[e]; x1[e] = x2[e]; x2[e] = x3[e]; }
              v4u ow; ow.x = pk2(o[0], o[1]); ow.y = pk2(o[2], o[3]); ow.z = pk2(o[4], o[5]); ow.w = pk2(o[6], o[7]);
              *(GAS v4u*)(XBC + (size_t)(t0 + r) * SSD_CD + c0) = ow;
          }
      } }
    { LAS float* glr = (LAS float*)C.lds;
      bf16* QD = (bf16*)(C.ws + WS_QD); bf16* KI = (bf16*)(C.ws + WS_KI); float* GDEC = (float*)(C.ws + WS_GDEC);
      const float* w_gate = C.in[I_GLA_W_GATE] + (size_t)l * 16 * GLA_KT; const float bgv = C.in[I_GLA_B_GATE][l * GLA_KT + tid];
      float wg[16];
#pragma unroll
      for (int r = 0; r < 16; ++r) wg[r] = w_gate[r * GLA_KT + tid];
      for (int ck = C.bid; ck < BATCH * GLA_NC; ck += C.G) {
          const size_t row0 = (size_t)ck * GLA_L;
          __syncthreads();
          if (tid < 128) { const int t = tid >> 1, hf = tid & 1; const v4u r = *(const GAS v4u*)(PROJ + (row0 + t) * DINP + C_GLR + 8 * hf);
              *(LAS f32x4*)(glr + t * 16 + 8 * hf) = (f32x4){bflo(r.x), bfhi(r.x), bflo(r.y), bfhi(r.y)}; *(LAS f32x4*)(glr + t * 16 + 8 * hf + 4) = (f32x4){bflo(r.z), bfhi(r.z), bflo(r.w), bfhi(r.w)}; }
          __syncthreads();
          float cum = 0.f;
#pragma unroll 8
          for (int t = 0; t < GLA_L; ++t) {
              const float qv = bf1(PROJ[(row0 + t) * DINP + C_GQ + tid]), kv = bf1(PROJ[(row0 + t) * DINP + C_GK + tid]);
              float z = bgv;
#pragma unroll
              for (int r4 = 0; r4 < 4; ++r4) { const f32x4 gv = *(const LAS f32x4*)(glr + t * 16 + 4 * r4); z += gv.x * wg[4 * r4] + gv.y * wg[4 * r4 + 1] + gv.z * wg[4 * r4 + 2] + gv.w * wg[4 * r4 + 3]; }
              const float ls = fminf(z, 0.f) - log1pf(expf(-fabsf(z))); cum += ls * 0.0625f;
              const float e = expf(cum);
              QD[(row0 + t) * GLA_KT + tid] = (bf16)f2bf(qv * 0.08838834764831845f * e); KI[(row0 + t) * GLA_KT + tid] = (bf16)f2bf(kv / e);
          }
          GDEC[(size_t)ck * GLA_KT + tid] = expf(cum);
      } }
}

__device__ __forceinline__ void gla_c1_unit(Ctx& C, int unit) {
    const int h = unit & 3, ck = unit >> 2; const size_t row0 = (size_t)ck * GLA_L;
    const int tid = C.tid, lane = C.lane, w = C.wave, c = lane & 15, hq = lane >> 4;
    LAS unsigned char* KEimg = C.lds; LAS unsigned char* Vimg = C.lds + 64 * BI_STRIDE;
    const bf16* PROJ = (const bf16*)(C.ws + WS_PROJ); const bf16* KI = (const bf16*)(C.ws + WS_KI); const float* GDEC = (const float*)(C.ws + WS_GDEC); float* GST = (float*)(C.ws + WS_GST);
    __syncthreads();
    { const int cg = tid & 15; const f32x4 d0 = *(const GAS f32x4*)(GDEC + (size_t)ck * GLA_KT + h * 128 + 8 * cg), d1 = *(const GAS f32x4*)(GDEC + (size_t)ck * GLA_KT + h * 128 + 8 * cg + 4);
#pragma unroll
      for (int it = 0; it < 2; ++it) { const int t = (tid + NTHR * it) >> 4; const v4u r = *(const GAS v4u*)(KI + (row0 + t) * GLA_KT + h * 128 + 8 * cg);
          v4u o; o.x = pk2(bflo(r.x) * d0.x, bfhi(r.x) * d0.y); o.y = pk2(bflo(r.y) * d0.z, bfhi(r.y) * d0.w); o.z = pk2(bflo(r.z) * d1.x, bfhi(r.z) * d1.y); o.w = pk2(bflo(r.w) * d1.z, bfhi(r.w) * d1.w);
          *(LAS v4u*)(KEimg + t * BI_STRIDE + 16 * cg) = o; } }
#pragma unroll
    for (int it = 0; it < 4; ++it) { const int idx = tid + NTHR * it, t = idx >> 5, cg = idx & 31; *(LAS v4u*)(Vimg + t * XI_STRIDE + 16 * cg) = *(const GAS v4u*)(PROJ + (row0 + t) * DINP + C_GV + h * 256 + 8 * cg); }
    __syncthreads();
    f32x4 acc[16];
#pragma unroll
    for (int nt = 0; nt < 16; ++nt) acc[nt] = (f32x4){0.f, 0.f, 0.f, 0.f};
#pragma unroll
    for (int ks = 0; ks < 2; ++ks) { const bf16x8 af = trfrag(KEimg, BI_STRIDE, 32 * ks + 8 * hq, 32 * ks + 8 * hq + 4, 16 * w, lane);
#pragma unroll
        for (int nt = 0; nt < 16; ++nt) acc[nt] = mfma16(af, trfrag(Vimg, XI_STRIDE, 32 * ks + 8 * hq, 32 * ks + 8 * hq + 4, 16 * nt, lane), acc[nt]); }
    float* gp = GST + (size_t)unit * 32768 + 16 * w + 4 * hq;
#pragma unroll
    for (int nt = 0; nt < 16; ++nt) *(GAS f32x4*)(gp + (size_t)(16 * nt + c) * 128) = acc[nt];
}

__device__ __forceinline__ void scan_phase(Ctx& C) {
    const float* GST = (const float*)(C.ws + WS_GST); bf16* GPV = (bf16*)(C.ws + WS_GPV); const float* GDEC = (const float*)(C.ws + WS_GDEC);
    const float* ST = (const float*)(C.ws + WS_ST); bf16* PV = (bf16*)(C.ws + WS_PV); const float* DEC = (const float*)(C.ws + WS_DEC);
    constexpr int N_G = BATCH * 4 * 256 * 32, N_S = BATCH * SSD_H * 64 * 32;
    for (int it = C.bid * NTHR + C.tid; it < N_G + N_S; it += C.G * NTHR) {
        if (it < N_S) {
            const int n4 = it & 31, p = (it >> 5) & 63, h = (it >> 11) & 31, b = it >> 16;
            f32x4 run = (f32x4){0.f, 0.f, 0.f, 0.f};
#pragma unroll 8
            for (int c = 0; c < SSD_NC; ++c) { const size_t u = (size_t)(b * SSD_NC + c) * SSD_H + h; const size_t off = u * 8192 + p * 128 + 4 * n4;
                const f32x4 x = *(const GAS f32x4*)(ST + off); const float d = DEC[u];
                v2u o; o.x = pk2(run.x, run.y); o.y = pk2(run.z, run.w); *(GAS v2u*)(PV + off) = o;
                run = run * d + x; }
        } else {
            const int i2 = it - N_S; const int k4 = i2 & 31, v = (i2 >> 5) & 255, h = (i2 >> 13) & 3, b = i2 >> 15;
            f32x4 run = (f32x4){0.f, 0.f, 0.f, 0.f};
#pragma unroll 8
            for (int c = 0; c < GLA_NC; ++c) { const size_t ck = (size_t)(b * GLA_NC + c); const size_t off = (ck * 4 + h) * 32768 + v * 128 + 4 * k4;
                const f32x4 x = *(const GAS f32x4*)(GST + off); const f32x4 d = *(const GAS f32x4*)(GDEC + ck * GLA_KT + h * 128 + 4 * k4);
                v2u o; o.x = pk2(run.x, run.y); o.y = pk2(run.z, run.w); *(GAS v2u*)(GPV + off) = o;
                run = run * d + x; }
        }
    }
}

__device__ __forceinline__ void gla_c3_unit(Ctx& C, int l, int unit) {
    const int h = unit & 3, ck = unit >> 2; const size_t row0 = (size_t)ck * GLA_L;
    const int tid = C.tid, lane = C.lane, w = C.wave, c = lane & 15, hq = lane >> 4;
    LAS unsigned char* Vimg = C.lds; LAS float* xch = (LAS float*)(C.lds + 64 * XI_STRIDE);
    const bf16* PROJ = (const bf16*)(C.ws + WS_PROJ); const bf16* QD = (const bf16*)(C.ws + WS_QD); const bf16* KI = (const bf16*)(C.ws + WS_KI); const bf16* GPV = (const bf16*)(C.ws + WS_GPV); bf16* Y = (bf16*)(C.ws + WS_Y);
    __syncthreads();
#pragma unroll
    for (int it = 0; it < 4; ++it) { const int idx = tid + NTHR * it, t = idx >> 5, cg = idx & 31; *(LAS v4u*)(Vimg + t * XI_STRIDE + 16 * cg) = *(const GAS v4u*)(PROJ + (row0 + t) * DINP + C_GV + h * 256 + 8 * cg); }
    const int lt = w >> 1, vh = w & 1;
    bf16x8 qf[4];
#pragma unroll
    for (int ks = 0; ks < 4; ++ks) qf[ks] = gfrag(QD + row0 * GLA_KT + h * 128, GLA_KT, 16 * lt, 32 * ks, lane);
    f32x4 att[4];
#pragma unroll
    for (int st = 0; st < 4; ++st) { f32x4 a = (f32x4){0.f, 0.f, 0.f, 0.f};
        if (st <= lt) {
#pragma unroll
            for (int ks = 0; ks < 4; ++ks) a = mfma16(gfrag(KI + row0 * GLA_KT + h * 128, GLA_KT, 16 * st, 32 * ks, lane), qf[ks], a);
#pragma unroll
            for (int r = 0; r < 4; ++r) if (16 * st + 4 * hq + r > 16 * lt + c) a[r] = 0.f;
        }
        att[st] = a; }
    __syncthreads();
    f32x4 oacc[8];
#pragma unroll
    for (int vt = 0; vt < 8; ++vt) oacc[vt] = (f32x4){0.f, 0.f, 0.f, 0.f};
    const bf16* gpv = GPV + (size_t)unit * 32768;
#pragma unroll
    for (int ks = 0; ks < 4; ++ks)
#pragma unroll
        for (int vt = 0; vt < 8; ++vt) oacc[vt] = mfma16(gfrag(gpv, 128, 16 * (8 * vh + vt), 32 * ks, lane), qf[ks], oacc[vt]);
#pragma unroll
    for (int ks2 = 0; ks2 < 2; ++ks2) { const bf16x8 pf = pack8(att[2 * ks2], att[2 * ks2 + 1]);
#pragma unroll
        for (int vt = 0; vt < 8; ++vt) oacc[vt] = mfma16(trfrag(Vimg, XI_STRIDE, 32 * ks2 + 4 * hq, 32 * ks2 + 16 + 4 * hq, 16 * (8 * vh + vt), lane), pf, oacc[vt]); }
    float ssq = 0.f;
#pragma unroll
    for (int vt = 0; vt < 8; ++vt) ssq += (oacc[vt].x * oacc[vt].x + oacc[vt].y * oacc[vt].y) + (oacc[vt].z * oacc[vt].z + oacc[vt].w * oacc[vt].w);
    ssq = xsum4(ssq);
    if (hq == 0) xch[w * 16 + c] = ssq;
    __syncthreads();
    const float rstd = 1.f / sqrtf((xch[w * 16 + c] + xch[(w ^ 1) * 16 + c]) * (1.f / 256.f) + EPS);
    const float* gla_norm = C.in[I_GLA_NORM] + (size_t)l * 256;
    const size_t row = row0 + 16 * lt + c;
#pragma unroll
    for (int vt = 0; vt < 8; ++vt) { const int v0 = 16 * (8 * vh + vt) + 4 * hq; const f32x4 gn = *(const GAS f32x4*)(gla_norm + v0); const v2u gg = *(const GAS v2u*)(PROJ + row * DINP + C_GG + h * 256 + v0);
        const f32x4 o = oacc[vt]; v2u ow; ow.x = pk2(o.x * rstd * gn.x * silu_f(bflo(gg.x)), o.y * rstd * gn.y * silu_f(bfhi(gg.x))); ow.y = pk2(o.z * rstd * gn.z * silu_f(bflo(gg.y)), o.w * rstd * gn.w * silu_f(bfhi(gg.y)));
        *(GAS v2u*)(Y + row * DM + 3072 + h * 256 + v0) = ow; }
}

__device__ __forceinline__ void ssd_c1_unit(Ctx& C, int unit) {
    const int g = unit & 7, bc = unit >> 3; const size_t row0 = (size_t)bc * SSD_L;
    const int tid = C.tid, lane = C.lane, w = C.wave, c = lane & 15, hq = lane >> 4;
    LAS float* acs = (LAS float*)C.lds; LAS float* dts = acs + 512;
    LAS unsigned char* XWimg = C.lds + 4096; LAS unsigned char* Bimg = C.lds + 4096 + 128 * XI_STRIDE;
    const bf16* XBC = (const bf16*)(C.ws + WS_XBC); const float* DT = (const float*)(C.ws + WS_DT); const float* ACS = (const float*)(C.ws + WS_ACS); float* ST = (float*)(C.ws + WS_ST);
    __syncthreads();
    { const int t = tid >> 2, hh = tid & 3; acs[tid] = ACS[(row0 + t) * SSD_H + 4 * g + hh]; dts[tid] = DT[(row0 + t) * SSD_H + 4 * g + hh]; }
    __syncthreads();
#pragma unroll
    for (int it = 0; it < 8; ++it) { const int idx = tid + NTHR * it, t = idx >> 5, cg = idx & 31, hh = cg >> 3; const float wgt = __expf(acs[127 * 4 + hh] - acs[t * 4 + hh]) * dts[t * 4 + hh];
        const v4u r = *(const GAS v4u*)(XBC + (row0 + t) * SSD_CD + g * 256 + 8 * cg);
        v4u o; o.x = pk2(bflo(r.x) * wgt, bfhi(r.x) * wgt); o.y = pk2(bflo(r.y) * wgt, bfhi(r.y) * wgt); o.z = pk2(bflo(r.z) * wgt, bfhi(r.z) * wgt); o.w = pk2(bflo(r.w) * wgt, bfhi(r.w) * wgt);
        *(LAS v4u*)(XWimg + t * XI_STRIDE + 16 * cg) = o; }
#pragma unroll
    for (int it = 0; it < 4; ++it) { const int idx = tid + NTHR * it, t = idx >> 4, cg = idx & 15; *(LAS v4u*)(Bimg + t * BI_STRIDE + 16 * cg) = *(const GAS v4u*)(XBC + (row0 + t) * SSD_CD + 2048 + g * 128 + 8 * cg); }
    __syncthreads();
    const int hh = w >> 1, ph = w & 1;
    f32x4 acc[8][2];
#pragma unroll
    for (int mt = 0; mt < 8; ++mt) { acc[mt][0] = (f32x4){0.f, 0.f, 0.f, 0.f}; acc[mt][1] = (f32x4){0.f, 0.f, 0.f, 0.f}; }
#pragma unroll
    for (int ks = 0; ks < 4; ++ks) { const int r0 = 32 * ks + 8 * hq;
        const bf16x8 x0 = trfrag(XWimg, XI_STRIDE, r0, r0 + 4, hh * 64 + 32 * ph, lane), x1 = trfrag(XWimg, XI_STRIDE, r0, r0 + 4, hh * 64 + 32 * ph + 16, lane);
#pragma unroll
        for (int mt = 0; mt < 8; ++mt) { const bf16x8 bf = trfrag(Bimg, BI_STRIDE, r0, r0 + 4, 16 * mt, lane); acc[mt][0] = mfma16(bf, x0, acc[mt][0]); acc[mt][1] = mfma16(bf, x1, acc[mt][1]); } }
    float* sp = ST + ((size_t)bc * SSD_H + 4 * g + hh) * 8192 + 4 * hq;
#pragma unroll
    for (int mt = 0; mt < 8; ++mt)
#pragma unroll
        for (int pt = 0; pt < 2; ++pt) *(GAS f32x4*)(sp + (size_t)(32 * ph + 16 * pt + c) * 128 + 16 * mt) = acc[mt][pt];
}

__device__ __forceinline__ void ssd_c3_unit(Ctx& C, int l, int unit) {
    const int g = unit & 7, bc = unit >> 3; const size_t row0 = (size_t)bc * SSD_L;
    const int tid = C.tid, lane = C.lane, w = C.wave, c = lane & 15, hq = lane >> 4;
    LAS float* acs = (LAS float*)C.lds; LAS float* dts = acs + 512;
    LAS unsigned char* Ximg = C.lds + 4096;
    const bf16* PROJ = (const bf16*)(C.ws + WS_PROJ); const bf16* XBC = (const bf16*)(C.ws + WS_XBC); const float* DT = (const float*)(C.ws + WS_DT); const float* ACS = (const float*)(C.ws + WS_ACS);
    const bf16* PV = (const bf16*)(C.ws + WS_PV); bf16* Y = (bf16*)(C.ws + WS_Y);
    __syncthreads();
    { const int t = tid >> 2, hh = tid & 3; acs[tid] = ACS[(row0 + t) * SSD_H + 4 * g + hh]; dts[tid] = DT[(row0 + t) * SSD_H + 4 * g + hh]; }
#pragma unroll
    for (int it = 0; it < 8; ++it) { const int idx = tid + NTHR * it, t = idx >> 5, cg = idx & 31; *(LAS v4u*)(Ximg + t * XI_STRIDE + 16 * cg) = *(const GAS v4u*)(XBC + (row0 + t) * SSD_CD + g * 256 + 8 * cg); }
    bf16x8 cf[4];
#pragma unroll
    for (int ks = 0; ks < 4; ++ks) cf[ks] = gfrag(XBC + row0 * SSD_CD + 3072 + g * 128, SSD_CD, 16 * w, 32 * ks, lane);
    f32x4 cb[8];
#pragma unroll
    for (int st = 0; st < 8; ++st) { f32x4 a = (f32x4){0.f, 0.f, 0.f, 0.f};
        if (st <= w) {
#pragma unroll
            for (int ks = 0; ks < 4; ++ks) a = mfma16(gfrag(XBC + row0 * SSD_CD + 2048 + g * 128, SSD_CD, 16 * st, 32 * ks, lane), cf[ks], a);
        }
        cb[st] = a; }
    __syncthreads();
    const int tl = 16 * w + c; const size_t row = row0 + tl;
    float* YT = (float*)(C.ws + WS_ST) + row * SSD_W + g * 256;
    float ssq = 0.f;
#pragma nounroll
    for (int hh = 0; hh < 4; ++hh) {
        const float acs_l = acs[tl * 4 + hh], el = __expf(acs_l);
        const bf16* pv = PV + ((size_t)bc * SSD_H + 4 * g + hh) * 8192;
        f32x4 ya[4];
#pragma unroll
        for (int pt = 0; pt < 4; ++pt) ya[pt] = (f32x4){0.f, 0.f, 0.f, 0.f};
#pragma unroll
        for (int ks = 0; ks < 4; ++ks)
#pragma unroll
            for (int pt = 0; pt < 4; ++pt) ya[pt] = mfma16(gfrag(pv, 128, 16 * pt, 32 * ks, lane), cf[ks], ya[pt]);
#pragma unroll
        for (int pt = 0; pt < 4; ++pt) ya[pt] = ya[pt] * el;
#pragma unroll
        for (int ks2 = 0; ks2 < 4; ++ks2) {
            if (2 * ks2 <= w) {
                f32x4 lm[2];
#pragma unroll
                for (int t2 = 0; t2 < 2; ++t2)
#pragma unroll
                    for (int r = 0; r < 4; ++r) { const int s = 32 * ks2 + 16 * t2 + 4 * hq + r; const float d = fminf(acs_l - acs[s * 4 + hh], 0.f);
                        lm[t2][r] = (s <= tl) ? cb[2 * ks2 + t2][r] * __expf(d) * dts[s * 4 + hh] : 0.f; }
                const bf16x8 pf = pack8(lm[0], lm[1]);
#pragma unroll
                for (int pt = 0; pt < 4; ++pt) ya[pt] = mfma16(trfrag(Ximg, XI_STRIDE, 32 * ks2 + 4 * hq, 32 * ks2 + 16 + 4 * hq, hh * 64 + 16 * pt, lane), pf, ya[pt]);
            }
        }
        const float Dh = C.in[I_SSD_D][l * SSD_H + 4 * g + hh];
#pragma unroll
        for (int pt = 0; pt < 4; ++pt) { const int col = hh * 64 + 16 * pt + 4 * hq; const v2u xw = *(const LAS v2u*)(Ximg + tl * XI_STRIDE + col * 2); const v2u zz = *(const GAS v2u*)(PROJ + row * DINP + C_Z + g * 256 + col);
            f32x4 v; v.x = (ya[pt].x + Dh * bflo(xw.x)) * silu_f(bflo(zz.x)); v.y = (ya[pt].y + Dh * bfhi(xw.x)) * silu_f(bfhi(zz.x)); v.z = (ya[pt].z + Dh * bflo(xw.y)) * silu_f(bflo(zz.y)); v.w = (ya[pt].w + Dh * bfhi(xw.y)) * silu_f(bfhi(zz.y));
            *(GAS f32x4*)(YT + col) = v; ssq += (v.x * v.x + v.y * v.y) + (v.z * v.z + v.w * v.w); }
    }
    ssq = xsum4(ssq);
    const float rstd = 1.f / sqrtf(ssq * (1.f / 256.f) + EPS);
    const float* ssd_norm = C.in[I_SSD_NORM] + (size_t)l * SSD_W + g * 256;
    asm volatile("s_waitcnt vmcnt(0)" ::: "memory");
#pragma unroll 4
    for (int i = 0; i < 16; ++i) { const int col = 16 * i + 4 * hq; const f32x4 gn = *(const GAS f32x4*)(ssd_norm + col); const f32x4 v = *(const GAS f32x4*)(YT + col);
        v2u ow; ow.x = pk2(v.x * rstd * gn.x, v.y * rstd * gn.y); ow.y = pk2(v.z * rstd * gn.z, v.w * rstd * gn.w); *(GAS v2u*)(Y + row * DM + g * 256 + col) = ow; }
}

__device__ __forceinline__ void mix_c1_phase(Ctx& C, int l) {
    for (int u = C.bid; u < N_SSD_CU; u += C.G) ssd_c1_unit(C, u);
    for (int u = C.bid; u < N_GLA_CU; u += C.G) gla_c1_unit(C, u);
    for (int u = C.bid; u < N_SWA_UNITS; u += C.G) swa_unit_mfma(C, l, u);
}
__device__ __forceinline__ void mix_c3_phase(Ctx& C, int l) {
    for (int u = C.bid; u < N_SSD_CU; u += C.G) ssd_c3_unit(C, l, u);
    for (int u = C.bid; u < N_GLA_CU; u += C.G) gla_c3_unit(C, l, u);
}

__device__ __forceinline__ void act_fixup_phase(Ctx& C, int l) {
    bf16* ACT = (bf16*)(C.ws + WS_ACT); const float* HTG = (const float*)(C.ws + WS_HTG); const float* HTU = (const float*)(C.ws + WS_HTU); const float* HBG = (const float*)(C.ws + WS_HBG);
    const float* cw = C.in[I_FFN_CONV_W] + (size_t)l * 3 * DFF; const float* cb = C.in[I_FFN_CONV_B] + (size_t)l * DFF;
    constexpr int NC4 = DFF / 4, NIT = (M / 64) * 2 * NC4;
    for (int it = C.bid * NTHR + C.tid; it < NIT; it += C.G * NTHR) {
        const int c4 = it % NC4, ri = it / NC4, i = ri & 1, blk = ri >> 1, c0 = 4 * c4; const bool first = (blk % (SEQ / 64)) == 0;
        const f32x4 z4 = (f32x4){0.f, 0.f, 0.f, 0.f};
        const f32x4 g0 = *(const GAS f32x4*)(HTG + ((size_t)blk * 2 + i) * DFF + c0), up = *(const GAS f32x4*)(HTU + ((size_t)blk * 2 + i) * DFF + c0);
        const f32x4 pb1 = first ? z4 : *(const GAS f32x4*)(HBG + ((size_t)(blk - 1) * 2 + 1) * DFF + c0), pb0 = first ? z4 : *(const GAS f32x4*)(HBG + ((size_t)(blk - 1) * 2 + 0) * DFF + c0);
        const f32x4 g1 = i ? *(const GAS f32x4*)(HTG + ((size_t)blk * 2 + 0) * DFF + c0) : pb1, g2 = i ? pb1 : pb0;
        const f32x4 w0 = *(const GAS f32x4*)(cw + c0), w1 = *(const GAS f32x4*)(cw + DFF + c0), w2 = *(const GAS f32x4*)(cw + 2 * DFF + c0), bb = *(const GAS f32x4*)(cb + c0);
        f32x4 o;
#pragma unroll
        for (int e = 0; e < 4; ++e) { const float gc = bb[e] + w0[e] * g2[e] + w1[e] * g1[e] + w2[e] * g0[e]; o[e] = silu_f(gc) * up[e]; }
        v2u ow; ow.x = pk2(o.x, o.y); ow.y = pk2(o.z, o.w); *(GAS v2u*)(ACT + (size_t)(64 * blk + i) * DFF + c0) = ow;
    }
}

constexpr int PH_PER_LAYER = 11, PH_FINAL = DEPTH * PH_PER_LAYER, N_PHASES = PH_FINAL + 1;
#ifndef MK_ONE_LAUNCH
#define MK_ONE_LAUNCH 1
#endif
__global__ void __launch_bounds__(NTHR, 2) fwd_kernel(Args args) {
    extern __shared__ __attribute__((aligned(16))) unsigned char lds[];
    Ctx C;
    C.lds = (LAS unsigned char*)lds;
    C.tid = threadIdx.x; C.lane = C.tid & 63; C.wave = __builtin_amdgcn_readfirstlane(C.tid >> 6);
    C.G = gridDim.x; C.bid = blockIdx.x;
    C.in = args.in; C.out = args.out; C.ws = args.ws;
    volatile LAS unsigned* MISC = (volatile LAS unsigned*)(C.lds + MISC_OFF);
    for (int u = C.tid; u < (LDS_BYTES - RING_BYTES) / 4; u += NTHR) ((LAS unsigned*)(C.lds + RING_BYTES))[u] = 0u;
    __syncthreads();
    gu32* ctl = (gu32*)(args.ws + WS_CTL);
    XcdBarrier bar = xcd_barrier_post((unsigned*)(ctl + CW_BAR) + args.li * XCD_BAR_WORDS, MISC + 8);
    const int lo = args.ph_lo, hi = args.ph_hi;
#define IN(k) (lo <= (k) && (k) < hi)
#define SEAM(k) do { if (IN(k) && IN((k) + 1)) xcd_barrier(bar); } while (0)
    float* xres = args.out;
    bf16* H = (bf16*)(args.ws + WS_H);
#define LAYER_BODY(l) do { \
        const int pb = l * PH_PER_LAYER; \
        const float* xin = (l == 0) ? args.in[I_X] : (const float*)xres; \
        if (IN(pb + 0)) { convert_weights(C, l); rmsnorm_phase(C, xin, args.in[I_ATTN_NORM] + (size_t)l * DM, H); } \
        SEAM(pb + 0); \
        if (IN(pb + 1)) { \
            pg8::Gemm g{H, (const bf16*)(args.ws + WS_WIN), M, DINP, DM}; pg8::StaticOrder S; S.init(M, DINP, C.G, C.bid); \
            pg8::EpiBf16 E{(bf16*)(args.ws + WS_PROJ), DINP}; \
            pg8::gemm_phase<pg8::EpiBf16, pg8::StaticOrder, true, true>(C.lds, g, S, E); \
        } \
        SEAM(pb + 1); \
        if (IN(pb + 2)) prep_phase(C, l); \
        SEAM(pb + 2); \
        if (IN(pb + 3)) mix_c1_phase(C, l); \
        SEAM(pb + 3); \
        if (IN(pb + 4)) scan_phase(C); \
        SEAM(pb + 4); \
        if (IN(pb + 5)) mix_c3_phase(C, l); \
        SEAM(pb + 5); \
        if (IN(pb + 6)) { \
            pg8::Gemm g{(const bf16*)(args.ws + WS_Y), (const bf16*)(args.ws + WS_WOUT), M, DM, DM}; pg8::StaticOrder S; S.init(M, DM, C.G, C.bid); \
            pg8::EpiRes E{xin, xres, DM}; \
            pg8::gemm_phase<pg8::EpiRes, pg8::StaticOrder, true, true>(C.lds, g, S, E); \
        } \
        SEAM(pb + 6); \
        if (IN(pb + 7)) rmsnorm_phase(C, xres, args.in[I_FFN_NORM] + (size_t)l * DM, H); \
        SEAM(pb + 7); \
        if (IN(pb + 8)) { \
            pg8::Gemm g{H, (const bf16*)(args.ws + WS_WGU), M, DGU, DM}; pg8::StaticOrder S; S.init(M, DGU, C.G, C.bid); \
            pg8::EpiGateUp E{(bf16*)(args.ws + WS_ACT), args.in[I_FFN_CONV_W] + (size_t)l * 3 * DFF, args.in[I_FFN_CONV_B] + (size_t)l * DFF, (float*)(args.ws + WS_HTG), (float*)(args.ws + WS_HTU), (float*)(args.ws + WS_HBG), DFF}; \
            pg8::gemm_phase<pg8::EpiGateUp, pg8::StaticOrder, true, true>(C.lds, g, S, E); \
        } \
        SEAM(pb + 8); \
        if (IN(pb + 9)) act_fixup_phase(C, l); \
        SEAM(pb + 9); \
        if (IN(pb + 10)) { \
            pg8::Gemm g{(const bf16*)(args.ws + WS_ACT), (const bf16*)(args.ws + WS_WDN), M, DM, DFF}; pg8::StaticOrder S; S.init(M, DM, C.G, C.bid); \
            pg8::EpiRes E{xres, xres, DM}; \
            pg8::gemm_phase<pg8::EpiRes, pg8::StaticOrder, true, true>(C.lds, g, S, E); \
        } \
        SEAM(pb + 10); \
     \
    } while (0)
    LAYER_BODY(0);
    LAYER_BODY(1);
#undef LAYER_BODY
    if (IN(PH_FINAL)) final_norm_phase(C, xres, args.in[I_FINAL_NORM]);
#undef IN
#undef SEAM
}

extern "C" void kernel_launch(void* const* d_in, const int* in_sizes, int n_in, void* d_out, int out_size, void* d_ws, size_t ws_size, hipStream_t stream) {
    static int grid = 0;
    if (grid == 0) {
        if (n_in != N_IN || out_size != M * DM || ws_size < WS_END) { fprintf(stderr, "kernel_launch: unexpected shapes (n_in %d, out %d, ws %zu < %zu)\n", n_in, out_size, ws_size, (size_t)WS_END); grid = -1; return; }
        int dev = 0, cus = 0, per_cu = 0;
        if (hipGetDevice(&dev) != hipSuccess || hipDeviceGetAttribute(&cus, hipDeviceAttributeMultiprocessorCount, dev) != hipSuccess) { grid = -1; return; }
        if (hipFuncSetAttribute((const void*)fwd_kernel, hipFuncAttributeMaxDynamicSharedMemorySize, LDS_BYTES) != hipSuccess) { fprintf(stderr, "kernel_launch: hipFuncSetAttribute failed\n"); grid = -1; return; }
        if (hipOccupancyMaxActiveBlocksPerMultiprocessor(&per_cu, (const void*)fwd_kernel, NTHR, LDS_BYTES) != hipSuccess || per_cu < 1) { fprintf(stderr, "kernel_launch: occupancy query says %d\n", per_cu); (void)hipGetLastError(); grid = -1; return; }
        grid = cus;
    }
    if (grid < 0) return;
    if (hipMemsetAsync((char*)d_ws + WS_CTL, 0, CTL_ZERO_BYTES, stream) != hipSuccess) return;
    Args a{};
    for (int i = 0; i < N_IN; ++i) a.in[i] = (const float*)d_in[i];
    a.out = (float*)d_out; a.ws = (unsigned char*)d_ws; a.pad = 0;
#if MK_ONE_LAUNCH
    a.ph_lo = 0; a.ph_hi = N_PHASES; a.li = 0;
    hipLaunchKernelGGL(fwd_kernel, dim3(grid), dim3(NTHR), LDS_BYTES, stream, a);
#else
    for (int p = 0; p < N_PHASES; ++p) { a.ph_lo = p; a.ph_hi = p + 1; a.li = p;
        hipLaunchKernelGGL(fwd_kernel, dim3(grid), dim3(NTHR), LDS_BYTES, stream, a); }
#endif
}
```

```cpp
#include <hip/hip_runtime.h>
#include <cstdio>
#include <cstdint>
namespace pg8 {
#define PG8_LAS __attribute__((address_space(3)))
typedef unsigned short bf16_t;
typedef short bf16x8 __attribute__((ext_vector_type(8)));
typedef float f32x4 __attribute__((ext_vector_type(4)));
typedef unsigned u32x4 __attribute__((ext_vector_type(4)));
constexpr int BM = 256, BK = 64, HALF = 128, HTB = HALF * BK * 2  , STAGE_BYTES = 8 * HTB, NXCD = 8, WGM = 8;

__host__ __device__ __forceinline__ int lds_byte(int r, int c) { const int st = (r >> 4) * 2 + (c >> 5), rr = r & 15, cc = c & 31, ob = rr * 64 + cc * 2; return st * 1024 + (ob ^ (((ob >> 9) & 1) << 5)); }
__host__ __device__ __forceinline__ void stage_rc(int b, int& R, int& C) { const int st = b / 1024, sb = b % 1024, swz = sb ^ (((sb >> 9) & 1) << 5); R = (st >> 1) * 16 + swz / 64; C = (st & 1) * 32 + (swz % 64) / 2; }
__host__ __device__ __forceinline__ int perm32(int rho) { const int n = rho >> 4, i = rho & 15; return 8 * (i >> 2) + 4 * n + (i & 3); }

struct Unit { int pm, pn; };
struct Gemm { const bf16_t* A; const bf16_t* Bt; int M, N, K; };

struct StaticOrder {
    int nM, nN, nwg, G, c;
    __host__ __device__ void init(int M, int N, int G_, int c_) { nM = M / BM; nN = N / BM; nwg = nM * nN; G = G_; c = c_; }
    __host__ __device__ bool next(int i, Unit& u) const {
        const long L = (long)i * G + c; if (L >= nwg) return false;
        int wgid = (int)L; { const int q = nwg / NXCD, r = nwg % NXCD, xcd = wgid % NXCD, off = wgid / NXCD; wgid = (xcd < r ? xcd * (q + 1) : r * (q + 1) + (xcd - r) * q) + off; }
        const int nig = WGM * nN, gid = wgid / nig, fm = gid * WGM, gsz = (nM - fm) < WGM ? (nM - fm) : WGM;
        u.pm = fm + ((wgid % nig) % gsz); u.pn = (wgid % nig) / gsz; return true;
    }
    __device__ __forceinline__ void a_ready(const Unit&) const {}
    __device__ __forceinline__ void done(const Unit&) const {}
};

__device__ __forceinline__ unsigned cvt_pk_bf16(float lo, float hi) { unsigned r; asm volatile("v_cvt_pk_bf16_f32 %0, %1, %2" : "=v"(r) : "v"(lo), "v"(hi)); return r; }

struct EpiBf16 {
    static constexpr bool PERM = true, AFTER_DRAIN = false;
    bf16_t* O; int ldc;
    __device__ __forceinline__ void operator()(const f32x4 (&acc)[2][2][4][2], const Unit& u, int wr, int wc, int fr, int fq) const {
        const int row0 = u.pm * BM + wr * 64 + fr; const int col0 = u.pn * BM + wc * 32 + 8 * fq;
#pragma unroll
        for (int ai = 0; ai < 2; ++ai)
#pragma unroll
            for (int m = 0; m < 4; ++m) { bf16_t* rowp = O + (size_t)(row0 + ai * HALF + m * 16) * ldc + col0;
#pragma unroll
                for (int bj = 0; bj < 2; ++bj) { const f32x4 v0 = acc[ai][bj][m][0], v1 = acc[ai][bj][m][1];
                    u32x4 w; w.x = cvt_pk_bf16(v0[0], v0[1]); w.y = cvt_pk_bf16(v0[2], v0[3]); w.z = cvt_pk_bf16(v1[0], v1[1]); w.w = cvt_pk_bf16(v1[2], v1[3]);
                    *(u32x4*)(rowp + bj * HALF) = w; } }
    }
};
template <int CTRL> __device__ __forceinline__ float dpp_old(float old, float v) { return __int_as_float(__builtin_amdgcn_update_dpp(__float_as_int(old), __float_as_int(v), CTRL, 0xf, 0xf, false)); }
struct EpiGateUp {
    static constexpr bool PERM = true, AFTER_DRAIN = false;
    bf16_t* ACT; const float* cw; const float* cb; float* HTG; float* HTU; float* HBG; int dff;
    __device__ __forceinline__ void operator()(const f32x4 (&acc)[2][2][4][2], const Unit& u, int wr, int wc, int fr, int fq) const {
        const int j0 = u.pn * 128 + wc * 32 + 8 * fq;
        float w0[8], w1[8], w2[8], bb[8];
#pragma unroll
        for (int h = 0; h < 2; ++h) { const f32x4 a = *(const f32x4*)(cw + j0 + 4 * h), b = *(const f32x4*)(cw + dff + j0 + 4 * h), c = *(const f32x4*)(cw + 2 * dff + j0 + 4 * h), d = *(const f32x4*)(cb + j0 + 4 * h);
#pragma unroll
            for (int e = 0; e < 4; ++e) { w0[4 * h + e] = a[e]; w1[4 * h + e] = b[e]; w2[4 * h + e] = c[e]; bb[4 * h + e] = d[e]; } }
#pragma unroll
        for (int ai = 0; ai < 2; ++ai) {
            const int rowb = u.pm * BM + ai * HALF + wr * 64; const size_t blk = (size_t)(rowb >> 6);
#pragma unroll
            for (int m = 0; m < 4; ++m) {
                const int row = rowb + 16 * m + fr; float o[8];
#pragma unroll
                for (int n = 0; n < 2; ++n)
#pragma unroll
                    for (int e = 0; e < 4; ++e) { const int k = 4 * n + e; const float g0 = acc[ai][0][m][n][e], up = acc[ai][1][m][n][e]; const float gp = m > 0 ? acc[ai][0][m > 0 ? m - 1 : 0][n][e] : 0.f;
                        const float g1 = dpp_old<0x111>(dpp_old<0x121>(0.f, gp), g0), g2 = dpp_old<0x112>(dpp_old<0x122>(0.f, gp), g0);
                        const float gc = bb[k] + w0[k] * g2 + w1[k] * g1 + w2[k] * g0; o[k] = gc / (1.f + __expf(-gc)) * up; }
                u32x4 w; w.x = cvt_pk_bf16(o[0], o[1]); w.y = cvt_pk_bf16(o[2], o[3]); w.z = cvt_pk_bf16(o[4], o[5]); w.w = cvt_pk_bf16(o[6], o[7]);
                *(u32x4*)(ACT + (size_t)row * dff + j0) = w;
                if (m == 0 && fr < 2) { float* pg = HTG + (blk * 2 + fr) * dff + j0; float* pu = HTU + (blk * 2 + fr) * dff + j0;
                    *(f32x4*)pg = acc[ai][0][0][0]; *(f32x4*)(pg + 4) = acc[ai][0][0][1]; *(f32x4*)pu = acc[ai][1][0][0]; *(f32x4*)(pu + 4) = acc[ai][1][0][1]; }
                if (m == 3 && fr >= 14) { float* pg = HBG + (blk * 2 + (fr - 14)) * dff + j0; *(f32x4*)pg = acc[ai][0][3][0]; *(f32x4*)(pg + 4) = acc[ai][0][3][1]; }
            }
        }
    }
};
struct EpiRes {
    static constexpr bool PERM = false, AFTER_DRAIN = false;
    const float* base; float* out; int ldc;
    __device__ __forceinline__ void operator()(const f32x4 (&acc)[2][2][4][2], const Unit& u, int wr, int wc, int fr, int fq) const {
        const int row0 = u.pm * BM + wr * 64 + fr, col0 = u.pn * BM + wc * 32 + 4 * fq;
#pragma unroll
        for (int ai = 0; ai < 2; ++ai)
#pragma unroll
            for (int m = 0; m < 4; ++m) { const size_t off = (size_t)(row0 + ai * HALF + m * 16) * ldc + col0;
#pragma unroll
                for (int bj = 0; bj < 2; ++bj)
#pragma unroll
                    for (int n = 0; n < 2; ++n) { const f32x4 bs = *(const f32x4*)(base + off + bj * HALF + n * 16); *(f32x4*)(out + off + bj * HALF + n * 16) = bs + acc[ai][bj][m][n]; } }
    }
};
template <class Epi, class Sched, bool ALIGN_EPI = false, bool SP2 = false>
__device__ __forceinline__ void gemm_phase(PG8_LAS unsigned char* lds, const Gemm g, const Sched& S, const Epi& E) {
    const int tid = threadIdx.x, wid = __builtin_amdgcn_readfirstlane(tid >> 6), lane = tid & 63, wr = wid >> 2, wc = wid & 3, fr = lane & 15, fq = lane >> 4;
    const int K = g.K, nt = K / BK;
    unsigned voffA[2], voffB[2];
#pragma unroll
    for (int i = 0; i < 2; ++i) { int R, C; stage_rc(tid * 16 + i * 8192, R, C); const int Rb = Epi::PERM ? ((R & ~31) + perm32(R & 31)) : R;
        voffA[i] = (unsigned)(R * K + C) * 2u; voffB[i] = (unsigned)(Rb * K + C) * 2u; }
    const size_t kstep = (size_t)(BK * 2);
    const size_t hstep = (size_t)HALF * K * 2;
    const size_t tstep = 2 * hstep;
    const unsigned ldsw = (unsigned)wid * 1024u;
    const int aoff = lds_byte(wr * 64 + fr, fq * 8), boff = lds_byte(wc * 32 + fr, fq * 8);
#define PG8_SA(b, h) (((b) * 2 + (h)) * HTB)
#define PG8_SB(b, h) ((4 + (b) * 2 + (h)) * HTB)
#define PG8_STAGE(bufoff, gbase, voff) do { _Pragma("unroll") for (int _i = 0; _i < 2; ++_i) \
        __builtin_amdgcn_global_load_lds((const unsigned*)((const char*)(gbase) + (voff)[_i]), (PG8_LAS unsigned*)(lds + (bufoff) + ldsw + _i * 8192), 16, 0, 0); } while (0)
#define PG8_LDA(dst, b, h) do { _Pragma("unroll") for (int m = 0; m < 4; ++m) _Pragma("unroll") for (int k = 0; k < 2; ++k) dst[m][k] = *(const PG8_LAS bf16x8*)(lds + PG8_SA(b, h) + aoff + m * 2048 + k * 1024); } while (0)
#define PG8_LDB(dst, b, h) do { _Pragma("unroll") for (int n = 0; n < 2; ++n) _Pragma("unroll") for (int k = 0; k < 2; ++k) dst[n][k] = *(const PG8_LAS bf16x8*)(lds + PG8_SB(b, h) + boff + n * 2048 + k * 1024); } while (0)
#define PG8_MMA(ai, bj, At, Bt) do { __builtin_amdgcn_s_setprio(1); _Pragma("unroll") for (int m = 0; m < 4; ++m) _Pragma("unroll") for (int n = 0; n < 2; ++n) _Pragma("unroll") for (int k = 0; k < 2; ++k) \
        acc[ai][bj][m][n] = __builtin_amdgcn_mfma_f32_16x16x32_bf16(Bt[n][k], At[m][k], acc[ai][bj][m][n], 0, 0, 0); __builtin_amdgcn_s_setprio(0); } while (0)
#define PG8_WAIT_V(n) asm volatile("s_waitcnt vmcnt(" #n ")" ::: "memory")
#define PG8_WAIT_L(n) asm volatile("s_waitcnt lgkmcnt(" #n ")" ::: "memory")
#define PG8_BAR __builtin_amdgcn_s_barrier()
#define PG8_SCHED __builtin_amdgcn_sched_barrier(0)
    Unit cur, nxt; int ui = 0;
    if (!S.next(0, cur)) return;
    f32x4 acc[2][2][4][2];
#pragma unroll
    for (int a = 0; a < 2; ++a)
#pragma unroll
        for (int b = 0; b < 2; ++b)
#pragma unroll
            for (int m = 0; m < 4; ++m)
#pragma unroll
                for (int n = 0; n < 2; ++n) acc[a][b][m][n] = (f32x4){0.f, 0.f, 0.f, 0.f};
    bf16x8 At[4][2], B0[2][2], B1[2][2];
    const char* cA = (const char*)g.A + (size_t)cur.pm * tstep; const char* cB = (const char*)g.Bt + (size_t)cur.pn * tstep;
    S.a_ready(cur);
    if constexpr (SP2) {
        PG8_STAGE(PG8_SB(0, 0), cB, voffB); PG8_STAGE(PG8_SB(0, 1), cB + hstep, voffB); PG8_STAGE(PG8_SA(0, 0), cA, voffA); PG8_STAGE(PG8_SA(0, 1), cA + hstep, voffA);
        if (wr == 1) PG8_BAR;
        PG8_WAIT_V(2); PG8_BAR;
        PG8_STAGE(PG8_SB(1, 0), cB + kstep, voffB); PG8_STAGE(PG8_SA(1, 0), cA + kstep, voffA); PG8_STAGE(PG8_SB(1, 1), cB + hstep + kstep, voffB);
        PG8_WAIT_V(6); PG8_BAR;
    } else {
        PG8_STAGE(PG8_SB(0, 0), cB, voffB); PG8_STAGE(PG8_SA(0, 0), cA, voffA); PG8_STAGE(PG8_SB(0, 1), cB + hstep, voffB); PG8_STAGE(PG8_SA(0, 1), cA + hstep, voffA);
        if (wr == 1) PG8_BAR;
        PG8_WAIT_V(4); PG8_BAR;
        PG8_STAGE(PG8_SB(1, 0), cB + kstep, voffB); PG8_STAGE(PG8_SA(1, 0), cA + kstep, voffA); PG8_STAGE(PG8_SB(1, 1), cB + hstep + kstep, voffB);
        PG8_WAIT_V(6); PG8_BAR;
    }
    for (;;) {
        const bool has_next = S.next(ui + 1, nxt);
        const char* nA = has_next ? (const char*)g.A + (size_t)nxt.pm * tstep : cA; const char* nB = has_next ? (const char*)g.Bt + (size_t)nxt.pn * tstep : cB;
        for (int t = 0; t < nt; t += 2) {
            const bool last = (t == nt - 2);
            const char* a1 = cA + (size_t)(t + 1) * kstep;
            const char* a2 = last ? nA : cA + (size_t)(t + 2) * kstep; const char* b2 = last ? nB : cB + (size_t)(t + 2) * kstep;
            const char* a3 = a2 + kstep; const char* b3 = b2 + kstep;
            if (last && has_next) S.a_ready(nxt);
            if constexpr (SP2) {
            PG8_LDB(B0, 0, 0); PG8_LDB(B1, 0, 1); PG8_SCHED; PG8_LDA(At, 0, 0); PG8_STAGE(PG8_SA(1, 1), a1 + hstep, voffA);
            PG8_WAIT_V(8); PG8_WAIT_L(0); PG8_BAR; PG8_MMA(0, 0, At, B0); PG8_MMA(0, 1, At, B1); PG8_BAR; PG8_SCHED;
            PG8_LDA(At, 0, 1); PG8_STAGE(PG8_SB(0, 0), b2, voffB); PG8_STAGE(PG8_SB(0, 1), b2 + hstep, voffB); PG8_STAGE(PG8_SA(0, 0), a2, voffA);
            PG8_WAIT_V(8); PG8_WAIT_L(0); PG8_BAR; PG8_MMA(1, 0, At, B0); PG8_MMA(1, 1, At, B1); PG8_BAR; PG8_SCHED;
            PG8_LDB(B0, 1, 0); PG8_LDB(B1, 1, 1); PG8_SCHED; PG8_LDA(At, 1, 0); PG8_STAGE(PG8_SA(0, 1), a2 + hstep, voffA);
            PG8_WAIT_V(8); PG8_WAIT_L(0); PG8_BAR; PG8_MMA(0, 0, At, B0); PG8_MMA(0, 1, At, B1); PG8_BAR; PG8_SCHED;
            PG8_LDA(At, 1, 1); PG8_STAGE(PG8_SB(1, 0), b3, voffB); PG8_STAGE(PG8_SB(1, 1), b3 + hstep, voffB); PG8_STAGE(PG8_SA(1, 0), a3, voffA);
            PG8_WAIT_V(8); PG8_WAIT_L(0); PG8_BAR; PG8_MMA(1, 0, At, B0); PG8_MMA(1, 1, At, B1); PG8_BAR; PG8_SCHED;
            } else {
            PG8_LDB(B0, 0, 0); PG8_SCHED; PG8_LDA(At, 0, 0); PG8_STAGE(PG8_SA(1, 1), a1 + hstep, voffA);
            PG8_WAIT_L(8); PG8_BAR; PG8_WAIT_L(0); PG8_MMA(0, 0, At, B0); PG8_BAR; PG8_SCHED;
            PG8_LDB(B1, 0, 1); PG8_STAGE(PG8_SB(0, 0), b2, voffB);
            PG8_BAR; PG8_WAIT_L(0); PG8_MMA(0, 1, At, B1); PG8_BAR;
            PG8_LDA(At, 0, 1); PG8_STAGE(PG8_SA(0, 0), a2, voffA);
            PG8_BAR; PG8_WAIT_L(0); PG8_MMA(1, 0, At, B0); PG8_BAR; PG8_SCHED;
            PG8_STAGE(PG8_SB(0, 1), b2 + hstep, voffB);
            PG8_WAIT_V(6); PG8_BAR; PG8_MMA(1, 1, At, B1); PG8_BAR;
            PG8_LDB(B0, 1, 0); PG8_SCHED; PG8_LDA(At, 1, 0); PG8_STAGE(PG8_SA(0, 1), a2 + hstep, voffA);
            PG8_WAIT_L(8); PG8_BAR; PG8_WAIT_L(0); PG8_MMA(0, 0, At, B0); PG8_BAR; PG8_SCHED;
            PG8_LDB(B1, 1, 1); PG8_STAGE(PG8_SB(1, 0), b3, voffB);
            PG8_BAR; PG8_WAIT_L(0); PG8_MMA(0, 1, At, B1); PG8_BAR;
            PG8_LDA(At, 1, 1); PG8_STAGE(PG8_SA(1, 0), a3, voffA);
            PG8_BAR; PG8_WAIT_L(0); PG8_MMA(1, 0, At, B0); PG8_BAR; PG8_SCHED;
            PG8_STAGE(PG8_SB(1, 1), b3 + hstep, voffB);
            PG8_WAIT_V(6); PG8_BAR; PG8_MMA(1, 1, At, B1); PG8_BAR;
            }
        }
        if constexpr (ALIGN_EPI) { if (wr == 0) PG8_BAR; }
        if constexpr (!Epi::AFTER_DRAIN) { E(acc, cur, wr, wc, fr, fq); S.done(cur); }
        if (!has_next) break;
#pragma unroll
        for (int a = 0; a < 2; ++a)
#pragma unroll
            for (int b = 0; b < 2; ++b)
#pragma unroll
                for (int m = 0; m < 4; ++m)
#pragma unroll
                    for (int n = 0; n < 2; ++n) acc[a][b][m][n] = (f32x4){0.f, 0.f, 0.f, 0.f};
        cur = nxt; cA = nA; cB = nB; ++ui;
        if constexpr (ALIGN_EPI) { if (wr == 1) PG8_BAR; }
    }
    PG8_WAIT_V(0);
    if constexpr (!ALIGN_EPI) { if (wr == 0) PG8_BAR; }
    PG8_BAR;
    if constexpr (Epi::AFTER_DRAIN) { E.fused(acc, cur, wr, wc, fr, fq, lds, wid, lane); S.done(cur); }
#undef PG8_SA
#undef PG8_SB
#undef PG8_STAGE
#undef PG8_LDA
#undef PG8_LDB
#undef PG8_MMA
#undef PG8_WAIT_V
#undef PG8_WAIT_L
#undef PG8_BAR
#undef PG8_SCHED
}
}

constexpr int NWAVES = 8, NTHR = NWAVES * 64;
constexpr int BATCH = 2, SEQ = 8192, M = BATCH * SEQ, DM = 4096, DEPTH = 2;
constexpr int SSD_W = 2048, SSD_H = 32, SSD_CD = 4096;
constexpr int SWA_W = 1024, SWA_H = 16;
constexpr int GLA_W = 1024, GLA_KT = 512;
constexpr int DFF = 11008, DIN = 10800, DINP = 11008, DGU = 2 * DFF;
constexpr float EPS = 1e-6f;
constexpr int C_Z = 0, C_XBC = 2048, C_DT = 6144, C_SQ = 6176, C_SK = 7200, C_SV = 7456, C_GQ = 7712, C_GK = 8224, C_GV = 8736, C_GG = 9760, C_GLR = 10784;
enum { I_X = 0, I_ATTN_NORM, I_W_IN, I_SSD_CONV_W, I_SSD_CONV_B, I_SSD_DT_BIAS, I_SSD_A_LOG, I_SSD_D, I_SSD_NORM, I_SWA_SINKS, I_SWA_NORM, I_GLA_W_GATE, I_GLA_B_GATE, I_GLA_NORM,
       I_W_OUT, I_FFN_NORM, I_W_GATE, I_W_UP, I_FFN_CONV_W, I_FFN_CONV_B, I_W_DOWN, I_REL_BIAS, I_FINAL_NORM, N_IN };

constexpr size_t MiB = 1u << 20;
constexpr size_t WS_CTL = 0, CTL_ZERO_BYTES = 1 * MiB;
constexpr size_t WS_WIN = 1 * MiB;
constexpr size_t WS_WOUT = 87 * MiB;
constexpr size_t WS_WGU = 119 * MiB;
constexpr size_t WS_WDN = 291 * MiB;
constexpr size_t WS_H = 377 * MiB;
constexpr size_t WS_R = 505 * MiB;
constexpr size_t WS_PROJ = WS_R;
constexpr size_t WS_XBC = WS_R + 344 * MiB;
constexpr size_t WS_QD = WS_R + 472 * MiB;
constexpr size_t WS_KI = WS_R + 488 * MiB;
constexpr size_t WS_DT = WS_R + 520 * MiB;
constexpr size_t WS_ACS = WS_R + 522 * MiB;
constexpr size_t WS_DEC = WS_R + 524 * MiB;
constexpr size_t WS_GDEC = WS_R + 525 * MiB;
constexpr size_t WS_ST = WS_R + 528 * MiB;
constexpr size_t WS_PV = WS_R + 656 * MiB;
constexpr size_t WS_GST = WS_R + 720 * MiB;
constexpr size_t WS_GPV = WS_R + 848 * MiB;
constexpr size_t WS_OSWA = WS_R + 912 * MiB;
constexpr size_t WS_Y = WS_R + 976 * MiB;
constexpr size_t WS_ACT = WS_R + 688 * MiB;
constexpr size_t WS_HTG = WS_R + 1032 * MiB, WS_HTU = WS_R + 1054 * MiB, WS_HBG = WS_R + 1076 * MiB;
constexpr size_t WS_END = WS_R + 1104 * MiB;
static_assert(DEPTH == 2 && (size_t)DINP * DM * 2 == 86 * MiB && (size_t)DGU * DM * 2 == 172 * MiB && (size_t)M * DINP * 2 == 344 * MiB , "ws map");
constexpr int CW_BAR = 4096;

constexpr int RING_BYTES = 131072;
constexpr int MISC_OFF = 147456 - 256;
constexpr int LDS_BYTES = 147456;

#define GAS __attribute__((address_space(1)))
#define LAS __attribute__((address_space(3)))
typedef unsigned short bf16;
typedef unsigned v4u __attribute__((ext_vector_type(4)));
typedef unsigned v2u __attribute__((ext_vector_type(2)));
typedef float f32x4 __attribute__((ext_vector_type(4)));
typedef GAS unsigned gu32;
#define RLX_AGENT __ATOMIC_RELAXED, __HIP_MEMORY_SCOPE_AGENT
#define LDS_WAIT() asm volatile("s_waitcnt lgkmcnt(0)" ::: "memory")
__device__ __forceinline__ unsigned f2bf(float f) { unsigned u = __builtin_bit_cast(unsigned, f); return (u + 0x7fffu + ((u >> 16) & 1u)) >> 16; }
__device__ __forceinline__ unsigned pk2(float lo, float hi) { return f2bf(lo) | (f2bf(hi) << 16); }
__device__ __forceinline__ float bflo(unsigned w) { return __uint_as_float(w << 16); }
__device__ __forceinline__ float bfhi(unsigned w) { return __uint_as_float(w & 0xffff0000u); }
__device__ __forceinline__ float bf1(bf16 h) { return __uint_as_float((unsigned)h << 16); }
__device__ __forceinline__ float silu_f(float x) { return x / (1.f + __expf(-x)); }
__device__ __forceinline__ float wave_sum(float v) {
#pragma unroll
    for (int o = 1; o < 64; o <<= 1) v += __shfl_xor(v, o);
    return v;
}
template <int CTRL> __device__ __forceinline__ float dpp_f(float v) { return __int_as_float(__builtin_amdgcn_update_dpp(0, __float_as_int(v), CTRL, 0xf, 0xf, false)); }
__device__ __forceinline__ float row16_sum(float v) { v += dpp_f<0xB1>(v); v += dpp_f<0x4E>(v); v += dpp_f<0x124>(v); v += dpp_f<0x128>(v); return v; }
__device__ __forceinline__ float pair_sum(float v) { return v + dpp_f<0xB1>(v); }
#define XB_TMO      128
#define XB_XCNT(j)  (256  + 64 * (j))
#define XB_XSUB(j)  (1280 + 64 * (j))
#define XB_XGEN(j)  (2304 + 64 * (j))
#define XB_TOP      3328
#define XB_TOPGEN   3392
#define XCD_BAR_WORDS 3456
#define XB_SPIN_CAP (1u << 18)

__device__ __forceinline__ unsigned xb_ld(unsigned* p)              { return __hip_atomic_load(p, __ATOMIC_RELAXED, __HIP_MEMORY_SCOPE_AGENT); }
__device__ __forceinline__ unsigned xb_add(unsigned* p, unsigned v) { return __hip_atomic_fetch_add(p, v, __ATOMIC_RELAXED, __HIP_MEMORY_SCOPE_AGENT); }
__device__ __forceinline__ unsigned xb_xcc_id() { return (unsigned)__builtin_amdgcn_s_getreg((3 << 11) | 20) & 0xFu; }
#define XB_SPIN(cond, bar) do { unsigned _sp = 0; while (cond) { __builtin_amdgcn_s_sleep(1); \
    if ((++_sp & 255u) == 0u) { if (xb_ld(&(bar)[XB_TMO])) break; if (_sp > XB_SPIN_CAP) { atomicAdd(&(bar)[XB_TMO], 1u); break; } } } } while (0)

struct XcdBarrier {
    unsigned* bar; unsigned x;
    volatile LAS unsigned* st;
};

__device__ __forceinline__ XcdBarrier xcd_barrier_post(unsigned* bar, volatile LAS unsigned* st) {
    XcdBarrier b; b.bar = bar; b.x = xb_xcc_id(); b.st = st;
    if (threadIdx.x == 0) (void)xb_add(&bar[XB_XCNT(b.x)], 1u);
    return b;
}
__device__ __forceinline__ void xcd_barrier_complete(unsigned* bar, unsigned x, unsigned& nloc, unsigned& nx) {
    const unsigned G = gridDim.x * gridDim.y * gridDim.z;
    unsigned sum, cnt, mine, sp = 0u;
    for (;;) {
        sum = 0u; cnt = 0u; mine = 0u;
#pragma unroll
        for (unsigned j = 0; j < 16; ++j) { const unsigned c = xb_ld(&bar[XB_XCNT(j)]); sum += c; cnt += (c > 0u) ? 1u : 0u; mine = (j == x) ? c : mine; }
        if (sum == G) break;
        __builtin_amdgcn_s_sleep(1);
        if ((++sp & 255u) == 0u) { if (xb_ld(&bar[XB_TMO])) break; if (sp > XB_SPIN_CAP) { atomicAdd(&bar[XB_TMO], 1u); break; } }
    }
    nloc = mine > 0u ? mine : 1u; nx = cnt > 0u ? cnt : 1u;
}

__device__ __forceinline__ void xcd_barrier(const XcdBarrier& b) {
    asm volatile("s_waitcnt vmcnt(0)" ::: "memory");
    __syncthreads();
    if (threadIdx.x == 0) {
        unsigned* bar = b.bar;
        __builtin_amdgcn_s_waitcnt(0);
        unsigned nloc = b.st[0], nx = b.st[1];
        if (nloc == 0u) { xcd_barrier_complete(bar, b.x, nloc, nx); b.st[0] = nloc; b.st[1] = nx; }
        const unsigned old = xb_add(&bar[XB_XSUB(b.x)], 1u);
        const unsigned gen = old / nloc;
        if (old + 1u == (gen + 1u) * nloc) {
            __builtin_amdgcn_fence(__ATOMIC_RELEASE, "agent");
            asm volatile("s_waitcnt vmcnt(0)" ::: "memory");
            const unsigned og = xb_add(&bar[XB_TOP], 1u);
            const unsigned tg = og / nx;
            if (og + 1u == (tg + 1u) * nx) xb_add(&bar[XB_TOPGEN], 1u);
            else XB_SPIN(xb_ld(&bar[XB_TOPGEN]) == tg, bar);
            __builtin_amdgcn_fence(__ATOMIC_ACQUIRE, "agent");
            xb_add(&bar[XB_XGEN(b.x)], 1u);
            asm volatile("s_waitcnt vmcnt(0)" ::: "memory");
        } else {
            XB_SPIN(xb_ld(&bar[XB_XGEN(b.x)]) == gen, bar);
            __builtin_amdgcn_fence(__ATOMIC_ACQUIRE, "agent");
            asm volatile("s_waitcnt vmcnt(0)" ::: "memory");
        }
    }
    __syncthreads();
}

struct Args { const float* in[N_IN]; float* out; unsigned char* ws; int ph_lo, ph_hi, li, pad; };
struct Ctx {
    LAS unsigned char* lds;
    int tid, lane, wave, G, bid;
    const float* const* in; float* out; unsigned char* ws;
};
__device__ const unsigned char T5_BUCKET[128] = {0, 1, 2, 3, 4, 5, 6, 7, 8, 9, 10, 11, 12, 13, 14, 15, 16, 16, 16, 17, 17, 18, 18, 18, 19, 19, 19, 20, 20, 20, 20, 21, 21, 21, 21, 22, 22, 22, 22, 22, 23, 23, 23, 23, 23, 23, 24, 24, 24, 24, 24, 24, 25, 25, 25, 25, 25, 25, 25, 26, 26, 26, 26, 26, 26, 26, 26, 27, 27, 27, 27, 27, 27, 27, 27, 27, 27, 28, 28, 28, 28, 28, 28, 28, 28, 28, 28, 29, 29, 29, 29, 29, 29, 29, 29, 29, 29, 29, 29, 30, 30, 30, 30, 30, 30, 30, 30, 30, 30, 30, 30, 30, 30, 31, 31, 31, 31, 31, 31, 31, 31, 31, 31, 31, 31, 31, 31, 31};

struct TItem { const float* src; bf16* dst; int N, K, nvalid; };
constexpr int CV_NITEMS = 32 * 86 * 3 + 32 * 32 + 86 * 32;
__device__ __forceinline__ TItem titem_decode(Ctx& C, int l, int it) {
    constexpr int I_IN = 32 * 86, I_OUT = 32 * 32, I_G = 32 * 86;
    TItem t; int r = it, kb, nb;
    if (r < I_IN) { kb = r / 86; nb = r % 86; t.N = DIN; t.K = DM; t.src = C.in[I_W_IN] + (size_t)l * DM * DIN; t.dst = (bf16*)(C.ws + WS_WIN) + (size_t)(128 * nb) * DM; }
    else if ((r -= I_IN) < I_OUT) { kb = r / 32; nb = r % 32; t.N = DM; t.K = DM; t.src = C.in[I_W_OUT] + (size_t)l * DM * DM; t.dst = (bf16*)(C.ws + WS_WOUT) + (size_t)(128 * nb) * DM; }
    else if ((r -= I_OUT) < I_G) { kb = r / 86; nb = r % 86; t.N = DFF; t.K = DM; t.src = C.in[I_W_GATE] + (size_t)l * DM * DFF; t.dst = (bf16*)(C.ws + WS_WGU) + (size_t)(256 * nb) * DM; }
    else if ((r -= I_G) < I_G) { kb = r / 86; nb = r % 86; t.N = DFF; t.K = DM; t.src = C.in[I_W_UP] + (size_t)l * DM * DFF; t.dst = (bf16*)(C.ws + WS_WGU) + (size_t)(256 * nb + 128) * DM; }
    else { r -= I_G; kb = r / 32; nb = r % 32; t.N = DM; t.K = DFF; t.src = C.in[I_W_DOWN] + (size_t)l * DFF * DM; t.dst = (bf16*)(C.ws + WS_WDN) + (size_t)(128 * nb) * DFF; }
    t.src += (size_t)(128 * kb) * t.N + 128 * nb; t.dst += 128 * kb;
    const int rem = t.N - 128 * nb; t.nvalid = rem >= 128 ? 128 : (rem > 0 ? rem : 0);
    return t;
}
__device__ __forceinline__ void titem_load(const TItem& t, f32x4 (&v)[8], int wave, int lane) {
    const bool nv = 4 * (lane & 31) < t.nvalid; const float* p = t.src + (size_t)(16 * wave + 2 * (lane >> 5)) * t.N + 4 * (lane & 31);
#pragma unroll
    for (int i = 0; i < 4; ++i) { v[2 * i] = nv ? *(const GAS f32x4*)(p + (size_t)(4 * i) * t.N) : (f32x4){0.f, 0.f, 0.f, 0.f}; v[2 * i + 1] = nv ? *(const GAS f32x4*)(p + (size_t)(4 * i + 1) * t.N) : (f32x4){0.f, 0.f, 0.f, 0.f}; }
}
__device__ __forceinline__ void titem_store(const TItem& t, const f32x4 (&v)[8], LAS unsigned* T, int tid, int wave, int lane) {
    __syncthreads();
    { const int kd = 8 * wave + (lane >> 5);
#pragma unroll
      for (int i = 0; i < 4; ++i)
#pragma unroll
          for (int e = 0; e < 4; ++e) T[(4 * (lane & 31) + e) * 65 + kd + 2 * i] = pg8::cvt_pk_bf16(v[2 * i][e], v[2 * i + 1][e]); }
    __syncthreads();
    const int ch = tid & 15;
#pragma unroll
    for (int ps = 0; ps < 4; ++ps) { const int n = 32 * ps + (tid >> 4); const LAS unsigned* s = T + n * 65 + 4 * ch;
        v4u o; o.x = s[0]; o.y = s[1]; o.z = s[2]; o.w = s[3];
        *(GAS v4u*)(t.dst + (size_t)n * t.K + 8 * ch) = o; }
}
__device__ __forceinline__ void convert_weights(Ctx& C, int l) {
    LAS unsigned* T = (LAS unsigned*)C.lds;
    int it = C.bid; if (it >= CV_NITEMS) return;
    TItem cur = titem_decode(C, l, it); f32x4 va[8], vb[8];
    titem_load(cur, va, C.wave, C.lane);
    for (;;) {
        int nx = it + C.G; TItem tn = cur; const bool hn = nx < CV_NITEMS;
        if (hn) { tn = titem_decode(C, l, nx); titem_load(tn, vb, C.wave, C.lane); }
        titem_store(cur, va, T, C.tid, C.wave, C.lane);
        if (!hn) break;
        nx += C.G; const bool hn2 = nx < CV_NITEMS; TItem t2 = tn;
        if (hn2) { t2 = titem_decode(C, l, nx); titem_load(t2, va, C.wave, C.lane); }
        titem_store(tn, vb, T, C.tid, C.wave, C.lane);
        if (!hn2) break;
        cur = t2; it = nx;
    }
    __syncthreads();
}
__device__ __forceinline__ void rmsnorm_row_bf16(const float* xrow, const float* w, bf16* orow, int lane) {
    const GAS f32x4* xr = (const GAS f32x4*)xrow + lane; const GAS f32x4* wr = (const GAS f32x4*)w + lane;
    f32x4 v[16]; float ss = 0.f;
#pragma unroll
    for (int j = 0; j < 16; ++j) { v[j] = xr[64 * j]; ss += (v[j].x * v[j].x + v[j].y * v[j].y) + (v[j].z * v[j].z + v[j].w * v[j].w); }
    const float rstd = 1.f / sqrtf(wave_sum(ss) * (1.f / DM) + EPS);
    GAS v2u* o8 = (GAS v2u*)orow + lane;
#pragma unroll
    for (int j = 0; j < 16; ++j) { const f32x4 g = wr[64 * j]; v2u o; o.x = pk2(v[j].x * rstd * g.x, v[j].y * rstd * g.y); o.y = pk2(v[j].z * rstd * g.z, v[j].w * rstd * g.w); o8[64 * j] = o; }
}
__device__ __forceinline__ void rmsnorm_phase(Ctx& C, const float* X, const float* w, bf16* H) {
    const int gw = C.bid * NWAVES + C.wave, NGW = C.G * NWAVES;
    for (int m = gw; m < M; m += NGW) rmsnorm_row_bf16(X + (size_t)m * DM, w, H + (size_t)m * DM, C.lane);
}
__device__ __forceinline__ void final_norm_phase(Ctx& C, float* X, const float* w) {
    const int gw = C.bid * NWAVES + C.wave, NGW = C.G * NWAVES;
    for (int m = gw; m < M; m += NGW) {
        GAS f32x4* xr = (GAS f32x4*)(X + (size_t)m * DM) + C.lane; const GAS f32x4* wr = (const GAS f32x4*)w + C.lane;
        f32x4 v[16]; float ss = 0.f;
#pragma unroll
        for (int j = 0; j < 16; ++j) { v[j] = xr[64 * j]; ss += (v[j].x * v[j].x + v[j].y * v[j].y) + (v[j].z * v[j].z + v[j].w * v[j].w); }
        const float rstd = 1.f / sqrtf(wave_sum(ss) * (1.f / DM) + EPS);
#pragma unroll
        for (int j = 0; j < 16; ++j) { const f32x4 g = wr[64 * j]; xr[64 * j] = v[j] * rstd * g; }
    }
}

typedef short bf16x8 __attribute__((ext_vector_type(8)));
typedef short s16x4 __attribute__((ext_vector_type(4)));
__device__ __forceinline__ f32x4 mfma16(bf16x8 a, bf16x8 b, f32x4 c) { return __builtin_amdgcn_mfma_f32_16x16x32_bf16(a, b, c, 0, 0, 0); }
__device__ __forceinline__ bf16x8 pack8(f32x4 lo, f32x4 hi) { v4u w; w.x = pg8::cvt_pk_bf16(lo.x, lo.y); w.y = pg8::cvt_pk_bf16(lo.z, lo.w); w.z = pg8::cvt_pk_bf16(hi.x, hi.y); w.w = pg8::cvt_pk_bf16(hi.z, hi.w); return __builtin_bit_cast(bf16x8, w); }
__device__ __forceinline__ bf16x8 gfrag(const bf16* Mx, size_t ld, int row0, int k0, int lane) { return *(const GAS bf16x8*)(Mx + (size_t)(row0 + (lane & 15)) * ld + k0 + 8 * (lane >> 4)); }
__device__ __forceinline__ bf16x8 trfrag(const LAS unsigned char* img, int stride, int r0, int r1, int col0, int lane) {
    const int q = (lane & 15) >> 2, p = lane & 3;
    const s16x4 a = __builtin_amdgcn_ds_read_tr16_b64_v4i16((LAS s16x4*)(img + (r0 + q) * stride + (col0 + 4 * p) * 2));
    const s16x4 b = __builtin_amdgcn_ds_read_tr16_b64_v4i16((LAS s16x4*)(img + (r1 + q) * stride + (col0 + 4 * p) * 2));
    return __builtin_shufflevector(a, b, 0, 1, 2, 3, 4, 5, 6, 7);
}
__device__ __forceinline__ float xsum4(float v) { v += __shfl_xor(v, 16); v += __shfl_xor(v, 32); return v; }
__device__ __forceinline__ float xmax4(float v) { v = fmaxf(v, __shfl_xor(v, 16)); v = fmaxf(v, __shfl_xor(v, 32)); return v; }

constexpr int SWA_VSTRIDE = 144;
constexpr int SWA_V_BYTES = 192 * SWA_VSTRIDE;
__device__ __forceinline__ void swa_unit_mfma(Ctx& C, int l, int unit) {
    const int b = unit >> 7, qb = unit & 127, q0 = qb * 64;
    const int tid = C.tid, lane = C.lane, w = C.wave, c = lane & 15, hq = lane >> 4;
    LAS unsigned char* Vimg = C.lds;
    LAS float* tb = (LAS float*)(C.lds + 30720);
    LAS float* ssqx = (LAS float*)(C.lds + 30720 + 12288);
    const bf16* PROJ = (const bf16*)(C.ws + WS_PROJ); float* OSWA = (float*)(C.ws + WS_OSWA); bf16* Y = (bf16*)(C.ws + WS_Y);
    const bf16* Pb = PROJ + (size_t)b * SEQ * DINP;
    __syncthreads();
    for (int i = tid; i < 16 * 192; i += NTHR) { const int hd = i / 192, x = i % 192, dist = x - 32; tb[i] = (dist >= 0 && dist < 128) ? C.in[I_REL_BIAS][T5_BUCKET[dist] * SWA_H + hd] : 0.f; }
    if (tid < 16 * 9) *(LAS v4u*)(Vimg + (192 + tid / 9) * SWA_VSTRIDE + 16 * (tid % 9)) = (v4u){0u, 0u, 0u, 0u};
    const int g = w >> 1, qhalf = w & 1;
    float ssq0 = 0.f, ssq1 = 0.f;
    for (int kvh = 0; kvh < 4; ++kvh) {
        const int head = kvh * 4 + g;
        __syncthreads();
#pragma unroll
        for (int it = 0; it < 3; ++it) { const int idx = tid + NTHR * it, j = idx >> 3, cg = idx & 7; int s = q0 - 128 + j; s = s < 0 ? 0 : s;
            const v4u v = *(const GAS v4u*)(Pb + (size_t)s * DINP + C_SV + kvh * 64 + 8 * cg); *(LAS v4u*)(Vimg + j * SWA_VSTRIDE + 16 * cg) = v; }
        __syncthreads();
        const float sink = C.in[I_SWA_SINKS][l * SWA_H + head];
#pragma nounroll
        for (int qt = 0; qt < 2; ++qt) {
            const int j0 = 32 * qhalf + 16 * qt;
            const bf16x8 qf0 = gfrag(Pb + C_SQ + head * 64, DINP, q0 + j0, 0, lane), qf1 = gfrag(Pb + C_SQ + head * 64, DINP, q0 + j0, 32, lane);
            f32x4 sacc[10];
#pragma unroll
            for (int kt = 0; kt < 10; ++kt) {
                int srow = q0 - 128 + j0 + 16 * kt + c; srow = srow < 0 ? 0 : srow; srow = srow > q0 + 63 ? q0 + 63 : srow;
                const bf16* kp = Pb + (size_t)srow * DINP + C_SK + kvh * 64 + 8 * hq;
                const bf16x8 k0 = *(const GAS bf16x8*)kp, k1 = *(const GAS bf16x8*)(kp + 32);
                f32x4 a = (f32x4){0.f, 0.f, 0.f, 0.f}; a = mfma16(k0, qf0, a); a = mfma16(k1, qf1, a); sacc[kt] = a;
            }
            float mx = sink;
#pragma unroll
            for (int kt = 0; kt < 10; ++kt)
#pragma unroll
                for (int r = 0; r < 4; ++r) { const int dist = c + 128 - 16 * kt - 4 * hq - r; const int s = q0 - 128 + j0 + 16 * kt + 4 * hq + r;
                    const bool valid = (dist >= 0) && (dist < 128) && (s >= 0);
                    const float sc = valid ? sacc[kt][r] * 0.125f + tb[head * 192 + dist + 32] : -1e30f;
                    sacc[kt][r] = sc; mx = fmaxf(mx, sc); }
            mx = xmax4(mx); float sum = 0.f;
#pragma unroll
            for (int kt = 0; kt < 10; ++kt)
#pragma unroll
                for (int r = 0; r < 4; ++r) { const float p = __expf(sacc[kt][r] - mx); sacc[kt][r] = p; sum += p; }
            sum = xsum4(sum); const float inv = 1.f / (sum + __expf(sink - mx));
            f32x4 oacc[4];
#pragma unroll
            for (int dt = 0; dt < 4; ++dt) oacc[dt] = (f32x4){0.f, 0.f, 0.f, 0.f};
#pragma unroll
            for (int ks = 0; ks < 5; ++ks) { const bf16x8 pf = pack8(sacc[2 * ks], sacc[2 * ks + 1]);
#pragma unroll
                for (int dt = 0; dt < 4; ++dt) oacc[dt] = mfma16(trfrag(Vimg, SWA_VSTRIDE, j0 + 32 * ks + 4 * hq, j0 + 32 * ks + 16 + 4 * hq, 16 * dt, lane), pf, oacc[dt]); }
            float sq = 0.f; float* op = OSWA + (size_t)(b * SEQ + q0 + j0 + c) * SWA_W + head * 64 + 4 * hq;
#pragma unroll
            for (int dt = 0; dt < 4; ++dt) { const f32x4 o = oacc[dt] * inv; sq += (o.x * o.x + o.y * o.y) + (o.z * o.z + o.w * o.w); *(GAS f32x4*)(op + 16 * dt) = o; }
            if (qt == 0) ssq0 += sq; else ssq1 += sq;
        }
    }
    ssq0 = xsum4(ssq0); ssq1 = xsum4(ssq1);
    if (hq == 0) { ssqx[w * 32 + c] = ssq0; ssqx[w * 32 + 16 + c] = ssq1; }
    asm volatile("s_waitcnt vmcnt(0)" ::: "memory");
    __syncthreads();
    const float* swa_norm = C.in[I_SWA_NORM] + (size_t)l * SWA_W;
#pragma nounroll
    for (int qt = 0; qt < 2; ++qt) { const int qi = 16 * qt + c;
        const float tot = ssqx[(qhalf + 0) * 32 + qi] + ssqx[(qhalf + 2) * 32 + qi] + ssqx[(qhalf + 4) * 32 + qi] + ssqx[(qhalf + 6) * 32 + qi];
        const float rstd = 1.f / sqrtf(tot * (1.f / 1024.f) + EPS);
        const size_t row = (size_t)(b * SEQ + q0 + 32 * qhalf + qi);
#pragma unroll
        for (int kvh = 0; kvh < 4; ++kvh)
#pragma unroll
            for (int dt = 0; dt < 4; ++dt) { const int col = (kvh * 4 + g) * 64 + 16 * dt + 4 * hq; const f32x4 o = *(const GAS f32x4*)(OSWA + row * SWA_W + col); const f32x4 gn = *(const GAS f32x4*)(swa_norm + col);
                v2u ow; ow.x = pk2(o.x * rstd * gn.x, o.y * rstd * gn.y); ow.y = pk2(o.z * rstd * gn.z, o.w * rstd * gn.w); *(GAS v2u*)(Y + row * DM + 2048 + col) = ow; } }
}

constexpr int N_SWA_UNITS = BATCH * (SEQ / 64);

constexpr int SSD_L = 128, SSD_NC = SEQ / SSD_L, GLA_L = 64, GLA_NC = SEQ / GLA_L;
constexpr int N_SSD_CU = BATCH * SSD_NC * 8, N_GLA_CU = BATCH * GLA_NC * 4;
constexpr int XI_STRIDE = 528, BI_STRIDE = 272;

__device__ __forceinline__ void prep_phase(Ctx& C, int l) {
    const bf16* PROJ = (const bf16*)(C.ws + WS_PROJ); bf16* XBC = (bf16*)(C.ws + WS_XBC);
    const int tid = C.tid, lane = C.lane;
    { const int gw = C.bid * NWAVES + C.wave;
      if ((gw & 15) == 0 && (gw >> 4) < BATCH * SSD_NC && lane < SSD_H) {
          const int bc = gw >> 4; const size_t row0 = (size_t)bc * SSD_L;
          float* DT = (float*)(C.ws + WS_DT); float* ACS = (float*)(C.ws + WS_ACS); float* DEC = (float*)(C.ws + WS_DEC);
          const float dtb = C.in[I_SSD_DT_BIAS][l * SSD_H + lane], Ah = -expf(C.in[I_SSD_A_LOG][l * SSD_H + lane]);
          float cs = 0.f;
#pragma unroll 8
          for (int s = 0; s < SSD_L; ++s) { const float xr = bf1(PROJ[(row0 + s) * DINP + C_DT + lane]) + dtb; const float dt = xr > 20.f ? xr : log1pf(expf(xr)); cs += dt * Ah;
              DT[(row0 + s) * SSD_H + lane] = dt; ACS[(row0 + s) * SSD_H + lane] = cs; }
          DEC[bc * SSD_H + lane] = expf(cs);
      } }
    { const float* conv_w = C.in[I_SSD_CONV_W] + (size_t)l * 4 * SSD_CD; const float* conv_b = C.in[I_SSD_CONV_B] + (size_t)l * SSD_CD;
      constexpr int NIT = (M / 16) * 512;
      for (int it = C.bid * NTHR + tid; it < NIT; it += C.G * NTHR) {
          const int cg = it & 511, rb = it >> 9, c0 = 8 * cg, t0 = 16 * rb;
          float wv[4][8], bb[8];
#pragma unroll
          for (int i = 0; i < 4; ++i) { const f32x4 a = *(const GAS f32x4*)(conv_w + i * SSD_CD + c0), b2 = *(const GAS f32x4*)(conv_w + i * SSD_CD + c0 + 4);
              wv[i][0] = a.x; wv[i][1] = a.y; wv[i][2] = a.z; wv[i][3] = a.w; wv[i][4] = b2.x; wv[i][5] = b2.y; wv[i][6] = b2.z; wv[i][7] = b2.w; }
          { const f32x4 a = *(const GAS f32x4*)(conv_b + c0), b2 = *(const GAS f32x4*)(conv_b + c0 + 4); bb[0] = a.x; bb[1] = a.y; bb[2] = a.z; bb[3] = a.w; bb[4] = b2.x; bb[5] = b2.y; bb[6] = b2.z; bb[7] = b2.w; }
          float x0[8], x1[8], x2[8];
          const bool first = (t0 % SEQ) == 0;
          { v4u r0 = (v4u){0u, 0u, 0u, 0u}, r1 = r0, r2 = r0;
            if (!first) { r0 = *(const GAS v4u*)(PROJ + (size_t)(t0 - 3) * DINP + C_XBC + c0); r1 = *(const GAS v4u*)(PROJ + (size_t)(t0 - 2) * DINP + C_XBC + c0); r2 = *(const GAS v4u*)(PROJ + (size_t)(t0 - 1) * DINP + C_XBC + c0); }
            x0[0] = bflo(r0.x); x0[1] = bfhi(r0.x); x0[2] = bflo(r0.y); x0[3] = bfhi(r0.y); x0[4] = bflo(r0.z); x0[5] = bfhi(r0.z); x0[6] = bflo(r0.w); x0[7] = bfhi(r0.w);
            x1[0] = bflo(r1.x); x1[1] = bfhi(r1.x); x1[2] = bflo(r1.y); x1[3] = bfhi(r1.y); x1[4] = bflo(r1.z); x1[5] = bfhi(r1.z); x1[6] = bflo(r1.w); x1[7] = bfhi(r1.w);
            x2[0] = bflo(r2.x); x2[1] = bfhi(r2.x); x2[2] = bflo(r2.y); x2[3] = bfhi(r2.y); x2[4] = bflo(r2.z); x2[5] = bfhi(r2.z); x2[6] = bflo(r2.w); x2[7] = bfhi(r2.w); }
#pragma unroll 4
          for (int r = 0; r < 16; ++r) {
              const v4u rw = *(const GAS v4u*)(PROJ + (size_t)(t0 + r) * DINP + C_XBC + c0);
              float x3[8], o[8];
              x3[0] = bflo(rw.x); x3[1] = bfhi(rw.x); x3[2] = bflo(rw.y); x3[3] = bfhi(rw.y); x3[4] = bflo(rw.z); x3[5] = bfhi(rw.z); x3[6] = bflo(rw.w); x3[7] = bfhi(rw.w);
#pragma unroll
              for (int e = 0; e < 8; ++e) { const float a = bb[e] + wv[0][e] * x0[e] + wv[1][e] * x1[e] + wv[2][e] * x2[e] + wv[3][e] * x3[e]; o[e] = silu_f(a); x0[e] = x1[e]; x1[e] = x2[e]; x2[e] = x3[e]; }
              v4u ow; ow.x = pk2(o[0], o[1]); ow.y = pk2(o[2], o[3]); ow.z = pk2(o[4], o[5]); ow.w = pk2(o[6], o[7]);
              *(GAS v4u*)(XBC + (size_t)(t0 + r) * SSD_CD + c0) = ow;
          }
      } }
    { LAS float* glr = (LAS float*)C.lds;
      bf16* QD = (bf16*)(C.ws + WS_QD); bf16* KI = (bf16*)(C.ws + WS_KI); float* GDEC = (float*)(C.ws + WS_GDEC);
      const float* w_gate = C.in[I_GLA_W_GATE] + (size_t)l * 16 * GLA_KT; const float bgv = C.in[I_GLA_B_GATE][l * GLA_KT + tid];
      float wg[16];
#pragma unroll
      for (int r = 0; r < 16; ++r) wg[r] = w_gate[r * GLA_KT + tid];
      for (int ck = C.bid; ck < BATCH * GLA_NC; ck += C.G) {
          const size_t row0 = (size_t)ck * GLA_L;
          __syncthreads();
          if (tid < 128) { const int t = tid >> 1, hf = tid & 1; const v4u r = *(const GAS v4u*)(PROJ + (row0 + t) * DINP + C_GLR + 8 * hf);
              *(LAS f32x4*)(glr + t * 16 + 8 * hf) = (f32x4){bflo(r.x), bfhi(r.x), bflo(r.y), bfhi(r.y)}; *(LAS f32x4*)(glr + t * 16 + 8 * hf + 4) = (f32x4){bflo(r.z), bfhi(r.z), bflo(r.w), bfhi(r.w)}; }
          __syncthreads();
          float cum = 0.f;
#pragma unroll 8
          for (int t = 0; t < GLA_L; ++t) {
              const float qv = bf1(PROJ[(row0 + t) * DINP + C_GQ + tid]), kv = bf1(PROJ[(row0 + t) * DINP + C_GK + tid]);
              float z = bgv;
#pragma unroll
              for (int r4 = 0; r4 < 4; ++r4) { const f32x4 gv = *(const LAS f32x4*)(glr + t * 16 + 4 * r4); z += gv.x * wg[4 * r4] + gv.y * wg[4 * r4 + 1] + gv.z * wg[4 * r4 + 2] + gv.w * wg[4 * r4 + 3]; }
              const float ls = fminf(z, 0.f) - __logf(1.f + __expf(-fabsf(z))); cum += ls * 0.0625f;
              QD[(row0 + t) * GLA_KT + tid] = (bf16)f2bf(qv * 0.08838834764831845f * __expf(cum)); KI[(row0 + t) * GLA_KT + tid] = (bf16)f2bf(kv * __expf(-cum));
          }
          GDEC[(size_t)ck * GLA_KT + tid] = __expf(cum);
      } }
}

__device__ __forceinline__ void gla_c1_unit(Ctx& C, int unit) {
    const int h = unit & 3, ck = unit >> 2; const size_t row0 = (size_t)ck * GLA_L;
    const int tid = C.tid, lane = C.lane, w = C.wave, c = lane & 15, hq = lane >> 4;
    LAS unsigned char* KEimg = C.lds; LAS unsigned char* Vimg = C.lds + 64 * BI_STRIDE;
    const bf16* PROJ = (const bf16*)(C.ws + WS_PROJ); const bf16* KI = (const bf16*)(C.ws + WS_KI); const float* GDEC = (const float*)(C.ws + WS_GDEC); bf16* GST = (bf16*)(C.ws + WS_GST);
    __syncthreads();
    { const int cg = tid & 15; const f32x4 d0 = *(const GAS f32x4*)(GDEC + (size_t)ck * GLA_KT + h * 128 + 8 * cg), d1 = *(const GAS f32x4*)(GDEC + (size_t)ck * GLA_KT + h * 128 + 8 * cg + 4);
#pragma unroll
      for (int it = 0; it < 2; ++it) { const int t = (tid + NTHR * it) >> 4; const v4u r = *(const GAS v4u*)(KI + (row0 + t) * GLA_KT + h * 128 + 8 * cg);
          v4u o; o.x = pk2(bflo(r.x) * d0.x, bfhi(r.x) * d0.y); o.y = pk2(bflo(r.y) * d0.z, bfhi(r.y) * d0.w); o.z = pk2(bflo(r.z) * d1.x, bfhi(r.z) * d1.y); o.w = pk2(bflo(r.w) * d1.z, bfhi(r.w) * d1.w);
          *(LAS v4u*)(KEimg + t * BI_STRIDE + 16 * cg) = o; } }
#pragma unroll
    for (int it = 0; it < 4; ++it) { const int idx = tid + NTHR * it, t = idx >> 5, cg = idx & 31; *(LAS v4u*)(Vimg + t * XI_STRIDE + 16 * cg) = *(const GAS v4u*)(PROJ + (row0 + t) * DINP + C_GV + h * 256 + 8 * cg); }
    __syncthreads();
    f32x4 acc[16];
#pragma unroll
    for (int nt = 0; nt < 16; ++nt) acc[nt] = (f32x4){0.f, 0.f, 0.f, 0.f};
#pragma unroll
    for (int ks = 0; ks < 2; ++ks) { const bf16x8 af = trfrag(KEimg, BI_STRIDE, 32 * ks + 8 * hq, 32 * ks + 8 * hq + 4, 16 * w, lane);
#pragma unroll
        for (int nt = 0; nt < 16; ++nt) acc[nt] = mfma16(af, trfrag(Vimg, XI_STRIDE, 32 * ks + 8 * hq, 32 * ks + 8 * hq + 4, 16 * nt, lane), acc[nt]); }
    bf16* gp = GST + (size_t)unit * 32768 + 16 * w + 4 * hq;
#pragma unroll
    for (int nt = 0; nt < 16; ++nt) { v2u o; o.x = pk2(acc[nt].x, acc[nt].y); o.y = pk2(acc[nt].z, acc[nt].w); *(GAS v2u*)(gp + (size_t)(16 * nt + c) * 128) = o; }
}

__device__ __forceinline__ void scan_phase(Ctx& C) {
    const bf16* GST = (const bf16*)(C.ws + WS_GST); bf16* GPV = (bf16*)(C.ws + WS_GPV); const float* GDEC = (const float*)(C.ws + WS_GDEC);
    const bf16* ST = (const bf16*)(C.ws + WS_ST); bf16* PV = (bf16*)(C.ws + WS_PV); const float* DEC = (const float*)(C.ws + WS_DEC);
    constexpr int N_G = BATCH * 4 * 256 * 32, N_S = BATCH * SSD_H * 64 * 32;
    for (int it = C.bid * NTHR + C.tid; it < N_G + N_S; it += C.G * NTHR) {
        if (it < N_S) {
            const int n4 = it & 31, p = (it >> 5) & 63, h = (it >> 11) & 31, b = it >> 16;
            f32x4 run = (f32x4){0.f, 0.f, 0.f, 0.f};
#pragma unroll 8
            for (int c = 0; c < SSD_NC; ++c) { const size_t u = (size_t)(b * SSD_NC + c) * SSD_H + h; const size_t off = u * 8192 + p * 128 + 4 * n4;
                const v2u xr = *(const GAS v2u*)(ST + off); const f32x4 x = (f32x4){bflo(xr.x), bfhi(xr.x), bflo(xr.y), bfhi(xr.y)}; const float d = DEC[u];
                v2u o; o.x = pk2(run.x, run.y); o.y = pk2(run.z, run.w); *(GAS v2u*)(PV + off) = o;
                run = run * d + x; }
        } else {
            const int i2 = it - N_S; const int k4 = i2 & 31, v = (i2 >> 5) & 255, h = (i2 >> 13) & 3, b = i2 >> 15;
            f32x4 run = (f32x4){0.f, 0.f, 0.f, 0.f};
#pragma unroll 8
            for (int c = 0; c < GLA_NC; ++c) { const size_t ck = (size_t)(b * GLA_NC + c); const size_t off = (ck * 4 + h) * 32768 + v * 128 + 4 * k4;
                const v2u xr = *(const GAS v2u*)(GST + off); const f32x4 x = (f32x4){bflo(xr.x), bfhi(xr.x), bflo(xr.y), bfhi(xr.y)}; const f32x4 d = *(const GAS f32x4*)(GDEC + ck * GLA_KT + h * 128 + 4 * k4);
                v2u o; o.x = pk2(run.x, run.y); o.y = pk2(run.z, run.w); *(GAS v2u*)(GPV + off) = o;
                run = run * d + x; }
        }
    }
}

constexpr int GC3_GP_OFF = 64 * XI_STRIDE, GC3_XCH_OFF = GC3_GP_OFF + 256 * BI_STRIDE;
__device__ __forceinline__ void gla_c3_unit(Ctx& C, int l, int unit) {
    const int h = unit & 3, ck = unit >> 2; const size_t row0 = (size_t)ck * GLA_L;
    const int tid = C.tid, lane = C.lane, w = C.wave, c = lane & 15, hq = lane >> 4;
    LAS unsigned char* Vimg = C.lds; LAS unsigned char* GPimg = C.lds + GC3_GP_OFF; LAS float* xch = (LAS float*)(C.lds + GC3_XCH_OFF);
    const bf16* PROJ = (const bf16*)(C.ws + WS_PROJ); const bf16* QD = (const bf16*)(C.ws + WS_QD); const bf16* KI = (const bf16*)(C.ws + WS_KI); const bf16* GPV = (const bf16*)(C.ws + WS_GPV); bf16* Y = (bf16*)(C.ws + WS_Y);
    const int lt = w >> 1, vh = w & 1; const size_t row = row0 + 16 * lt + c;
    __syncthreads();
    { const bf16* gpv = GPV + (size_t)unit * 32768;
      v4u tv[4], tg[8];
#pragma unroll
      for (int it = 0; it < 4; ++it) { const int idx = tid + NTHR * it, t = idx >> 5, cg = idx & 31; tv[it] = *(const GAS v4u*)(PROJ + (row0 + t) * DINP + C_GV + h * 256 + 8 * cg); }
#pragma unroll
      for (int it = 0; it < 8; ++it) { const int idx = tid + NTHR * it; tg[it] = *(const GAS v4u*)(gpv + (size_t)idx * 8); }
#pragma unroll
      for (int it = 0; it < 4; ++it) { const int idx = tid + NTHR * it, t = idx >> 5, cg = idx & 31; *(LAS v4u*)(Vimg + t * XI_STRIDE + 16 * cg) = tv[it]; }
#pragma unroll
      for (int it = 0; it < 8; ++it) { const int idx = tid + NTHR * it, v = idx >> 4, cg = idx & 15; *(LAS v4u*)(GPimg + v * BI_STRIDE + 16 * cg) = tg[it]; } }
    bf16x8 qf[4];
#pragma unroll
    for (int ks = 0; ks < 4; ++ks) qf[ks] = gfrag(QD + row0 * GLA_KT + h * 128, GLA_KT, 16 * lt, 32 * ks, lane);
    v2u ggv[8];
#pragma unroll
    for (int vt = 0; vt < 8; ++vt) ggv[vt] = *(const GAS v2u*)(PROJ + row * DINP + C_GG + h * 256 + 16 * (8 * vh + vt) + 4 * hq);
    f32x4 att[4];
#pragma unroll
    for (int st = 0; st < 4; ++st) { f32x4 a = (f32x4){0.f, 0.f, 0.f, 0.f};
        if (st <= lt) {
#pragma unroll
            for (int ks = 0; ks < 4; ++ks) a = mfma16(gfrag(KI + row0 * GLA_KT + h * 128, GLA_KT, 16 * st, 32 * ks, lane), qf[ks], a);
#pragma unroll
            for (int r = 0; r < 4; ++r) if (16 * st + 4 * hq + r > 16 * lt + c) a[r] = 0.f;
        }
        att[st] = a; }
    __syncthreads();
    f32x4 oacc[8];
#pragma unroll
    for (int vt = 0; vt < 8; ++vt) oacc[vt] = (f32x4){0.f, 0.f, 0.f, 0.f};
#pragma unroll
    for (int ks = 0; ks < 4; ++ks)
#pragma unroll
        for (int vt = 0; vt < 8; ++vt) oacc[vt] = mfma16(*(const LAS bf16x8*)(GPimg + (16 * (8 * vh + vt) + c) * BI_STRIDE + (32 * ks + 8 * hq) * 2), qf[ks], oacc[vt]);
#pragma unroll
    for (int ks2 = 0; ks2 < 2; ++ks2) { const bf16x8 pf = pack8(att[2 * ks2], att[2 * ks2 + 1]);
#pragma unroll
        for (int vt = 0; vt < 8; ++vt) oacc[vt] = mfma16(trfrag(Vimg, XI_STRIDE, 32 * ks2 + 4 * hq, 32 * ks2 + 16 + 4 * hq, 16 * (8 * vh + vt), lane), pf, oacc[vt]); }
    float ssq = 0.f;
#pragma unroll
    for (int vt = 0; vt < 8; ++vt) ssq += (oacc[vt].x * oacc[vt].x + oacc[vt].y * oacc[vt].y) + (oacc[vt].z * oacc[vt].z + oacc[vt].w * oacc[vt].w);
    ssq = xsum4(ssq);
    if (hq == 0) xch[w * 16 + c] = ssq;
    __syncthreads();
    const float rstd = 1.f / sqrtf((xch[w * 16 + c] + xch[(w ^ 1) * 16 + c]) * (1.f / 256.f) + EPS);
    const float* gla_norm = C.in[I_GLA_NORM] + (size_t)l * 256;
#pragma unroll
    for (int vt = 0; vt < 8; ++vt) { const int v0 = 16 * (8 * vh + vt) + 4 * hq; const f32x4 gn = *(const GAS f32x4*)(gla_norm + v0); const v2u gg = ggv[vt];
        const f32x4 o = oacc[vt]; v2u ow; ow.x = pk2(o.x * rstd * gn.x * silu_f(bflo(gg.x)), o.y * rstd * gn.y * silu_f(bfhi(gg.x))); ow.y = pk2(o.z * rstd * gn.z * silu_f(bflo(gg.y)), o.w * rstd * gn.w * silu_f(bfhi(gg.y)));
        *(GAS v2u*)(Y + row * DM + 3072 + h * 256 + v0) = ow; }
}

__device__ __forceinline__ void ssd_c1_unit(Ctx& C, int unit) {
    const int g = unit & 7, bc = unit >> 3; const size_t row0 = (size_t)bc * SSD_L;
    const int tid = C.tid, lane = C.lane, w = C.wave, c = lane & 15, hq = lane >> 4;
    LAS float* acs = (LAS float*)C.lds; LAS float* dts = acs + 512;
    LAS unsigned char* XWimg = C.lds + 4096; LAS unsigned char* Bimg = C.lds + 4096 + 128 * XI_STRIDE;
    const bf16* XBC = (const bf16*)(C.ws + WS_XBC); const float* DT = (const float*)(C.ws + WS_DT); const float* ACS = (const float*)(C.ws + WS_ACS); bf16* ST = (bf16*)(C.ws + WS_ST);
    __syncthreads();
    { const int t = tid >> 2, hh = tid & 3; acs[tid] = ACS[(row0 + t) * SSD_H + 4 * g + hh]; dts[tid] = DT[(row0 + t) * SSD_H + 4 * g + hh]; }
    __syncthreads();
#pragma unroll
    for (int it = 0; it < 8; ++it) { const int idx = tid + NTHR * it, t = idx >> 5, cg = idx & 31, hh = cg >> 3; const float wgt = __expf(acs[127 * 4 + hh] - acs[t * 4 + hh]) * dts[t * 4 + hh];
        const v4u r = *(const GAS v4u*)(XBC + (row0 + t) * SSD_CD + g * 256 + 8 * cg);
        v4u o; o.x = pk2(bflo(r.x) * wgt, bfhi(r.x) * wgt); o.y = pk2(bflo(r.y) * wgt, bfhi(r.y) * wgt); o.z = pk2(bflo(r.z) * wgt, bfhi(r.z) * wgt); o.w = pk2(bflo(r.w) * wgt, bfhi(r.w) * wgt);
        *(LAS v4u*)(XWimg + t * XI_STRIDE + 16 * cg) = o; }
#pragma unroll
    for (int it = 0; it < 4; ++it) { const int idx = tid + NTHR * it, t = idx >> 4, cg = idx & 15; *(LAS v4u*)(Bimg + t * BI_STRIDE + 16 * cg) = *(const GAS v4u*)(XBC + (row0 + t) * SSD_CD + 2048 + g * 128 + 8 * cg); }
    __syncthreads();
    const int hh = w >> 1, ph = w & 1;
    f32x4 acc[8][2];
#pragma unroll
    for (int mt = 0; mt < 8; ++mt) { acc[mt][0] = (f32x4){0.f, 0.f, 0.f, 0.f}; acc[mt][1] = (f32x4){0.f, 0.f, 0.f, 0.f}; }
#pragma unroll
    for (int ks = 0; ks < 4; ++ks) { const int r0 = 32 * ks + 8 * hq;
        const bf16x8 x0 = trfrag(XWimg, XI_STRIDE, r0, r0 + 4, hh * 64 + 32 * ph, lane), x1 = trfrag(XWimg, XI_STRIDE, r0, r0 + 4, hh * 64 + 32 * ph + 16, lane);
#pragma unroll
        for (int mt = 0; mt < 8; ++mt) { const bf16x8 bf = trfrag(Bimg, BI_STRIDE, r0, r0 + 4, 16 * mt, lane); acc[mt][0] = mfma16(bf, x0, acc[mt][0]); acc[mt][1] = mfma16(bf, x1, acc[mt][1]); } }
    bf16* sp = ST + ((size_t)bc * SSD_H + 4 * g + hh) * 8192 + 4 * hq;
#pragma unroll
    for (int mt = 0; mt < 8; ++mt)
#pragma unroll
        for (int pt = 0; pt < 2; ++pt) { v2u o; o.x = pk2(acc[mt][pt].x, acc[mt][pt].y); o.y = pk2(acc[mt][pt].z, acc[mt][pt].w); *(GAS v2u*)(sp + (size_t)(32 * ph + 16 * pt + c) * 128 + 16 * mt) = o; }
}

constexpr int SC3_X_OFF = 4096, SC3_PV_OFF = SC3_X_OFF + 128 * XI_STRIDE, SC3_PV_HEAD = 64 * BI_STRIDE;
static_assert(SC3_PV_OFF + 4 * SC3_PV_HEAD <= MISC_OFF && GC3_XCH_OFF + 512 <= MISC_OFF, "mixer LDS maps");
__device__ __forceinline__ void ssd_c3_unit(Ctx& C, int l, int unit) {
    const int g = unit & 7, bc = unit >> 3; const size_t row0 = (size_t)bc * SSD_L;
    const int tid = C.tid, lane = C.lane, w = C.wave, c = lane & 15, hq = lane >> 4;
    LAS float* acs = (LAS float*)C.lds; LAS float* dts = acs + 512;
    LAS unsigned char* Ximg = C.lds + SC3_X_OFF; LAS unsigned char* PVimg = C.lds + SC3_PV_OFF;
    const bf16* PROJ = (const bf16*)(C.ws + WS_PROJ); const bf16* XBC = (const bf16*)(C.ws + WS_XBC); const float* DT = (const float*)(C.ws + WS_DT); const float* ACS = (const float*)(C.ws + WS_ACS);
    const bf16* PV = (const bf16*)(C.ws + WS_PV); bf16* Y = (bf16*)(C.ws + WS_Y);
    const int tl = 16 * w + c; const size_t row = row0 + tl;
    __syncthreads();
    { const int t = tid >> 2, hh = tid & 3; const float a0 = ACS[(row0 + t) * SSD_H + 4 * g + hh], d0 = DT[(row0 + t) * SSD_H + 4 * g + hh];
      const bf16* pvb = PV + ((size_t)bc * SSD_H + 4 * g) * 8192;
      v4u tx[8], tp[8];
#pragma unroll
      for (int it = 0; it < 8; ++it) { const int idx = tid + NTHR * it, t2 = idx >> 5, cg = idx & 31; tx[it] = *(const GAS v4u*)(XBC + (row0 + t2) * SSD_CD + g * 256 + 8 * cg); }
#pragma unroll
      for (int it = 0; it < 8; ++it) { const int idx = tid + NTHR * it; tp[it] = *(const GAS v4u*)(pvb + (size_t)idx * 8); }
      acs[tid] = a0; dts[tid] = d0;
#pragma unroll
      for (int it = 0; it < 8; ++it) { const int idx = tid + NTHR * it, t2 = idx >> 5, cg = idx & 31; *(LAS v4u*)(Ximg + t2 * XI_STRIDE + 16 * cg) = tx[it]; }
#pragma unroll
      for (int it = 0; it < 8; ++it) { const int idx = tid + NTHR * it, pr = idx >> 4, cg = idx & 15; *(LAS v4u*)(PVimg + pr * BI_STRIDE + 16 * cg) = tp[it]; } }
    bf16x8 cf[4];
#pragma unroll
    for (int ks = 0; ks < 4; ++ks) cf[ks] = gfrag(XBC + row0 * SSD_CD + 3072 + g * 128, SSD_CD, 16 * w, 32 * ks, lane);
    f32x4 cb[8];
#pragma unroll
    for (int st = 0; st < 8; ++st) { f32x4 a = (f32x4){0.f, 0.f, 0.f, 0.f};
        if (st <= w) {
#pragma unroll
            for (int ks = 0; ks < 4; ++ks) a = mfma16(gfrag(XBC + row0 * SSD_CD + 2048 + g * 128, SSD_CD, 16 * st, 32 * ks, lane), cf[ks], a);
        }
        cb[st] = a; }
    __syncthreads();
    float* YT = (float*)(C.ws + WS_ST) + row * SSD_W + g * 256;
    float ssq = 0.f;
#pragma nounroll
    for (int hh = 0; hh < 4; ++hh) {
        v2u zz[4];
#pragma unroll
        for (int pt = 0; pt < 4; ++pt) zz[pt] = *(const GAS v2u*)(PROJ + row * DINP + C_Z + g * 256 + hh * 64 + 16 * pt + 4 * hq);
        const float acs_l = acs[tl * 4 + hh], el = __expf(acs_l);
        f32x4 ya[4];
#pragma unroll
        for (int pt = 0; pt < 4; ++pt) ya[pt] = (f32x4){0.f, 0.f, 0.f, 0.f};
#pragma unroll
        for (int ks = 0; ks < 4; ++ks)
#pragma unroll
            for (int pt = 0; pt < 4; ++pt) ya[pt] = mfma16(*(const LAS bf16x8*)(PVimg + (hh * 64 + 16 * pt + c) * BI_STRIDE + (32 * ks + 8 * hq) * 2), cf[ks], ya[pt]);
#pragma unroll
        for (int pt = 0; pt < 4; ++pt) ya[pt] = ya[pt] * el;
#pragma unroll
        for (int ks2 = 0; ks2 < 4; ++ks2) {
            if (2 * ks2 <= w) {
                f32x4 lm[2];
#pragma unroll
                for (int t2 = 0; t2 < 2; ++t2)
#pragma unroll
                    for (int r = 0; r < 4; ++r) { const int s = 32 * ks2 + 16 * t2 + 4 * hq + r; const float d = fminf(acs_l - acs[s * 4 + hh], 0.f);
                        lm[t2][r] = (s <= tl) ? cb[2 * ks2 + t2][r] * __expf(d) * dts[s * 4 + hh] : 0.f; }
                const bf16x8 pf = pack8(lm[0], lm[1]);
#pragma unroll
                for (int pt = 0; pt < 4; ++pt) ya[pt] = mfma16(trfrag(Ximg, XI_STRIDE, 32 * ks2 + 4 * hq, 32 * ks2 + 16 + 4 * hq, hh * 64 + 16 * pt, lane), pf, ya[pt]);
            }
        }
        const float Dh = C.in[I_SSD_D][l * SSD_H + 4 * g + hh];
#pragma unroll
        for (int pt = 0; pt < 4; ++pt) { const int col = hh * 64 + 16 * pt + 4 * hq; const v2u xw = *(const LAS v2u*)(Ximg + tl * XI_STRIDE + col * 2); const v2u z2 = zz[pt];
            f32x4 v; v.x = (ya[pt].x + Dh * bflo(xw.x)) * silu_f(bflo(z2.x)); v.y = (ya[pt].y + Dh * bfhi(xw.x)) * silu_f(bfhi(z2.x)); v.z = (ya[pt].z + Dh * bflo(xw.y)) * silu_f(bflo(z2.y)); v.w = (ya[pt].w + Dh * bfhi(xw.y)) * silu_f(bfhi(z2.y));
            *(GAS f32x4*)(YT + col) = v; ssq += (v.x * v.x + v.y * v.y) + (v.z * v.z + v.w * v.w); }
    }
    ssq = xsum4(ssq);
    const float rstd = 1.f / sqrtf(ssq * (1.f / 256.f) + EPS);
    const float* ssd_norm = C.in[I_SSD_NORM] + (size_t)l * SSD_W + g * 256;
    asm volatile("s_waitcnt vmcnt(0)" ::: "memory");
#pragma unroll 4
    for (int i = 0; i < 16; ++i) { const int col = 16 * i + 4 * hq; const f32x4 gn = *(const GAS f32x4*)(ssd_norm + col); const f32x4 v = *(const GAS f32x4*)(YT + col);
        v2u ow; ow.x = pk2(v.x * rstd * gn.x, v.y * rstd * gn.y); ow.y = pk2(v.z * rstd * gn.z, v.w * rstd * gn.w); *(GAS v2u*)(Y + row * DM + g * 256 + col) = ow; }
}

__device__ __forceinline__ void mix_c1_phase(Ctx& C, int l) {
    for (int u = C.bid; u < N_SSD_CU; u += C.G) ssd_c1_unit(C, u);
    for (int u = C.bid; u < N_GLA_CU; u += C.G) gla_c1_unit(C, u);
    for (int u = C.bid; u < N_SWA_UNITS; u += C.G) swa_unit_mfma(C, l, u);
}
__device__ __forceinline__ void mix_c3_phase(Ctx& C, int l) {
    for (int u = C.bid; u < N_SSD_CU; u += C.G) ssd_c3_unit(C, l, u);
    for (int u = C.bid; u < N_GLA_CU; u += C.G) gla_c3_unit(C, l, u);
}

__device__ __forceinline__ void act_fixup_phase(Ctx& C, int l) {
    bf16* ACT = (bf16*)(C.ws + WS_ACT); const float* HTG = (const float*)(C.ws + WS_HTG); const float* HTU = (const float*)(C.ws + WS_HTU); const float* HBG = (const float*)(C.ws + WS_HBG);
    const float* cw = C.in[I_FFN_CONV_W] + (size_t)l * 3 * DFF; const float* cb = C.in[I_FFN_CONV_B] + (size_t)l * DFF;
    constexpr int NC4 = DFF / 4, NIT = (M / 64) * 2 * NC4;
    for (int it = C.bid * NTHR + C.tid; it < NIT; it += C.G * NTHR) {
        const int c4 = it % NC4, ri = it / NC4, i = ri & 1, blk = ri >> 1, c0 = 4 * c4; const bool first = (blk % (SEQ / 64)) == 0;
        const f32x4 z4 = (f32x4){0.f, 0.f, 0.f, 0.f};
        const f32x4 g0 = *(const GAS f32x4*)(HTG + ((size_t)blk * 2 + i) * DFF + c0), up = *(const GAS f32x4*)(HTU + ((size_t)blk * 2 + i) * DFF + c0);
        const f32x4 pb1 = first ? z4 : *(const GAS f32x4*)(HBG + ((size_t)(blk - 1) * 2 + 1) * DFF + c0), pb0 = first ? z4 : *(const GAS f32x4*)(HBG + ((size_t)(blk - 1) * 2 + 0) * DFF + c0);
        const f32x4 g1 = i ? *(const GAS f32x4*)(HTG + ((size_t)blk * 2 + 0) * DFF + c0) : pb1, g2 = i ? pb1 : pb0;
        const f32x4 w0 = *(const GAS f32x4*)(cw + c0), w1 = *(const GAS f32x4*)(cw + DFF + c0), w2 = *(const GAS f32x4*)(cw + 2 * DFF + c0), bb = *(const GAS f32x4*)(cb + c0);
        f32x4 o;
#pragma unroll
        for (int e = 0; e < 4; ++e) { const float gc = bb[e] + w0[e] * g2[e] + w1[e] * g1[e] + w2[e] * g0[e]; o[e] = silu_f(gc) * up[e]; }
        v2u ow; ow.x = pk2(o.x, o.y); ow.y = pk2(o.z, o.w); *(GAS v2u*)(ACT + (size_t)(64 * blk + i) * DFF + c0) = ow;
    }
}

constexpr int PH_PER_LAYER = 11, PH_FINAL = DEPTH * PH_PER_LAYER, N_PHASES = PH_FINAL + 1;
#ifndef MK_ONE_LAUNCH
#define MK_ONE_LAUNCH 1
#endif
__global__ void __launch_bounds__(NTHR, 2) fwd_kernel(Args args) {
    extern __shared__ __attribute__((aligned(16))) unsigned char lds[];
    Ctx C;
    C.lds = (LAS unsigned char*)lds;
    C.tid = threadIdx.x; C.lane = C.tid & 63; C.wave = __builtin_amdgcn_readfirstlane(C.tid >> 6);
    C.G = gridDim.x; C.bid = blockIdx.x;
    C.in = args.in; C.out = args.out; C.ws = args.ws;
    volatile LAS unsigned* MISC = (volatile LAS unsigned*)(C.lds + MISC_OFF);
    for (int u = C.tid; u < (LDS_BYTES - MISC_OFF) / 4; u += NTHR) ((LAS unsigned*)(C.lds + MISC_OFF))[u] = 0u;
    __syncthreads();
    gu32* ctl = (gu32*)(args.ws + WS_CTL);
    XcdBarrier bar = xcd_barrier_post((unsigned*)(ctl + CW_BAR) + args.li * XCD_BAR_WORDS, MISC + 8);
    const int lo = args.ph_lo, hi = args.ph_hi;
#define IN(k) (lo <= (k) && (k) < hi)
#define SEAM(k) do { if (IN(k) && IN((k) + 1)) xcd_barrier(bar); } while (0)
    float* xres = args.out;
    bf16* H = (bf16*)(args.ws + WS_H);
#define LAYER_BODY(l) do { \
        const int pb = l * PH_PER_LAYER; \
        const float* xin = (l == 0) ? args.in[I_X] : (const float*)xres; \
        if (IN(pb + 0)) { convert_weights(C, l); rmsnorm_phase(C, xin, args.in[I_ATTN_NORM] + (size_t)l * DM, H); } \
        SEAM(pb + 0); \
        if (IN(pb + 1)) { \
            pg8::Gemm g{H, (const bf16*)(args.ws + WS_WIN), M, DINP, DM}; pg8::StaticOrder S; S.init(M, DINP, C.G, C.bid); \
            pg8::EpiBf16 E{(bf16*)(args.ws + WS_PROJ), DINP}; \
            pg8::gemm_phase<pg8::EpiBf16, pg8::StaticOrder, true, true>(C.lds, g, S, E); \
        } \
        SEAM(pb + 1); \
        if (IN(pb + 2)) prep_phase(C, l); \
        SEAM(pb + 2); \
        if (IN(pb + 3)) mix_c1_phase(C, l); \
        SEAM(pb + 3); \
        if (IN(pb + 4)) scan_phase(C); \
        SEAM(pb + 4); \
        if (IN(pb + 5)) mix_c3_phase(C, l); \
        SEAM(pb + 5); \
        if (IN(pb + 6)) { \
            pg8::Gemm g{(const bf16*)(args.ws + WS_Y), (const bf16*)(args.ws + WS_WOUT), M, DM, DM}; pg8::StaticOrder S; S.init(M, DM, C.G, C.bid); \
            pg8::EpiRes E{xin, xres, DM}; \
            pg8::gemm_phase<pg8::EpiRes, pg8::StaticOrder, true, true>(C.lds, g, S, E); \
        } \
        SEAM(pb + 6); \
        if (IN(pb + 7)) rmsnorm_phase(C, xres, args.in[I_FFN_NORM] + (size_t)l * DM, H); \
        SEAM(pb + 7); \
        if (IN(pb + 8)) { \
            pg8::Gemm g{H, (const bf16*)(args.ws + WS_WGU), M, DGU, DM}; pg8::StaticOrder S; S.init(M, DGU, C.G, C.bid); \
            pg8::EpiGateUp E{(bf16*)(args.ws + WS_ACT), args.in[I_FFN_CONV_W] + (size_t)l * 3 * DFF, args.in[I_FFN_CONV_B] + (size_t)l * DFF, (float*)(args.ws + WS_HTG), (float*)(args.ws + WS_HTU), (float*)(args.ws + WS_HBG), DFF}; \
            pg8::gemm_phase<pg8::EpiGateUp, pg8::StaticOrder, true, true>(C.lds, g, S, E); \
        } \
        SEAM(pb + 8); \
        if (IN(pb + 9)) act_fixup_phase(C, l); \
        SEAM(pb + 9); \
        if (IN(pb + 10)) { \
            pg8::Gemm g{(const bf16*)(args.ws + WS_ACT), (const bf16*)(args.ws + WS_WDN), M, DM, DFF}; pg8::StaticOrder S; S.init(M, DM, C.G, C.bid); \
            pg8::EpiRes E{xres, xres, DM}; \
            pg8::gemm_phase<pg8::EpiRes, pg8::StaticOrder, true, true>(C.lds, g, S, E); \
        } \
        SEAM(pb + 10); \
     \
    } while (0)
    LAYER_BODY(0);
    LAYER_BODY(1);
#undef LAYER_BODY
    if (IN(PH_FINAL)) final_norm_phase(C, xres, args.in[I_FINAL_NORM]);
#undef IN
#undef SEAM
}

extern "C" void kernel_launch(void* const* d_in, const int* in_sizes, int n_in, void* d_out, int out_size, void* d_ws, size_t ws_size, hipStream_t stream) {
    static int grid = 0;
    if (grid == 0) {
        if (n_in != N_IN || out_size != M * DM || ws_size < WS_END) { fprintf(stderr, "kernel_launch: unexpected shapes (n_in %d, out %d, ws %zu < %zu)\n", n_in, out_size, ws_size, (size_t)WS_END); grid = -1; return; }
        int dev = 0, cus = 0, per_cu = 0;
        if (hipGetDevice(&dev) != hipSuccess || hipDeviceGetAttribute(&cus, hipDeviceAttributeMultiprocessorCount, dev) != hipSuccess) { grid = -1; return; }
        if (hipFuncSetAttribute((const void*)fwd_kernel, hipFuncAttributeMaxDynamicSharedMemorySize, LDS_BYTES) != hipSuccess) { fprintf(stderr, "kernel_launch: hipFuncSetAttribute failed\n"); grid = -1; return; }
        if (hipOccupancyMaxActiveBlocksPerMultiprocessor(&per_cu, (const void*)fwd_kernel, NTHR, LDS_BYTES) != hipSuccess || per_cu < 1) { fprintf(stderr, "kernel_launch: occupancy query says %d\n", per_cu); (void)hipGetLastError(); grid = -1; return; }
        grid = cus;
    }
    if (grid < 0) return;
    if (hipMemsetAsync((char*)d_ws + WS_CTL, 0, CTL_ZERO_BYTES, stream) != hipSuccess) return;
    Args a{};
    for (int i = 0; i < N_IN; ++i) a.in[i] = (const float*)d_in[i];
    a.out = (float*)d_out; a.ws = (unsigned char*)d_ws; a.pad = 0;
#if MK_ONE_LAUNCH
    a.ph_lo = 0; a.ph_hi = N_PHASES; a.li = 0;
    hipLaunchKernelGGL(fwd_kernel, dim3(grid), dim3(NTHR), LDS_BYTES, stream, a);
#else
    for (int p = 0; p < N_PHASES; ++p) { a.ph_lo = p; a.ph_hi = p + 1; a.li = p;
        hipLaunchKernelGGL(fwd_kernel, dim3(grid), dim3(NTHR), LDS_BYTES, stream, a); }
#endif
}
```

```cpp
#include <hip/hip_runtime.h>
#include <cstdio>
#include <cstdint>
namespace pg8 {
#define PG8_LAS __attribute__((address_space(3)))
typedef unsigned short bf16_t;
typedef short bf16x8 __attribute__((ext_vector_type(8)));
typedef float f32x4 __attribute__((ext_vector_type(4)));
typedef unsigned u32x4 __attribute__((ext_vector_type(4)));
constexpr int BM = 256, BK = 64, HALF = 128, HTB = HALF * BK * 2  , STAGE_BYTES = 8 * HTB, NXCD = 8, WGM = 8;

__host__ __device__ __forceinline__ int lds_byte(int r, int c) { const int st = (r >> 4) * 2 + (c >> 5), rr = r & 15, cc = c & 31, ob = rr * 64 + cc * 2; return st * 1024 + (ob ^ (((ob >> 9) & 1) << 5)); }
__host__ __device__ __forceinline__ void stage_rc(int b, int& R, int& C) { const int st = b / 1024, sb = b % 1024, swz = sb ^ (((sb >> 9) & 1) << 5); R = (st >> 1) * 16 + swz / 64; C = (st & 1) * 32 + (swz % 64) / 2; }
__host__ __device__ __forceinline__ int perm32(int rho) { const int n = rho >> 4, i = rho & 15; return 8 * (i >> 2) + 4 * n + (i & 3); }

struct Unit { int pm, pn; };
struct Gemm { const bf16_t* A; const bf16_t* Bt; int M, N, K; };

struct StaticOrder {
    int nM, nN, nwg, G, c;
    __host__ __device__ void init(int M, int N, int G_, int c_) { nM = M / BM; nN = N / BM; nwg = nM * nN; G = G_; c = c_; }
    __host__ __device__ bool next(int i, Unit& u) const {
        const long L = (long)i * G + c; if (L >= nwg) return false;
        int wgid = (int)L; { const int q = nwg / NXCD, r = nwg % NXCD, xcd = wgid % NXCD, off = wgid / NXCD; wgid = (xcd < r ? xcd * (q + 1) : r * (q + 1) + (xcd - r) * q) + off; }
        const int nig = WGM * nN, gid = wgid / nig, fm = gid * WGM, gsz = (nM - fm) < WGM ? (nM - fm) : WGM;
        u.pm = fm + ((wgid % nig) % gsz); u.pn = (wgid % nig) / gsz; return true;
    }
    __device__ __forceinline__ void a_ready(const Unit&) const {}
    __device__ __forceinline__ void done(const Unit&) const {}
};

__device__ __forceinline__ unsigned cvt_pk_bf16(float lo, float hi) { unsigned r; asm volatile("v_cvt_pk_bf16_f32 %0, %1, %2" : "=v"(r) : "v"(lo), "v"(hi)); return r; }

struct EpiBf16 {
    static constexpr bool PERM = true, AFTER_DRAIN = false;
    bf16_t* O; int ldc;
    __device__ __forceinline__ void operator()(const f32x4 (&acc)[2][2][4][2], const Unit& u, int wr, int wc, int fr, int fq) const {
        const int row0 = u.pm * BM + wr * 64 + fr; const int col0 = u.pn * BM + wc * 32 + 8 * fq;
#pragma unroll
        for (int ai = 0; ai < 2; ++ai)
#pragma unroll
            for (int m = 0; m < 4; ++m) { bf16_t* rowp = O + (size_t)(row0 + ai * HALF + m * 16) * ldc + col0;
#pragma unroll
                for (int bj = 0; bj < 2; ++bj) { const f32x4 v0 = acc[ai][bj][m][0], v1 = acc[ai][bj][m][1];
                    u32x4 w; w.x = cvt_pk_bf16(v0[0], v0[1]); w.y = cvt_pk_bf16(v0[2], v0[3]); w.z = cvt_pk_bf16(v1[0], v1[1]); w.w = cvt_pk_bf16(v1[2], v1[3]);
                    *(u32x4*)(rowp + bj * HALF) = w; } }
    }
};
template <int CTRL> __device__ __forceinline__ float dpp_old(float old, float v) { return __int_as_float(__builtin_amdgcn_update_dpp(__float_as_int(old), __float_as_int(v), CTRL, 0xf, 0xf, false)); }
struct EpiGateUp {
    static constexpr bool PERM = true, AFTER_DRAIN = false;
    bf16_t* ACT; const float* cw; const float* cb; float* HTG; float* HTU; float* HBG; int dff;
    __device__ __forceinline__ void operator()(const f32x4 (&acc)[2][2][4][2], const Unit& u, int wr, int wc, int fr, int fq) const {
        const int j0 = u.pn * 128 + wc * 32 + 8 * fq;
        float w0[8], w1[8], w2[8], bb[8];
#pragma unroll
        for (int h = 0; h < 2; ++h) { const f32x4 a = *(const f32x4*)(cw + j0 + 4 * h), b = *(const f32x4*)(cw + dff + j0 + 4 * h), c = *(const f32x4*)(cw + 2 * dff + j0 + 4 * h), d = *(const f32x4*)(cb + j0 + 4 * h);
#pragma unroll
            for (int e = 0; e < 4; ++e) { w0[4 * h + e] = a[e]; w1[4 * h + e] = b[e]; w2[4 * h + e] = c[e]; bb[4 * h + e] = d[e]; } }
#pragma unroll
        for (int ai = 0; ai < 2; ++ai) {
            const int rowb = u.pm * BM + ai * HALF + wr * 64; const size_t blk = (size_t)(rowb >> 6);
#pragma unroll
            for (int m = 0; m < 4; ++m) {
                const int row = rowb + 16 * m + fr; float o[8];
#pragma unroll
                for (int n = 0; n < 2; ++n)
#pragma unroll
                    for (int e = 0; e < 4; ++e) { const int k = 4 * n + e; const float g0 = acc[ai][0][m][n][e], up = acc[ai][1][m][n][e]; const float gp = m > 0 ? acc[ai][0][m > 0 ? m - 1 : 0][n][e] : 0.f;
                        const float g1 = dpp_old<0x111>(dpp_old<0x121>(0.f, gp), g0), g2 = dpp_old<0x112>(dpp_old<0x122>(0.f, gp), g0);
                        const float gc = bb[k] + w0[k] * g2 + w1[k] * g1 + w2[k] * g0; o[k] = gc / (1.f + __expf(-gc)) * up; }
                u32x4 w; w.x = cvt_pk_bf16(o[0], o[1]); w.y = cvt_pk_bf16(o[2], o[3]); w.z = cvt_pk_bf16(o[4], o[5]); w.w = cvt_pk_bf16(o[6], o[7]);
                *(u32x4*)(ACT + (size_t)row * dff + j0) = w;
                if (m == 0 && fr < 2) { float* pg = HTG + (blk * 2 + fr) * dff + j0; float* pu = HTU + (blk * 2 + fr) * dff + j0;
                    *(f32x4*)pg = acc[ai][0][0][0]; *(f32x4*)(pg + 4) = acc[ai][0][0][1]; *(f32x4*)pu = acc[ai][1][0][0]; *(f32x4*)(pu + 4) = acc[ai][1][0][1]; }
                if (m == 3 && fr >= 14) { float* pg = HBG + (blk * 2 + (fr - 14)) * dff + j0; *(f32x4*)pg = acc[ai][0][3][0]; *(f32x4*)(pg + 4) = acc[ai][0][3][1]; }
            }
        }
    }
};
struct EpiProjConv {
    static constexpr bool PERM = true, AFTER_DRAIN = false;
    bf16_t* O; int ldc; bf16_t* XBC; const float* cw; const float* cb; float* HT; float* HB;
    __device__ __forceinline__ void operator()(const f32x4 (&acc)[2][2][4][2], const Unit& u, int wr, int wc, int fr, int fq) const {
        if (u.pn < 8 || u.pn >= 24) {
            const int row0 = u.pm * BM + wr * 64 + fr; const int col0 = u.pn * BM + wc * 32 + 8 * fq;
#pragma unroll
            for (int ai = 0; ai < 2; ++ai)
#pragma unroll
                for (int m = 0; m < 4; ++m) { bf16_t* rowp = O + (size_t)(row0 + ai * HALF + m * 16) * ldc + col0;
#pragma unroll
                    for (int bj = 0; bj < 2; ++bj) { const f32x4 v0 = acc[ai][bj][m][0], v1 = acc[ai][bj][m][1];
                        u32x4 w; w.x = cvt_pk_bf16(v0[0], v0[1]); w.y = cvt_pk_bf16(v0[2], v0[3]); w.z = cvt_pk_bf16(v1[0], v1[1]); w.w = cvt_pk_bf16(v1[2], v1[3]);
                        *(u32x4*)(rowp + bj * HALF) = w; } }
            return;
        }
#pragma unroll
        for (int bj = 0; bj < 2; ++bj) {
            const int c0 = (u.pn - 8) * BM + bj * HALF + wc * 32 + 8 * fq;
            float wv[4][8], bb[8];
#pragma unroll
            for (int h = 0; h < 2; ++h) { const f32x4 d = *(const f32x4*)(cb + c0 + 4 * h);
#pragma unroll
                for (int e = 0; e < 4; ++e) bb[4 * h + e] = d[e];
#pragma unroll
                for (int i = 0; i < 4; ++i) { const f32x4 a = *(const f32x4*)(cw + i * 4096 + c0 + 4 * h);
#pragma unroll
                    for (int e = 0; e < 4; ++e) wv[i][4 * h + e] = a[e]; } }
#pragma unroll
            for (int ai = 0; ai < 2; ++ai) {
                const int rowb = u.pm * BM + ai * HALF + wr * 64; const size_t blk = (size_t)(rowb >> 6);
#pragma unroll
                for (int m = 0; m < 4; ++m) {
                    const int row = rowb + 16 * m + fr; float o[8];
#pragma unroll
                    for (int n = 0; n < 2; ++n)
#pragma unroll
                        for (int e = 0; e < 4; ++e) { const int k = 4 * n + e; const float x0 = acc[ai][bj][m][n][e]; const float xp = m > 0 ? acc[ai][bj][m > 0 ? m - 1 : 0][n][e] : 0.f;
                            const float x1 = dpp_old<0x111>(dpp_old<0x121>(0.f, xp), x0), x2 = dpp_old<0x112>(dpp_old<0x122>(0.f, xp), x0), x3 = dpp_old<0x113>(dpp_old<0x123>(0.f, xp), x0);
                            const float a = bb[k] + wv[0][k] * x3 + wv[1][k] * x2 + wv[2][k] * x1 + wv[3][k] * x0; o[k] = a / (1.f + __expf(-a)); }
                    u32x4 w; w.x = cvt_pk_bf16(o[0], o[1]); w.y = cvt_pk_bf16(o[2], o[3]); w.z = cvt_pk_bf16(o[4], o[5]); w.w = cvt_pk_bf16(o[6], o[7]);
                    *(u32x4*)(XBC + (size_t)row * 4096 + c0) = w;
                    if (m == 0 && fr < 3) { float* p = HT + (blk * 3 + fr) * 4096 + c0; *(f32x4*)p = acc[ai][bj][0][0]; *(f32x4*)(p + 4) = acc[ai][bj][0][1]; }
                    if (m == 3 && fr >= 13) { float* p = HB + (blk * 3 + (fr - 13)) * 4096 + c0; *(f32x4*)p = acc[ai][bj][3][0]; *(f32x4*)(p + 4) = acc[ai][bj][3][1]; }
                }
            }
        }
    }
};
struct EpiRes {
    static constexpr bool PERM = false, AFTER_DRAIN = false;
    const float* base; float* out; int ldc;
    __device__ __forceinline__ void operator()(const f32x4 (&acc)[2][2][4][2], const Unit& u, int wr, int wc, int fr, int fq) const {
        const int row0 = u.pm * BM + wr * 64 + fr, col0 = u.pn * BM + wc * 32 + 4 * fq;
#pragma unroll
        for (int ai = 0; ai < 2; ++ai)
#pragma unroll
            for (int m = 0; m < 4; ++m) { const size_t off = (size_t)(row0 + ai * HALF + m * 16) * ldc + col0;
#pragma unroll
                for (int bj = 0; bj < 2; ++bj)
#pragma unroll
                    for (int n = 0; n < 2; ++n) { const f32x4 bs = *(const f32x4*)(base + off + bj * HALF + n * 16); *(f32x4*)(out + off + bj * HALF + n * 16) = bs + acc[ai][bj][m][n]; } }
    }
};
template <class Epi, class Sched, bool ALIGN_EPI = false, bool SP2 = false>
__device__ __forceinline__ void gemm_phase(PG8_LAS unsigned char* lds, const Gemm g, const Sched& S, const Epi& E) {
    const int tid = threadIdx.x, wid = __builtin_amdgcn_readfirstlane(tid >> 6), lane = tid & 63, wr = wid >> 2, wc = wid & 3, fr = lane & 15, fq = lane >> 4;
    const int K = g.K, nt = K / BK;
    unsigned voffA[2], voffB[2];
#pragma unroll
    for (int i = 0; i < 2; ++i) { int R, C; stage_rc(tid * 16 + i * 8192, R, C); const int Rb = Epi::PERM ? ((R & ~31) + perm32(R & 31)) : R;
        voffA[i] = (unsigned)(R * K + C) * 2u; voffB[i] = (unsigned)(Rb * K + C) * 2u; }
    const size_t kstep = (size_t)(BK * 2);
    const size_t hstep = (size_t)HALF * K * 2;
    const size_t tstep = 2 * hstep;
    const unsigned ldsw = (unsigned)wid * 1024u;
    const int aoff = lds_byte(wr * 64 + fr, fq * 8), boff = lds_byte(wc * 32 + fr, fq * 8);
#define PG8_SA(b, h) (((b) * 2 + (h)) * HTB)
#define PG8_SB(b, h) ((4 + (b) * 2 + (h)) * HTB)
#define PG8_STAGE(bufoff, gbase, voff) do { _Pragma("unroll") for (int _i = 0; _i < 2; ++_i) \
        __builtin_amdgcn_global_load_lds((const unsigned*)((const char*)(gbase) + (voff)[_i]), (PG8_LAS unsigned*)(lds + (bufoff) + ldsw + _i * 8192), 16, 0, 0); } while (0)
#define PG8_LDA(dst, b, h) do { _Pragma("unroll") for (int m = 0; m < 4; ++m) _Pragma("unroll") for (int k = 0; k < 2; ++k) dst[m][k] = *(const PG8_LAS bf16x8*)(lds + PG8_SA(b, h) + aoff + m * 2048 + k * 1024); } while (0)
#define PG8_LDB(dst, b, h) do { _Pragma("unroll") for (int n = 0; n < 2; ++n) _Pragma("unroll") for (int k = 0; k < 2; ++k) dst[n][k] = *(const PG8_LAS bf16x8*)(lds + PG8_SB(b, h) + boff + n * 2048 + k * 1024); } while (0)
#define PG8_MMA(ai, bj, At, Bt) do { __builtin_amdgcn_s_setprio(1); _Pragma("unroll") for (int m = 0; m < 4; ++m) _Pragma("unroll") for (int n = 0; n < 2; ++n) _Pragma("unroll") for (int k = 0; k < 2; ++k) \
        acc[ai][bj][m][n] = __builtin_amdgcn_mfma_f32_16x16x32_bf16(Bt[n][k], At[m][k], acc[ai][bj][m][n], 0, 0, 0); __builtin_amdgcn_s_setprio(0); } while (0)
#define PG8_WAIT_V(n) asm volatile("s_waitcnt vmcnt(" #n ")" ::: "memory")
#define PG8_WAIT_L(n) asm volatile("s_waitcnt lgkmcnt(" #n ")" ::: "memory")
#define PG8_BAR __builtin_amdgcn_s_barrier()
#define PG8_SCHED __builtin_amdgcn_sched_barrier(0)
    Unit cur, nxt; int ui = 0;
    if (!S.next(0, cur)) return;
    f32x4 acc[2][2][4][2];
#pragma unroll
    for (int a = 0; a < 2; ++a)
#pragma unroll
        for (int b = 0; b < 2; ++b)
#pragma unroll
            for (int m = 0; m < 4; ++m)
#pragma unroll
                for (int n = 0; n < 2; ++n) acc[a][b][m][n] = (f32x4){0.f, 0.f, 0.f, 0.f};
    bf16x8 At[4][2], B0[2][2], B1[2][2];
    const char* cA = (const char*)g.A + (size_t)cur.pm * tstep; const char* cB = (const char*)g.Bt + (size_t)cur.pn * tstep;
    S.a_ready(cur);
    if constexpr (SP2) {
        PG8_STAGE(PG8_SB(0, 0), cB, voffB); PG8_STAGE(PG8_SB(0, 1), cB + hstep, voffB); PG8_STAGE(PG8_SA(0, 0), cA, voffA); PG8_STAGE(PG8_SA(0, 1), cA + hstep, voffA);
        if (wr == 1) PG8_BAR;
        PG8_WAIT_V(2); PG8_BAR;
        PG8_STAGE(PG8_SB(1, 0), cB + kstep, voffB); PG8_STAGE(PG8_SA(1, 0), cA + kstep, voffA); PG8_STAGE(PG8_SB(1, 1), cB + hstep + kstep, voffB);
        PG8_WAIT_V(6); PG8_BAR;
    } else {
        PG8_STAGE(PG8_SB(0, 0), cB, voffB); PG8_STAGE(PG8_SA(0, 0), cA, voffA); PG8_STAGE(PG8_SB(0, 1), cB + hstep, voffB); PG8_STAGE(PG8_SA(0, 1), cA + hstep, voffA);
        if (wr == 1) PG8_BAR;
        PG8_WAIT_V(4); PG8_BAR;
        PG8_STAGE(PG8_SB(1, 0), cB + kstep, voffB); PG8_STAGE(PG8_SA(1, 0), cA + kstep, voffA); PG8_STAGE(PG8_SB(1, 1), cB + hstep + kstep, voffB);
        PG8_WAIT_V(6); PG8_BAR;
    }
    for (;;) {
        const bool has_next = S.next(ui + 1, nxt);
        const char* nA = has_next ? (const char*)g.A + (size_t)nxt.pm * tstep : cA; const char* nB = has_next ? (const char*)g.Bt + (size_t)nxt.pn * tstep : cB;
        for (int t = 0; t < nt; t += 2) {
            const bool last = (t == nt - 2);
            const char* a1 = cA + (size_t)(t + 1) * kstep;
            const char* a2 = last ? nA : cA + (size_t)(t + 2) * kstep; const char* b2 = last ? nB : cB + (size_t)(t + 2) * kstep;
            const char* a3 = a2 + kstep; const char* b3 = b2 + kstep;
            if (last && has_next) S.a_ready(nxt);
            if constexpr (SP2) {
            PG8_LDB(B0, 0, 0); PG8_LDB(B1, 0, 1); PG8_SCHED; PG8_LDA(At, 0, 0); PG8_STAGE(PG8_SA(1, 1), a1 + hstep, voffA);
            PG8_WAIT_V(8); PG8_WAIT_L(0); PG8_BAR; PG8_MMA(0, 0, At, B0); PG8_MMA(0, 1, At, B1); PG8_BAR; PG8_SCHED;
            PG8_LDA(At, 0, 1); PG8_STAGE(PG8_SB(0, 0), b2, voffB); PG8_STAGE(PG8_SB(0, 1), b2 + hstep, voffB); PG8_STAGE(PG8_SA(0, 0), a2, voffA);
            PG8_WAIT_V(8); PG8_WAIT_L(0); PG8_BAR; PG8_MMA(1, 0, At, B0); PG8_MMA(1, 1, At, B1); PG8_BAR; PG8_SCHED;
            PG8_LDB(B0, 1, 0); PG8_LDB(B1, 1, 1); PG8_SCHED; PG8_LDA(At, 1, 0); PG8_STAGE(PG8_SA(0, 1), a2 + hstep, voffA);
            PG8_WAIT_V(8); PG8_WAIT_L(0); PG8_BAR; PG8_MMA(0, 0, At, B0); PG8_MMA(0, 1, At, B1); PG8_BAR; PG8_SCHED;
            PG8_LDA(At, 1, 1); PG8_STAGE(PG8_SB(1, 0), b3, voffB); PG8_STAGE(PG8_SB(1, 1), b3 + hstep, voffB); PG8_STAGE(PG8_SA(1, 0), a3, voffA);
            PG8_WAIT_V(8); PG8_WAIT_L(0); PG8_BAR; PG8_MMA(1, 0, At, B0); PG8_MMA(1, 1, At, B1); PG8_BAR; PG8_SCHED;
            } else {
            PG8_LDB(B0, 0, 0); PG8_SCHED; PG8_LDA(At, 0, 0); PG8_STAGE(PG8_SA(1, 1), a1 + hstep, voffA);
            PG8_WAIT_L(8); PG8_BAR; PG8_WAIT_L(0); PG8_MMA(0, 0, At, B0); PG8_BAR; PG8_SCHED;
            PG8_LDB(B1, 0, 1); PG8_STAGE(PG8_SB(0, 0), b2, voffB);
            PG8_BAR; PG8_WAIT_L(0); PG8_MMA(0, 1, At, B1); PG8_BAR;
            PG8_LDA(At, 0, 1); PG8_STAGE(PG8_SA(0, 0), a2, voffA);
            PG8_BAR; PG8_WAIT_L(0); PG8_MMA(1, 0, At, B0); PG8_BAR; PG8_SCHED;
            PG8_STAGE(PG8_SB(0, 1), b2 + hstep, voffB);
            PG8_WAIT_V(6); PG8_BAR; PG8_MMA(1, 1, At, B1); PG8_BAR;
            PG8_LDB(B0, 1, 0); PG8_SCHED; PG8_LDA(At, 1, 0); PG8_STAGE(PG8_SA(0, 1), a2 + hstep, voffA);
            PG8_WAIT_L(8); PG8_BAR; PG8_WAIT_L(0); PG8_MMA(0, 0, At, B0); PG8_BAR; PG8_SCHED;
            PG8_LDB(B1, 1, 1); PG8_STAGE(PG8_SB(1, 0), b3, voffB);
            PG8_BAR; PG8_WAIT_L(0); PG8_MMA(0, 1, At, B1); PG8_BAR;
            PG8_LDA(At, 1, 1); PG8_STAGE(PG8_SA(1, 0), a3, voffA);
            PG8_BAR; PG8_WAIT_L(0); PG8_MMA(1, 0, At, B0); PG8_BAR; PG8_SCHED;
            PG8_STAGE(PG8_SB(1, 1), b3 + hstep, voffB);
            PG8_WAIT_V(6); PG8_BAR; PG8_MMA(1, 1, At, B1); PG8_BAR;
            }
        }
        if constexpr (ALIGN_EPI) { if (wr == 0) PG8_BAR; }
        if constexpr (!Epi::AFTER_DRAIN) { E(acc, cur, wr, wc, fr, fq); S.done(cur); }
        if (!has_next) break;
#pragma unroll
        for (int a = 0; a < 2; ++a)
#pragma unroll
            for (int b = 0; b < 2; ++b)
#pragma unroll
                for (int m = 0; m < 4; ++m)
#pragma unroll
                    for (int n = 0; n < 2; ++n) acc[a][b][m][n] = (f32x4){0.f, 0.f, 0.f, 0.f};
        cur = nxt; cA = nA; cB = nB; ++ui;
        if constexpr (ALIGN_EPI) { if (wr == 1) PG8_BAR; }
    }
    PG8_WAIT_V(0);
    if constexpr (!ALIGN_EPI) { if (wr == 0) PG8_BAR; }
    PG8_BAR;
    if constexpr (Epi::AFTER_DRAIN) { E.fused(acc, cur, wr, wc, fr, fq, lds, wid, lane); S.done(cur); }
#undef PG8_SA
#undef PG8_SB
#undef PG8_STAGE
#undef PG8_LDA
#undef PG8_LDB
#undef PG8_MMA
#undef PG8_WAIT_V
#undef PG8_WAIT_L
#undef PG8_BAR
#undef PG8_SCHED
}
}

constexpr int NWAVES = 8, NTHR = NWAVES * 64;
constexpr int BATCH = 2, SEQ = 8192, M = BATCH * SEQ, DM = 4096, DEPTH = 2;
constexpr int SSD_W = 2048, SSD_H = 32, SSD_CD = 4096;
constexpr int SWA_W = 1024, SWA_H = 16;
constexpr int GLA_W = 1024, GLA_KT = 512;
constexpr int DFF = 11008, DIN = 10800, DINP = 11008, DGU = 2 * DFF;
constexpr float EPS = 1e-6f;
constexpr int C_Z = 0, C_XBC = 2048, C_DT = 6144, C_SQ = 6176, C_SK = 7200, C_SV = 7456, C_GQ = 7712, C_GK = 8224, C_GV = 8736, C_GG = 9760, C_GLR = 10784;
enum { I_X = 0, I_ATTN_NORM, I_W_IN, I_SSD_CONV_W, I_SSD_CONV_B, I_SSD_DT_BIAS, I_SSD_A_LOG, I_SSD_D, I_SSD_NORM, I_SWA_SINKS, I_SWA_NORM, I_GLA_W_GATE, I_GLA_B_GATE, I_GLA_NORM,
       I_W_OUT, I_FFN_NORM, I_W_GATE, I_W_UP, I_FFN_CONV_W, I_FFN_CONV_B, I_W_DOWN, I_REL_BIAS, I_FINAL_NORM, N_IN };

constexpr size_t MiB = 1u << 20;
constexpr size_t WS_CTL = 0, CTL_ZERO_BYTES = 1 * MiB;
constexpr size_t WS_WIN = 1 * MiB;
constexpr size_t WS_WOUT = 87 * MiB;
constexpr size_t WS_WGU = 119 * MiB;
constexpr size_t WS_WDN = 291 * MiB;
constexpr size_t WS_H = 377 * MiB;
constexpr size_t WS_R = 505 * MiB;
constexpr size_t WS_PROJ = WS_R;
constexpr size_t WS_XBC = WS_R + 344 * MiB;
constexpr size_t WS_QD = WS_R + 472 * MiB;
constexpr size_t WS_KI = WS_R + 488 * MiB;
constexpr size_t WS_DT = WS_R + 520 * MiB;
constexpr size_t WS_ACS = WS_R + 522 * MiB;
constexpr size_t WS_DEC = WS_R + 524 * MiB;
constexpr size_t WS_GDEC = WS_R + 525 * MiB;
constexpr size_t WS_ST = WS_R + 528 * MiB;
constexpr size_t WS_PV = WS_R + 656 * MiB;
constexpr size_t WS_GST = WS_R + 720 * MiB;
constexpr size_t WS_GPV = WS_R + 848 * MiB;
constexpr size_t WS_OSWA = WS_R + 912 * MiB;
constexpr size_t WS_Y = WS_R + 976 * MiB;
constexpr size_t WS_ACT = WS_R + 688 * MiB;
constexpr size_t WS_HTG = WS_R + 1032 * MiB, WS_HTU = WS_R + 1054 * MiB, WS_HBG = WS_R + 1076 * MiB;
constexpr size_t WS_XHT = WS_R + 504 * MiB, WS_XHB = WS_R + 1104 * MiB;
constexpr size_t WS_END = WS_R + 1120 * MiB;
static_assert(DEPTH == 2 && (size_t)DINP * DM * 2 == 86 * MiB && (size_t)DGU * DM * 2 == 172 * MiB && (size_t)M * DINP * 2 == 344 * MiB , "ws map");
constexpr int CW_BAR = 4096;

constexpr int RING_BYTES = 131072;
constexpr int MISC_OFF = 147456 - 256;
constexpr int LDS_BYTES = 147456;

#define GAS __attribute__((address_space(1)))
#define LAS __attribute__((address_space(3)))
typedef unsigned short bf16;
typedef unsigned v4u __attribute__((ext_vector_type(4)));
typedef unsigned v2u __attribute__((ext_vector_type(2)));
typedef float f32x4 __attribute__((ext_vector_type(4)));
typedef GAS unsigned gu32;
#define RLX_AGENT __ATOMIC_RELAXED, __HIP_MEMORY_SCOPE_AGENT
#define LDS_WAIT() asm volatile("s_waitcnt lgkmcnt(0)" ::: "memory")
__device__ __forceinline__ unsigned f2bf(float f) { unsigned u = __builtin_bit_cast(unsigned, f); return (u + 0x7fffu + ((u >> 16) & 1u)) >> 16; }
__device__ __forceinline__ unsigned pk2(float lo, float hi) { return f2bf(lo) | (f2bf(hi) << 16); }
__device__ __forceinline__ float bflo(unsigned w) { return __uint_as_float(w << 16); }
__device__ __forceinline__ float bfhi(unsigned w) { return __uint_as_float(w & 0xffff0000u); }
__device__ __forceinline__ float bf1(bf16 h) { return __uint_as_float((unsigned)h << 16); }
__device__ __forceinline__ float silu_f(float x) { return x / (1.f + __expf(-x)); }
__device__ __forceinline__ float wave_sum(float v) {
#pragma unroll
    for (int o = 1; o < 64; o <<= 1) v += __shfl_xor(v, o);
    return v;
}
template <int CTRL> __device__ __forceinline__ float dpp_f(float v) { return __int_as_float(__builtin_amdgcn_update_dpp(0, __float_as_int(v), CTRL, 0xf, 0xf, false)); }
__device__ __forceinline__ float row16_sum(float v) { v += dpp_f<0xB1>(v); v += dpp_f<0x4E>(v); v += dpp_f<0x124>(v); v += dpp_f<0x128>(v); return v; }
__device__ __forceinline__ float pair_sum(float v) { return v + dpp_f<0xB1>(v); }
#define XB_TMO      128
#define XB_XCNT(j)  (256  + 64 * (j))
#define XB_XSUB(j)  (1280 + 64 * (j))
#define XB_XGEN(j)  (2304 + 64 * (j))
#define XB_TOP      3328
#define XB_TOPGEN   3392
#define XCD_BAR_WORDS 3456
#define XB_SPIN_CAP (1u << 18)

__device__ __forceinline__ unsigned xb_ld(unsigned* p)              { return __hip_atomic_load(p, __ATOMIC_RELAXED, __HIP_MEMORY_SCOPE_AGENT); }
__device__ __forceinline__ unsigned xb_add(unsigned* p, unsigned v) { return __hip_atomic_fetch_add(p, v, __ATOMIC_RELAXED, __HIP_MEMORY_SCOPE_AGENT); }
__device__ __forceinline__ unsigned xb_xcc_id() { return (unsigned)__builtin_amdgcn_s_getreg((3 << 11) | 20) & 0xFu; }
#define XB_SPIN(cond, bar) do { unsigned _sp = 0; while (cond) { __builtin_amdgcn_s_sleep(1); \
    if ((++_sp & 255u) == 0u) { if (xb_ld(&(bar)[XB_TMO])) break; if (_sp > XB_SPIN_CAP) { atomicAdd(&(bar)[XB_TMO], 1u); break; } } } } while (0)

struct XcdBarrier {
    unsigned* bar; unsigned x;
    volatile LAS unsigned* st;
};

__device__ __forceinline__ XcdBarrier xcd_barrier_post(unsigned* bar, volatile LAS unsigned* st) {
    XcdBarrier b; b.bar = bar; b.x = xb_xcc_id(); b.st = st;
    if (threadIdx.x == 0) (void)xb_add(&bar[XB_XCNT(b.x)], 1u);
    return b;
}
__device__ __forceinline__ void xcd_barrier_complete(unsigned* bar, unsigned x, unsigned& nloc, unsigned& nx) {
    const unsigned G = gridDim.x * gridDim.y * gridDim.z;
    unsigned sum, cnt, mine, sp = 0u;
    for (;;) {
        sum = 0u; cnt = 0u; mine = 0u;
#pragma unroll
        for (unsigned j = 0; j < 16; ++j) { const unsigned c = xb_ld(&bar[XB_XCNT(j)]); sum += c; cnt += (c > 0u) ? 1u : 0u; mine = (j == x) ? c : mine; }
        if (sum == G) break;
        __builtin_amdgcn_s_sleep(1);
        if ((++sp & 255u) == 0u) { if (xb_ld(&bar[XB_TMO])) break; if (sp > XB_SPIN_CAP) { atomicAdd(&bar[XB_TMO], 1u); break; } }
    }
    nloc = mine > 0u ? mine : 1u; nx = cnt > 0u ? cnt : 1u;
}

__device__ __forceinline__ void xcd_barrier(const XcdBarrier& b) {
    asm volatile("s_waitcnt vmcnt(0)" ::: "memory");
    __syncthreads();
    if (threadIdx.x == 0) {
        unsigned* bar = b.bar;
        __builtin_amdgcn_s_waitcnt(0);
        unsigned nloc = b.st[0], nx = b.st[1];
        if (nloc == 0u) { xcd_barrier_complete(bar, b.x, nloc, nx); b.st[0] = nloc; b.st[1] = nx; }
        const unsigned old = xb_add(&bar[XB_XSUB(b.x)], 1u);
        const unsigned gen = old / nloc;
        if (old + 1u == (gen + 1u) * nloc) {
            __builtin_amdgcn_fence(__ATOMIC_RELEASE, "agent");
            asm volatile("s_waitcnt vmcnt(0)" ::: "memory");
            const unsigned og = xb_add(&bar[XB_TOP], 1u);
            const unsigned tg = og / nx;
            if (og + 1u == (tg + 1u) * nx) xb_add(&bar[XB_TOPGEN], 1u);
            else XB_SPIN(xb_ld(&bar[XB_TOPGEN]) == tg, bar);
            __builtin_amdgcn_fence(__ATOMIC_ACQUIRE, "agent");
            xb_add(&bar[XB_XGEN(b.x)], 1u);
            asm volatile("s_waitcnt vmcnt(0)" ::: "memory");
        } else {
            XB_SPIN(xb_ld(&bar[XB_XGEN(b.x)]) == gen, bar);
            __builtin_amdgcn_fence(__ATOMIC_ACQUIRE, "agent");
            asm volatile("s_waitcnt vmcnt(0)" ::: "memory");
        }
    }
    __syncthreads();
}

struct Args { const float* in[N_IN]; float* out; unsigned char* ws; int ph_lo, ph_hi, li, pad; };
struct Ctx {
    LAS unsigned char* lds;
    int tid, lane, wave, G, bid;
    const float* const* in; float* out; unsigned char* ws;
};
__device__ const unsigned char T5_BUCKET[128] = {0, 1, 2, 3, 4, 5, 6, 7, 8, 9, 10, 11, 12, 13, 14, 15, 16, 16, 16, 17, 17, 18, 18, 18, 19, 19, 19, 20, 20, 20, 20, 21, 21, 21, 21, 22, 22, 22, 22, 22, 23, 23, 23, 23, 23, 23, 24, 24, 24, 24, 24, 24, 25, 25, 25, 25, 25, 25, 25, 26, 26, 26, 26, 26, 26, 26, 26, 27, 27, 27, 27, 27, 27, 27, 27, 27, 27, 28, 28, 28, 28, 28, 28, 28, 28, 28, 28, 29, 29, 29, 29, 29, 29, 29, 29, 29, 29, 29, 29, 30, 30, 30, 30, 30, 30, 30, 30, 30, 30, 30, 30, 30, 30, 31, 31, 31, 31, 31, 31, 31, 31, 31, 31, 31, 31, 31, 31, 31};

struct TItem { const float* src; bf16* dst; int N, K, nvalid; };
constexpr int CV_NITEMS = 32 * 86 * 3 + 32 * 32 + 86 * 32;
__device__ __forceinline__ TItem titem_decode(Ctx& C, int l, int it) {
    constexpr int I_IN = 32 * 86, I_OUT = 32 * 32, I_G = 32 * 86;
    TItem t; int r = it, kb, nb;
    if (r < I_IN) { kb = r / 86; nb = r % 86; t.N = DIN; t.K = DM; t.src = C.in[I_W_IN] + (size_t)l * DM * DIN; t.dst = (bf16*)(C.ws + WS_WIN) + (size_t)(128 * nb) * DM; }
    else if ((r -= I_IN) < I_OUT) { kb = r / 32; nb = r % 32; t.N = DM; t.K = DM; t.src = C.in[I_W_OUT] + (size_t)l * DM * DM; t.dst = (bf16*)(C.ws + WS_WOUT) + (size_t)(128 * nb) * DM; }
    else if ((r -= I_OUT) < I_G) { kb = r / 86; nb = r % 86; t.N = DFF; t.K = DM; t.src = C.in[I_W_GATE] + (size_t)l * DM * DFF; t.dst = (bf16*)(C.ws + WS_WGU) + (size_t)(256 * nb) * DM; }
    else if ((r -= I_G) < I_G) { kb = r / 86; nb = r % 86; t.N = DFF; t.K = DM; t.src = C.in[I_W_UP] + (size_t)l * DM * DFF; t.dst = (bf16*)(C.ws + WS_WGU) + (size_t)(256 * nb + 128) * DM; }
    else { r -= I_G; kb = r / 32; nb = r % 32; t.N = DM; t.K = DFF; t.src = C.in[I_W_DOWN] + (size_t)l * DFF * DM; t.dst = (bf16*)(C.ws + WS_WDN) + (size_t)(128 * nb) * DFF; }
    t.src += (size_t)(128 * kb) * t.N + 128 * nb; t.dst += 128 * kb;
    const int rem = t.N - 128 * nb; t.nvalid = rem >= 128 ? 128 : (rem > 0 ? rem : 0);
    return t;
}
__device__ __forceinline__ void titem_load(const TItem& t, f32x4 (&v)[8], int wave, int lane) {
    const bool nv = 4 * (lane & 31) < t.nvalid; const float* p = t.src + (size_t)(16 * wave + 2 * (lane >> 5)) * t.N + 4 * (lane & 31);
#pragma unroll
    for (int i = 0; i < 4; ++i) { v[2 * i] = nv ? *(const GAS f32x4*)(p + (size_t)(4 * i) * t.N) : (f32x4){0.f, 0.f, 0.f, 0.f}; v[2 * i + 1] = nv ? *(const GAS f32x4*)(p + (size_t)(4 * i + 1) * t.N) : (f32x4){0.f, 0.f, 0.f, 0.f}; }
}
__device__ __forceinline__ void titem_store(const TItem& t, const f32x4 (&v)[8], LAS unsigned* T, int tid, int wave, int lane) {
    __syncthreads();
    { const int kd = 8 * wave + (lane >> 5);
#pragma unroll
      for (int i = 0; i < 4; ++i)
#pragma unroll
          for (int e = 0; e < 4; ++e) T[(4 * (lane & 31) + e) * 65 + kd + 2 * i] = pg8::cvt_pk_bf16(v[2 * i][e], v[2 * i + 1][e]); }
    __syncthreads();
    const int ch = tid & 15;
#pragma unroll
    for (int ps = 0; ps < 4; ++ps) { const int n = 32 * ps + (tid >> 4); const LAS unsigned* s = T + n * 65 + 4 * ch;
        v4u o; o.x = s[0]; o.y = s[1]; o.z = s[2]; o.w = s[3];
        *(GAS v4u*)(t.dst + (size_t)n * t.K + 8 * ch) = o; }
}
__device__ __forceinline__ void convert_weights(Ctx& C, int l) {
    LAS unsigned* T = (LAS unsigned*)C.lds;
    int it = C.bid; if (it >= CV_NITEMS) return;
    TItem cur = titem_decode(C, l, it); f32x4 va[8], vb[8];
    titem_load(cur, va, C.wave, C.lane);
    for (;;) {
        int nx = it + C.G; TItem tn = cur; const bool hn = nx < CV_NITEMS;
        if (hn) { tn = titem_decode(C, l, nx); titem_load(tn, vb, C.wave, C.lane); }
        titem_store(cur, va, T, C.tid, C.wave, C.lane);
        if (!hn) break;
        nx += C.G; const bool hn2 = nx < CV_NITEMS; TItem t2 = tn;
        if (hn2) { t2 = titem_decode(C, l, nx); titem_load(t2, va, C.wave, C.lane); }
        titem_store(tn, vb, T, C.tid, C.wave, C.lane);
        if (!hn2) break;
        cur = t2; it = nx;
    }
    __syncthreads();
}
__device__ __forceinline__ void rmsnorm_row_bf16(const float* xrow, const float* w, bf16* orow, int lane) {
    const GAS f32x4* xr = (const GAS f32x4*)xrow + lane; const GAS f32x4* wr = (const GAS f32x4*)w + lane;
    f32x4 v[16]; float ss = 0.f;
#pragma unroll
    for (int j = 0; j < 16; ++j) { v[j] = xr[64 * j]; ss += (v[j].x * v[j].x + v[j].y * v[j].y) + (v[j].z * v[j].z + v[j].w * v[j].w); }
    const float rstd = 1.f / sqrtf(wave_sum(ss) * (1.f / DM) + EPS);
    GAS v2u* o8 = (GAS v2u*)orow + lane;
#pragma unroll
    for (int j = 0; j < 16; ++j) { const f32x4 g = wr[64 * j]; v2u o; o.x = pk2(v[j].x * rstd * g.x, v[j].y * rstd * g.y); o.y = pk2(v[j].z * rstd * g.z, v[j].w * rstd * g.w); o8[64 * j] = o; }
}
__device__ __forceinline__ void rmsnorm_phase(Ctx& C, const float* X, const float* w, bf16* H) {
    const int gw = C.bid * NWAVES + C.wave, NGW = C.G * NWAVES;
    for (int m = gw; m < M; m += NGW) rmsnorm_row_bf16(X + (size_t)m * DM, w, H + (size_t)m * DM, C.lane);
}
__device__ __forceinline__ void final_norm_phase(Ctx& C, float* X, const float* w) {
    const int gw = C.bid * NWAVES + C.wave, NGW = C.G * NWAVES;
    for (int m = gw; m < M; m += NGW) {
        GAS f32x4* xr = (GAS f32x4*)(X + (size_t)m * DM) + C.lane; const GAS f32x4* wr = (const GAS f32x4*)w + C.lane;
        f32x4 v[16]; float ss = 0.f;
#pragma unroll
        for (int j = 0; j < 16; ++j) { v[j] = xr[64 * j]; ss += (v[j].x * v[j].x + v[j].y * v[j].y) + (v[j].z * v[j].z + v[j].w * v[j].w); }
        const float rstd = 1.f / sqrtf(wave_sum(ss) * (1.f / DM) + EPS);
#pragma unroll
        for (int j = 0; j < 16; ++j) { const f32x4 g = wr[64 * j]; xr[64 * j] = v[j] * rstd * g; }
    }
}

typedef short bf16x8 __attribute__((ext_vector_type(8)));
typedef short s16x4 __attribute__((ext_vector_type(4)));
__device__ __forceinline__ f32x4 mfma16(bf16x8 a, bf16x8 b, f32x4 c) { return __builtin_amdgcn_mfma_f32_16x16x32_bf16(a, b, c, 0, 0, 0); }
__device__ __forceinline__ bf16x8 pack8(f32x4 lo, f32x4 hi) { v4u w; w.x = pg8::cvt_pk_bf16(lo.x, lo.y); w.y = pg8::cvt_pk_bf16(lo.z, lo.w); w.z = pg8::cvt_pk_bf16(hi.x, hi.y); w.w = pg8::cvt_pk_bf16(hi.z, hi.w); return __builtin_bit_cast(bf16x8, w); }
__device__ __forceinline__ bf16x8 gfrag(const bf16* Mx, size_t ld, int row0, int k0, int lane) { return *(const GAS bf16x8*)(Mx + (size_t)(row0 + (lane & 15)) * ld + k0 + 8 * (lane >> 4)); }
__device__ __forceinline__ bf16x8 trfrag(const LAS unsigned char* img, int stride, int r0, int r1, int col0, int lane) {
    const int q = (lane & 15) >> 2, p = lane & 3;
    const s16x4 a = __builtin_amdgcn_ds_read_tr16_b64_v4i16((LAS s16x4*)(img + (r0 + q) * stride + (col0 + 4 * p) * 2));
    const s16x4 b = __builtin_amdgcn_ds_read_tr16_b64_v4i16((LAS s16x4*)(img + (r1 + q) * stride + (col0 + 4 * p) * 2));
    return __builtin_shufflevector(a, b, 0, 1, 2, 3, 4, 5, 6, 7);
}
__device__ __forceinline__ float xsum4(float v) { v += __shfl_xor(v, 16); v += __shfl_xor(v, 32); return v; }
__device__ __forceinline__ float xmax4(float v) { v = fmaxf(v, __shfl_xor(v, 16)); v = fmaxf(v, __shfl_xor(v, 32)); return v; }

constexpr int SWA_VSTRIDE = 144;
constexpr int SWA_V_BYTES = 192 * SWA_VSTRIDE;
__device__ __forceinline__ void swa_unit_mfma(Ctx& C, int l, int unit) {
    const int b = unit >> 7, qb = unit & 127, q0 = qb * 64;
    const int tid = C.tid, lane = C.lane, w = C.wave, c = lane & 15, hq = lane >> 4;
    LAS unsigned char* Vimg = C.lds;
    LAS float* tb = (LAS float*)(C.lds + 30720);
    LAS float* ssqx = (LAS float*)(C.lds + 30720 + 12288);
    const bf16* PROJ = (const bf16*)(C.ws + WS_PROJ); float* OSWA = (float*)(C.ws + WS_OSWA); bf16* Y = (bf16*)(C.ws + WS_Y);
    const bf16* Pb = PROJ + (size_t)b * SEQ * DINP;
    __syncthreads();
    for (int i = tid; i < 16 * 192; i += NTHR) { const int hd = i / 192, x = i % 192, dist = x - 32; tb[i] = (dist >= 0 && dist < 128) ? C.in[I_REL_BIAS][T5_BUCKET[dist] * SWA_H + hd] : 0.f; }
    if (tid < 16 * 9) *(LAS v4u*)(Vimg + (192 + tid / 9) * SWA_VSTRIDE + 16 * (tid % 9)) = (v4u){0u, 0u, 0u, 0u};
    const int g = w >> 1, qhalf = w & 1;
    float ssq0 = 0.f, ssq1 = 0.f;
    for (int kvh = 0; kvh < 4; ++kvh) {
        const int head = kvh * 4 + g;
        __syncthreads();
#pragma unroll
        for (int it = 0; it < 3; ++it) { const int idx = tid + NTHR * it, j = idx >> 3, cg = idx & 7; int s = q0 - 128 + j; s = s < 0 ? 0 : s;
            const v4u v = *(const GAS v4u*)(Pb + (size_t)s * DINP + C_SV + kvh * 64 + 8 * cg); *(LAS v4u*)(Vimg + j * SWA_VSTRIDE + 16 * cg) = v; }
        __syncthreads();
        const float sink = C.in[I_SWA_SINKS][l * SWA_H + head];
#pragma nounroll
        for (int qt = 0; qt < 2; ++qt) {
            const int j0 = 32 * qhalf + 16 * qt;
            const bf16x8 qf0 = gfrag(Pb + C_SQ + head * 64, DINP, q0 + j0, 0, lane), qf1 = gfrag(Pb + C_SQ + head * 64, DINP, q0 + j0, 32, lane);
            f32x4 sacc[10];
#pragma unroll
            for (int kt = 0; kt < 10; ++kt) {
                int srow = q0 - 128 + j0 + 16 * kt + c; srow = srow < 0 ? 0 : srow; srow = srow > q0 + 63 ? q0 + 63 : srow;
                const bf16* kp = Pb + (size_t)srow * DINP + C_SK + kvh * 64 + 8 * hq;
                const bf16x8 k0 = *(const GAS bf16x8*)kp, k1 = *(const GAS bf16x8*)(kp + 32);
                f32x4 a = (f32x4){0.f, 0.f, 0.f, 0.f}; a = mfma16(k0, qf0, a); a = mfma16(k1, qf1, a); sacc[kt] = a;
            }
            float mx = sink;
#pragma unroll
            for (int kt = 0; kt < 10; ++kt)
#pragma unroll
                for (int r = 0; r < 4; ++r) { const int dist = c + 128 - 16 * kt - 4 * hq - r; const int s = q0 - 128 + j0 + 16 * kt + 4 * hq + r;
                    const bool valid = (dist >= 0) && (dist < 128) && (s >= 0);
                    const float sc = valid ? sacc[kt][r] * 0.125f + tb[head * 192 + dist + 32] : -1e30f;
                    sacc[kt][r] = sc; mx = fmaxf(mx, sc); }
            mx = xmax4(mx); float sum = 0.f;
#pragma unroll
            for (int kt = 0; kt < 10; ++kt)
#pragma unroll
                for (int r = 0; r < 4; ++r) { const float p = __expf(sacc[kt][r] - mx); sacc[kt][r] = p; sum += p; }
            sum = xsum4(sum); const float inv = 1.f / (sum + __expf(sink - mx));
            f32x4 oacc[4];
#pragma unroll
            for (int dt = 0; dt < 4; ++dt) oacc[dt] = (f32x4){0.f, 0.f, 0.f, 0.f};
#pragma unroll
            for (int ks = 0; ks < 5; ++ks) { const bf16x8 pf = pack8(sacc[2 * ks], sacc[2 * ks + 1]);
#pragma unroll
                for (int dt = 0; dt < 4; ++dt) oacc[dt] = mfma16(trfrag(Vimg, SWA_VSTRIDE, j0 + 32 * ks + 4 * hq, j0 + 32 * ks + 16 + 4 * hq, 16 * dt, lane), pf, oacc[dt]); }
            float sq = 0.f; float* op = OSWA + (size_t)(b * SEQ + q0 + j0 + c) * SWA_W + head * 64 + 4 * hq;
#pragma unroll
            for (int dt = 0; dt < 4; ++dt) { const f32x4 o = oacc[dt] * inv; sq += (o.x * o.x + o.y * o.y) + (o.z * o.z + o.w * o.w); *(GAS f32x4*)(op + 16 * dt) = o; }
            if (qt == 0) ssq0 += sq; else ssq1 += sq;
        }
    }
    ssq0 = xsum4(ssq0); ssq1 = xsum4(ssq1);
    if (hq == 0) { ssqx[w * 32 + c] = ssq0; ssqx[w * 32 + 16 + c] = ssq1; }
    asm volatile("s_waitcnt vmcnt(0)" ::: "memory");
    __syncthreads();
    const float* swa_norm = C.in[I_SWA_NORM] + (size_t)l * SWA_W;
#pragma nounroll
    for (int qt = 0; qt < 2; ++qt) { const int qi = 16 * qt + c;
        const float tot = ssqx[(qhalf + 0) * 32 + qi] + ssqx[(qhalf + 2) * 32 + qi] + ssqx[(qhalf + 4) * 32 + qi] + ssqx[(qhalf + 6) * 32 + qi];
        const float rstd = 1.f / sqrtf(tot * (1.f / 1024.f) + EPS);
        const size_t row = (size_t)(b * SEQ + q0 + 32 * qhalf + qi);
#pragma unroll
        for (int kvh = 0; kvh < 4; ++kvh)
#pragma unroll
            for (int dt = 0; dt < 4; ++dt) { const int col = (kvh * 4 + g) * 64 + 16 * dt + 4 * hq; const f32x4 o = *(const GAS f32x4*)(OSWA + row * SWA_W + col); const f32x4 gn = *(const GAS f32x4*)(swa_norm + col);
                v2u ow; ow.x = pk2(o.x * rstd * gn.x, o.y * rstd * gn.y); ow.y = pk2(o.z * rstd * gn.z, o.w * rstd * gn.w); *(GAS v2u*)(Y + row * DM + 2048 + col) = ow; } }
}

constexpr int N_SWA_UNITS = BATCH * (SEQ / 64);

constexpr int SSD_L = 128, SSD_NC = SEQ / SSD_L, GLA_L = 64, GLA_NC = SEQ / GLA_L;
constexpr int N_SSD_CU = BATCH * SSD_NC * 8, N_GLA_CU = BATCH * GLA_NC * 4;
constexpr int XI_STRIDE = 528, BI_STRIDE = 272;

__device__ __forceinline__ void prep_phase(Ctx& C, int l) {
    const bf16* PROJ = (const bf16*)(C.ws + WS_PROJ); bf16* XBC = (bf16*)(C.ws + WS_XBC);
    const int tid = C.tid, lane = C.lane;
    { const int gw0 = C.bid * NWAVES + C.wave;
      for (int gw = gw0; gw < BATCH * SSD_NC * 16; gw += C.G * NWAVES) if ((gw & 15) == 0 && lane < SSD_H) {
          const int bc = gw >> 4; const size_t row0 = (size_t)bc * SSD_L;
          float* DT = (float*)(C.ws + WS_DT); float* ACS = (float*)(C.ws + WS_ACS); float* DEC = (float*)(C.ws + WS_DEC);
          const float dtb = C.in[I_SSD_DT_BIAS][l * SSD_H + lane], Ah = -expf(C.in[I_SSD_A_LOG][l * SSD_H + lane]);
          float cs = 0.f;
#pragma unroll 8
          for (int s = 0; s < SSD_L; ++s) { const float xr = bf1(PROJ[(row0 + s) * DINP + C_DT + lane]) + dtb; const float dt = xr > 20.f ? xr : log1pf(expf(xr)); cs += dt * Ah;
              DT[(row0 + s) * SSD_H + lane] = dt; ACS[(row0 + s) * SSD_H + lane] = cs; }
          DEC[bc * SSD_H + lane] = expf(cs);
      } }
    { const float* conv_w = C.in[I_SSD_CONV_W] + (size_t)l * 4 * SSD_CD; const float* conv_b = C.in[I_SSD_CONV_B] + (size_t)l * SSD_CD;
      const float* HT = (const float*)(C.ws + WS_XHT); const float* HB = (const float*)(C.ws + WS_XHB);
      constexpr int NIT = (M / 64) * 3 * 1024;
      for (int it = C.bid * NTHR + tid; it < NIT; it += C.G * NTHR) {
          const int c4 = it & 1023, ri = it >> 10, i = ri % 3, blk = ri / 3, c0 = 4 * c4; const bool first = (blk % (SEQ / 64)) == 0;
          f32x4 sq[6]; const f32x4 z4 = (f32x4){0.f, 0.f, 0.f, 0.f};
#pragma unroll
          for (int j = 0; j < 3; ++j) { sq[j] = first ? z4 : *(const GAS f32x4*)(HB + ((size_t)(blk - 1) * 3 + j) * 4096 + c0); sq[3 + j] = *(const GAS f32x4*)(HT + ((size_t)blk * 3 + j) * 4096 + c0); }
          const f32x4 x3 = i == 0 ? sq[0] : (i == 1 ? sq[1] : sq[2]), x2 = i == 0 ? sq[1] : (i == 1 ? sq[2] : sq[3]), x1 = i == 0 ? sq[2] : (i == 1 ? sq[3] : sq[4]), x0 = i == 0 ? sq[3] : (i == 1 ? sq[4] : sq[5]);
          const f32x4 w0 = *(const GAS f32x4*)(conv_w + c0), w1 = *(const GAS f32x4*)(conv_w + 4096 + c0), w2 = *(const GAS f32x4*)(conv_w + 2 * 4096 + c0), w3 = *(const GAS f32x4*)(conv_w + 3 * 4096 + c0), bb = *(const GAS f32x4*)(conv_b + c0);
          f32x4 o;
#pragma unroll
          for (int e = 0; e < 4; ++e) o[e] = silu_f(bb[e] + w0[e] * x3[e] + w1[e] * x2[e] + w2[e] * x1[e] + w3[e] * x0[e]);
          v2u ow; ow.x = pk2(o.x, o.y); ow.y = pk2(o.z, o.w); *(GAS v2u*)(XBC + (size_t)(64 * blk + i) * SSD_CD + c0) = ow;
      } }
    { LAS float* glr = (LAS float*)C.lds;
      bf16* QD = (bf16*)(C.ws + WS_QD); bf16* KI = (bf16*)(C.ws + WS_KI); float* GDEC = (float*)(C.ws + WS_GDEC);
      const float* w_gate = C.in[I_GLA_W_GATE] + (size_t)l * 16 * GLA_KT; const float bgv = C.in[I_GLA_B_GATE][l * GLA_KT + tid];
      float wg[16];
#pragma unroll
      for (int r = 0; r < 16; ++r) wg[r] = w_gate[r * GLA_KT + tid];
      for (int ck = C.bid; ck < BATCH * GLA_NC; ck += C.G) {
          const size_t row0 = (size_t)ck * GLA_L;
          __syncthreads();
          if (tid < 128) { const int t = tid >> 1, hf = tid & 1; const v4u r = *(const GAS v4u*)(PROJ + (row0 + t) * DINP + C_GLR + 8 * hf);
              *(LAS f32x4*)(glr + t * 16 + 8 * hf) = (f32x4){bflo(r.x), bfhi(r.x), bflo(r.y), bfhi(r.y)}; *(LAS f32x4*)(glr + t * 16 + 8 * hf + 4) = (f32x4){bflo(r.z), bfhi(r.z), bflo(r.w), bfhi(r.w)}; }
          __syncthreads();
          float cum = 0.f;
#pragma unroll 8
          for (int t = 0; t < GLA_L; ++t) {
              const float qv = bf1(PROJ[(row0 + t) * DINP + C_GQ + tid]), kv = bf1(PROJ[(row0 + t) * DINP + C_GK + tid]);
              float z = bgv;
#pragma unroll
              for (int r4 = 0; r4 < 4; ++r4) { const f32x4 gv = *(const LAS f32x4*)(glr + t * 16 + 4 * r4); z += gv.x * wg[4 * r4] + gv.y * wg[4 * r4 + 1] + gv.z * wg[4 * r4 + 2] + gv.w * wg[4 * r4 + 3]; }
              const float ls = fminf(z, 0.f) - __logf(1.f + __expf(-fabsf(z))); cum += ls * 0.0625f;
              QD[(row0 + t) * GLA_KT + tid] = (bf16)f2bf(qv * 0.08838834764831845f * __expf(cum)); KI[(row0 + t) * GLA_KT + tid] = (bf16)f2bf(kv * __expf(-cum));
          }
          GDEC[(size_t)ck * GLA_KT + tid] = __expf(cum);
      } }
}

__device__ __forceinline__ void gla_c1_unit(Ctx& C, int unit) {
    const int h = unit & 3, ck = unit >> 2; const size_t row0 = (size_t)ck * GLA_L;
    const int tid = C.tid, lane = C.lane, w = C.wave, c = lane & 15, hq = lane >> 4;
    LAS unsigned char* KEimg = C.lds; LAS unsigned char* Vimg = C.lds + 64 * BI_STRIDE;
    const bf16* PROJ = (const bf16*)(C.ws + WS_PROJ); const bf16* KI = (const bf16*)(C.ws + WS_KI); const float* GDEC = (const float*)(C.ws + WS_GDEC); bf16* GST = (bf16*)(C.ws + WS_GST);
    __syncthreads();
    { const int cg = tid & 15; const f32x4 d0 = *(const GAS f32x4*)(GDEC + (size_t)ck * GLA_KT + h * 128 + 8 * cg), d1 = *(const GAS f32x4*)(GDEC + (size_t)ck * GLA_KT + h * 128 + 8 * cg + 4);
#pragma unroll
      for (int it = 0; it < 2; ++it) { const int t = (tid + NTHR * it) >> 4; const v4u r = *(const GAS v4u*)(KI + (row0 + t) * GLA_KT + h * 128 + 8 * cg);
          v4u o; o.x = pk2(bflo(r.x) * d0.x, bfhi(r.x) * d0.y); o.y = pk2(bflo(r.y) * d0.z, bfhi(r.y) * d0.w); o.z = pk2(bflo(r.z) * d1.x, bfhi(r.z) * d1.y); o.w = pk2(bflo(r.w) * d1.z, bfhi(r.w) * d1.w);
          *(LAS v4u*)(KEimg + t * BI_STRIDE + 16 * cg) = o; } }
#pragma unroll
    for (int it = 0; it < 4; ++it) { const int idx = tid + NTHR * it, t = idx >> 5, cg = idx & 31; *(LAS v4u*)(Vimg + t * XI_STRIDE + 16 * cg) = *(const GAS v4u*)(PROJ + (row0 + t) * DINP + C_GV + h * 256 + 8 * cg); }
    __syncthreads();
    f32x4 acc[16];
#pragma unroll
    for (int nt = 0; nt < 16; ++nt) acc[nt] = (f32x4){0.f, 0.f, 0.f, 0.f};
#pragma unroll
    for (int ks = 0; ks < 2; ++ks) { const bf16x8 af = trfrag(KEimg, BI_STRIDE, 32 * ks + 8 * hq, 32 * ks + 8 * hq + 4, 16 * w, lane);
#pragma unroll
        for (int nt = 0; nt < 16; ++nt) acc[nt] = mfma16(af, trfrag(Vimg, XI_STRIDE, 32 * ks + 8 * hq, 32 * ks + 8 * hq + 4, 16 * nt, lane), acc[nt]); }
    bf16* gp = GST + (size_t)unit * 32768 + 16 * w + 4 * hq;
#pragma unroll
    for (int nt = 0; nt < 16; ++nt) { v2u o; o.x = pk2(acc[nt].x, acc[nt].y); o.y = pk2(acc[nt].z, acc[nt].w); *(GAS v2u*)(gp + (size_t)(16 * nt + c) * 128) = o; }
}

__device__ __forceinline__ void scan_phase(Ctx& C) {
    const bf16* GST = (const bf16*)(C.ws + WS_GST); bf16* GPV = (bf16*)(C.ws + WS_GPV); const float* GDEC = (const float*)(C.ws + WS_GDEC);
    const bf16* ST = (const bf16*)(C.ws + WS_ST); bf16* PV = (bf16*)(C.ws + WS_PV); const float* DEC = (const float*)(C.ws + WS_DEC);
    constexpr int N_G = BATCH * 4 * 256 * 32, N_S = BATCH * SSD_H * 64 * 32;
    for (int it = C.bid * NTHR + C.tid; it < N_G + N_S; it += C.G * NTHR) {
        if (it < N_S) {
            const int n4 = it & 31, p = (it >> 5) & 63, h = (it >> 11) & 31, b = it >> 16;
            f32x4 run = (f32x4){0.f, 0.f, 0.f, 0.f};
#pragma unroll 8
            for (int c = 0; c < SSD_NC; ++c) { const size_t u = (size_t)(b * SSD_NC + c) * SSD_H + h; const size_t off = u * 8192 + p * 128 + 4 * n4;
                const v2u xr = *(const GAS v2u*)(ST + off); const f32x4 x = (f32x4){bflo(xr.x), bfhi(xr.x), bflo(xr.y), bfhi(xr.y)}; const float d = DEC[u];
                v2u o; o.x = pk2(run.x, run.y); o.y = pk2(run.z, run.w); *(GAS v2u*)(PV + off) = o;
                run = run * d + x; }
        } else {
            const int i2 = it - N_S; const int k4 = i2 & 31, v = (i2 >> 5) & 255, h = (i2 >> 13) & 3, b = i2 >> 15;
            f32x4 run = (f32x4){0.f, 0.f, 0.f, 0.f};
#pragma unroll 8
            for (int c = 0; c < GLA_NC; ++c) { const size_t ck = (size_t)(b * GLA_NC + c); const size_t off = (ck * 4 + h) * 32768 + v * 128 + 4 * k4;
                const v2u xr = *(const GAS v2u*)(GST + off); const f32x4 x = (f32x4){bflo(xr.x), bfhi(xr.x), bflo(xr.y), bfhi(xr.y)}; const f32x4 d = *(const GAS f32x4*)(GDEC + ck * GLA_KT + h * 128 + 4 * k4);
                v2u o; o.x = pk2(run.x, run.y); o.y = pk2(run.z, run.w); *(GAS v2u*)(GPV + off) = o;
                run = run * d + x; }
        }
    }
}

constexpr int GC3_GP_OFF = 64 * XI_STRIDE, GC3_XCH_OFF = GC3_GP_OFF + 256 * BI_STRIDE;
__device__ __forceinline__ void gla_c3_unit(Ctx& C, int l, int unit) {
    const int h = unit & 3, ck = unit >> 2; const size_t row0 = (size_t)ck * GLA_L;
    const int tid = C.tid, lane = C.lane, w = C.wave, c = lane & 15, hq = lane >> 4;
    LAS unsigned char* Vimg = C.lds; LAS unsigned char* GPimg = C.lds + GC3_GP_OFF; LAS float* xch = (LAS float*)(C.lds + GC3_XCH_OFF);
    const bf16* PROJ = (const bf16*)(C.ws + WS_PROJ); const bf16* QD = (const bf16*)(C.ws + WS_QD); const bf16* KI = (const bf16*)(C.ws + WS_KI); const bf16* GPV = (const bf16*)(C.ws + WS_GPV); bf16* Y = (bf16*)(C.ws + WS_Y);
    const int lt = w >> 1, vh = w & 1; const size_t row = row0 + 16 * lt + c;
    __syncthreads();
    { const bf16* gpv = GPV + (size_t)unit * 32768;
      v4u tv[4], tg[8];
#pragma unroll
      for (int it = 0; it < 4; ++it) { const int idx = tid + NTHR * it, t = idx >> 5, cg = idx & 31; tv[it] = *(const GAS v4u*)(PROJ + (row0 + t) * DINP + C_GV + h * 256 + 8 * cg); }
#pragma unroll
      for (int it = 0; it < 8; ++it) { const int idx = tid + NTHR * it; tg[it] = *(const GAS v4u*)(gpv + (size_t)idx * 8); }
#pragma unroll
      for (int it = 0; it < 4; ++it) { const int idx = tid + NTHR * it, t = idx >> 5, cg = idx & 31; *(LAS v4u*)(Vimg + t * XI_STRIDE + 16 * cg) = tv[it]; }
#pragma unroll
      for (int it = 0; it < 8; ++it) { const int idx = tid + NTHR * it, v = idx >> 4, cg = idx & 15; *(LAS v4u*)(GPimg + v * BI_STRIDE + 16 * cg) = tg[it]; } }
    bf16x8 qf[4];
#pragma unroll
    for (int ks = 0; ks < 4; ++ks) qf[ks] = gfrag(QD + row0 * GLA_KT + h * 128, GLA_KT, 16 * lt, 32 * ks, lane);
    v2u ggv[8];
#pragma unroll
    for (int vt = 0; vt < 8; ++vt) ggv[vt] = *(const GAS v2u*)(PROJ + row * DINP + C_GG + h * 256 + 16 * (8 * vh + vt) + 4 * hq);
    f32x4 att[4];
#pragma unroll
    for (int st = 0; st < 4; ++st) { f32x4 a = (f32x4){0.f, 0.f, 0.f, 0.f};
        if (st <= lt) {
#pragma unroll
            for (int ks = 0; ks < 4; ++ks) a = mfma16(gfrag(KI + row0 * GLA_KT + h * 128, GLA_KT, 16 * st, 32 * ks, lane), qf[ks], a);
#pragma unroll
            for (int r = 0; r < 4; ++r) if (16 * st + 4 * hq + r > 16 * lt + c) a[r] = 0.f;
        }
        att[st] = a; }
    __syncthreads();
    f32x4 oacc[8];
#pragma unroll
    for (int vt = 0; vt < 8; ++vt) oacc[vt] = (f32x4){0.f, 0.f, 0.f, 0.f};
#pragma unroll
    for (int ks = 0; ks < 4; ++ks)
#pragma unroll
        for (int vt = 0; vt < 8; ++vt) oacc[vt] = mfma16(*(const LAS bf16x8*)(GPimg + (16 * (8 * vh + vt) + c) * BI_STRIDE + (32 * ks + 8 * hq) * 2), qf[ks], oacc[vt]);
#pragma unroll
    for (int ks2 = 0; ks2 < 2; ++ks2) { const bf16x8 pf = pack8(att[2 * ks2], att[2 * ks2 + 1]);
#pragma unroll
        for (int vt = 0; vt < 8; ++vt) oacc[vt] = mfma16(trfrag(Vimg, XI_STRIDE, 32 * ks2 + 4 * hq, 32 * ks2 + 16 + 4 * hq, 16 * (8 * vh + vt), lane), pf, oacc[vt]); }
    float ssq = 0.f;
#pragma unroll
    for (int vt = 0; vt < 8; ++vt) ssq += (oacc[vt].x * oacc[vt].x + oacc[vt].y * oacc[vt].y) + (oacc[vt].z * oacc[vt].z + oacc[vt].w * oacc[vt].w);
    ssq = xsum4(ssq);
    if (hq == 0) xch[w * 16 + c] = ssq;
    __syncthreads();
    const float rstd = 1.f / sqrtf((xch[w * 16 + c] + xch[(w ^ 1) * 16 + c]) * (1.f / 256.f) + EPS);
    const float* gla_norm = C.in[I_GLA_NORM] + (size_t)l * 256;
#pragma unroll
    for (int vt = 0; vt < 8; ++vt) { const int v0 = 16 * (8 * vh + vt) + 4 * hq; const f32x4 gn = *(const GAS f32x4*)(gla_norm + v0); const v2u gg = ggv[vt];
        const f32x4 o = oacc[vt]; v2u ow; ow.x = pk2(o.x * rstd * gn.x * silu_f(bflo(gg.x)), o.y * rstd * gn.y * silu_f(bfhi(gg.x))); ow.y = pk2(o.z * rstd * gn.z * silu_f(bflo(gg.y)), o.w * rstd * gn.w * silu_f(bfhi(gg.y)));
        *(GAS v2u*)(Y + row * DM + 3072 + h * 256 + v0) = ow; }
}

__device__ __forceinline__ void ssd_c1_unit(Ctx& C, int unit) {
    const int g = unit & 7, bc = unit >> 3; const size_t row0 = (size_t)bc * SSD_L;
    const int tid = C.tid, lane = C.lane, w = C.wave, c = lane & 15, hq = lane >> 4;
    LAS float* acs = (LAS float*)C.lds; LAS float* dts = acs + 512;
    LAS unsigned char* XWimg = C.lds + 4096; LAS unsigned char* Bimg = C.lds + 4096 + 128 * XI_STRIDE;
    const bf16* XBC = (const bf16*)(C.ws + WS_XBC); const float* DT = (const float*)(C.ws + WS_DT); const float* ACS = (const float*)(C.ws + WS_ACS); bf16* ST = (bf16*)(C.ws + WS_ST);
    __syncthreads();
    { const int t = tid >> 2, hh = tid & 3; acs[tid] = ACS[(row0 + t) * SSD_H + 4 * g + hh]; dts[tid] = DT[(row0 + t) * SSD_H + 4 * g + hh]; }
    __syncthreads();
#pragma unroll
    for (int it = 0; it < 8; ++it) { const int idx = tid + NTHR * it, t = idx >> 5, cg = idx & 31, hh = cg >> 3; const float wgt = __expf(acs[127 * 4 + hh] - acs[t * 4 + hh]) * dts[t * 4 + hh];
        const v4u r = *(const GAS v4u*)(XBC + (row0 + t) * SSD_CD + g * 256 + 8 * cg);
        v4u o; o.x = pk2(bflo(r.x) * wgt, bfhi(r.x) * wgt); o.y = pk2(bflo(r.y) * wgt, bfhi(r.y) * wgt); o.z = pk2(bflo(r.z) * wgt, bfhi(r.z) * wgt); o.w = pk2(bflo(r.w) * wgt, bfhi(r.w) * wgt);
        *(LAS v4u*)(XWimg + t * XI_STRIDE + 16 * cg) = o; }
#pragma unroll
    for (int it = 0; it < 4; ++it) { const int idx = tid + NTHR * it, t = idx >> 4, cg = idx & 15; *(LAS v4u*)(Bimg + t * BI_STRIDE + 16 * cg) = *(const GAS v4u*)(XBC + (row0 + t) * SSD_CD + 2048 + g * 128 + 8 * cg); }
    __syncthreads();
    const int hh = w >> 1, ph = w & 1;
    f32x4 acc[8][2];
#pragma unroll
    for (int mt = 0; mt < 8; ++mt) { acc[mt][0] = (f32x4){0.f, 0.f, 0.f, 0.f}; acc[mt][1] = (f32x4){0.f, 0.f, 0.f, 0.f}; }
#pragma unroll
    for (int ks = 0; ks < 4; ++ks) { const int r0 = 32 * ks + 8 * hq;
        const bf16x8 x0 = trfrag(XWimg, XI_STRIDE, r0, r0 + 4, hh * 64 + 32 * ph, lane), x1 = trfrag(XWimg, XI_STRIDE, r0, r0 + 4, hh * 64 + 32 * ph + 16, lane);
#pragma unroll
        for (int mt = 0; mt < 8; ++mt) { const bf16x8 bf = trfrag(Bimg, BI_STRIDE, r0, r0 + 4, 16 * mt, lane); acc[mt][0] = mfma16(bf, x0, acc[mt][0]); acc[mt][1] = mfma16(bf, x1, acc[mt][1]); } }
    bf16* sp = ST + ((size_t)bc * SSD_H + 4 * g + hh) * 8192 + 4 * hq;
#pragma unroll
    for (int mt = 0; mt < 8; ++mt)
#pragma unroll
        for (int pt = 0; pt < 2; ++pt) { v2u o; o.x = pk2(acc[mt][pt].x, acc[mt][pt].y); o.y = pk2(acc[mt][pt].z, acc[mt][pt].w); *(GAS v2u*)(sp + (size_t)(32 * ph + 16 * pt + c) * 128 + 16 * mt) = o; }
}

constexpr int SC3_X_OFF = 4096, SC3_PV_OFF = SC3_X_OFF + 128 * XI_STRIDE, SC3_PV_HEAD = 64 * BI_STRIDE;
static_assert(SC3_PV_OFF + 4 * SC3_PV_HEAD <= MISC_OFF && GC3_XCH_OFF + 512 <= MISC_OFF, "mixer LDS maps");
__device__ __forceinline__ void ssd_c3_unit(Ctx& C, int l, int unit) {
    const int g = unit & 7, bc = unit >> 3; const size_t row0 = (size_t)bc * SSD_L;
    const int tid = C.tid, lane = C.lane, w = C.wave, c = lane & 15, hq = lane >> 4;
    LAS float* acs = (LAS float*)C.lds; LAS float* dts = acs + 512;
    LAS unsigned char* Ximg = C.lds + SC3_X_OFF; LAS unsigned char* PVimg = C.lds + SC3_PV_OFF;
    const bf16* PROJ = (const bf16*)(C.ws + WS_PROJ); const bf16* XBC = (const bf16*)(C.ws + WS_XBC); const float* DT = (const float*)(C.ws + WS_DT); const float* ACS = (const float*)(C.ws + WS_ACS);
    const bf16* PV = (const bf16*)(C.ws + WS_PV); bf16* Y = (bf16*)(C.ws + WS_Y);
    const int tl = 16 * w + c; const size_t row = row0 + tl;
    __syncthreads();
    { const int t = tid >> 2, hh = tid & 3; const float a0 = ACS[(row0 + t) * SSD_H + 4 * g + hh], d0 = DT[(row0 + t) * SSD_H + 4 * g + hh];
      const bf16* pvb = PV + ((size_t)bc * SSD_H + 4 * g) * 8192;
      v4u tx[8], tp[8];
#pragma unroll
      for (int it = 0; it < 8; ++it) { const int idx = tid + NTHR * it, t2 = idx >> 5, cg = idx & 31; tx[it] = *(const GAS v4u*)(XBC + (row0 + t2) * SSD_CD + g * 256 + 8 * cg); }
#pragma unroll
      for (int it = 0; it < 8; ++it) { const int idx = tid + NTHR * it; tp[it] = *(const GAS v4u*)(pvb + (size_t)idx * 8); }
      acs[tid] = a0; dts[tid] = d0;
#pragma unroll
      for (int it = 0; it < 8; ++it) { const int idx = tid + NTHR * it, t2 = idx >> 5, cg = idx & 31; *(LAS v4u*)(Ximg + t2 * XI_STRIDE + 16 * cg) = tx[it]; }
#pragma unroll
      for (int it = 0; it < 8; ++it) { const int idx = tid + NTHR * it, pr = idx >> 4, cg = idx & 15; *(LAS v4u*)(PVimg + pr * BI_STRIDE + 16 * cg) = tp[it]; } }
    bf16x8 cf[4];
#pragma unroll
    for (int ks = 0; ks < 4; ++ks) cf[ks] = gfrag(XBC + row0 * SSD_CD + 3072 + g * 128, SSD_CD, 16 * w, 32 * ks, lane);
    f32x4 cb[8];
#pragma unroll
    for (int st = 0; st < 8; ++st) { f32x4 a = (f32x4){0.f, 0.f, 0.f, 0.f};
        if (st <= w) {
#pragma unroll
            for (int ks = 0; ks < 4; ++ks) a = mfma16(gfrag(XBC + row0 * SSD_CD + 2048 + g * 128, SSD_CD, 16 * st, 32 * ks, lane), cf[ks], a);
        }
        cb[st] = a; }
    __syncthreads();
    float* YT = (float*)(C.ws + WS_ST) + row * SSD_W + g * 256;
    float ssq = 0.f;
#pragma nounroll
    for (int hh = 0; hh < 4; ++hh) {
        v2u zz[4];
#pragma unroll
        for (int pt = 0; pt < 4; ++pt) zz[pt] = *(const GAS v2u*)(PROJ + row * DINP + C_Z + g * 256 + hh * 64 + 16 * pt + 4 * hq);
        const float acs_l = acs[tl * 4 + hh], el = __expf(acs_l);
        f32x4 ya[4];
#pragma unroll
        for (int pt = 0; pt < 4; ++pt) ya[pt] = (f32x4){0.f, 0.f, 0.f, 0.f};
#pragma unroll
        for (int ks = 0; ks < 4; ++ks)
#pragma unroll
            for (int pt = 0; pt < 4; ++pt) ya[pt] = mfma16(*(const LAS bf16x8*)(PVimg + (hh * 64 + 16 * pt + c) * BI_STRIDE + (32 * ks + 8 * hq) * 2), cf[ks], ya[pt]);
#pragma unroll
        for (int pt = 0; pt < 4; ++pt) ya[pt] = ya[pt] * el;
#pragma unroll
        for (int ks2 = 0; ks2 < 4; ++ks2) {
            if (2 * ks2 <= w) {
                f32x4 lm[2];
#pragma unroll
                for (int t2 = 0; t2 < 2; ++t2)
#pragma unroll
                    for (int r = 0; r < 4; ++r) { const int s = 32 * ks2 + 16 * t2 + 4 * hq + r; const float d = fminf(acs_l - acs[s * 4 + hh], 0.f);
                        lm[t2][r] = (s <= tl) ? cb[2 * ks2 + t2][r] * __expf(d) * dts[s * 4 + hh] : 0.f; }
                const bf16x8 pf = pack8(lm[0], lm[1]);
#pragma unroll
                for (int pt = 0; pt < 4; ++pt) ya[pt] = mfma16(trfrag(Ximg, XI_STRIDE, 32 * ks2 + 4 * hq, 32 * ks2 + 16 + 4 * hq, hh * 64 + 16 * pt, lane), pf, ya[pt]);
            }
        }
        const float Dh = C.in[I_SSD_D][l * SSD_H + 4 * g + hh];
#pragma unroll
        for (int pt = 0; pt < 4; ++pt) { const int col = hh * 64 + 16 * pt + 4 * hq; const v2u xw = *(const LAS v2u*)(Ximg + tl * XI_STRIDE + col * 2); const v2u z2 = zz[pt];
            f32x4 v; v.x = (ya[pt].x + Dh * bflo(xw.x)) * silu_f(bflo(z2.x)); v.y = (ya[pt].y + Dh * bfhi(xw.x)) * silu_f(bfhi(z2.x)); v.z = (ya[pt].z + Dh * bflo(xw.y)) * silu_f(bflo(z2.y)); v.w = (ya[pt].w + Dh * bfhi(xw.y)) * silu_f(bfhi(z2.y));
            *(GAS f32x4*)(YT + col) = v; ssq += (v.x * v.x + v.y * v.y) + (v.z * v.z + v.w * v.w); }
    }
    ssq = xsum4(ssq);
    const float rstd = 1.f / sqrtf(ssq * (1.f / 256.f) + EPS);
    const float* ssd_norm = C.in[I_SSD_NORM] + (size_t)l * SSD_W + g * 256;
    asm volatile("s_waitcnt vmcnt(0)" ::: "memory");
#pragma unroll 4
    for (int i = 0; i < 16; ++i) { const int col = 16 * i + 4 * hq; const f32x4 gn = *(const GAS f32x4*)(ssd_norm + col); const f32x4 v = *(const GAS f32x4*)(YT + col);
        v2u ow; ow.x = pk2(v.x * rstd * gn.x, v.y * rstd * gn.y); ow.y = pk2(v.z * rstd * gn.z, v.w * rstd * gn.w); *(GAS v2u*)(Y + row * DM + g * 256 + col) = ow; }
}

__device__ __forceinline__ void mix_c1_phase(Ctx& C, int l) {
    for (int u = C.bid; u < N_SSD_CU; u += C.G) ssd_c1_unit(C, u);
    for (int u = C.bid; u < N_GLA_CU; u += C.G) gla_c1_unit(C, u);
    for (int u = C.bid; u < N_SWA_UNITS; u += C.G) swa_unit_mfma(C, l, u);
}
__device__ __forceinline__ void mix_c3_phase(Ctx& C, int l) {
    for (int u = C.bid; u < N_SSD_CU; u += C.G) ssd_c3_unit(C, l, u);
    for (int u = C.bid; u < N_GLA_CU; u += C.G) gla_c3_unit(C, l, u);
}

__device__ __forceinline__ void act_fixup_phase(Ctx& C, int l) {
    bf16* ACT = (bf16*)(C.ws + WS_ACT); const float* HTG = (const float*)(C.ws + WS_HTG); const float* HTU = (const float*)(C.ws + WS_HTU); const float* HBG = (const float*)(C.ws + WS_HBG);
    const float* cw = C.in[I_FFN_CONV_W] + (size_t)l * 3 * DFF; const float* cb = C.in[I_FFN_CONV_B] + (size_t)l * DFF;
    constexpr int NC4 = DFF / 4, NIT = (M / 64) * 2 * NC4;
    for (int it = C.bid * NTHR + C.tid; it < NIT; it += C.G * NTHR) {
        const int c4 = it % NC4, ri = it / NC4, i = ri & 1, blk = ri >> 1, c0 = 4 * c4; const bool first = (blk % (SEQ / 64)) == 0;
        const f32x4 z4 = (f32x4){0.f, 0.f, 0.f, 0.f};
        const f32x4 g0 = *(const GAS f32x4*)(HTG + ((size_t)blk * 2 + i) * DFF + c0), up = *(const GAS f32x4*)(HTU + ((size_t)blk * 2 + i) * DFF + c0);
        const f32x4 pb1 = first ? z4 : *(const GAS f32x4*)(HBG + ((size_t)(blk - 1) * 2 + 1) * DFF + c0), pb0 = first ? z4 : *(const GAS f32x4*)(HBG + ((size_t)(blk - 1) * 2 + 0) * DFF + c0);
        const f32x4 g1 = i ? *(const GAS f32x4*)(HTG + ((size_t)blk * 2 + 0) * DFF + c0) : pb1, g2 = i ? pb1 : pb0;
        const f32x4 w0 = *(const GAS f32x4*)(cw + c0), w1 = *(const GAS f32x4*)(cw + DFF + c0), w2 = *(const GAS f32x4*)(cw + 2 * DFF + c0), bb = *(const GAS f32x4*)(cb + c0);
        f32x4 o;
#pragma unroll
        for (int e = 0; e < 4; ++e) { const float gc = bb[e] + w0[e] * g2[e] + w1[e] * g1[e] + w2[e] * g0[e]; o[e] = silu_f(gc) * up[e]; }
        v2u ow; ow.x = pk2(o.x, o.y); ow.y = pk2(o.z, o.w); *(GAS v2u*)(ACT + (size_t)(64 * blk + i) * DFF + c0) = ow;
    }
}

constexpr int PH_PER_LAYER = 11, PH_FINAL = DEPTH * PH_PER_LAYER, N_PHASES = PH_FINAL + 1;
#ifndef MK_ONE_LAUNCH
#define MK_ONE_LAUNCH 1
#endif
__global__ void __launch_bounds__(NTHR, 2) fwd_kernel(Args args) {
    extern __shared__ __attribute__((aligned(16))) unsigned char lds[];
    Ctx C;
    C.lds = (LAS unsigned char*)lds;
    C.tid = threadIdx.x; C.lane = C.tid & 63; C.wave = __builtin_amdgcn_readfirstlane(C.tid >> 6);
    C.G = gridDim.x; C.bid = blockIdx.x;
    C.in = args.in; C.out = args.out; C.ws = args.ws;
    volatile LAS unsigned* MISC = (volatile LAS unsigned*)(C.lds + MISC_OFF);
    for (int u = C.tid; u < (LDS_BYTES - MISC_OFF) / 4; u += NTHR) ((LAS unsigned*)(C.lds + MISC_OFF))[u] = 0u;
    __syncthreads();
    gu32* ctl = (gu32*)(args.ws + WS_CTL);
    XcdBarrier bar = xcd_barrier_post((unsigned*)(ctl + CW_BAR) + args.li * XCD_BAR_WORDS, MISC + 8);
    const int lo = args.ph_lo, hi = args.ph_hi;
#define IN(k) (lo <= (k) && (k) < hi)
#define SEAM(k) do { if (IN(k) && IN((k) + 1)) xcd_barrier(bar); } while (0)
    float* xres = args.out;
    bf16* H = (bf16*)(args.ws + WS_H);
#define LAYER_BODY(l) do { \
        const int pb = l * PH_PER_LAYER; \
        const float* xin = (l == 0) ? args.in[I_X] : (const float*)xres; \
        if (IN(pb + 0)) { convert_weights(C, l); rmsnorm_phase(C, xin, args.in[I_ATTN_NORM] + (size_t)l * DM, H); } \
        SEAM(pb + 0); \
        if (IN(pb + 1)) { \
            pg8::Gemm g{H, (const bf16*)(args.ws + WS_WIN), M, DINP, DM}; pg8::StaticOrder S; S.init(M, DINP, C.G, C.bid); \
            pg8::EpiProjConv E{(bf16*)(args.ws + WS_PROJ), DINP, (bf16*)(args.ws + WS_XBC), args.in[I_SSD_CONV_W] + (size_t)l * 4 * SSD_CD, args.in[I_SSD_CONV_B] + (size_t)l * SSD_CD, (float*)(args.ws + WS_XHT), (float*)(args.ws + WS_XHB)}; \
            pg8::gemm_phase<pg8::EpiProjConv, pg8::StaticOrder, true, true>(C.lds, g, S, E); \
        } \
        SEAM(pb + 1); \
        if (IN(pb + 2)) prep_phase(C, l); \
        SEAM(pb + 2); \
        if (IN(pb + 3)) mix_c1_phase(C, l); \
        SEAM(pb + 3); \
        if (IN(pb + 4)) scan_phase(C); \
        SEAM(pb + 4); \
        if (IN(pb + 5)) mix_c3_phase(C, l); \
        SEAM(pb + 5); \
        if (IN(pb + 6)) { \
            pg8::Gemm g{(const bf16*)(args.ws + WS_Y), (const bf16*)(args.ws + WS_WOUT), M, DM, DM}; pg8::StaticOrder S; S.init(M, DM, C.G, C.bid); \
            pg8::EpiRes E{xin, xres, DM}; \
            pg8::gemm_phase<pg8::EpiRes, pg8::StaticOrder, true, true>(C.lds, g, S, E); \
        } \
        SEAM(pb + 6); \
        if (IN(pb + 7)) rmsnorm_phase(C, xres, args.in[I_FFN_NORM] + (size_t)l * DM, H); \
        SEAM(pb + 7); \
        if (IN(pb + 8)) { \
            pg8::Gemm g{H, (const bf16*)(args.ws + WS_WGU), M, DGU, DM}; pg8::StaticOrder S; S.init(M, DGU, C.G, C.bid); \
            pg8::EpiGateUp E{(bf16*)(args.ws + WS_ACT), args.in[I_FFN_CONV_W] + (size_t)l * 3 * DFF, args.in[I_FFN_CONV_B] + (size_t)l * DFF, (float*)(args.ws + WS_HTG), (float*)(args.ws + WS_HTU), (float*)(args.ws + WS_HBG), DFF}; \
            pg8::gemm_phase<pg8::EpiGateUp, pg8::StaticOrder, true, true>(C.lds, g, S, E); \
        } \
        SEAM(pb + 8); \
        if (IN(pb + 9)) act_fixup_phase(C, l); \
        SEAM(pb + 9); \
        if (IN(pb + 10)) { \
            pg8::Gemm g{(const bf16*)(args.ws + WS_ACT), (const bf16*)(args.ws + WS_WDN), M, DM, DFF}; pg8::StaticOrder S; S.init(M, DM, C.G, C.bid); \
            pg8::EpiRes E{xres, xres, DM}; \
            pg8::gemm_phase<pg8::EpiRes, pg8::StaticOrder, true, true>(C.lds, g, S, E); \
        } \
        SEAM(pb + 10); \
     \
    } while (0)
    LAYER_BODY(0);
    LAYER_BODY(1);
#undef LAYER_BODY
    if (IN(PH_FINAL)) final_norm_phase(C, xres, args.in[I_FINAL_NORM]);
#undef IN
#undef SEAM
}

extern "C" void kernel_launch(void* const* d_in, const int* in_sizes, int n_in, void* d_out, int out_size, void* d_ws, size_t ws_size, hipStream_t stream) {
    static int grid = 0;
    if (grid == 0) {
        if (n_in != N_IN || out_size != M * DM || ws_size < WS_END) { fprintf(stderr, "kernel_launch: unexpected shapes (n_in %d, out %d, ws %zu < %zu)\n", n_in, out_size, ws_size, (size_t)WS_END); grid = -1; return; }
        int dev = 0, cus = 0, per_cu = 0;
        if (hipGetDevice(&dev) != hipSuccess || hipDeviceGetAttribute(&cus, hipDeviceAttributeMultiprocessorCount, dev) != hipSuccess) { grid = -1; return; }
        if (hipFuncSetAttribute((const void*)fwd_kernel, hipFuncAttributeMaxDynamicSharedMemorySize, LDS_BYTES) != hipSuccess) { fprintf(stderr, "kernel_launch: hipFuncSetAttribute failed\n"); grid = -1; return; }
        if (hipOccupancyMaxActiveBlocksPerMultiprocessor(&per_cu, (const void*)fwd_kernel, NTHR, LDS_BYTES) != hipSuccess || per_cu < 1) { fprintf(stderr, "kernel_launch: occupancy query says %d\n", per_cu); (void)hipGetLastError(); grid = -1; return; }
        grid = cus;
    }
    if (grid < 0) return;
    if (hipMemsetAsync((char*)d_ws + WS_CTL, 0, CTL_ZERO_BYTES, stream) != hipSuccess) return;
    Args a{};
    for (int i = 0; i < N_IN; ++i) a.in[i] = (const float*)d_in[i];
    a.out = (float*)d_out; a.ws = (unsigned char*)d_ws; a.pad = 0;
#if MK_ONE_LAUNCH
    a.ph_lo = 0; a.ph_hi = N_PHASES; a.li = 0;
    hipLaunchKernelGGL(fwd_kernel, dim3(grid), dim3(NTHR), LDS_BYTES, stream, a);
#else
    for (int p = 0; p < N_PHASES; ++p) { a.ph_lo = p; a.ph_hi = p + 1; a.li = p;
        hipLaunchKernelGGL(fwd_kernel, dim3(grid), dim3(NTHR), LDS_BYTES, stream, a); }
#endif
}
```

```cpp
#include <hip/hip_runtime.h>
#include <cstdio>
#include <cstdint>
namespace pg8 {
#define PG8_LAS __attribute__((address_space(3)))
typedef unsigned short bf16_t;
typedef short bf16x8 __attribute__((ext_vector_type(8)));
typedef float f32x4 __attribute__((ext_vector_type(4)));
typedef unsigned u32x4 __attribute__((ext_vector_type(4)));
constexpr int BM = 256, BK = 64, HALF = 128, HTB = HALF * BK * 2  , STAGE_BYTES = 8 * HTB, NXCD = 8, WGM = 8;

__host__ __device__ __forceinline__ int lds_byte(int r, int c) { const int st = (r >> 4) * 2 + (c >> 5), rr = r & 15, cc = c & 31, ob = rr * 64 + cc * 2; return st * 1024 + (ob ^ (((ob >> 9) & 1) << 5)); }
__host__ __device__ __forceinline__ void stage_rc(int b, int& R, int& C) { const int st = b / 1024, sb = b % 1024, swz = sb ^ (((sb >> 9) & 1) << 5); R = (st >> 1) * 16 + swz / 64; C = (st & 1) * 32 + (swz % 64) / 2; }
__host__ __device__ __forceinline__ int perm32(int rho) { const int n = rho >> 4, i = rho & 15; return 8 * (i >> 2) + 4 * n + (i & 3); }

struct Unit { int pm, pn; };
struct Gemm { const bf16_t* A; const bf16_t* Bt; int M, N, K; };

struct StaticOrder {
    int nM, nN, nwg, G, c;
    __host__ __device__ void init(int M, int N, int G_, int c_) { nM = M / BM; nN = N / BM; nwg = nM * nN; G = G_; c = c_; }
    __host__ __device__ bool next(int i, Unit& u) const {
        const long L = (long)i * G + c; if (L >= nwg) return false;
        int wgid = (int)L; { const int q = nwg / NXCD, r = nwg % NXCD, xcd = wgid % NXCD, off = wgid / NXCD; wgid = (xcd < r ? xcd * (q + 1) : r * (q + 1) + (xcd - r) * q) + off; }
        const int nig = WGM * nN, gid = wgid / nig, fm = gid * WGM, gsz = (nM - fm) < WGM ? (nM - fm) : WGM;
        u.pm = fm + ((wgid % nig) % gsz); u.pn = (wgid % nig) / gsz; return true;
    }
    __device__ __forceinline__ void a_ready(const Unit&) const {}
    __device__ __forceinline__ void done(const Unit&) const {}
};

typedef float f32x2c __attribute__((ext_vector_type(2)));
typedef __bf16 bf16x2c __attribute__((ext_vector_type(2)));
__device__ __forceinline__ unsigned cvt_pk_bf16(float lo, float hi) { const f32x2c v = {lo, hi}; return __builtin_bit_cast(unsigned, __builtin_convertvector(v, bf16x2c)); }

struct EpiBf16 {
    static constexpr bool PERM = true, AFTER_DRAIN = false;
    bf16_t* O; int ldc;
    __device__ __forceinline__ void operator()(const f32x4 (&acc)[2][2][4][2], const Unit& u, int wr, int wc, int fr, int fq) const {
        const int row0 = u.pm * BM + wr * 64 + fr; const int col0 = u.pn * BM + wc * 32 + 8 * fq;
#pragma unroll
        for (int ai = 0; ai < 2; ++ai)
#pragma unroll
            for (int m = 0; m < 4; ++m) { bf16_t* rowp = O + (size_t)(row0 + ai * HALF + m * 16) * ldc + col0;
#pragma unroll
                for (int bj = 0; bj < 2; ++bj) { const f32x4 v0 = acc[ai][bj][m][0], v1 = acc[ai][bj][m][1];
                    u32x4 w; w.x = cvt_pk_bf16(v0[0], v0[1]); w.y = cvt_pk_bf16(v0[2], v0[3]); w.z = cvt_pk_bf16(v1[0], v1[1]); w.w = cvt_pk_bf16(v1[2], v1[3]);
                    *(u32x4*)(rowp + bj * HALF) = w; } }
    }
};
template <int CTRL> __device__ __forceinline__ float dpp_old(float old, float v) { return __int_as_float(__builtin_amdgcn_update_dpp(__float_as_int(old), __float_as_int(v), CTRL, 0xf, 0xf, false)); }
struct EpiGateUp {
    static constexpr bool PERM = true, AFTER_DRAIN = false;
    bf16_t* ACT; const float* cw; const float* cb; float* HTG; float* HTU; float* HBG; int dff;
    __device__ __forceinline__ void operator()(const f32x4 (&acc)[2][2][4][2], const Unit& u, int wr, int wc, int fr, int fq) const {
        const int j0 = u.pn * 128 + wc * 32 + 8 * fq;
        float w0[8], w1[8], w2[8], bb[8];
#pragma unroll
        for (int h = 0; h < 2; ++h) { const f32x4 a = *(const f32x4*)(cw + j0 + 4 * h), b = *(const f32x4*)(cw + dff + j0 + 4 * h), c = *(const f32x4*)(cw + 2 * dff + j0 + 4 * h), d = *(const f32x4*)(cb + j0 + 4 * h);
#pragma unroll
            for (int e = 0; e < 4; ++e) { w0[4 * h + e] = a[e]; w1[4 * h + e] = b[e]; w2[4 * h + e] = c[e]; bb[4 * h + e] = d[e]; } }
#pragma unroll
        for (int ai = 0; ai < 2; ++ai) {
            const int rowb = u.pm * BM + ai * HALF + wr * 64; const size_t blk = (size_t)(rowb >> 6);
#pragma unroll
            for (int m = 0; m < 4; ++m) {
                const int row = rowb + 16 * m + fr; float o[8];
#pragma unroll
                for (int n = 0; n < 2; ++n)
#pragma unroll
                    for (int e = 0; e < 4; ++e) { const int k = 4 * n + e; const float g0 = acc[ai][0][m][n][e], up = acc[ai][1][m][n][e]; const float gp = m > 0 ? acc[ai][0][m > 0 ? m - 1 : 0][n][e] : 0.f;
                        const float g1 = dpp_old<0x111>(dpp_old<0x121>(0.f, gp), g0), g2 = dpp_old<0x112>(dpp_old<0x122>(0.f, gp), g0);
                        const float gc = bb[k] + w0[k] * g2 + w1[k] * g1 + w2[k] * g0; o[k] = gc * __builtin_amdgcn_rcpf(1.f + __expf(-gc)) * up; }
                u32x4 w; w.x = cvt_pk_bf16(o[0], o[1]); w.y = cvt_pk_bf16(o[2], o[3]); w.z = cvt_pk_bf16(o[4], o[5]); w.w = cvt_pk_bf16(o[6], o[7]);
                if (!(m == 0 && fr < 2)) *(u32x4*)(ACT + (size_t)row * dff + j0) = w;
                if (m == 0 && fr < 2) { float* pg = HTG + (blk * 2 + fr) * dff + j0; float* pu = HTU + (blk * 2 + fr) * dff + j0;
                    *(f32x4*)pg = acc[ai][0][0][0]; *(f32x4*)(pg + 4) = acc[ai][0][0][1]; *(f32x4*)pu = acc[ai][1][0][0]; *(f32x4*)(pu + 4) = acc[ai][1][0][1]; }
                if (m == 3 && fr >= 14) { float* pg = HBG + (blk * 2 + (fr - 14)) * dff + j0; *(f32x4*)pg = acc[ai][0][3][0]; *(f32x4*)(pg + 4) = acc[ai][0][3][1]; }
            }
        }
    }
};
struct EpiProjConv {
    static constexpr bool PERM = true, AFTER_DRAIN = false;
    bf16_t* O; int ldc; bf16_t* XBC; const float* cw; const float* cb; float* HT; float* HB;
    __device__ __forceinline__ void operator()(const f32x4 (&acc)[2][2][4][2], const Unit& u, int wr, int wc, int fr, int fq) const {
        if (u.pn < 8 || u.pn >= 24) {
            const int row0 = u.pm * BM + wr * 64 + fr; const int col0 = u.pn * BM + wc * 32 + 8 * fq;
#pragma unroll
            for (int ai = 0; ai < 2; ++ai)
#pragma unroll
                for (int m = 0; m < 4; ++m) { bf16_t* rowp = O + (size_t)(row0 + ai * HALF + m * 16) * ldc + col0;
#pragma unroll
                    for (int bj = 0; bj < 2; ++bj) { const f32x4 v0 = acc[ai][bj][m][0], v1 = acc[ai][bj][m][1];
                        u32x4 w; w.x = cvt_pk_bf16(v0[0], v0[1]); w.y = cvt_pk_bf16(v0[2], v0[3]); w.z = cvt_pk_bf16(v1[0], v1[1]); w.w = cvt_pk_bf16(v1[2], v1[3]);
                        *(u32x4*)(rowp + bj * HALF) = w; } }
            return;
        }
#pragma unroll
        for (int bj = 0; bj < 2; ++bj) {
            const int c0 = (u.pn - 8) * BM + bj * HALF + wc * 32 + 8 * fq;
            float wv[4][8], bb[8];
#pragma unroll
            for (int h = 0; h < 2; ++h) { const f32x4 d = *(const f32x4*)(cb + c0 + 4 * h);
#pragma unroll
                for (int e = 0; e < 4; ++e) bb[4 * h + e] = d[e];
#pragma unroll
                for (int i = 0; i < 4; ++i) { const f32x4 a = *(const f32x4*)(cw + i * 4096 + c0 + 4 * h);
#pragma unroll
                    for (int e = 0; e < 4; ++e) wv[i][4 * h + e] = a[e]; } }
#pragma unroll
            for (int ai = 0; ai < 2; ++ai) {
                const int rowb = u.pm * BM + ai * HALF + wr * 64; const size_t blk = (size_t)(rowb >> 6);
#pragma unroll
                for (int m = 0; m < 4; ++m) {
                    const int row = rowb + 16 * m + fr; float o[8];
#pragma unroll
                    for (int n = 0; n < 2; ++n)
#pragma unroll
                        for (int e = 0; e < 4; ++e) { const int k = 4 * n + e; const float x0 = acc[ai][bj][m][n][e]; const float xp = m > 0 ? acc[ai][bj][m > 0 ? m - 1 : 0][n][e] : 0.f;
                            const float x1 = dpp_old<0x111>(dpp_old<0x121>(0.f, xp), x0), x2 = dpp_old<0x112>(dpp_old<0x122>(0.f, xp), x0), x3 = dpp_old<0x113>(dpp_old<0x123>(0.f, xp), x0);
                            const float a = bb[k] + wv[0][k] * x3 + wv[1][k] * x2 + wv[2][k] * x1 + wv[3][k] * x0; o[k] = a * __builtin_amdgcn_rcpf(1.f + __expf(-a)); }
                    u32x4 w; w.x = cvt_pk_bf16(o[0], o[1]); w.y = cvt_pk_bf16(o[2], o[3]); w.z = cvt_pk_bf16(o[4], o[5]); w.w = cvt_pk_bf16(o[6], o[7]);
                    if (!(m == 0 && fr < 3)) *(u32x4*)(XBC + (size_t)row * 4096 + c0) = w;
                    if (m == 0 && fr < 3) { float* p = HT + (blk * 3 + fr) * 4096 + c0; *(f32x4*)p = acc[ai][bj][0][0]; *(f32x4*)(p + 4) = acc[ai][bj][0][1]; }
                    if (m == 3 && fr >= 13) { float* p = HB + (blk * 3 + (fr - 13)) * 4096 + c0; *(f32x4*)p = acc[ai][bj][3][0]; *(f32x4*)(p + 4) = acc[ai][bj][3][1]; }
                }
            }
        }
    }
};
struct EpiRes {
    static constexpr bool PERM = false, AFTER_DRAIN = false;
    const float* base; float* out; int ldc;
    __device__ __forceinline__ void operator()(const f32x4 (&acc)[2][2][4][2], const Unit& u, int wr, int wc, int fr, int fq) const {
        const int row0 = u.pm * BM + wr * 64 + fr, col0 = u.pn * BM + wc * 32 + 4 * fq;
#pragma unroll
        for (int ai = 0; ai < 2; ++ai)
#pragma unroll
            for (int m = 0; m < 4; ++m) { const size_t off = (size_t)(row0 + ai * HALF + m * 16) * ldc + col0;
#pragma unroll
                for (int bj = 0; bj < 2; ++bj)
#pragma unroll
                    for (int n = 0; n < 2; ++n) { const f32x4 bs = *(const f32x4*)(base + off + bj * HALF + n * 16); *(f32x4*)(out + off + bj * HALF + n * 16) = bs + acc[ai][bj][m][n]; } }
    }
};
template <class Epi, class Sched, bool ALIGN_EPI = false, bool SP2 = false>
__device__ __forceinline__ void gemm_phase(PG8_LAS unsigned char* lds, const Gemm g, const Sched& S, const Epi& E) {
    const int tid = threadIdx.x, wid = __builtin_amdgcn_readfirstlane(tid >> 6), lane = tid & 63, wr = wid >> 2, wc = wid & 3, fr = lane & 15, fq = lane >> 4;
    const int K = g.K, nt = K / BK;
    unsigned voffA[2], voffB[2];
#pragma unroll
    for (int i = 0; i < 2; ++i) { int R, C; stage_rc(tid * 16 + i * 8192, R, C); const int Rb = Epi::PERM ? ((R & ~31) + perm32(R & 31)) : R;
        voffA[i] = (unsigned)(R * K + C) * 2u; voffB[i] = (unsigned)(Rb * K + C) * 2u; }
    const size_t kstep = (size_t)(BK * 2);
    const size_t hstep = (size_t)HALF * K * 2;
    const size_t tstep = 2 * hstep;
    const unsigned ldsw = (unsigned)wid * 1024u;
    const int aoff = lds_byte(wr * 64 + fr, fq * 8), boff = lds_byte(wc * 32 + fr, fq * 8);
#define PG8_SA(b, h) (((b) * 2 + (h)) * HTB)
#define PG8_SB(b, h) ((4 + (b) * 2 + (h)) * HTB)
#define PG8_STAGE(bufoff, gbase, voff) do { _Pragma("unroll") for (int _i = 0; _i < 2; ++_i) \
        __builtin_amdgcn_global_load_lds((const unsigned*)((const char*)(gbase) + (voff)[_i]), (PG8_LAS unsigned*)(lds + (bufoff) + ldsw + _i * 8192), 16, 0, 0); } while (0)
#define PG8_LDA(dst, b, h) do { _Pragma("unroll") for (int m = 0; m < 4; ++m) _Pragma("unroll") for (int k = 0; k < 2; ++k) dst[m][k] = *(const PG8_LAS bf16x8*)(lds + PG8_SA(b, h) + aoff + m * 2048 + k * 1024); } while (0)
#define PG8_LDB(dst, b, h) do { _Pragma("unroll") for (int n = 0; n < 2; ++n) _Pragma("unroll") for (int k = 0; k < 2; ++k) dst[n][k] = *(const PG8_LAS bf16x8*)(lds + PG8_SB(b, h) + boff + n * 2048 + k * 1024); } while (0)
#define PG8_MMA(ai, bj, At, Bt) do { __builtin_amdgcn_s_setprio(1); _Pragma("unroll") for (int m = 0; m < 4; ++m) _Pragma("unroll") for (int n = 0; n < 2; ++n) _Pragma("unroll") for (int k = 0; k < 2; ++k) \
        acc[ai][bj][m][n] = __builtin_amdgcn_mfma_f32_16x16x32_bf16(Bt[n][k], At[m][k], acc[ai][bj][m][n], 0, 0, 0); __builtin_amdgcn_s_setprio(0); } while (0)
#define PG8_WAIT_V(n) asm volatile("s_waitcnt vmcnt(" #n ")" ::: "memory")
#define PG8_WAIT_L(n) asm volatile("s_waitcnt lgkmcnt(" #n ")" ::: "memory")
#define PG8_BAR __builtin_amdgcn_s_barrier()
#define PG8_SCHED __builtin_amdgcn_sched_barrier(0)
    Unit cur, nxt; int ui = 0;
    if (!S.next(0, cur)) return;
    f32x4 acc[2][2][4][2];
#pragma unroll
    for (int a = 0; a < 2; ++a)
#pragma unroll
        for (int b = 0; b < 2; ++b)
#pragma unroll
            for (int m = 0; m < 4; ++m)
#pragma unroll
                for (int n = 0; n < 2; ++n) acc[a][b][m][n] = (f32x4){0.f, 0.f, 0.f, 0.f};
    bf16x8 At[4][2], B0[2][2], B1[2][2];
    const char* cA = (const char*)g.A + (size_t)cur.pm * tstep; const char* cB = (const char*)g.Bt + (size_t)cur.pn * tstep;
    S.a_ready(cur);
    if constexpr (SP2) {
        PG8_STAGE(PG8_SB(0, 0), cB, voffB); PG8_STAGE(PG8_SB(0, 1), cB + hstep, voffB); PG8_STAGE(PG8_SA(0, 0), cA, voffA); PG8_STAGE(PG8_SA(0, 1), cA + hstep, voffA);
        if (wr == 1) PG8_BAR;
        PG8_WAIT_V(2); PG8_BAR;
        PG8_STAGE(PG8_SB(1, 0), cB + kstep, voffB); PG8_STAGE(PG8_SA(1, 0), cA + kstep, voffA); PG8_STAGE(PG8_SB(1, 1), cB + hstep + kstep, voffB);
        PG8_WAIT_V(6); PG8_BAR;
    } else {
        PG8_STAGE(PG8_SB(0, 0), cB, voffB); PG8_STAGE(PG8_SA(0, 0), cA, voffA); PG8_STAGE(PG8_SB(0, 1), cB + hstep, voffB); PG8_STAGE(PG8_SA(0, 1), cA + hstep, voffA);
        if (wr == 1) PG8_BAR;
        PG8_WAIT_V(4); PG8_BAR;
        PG8_STAGE(PG8_SB(1, 0), cB + kstep, voffB); PG8_STAGE(PG8_SA(1, 0), cA + kstep, voffA); PG8_STAGE(PG8_SB(1, 1), cB + hstep + kstep, voffB);
        PG8_WAIT_V(6); PG8_BAR;
    }
    for (;;) {
        const bool has_next = S.next(ui + 1, nxt);
        const char* nA = has_next ? (const char*)g.A + (size_t)nxt.pm * tstep : cA; const char* nB = has_next ? (const char*)g.Bt + (size_t)nxt.pn * tstep : cB;
        for (int t = 0; t < nt; t += 2) {
            const bool last = (t == nt - 2);
            const char* a1 = cA + (size_t)(t + 1) * kstep;
            const char* a2 = last ? nA : cA + (size_t)(t + 2) * kstep; const char* b2 = last ? nB : cB + (size_t)(t + 2) * kstep;
            const char* a3 = a2 + kstep; const char* b3 = b2 + kstep;
            if (last && has_next) S.a_ready(nxt);
            if constexpr (SP2) {
            PG8_LDB(B0, 0, 0); PG8_LDB(B1, 0, 1); PG8_SCHED; PG8_LDA(At, 0, 0); PG8_STAGE(PG8_SA(1, 1), a1 + hstep, voffA);
            PG8_WAIT_V(8); PG8_WAIT_L(0); PG8_BAR; PG8_MMA(0, 0, At, B0); PG8_MMA(0, 1, At, B1); PG8_BAR; PG8_SCHED;
            PG8_LDA(At, 0, 1); PG8_STAGE(PG8_SB(0, 0), b2, voffB); PG8_STAGE(PG8_SB(0, 1), b2 + hstep, voffB); PG8_STAGE(PG8_SA(0, 0), a2, voffA);
            PG8_WAIT_V(8); PG8_WAIT_L(0); PG8_BAR; PG8_MMA(1, 0, At, B0); PG8_MMA(1, 1, At, B1); PG8_BAR; PG8_SCHED;
            PG8_LDB(B0, 1, 0); PG8_LDB(B1, 1, 1); PG8_SCHED; PG8_LDA(At, 1, 0); PG8_STAGE(PG8_SA(0, 1), a2 + hstep, voffA);
            PG8_WAIT_V(8); PG8_WAIT_L(0); PG8_BAR; PG8_MMA(0, 0, At, B0); PG8_MMA(0, 1, At, B1); PG8_BAR; PG8_SCHED;
            PG8_LDA(At, 1, 1); PG8_STAGE(PG8_SB(1, 0), b3, voffB); PG8_STAGE(PG8_SB(1, 1), b3 + hstep, voffB); PG8_STAGE(PG8_SA(1, 0), a3, voffA);
            PG8_WAIT_V(8); PG8_WAIT_L(0); PG8_BAR; PG8_MMA(1, 0, At, B0); PG8_MMA(1, 1, At, B1); PG8_BAR; PG8_SCHED;
            } else {
            PG8_LDB(B0, 0, 0); PG8_SCHED; PG8_LDA(At, 0, 0); PG8_STAGE(PG8_SA(1, 1), a1 + hstep, voffA);
            PG8_WAIT_L(8); PG8_BAR; PG8_WAIT_L(0); PG8_MMA(0, 0, At, B0); PG8_BAR; PG8_SCHED;
            PG8_LDB(B1, 0, 1); PG8_STAGE(PG8_SB(0, 0), b2, voffB);
            PG8_BAR; PG8_WAIT_L(0); PG8_MMA(0, 1, At, B1); PG8_BAR;
            PG8_LDA(At, 0, 1); PG8_STAGE(PG8_SA(0, 0), a2, voffA);
            PG8_BAR; PG8_WAIT_L(0); PG8_MMA(1, 0, At, B0); PG8_BAR; PG8_SCHED;
            PG8_STAGE(PG8_SB(0, 1), b2 + hstep, voffB);
            PG8_WAIT_V(6); PG8_BAR; PG8_MMA(1, 1, At, B1); PG8_BAR;
            PG8_LDB(B0, 1, 0); PG8_SCHED; PG8_LDA(At, 1, 0); PG8_STAGE(PG8_SA(0, 1), a2 + hstep, voffA);
            PG8_WAIT_L(8); PG8_BAR; PG8_WAIT_L(0); PG8_MMA(0, 0, At, B0); PG8_BAR; PG8_SCHED;
            PG8_LDB(B1, 1, 1); PG8_STAGE(PG8_SB(1, 0), b3, voffB);
            PG8_BAR; PG8_WAIT_L(0); PG8_MMA(0, 1, At, B1); PG8_BAR;
            PG8_LDA(At, 1, 1); PG8_STAGE(PG8_SA(1, 0), a3, voffA);
            PG8_BAR; PG8_WAIT_L(0); PG8_MMA(1, 0, At, B0); PG8_BAR; PG8_SCHED;
            PG8_STAGE(PG8_SB(1, 1), b3 + hstep, voffB);
            PG8_WAIT_V(6); PG8_BAR; PG8_MMA(1, 1, At, B1); PG8_BAR;
            }
        }
        if constexpr (ALIGN_EPI) { if (wr == 0) PG8_BAR; }
        if constexpr (!Epi::AFTER_DRAIN) { E(acc, cur, wr, wc, fr, fq); S.done(cur); }
        if (!has_next) break;
#pragma unroll
        for (int a = 0; a < 2; ++a)
#pragma unroll
            for (int b = 0; b < 2; ++b)
#pragma unroll
                for (int m = 0; m < 4; ++m)
#pragma unroll
                    for (int n = 0; n < 2; ++n) acc[a][b][m][n] = (f32x4){0.f, 0.f, 0.f, 0.f};
        cur = nxt; cA = nA; cB = nB; ++ui;
        if constexpr (ALIGN_EPI) { if (wr == 1) PG8_BAR; }
    }
    PG8_WAIT_V(0);
    if constexpr (!ALIGN_EPI) { if (wr == 0) PG8_BAR; }
    PG8_BAR;
    if constexpr (Epi::AFTER_DRAIN) { E.fused(acc, cur, wr, wc, fr, fq, lds, wid, lane); S.done(cur); }
#undef PG8_SA
#undef PG8_SB
#undef PG8_STAGE
#undef PG8_LDA
#undef PG8_LDB
#undef PG8_MMA
#undef PG8_WAIT_V
#undef PG8_WAIT_L
#undef PG8_BAR
#undef PG8_SCHED
}
}

constexpr int NWAVES = 8, NTHR = NWAVES * 64;
constexpr int BATCH = 2, SEQ = 8192, M = BATCH * SEQ, DM = 4096, DEPTH = 2;
constexpr int SSD_W = 2048, SSD_H = 32, SSD_CD = 4096;
constexpr int SWA_W = 1024, SWA_H = 16;
constexpr int GLA_W = 1024, GLA_KT = 512;
constexpr int DFF = 11008, DIN = 10800, DINP = 11008, DGU = 2 * DFF;
constexpr float EPS = 1e-6f;
constexpr int C_Z = 0, C_XBC = 2048, C_DT = 6144, C_SQ = 6176, C_SK = 7200, C_SV = 7456, C_GQ = 7712, C_GK = 8224, C_GV = 8736, C_GG = 9760, C_GLR = 10784;
enum { I_X = 0, I_ATTN_NORM, I_W_IN, I_SSD_CONV_W, I_SSD_CONV_B, I_SSD_DT_BIAS, I_SSD_A_LOG, I_SSD_D, I_SSD_NORM, I_SWA_SINKS, I_SWA_NORM, I_GLA_W_GATE, I_GLA_B_GATE, I_GLA_NORM,
       I_W_OUT, I_FFN_NORM, I_W_GATE, I_W_UP, I_FFN_CONV_W, I_FFN_CONV_B, I_W_DOWN, I_REL_BIAS, I_FINAL_NORM, N_IN };

constexpr size_t MiB = 1u << 20;
constexpr size_t WS_CTL = 0, CTL_ZERO_BYTES = 1 * MiB;
constexpr size_t WS_WIN = 1 * MiB;
constexpr size_t WS_WOUT = 87 * MiB;
constexpr size_t WS_WGU = 119 * MiB;
constexpr size_t WS_WDN = 291 * MiB;
constexpr size_t WS_H = 377 * MiB;
constexpr size_t WS_R = 505 * MiB;
constexpr size_t WS_PROJ = WS_R;
constexpr size_t WS_XBC = WS_R + 344 * MiB;
constexpr size_t WS_QD = WS_R + 472 * MiB;
constexpr size_t WS_KI = WS_R + 488 * MiB;
constexpr size_t WS_DT = WS_R + 520 * MiB;
constexpr size_t WS_ACS = WS_R + 522 * MiB;
constexpr size_t WS_DEC = WS_R + 524 * MiB;
constexpr size_t WS_GDEC = WS_R + 525 * MiB;
constexpr size_t WS_ST = WS_R + 528 * MiB;
constexpr size_t WS_PV = WS_R + 656 * MiB;
constexpr size_t WS_GST = WS_R + 720 * MiB;
constexpr size_t WS_GPV = WS_R + 848 * MiB;
constexpr size_t WS_OSWA = WS_R + 912 * MiB;
constexpr size_t WS_Y = WS_R + 976 * MiB;
constexpr size_t WS_ACT = WS_R + 688 * MiB;
constexpr size_t WS_HTG = WS_R + 1032 * MiB, WS_HTU = WS_R + 1054 * MiB, WS_HBG = WS_R + 1076 * MiB;
constexpr size_t WS_XHT = WS_R + 504 * MiB, WS_XHB = WS_R + 1104 * MiB;
constexpr size_t WS_END = WS_R + 1120 * MiB;
static_assert(DEPTH == 2 && (size_t)DINP * DM * 2 == 86 * MiB && (size_t)DGU * DM * 2 == 172 * MiB && (size_t)M * DINP * 2 == 344 * MiB , "ws map");
constexpr int CW_BAR = 4096;

constexpr int RING_BYTES = 131072;
constexpr int MISC_OFF = 147456 - 256;
constexpr int LDS_BYTES = 147456;

#define GAS __attribute__((address_space(1)))
#define LAS __attribute__((address_space(3)))
typedef unsigned short bf16;
typedef unsigned v4u __attribute__((ext_vector_type(4)));
typedef unsigned v2u __attribute__((ext_vector_type(2)));
typedef float f32x4 __attribute__((ext_vector_type(4)));
typedef GAS unsigned gu32;
#define RLX_AGENT __ATOMIC_RELAXED, __HIP_MEMORY_SCOPE_AGENT
#define LDS_WAIT() asm volatile("s_waitcnt lgkmcnt(0)" ::: "memory")
__device__ __forceinline__ unsigned f2bf(float f) { unsigned u = __builtin_bit_cast(unsigned, f); return (u + 0x7fffu + ((u >> 16) & 1u)) >> 16; }
__device__ __forceinline__ unsigned pk2(float lo, float hi) { return pg8::cvt_pk_bf16(lo, hi); }
__device__ __forceinline__ float bflo(unsigned w) { return __uint_as_float(w << 16); }
__device__ __forceinline__ float bfhi(unsigned w) { return __uint_as_float(w & 0xffff0000u); }
__device__ __forceinline__ float bf1(bf16 h) { return __uint_as_float((unsigned)h << 16); }
__device__ __forceinline__ float silu_f(float x) { return x * __builtin_amdgcn_rcpf(1.f + __expf(-x)); }
__device__ __forceinline__ float wave_sum(float v) {
#pragma unroll
    for (int o = 1; o < 64; o <<= 1) v += __shfl_xor(v, o);
    return v;
}
template <int CTRL> __device__ __forceinline__ float dpp_f(float v) { return __int_as_float(__builtin_amdgcn_update_dpp(0, __float_as_int(v), CTRL, 0xf, 0xf, false)); }
__device__ __forceinline__ float row16_sum(float v) { v += dpp_f<0xB1>(v); v += dpp_f<0x4E>(v); v += dpp_f<0x124>(v); v += dpp_f<0x128>(v); return v; }
__device__ __forceinline__ float pair_sum(float v) { return v + dpp_f<0xB1>(v); }
#define XB_TMO      128
#define XB_XCNT(j)  (256  + 64 * (j))
#define XB_XSUB(j)  (1280 + 64 * (j))
#define XB_XGEN(j)  (2304 + 64 * (j))
#define XB_TOP      3328
#define XB_TOPGEN   3392
#define XCD_BAR_WORDS 3456
#define XB_SPIN_CAP (1u << 18)

__device__ __forceinline__ unsigned xb_ld(unsigned* p)              { return __hip_atomic_load(p, __ATOMIC_RELAXED, __HIP_MEMORY_SCOPE_AGENT); }
__device__ __forceinline__ unsigned xb_add(unsigned* p, unsigned v) { return __hip_atomic_fetch_add(p, v, __ATOMIC_RELAXED, __HIP_MEMORY_SCOPE_AGENT); }
__device__ __forceinline__ unsigned xb_xcc_id() { return (unsigned)__builtin_amdgcn_s_getreg((3 << 11) | 20) & 0xFu; }
#define XB_SPIN(cond, bar) do { unsigned _sp = 0; while (cond) { __builtin_amdgcn_s_sleep(1); \
    if ((++_sp & 255u) == 0u) { if (xb_ld(&(bar)[XB_TMO])) break; if (_sp > XB_SPIN_CAP) { atomicAdd(&(bar)[XB_TMO], 1u); break; } } } } while (0)

struct XcdBarrier {
    unsigned* bar; unsigned x;
    volatile LAS unsigned* st;
};

__device__ __forceinline__ XcdBarrier xcd_barrier_post(unsigned* bar, volatile LAS unsigned* st) {
    XcdBarrier b; b.bar = bar; b.x = xb_xcc_id(); b.st = st;
    if (threadIdx.x == 0) (void)xb_add(&bar[XB_XCNT(b.x)], 1u);
    return b;
}
__device__ __forceinline__ void xcd_barrier_complete(unsigned* bar, unsigned x, unsigned& nloc, unsigned& nx) {
    const unsigned G = gridDim.x * gridDim.y * gridDim.z;
    unsigned sum, cnt, mine, sp = 0u;
    for (;;) {
        sum = 0u; cnt = 0u; mine = 0u;
#pragma unroll
        for (unsigned j = 0; j < 16; ++j) { const unsigned c = xb_ld(&bar[XB_XCNT(j)]); sum += c; cnt += (c > 0u) ? 1u : 0u; mine = (j == x) ? c : mine; }
        if (sum == G) break;
        __builtin_amdgcn_s_sleep(1);
        if ((++sp & 255u) == 0u) { if (xb_ld(&bar[XB_TMO])) break; if (sp > XB_SPIN_CAP) { atomicAdd(&bar[XB_TMO], 1u); break; } }
    }
    nloc = mine > 0u ? mine : 1u; nx = cnt > 0u ? cnt : 1u;
}

__device__ __forceinline__ void xcd_barrier(const XcdBarrier& b) {
    asm volatile("s_waitcnt vmcnt(0)" ::: "memory");
    __syncthreads();
    if (threadIdx.x == 0) {
        unsigned* bar = b.bar;
        __builtin_amdgcn_s_waitcnt(0);
        unsigned nloc = b.st[0], nx = b.st[1];
        if (nloc == 0u) { xcd_barrier_complete(bar, b.x, nloc, nx); b.st[0] = nloc; b.st[1] = nx; }
        const unsigned old = xb_add(&bar[XB_XSUB(b.x)], 1u);
        const unsigned gen = old / nloc;
        if (old + 1u == (gen + 1u) * nloc) {
            __builtin_amdgcn_fence(__ATOMIC_RELEASE, "agent");
            asm volatile("s_waitcnt vmcnt(0)" ::: "memory");
            const unsigned og = xb_add(&bar[XB_TOP], 1u);
            const unsigned tg = og / nx;
            if (og + 1u == (tg + 1u) * nx) xb_add(&bar[XB_TOPGEN], 1u);
            else XB_SPIN(xb_ld(&bar[XB_TOPGEN]) == tg, bar);
            __builtin_amdgcn_fence(__ATOMIC_ACQUIRE, "agent");
            xb_add(&bar[XB_XGEN(b.x)], 1u);
            asm volatile("s_waitcnt vmcnt(0)" ::: "memory");
        } else {
            XB_SPIN(xb_ld(&bar[XB_XGEN(b.x)]) == gen, bar);
            __builtin_amdgcn_fence(__ATOMIC_ACQUIRE, "agent");
            asm volatile("s_waitcnt vmcnt(0)" ::: "memory");
        }
    }
    __syncthreads();
}

struct Args { const float* in[N_IN]; float* out; unsigned char* ws; int ph_lo, ph_hi, li, pad; };
struct Ctx {
    LAS unsigned char* lds;
    int tid, lane, wave, G, bid;
    const float* const* in; float* out; unsigned char* ws;
};
__device__ const unsigned char T5_BUCKET[128] = {0, 1, 2, 3, 4, 5, 6, 7, 8, 9, 10, 11, 12, 13, 14, 15, 16, 16, 16, 17, 17, 18, 18, 18, 19, 19, 19, 20, 20, 20, 20, 21, 21, 21, 21, 22, 22, 22, 22, 22, 23, 23, 23, 23, 23, 23, 24, 24, 24, 24, 24, 24, 25, 25, 25, 25, 25, 25, 25, 26, 26, 26, 26, 26, 26, 26, 26, 27, 27, 27, 27, 27, 27, 27, 27, 27, 27, 28, 28, 28, 28, 28, 28, 28, 28, 28, 28, 29, 29, 29, 29, 29, 29, 29, 29, 29, 29, 29, 29, 30, 30, 30, 30, 30, 30, 30, 30, 30, 30, 30, 30, 30, 30, 31, 31, 31, 31, 31, 31, 31, 31, 31, 31, 31, 31, 31, 31, 31};

struct TItem { const float* src; bf16* dst; int N, K, nvalid; };
constexpr int CV_NITEMS = 32 * 86 * 3 + 32 * 32 + 86 * 32;
__device__ __forceinline__ TItem titem_decode(Ctx& C, int l, int it) {
    constexpr int I_IN = 32 * 86, I_OUT = 32 * 32, I_G = 32 * 86;
    TItem t; int r = it, kb, nb;
    if (r < I_IN) { kb = r / 86; nb = r % 86; t.N = DIN; t.K = DM; t.src = C.in[I_W_IN] + (size_t)l * DM * DIN; t.dst = (bf16*)(C.ws + WS_WIN) + (size_t)(128 * nb) * DM; }
    else if ((r -= I_IN) < I_OUT) { kb = r / 32; nb = r % 32; t.N = DM; t.K = DM; t.src = C.in[I_W_OUT] + (size_t)l * DM * DM; t.dst = (bf16*)(C.ws + WS_WOUT) + (size_t)(128 * nb) * DM; }
    else if ((r -= I_OUT) < I_G) { kb = r / 86; nb = r % 86; t.N = DFF; t.K = DM; t.src = C.in[I_W_GATE] + (size_t)l * DM * DFF; t.dst = (bf16*)(C.ws + WS_WGU) + (size_t)(256 * nb) * DM; }
    else if ((r -= I_G) < I_G) { kb = r / 86; nb = r % 86; t.N = DFF; t.K = DM; t.src = C.in[I_W_UP] + (size_t)l * DM * DFF; t.dst = (bf16*)(C.ws + WS_WGU) + (size_t)(256 * nb + 128) * DM; }
    else { r -= I_G; kb = r / 32; nb = r % 32; t.N = DM; t.K = DFF; t.src = C.in[I_W_DOWN] + (size_t)l * DFF * DM; t.dst = (bf16*)(C.ws + WS_WDN) + (size_t)(128 * nb) * DFF; }
    t.src += (size_t)(128 * kb) * t.N + 128 * nb; t.dst += 128 * kb;
    const int rem = t.N - 128 * nb; t.nvalid = rem >= 128 ? 128 : (rem > 0 ? rem : 0);
    return t;
}
__device__ __forceinline__ void titem_load(const TItem& t, f32x4 (&v)[8], int wave, int lane) {
    const bool nv = 4 * (lane & 31) < t.nvalid; const float* p = t.src + (size_t)(16 * wave + 2 * (lane >> 5)) * t.N + 4 * (lane & 31);
#pragma unroll
    for (int i = 0; i < 4; ++i) { v[2 * i] = nv ? *(const GAS f32x4*)(p + (size_t)(4 * i) * t.N) : (f32x4){0.f, 0.f, 0.f, 0.f}; v[2 * i + 1] = nv ? *(const GAS f32x4*)(p + (size_t)(4 * i + 1) * t.N) : (f32x4){0.f, 0.f, 0.f, 0.f}; }
}
__device__ __forceinline__ void titem_store(const TItem& t, const f32x4 (&v)[8], LAS unsigned* T, int tid, int wave, int lane) {
    __syncthreads();
    { const int kd = 8 * wave + (lane >> 5);
#pragma unroll
      for (int i = 0; i < 4; ++i)
#pragma unroll
          for (int e = 0; e < 4; ++e) T[(4 * (lane & 31) + e) * 65 + kd + 2 * i] = pg8::cvt_pk_bf16(v[2 * i][e], v[2 * i + 1][e]); }
    __syncthreads();
    const int ch = tid & 15;
#pragma unroll
    for (int ps = 0; ps < 4; ++ps) { const int n = 32 * ps + (tid >> 4); const LAS unsigned* s = T + n * 65 + 4 * ch;
        v4u o; o.x = s[0]; o.y = s[1]; o.z = s[2]; o.w = s[3];
        *(GAS v4u*)(t.dst + (size_t)n * t.K + 8 * ch) = o; }
}
__device__ __forceinline__ void convert_weights(Ctx& C, int l) {
    LAS unsigned* T = (LAS unsigned*)C.lds;
    int it = C.bid; if (it >= CV_NITEMS) return;
    TItem cur = titem_decode(C, l, it); f32x4 va[8], vb[8];
    titem_load(cur, va, C.wave, C.lane);
    for (;;) {
        int nx = it + C.G; TItem tn = cur; const bool hn = nx < CV_NITEMS;
        if (hn) { tn = titem_decode(C, l, nx); titem_load(tn, vb, C.wave, C.lane); }
        titem_store(cur, va, T, C.tid, C.wave, C.lane);
        if (!hn) break;
        nx += C.G; const bool hn2 = nx < CV_NITEMS; TItem t2 = tn;
        if (hn2) { t2 = titem_decode(C, l, nx); titem_load(t2, va, C.wave, C.lane); }
        titem_store(tn, vb, T, C.tid, C.wave, C.lane);
        if (!hn2) break;
        cur = t2; it = nx;
    }
    __syncthreads();
}
__device__ __forceinline__ void rmsnorm_row_bf16(const float* xrow, const float* w, bf16* orow, int lane) {
    const GAS f32x4* xr = (const GAS f32x4*)xrow + lane; const GAS f32x4* wr = (const GAS f32x4*)w + lane;
    f32x4 v[16]; float ss = 0.f;
#pragma unroll
    for (int j = 0; j < 16; ++j) { v[j] = xr[64 * j]; ss += (v[j].x * v[j].x + v[j].y * v[j].y) + (v[j].z * v[j].z + v[j].w * v[j].w); }
    const float rstd = 1.f / sqrtf(wave_sum(ss) * (1.f / DM) + EPS);
    GAS v2u* o8 = (GAS v2u*)orow + lane;
#pragma unroll
    for (int j = 0; j < 16; ++j) { const f32x4 g = wr[64 * j]; v2u o; o.x = pk2(v[j].x * rstd * g.x, v[j].y * rstd * g.y); o.y = pk2(v[j].z * rstd * g.z, v[j].w * rstd * g.w); o8[64 * j] = o; }
}
__device__ __forceinline__ void rmsnorm_phase(Ctx& C, const float* X, const float* w, bf16* H) {
    const int gw = C.bid * NWAVES + C.wave, NGW = C.G * NWAVES;
    for (int m = gw; m < M; m += NGW) rmsnorm_row_bf16(X + (size_t)m * DM, w, H + (size_t)m * DM, C.lane);
}
__device__ __forceinline__ void final_norm_phase(Ctx& C, float* X, const float* w) {
    const int gw = C.bid * NWAVES + C.wave, NGW = C.G * NWAVES;
    for (int m = gw; m < M; m += NGW) {
        GAS f32x4* xr = (GAS f32x4*)(X + (size_t)m * DM) + C.lane; const GAS f32x4* wr = (const GAS f32x4*)w + C.lane;
        f32x4 v[16]; float ss = 0.f;
#pragma unroll
        for (int j = 0; j < 16; ++j) { v[j] = xr[64 * j]; ss += (v[j].x * v[j].x + v[j].y * v[j].y) + (v[j].z * v[j].z + v[j].w * v[j].w); }
        const float rstd = 1.f / sqrtf(wave_sum(ss) * (1.f / DM) + EPS);
#pragma unroll
        for (int j = 0; j < 16; ++j) { const f32x4 g = wr[64 * j]; xr[64 * j] = v[j] * rstd * g; }
    }
}

typedef short bf16x8 __attribute__((ext_vector_type(8)));
typedef short s16x4 __attribute__((ext_vector_type(4)));
__device__ __forceinline__ f32x4 mfma16(bf16x8 a, bf16x8 b, f32x4 c) { return __builtin_amdgcn_mfma_f32_16x16x32_bf16(a, b, c, 0, 0, 0); }
__device__ __forceinline__ bf16x8 pack8(f32x4 lo, f32x4 hi) { v4u w; w.x = pg8::cvt_pk_bf16(lo.x, lo.y); w.y = pg8::cvt_pk_bf16(lo.z, lo.w); w.z = pg8::cvt_pk_bf16(hi.x, hi.y); w.w = pg8::cvt_pk_bf16(hi.z, hi.w); return __builtin_bit_cast(bf16x8, w); }
__device__ __forceinline__ bf16x8 gfrag(const bf16* Mx, size_t ld, int row0, int k0, int lane) { return *(const GAS bf16x8*)(Mx + (size_t)(row0 + (lane & 15)) * ld + k0 + 8 * (lane >> 4)); }
__device__ __forceinline__ bf16x8 trfrag(const LAS unsigned char* img, int stride, int r0, int r1, int col0, int lane) {
    const int q = (lane & 15) >> 2, p = lane & 3;
    const s16x4 a = __builtin_amdgcn_ds_read_tr16_b64_v4i16((LAS s16x4*)(img + (r0 + q) * stride + (col0 + 4 * p) * 2));
    const s16x4 b = __builtin_amdgcn_ds_read_tr16_b64_v4i16((LAS s16x4*)(img + (r1 + q) * stride + (col0 + 4 * p) * 2));
    return __builtin_shufflevector(a, b, 0, 1, 2, 3, 4, 5, 6, 7);
}
__device__ __forceinline__ float xsum4(float v) { v += __shfl_xor(v, 16); v += __shfl_xor(v, 32); return v; }
__device__ __forceinline__ float xmax4(float v) { v = fmaxf(v, __shfl_xor(v, 16)); v = fmaxf(v, __shfl_xor(v, 32)); return v; }

constexpr int SWA_VSTRIDE = 144;
constexpr int SWA_V_BYTES = 192 * SWA_VSTRIDE;
__device__ __forceinline__ void swa_unit_mfma(Ctx& C, int l, int unit) {
    const int b = unit >> 7, qb = unit & 127, q0 = qb * 64;
    const int tid = C.tid, lane = C.lane, w = C.wave, c = lane & 15, hq = lane >> 4;
    LAS unsigned char* Vimg = C.lds;
    LAS float* tb = (LAS float*)(C.lds + 30720);
    LAS float* ssqx = (LAS float*)(C.lds + 30720 + 12288);
    const bf16* PROJ = (const bf16*)(C.ws + WS_PROJ); float* OSWA = (float*)(C.ws + WS_OSWA); bf16* Y = (bf16*)(C.ws + WS_Y);
    const bf16* Pb = PROJ + (size_t)b * SEQ * DINP;
    __syncthreads();
    for (int i = tid; i < 16 * 192; i += NTHR) { const int hd = i / 192, x = i % 192, dist = x - 32; tb[i] = (dist >= 0 && dist < 128) ? C.in[I_REL_BIAS][T5_BUCKET[dist] * SWA_H + hd] : 0.f; }
    if (tid < 16 * 9) *(LAS v4u*)(Vimg + (192 + tid / 9) * SWA_VSTRIDE + 16 * (tid % 9)) = (v4u){0u, 0u, 0u, 0u};
    const int g = w >> 1, qhalf = w & 1;
    float ssq0 = 0.f, ssq1 = 0.f;
    for (int kvh = 0; kvh < 4; ++kvh) {
        const int head = kvh * 4 + g;
        __syncthreads();
#pragma unroll
        for (int it = 0; it < 3; ++it) { const int idx = tid + NTHR * it, j = idx >> 3, cg = idx & 7; int s = q0 - 128 + j; s = s < 0 ? 0 : s;
            const v4u v = *(const GAS v4u*)(Pb + (size_t)s * DINP + C_SV + kvh * 64 + 8 * cg); *(LAS v4u*)(Vimg + j * SWA_VSTRIDE + 16 * cg) = v; }
        __syncthreads();
        const float sink = C.in[I_SWA_SINKS][l * SWA_H + head];
#pragma nounroll
        for (int qt = 0; qt < 2; ++qt) {
            const int j0 = 32 * qhalf + 16 * qt;
            const bf16x8 qf0 = gfrag(Pb + C_SQ + head * 64, DINP, q0 + j0, 0, lane), qf1 = gfrag(Pb + C_SQ + head * 64, DINP, q0 + j0, 32, lane);
            f32x4 sacc[10];
#pragma unroll
            for (int kt = 0; kt < 10; ++kt) {
                int srow = q0 - 128 + j0 + 16 * kt + c; srow = srow < 0 ? 0 : srow; srow = srow > q0 + 63 ? q0 + 63 : srow;
                const bf16* kp = Pb + (size_t)srow * DINP + C_SK + kvh * 64 + 8 * hq;
                const bf16x8 k0 = *(const GAS bf16x8*)kp, k1 = *(const GAS bf16x8*)(kp + 32);
                f32x4 a = (f32x4){0.f, 0.f, 0.f, 0.f}; a = mfma16(k0, qf0, a); a = mfma16(k1, qf1, a); sacc[kt] = a;
            }
            float mx = sink;
#pragma unroll
            for (int kt = 0; kt < 10; ++kt)
#pragma unroll
                for (int r = 0; r < 4; ++r) { const int dist = c + 128 - 16 * kt - 4 * hq - r; const int s = q0 - 128 + j0 + 16 * kt + 4 * hq + r;
                    const bool valid = (dist >= 0) && (dist < 128) && (s >= 0);
                    const float sc = valid ? sacc[kt][r] * 0.125f + tb[head * 192 + dist + 32] : -1e30f;
                    sacc[kt][r] = sc; mx = fmaxf(mx, sc); }
            mx = xmax4(mx); float sum = 0.f;
#pragma unroll
            for (int kt = 0; kt < 10; ++kt)
#pragma unroll
                for (int r = 0; r < 4; ++r) { const float p = __expf(sacc[kt][r] - mx); sacc[kt][r] = p; sum += p; }
            sum = xsum4(sum); const float inv = 1.f / (sum + __expf(sink - mx));
            f32x4 oacc[4];
#pragma unroll
            for (int dt = 0; dt < 4; ++dt) oacc[dt] = (f32x4){0.f, 0.f, 0.f, 0.f};
#pragma unroll
            for (int ks = 0; ks < 5; ++ks) { const bf16x8 pf = pack8(sacc[2 * ks], sacc[2 * ks + 1]);
#pragma unroll
                for (int dt = 0; dt < 4; ++dt) oacc[dt] = mfma16(trfrag(Vimg, SWA_VSTRIDE, j0 + 32 * ks + 4 * hq, j0 + 32 * ks + 16 + 4 * hq, 16 * dt, lane), pf, oacc[dt]); }
            float sq = 0.f; float* op = OSWA + (size_t)(b * SEQ + q0 + j0 + c) * SWA_W + head * 64 + 4 * hq;
#pragma unroll
            for (int dt = 0; dt < 4; ++dt) { const f32x4 o = oacc[dt] * inv; sq += (o.x * o.x + o.y * o.y) + (o.z * o.z + o.w * o.w); *(GAS f32x4*)(op + 16 * dt) = o; }
            if (qt == 0) ssq0 += sq; else ssq1 += sq;
        }
    }
    ssq0 = xsum4(ssq0); ssq1 = xsum4(ssq1);
    if (hq == 0) { ssqx[w * 32 + c] = ssq0; ssqx[w * 32 + 16 + c] = ssq1; }
    asm volatile("s_waitcnt vmcnt(0)" ::: "memory");
    __syncthreads();
    const float* swa_norm = C.in[I_SWA_NORM] + (size_t)l * SWA_W;
#pragma nounroll
    for (int qt = 0; qt < 2; ++qt) { const int qi = 16 * qt + c;
        const float tot = ssqx[(qhalf + 0) * 32 + qi] + ssqx[(qhalf + 2) * 32 + qi] + ssqx[(qhalf + 4) * 32 + qi] + ssqx[(qhalf + 6) * 32 + qi];
        const float rstd = 1.f / sqrtf(tot * (1.f / 1024.f) + EPS);
        const size_t row = (size_t)(b * SEQ + q0 + 32 * qhalf + qi);
#pragma unroll
        for (int kvh = 0; kvh < 4; ++kvh)
#pragma unroll
            for (int dt = 0; dt < 4; ++dt) { const int col = (kvh * 4 + g) * 64 + 16 * dt + 4 * hq; const f32x4 o = *(const GAS f32x4*)(OSWA + row * SWA_W + col); const f32x4 gn = *(const GAS f32x4*)(swa_norm + col);
                v2u ow; ow.x = pk2(o.x * rstd * gn.x, o.y * rstd * gn.y); ow.y = pk2(o.z * rstd * gn.z, o.w * rstd * gn.w); *(GAS v2u*)(Y + row * DM + 2048 + col) = ow; } }
}

constexpr int N_SWA_UNITS = BATCH * (SEQ / 64);

constexpr int SSD_L = 128, SSD_NC = SEQ / SSD_L, GLA_L = 64, GLA_NC = SEQ / GLA_L;
constexpr int N_SSD_CU = BATCH * SSD_NC * 8, N_GLA_CU = BATCH * GLA_NC * 4;
constexpr int XI_STRIDE = 528, BI_STRIDE = 272;

__device__ __forceinline__ void prep_phase(Ctx& C, int l) {
    const bf16* PROJ = (const bf16*)(C.ws + WS_PROJ); bf16* XBC = (bf16*)(C.ws + WS_XBC);
    const int tid = C.tid, lane = C.lane;
    { const int gw0 = C.bid * NWAVES + C.wave;
      for (int gw = gw0; gw < BATCH * SSD_NC * 16; gw += C.G * NWAVES) if ((gw & 15) == 0 && lane < SSD_H) {
          const int bc = gw >> 4; const size_t row0 = (size_t)bc * SSD_L;
          float* DT = (float*)(C.ws + WS_DT); float* ACS = (float*)(C.ws + WS_ACS); float* DEC = (float*)(C.ws + WS_DEC);
          const float dtb = C.in[I_SSD_DT_BIAS][l * SSD_H + lane], Ah = -expf(C.in[I_SSD_A_LOG][l * SSD_H + lane]);
          float cs = 0.f;
#pragma unroll 8
          for (int s = 0; s < SSD_L; ++s) { const float xr = bf1(PROJ[(row0 + s) * DINP + C_DT + lane]) + dtb; const float dt = xr > 20.f ? xr : log1pf(expf(xr)); cs += dt * Ah;
              DT[(row0 + s) * SSD_H + lane] = dt; ACS[(row0 + s) * SSD_H + lane] = cs; }
          DEC[bc * SSD_H + lane] = expf(cs);
      } }
    { const float* conv_w = C.in[I_SSD_CONV_W] + (size_t)l * 4 * SSD_CD; const float* conv_b = C.in[I_SSD_CONV_B] + (size_t)l * SSD_CD;
      const float* HT = (const float*)(C.ws + WS_XHT); const float* HB = (const float*)(C.ws + WS_XHB);
      constexpr int NIT = (M / 64) * 3 * 1024;
      for (int it = C.bid * NTHR + tid; it < NIT; it += C.G * NTHR) {
          const int c4 = it & 1023, ri = it >> 10, i = ri % 3, blk = ri / 3, c0 = 4 * c4; const bool first = (blk % (SEQ / 64)) == 0;
          f32x4 sq[6]; const f32x4 z4 = (f32x4){0.f, 0.f, 0.f, 0.f};
#pragma unroll
          for (int j = 0; j < 3; ++j) { sq[j] = first ? z4 : *(const GAS f32x4*)(HB + ((size_t)(blk - 1) * 3 + j) * 4096 + c0); sq[3 + j] = *(const GAS f32x4*)(HT + ((size_t)blk * 3 + j) * 4096 + c0); }
          const f32x4 x3 = i == 0 ? sq[0] : (i == 1 ? sq[1] : sq[2]), x2 = i == 0 ? sq[1] : (i == 1 ? sq[2] : sq[3]), x1 = i == 0 ? sq[2] : (i == 1 ? sq[3] : sq[4]), x0 = i == 0 ? sq[3] : (i == 1 ? sq[4] : sq[5]);
          const f32x4 w0 = *(const GAS f32x4*)(conv_w + c0), w1 = *(const GAS f32x4*)(conv_w + 4096 + c0), w2 = *(const GAS f32x4*)(conv_w + 2 * 4096 + c0), w3 = *(const GAS f32x4*)(conv_w + 3 * 4096 + c0), bb = *(const GAS f32x4*)(conv_b + c0);
          f32x4 o;
#pragma unroll
          for (int e = 0; e < 4; ++e) o[e] = silu_f(bb[e] + w0[e] * x3[e] + w1[e] * x2[e] + w2[e] * x1[e] + w3[e] * x0[e]);
          v2u ow; ow.x = pk2(o.x, o.y); ow.y = pk2(o.z, o.w); *(GAS v2u*)(XBC + (size_t)(64 * blk + i) * SSD_CD + c0) = ow;
      } }
    { LAS float* glr = (LAS float*)C.lds;
      bf16* QD = (bf16*)(C.ws + WS_QD); bf16* KI = (bf16*)(C.ws + WS_KI); float* GDEC = (float*)(C.ws + WS_GDEC);
      const float* w_gate = C.in[I_GLA_W_GATE] + (size_t)l * 16 * GLA_KT; const float bgv = C.in[I_GLA_B_GATE][l * GLA_KT + tid];
      float wg[16];
#pragma unroll
      for (int r = 0; r < 16; ++r) wg[r] = w_gate[r * GLA_KT + tid];
      for (int ck = C.bid; ck < BATCH * GLA_NC; ck += C.G) {
          const size_t row0 = (size_t)ck * GLA_L;
          __syncthreads();
          if (tid < 128) { const int t = tid >> 1, hf = tid & 1; const v4u r = *(const GAS v4u*)(PROJ + (row0 + t) * DINP + C_GLR + 8 * hf);
              *(LAS f32x4*)(glr + t * 16 + 8 * hf) = (f32x4){bflo(r.x), bfhi(r.x), bflo(r.y), bfhi(r.y)}; *(LAS f32x4*)(glr + t * 16 + 8 * hf + 4) = (f32x4){bflo(r.z), bfhi(r.z), bflo(r.w), bfhi(r.w)}; }
          __syncthreads();
          float cum = 0.f;
#pragma unroll 8
          for (int t = 0; t < GLA_L; ++t) {
              const float qv = bf1(PROJ[(row0 + t) * DINP + C_GQ + tid]), kv = bf1(PROJ[(row0 + t) * DINP + C_GK + tid]);
              float z = bgv;
#pragma unroll
              for (int r4 = 0; r4 < 4; ++r4) { const f32x4 gv = *(const LAS f32x4*)(glr + t * 16 + 4 * r4); z += gv.x * wg[4 * r4] + gv.y * wg[4 * r4 + 1] + gv.z * wg[4 * r4 + 2] + gv.w * wg[4 * r4 + 3]; }
              const float ls = fminf(z, 0.f) - __logf(1.f + __expf(-fabsf(z))); cum += ls * 0.0625f;
              QD[(row0 + t) * GLA_KT + tid] = (bf16)f2bf(qv * 0.08838834764831845f * __expf(cum)); KI[(row0 + t) * GLA_KT + tid] = (bf16)f2bf(kv * __expf(-cum));
          }
          GDEC[(size_t)ck * GLA_KT + tid] = __expf(cum);
      } }
}

__device__ __forceinline__ void gla_c1_unit(Ctx& C, int unit) {
    const int h = unit & 3, ck = unit >> 2; const size_t row0 = (size_t)ck * GLA_L;
    const int tid = C.tid, lane = C.lane, w = C.wave, c = lane & 15, hq = lane >> 4;
    LAS unsigned char* KEimg = C.lds; LAS unsigned char* Vimg = C.lds + 64 * BI_STRIDE;
    const bf16* PROJ = (const bf16*)(C.ws + WS_PROJ); const bf16* KI = (const bf16*)(C.ws + WS_KI); const float* GDEC = (const float*)(C.ws + WS_GDEC); bf16* GST = (bf16*)(C.ws + WS_GST);
    __syncthreads();
    { const int cg = tid & 15; const f32x4 d0 = *(const GAS f32x4*)(GDEC + (size_t)ck * GLA_KT + h * 128 + 8 * cg), d1 = *(const GAS f32x4*)(GDEC + (size_t)ck * GLA_KT + h * 128 + 8 * cg + 4);
#pragma unroll
      for (int it = 0; it < 2; ++it) { const int t = (tid + NTHR * it) >> 4; const v4u r = *(const GAS v4u*)(KI + (row0 + t) * GLA_KT + h * 128 + 8 * cg);
          v4u o; o.x = pk2(bflo(r.x) * d0.x, bfhi(r.x) * d0.y); o.y = pk2(bflo(r.y) * d0.z, bfhi(r.y) * d0.w); o.z = pk2(bflo(r.z) * d1.x, bfhi(r.z) * d1.y); o.w = pk2(bflo(r.w) * d1.z, bfhi(r.w) * d1.w);
          *(LAS v4u*)(KEimg + t * BI_STRIDE + 16 * cg) = o; } }
#pragma unroll
    for (int it = 0; it < 4; ++it) { const int idx = tid + NTHR * it, t = idx >> 5, cg = idx & 31; *(LAS v4u*)(Vimg + t * XI_STRIDE + 16 * cg) = *(const GAS v4u*)(PROJ + (row0 + t) * DINP + C_GV + h * 256 + 8 * cg); }
    __syncthreads();
    f32x4 acc[16];
#pragma unroll
    for (int nt = 0; nt < 16; ++nt) acc[nt] = (f32x4){0.f, 0.f, 0.f, 0.f};
#pragma unroll
    for (int ks = 0; ks < 2; ++ks) { const bf16x8 af = trfrag(KEimg, BI_STRIDE, 32 * ks + 8 * hq, 32 * ks + 8 * hq + 4, 16 * w, lane);
#pragma unroll
        for (int nt = 0; nt < 16; ++nt) acc[nt] = mfma16(af, trfrag(Vimg, XI_STRIDE, 32 * ks + 8 * hq, 32 * ks + 8 * hq + 4, 16 * nt, lane), acc[nt]); }
    bf16* gp = GST + (size_t)unit * 32768 + 16 * w + 4 * hq;
#pragma unroll
    for (int nt = 0; nt < 16; ++nt) { v2u o; o.x = pk2(acc[nt].x, acc[nt].y); o.y = pk2(acc[nt].z, acc[nt].w); *(GAS v2u*)(gp + (size_t)(16 * nt + c) * 128) = o; }
}

__device__ __forceinline__ void scan_phase(Ctx& C) {
    const bf16* GST = (const bf16*)(C.ws + WS_GST); bf16* GPV = (bf16*)(C.ws + WS_GPV); const float* GDEC = (const float*)(C.ws + WS_GDEC);
    const bf16* ST = (const bf16*)(C.ws + WS_ST); bf16* PV = (bf16*)(C.ws + WS_PV); const float* DEC = (const float*)(C.ws + WS_DEC);
    constexpr int N_G = BATCH * 4 * 256 * 32, N_S = BATCH * SSD_H * 64 * 32;
    for (int it = C.bid * NTHR + C.tid; it < N_G + N_S; it += C.G * NTHR) {
        if (it < N_S) {
            const int n4 = it & 31, p = (it >> 5) & 63, h = (it >> 11) & 31, b = it >> 16;
            f32x4 run = (f32x4){0.f, 0.f, 0.f, 0.f};
#pragma unroll 8
            for (int c = 0; c < SSD_NC; ++c) { const size_t u = (size_t)(b * SSD_NC + c) * SSD_H + h; const size_t off = u * 8192 + p * 128 + 4 * n4;
                const v2u xr = *(const GAS v2u*)(ST + off); const f32x4 x = (f32x4){bflo(xr.x), bfhi(xr.x), bflo(xr.y), bfhi(xr.y)}; const float d = DEC[u];
                v2u o; o.x = pk2(run.x, run.y); o.y = pk2(run.z, run.w); *(GAS v2u*)(PV + off) = o;
                run = run * d + x; }
        } else {
            const int i2 = it - N_S; const int k4 = i2 & 31, v = (i2 >> 5) & 255, h = (i2 >> 13) & 3, b = i2 >> 15;
            f32x4 run = (f32x4){0.f, 0.f, 0.f, 0.f};
#pragma unroll 8
            for (int c = 0; c < GLA_NC; ++c) { const size_t ck = (size_t)(b * GLA_NC + c); const size_t off = (ck * 4 + h) * 32768 + v * 128 + 4 * k4;
                const v2u xr = *(const GAS v2u*)(GST + off); const f32x4 x = (f32x4){bflo(xr.x), bfhi(xr.x), bflo(xr.y), bfhi(xr.y)}; const f32x4 d = *(const GAS f32x4*)(GDEC + ck * GLA_KT + h * 128 + 4 * k4);
                v2u o; o.x = pk2(run.x, run.y); o.y = pk2(run.z, run.w); *(GAS v2u*)(GPV + off) = o;
                run = run * d + x; }
        }
    }
}

constexpr int GC3_GP_OFF = 64 * XI_STRIDE, GC3_XCH_OFF = GC3_GP_OFF + 256 * BI_STRIDE;
__device__ __forceinline__ void gla_c3_unit(Ctx& C, int l, int unit) {
    const int h = unit & 3, ck = unit >> 2; const size_t row0 = (size_t)ck * GLA_L;
    const int tid = C.tid, lane = C.lane, w = C.wave, c = lane & 15, hq = lane >> 4;
    LAS unsigned char* Vimg = C.lds; LAS unsigned char* GPimg = C.lds + GC3_GP_OFF; LAS float* xch = (LAS float*)(C.lds + GC3_XCH_OFF);
    const bf16* PROJ = (const bf16*)(C.ws + WS_PROJ); const bf16* QD = (const bf16*)(C.ws + WS_QD); const bf16* KI = (const bf16*)(C.ws + WS_KI); const bf16* GPV = (const bf16*)(C.ws + WS_GPV); bf16* Y = (bf16*)(C.ws + WS_Y);
    const int lt = w >> 1, vh = w & 1; const size_t row = row0 + 16 * lt + c;
    __syncthreads();
    { const bf16* gpv = GPV + (size_t)unit * 32768;
      v4u tv[4], tg[8];
#pragma unroll
      for (int it = 0; it < 4; ++it) { const int idx = tid + NTHR * it, t = idx >> 5, cg = idx & 31; tv[it] = *(const GAS v4u*)(PROJ + (row0 + t) * DINP + C_GV + h * 256 + 8 * cg); }
#pragma unroll
      for (int it = 0; it < 8; ++it) { const int idx = tid + NTHR * it; tg[it] = *(const GAS v4u*)(gpv + (size_t)idx * 8); }
#pragma unroll
      for (int it = 0; it < 4; ++it) { const int idx = tid + NTHR * it, t = idx >> 5, cg = idx & 31; *(LAS v4u*)(Vimg + t * XI_STRIDE + 16 * cg) = tv[it]; }
#pragma unroll
      for (int it = 0; it < 8; ++it) { const int idx = tid + NTHR * it, v = idx >> 4, cg = idx & 15; *(LAS v4u*)(GPimg + v * BI_STRIDE + 16 * cg) = tg[it]; } }
    bf16x8 qf[4];
#pragma unroll
    for (int ks = 0; ks < 4; ++ks) qf[ks] = gfrag(QD + row0 * GLA_KT + h * 128, GLA_KT, 16 * lt, 32 * ks, lane);
    v2u ggv[8];
#pragma unroll
    for (int vt = 0; vt < 8; ++vt) ggv[vt] = *(const GAS v2u*)(PROJ + row * DINP + C_GG + h * 256 + 16 * (8 * vh + vt) + 4 * hq);
    f32x4 att[4];
#pragma unroll
    for (int st = 0; st < 4; ++st) { f32x4 a = (f32x4){0.f, 0.f, 0.f, 0.f};
        if (st <= lt) {
#pragma unroll
            for (int ks = 0; ks < 4; ++ks) a = mfma16(gfrag(KI + row0 * GLA_KT + h * 128, GLA_KT, 16 * st, 32 * ks, lane), qf[ks], a);
#pragma unroll
            for (int r = 0; r < 4; ++r) if (16 * st + 4 * hq + r > 16 * lt + c) a[r] = 0.f;
        }
        att[st] = a; }
    __syncthreads();
    f32x4 oacc[8];
#pragma unroll
    for (int vt = 0; vt < 8; ++vt) oacc[vt] = (f32x4){0.f, 0.f, 0.f, 0.f};
#pragma unroll
    for (int ks = 0; ks < 4; ++ks)
#pragma unroll
        for (int vt = 0; vt < 8; ++vt) oacc[vt] = mfma16(*(const LAS bf16x8*)(GPimg + (16 * (8 * vh + vt) + c) * BI_STRIDE + (32 * ks + 8 * hq) * 2), qf[ks], oacc[vt]);
#pragma unroll
    for (int ks2 = 0; ks2 < 2; ++ks2) { const bf16x8 pf = pack8(att[2 * ks2], att[2 * ks2 + 1]);
#pragma unroll
        for (int vt = 0; vt < 8; ++vt) oacc[vt] = mfma16(trfrag(Vimg, XI_STRIDE, 32 * ks2 + 4 * hq, 32 * ks2 + 16 + 4 * hq, 16 * (8 * vh + vt), lane), pf, oacc[vt]); }
    float ssq = 0.f;
#pragma unroll
    for (int vt = 0; vt < 8; ++vt) ssq += (oacc[vt].x * oacc[vt].x + oacc[vt].y * oacc[vt].y) + (oacc[vt].z * oacc[vt].z + oacc[vt].w * oacc[vt].w);
    ssq = xsum4(ssq);
    if (hq == 0) xch[w * 16 + c] = ssq;
    __syncthreads();
    const float rstd = 1.f / sqrtf((xch[w * 16 + c] + xch[(w ^ 1) * 16 + c]) * (1.f / 256.f) + EPS);
    const float* gla_norm = C.in[I_GLA_NORM] + (size_t)l * 256;
#pragma unroll
    for (int vt = 0; vt < 8; ++vt) { const int v0 = 16 * (8 * vh + vt) + 4 * hq; const f32x4 gn = *(const GAS f32x4*)(gla_norm + v0); const v2u gg = ggv[vt];
        const f32x4 o = oacc[vt]; v2u ow; ow.x = pk2(o.x * rstd * gn.x * silu_f(bflo(gg.x)), o.y * rstd * gn.y * silu_f(bfhi(gg.x))); ow.y = pk2(o.z * rstd * gn.z * silu_f(bflo(gg.y)), o.w * rstd * gn.w * silu_f(bfhi(gg.y)));
        *(GAS v2u*)(Y + row * DM + 3072 + h * 256 + v0) = ow; }
}

__device__ __forceinline__ void ssd_c1_unit(Ctx& C, int unit) {
    const int g = unit & 7, bc = unit >> 3; const size_t row0 = (size_t)bc * SSD_L;
    const int tid = C.tid, lane = C.lane, w = C.wave, c = lane & 15, hq = lane >> 4;
    LAS float* acs = (LAS float*)C.lds; LAS float* dts = acs + 512;
    LAS unsigned char* XWimg = C.lds + 4096; LAS unsigned char* Bimg = C.lds + 4096 + 128 * XI_STRIDE;
    const bf16* XBC = (const bf16*)(C.ws + WS_XBC); const float* DT = (const float*)(C.ws + WS_DT); const float* ACS = (const float*)(C.ws + WS_ACS); bf16* ST = (bf16*)(C.ws + WS_ST);
    __syncthreads();
    { const int t = tid >> 2, hh = tid & 3; acs[tid] = ACS[(row0 + t) * SSD_H + 4 * g + hh]; dts[tid] = DT[(row0 + t) * SSD_H + 4 * g + hh]; }
    __syncthreads();
#pragma unroll
    for (int it = 0; it < 8; ++it) { const int idx = tid + NTHR * it, t = idx >> 5, cg = idx & 31, hh = cg >> 3; const float wgt = __expf(acs[127 * 4 + hh] - acs[t * 4 + hh]) * dts[t * 4 + hh];
        const v4u r = *(const GAS v4u*)(XBC + (row0 + t) * SSD_CD + g * 256 + 8 * cg);
        v4u o; o.x = pk2(bflo(r.x) * wgt, bfhi(r.x) * wgt); o.y = pk2(bflo(r.y) * wgt, bfhi(r.y) * wgt); o.z = pk2(bflo(r.z) * wgt, bfhi(r.z) * wgt); o.w = pk2(bflo(r.w) * wgt, bfhi(r.w) * wgt);
        *(LAS v4u*)(XWimg + t * XI_STRIDE + 16 * cg) = o; }
#pragma unroll
    for (int it = 0; it < 4; ++it) { const int idx = tid + NTHR * it, t = idx >> 4, cg = idx & 15; *(LAS v4u*)(Bimg + t * BI_STRIDE + 16 * cg) = *(const GAS v4u*)(XBC + (row0 + t) * SSD_CD + 2048 + g * 128 + 8 * cg); }
    __syncthreads();
    const int hh = w >> 1, ph = w & 1;
    f32x4 acc[8][2];
#pragma unroll
    for (int mt = 0; mt < 8; ++mt) { acc[mt][0] = (f32x4){0.f, 0.f, 0.f, 0.f}; acc[mt][1] = (f32x4){0.f, 0.f, 0.f, 0.f}; }
#pragma unroll
    for (int ks = 0; ks < 4; ++ks) { const int r0 = 32 * ks + 8 * hq;
        const bf16x8 x0 = trfrag(XWimg, XI_STRIDE, r0, r0 + 4, hh * 64 + 32 * ph, lane), x1 = trfrag(XWimg, XI_STRIDE, r0, r0 + 4, hh * 64 + 32 * ph + 16, lane);
#pragma unroll
        for (int mt = 0; mt < 8; ++mt) { const bf16x8 bf = trfrag(Bimg, BI_STRIDE, r0, r0 + 4, 16 * mt, lane); acc[mt][0] = mfma16(bf, x0, acc[mt][0]); acc[mt][1] = mfma16(bf, x1, acc[mt][1]); } }
    bf16* sp = ST + ((size_t)bc * SSD_H + 4 * g + hh) * 8192 + 4 * hq;
#pragma unroll
    for (int mt = 0; mt < 8; ++mt)
#pragma unroll
        for (int pt = 0; pt < 2; ++pt) { v2u o; o.x = pk2(acc[mt][pt].x, acc[mt][pt].y); o.y = pk2(acc[mt][pt].z, acc[mt][pt].w); *(GAS v2u*)(sp + (size_t)(32 * ph + 16 * pt + c) * 128 + 16 * mt) = o; }
}

constexpr int SC3_X_OFF = 4096, SC3_PV_OFF = SC3_X_OFF + 128 * XI_STRIDE, SC3_PV_HEAD = 64 * BI_STRIDE;
static_assert(SC3_PV_OFF + 4 * SC3_PV_HEAD <= MISC_OFF && GC3_XCH_OFF + 512 <= MISC_OFF, "mixer LDS maps");
__device__ __forceinline__ void ssd_c3_unit(Ctx& C, int l, int unit) {
    const int g = unit & 7, bc = unit >> 3; const size_t row0 = (size_t)bc * SSD_L;
    const int tid = C.tid, lane = C.lane, w = C.wave, c = lane & 15, hq = lane >> 4;
    LAS float* acs = (LAS float*)C.lds; LAS float* dts = acs + 512;
    LAS unsigned char* Ximg = C.lds + SC3_X_OFF; LAS unsigned char* PVimg = C.lds + SC3_PV_OFF;
    const bf16* PROJ = (const bf16*)(C.ws + WS_PROJ); const bf16* XBC = (const bf16*)(C.ws + WS_XBC); const float* DT = (const float*)(C.ws + WS_DT); const float* ACS = (const float*)(C.ws + WS_ACS);
    const bf16* PV = (const bf16*)(C.ws + WS_PV); bf16* Y = (bf16*)(C.ws + WS_Y);
    const int tl = 16 * w + c; const size_t row = row0 + tl;
    __syncthreads();
    { const int t = tid >> 2, hh = tid & 3; const float a0 = ACS[(row0 + t) * SSD_H + 4 * g + hh], d0 = DT[(row0 + t) * SSD_H + 4 * g + hh];
      const bf16* pvb = PV + ((size_t)bc * SSD_H + 4 * g) * 8192;
      v4u tx[8], tp[8];
#pragma unroll
      for (int it = 0; it < 8; ++it) { const int idx = tid + NTHR * it, t2 = idx >> 5, cg = idx & 31; tx[it] = *(const GAS v4u*)(XBC + (row0 + t2) * SSD_CD + g * 256 + 8 * cg); }
#pragma unroll
      for (int it = 0; it < 8; ++it) { const int idx = tid + NTHR * it; tp[it] = *(const GAS v4u*)(pvb + (size_t)idx * 8); }
      acs[tid] = a0; dts[tid] = d0;
#pragma unroll
      for (int it = 0; it < 8; ++it) { const int idx = tid + NTHR * it, t2 = idx >> 5, cg = idx & 31; *(LAS v4u*)(Ximg + t2 * XI_STRIDE + 16 * cg) = tx[it]; }
#pragma unroll
      for (int it = 0; it < 8; ++it) { const int idx = tid + NTHR * it, pr = idx >> 4, cg = idx & 15; *(LAS v4u*)(PVimg + pr * BI_STRIDE + 16 * cg) = tp[it]; } }
    bf16x8 cf[4];
#pragma unroll
    for (int ks = 0; ks < 4; ++ks) cf[ks] = gfrag(XBC + row0 * SSD_CD + 3072 + g * 128, SSD_CD, 16 * w, 32 * ks, lane);
    f32x4 cb[8];
#pragma unroll
    for (int st = 0; st < 8; ++st) { f32x4 a = (f32x4){0.f, 0.f, 0.f, 0.f};
        if (st <= w) {
#pragma unroll
            for (int ks = 0; ks < 4; ++ks) a = mfma16(gfrag(XBC + row0 * SSD_CD + 2048 + g * 128, SSD_CD, 16 * st, 32 * ks, lane), cf[ks], a);
        }
        cb[st] = a; }
    __syncthreads();
    float* YT = (float*)(C.ws + WS_ST) + row * SSD_W + g * 256;
    float ssq = 0.f;
#pragma nounroll
    for (int hh = 0; hh < 4; ++hh) {
        v2u zz[4];
#pragma unroll
        for (int pt = 0; pt < 4; ++pt) zz[pt] = *(const GAS v2u*)(PROJ + row * DINP + C_Z + g * 256 + hh * 64 + 16 * pt + 4 * hq);
        const float acs_l = acs[tl * 4 + hh], el = __expf(acs_l);
        f32x4 ya[4];
#pragma unroll
        for (int pt = 0; pt < 4; ++pt) ya[pt] = (f32x4){0.f, 0.f, 0.f, 0.f};
#pragma unroll
        for (int ks = 0; ks < 4; ++ks)
#pragma unroll
            for (int pt = 0; pt < 4; ++pt) ya[pt] = mfma16(*(const LAS bf16x8*)(PVimg + (hh * 64 + 16 * pt + c) * BI_STRIDE + (32 * ks + 8 * hq) * 2), cf[ks], ya[pt]);
#pragma unroll
        for (int pt = 0; pt < 4; ++pt) ya[pt] = ya[pt] * el;
#pragma unroll
        for (int ks2 = 0; ks2 < 4; ++ks2) {
            if (2 * ks2 <= w) {
                f32x4 lm[2];
#pragma unroll
                for (int t2 = 0; t2 < 2; ++t2)
#pragma unroll
                    for (int r = 0; r < 4; ++r) { const int s = 32 * ks2 + 16 * t2 + 4 * hq + r; const float d = fminf(acs_l - acs[s * 4 + hh], 0.f);
                        lm[t2][r] = (s <= tl) ? cb[2 * ks2 + t2][r] * __expf(d) * dts[s * 4 + hh] : 0.f; }
                const bf16x8 pf = pack8(lm[0], lm[1]);
#pragma unroll
                for (int pt = 0; pt < 4; ++pt) ya[pt] = mfma16(trfrag(Ximg, XI_STRIDE, 32 * ks2 + 4 * hq, 32 * ks2 + 16 + 4 * hq, hh * 64 + 16 * pt, lane), pf, ya[pt]);
            }
        }
        const float Dh = C.in[I_SSD_D][l * SSD_H + 4 * g + hh];
#pragma unroll
        for (int pt = 0; pt < 4; ++pt) { const int col = hh * 64 + 16 * pt + 4 * hq; const v2u xw = *(const LAS v2u*)(Ximg + tl * XI_STRIDE + col * 2); const v2u z2 = zz[pt];
            f32x4 v; v.x = (ya[pt].x + Dh * bflo(xw.x)) * silu_f(bflo(z2.x)); v.y = (ya[pt].y + Dh * bfhi(xw.x)) * silu_f(bfhi(z2.x)); v.z = (ya[pt].z + Dh * bflo(xw.y)) * silu_f(bflo(z2.y)); v.w = (ya[pt].w + Dh * bfhi(xw.y)) * silu_f(bfhi(z2.y));
            *(GAS f32x4*)(YT + col) = v; ssq += (v.x * v.x + v.y * v.y) + (v.z * v.z + v.w * v.w); }
    }
    ssq = xsum4(ssq);
    const float rstd = 1.f / sqrtf(ssq * (1.f / 256.f) + EPS);
    const float* ssd_norm = C.in[I_SSD_NORM] + (size_t)l * SSD_W + g * 256;
    asm volatile("s_waitcnt vmcnt(0)" ::: "memory");
#pragma unroll 4
    for (int i = 0; i < 16; ++i) { const int col = 16 * i + 4 * hq; const f32x4 gn = *(const GAS f32x4*)(ssd_norm + col); const f32x4 v = *(const GAS f32x4*)(YT + col);
        v2u ow; ow.x = pk2(v.x * rstd * gn.x, v.y * rstd * gn.y); ow.y = pk2(v.z * rstd * gn.z, v.w * rstd * gn.w); *(GAS v2u*)(Y + row * DM + g * 256 + col) = ow; }
}

__device__ __forceinline__ void mix_c1_phase(Ctx& C, int l) {
    for (int u = C.bid; u < N_SSD_CU; u += C.G) ssd_c1_unit(C, u);
    for (int u = C.bid; u < N_GLA_CU; u += C.G) gla_c1_unit(C, u);
    for (int u = C.bid; u < N_SWA_UNITS; u += C.G) swa_unit_mfma(C, l, u);
}
__device__ __forceinline__ void mix_c3_phase(Ctx& C, int l) {
    for (int u = C.bid; u < N_SSD_CU; u += C.G) ssd_c3_unit(C, l, u);
    for (int u = C.bid; u < N_GLA_CU; u += C.G) gla_c3_unit(C, l, u);
}

__device__ __forceinline__ void act_fixup_phase(Ctx& C, int l) {
    bf16* ACT = (bf16*)(C.ws + WS_ACT); const float* HTG = (const float*)(C.ws + WS_HTG); const float* HTU = (const float*)(C.ws + WS_HTU); const float* HBG = (const float*)(C.ws + WS_HBG);
    const float* cw = C.in[I_FFN_CONV_W] + (size_t)l * 3 * DFF; const float* cb = C.in[I_FFN_CONV_B] + (size_t)l * DFF;
    constexpr int NC4 = DFF / 4, NIT = (M / 64) * 2 * NC4;
    for (int it = C.bid * NTHR + C.tid; it < NIT; it += C.G * NTHR) {
        const int c4 = it % NC4, ri = it / NC4, i = ri & 1, blk = ri >> 1, c0 = 4 * c4; const bool first = (blk % (SEQ / 64)) == 0;
        const f32x4 z4 = (f32x4){0.f, 0.f, 0.f, 0.f};
        const f32x4 g0 = *(const GAS f32x4*)(HTG + ((size_t)blk * 2 + i) * DFF + c0), up = *(const GAS f32x4*)(HTU + ((size_t)blk * 2 + i) * DFF + c0);
        const f32x4 pb1 = first ? z4 : *(const GAS f32x4*)(HBG + ((size_t)(blk - 1) * 2 + 1) * DFF + c0), pb0 = first ? z4 : *(const GAS f32x4*)(HBG + ((size_t)(blk - 1) * 2 + 0) * DFF + c0);
        const f32x4 g1 = i ? *(const GAS f32x4*)(HTG + ((size_t)blk * 2 + 0) * DFF + c0) : pb1, g2 = i ? pb1 : pb0;
        const f32x4 w0 = *(const GAS f32x4*)(cw + c0), w1 = *(const GAS f32x4*)(cw + DFF + c0), w2 = *(const GAS f32x4*)(cw + 2 * DFF + c0), bb = *(const GAS f32x4*)(cb + c0);
        f32x4 o;
#pragma unroll
        for (int e = 0; e < 4; ++e) { const float gc = bb[e] + w0[e] * g2[e] + w1[e] * g1[e] + w2[e] * g0[e]; o[e] = silu_f(gc) * up[e]; }
        v2u ow; ow.x = pk2(o.x, o.y); ow.y = pk2(o.z, o.w); *(GAS v2u*)(ACT + (size_t)(64 * blk + i) * DFF + c0) = ow;
    }
}

constexpr int PH_PER_LAYER = 11, PH_FINAL = DEPTH * PH_PER_LAYER, N_PHASES = PH_FINAL + 1;
#ifndef MK_ONE_LAUNCH
#define MK_ONE_LAUNCH 1
#endif
__global__ void __launch_bounds__(NTHR, 2) fwd_kernel(Args args) {
    extern __shared__ __attribute__((aligned(16))) unsigned char lds[];
    Ctx C;
    C.lds = (LAS unsigned char*)lds;
    C.tid = threadIdx.x; C.lane = C.tid & 63; C.wave = __builtin_amdgcn_readfirstlane(C.tid >> 6);
    C.G = gridDim.x; C.bid = blockIdx.x;
    C.in = args.in; C.out = args.out; C.ws = args.ws;
    volatile LAS unsigned* MISC = (volatile LAS unsigned*)(C.lds + MISC_OFF);
    for (int u = C.tid; u < (LDS_BYTES - MISC_OFF) / 4; u += NTHR) ((LAS unsigned*)(C.lds + MISC_OFF))[u] = 0u;
    __syncthreads();
    gu32* ctl = (gu32*)(args.ws + WS_CTL);
    XcdBarrier bar = xcd_barrier_post((unsigned*)(ctl + CW_BAR) + args.li * XCD_BAR_WORDS, MISC + 8);
    const int lo = args.ph_lo, hi = args.ph_hi;
#define IN(k) (lo <= (k) && (k) < hi)
#define SEAM(k) do { if (IN(k) && IN((k) + 1)) xcd_barrier(bar); } while (0)
    float* xres = args.out;
    bf16* H = (bf16*)(args.ws + WS_H);
#define LAYER_BODY(l) do { \
        const int pb = l * PH_PER_LAYER; \
        const float* xin = (l == 0) ? args.in[I_X] : (const float*)xres; \
        if (IN(pb + 0)) { convert_weights(C, l); rmsnorm_phase(C, xin, args.in[I_ATTN_NORM] + (size_t)l * DM, H); } \
        SEAM(pb + 0); \
        if (IN(pb + 1)) { \
            pg8::Gemm g{H, (const bf16*)(args.ws + WS_WIN), M, DINP, DM}; pg8::StaticOrder S; S.init(M, DINP, C.G, C.bid); \
            pg8::EpiProjConv E{(bf16*)(args.ws + WS_PROJ), DINP, (bf16*)(args.ws + WS_XBC), args.in[I_SSD_CONV_W] + (size_t)l * 4 * SSD_CD, args.in[I_SSD_CONV_B] + (size_t)l * SSD_CD, (float*)(args.ws + WS_XHT), (float*)(args.ws + WS_XHB)}; \
            pg8::gemm_phase<pg8::EpiProjConv, pg8::StaticOrder, true, true>(C.lds, g, S, E); \
        } \
        SEAM(pb + 1); \
        if (IN(pb + 2)) prep_phase(C, l); \
        SEAM(pb + 2); \
        if (IN(pb + 3)) mix_c1_phase(C, l); \
        SEAM(pb + 3); \
        if (IN(pb + 4)) scan_phase(C); \
        SEAM(pb + 4); \
        if (IN(pb + 5)) mix_c3_phase(C, l); \
        SEAM(pb + 5); \
        if (IN(pb + 6)) { \
            pg8::Gemm g{(const bf16*)(args.ws + WS_Y), (const bf16*)(args.ws + WS_WOUT), M, DM, DM}; pg8::StaticOrder S; S.init(M, DM, C.G, C.bid); \
            pg8::EpiRes E{xin, xres, DM}; \
            pg8::gemm_phase<pg8::EpiRes, pg8::StaticOrder, true, true>(C.lds, g, S, E); \
        } \
        SEAM(pb + 6); \
        if (IN(pb + 7)) rmsnorm_phase(C, xres, args.in[I_FFN_NORM] + (size_t)l * DM, H); \
        SEAM(pb + 7); \
        if (IN(pb + 8)) { \
            pg8::Gemm g{H, (const bf16*)(args.ws + WS_WGU), M, DGU, DM}; pg8::StaticOrder S; S.init(M, DGU, C.G, C.bid); \
            pg8::EpiGateUp E{(bf16*)(args.ws + WS_ACT), args.in[I_FFN_CONV_W] + (size_t)l * 3 * DFF, args.in[I_FFN_CONV_B] + (size_t)l * DFF, (float*)(args.ws + WS_HTG), (float*)(args.ws + WS_HTU), (float*)(args.ws + WS_HBG), DFF}; \
            pg8::gemm_phase<pg8::EpiGateUp, pg8::StaticOrder, true, true>(C.lds, g, S, E); \
        } \
        SEAM(pb + 8); \
        if (IN(pb + 9)) act_fixup_phase(C, l); \
        SEAM(pb + 9); \
        if (IN(pb + 10)) { \
            pg8::Gemm g{(const bf16*)(args.ws + WS_ACT), (const bf16*)(args.ws + WS_WDN), M, DM, DFF}; pg8::StaticOrder S; S.init(M, DM, C.G, C.bid); \
            pg8::EpiRes E{xres, xres, DM}; \
            pg8::gemm_phase<pg8::EpiRes, pg8::StaticOrder, true, true>(C.lds, g, S, E); \
        } \
        SEAM(pb + 10); \
     \
    } while (0)
    LAYER_BODY(0);
    LAYER_BODY(1);
#undef LAYER_BODY
    if (IN(PH_FINAL)) final_norm_phase(C, xres, args.in[I_FINAL_NORM]);
#undef IN
#undef SEAM
}

extern "C" void kernel_launch(void* const* d_in, const int* in_sizes, int n_in, void* d_out, int out_size, void* d_ws, size_t ws_size, hipStream_t stream) {
    static int grid = 0;
    if (grid == 0) {
        if (n_in != N_IN || out_size != M * DM || ws_size < WS_END) { fprintf(stderr, "kernel_launch: unexpected shapes (n_in %d, out %d, ws %zu < %zu)\n", n_in, out_size, ws_size, (size_t)WS_END); grid = -1; return; }
        int dev = 0, cus = 0, per_cu = 0;
        if (hipGetDevice(&dev) != hipSuccess || hipDeviceGetAttribute(&cus, hipDeviceAttributeMultiprocessorCount, dev) != hipSuccess) { grid = -1; return; }
        if (hipFuncSetAttribute((const void*)fwd_kernel, hipFuncAttributeMaxDynamicSharedMemorySize, LDS_BYTES) != hipSuccess) { fprintf(stderr, "kernel_launch: hipFuncSetAttribute failed\n"); grid = -1; return; }
        if (hipOccupancyMaxActiveBlocksPerMultiprocessor(&per_cu, (const void*)fwd_kernel, NTHR, LDS_BYTES) != hipSuccess || per_cu < 1) { fprintf(stderr, "kernel_launch: occupancy query says %d\n", per_cu); (void)hipGetLastError(); grid = -1; return; }
        grid = cus;
    }
    if (grid < 0) return;
    if (hipMemsetAsync((char*)d_ws + WS_CTL, 0, CTL_ZERO_BYTES, stream) != hipSuccess) return;
    Args a{};
    for (int i = 0; i < N_IN; ++i) a.in[i] = (const float*)d_in[i];
    a.out = (float*)d_out; a.ws = (unsigned char*)d_ws; a.pad = 0;
#if MK_ONE_LAUNCH
    a.ph_lo = 0; a.ph_hi = N_PHASES; a.li = 0;
    hipLaunchKernelGGL(fwd_kernel, dim3(grid), dim3(NTHR), LDS_BYTES, stream, a);
#else
    for (int p = 0; p < N_PHASES; ++p) { a.ph_lo = p; a.ph_hi = p + 1; a.li = p;
        hipLaunchKernelGGL(fwd_kernel, dim3(grid), dim3(NTHR), LDS_BYTES, stream, a); }
#endif
}
```

```cpp
#include <hip/hip_runtime.h>
#include <cstdio>
#include <cstdint>
namespace pg8 {
#define PG8_LAS __attribute__((address_space(3)))
typedef unsigned short bf16_t;
typedef short bf16x8 __attribute__((ext_vector_type(8)));
typedef float f32x4 __attribute__((ext_vector_type(4)));
typedef unsigned u32x4 __attribute__((ext_vector_type(4)));
constexpr int BM = 256, BK = 64, HALF = 128, HTB = HALF * BK * 2  , STAGE_BYTES = 8 * HTB, NXCD = 8, WGM = 8;

__host__ __device__ __forceinline__ int lds_byte(int r, int c) { const int st = (r >> 4) * 2 + (c >> 5), rr = r & 15, cc = c & 31, ob = rr * 64 + cc * 2; return st * 1024 + (ob ^ (((ob >> 9) & 1) << 5)); }
__host__ __device__ __forceinline__ void stage_rc(int b, int& R, int& C) { const int st = b / 1024, sb = b % 1024, swz = sb ^ (((sb >> 9) & 1) << 5); R = (st >> 1) * 16 + swz / 64; C = (st & 1) * 32 + (swz % 64) / 2; }
__host__ __device__ __forceinline__ int perm32(int rho) { const int n = rho >> 4, i = rho & 15; return 8 * (i >> 2) + 4 * n + (i & 3); }

struct Unit { int pm, pn; };
struct Gemm { const bf16_t* A; const bf16_t* Bt; int M, N, K; };

struct StaticOrder {
    int nM, nN, nwg, G, c, wgm;
    __host__ __device__ void init(int M, int N, int G_, int c_, int wgm_ = WGM) { nM = M / BM; nN = N / BM; nwg = nM * nN; G = G_; c = c_; wgm = wgm_; }
    __host__ __device__ bool next(int i, Unit& u) const {
        const long L = (long)i * G + c; if (L >= nwg) return false;
        int wgid = (int)L; { const int q = nwg / NXCD, r = nwg % NXCD, xcd = wgid % NXCD, off = wgid / NXCD; wgid = (xcd < r ? xcd * (q + 1) : r * (q + 1) + (xcd - r) * q) + off; }
        const int nig = wgm * nN, gid = wgid / nig, fm = gid * wgm, gsz = (nM - fm) < wgm ? (nM - fm) : wgm;
        u.pm = fm + ((wgid % nig) % gsz); u.pn = (wgid % nig) / gsz; return true;
    }
    __device__ __forceinline__ void a_ready(const Unit&) const {}
    __device__ __forceinline__ void done(const Unit&) const {}
};

typedef float f32x2c __attribute__((ext_vector_type(2)));
typedef __bf16 bf16x2c __attribute__((ext_vector_type(2)));
__device__ __forceinline__ unsigned cvt_pk_bf16(float lo, float hi) { const f32x2c v = {lo, hi}; return __builtin_bit_cast(unsigned, __builtin_convertvector(v, bf16x2c)); }

struct EpiBf16 {
    static constexpr bool PERM = true, AFTER_DRAIN = false;
    bf16_t* O; int ldc;
    __device__ __forceinline__ void operator()(const f32x4 (&acc)[2][2][4][2], const Unit& u, int wr, int wc, int fr, int fq) const {
        const int row0 = u.pm * BM + wr * 64 + fr; const int col0 = u.pn * BM + wc * 32 + 8 * fq;
#pragma unroll
        for (int ai = 0; ai < 2; ++ai)
#pragma unroll
            for (int m = 0; m < 4; ++m) { bf16_t* rowp = O + (size_t)(row0 + ai * HALF + m * 16) * ldc + col0;
#pragma unroll
                for (int bj = 0; bj < 2; ++bj) { const f32x4 v0 = acc[ai][bj][m][0], v1 = acc[ai][bj][m][1];
                    u32x4 w; w.x = cvt_pk_bf16(v0[0], v0[1]); w.y = cvt_pk_bf16(v0[2], v0[3]); w.z = cvt_pk_bf16(v1[0], v1[1]); w.w = cvt_pk_bf16(v1[2], v1[3]);
                    *(u32x4*)(rowp + bj * HALF) = w; } }
    }
};
template <int CTRL> __device__ __forceinline__ float dpp_old(float old, float v) { return __int_as_float(__builtin_amdgcn_update_dpp(__float_as_int(old), __float_as_int(v), CTRL, 0xf, 0xf, false)); }
struct EpiGateUp {
    static constexpr bool PERM = true, AFTER_DRAIN = false;
    bf16_t* ACT; const float* cw; const float* cb; float* HTG; float* HTU; float* HBG; int dff;
    __device__ __forceinline__ void operator()(const f32x4 (&acc)[2][2][4][2], const Unit& u, int wr, int wc, int fr, int fq) const {
        const int j0 = u.pn * 128 + wc * 32 + 8 * fq;
        float w0[8], w1[8], w2[8], bb[8];
#pragma unroll
        for (int h = 0; h < 2; ++h) { const f32x4 a = *(const f32x4*)(cw + j0 + 4 * h), b = *(const f32x4*)(cw + dff + j0 + 4 * h), c = *(const f32x4*)(cw + 2 * dff + j0 + 4 * h), d = *(const f32x4*)(cb + j0 + 4 * h);
#pragma unroll
            for (int e = 0; e < 4; ++e) { w0[4 * h + e] = a[e]; w1[4 * h + e] = b[e]; w2[4 * h + e] = c[e]; bb[4 * h + e] = d[e]; } }
#pragma unroll
        for (int ai = 0; ai < 2; ++ai) {
            const int rowb = u.pm * BM + ai * HALF + wr * 64; const size_t blk = (size_t)(rowb >> 6);
#pragma unroll
            for (int m = 0; m < 4; ++m) {
                const int row = rowb + 16 * m + fr; float o[8];
#pragma unroll
                for (int n = 0; n < 2; ++n)
#pragma unroll
                    for (int e = 0; e < 4; ++e) { const int k = 4 * n + e; const float g0 = acc[ai][0][m][n][e], up = acc[ai][1][m][n][e]; const float gp = m > 0 ? acc[ai][0][m > 0 ? m - 1 : 0][n][e] : 0.f;
                        const float g1 = dpp_old<0x111>(dpp_old<0x121>(0.f, gp), g0), g2 = dpp_old<0x112>(dpp_old<0x122>(0.f, gp), g0);
                        const float gc = bb[k] + w0[k] * g2 + w1[k] * g1 + w2[k] * g0; o[k] = gc * __builtin_amdgcn_rcpf(1.f + __expf(-gc)) * up; }
                u32x4 w; w.x = cvt_pk_bf16(o[0], o[1]); w.y = cvt_pk_bf16(o[2], o[3]); w.z = cvt_pk_bf16(o[4], o[5]); w.w = cvt_pk_bf16(o[6], o[7]);
                if (!(m == 0 && fr < 2)) *(u32x4*)(ACT + (size_t)row * dff + j0) = w;
                if (m == 0 && fr < 2) { float* pg = HTG + (blk * 2 + fr) * dff + j0; float* pu = HTU + (blk * 2 + fr) * dff + j0;
                    *(f32x4*)pg = acc[ai][0][0][0]; *(f32x4*)(pg + 4) = acc[ai][0][0][1]; *(f32x4*)pu = acc[ai][1][0][0]; *(f32x4*)(pu + 4) = acc[ai][1][0][1]; }
                if (m == 3 && fr >= 14) { float* pg = HBG + (blk * 2 + (fr - 14)) * dff + j0; *(f32x4*)pg = acc[ai][0][3][0]; *(f32x4*)(pg + 4) = acc[ai][0][3][1]; }
            }
        }
    }
};
struct EpiProjConv {
    static constexpr bool PERM = true, AFTER_DRAIN = false;
    bf16_t* O; int ldc; bf16_t* XBC; const float* cw; const float* cb; float* HT; float* HB;
    __device__ __forceinline__ void operator()(const f32x4 (&acc)[2][2][4][2], const Unit& u, int wr, int wc, int fr, int fq) const {
        if (u.pn < 8 || u.pn >= 24) {
            const int row0 = u.pm * BM + wr * 64 + fr; const int col0 = u.pn * BM + wc * 32 + 8 * fq;
#pragma unroll
            for (int ai = 0; ai < 2; ++ai)
#pragma unroll
                for (int m = 0; m < 4; ++m) { bf16_t* rowp = O + (size_t)(row0 + ai * HALF + m * 16) * ldc + col0;
#pragma unroll
                    for (int bj = 0; bj < 2; ++bj) { const f32x4 v0 = acc[ai][bj][m][0], v1 = acc[ai][bj][m][1];
                        u32x4 w; w.x = cvt_pk_bf16(v0[0], v0[1]); w.y = cvt_pk_bf16(v0[2], v0[3]); w.z = cvt_pk_bf16(v1[0], v1[1]); w.w = cvt_pk_bf16(v1[2], v1[3]);
                        *(u32x4*)(rowp + bj * HALF) = w; } }
            return;
        }
#pragma unroll
        for (int bj = 0; bj < 2; ++bj) {
            const int c0 = (u.pn - 8) * BM + bj * HALF + wc * 32 + 8 * fq;
            float wv[4][8], bb[8];
#pragma unroll
            for (int h = 0; h < 2; ++h) { const f32x4 d = *(const f32x4*)(cb + c0 + 4 * h);
#pragma unroll
                for (int e = 0; e < 4; ++e) bb[4 * h + e] = d[e];
#pragma unroll
                for (int i = 0; i < 4; ++i) { const f32x4 a = *(const f32x4*)(cw + i * 4096 + c0 + 4 * h);
#pragma unroll
                    for (int e = 0; e < 4; ++e) wv[i][4 * h + e] = a[e]; } }
#pragma unroll
            for (int ai = 0; ai < 2; ++ai) {
                const int rowb = u.pm * BM + ai * HALF + wr * 64; const size_t blk = (size_t)(rowb >> 6);
#pragma unroll
                for (int m = 0; m < 4; ++m) {
                    const int row = rowb + 16 * m + fr; float o[8];
#pragma unroll
                    for (int n = 0; n < 2; ++n)
#pragma unroll
                        for (int e = 0; e < 4; ++e) { const int k = 4 * n + e; const float x0 = acc[ai][bj][m][n][e]; const float xp = m > 0 ? acc[ai][bj][m > 0 ? m - 1 : 0][n][e] : 0.f;
                            const float x1 = dpp_old<0x111>(dpp_old<0x121>(0.f, xp), x0), x2 = dpp_old<0x112>(dpp_old<0x122>(0.f, xp), x0), x3 = dpp_old<0x113>(dpp_old<0x123>(0.f, xp), x0);
                            const float a = bb[k] + wv[0][k] * x3 + wv[1][k] * x2 + wv[2][k] * x1 + wv[3][k] * x0; o[k] = a * __builtin_amdgcn_rcpf(1.f + __expf(-a)); }
                    u32x4 w; w.x = cvt_pk_bf16(o[0], o[1]); w.y = cvt_pk_bf16(o[2], o[3]); w.z = cvt_pk_bf16(o[4], o[5]); w.w = cvt_pk_bf16(o[6], o[7]);
                    if (!(m == 0 && fr < 3)) *(u32x4*)(XBC + (size_t)row * 4096 + c0) = w;
                    if (m == 0 && fr < 3) { float* p = HT + (blk * 3 + fr) * 4096 + c0; *(f32x4*)p = acc[ai][bj][0][0]; *(f32x4*)(p + 4) = acc[ai][bj][0][1]; }
                    if (m == 3 && fr >= 13) { float* p = HB + (blk * 3 + (fr - 13)) * 4096 + c0; *(f32x4*)p = acc[ai][bj][3][0]; *(f32x4*)(p + 4) = acc[ai][bj][3][1]; }
                }
            }
        }
    }
};
struct EpiRes {
    static constexpr bool PERM = false, AFTER_DRAIN = false;
    const float* base; float* out; int ldc;
    __device__ __forceinline__ void operator()(const f32x4 (&acc)[2][2][4][2], const Unit& u, int wr, int wc, int fr, int fq) const {
        const int row0 = u.pm * BM + wr * 64 + fr, col0 = u.pn * BM + wc * 32 + 4 * fq;
#pragma unroll
        for (int ai = 0; ai < 2; ++ai)
#pragma unroll
            for (int m = 0; m < 4; ++m) { const size_t off = (size_t)(row0 + ai * HALF + m * 16) * ldc + col0;
#pragma unroll
                for (int bj = 0; bj < 2; ++bj)
#pragma unroll
                    for (int n = 0; n < 2; ++n) { const f32x4 bs = *(const f32x4*)(base + off + bj * HALF + n * 16); *(f32x4*)(out + off + bj * HALF + n * 16) = bs + acc[ai][bj][m][n]; } }
    }
};
template <class Epi, class Sched, bool ALIGN_EPI = false, bool SP2 = false>
__device__ __forceinline__ void gemm_phase(PG8_LAS unsigned char* lds, const Gemm g, const Sched& S, const Epi& E) {
    const int tid = threadIdx.x, wid = __builtin_amdgcn_readfirstlane(tid >> 6), lane = tid & 63, wr = wid >> 2, wc = wid & 3, fr = lane & 15, fq = lane >> 4;
    const int K = g.K, nt = K / BK;
    unsigned voffA[2], voffB[2];
#pragma unroll
    for (int i = 0; i < 2; ++i) { int R, C; stage_rc(tid * 16 + i * 8192, R, C); const int Rb = Epi::PERM ? ((R & ~31) + perm32(R & 31)) : R;
        voffA[i] = (unsigned)(R * K + C) * 2u; voffB[i] = (unsigned)(Rb * K + C) * 2u; }
    const size_t kstep = (size_t)(BK * 2);
    const size_t hstep = (size_t)HALF * K * 2;
    const size_t tstep = 2 * hstep;
    const unsigned ldsw = (unsigned)wid * 1024u;
    const int aoff = lds_byte(wr * 64 + fr, fq * 8), boff = lds_byte(wc * 32 + fr, fq * 8);
#define PG8_SA(b, h) (((b) * 2 + (h)) * HTB)
#define PG8_SB(b, h) ((4 + (b) * 2 + (h)) * HTB)
#define PG8_STAGE(bufoff, gbase, voff) do { _Pragma("unroll") for (int _i = 0; _i < 2; ++_i) \
        __builtin_amdgcn_global_load_lds((const unsigned*)((const char*)(gbase) + (voff)[_i]), (PG8_LAS unsigned*)(lds + (bufoff) + ldsw + _i * 8192), 16, 0, 0); } while (0)
#define PG8_LDA(dst, b, h) do { _Pragma("unroll") for (int m = 0; m < 4; ++m) _Pragma("unroll") for (int k = 0; k < 2; ++k) dst[m][k] = *(const PG8_LAS bf16x8*)(lds + PG8_SA(b, h) + aoff + m * 2048 + k * 1024); } while (0)
#define PG8_LDB(dst, b, h) do { _Pragma("unroll") for (int n = 0; n < 2; ++n) _Pragma("unroll") for (int k = 0; k < 2; ++k) dst[n][k] = *(const PG8_LAS bf16x8*)(lds + PG8_SB(b, h) + boff + n * 2048 + k * 1024); } while (0)
#define PG8_MMA(ai, bj, At, Bt) do { __builtin_amdgcn_s_setprio(1); _Pragma("unroll") for (int m = 0; m < 4; ++m) _Pragma("unroll") for (int n = 0; n < 2; ++n) _Pragma("unroll") for (int k = 0; k < 2; ++k) \
        acc[ai][bj][m][n] = __builtin_amdgcn_mfma_f32_16x16x32_bf16(Bt[n][k], At[m][k], acc[ai][bj][m][n], 0, 0, 0); __builtin_amdgcn_s_setprio(0); } while (0)
#define PG8_WAIT_V(n) asm volatile("s_waitcnt vmcnt(" #n ")" ::: "memory")
#define PG8_WAIT_L(n) asm volatile("s_waitcnt lgkmcnt(" #n ")" ::: "memory")
#define PG8_BAR __builtin_amdgcn_s_barrier()
#define PG8_SCHED __builtin_amdgcn_sched_barrier(0)
    Unit cur, nxt; int ui = 0;
    if (!S.next(0, cur)) return;
    f32x4 acc[2][2][4][2];
#pragma unroll
    for (int a = 0; a < 2; ++a)
#pragma unroll
        for (int b = 0; b < 2; ++b)
#pragma unroll
            for (int m = 0; m < 4; ++m)
#pragma unroll
                for (int n = 0; n < 2; ++n) acc[a][b][m][n] = (f32x4){0.f, 0.f, 0.f, 0.f};
    bf16x8 At[4][2], B0[2][2], B1[2][2];
    const char* cA = (const char*)g.A + (size_t)cur.pm * tstep; const char* cB = (const char*)g.Bt + (size_t)cur.pn * tstep;
    S.a_ready(cur);
    if constexpr (SP2) {
        PG8_STAGE(PG8_SB(0, 0), cB, voffB); PG8_STAGE(PG8_SB(0, 1), cB + hstep, voffB); PG8_STAGE(PG8_SA(0, 0), cA, voffA); PG8_STAGE(PG8_SA(0, 1), cA + hstep, voffA);
        if (wr == 1) PG8_BAR;
        PG8_WAIT_V(2); PG8_BAR;
        PG8_STAGE(PG8_SB(1, 0), cB + kstep, voffB); PG8_STAGE(PG8_SA(1, 0), cA + kstep, voffA); PG8_STAGE(PG8_SB(1, 1), cB + hstep + kstep, voffB);
        PG8_WAIT_V(6); PG8_BAR;
    } else {
        PG8_STAGE(PG8_SB(0, 0), cB, voffB); PG8_STAGE(PG8_SA(0, 0), cA, voffA); PG8_STAGE(PG8_SB(0, 1), cB + hstep, voffB); PG8_STAGE(PG8_SA(0, 1), cA + hstep, voffA);
        if (wr == 1) PG8_BAR;
        PG8_WAIT_V(4); PG8_BAR;
        PG8_STAGE(PG8_SB(1, 0), cB + kstep, voffB); PG8_STAGE(PG8_SA(1, 0), cA + kstep, voffA); PG8_STAGE(PG8_SB(1, 1), cB + hstep + kstep, voffB);
        PG8_WAIT_V(6); PG8_BAR;
    }
    for (;;) {
        const bool has_next = S.next(ui + 1, nxt);
        const char* nA = has_next ? (const char*)g.A + (size_t)nxt.pm * tstep : cA; const char* nB = has_next ? (const char*)g.Bt + (size_t)nxt.pn * tstep : cB;
        for (int t = 0; t < nt; t += 2) {
            const bool last = (t == nt - 2);
            const char* a1 = cA + (size_t)(t + 1) * kstep;
            const char* a2 = last ? nA : cA + (size_t)(t + 2) * kstep; const char* b2 = last ? nB : cB + (size_t)(t + 2) * kstep;
            const char* a3 = a2 + kstep; const char* b3 = b2 + kstep;
            if (last && has_next) S.a_ready(nxt);
            if constexpr (SP2) {
            PG8_LDB(B0, 0, 0); PG8_LDB(B1, 0, 1); PG8_SCHED; PG8_LDA(At, 0, 0); PG8_STAGE(PG8_SA(1, 1), a1 + hstep, voffA);
            PG8_WAIT_V(8); PG8_WAIT_L(0); PG8_BAR; PG8_MMA(0, 0, At, B0); PG8_MMA(0, 1, At, B1); PG8_BAR; PG8_SCHED;
            PG8_LDA(At, 0, 1); PG8_STAGE(PG8_SB(0, 0), b2, voffB); PG8_STAGE(PG8_SB(0, 1), b2 + hstep, voffB); PG8_STAGE(PG8_SA(0, 0), a2, voffA);
            PG8_WAIT_V(8); PG8_WAIT_L(0); PG8_BAR; PG8_MMA(1, 0, At, B0); PG8_MMA(1, 1, At, B1); PG8_BAR; PG8_SCHED;
            PG8_LDB(B0, 1, 0); PG8_LDB(B1, 1, 1); PG8_SCHED; PG8_LDA(At, 1, 0); PG8_STAGE(PG8_SA(0, 1), a2 + hstep, voffA);
            PG8_WAIT_V(8); PG8_WAIT_L(0); PG8_BAR; PG8_MMA(0, 0, At, B0); PG8_MMA(0, 1, At, B1); PG8_BAR; PG8_SCHED;
            PG8_LDA(At, 1, 1); PG8_STAGE(PG8_SB(1, 0), b3, voffB); PG8_STAGE(PG8_SB(1, 1), b3 + hstep, voffB); PG8_STAGE(PG8_SA(1, 0), a3, voffA);
            PG8_WAIT_V(8); PG8_WAIT_L(0); PG8_BAR; PG8_MMA(1, 0, At, B0); PG8_MMA(1, 1, At, B1); PG8_BAR; PG8_SCHED;
            } else {
            PG8_LDB(B0, 0, 0); PG8_SCHED; PG8_LDA(At, 0, 0); PG8_STAGE(PG8_SA(1, 1), a1 + hstep, voffA);
            PG8_WAIT_L(8); PG8_BAR; PG8_WAIT_L(0); PG8_MMA(0, 0, At, B0); PG8_BAR; PG8_SCHED;
            PG8_LDB(B1, 0, 1); PG8_STAGE(PG8_SB(0, 0), b2, voffB);
            PG8_BAR; PG8_WAIT_L(0); PG8_MMA(0, 1, At, B1); PG8_BAR;
            PG8_LDA(At, 0, 1); PG8_STAGE(PG8_SA(0, 0), a2, voffA);
            PG8_BAR; PG8_WAIT_L(0); PG8_MMA(1, 0, At, B0); PG8_BAR; PG8_SCHED;
            PG8_STAGE(PG8_SB(0, 1), b2 + hstep, voffB);
            PG8_WAIT_V(6); PG8_BAR; PG8_MMA(1, 1, At, B1); PG8_BAR;
            PG8_LDB(B0, 1, 0); PG8_SCHED; PG8_LDA(At, 1, 0); PG8_STAGE(PG8_SA(0, 1), a2 + hstep, voffA);
            PG8_WAIT_L(8); PG8_BAR; PG8_WAIT_L(0); PG8_MMA(0, 0, At, B0); PG8_BAR; PG8_SCHED;
            PG8_LDB(B1, 1, 1); PG8_STAGE(PG8_SB(1, 0), b3, voffB);
            PG8_BAR; PG8_WAIT_L(0); PG8_MMA(0, 1, At, B1); PG8_BAR;
            PG8_LDA(At, 1, 1); PG8_STAGE(PG8_SA(1, 0), a3, voffA);
            PG8_BAR; PG8_WAIT_L(0); PG8_MMA(1, 0, At, B0); PG8_BAR; PG8_SCHED;
            PG8_STAGE(PG8_SB(1, 1), b3 + hstep, voffB);
            PG8_WAIT_V(6); PG8_BAR; PG8_MMA(1, 1, At, B1); PG8_BAR;
            }
        }
        if constexpr (ALIGN_EPI) { if (wr == 0) PG8_BAR; }
        if constexpr (!Epi::AFTER_DRAIN) { E(acc, cur, wr, wc, fr, fq); S.done(cur); }
        if (!has_next) break;
#pragma unroll
        for (int a = 0; a < 2; ++a)
#pragma unroll
            for (int b = 0; b < 2; ++b)
#pragma unroll
                for (int m = 0; m < 4; ++m)
#pragma unroll
                    for (int n = 0; n < 2; ++n) acc[a][b][m][n] = (f32x4){0.f, 0.f, 0.f, 0.f};
        cur = nxt; cA = nA; cB = nB; ++ui;
        if constexpr (ALIGN_EPI) { if (wr == 1) PG8_BAR; }
    }
    PG8_WAIT_V(0);
    if constexpr (!ALIGN_EPI) { if (wr == 0) PG8_BAR; }
    PG8_BAR;
    if constexpr (Epi::AFTER_DRAIN) { E.fused(acc, cur, wr, wc, fr, fq, lds, wid, lane); S.done(cur); }
#undef PG8_SA
#undef PG8_SB
#undef PG8_STAGE
#undef PG8_LDA
#undef PG8_LDB
#undef PG8_MMA
#undef PG8_WAIT_V
#undef PG8_WAIT_L
#undef PG8_BAR
#undef PG8_SCHED
}
}

constexpr int NWAVES = 8, NTHR = NWAVES * 64;
constexpr int BATCH = 2, SEQ = 8192, M = BATCH * SEQ, DM = 4096, DEPTH = 2;
constexpr int SSD_W = 2048, SSD_H = 32, SSD_CD = 4096;
constexpr int SWA_W = 1024, SWA_H = 16;
constexpr int GLA_W = 1024, GLA_KT = 512;
constexpr int DFF = 11008, DIN = 10800, DINP = 11008, DGU = 2 * DFF;
constexpr float EPS = 1e-6f;
constexpr int C_Z = 0, C_XBC = 2048, C_DT = 6144, C_SQ = 6176, C_SK = 7200, C_SV = 7456, C_GQ = 7712, C_GK = 8224, C_GV = 8736, C_GG = 9760, C_GLR = 10784;
enum { I_X = 0, I_ATTN_NORM, I_W_IN, I_SSD_CONV_W, I_SSD_CONV_B, I_SSD_DT_BIAS, I_SSD_A_LOG, I_SSD_D, I_SSD_NORM, I_SWA_SINKS, I_SWA_NORM, I_GLA_W_GATE, I_GLA_B_GATE, I_GLA_NORM,
       I_W_OUT, I_FFN_NORM, I_W_GATE, I_W_UP, I_FFN_CONV_W, I_FFN_CONV_B, I_W_DOWN, I_REL_BIAS, I_FINAL_NORM, N_IN };

constexpr size_t MiB = 1u << 20;
constexpr size_t WS_CTL = 0, CTL_ZERO_BYTES = 1 * MiB;
constexpr size_t WS_WIN = 1 * MiB;
constexpr size_t WS_WOUT = 87 * MiB;
constexpr size_t WS_WGU = 119 * MiB;
constexpr size_t WS_WDN = 291 * MiB;
constexpr size_t WS_H = 377 * MiB;
constexpr size_t WS_R = 505 * MiB;
constexpr size_t WS_PROJ = WS_R;
constexpr size_t WS_XBC = WS_R + 344 * MiB;
constexpr size_t WS_QD = WS_R + 472 * MiB;
constexpr size_t WS_KI = WS_R + 488 * MiB;
constexpr size_t WS_DT = WS_R + 520 * MiB;
constexpr size_t WS_ACS = WS_R + 522 * MiB;
constexpr size_t WS_DEC = WS_R + 524 * MiB;
constexpr size_t WS_GDEC = WS_R + 525 * MiB;
constexpr size_t WS_ST = WS_R + 528 * MiB;
constexpr size_t WS_PV = WS_R + 656 * MiB;
constexpr size_t WS_GST = WS_R + 720 * MiB;
constexpr size_t WS_GPV = WS_R + 848 * MiB;
constexpr size_t WS_OSWA = WS_R + 912 * MiB;
constexpr size_t WS_Y = WS_R + 976 * MiB;
constexpr size_t WS_ACT = WS_R + 688 * MiB;
constexpr size_t WS_HTG = WS_R + 1032 * MiB, WS_HTU = WS_R + 1054 * MiB, WS_HBG = WS_R + 1076 * MiB;
constexpr size_t WS_XHT = WS_R + 504 * MiB, WS_XHB = WS_R + 1104 * MiB;
constexpr size_t WS_END = WS_R + 1120 * MiB;
static_assert(DEPTH == 2 && (size_t)DINP * DM * 2 == 86 * MiB && (size_t)DGU * DM * 2 == 172 * MiB && (size_t)M * DINP * 2 == 344 * MiB , "ws map");
constexpr int CW_BAR = 4096;

constexpr int RING_BYTES = 131072;
constexpr int MISC_OFF = 147456 - 256;
constexpr int LDS_BYTES = 147456;

#define GAS __attribute__((address_space(1)))
#define LAS __attribute__((address_space(3)))
typedef unsigned short bf16;
typedef unsigned v4u __attribute__((ext_vector_type(4)));
typedef unsigned v2u __attribute__((ext_vector_type(2)));
typedef float f32x4 __attribute__((ext_vector_type(4)));
typedef GAS unsigned gu32;
#define RLX_AGENT __ATOMIC_RELAXED, __HIP_MEMORY_SCOPE_AGENT
#define LDS_WAIT() asm volatile("s_waitcnt lgkmcnt(0)" ::: "memory")
__device__ __forceinline__ unsigned f2bf(float f) { unsigned u = __builtin_bit_cast(unsigned, f); return (u + 0x7fffu + ((u >> 16) & 1u)) >> 16; }
__device__ __forceinline__ unsigned pk2(float lo, float hi) { return pg8::cvt_pk_bf16(lo, hi); }
__device__ __forceinline__ float bflo(unsigned w) { return __uint_as_float(w << 16); }
__device__ __forceinline__ float bfhi(unsigned w) { return __uint_as_float(w & 0xffff0000u); }
__device__ __forceinline__ float bf1(bf16 h) { return __uint_as_float((unsigned)h << 16); }
__device__ __forceinline__ float silu_f(float x) { return x * __builtin_amdgcn_rcpf(1.f + __expf(-x)); }
__device__ __forceinline__ float wave_sum(float v) {
#pragma unroll
    for (int o = 1; o < 64; o <<= 1) v += __shfl_xor(v, o);
    return v;
}
template <int CTRL> __device__ __forceinline__ float dpp_f(float v) { return __int_as_float(__builtin_amdgcn_update_dpp(0, __float_as_int(v), CTRL, 0xf, 0xf, false)); }
__device__ __forceinline__ float row16_sum(float v) { v += dpp_f<0xB1>(v); v += dpp_f<0x4E>(v); v += dpp_f<0x124>(v); v += dpp_f<0x128>(v); return v; }
__device__ __forceinline__ float pair_sum(float v) { return v + dpp_f<0xB1>(v); }
#define XB_TMO      128
#define XB_XCNT(j)  (256  + 64 * (j))
#define XB_XSUB(j)  (1280 + 64 * (j))
#define XB_XGEN(j)  (2304 + 64 * (j))
#define XB_TOP      3328
#define XB_TOPGEN   3392
#define XCD_BAR_WORDS 3456
#define XB_SPIN_CAP (1u << 18)

__device__ __forceinline__ unsigned xb_ld(unsigned* p)              { return __hip_atomic_load(p, __ATOMIC_RELAXED, __HIP_MEMORY_SCOPE_AGENT); }
__device__ __forceinline__ unsigned xb_add(unsigned* p, unsigned v) { return __hip_atomic_fetch_add(p, v, __ATOMIC_RELAXED, __HIP_MEMORY_SCOPE_AGENT); }
__device__ __forceinline__ unsigned xb_xcc_id() { return (unsigned)__builtin_amdgcn_s_getreg((3 << 11) | 20) & 0xFu; }
#define XB_SPIN(cond, bar) do { unsigned _sp = 0; while (cond) { __builtin_amdgcn_s_sleep(1); \
    if ((++_sp & 255u) == 0u) { if (xb_ld(&(bar)[XB_TMO])) break; if (_sp > XB_SPIN_CAP) { atomicAdd(&(bar)[XB_TMO], 1u); break; } } } } while (0)

struct XcdBarrier {
    unsigned* bar; unsigned x;
    volatile LAS unsigned* st;
};

__device__ __forceinline__ XcdBarrier xcd_barrier_post(unsigned* bar, volatile LAS unsigned* st) {
    XcdBarrier b; b.bar = bar; b.x = xb_xcc_id(); b.st = st;
    if (threadIdx.x == 0) (void)xb_add(&bar[XB_XCNT(b.x)], 1u);
    return b;
}
__device__ __forceinline__ void xcd_barrier_complete(unsigned* bar, unsigned x, unsigned& nloc, unsigned& nx) {
    const unsigned G = gridDim.x * gridDim.y * gridDim.z;
    unsigned sum, cnt, mine, sp = 0u;
    for (;;) {
        sum = 0u; cnt = 0u; mine = 0u;
#pragma unroll
        for (unsigned j = 0; j < 16; ++j) { const unsigned c = xb_ld(&bar[XB_XCNT(j)]); sum += c; cnt += (c > 0u) ? 1u : 0u; mine = (j == x) ? c : mine; }
        if (sum == G) break;
        __builtin_amdgcn_s_sleep(1);
        if ((++sp & 255u) == 0u) { if (xb_ld(&bar[XB_TMO])) break; if (sp > XB_SPIN_CAP) { atomicAdd(&bar[XB_TMO], 1u); break; } }
    }
    nloc = mine > 0u ? mine : 1u; nx = cnt > 0u ? cnt : 1u;
}

__device__ __forceinline__ void xcd_barrier(const XcdBarrier& b) {
    asm volatile("s_waitcnt vmcnt(0)" ::: "memory");
    __syncthreads();
    if (threadIdx.x == 0) {
        unsigned* bar = b.bar;
        __builtin_amdgcn_s_waitcnt(0);
        unsigned nloc = b.st[0], nx = b.st[1];
        if (nloc == 0u) { xcd_barrier_complete(bar, b.x, nloc, nx); b.st[0] = nloc; b.st[1] = nx; }
        const unsigned old = xb_add(&bar[XB_XSUB(b.x)], 1u);
        const unsigned gen = old / nloc;
        if (old + 1u == (gen + 1u) * nloc) {
            __builtin_amdgcn_fence(__ATOMIC_RELEASE, "agent");
            asm volatile("s_waitcnt vmcnt(0)" ::: "memory");
            const unsigned og = xb_add(&bar[XB_TOP], 1u);
            const unsigned tg = og / nx;
            if (og + 1u == (tg + 1u) * nx) xb_add(&bar[XB_TOPGEN], 1u);
            else XB_SPIN(xb_ld(&bar[XB_TOPGEN]) == tg, bar);
            __builtin_amdgcn_fence(__ATOMIC_ACQUIRE, "agent");
            xb_add(&bar[XB_XGEN(b.x)], 1u);
            asm volatile("s_waitcnt vmcnt(0)" ::: "memory");
        } else {
            XB_SPIN(xb_ld(&bar[XB_XGEN(b.x)]) == gen, bar);
            __builtin_amdgcn_fence(__ATOMIC_ACQUIRE, "agent");
            asm volatile("s_waitcnt vmcnt(0)" ::: "memory");
        }
    }
    __syncthreads();
}

struct Args { const float* in[N_IN]; float* out; unsigned char* ws; int ph_lo, ph_hi, li, pad; };
struct Ctx {
    LAS unsigned char* lds;
    int tid, lane, wave, G, bid;
    const float* const* in; float* out; unsigned char* ws;
};
__device__ const unsigned char T5_BUCKET[128] = {0, 1, 2, 3, 4, 5, 6, 7, 8, 9, 10, 11, 12, 13, 14, 15, 16, 16, 16, 17, 17, 18, 18, 18, 19, 19, 19, 20, 20, 20, 20, 21, 21, 21, 21, 22, 22, 22, 22, 22, 23, 23, 23, 23, 23, 23, 24, 24, 24, 24, 24, 24, 25, 25, 25, 25, 25, 25, 25, 26, 26, 26, 26, 26, 26, 26, 26, 27, 27, 27, 27, 27, 27, 27, 27, 27, 27, 28, 28, 28, 28, 28, 28, 28, 28, 28, 28, 29, 29, 29, 29, 29, 29, 29, 29, 29, 29, 29, 29, 30, 30, 30, 30, 30, 30, 30, 30, 30, 30, 30, 30, 30, 30, 31, 31, 31, 31, 31, 31, 31, 31, 31, 31, 31, 31, 31, 31, 31};

struct TItem { const float* src; bf16* dst; int N, K, nvalid; };
constexpr int CV_NITEMS = 32 * 86 * 3 + 32 * 32 + 86 * 32;
__device__ __forceinline__ TItem titem_decode(Ctx& C, int l, int it) {
    constexpr int I_IN = 32 * 86, I_OUT = 32 * 32, I_G = 32 * 86;
    TItem t; int r = it, kb, nb;
    if (r < I_IN) { kb = r / 86; nb = r % 86; t.N = DIN; t.K = DM; t.src = C.in[I_W_IN] + (size_t)l * DM * DIN; t.dst = (bf16*)(C.ws + WS_WIN) + (size_t)(128 * nb) * DM; }
    else if ((r -= I_IN) < I_OUT) { kb = r / 32; nb = r % 32; t.N = DM; t.K = DM; t.src = C.in[I_W_OUT] + (size_t)l * DM * DM; t.dst = (bf16*)(C.ws + WS_WOUT) + (size_t)(128 * nb) * DM; }
    else if ((r -= I_OUT) < I_G) { kb = r / 86; nb = r % 86; t.N = DFF; t.K = DM; t.src = C.in[I_W_GATE] + (size_t)l * DM * DFF; t.dst = (bf16*)(C.ws + WS_WGU) + (size_t)(256 * nb) * DM; }
    else if ((r -= I_G) < I_G) { kb = r / 86; nb = r % 86; t.N = DFF; t.K = DM; t.src = C.in[I_W_UP] + (size_t)l * DM * DFF; t.dst = (bf16*)(C.ws + WS_WGU) + (size_t)(256 * nb + 128) * DM; }
    else { r -= I_G; kb = r / 32; nb = r % 32; t.N = DM; t.K = DFF; t.src = C.in[I_W_DOWN] + (size_t)l * DFF * DM; t.dst = (bf16*)(C.ws + WS_WDN) + (size_t)(128 * nb) * DFF; }
    t.src += (size_t)(128 * kb) * t.N + 128 * nb; t.dst += 128 * kb;
    const int rem = t.N - 128 * nb; t.nvalid = rem >= 128 ? 128 : (rem > 0 ? rem : 0);
    return t;
}
__device__ __forceinline__ void titem_load(const TItem& t, f32x4 (&v)[8], int wave, int lane) {
    const bool nv = 4 * (lane & 31) < t.nvalid; const float* p = t.src + (size_t)(16 * wave + 2 * (lane >> 5)) * t.N + 4 * (lane & 31);
#pragma unroll
    for (int i = 0; i < 4; ++i) { v[2 * i] = nv ? *(const GAS f32x4*)(p + (size_t)(4 * i) * t.N) : (f32x4){0.f, 0.f, 0.f, 0.f}; v[2 * i + 1] = nv ? *(const GAS f32x4*)(p + (size_t)(4 * i + 1) * t.N) : (f32x4){0.f, 0.f, 0.f, 0.f}; }
}
__device__ __forceinline__ void titem_store(const TItem& t, const f32x4 (&v)[8], LAS unsigned* T, int tid, int wave, int lane) {
    __syncthreads();
    { const int kd = 8 * wave + (lane >> 5);
#pragma unroll
      for (int i = 0; i < 4; ++i)
#pragma unroll
          for (int e = 0; e < 4; ++e) T[(4 * (lane & 31) + e) * 65 + ((kd + 2 * i) ^ ((lane & 31) >> 3))] = pg8::cvt_pk_bf16(v[2 * i][e], v[2 * i + 1][e]); }
    __syncthreads();
    const int ch = tid & 15;
#pragma unroll
    for (int ps = 0; ps < 4; ++ps) { const int n = 32 * ps + (tid >> 4); const LAS unsigned* s = T + n * 65 + 4 * ch;
        v4u o; o.x = s[0 ^ ps]; o.y = s[1 ^ ps]; o.z = s[2 ^ ps]; o.w = s[3 ^ ps];
        *(GAS v4u*)(t.dst + (size_t)n * t.K + 8 * ch) = o; }
}
__device__ __forceinline__ void convert_weights(Ctx& C, int l) {
    LAS unsigned* T = (LAS unsigned*)C.lds;
    int it = C.bid; if (it >= CV_NITEMS) return;
    TItem cur = titem_decode(C, l, it); f32x4 va[8], vb[8];
    titem_load(cur, va, C.wave, C.lane);
    for (;;) {
        int nx = it + C.G; TItem tn = cur; const bool hn = nx < CV_NITEMS;
        if (hn) { tn = titem_decode(C, l, nx); titem_load(tn, vb, C.wave, C.lane); }
        titem_store(cur, va, T, C.tid, C.wave, C.lane);
        if (!hn) break;
        nx += C.G; const bool hn2 = nx < CV_NITEMS; TItem t2 = tn;
        if (hn2) { t2 = titem_decode(C, l, nx); titem_load(t2, va, C.wave, C.lane); }
        titem_store(tn, vb, T, C.tid, C.wave, C.lane);
        if (!hn2) break;
        cur = t2; it = nx;
    }
    __syncthreads();
}
__device__ __forceinline__ float row_ssq(const f32x4 (&v)[16]) { float ss = 0.f;
#pragma unroll
    for (int j = 0; j < 16; ++j) ss += (v[j].x * v[j].x + v[j].y * v[j].y) + (v[j].z * v[j].z + v[j].w * v[j].w);
    return ss; }
__device__ __forceinline__ void rmsnorm_phase(Ctx& C, const float* X, const float* w, bf16* H) {
    const int gw = C.bid * NWAVES + C.wave, NGW = C.G * NWAVES, lane = C.lane;
    const GAS f32x4* wr = (const GAS f32x4*)w + lane;
    for (int m = gw; m < M; m += 2 * NGW) {
        const int m2 = m + NGW; const bool h2 = m2 < M;
        const GAS f32x4* x0 = (const GAS f32x4*)(X + (size_t)m * DM) + lane; const GAS f32x4* x1 = (const GAS f32x4*)(X + (size_t)(h2 ? m2 : m) * DM) + lane;
        f32x4 v0[16], v1[16];
#pragma unroll
        for (int j = 0; j < 16; ++j) v0[j] = x0[64 * j];
#pragma unroll
        for (int j = 0; j < 16; ++j) v1[j] = x1[64 * j];
        const float r0 = 1.f / sqrtf(wave_sum(row_ssq(v0)) * (1.f / DM) + EPS), r1 = 1.f / sqrtf(wave_sum(row_ssq(v1)) * (1.f / DM) + EPS);
        GAS v2u* o0 = (GAS v2u*)(H + (size_t)m * DM) + lane; GAS v2u* o1 = (GAS v2u*)(H + (size_t)m2 * DM) + lane;
#pragma unroll
        for (int j = 0; j < 16; ++j) { const f32x4 g = wr[64 * j]; v2u o; o.x = pk2(v0[j].x * r0 * g.x, v0[j].y * r0 * g.y); o.y = pk2(v0[j].z * r0 * g.z, v0[j].w * r0 * g.w); o0[64 * j] = o;
            if (h2) { v2u p; p.x = pk2(v1[j].x * r1 * g.x, v1[j].y * r1 * g.y); p.y = pk2(v1[j].z * r1 * g.z, v1[j].w * r1 * g.w); o1[64 * j] = p; } }
    }
}
__device__ __forceinline__ void final_norm_phase(Ctx& C, float* X, const float* w) {
    const int gw = C.bid * NWAVES + C.wave, NGW = C.G * NWAVES, lane = C.lane;
    const GAS f32x4* wr = (const GAS f32x4*)w + lane;
    for (int m = gw; m < M; m += 2 * NGW) {
        const int m2 = m + NGW; const bool h2 = m2 < M;
        GAS f32x4* x0 = (GAS f32x4*)(X + (size_t)m * DM) + lane; GAS f32x4* x1 = (GAS f32x4*)(X + (size_t)(h2 ? m2 : m) * DM) + lane;
        f32x4 v0[16], v1[16];
#pragma unroll
        for (int j = 0; j < 16; ++j) v0[j] = x0[64 * j];
#pragma unroll
        for (int j = 0; j < 16; ++j) v1[j] = x1[64 * j];
        const float r0 = 1.f / sqrtf(wave_sum(row_ssq(v0)) * (1.f / DM) + EPS), r1 = 1.f / sqrtf(wave_sum(row_ssq(v1)) * (1.f / DM) + EPS);
#pragma unroll
        for (int j = 0; j < 16; ++j) { const f32x4 g = wr[64 * j]; x0[64 * j] = v0[j] * r0 * g; if (h2) x1[64 * j] = v1[j] * r1 * g; }
    }
}

typedef short bf16x8 __attribute__((ext_vector_type(8)));
typedef short s16x4 __attribute__((ext_vector_type(4)));
__device__ __forceinline__ f32x4 mfma16(bf16x8 a, bf16x8 b, f32x4 c) { return __builtin_amdgcn_mfma_f32_16x16x32_bf16(a, b, c, 0, 0, 0); }
__device__ __forceinline__ bf16x8 pack8(f32x4 lo, f32x4 hi) { v4u w; w.x = pg8::cvt_pk_bf16(lo.x, lo.y); w.y = pg8::cvt_pk_bf16(lo.z, lo.w); w.z = pg8::cvt_pk_bf16(hi.x, hi.y); w.w = pg8::cvt_pk_bf16(hi.z, hi.w); return __builtin_bit_cast(bf16x8, w); }
__device__ __forceinline__ bf16x8 gfrag(const bf16* Mx, size_t ld, int row0, int k0, int lane) { return *(const GAS bf16x8*)(Mx + (size_t)(row0 + (lane & 15)) * ld + k0 + 8 * (lane >> 4)); }
__device__ __forceinline__ bf16x8 trfrag(const LAS unsigned char* img, int stride, int r0, int r1, int col0, int lane) {
    const int q = (lane & 15) >> 2, p = lane & 3;
    const s16x4 a = __builtin_amdgcn_ds_read_tr16_b64_v4i16((LAS s16x4*)(img + (r0 + q) * stride + (col0 + 4 * p) * 2));
    const s16x4 b = __builtin_amdgcn_ds_read_tr16_b64_v4i16((LAS s16x4*)(img + (r1 + q) * stride + (col0 + 4 * p) * 2));
    return __builtin_shufflevector(a, b, 0, 1, 2, 3, 4, 5, 6, 7);
}
__device__ __forceinline__ float xsum4(float v) { v += __shfl_xor(v, 16); v += __shfl_xor(v, 32); return v; }
__device__ __forceinline__ float xmax4(float v) { v = fmaxf(v, __shfl_xor(v, 16)); v = fmaxf(v, __shfl_xor(v, 32)); return v; }

constexpr int SWA_VSTRIDE = 144;
constexpr int SWA_V_BYTES = 192 * SWA_VSTRIDE;
__device__ __forceinline__ void swa_unit_mfma(Ctx& C, int l, int unit) {
    const int b = unit >> 7, qb = unit & 127, q0 = qb * 64;
    const int tid = C.tid, lane = C.lane, w = C.wave, c = lane & 15, hq = lane >> 4;
    LAS unsigned char* Vimg = C.lds;
    LAS float* tb = (LAS float*)(C.lds + 30720);
    LAS float* ssqx = (LAS float*)(C.lds + 30720 + 12288);
    const bf16* PROJ = (const bf16*)(C.ws + WS_PROJ); float* OSWA = (float*)(C.ws + WS_OSWA); bf16* Y = (bf16*)(C.ws + WS_Y);
    const bf16* Pb = PROJ + (size_t)b * SEQ * DINP;
    __syncthreads();
    for (int i = tid; i < 16 * 192; i += NTHR) { const int hd = i / 192, x = i % 192, dist = x - 32; tb[i] = (dist >= 0 && dist < 128) ? C.in[I_REL_BIAS][T5_BUCKET[dist] * SWA_H + hd] : 0.f; }
    if (tid < 16 * 9) *(LAS v4u*)(Vimg + (192 + tid / 9) * SWA_VSTRIDE + 16 * (tid % 9)) = (v4u){0u, 0u, 0u, 0u};
    const int g = w >> 1, qhalf = w & 1;
    float ssq0 = 0.f, ssq1 = 0.f;
    for (int kvh = 0; kvh < 4; ++kvh) {
        const int head = kvh * 4 + g;
        __syncthreads();
#pragma unroll
        for (int it = 0; it < 3; ++it) { const int idx = tid + NTHR * it, j = idx >> 3, cg = idx & 7; int s = q0 - 128 + j; s = s < 0 ? 0 : s;
            const v4u v = *(const GAS v4u*)(Pb + (size_t)s * DINP + C_SV + kvh * 64 + 8 * cg); *(LAS v4u*)(Vimg + j * SWA_VSTRIDE + 16 * cg) = v; }
        __syncthreads();
        const float sink = C.in[I_SWA_SINKS][l * SWA_H + head];
#pragma nounroll
        for (int qt = 0; qt < 2; ++qt) {
            const int j0 = 32 * qhalf + 16 * qt;
            const bf16x8 qf0 = gfrag(Pb + C_SQ + head * 64, DINP, q0 + j0, 0, lane), qf1 = gfrag(Pb + C_SQ + head * 64, DINP, q0 + j0, 32, lane);
            f32x4 sacc[10];
#pragma unroll
            for (int kt = 0; kt < 10; ++kt) {
                int srow = q0 - 128 + j0 + 16 * kt + c; srow = srow < 0 ? 0 : srow; srow = srow > q0 + 63 ? q0 + 63 : srow;
                const bf16* kp = Pb + (size_t)srow * DINP + C_SK + kvh * 64 + 8 * hq;
                const bf16x8 k0 = *(const GAS bf16x8*)kp, k1 = *(const GAS bf16x8*)(kp + 32);
                f32x4 a = (f32x4){0.f, 0.f, 0.f, 0.f}; a = mfma16(k0, qf0, a); a = mfma16(k1, qf1, a); sacc[kt] = a;
            }
            float mx = sink;
#pragma unroll
            for (int kt = 0; kt < 10; ++kt)
#pragma unroll
                for (int r = 0; r < 4; ++r) { const int dist = c + 128 - 16 * kt - 4 * hq - r; const int s = q0 - 128 + j0 + 16 * kt + 4 * hq + r;
                    const bool valid = (dist >= 0) && (dist < 128) && (s >= 0);
                    const float sc = valid ? sacc[kt][r] * 0.125f + tb[head * 192 + dist + 32] : -1e30f;
                    sacc[kt][r] = sc; mx = fmaxf(mx, sc); }
            mx = xmax4(mx); float sum = 0.f;
#pragma unroll
            for (int kt = 0; kt < 10; ++kt)
#pragma unroll
                for (int r = 0; r < 4; ++r) { const float p = __expf(sacc[kt][r] - mx); sacc[kt][r] = p; sum += p; }
            sum = xsum4(sum); const float inv = 1.f / (sum + __expf(sink - mx));
            f32x4 oacc[4];
#pragma unroll
            for (int dt = 0; dt < 4; ++dt) oacc[dt] = (f32x4){0.f, 0.f, 0.f, 0.f};
#pragma unroll
            for (int ks = 0; ks < 5; ++ks) { const bf16x8 pf = pack8(sacc[2 * ks], sacc[2 * ks + 1]);
#pragma unroll
                for (int dt = 0; dt < 4; ++dt) oacc[dt] = mfma16(trfrag(Vimg, SWA_VSTRIDE, j0 + 32 * ks + 4 * hq, j0 + 32 * ks + 16 + 4 * hq, 16 * dt, lane), pf, oacc[dt]); }
            float sq = 0.f; float* op = OSWA + (size_t)(b * SEQ + q0 + j0 + c) * SWA_W + head * 64 + 4 * hq;
#pragma unroll
            for (int dt = 0; dt < 4; ++dt) { const f32x4 o = oacc[dt] * inv; sq += (o.x * o.x + o.y * o.y) + (o.z * o.z + o.w * o.w); *(GAS f32x4*)(op + 16 * dt) = o; }
            if (qt == 0) ssq0 += sq; else ssq1 += sq;
        }
    }
    ssq0 = xsum4(ssq0); ssq1 = xsum4(ssq1);
    if (hq == 0) { ssqx[w * 32 + c] = ssq0; ssqx[w * 32 + 16 + c] = ssq1; }
    asm volatile("s_waitcnt vmcnt(0)" ::: "memory");
    __syncthreads();
    const float* swa_norm = C.in[I_SWA_NORM] + (size_t)l * SWA_W;
#pragma nounroll
    for (int qt = 0; qt < 2; ++qt) { const int qi = 16 * qt + c;
        const float tot = ssqx[(qhalf + 0) * 32 + qi] + ssqx[(qhalf + 2) * 32 + qi] + ssqx[(qhalf + 4) * 32 + qi] + ssqx[(qhalf + 6) * 32 + qi];
        const float rstd = 1.f / sqrtf(tot * (1.f / 1024.f) + EPS);
        const size_t row = (size_t)(b * SEQ + q0 + 32 * qhalf + qi);
#pragma unroll
        for (int kvh = 0; kvh < 4; ++kvh)
#pragma unroll
            for (int dt = 0; dt < 4; ++dt) { const int col = (kvh * 4 + g) * 64 + 16 * dt + 4 * hq; const f32x4 o = *(const GAS f32x4*)(OSWA + row * SWA_W + col); const f32x4 gn = *(const GAS f32x4*)(swa_norm + col);
                v2u ow; ow.x = pk2(o.x * rstd * gn.x, o.y * rstd * gn.y); ow.y = pk2(o.z * rstd * gn.z, o.w * rstd * gn.w); *(GAS v2u*)(Y + row * DM + 2048 + col) = ow; } }
}

constexpr int N_SWA_UNITS = BATCH * (SEQ / 64);

constexpr int SSD_L = 128, SSD_NC = SEQ / SSD_L, GLA_L = 64, GLA_NC = SEQ / GLA_L;
constexpr int N_SSD_CU = BATCH * SSD_NC * 8, N_GLA_CU = BATCH * GLA_NC * 4;
constexpr int XI_STRIDE = 528, BI_STRIDE = 272;

__device__ __forceinline__ void prep_phase(Ctx& C, int l) {
    const bf16* PROJ = (const bf16*)(C.ws + WS_PROJ); bf16* XBC = (bf16*)(C.ws + WS_XBC);
    const int tid = C.tid, lane = C.lane;
    { const int gw0 = C.bid * NWAVES + C.wave;
      for (int gw = gw0; gw < BATCH * SSD_NC * 16; gw += C.G * NWAVES) if ((gw & 15) == 0 && lane < SSD_H) {
          const int bc = gw >> 4; const size_t row0 = (size_t)bc * SSD_L;
          float* DT = (float*)(C.ws + WS_DT); float* ACS = (float*)(C.ws + WS_ACS); float* DEC = (float*)(C.ws + WS_DEC);
          const float dtb = C.in[I_SSD_DT_BIAS][l * SSD_H + lane], Ah = -expf(C.in[I_SSD_A_LOG][l * SSD_H + lane]);
          float cs = 0.f;
#pragma unroll 8
          for (int s = 0; s < SSD_L; ++s) { const float xr = bf1(PROJ[(row0 + s) * DINP + C_DT + lane]) + dtb; const float dt = xr > 20.f ? xr : log1pf(expf(xr)); cs += dt * Ah;
              DT[(row0 + s) * SSD_H + lane] = dt; ACS[(row0 + s) * SSD_H + lane] = cs; }
          DEC[bc * SSD_H + lane] = expf(cs);
      } }
    { const float* conv_w = C.in[I_SSD_CONV_W] + (size_t)l * 4 * SSD_CD; const float* conv_b = C.in[I_SSD_CONV_B] + (size_t)l * SSD_CD;
      const float* HT = (const float*)(C.ws + WS_XHT); const float* HB = (const float*)(C.ws + WS_XHB);
      constexpr int NIT = (M / 64) * 3 * 1024;
      for (int it = C.bid * NTHR + tid; it < NIT; it += C.G * NTHR) {
          const int c4 = it & 1023, ri = it >> 10, i = ri % 3, blk = ri / 3, c0 = 4 * c4; const bool first = (blk % (SEQ / 64)) == 0;
          f32x4 sq[6]; const f32x4 z4 = (f32x4){0.f, 0.f, 0.f, 0.f};
#pragma unroll
          for (int j = 0; j < 3; ++j) { sq[j] = first ? z4 : *(const GAS f32x4*)(HB + ((size_t)(blk - 1) * 3 + j) * 4096 + c0); sq[3 + j] = *(const GAS f32x4*)(HT + ((size_t)blk * 3 + j) * 4096 + c0); }
          const f32x4 x3 = i == 0 ? sq[0] : (i == 1 ? sq[1] : sq[2]), x2 = i == 0 ? sq[1] : (i == 1 ? sq[2] : sq[3]), x1 = i == 0 ? sq[2] : (i == 1 ? sq[3] : sq[4]), x0 = i == 0 ? sq[3] : (i == 1 ? sq[4] : sq[5]);
          const f32x4 w0 = *(const GAS f32x4*)(conv_w + c0), w1 = *(const GAS f32x4*)(conv_w + 4096 + c0), w2 = *(const GAS f32x4*)(conv_w + 2 * 4096 + c0), w3 = *(const GAS f32x4*)(conv_w + 3 * 4096 + c0), bb = *(const GAS f32x4*)(conv_b + c0);
          f32x4 o;
#pragma unroll
          for (int e = 0; e < 4; ++e) o[e] = silu_f(bb[e] + w0[e] * x3[e] + w1[e] * x2[e] + w2[e] * x1[e] + w3[e] * x0[e]);
          v2u ow; ow.x = pk2(o.x, o.y); ow.y = pk2(o.z, o.w); *(GAS v2u*)(XBC + (size_t)(64 * blk + i) * SSD_CD + c0) = ow;
      } }
    { LAS float* glr = (LAS float*)C.lds;
      bf16* QD = (bf16*)(C.ws + WS_QD); bf16* KI = (bf16*)(C.ws + WS_KI); float* GDEC = (float*)(C.ws + WS_GDEC);
      const float* w_gate = C.in[I_GLA_W_GATE] + (size_t)l * 16 * GLA_KT; const float bgv = C.in[I_GLA_B_GATE][l * GLA_KT + tid];
      float wg[16];
#pragma unroll
      for (int r = 0; r < 16; ++r) wg[r] = w_gate[r * GLA_KT + tid];
      for (int ck = C.bid; ck < BATCH * GLA_NC; ck += C.G) {
          const size_t row0 = (size_t)ck * GLA_L;
          __syncthreads();
          if (tid < 128) { const int t = tid >> 1, hf = tid & 1; const v4u r = *(const GAS v4u*)(PROJ + (row0 + t) * DINP + C_GLR + 8 * hf);
              *(LAS f32x4*)(glr + t * 16 + 8 * hf) = (f32x4){bflo(r.x), bfhi(r.x), bflo(r.y), bfhi(r.y)}; *(LAS f32x4*)(glr + t * 16 + 8 * hf + 4) = (f32x4){bflo(r.z), bfhi(r.z), bflo(r.w), bfhi(r.w)}; }
          __syncthreads();
          float cum = 0.f;
#pragma unroll 8
          for (int t = 0; t < GLA_L; ++t) {
              const float qv = bf1(PROJ[(row0 + t) * DINP + C_GQ + tid]), kv = bf1(PROJ[(row0 + t) * DINP + C_GK + tid]);
              float z = bgv;
#pragma unroll
              for (int r4 = 0; r4 < 4; ++r4) { const f32x4 gv = *(const LAS f32x4*)(glr + t * 16 + 4 * r4); z += gv.x * wg[4 * r4] + gv.y * wg[4 * r4 + 1] + gv.z * wg[4 * r4 + 2] + gv.w * wg[4 * r4 + 3]; }
              const float ls = fminf(z, 0.f) - __logf(1.f + __expf(-fabsf(z))); cum += ls * 0.0625f;
              QD[(row0 + t) * GLA_KT + tid] = (bf16)f2bf(qv * 0.08838834764831845f * __expf(cum)); KI[(row0 + t) * GLA_KT + tid] = (bf16)f2bf(kv * __expf(-cum));
          }
          GDEC[(size_t)ck * GLA_KT + tid] = __expf(cum);
      } }
}

__device__ __forceinline__ void gla_c1_unit(Ctx& C, int unit) {
    const int h = unit & 3, ck = unit >> 2; const size_t row0 = (size_t)ck * GLA_L;
    const int tid = C.tid, lane = C.lane, w = C.wave, c = lane & 15, hq = lane >> 4;
    LAS unsigned char* KEimg = C.lds; LAS unsigned char* Vimg = C.lds + 64 * BI_STRIDE;
    const bf16* PROJ = (const bf16*)(C.ws + WS_PROJ); const bf16* KI = (const bf16*)(C.ws + WS_KI); const float* GDEC = (const float*)(C.ws + WS_GDEC); bf16* GST = (bf16*)(C.ws + WS_GST);
    __syncthreads();
    { const int cg = tid & 15; const f32x4 d0 = *(const GAS f32x4*)(GDEC + (size_t)ck * GLA_KT + h * 128 + 8 * cg), d1 = *(const GAS f32x4*)(GDEC + (size_t)ck * GLA_KT + h * 128 + 8 * cg + 4);
#pragma unroll
      for (int it = 0; it < 2; ++it) { const int t = (tid + NTHR * it) >> 4; const v4u r = *(const GAS v4u*)(KI + (row0 + t) * GLA_KT + h * 128 + 8 * cg);
          v4u o; o.x = pk2(bflo(r.x) * d0.x, bfhi(r.x) * d0.y); o.y = pk2(bflo(r.y) * d0.z, bfhi(r.y) * d0.w); o.z = pk2(bflo(r.z) * d1.x, bfhi(r.z) * d1.y); o.w = pk2(bflo(r.w) * d1.z, bfhi(r.w) * d1.w);
          *(LAS v4u*)(KEimg + t * BI_STRIDE + 16 * cg) = o; } }
#pragma unroll
    for (int it = 0; it < 4; ++it) { const int idx = tid + NTHR * it, t = idx >> 5, cg = idx & 31; *(LAS v4u*)(Vimg + t * XI_STRIDE + 16 * cg) = *(const GAS v4u*)(PROJ + (row0 + t) * DINP + C_GV + h * 256 + 8 * cg); }
    __syncthreads();
    f32x4 acc[16];
#pragma unroll
    for (int nt = 0; nt < 16; ++nt) acc[nt] = (f32x4){0.f, 0.f, 0.f, 0.f};
#pragma unroll
    for (int ks = 0; ks < 2; ++ks) { const bf16x8 af = trfrag(KEimg, BI_STRIDE, 32 * ks + 8 * hq, 32 * ks + 8 * hq + 4, 16 * w, lane);
#pragma unroll
        for (int nt = 0; nt < 16; ++nt) acc[nt] = mfma16(af, trfrag(Vimg, XI_STRIDE, 32 * ks + 8 * hq, 32 * ks + 8 * hq + 4, 16 * nt, lane), acc[nt]); }
    bf16* gp = GST + (size_t)unit * 32768 + 16 * w + 4 * hq;
#pragma unroll
    for (int nt = 0; nt < 16; ++nt) { v2u o; o.x = pk2(acc[nt].x, acc[nt].y); o.y = pk2(acc[nt].z, acc[nt].w); *(GAS v2u*)(gp + (size_t)(16 * nt + c) * 128) = o; }
}

__device__ __forceinline__ void scan_phase(Ctx& C) {
    const bf16* GST = (const bf16*)(C.ws + WS_GST); bf16* GPV = (bf16*)(C.ws + WS_GPV); const float* GDEC = (const float*)(C.ws + WS_GDEC);
    const bf16* ST = (const bf16*)(C.ws + WS_ST); bf16* PV = (bf16*)(C.ws + WS_PV); const float* DEC = (const float*)(C.ws + WS_DEC);
    constexpr int N_G = BATCH * 4 * 256 * 32, N_S = BATCH * SSD_H * 64 * 32;
    for (int it = C.bid * NTHR + C.tid; it < N_G + N_S; it += C.G * NTHR) {
        if (it < N_S) {
            const int n4 = it & 31, p = (it >> 5) & 63, h = (it >> 11) & 31, b = it >> 16;
            f32x4 run = (f32x4){0.f, 0.f, 0.f, 0.f};
#pragma unroll 8
            for (int c = 0; c < SSD_NC; ++c) { const size_t u = (size_t)(b * SSD_NC + c) * SSD_H + h; const size_t off = u * 8192 + p * 128 + 4 * n4;
                const v2u xr = *(const GAS v2u*)(ST + off); const f32x4 x = (f32x4){bflo(xr.x), bfhi(xr.x), bflo(xr.y), bfhi(xr.y)}; const float d = DEC[u];
                v2u o; o.x = pk2(run.x, run.y); o.y = pk2(run.z, run.w); *(GAS v2u*)(PV + off) = o;
                run = run * d + x; }
        } else {
            const int i2 = it - N_S; const int k4 = i2 & 31, v = (i2 >> 5) & 255, h = (i2 >> 13) & 3, b = i2 >> 15;
            f32x4 run = (f32x4){0.f, 0.f, 0.f, 0.f};
#pragma unroll 8
            for (int c = 0; c < GLA_NC; ++c) { const size_t ck = (size_t)(b * GLA_NC + c); const size_t off = (ck * 4 + h) * 32768 + v * 128 + 4 * k4;
                const v2u xr = *(const GAS v2u*)(GST + off); const f32x4 x = (f32x4){bflo(xr.x), bfhi(xr.x), bflo(xr.y), bfhi(xr.y)}; const f32x4 d = *(const GAS f32x4*)(GDEC + ck * GLA_KT + h * 128 + 4 * k4);
                v2u o; o.x = pk2(run.x, run.y); o.y = pk2(run.z, run.w); *(GAS v2u*)(GPV + off) = o;
                run = run * d + x; }
        }
    }
}

constexpr int GC3_GP_OFF = 64 * XI_STRIDE, GC3_XCH_OFF = GC3_GP_OFF + 256 * BI_STRIDE;
__device__ __forceinline__ void gla_c3_unit(Ctx& C, int l, int unit) {
    const int h = unit & 3, ck = unit >> 2; const size_t row0 = (size_t)ck * GLA_L;
    const int tid = C.tid, lane = C.lane, w = C.wave, c = lane & 15, hq = lane >> 4;
    LAS unsigned char* Vimg = C.lds; LAS unsigned char* GPimg = C.lds + GC3_GP_OFF; LAS float* xch = (LAS float*)(C.lds + GC3_XCH_OFF);
    const bf16* PROJ = (const bf16*)(C.ws + WS_PROJ); const bf16* QD = (const bf16*)(C.ws + WS_QD); const bf16* KI = (const bf16*)(C.ws + WS_KI); const bf16* GPV = (const bf16*)(C.ws + WS_GPV); bf16* Y = (bf16*)(C.ws + WS_Y);
    const int lt = w >> 1, vh = w & 1; const size_t row = row0 + 16 * lt + c;
    __syncthreads();
    { const bf16* gpv = GPV + (size_t)unit * 32768;
      v4u tv[4], tg[8];
#pragma unroll
      for (int it = 0; it < 4; ++it) { const int idx = tid + NTHR * it, t = idx >> 5, cg = idx & 31; tv[it] = *(const GAS v4u*)(PROJ + (row0 + t) * DINP + C_GV + h * 256 + 8 * cg); }
#pragma unroll
      for (int it = 0; it < 8; ++it) { const int idx = tid + NTHR * it; tg[it] = *(const GAS v4u*)(gpv + (size_t)idx * 8); }
#pragma unroll
      for (int it = 0; it < 4; ++it) { const int idx = tid + NTHR * it, t = idx >> 5, cg = idx & 31; *(LAS v4u*)(Vimg + t * XI_STRIDE + 16 * cg) = tv[it]; }
#pragma unroll
      for (int it = 0; it < 8; ++it) { const int idx = tid + NTHR * it, v = idx >> 4, cg = idx & 15; *(LAS v4u*)(GPimg + v * BI_STRIDE + 16 * cg) = tg[it]; } }
    bf16x8 qf[4];
#pragma unroll
    for (int ks = 0; ks < 4; ++ks) qf[ks] = gfrag(QD + row0 * GLA_KT + h * 128, GLA_KT, 16 * lt, 32 * ks, lane);
    v2u ggv[8];
#pragma unroll
    for (int vt = 0; vt < 8; ++vt) ggv[vt] = *(const GAS v2u*)(PROJ + row * DINP + C_GG + h * 256 + 16 * (8 * vh + vt) + 4 * hq);
    f32x4 att[4];
#pragma unroll
    for (int st = 0; st < 4; ++st) { f32x4 a = (f32x4){0.f, 0.f, 0.f, 0.f};
        if (st <= lt) {
#pragma unroll
            for (int ks = 0; ks < 4; ++ks) a = mfma16(gfrag(KI + row0 * GLA_KT + h * 128, GLA_KT, 16 * st, 32 * ks, lane), qf[ks], a);
#pragma unroll
            for (int r = 0; r < 4; ++r) if (16 * st + 4 * hq + r > 16 * lt + c) a[r] = 0.f;
        }
        att[st] = a; }
    __syncthreads();
    f32x4 oacc[8];
#pragma unroll
    for (int vt = 0; vt < 8; ++vt) oacc[vt] = (f32x4){0.f, 0.f, 0.f, 0.f};
#pragma unroll
    for (int ks = 0; ks < 4; ++ks)
#pragma unroll
        for (int vt = 0; vt < 8; ++vt) oacc[vt] = mfma16(*(const LAS bf16x8*)(GPimg + (16 * (8 * vh + vt) + c) * BI_STRIDE + (32 * ks + 8 * hq) * 2), qf[ks], oacc[vt]);
#pragma unroll
    for (int ks2 = 0; ks2 < 2; ++ks2) { const bf16x8 pf = pack8(att[2 * ks2], att[2 * ks2 + 1]);
#pragma unroll
        for (int vt = 0; vt < 8; ++vt) oacc[vt] = mfma16(trfrag(Vimg, XI_STRIDE, 32 * ks2 + 4 * hq, 32 * ks2 + 16 + 4 * hq, 16 * (8 * vh + vt), lane), pf, oacc[vt]); }
    float ssq = 0.f;
#pragma unroll
    for (int vt = 0; vt < 8; ++vt) ssq += (oacc[vt].x * oacc[vt].x + oacc[vt].y * oacc[vt].y) + (oacc[vt].z * oacc[vt].z + oacc[vt].w * oacc[vt].w);
    ssq = xsum4(ssq);
    if (hq == 0) xch[w * 16 + c] = ssq;
    __syncthreads();
    const float rstd = 1.f / sqrtf((xch[w * 16 + c] + xch[(w ^ 1) * 16 + c]) * (1.f / 256.f) + EPS);
    const float* gla_norm = C.in[I_GLA_NORM] + (size_t)l * 256;
#pragma unroll
    for (int vt = 0; vt < 8; ++vt) { const int v0 = 16 * (8 * vh + vt) + 4 * hq; const f32x4 gn = *(const GAS f32x4*)(gla_norm + v0); const v2u gg = ggv[vt];
        const f32x4 o = oacc[vt]; v2u ow; ow.x = pk2(o.x * rstd * gn.x * silu_f(bflo(gg.x)), o.y * rstd * gn.y * silu_f(bfhi(gg.x))); ow.y = pk2(o.z * rstd * gn.z * silu_f(bflo(gg.y)), o.w * rstd * gn.w * silu_f(bfhi(gg.y)));
        *(GAS v2u*)(Y + row * DM + 3072 + h * 256 + v0) = ow; }
}

__device__ __forceinline__ void ssd_c1_unit(Ctx& C, int unit) {
    const int g = unit & 7, bc = unit >> 3; const size_t row0 = (size_t)bc * SSD_L;
    const int tid = C.tid, lane = C.lane, w = C.wave, c = lane & 15, hq = lane >> 4;
    LAS float* acs = (LAS float*)C.lds; LAS float* dts = acs + 512;
    LAS unsigned char* XWimg = C.lds + 4096; LAS unsigned char* Bimg = C.lds + 4096 + 128 * XI_STRIDE;
    const bf16* XBC = (const bf16*)(C.ws + WS_XBC); const float* DT = (const float*)(C.ws + WS_DT); const float* ACS = (const float*)(C.ws + WS_ACS); bf16* ST = (bf16*)(C.ws + WS_ST);
    __syncthreads();
    { const int t = tid >> 2, hh = tid & 3; acs[tid] = ACS[(row0 + t) * SSD_H + 4 * g + hh]; dts[tid] = DT[(row0 + t) * SSD_H + 4 * g + hh]; }
    __syncthreads();
#pragma unroll
    for (int it = 0; it < 8; ++it) { const int idx = tid + NTHR * it, t = idx >> 5, cg = idx & 31, hh = cg >> 3; const float wgt = __expf(acs[127 * 4 + hh] - acs[t * 4 + hh]) * dts[t * 4 + hh];
        const v4u r = *(const GAS v4u*)(XBC + (row0 + t) * SSD_CD + g * 256 + 8 * cg);
        v4u o; o.x = pk2(bflo(r.x) * wgt, bfhi(r.x) * wgt); o.y = pk2(bflo(r.y) * wgt, bfhi(r.y) * wgt); o.z = pk2(bflo(r.z) * wgt, bfhi(r.z) * wgt); o.w = pk2(bflo(r.w) * wgt, bfhi(r.w) * wgt);
        *(LAS v4u*)(XWimg + t * XI_STRIDE + 16 * cg) = o; }
#pragma unroll
    for (int it = 0; it < 4; ++it) { const int idx = tid + NTHR * it, t = idx >> 4, cg = idx & 15; *(LAS v4u*)(Bimg + t * BI_STRIDE + 16 * cg) = *(const GAS v4u*)(XBC + (row0 + t) * SSD_CD + 2048 + g * 128 + 8 * cg); }
    __syncthreads();
    const int hh = w >> 1, ph = w & 1;
    f32x4 acc[8][2];
#pragma unroll
    for (int mt = 0; mt < 8; ++mt) { acc[mt][0] = (f32x4){0.f, 0.f, 0.f, 0.f}; acc[mt][1] = (f32x4){0.f, 0.f, 0.f, 0.f}; }
#pragma unroll
    for (int ks = 0; ks < 4; ++ks) { const int r0 = 32 * ks + 8 * hq;
        const bf16x8 x0 = trfrag(XWimg, XI_STRIDE, r0, r0 + 4, hh * 64 + 32 * ph, lane), x1 = trfrag(XWimg, XI_STRIDE, r0, r0 + 4, hh * 64 + 32 * ph + 16, lane);
#pragma unroll
        for (int mt = 0; mt < 8; ++mt) { const bf16x8 bf = trfrag(Bimg, BI_STRIDE, r0, r0 + 4, 16 * mt, lane); acc[mt][0] = mfma16(bf, x0, acc[mt][0]); acc[mt][1] = mfma16(bf, x1, acc[mt][1]); } }
    bf16* sp = ST + ((size_t)bc * SSD_H + 4 * g + hh) * 8192 + 4 * hq;
#pragma unroll
    for (int mt = 0; mt < 8; ++mt)
#pragma unroll
        for (int pt = 0; pt < 2; ++pt) { v2u o; o.x = pk2(acc[mt][pt].x, acc[mt][pt].y); o.y = pk2(acc[mt][pt].z, acc[mt][pt].w); *(GAS v2u*)(sp + (size_t)(32 * ph + 16 * pt + c) * 128 + 16 * mt) = o; }
}

constexpr int SC3_X_OFF = 4096, SC3_PV_OFF = SC3_X_OFF + 128 * XI_STRIDE, SC3_PV_HEAD = 64 * BI_STRIDE;
static_assert(SC3_PV_OFF + 4 * SC3_PV_HEAD <= MISC_OFF && GC3_XCH_OFF + 512 <= MISC_OFF, "mixer LDS maps");
__device__ __forceinline__ void ssd_c3_unit(Ctx& C, int l, int unit) {
    const int g = unit & 7, bc = unit >> 3; const size_t row0 = (size_t)bc * SSD_L;
    const int tid = C.tid, lane = C.lane, w = C.wave, c = lane & 15, hq = lane >> 4;
    LAS float* acs = (LAS float*)C.lds; LAS float* dts = acs + 512;
    LAS unsigned char* Ximg = C.lds + SC3_X_OFF; LAS unsigned char* PVimg = C.lds + SC3_PV_OFF;
    const bf16* PROJ = (const bf16*)(C.ws + WS_PROJ); const bf16* XBC = (const bf16*)(C.ws + WS_XBC); const float* DT = (const float*)(C.ws + WS_DT); const float* ACS = (const float*)(C.ws + WS_ACS);
    const bf16* PV = (const bf16*)(C.ws + WS_PV); bf16* Y = (bf16*)(C.ws + WS_Y);
    const int tl = 16 * w + c; const size_t row = row0 + tl;
    __syncthreads();
    { const int t = tid >> 2, hh = tid & 3; const float a0 = ACS[(row0 + t) * SSD_H + 4 * g + hh], d0 = DT[(row0 + t) * SSD_H + 4 * g + hh];
      const bf16* pvb = PV + ((size_t)bc * SSD_H + 4 * g) * 8192;
      v4u tx[8], tp[8];
#pragma unroll
      for (int it = 0; it < 8; ++it) { const int idx = tid + NTHR * it, t2 = idx >> 5, cg = idx & 31; tx[it] = *(const GAS v4u*)(XBC + (row0 + t2) * SSD_CD + g * 256 + 8 * cg); }
#pragma unroll
      for (int it = 0; it < 8; ++it) { const int idx = tid + NTHR * it; tp[it] = *(const GAS v4u*)(pvb + (size_t)idx * 8); }
      acs[tid] = a0; dts[tid] = d0;
#pragma unroll
      for (int it = 0; it < 8; ++it) { const int idx = tid + NTHR * it, t2 = idx >> 5, cg = idx & 31; *(LAS v4u*)(Ximg + t2 * XI_STRIDE + 16 * cg) = tx[it]; }
#pragma unroll
      for (int it = 0; it < 8; ++it) { const int idx = tid + NTHR * it, pr = idx >> 4, cg = idx & 15; *(LAS v4u*)(PVimg + pr * BI_STRIDE + 16 * cg) = tp[it]; } }
    bf16x8 cf[4];
#pragma unroll
    for (int ks = 0; ks < 4; ++ks) cf[ks] = gfrag(XBC + row0 * SSD_CD + 3072 + g * 128, SSD_CD, 16 * w, 32 * ks, lane);
    f32x4 cb[8];
#pragma unroll
    for (int st = 0; st < 8; ++st) { f32x4 a = (f32x4){0.f, 0.f, 0.f, 0.f};
        if (st <= w) {
#pragma unroll
            for (int ks = 0; ks < 4; ++ks) a = mfma16(gfrag(XBC + row0 * SSD_CD + 2048 + g * 128, SSD_CD, 16 * st, 32 * ks, lane), cf[ks], a);
        }
        cb[st] = a; }
    __syncthreads();
    float* YT = (float*)(C.ws + WS_ST) + row * SSD_W + g * 256;
    float ssq = 0.f;
#pragma nounroll
    for (int hh = 0; hh < 4; ++hh) {
        v2u zz[4];
#pragma unroll
        for (int pt = 0; pt < 4; ++pt) zz[pt] = *(const GAS v2u*)(PROJ + row * DINP + C_Z + g * 256 + hh * 64 + 16 * pt + 4 * hq);
        const float acs_l = acs[tl * 4 + hh], el = __expf(acs_l);
        f32x4 ya[4];
#pragma unroll
        for (int pt = 0; pt < 4; ++pt) ya[pt] = (f32x4){0.f, 0.f, 0.f, 0.f};
#pragma unroll
        for (int ks = 0; ks < 4; ++ks)
#pragma unroll
            for (int pt = 0; pt < 4; ++pt) ya[pt] = mfma16(*(const LAS bf16x8*)(PVimg + (hh * 64 + 16 * pt + c) * BI_STRIDE + (32 * ks + 8 * hq) * 2), cf[ks], ya[pt]);
#pragma unroll
        for (int pt = 0; pt < 4; ++pt) ya[pt] = ya[pt] * el;
#pragma unroll
        for (int ks2 = 0; ks2 < 4; ++ks2) {
            if (2 * ks2 <= w) {
                f32x4 lm[2];
#pragma unroll
                for (int t2 = 0; t2 < 2; ++t2)
#pragma unroll
                    for (int r = 0; r < 4; ++r) { const int s = 32 * ks2 + 16 * t2 + 4 * hq + r; const float d = fminf(acs_l - acs[s * 4 + hh], 0.f);
                        lm[t2][r] = (s <= tl) ? cb[2 * ks2 + t2][r] * __expf(d) * dts[s * 4 + hh] : 0.f; }
                const bf16x8 pf = pack8(lm[0], lm[1]);
#pragma unroll
                for (int pt = 0; pt < 4; ++pt) ya[pt] = mfma16(trfrag(Ximg, XI_STRIDE, 32 * ks2 + 4 * hq, 32 * ks2 + 16 + 4 * hq, hh * 64 + 16 * pt, lane), pf, ya[pt]);
            }
        }
        const float Dh = C.in[I_SSD_D][l * SSD_H + 4 * g + hh];
#pragma unroll
        for (int pt = 0; pt < 4; ++pt) { const int col = hh * 64 + 16 * pt + 4 * hq; const v2u xw = *(const LAS v2u*)(Ximg + tl * XI_STRIDE + col * 2); const v2u z2 = zz[pt];
            f32x4 v; v.x = (ya[pt].x + Dh * bflo(xw.x)) * silu_f(bflo(z2.x)); v.y = (ya[pt].y + Dh * bfhi(xw.x)) * silu_f(bfhi(z2.x)); v.z = (ya[pt].z + Dh * bflo(xw.y)) * silu_f(bflo(z2.y)); v.w = (ya[pt].w + Dh * bfhi(xw.y)) * silu_f(bfhi(z2.y));
            *(GAS f32x4*)(YT + col) = v; ssq += (v.x * v.x + v.y * v.y) + (v.z * v.z + v.w * v.w); }
    }
    ssq = xsum4(ssq);
    const float rstd = 1.f / sqrtf(ssq * (1.f / 256.f) + EPS);
    const float* ssd_norm = C.in[I_SSD_NORM] + (size_t)l * SSD_W + g * 256;
    asm volatile("s_waitcnt vmcnt(0)" ::: "memory");
#pragma unroll 4
    for (int i = 0; i < 16; ++i) { const int col = 16 * i + 4 * hq; const f32x4 gn = *(const GAS f32x4*)(ssd_norm + col); const f32x4 v = *(const GAS f32x4*)(YT + col);
        v2u ow; ow.x = pk2(v.x * rstd * gn.x, v.y * rstd * gn.y); ow.y = pk2(v.z * rstd * gn.z, v.w * rstd * gn.w); *(GAS v2u*)(Y + row * DM + g * 256 + col) = ow; }
}

__device__ __forceinline__ void mix_c1_phase(Ctx& C, int l) {
    for (int u = C.bid; u < N_SSD_CU; u += C.G) ssd_c1_unit(C, u);
    for (int u = C.bid; u < N_GLA_CU; u += C.G) gla_c1_unit(C, u);
    for (int u = C.bid; u < N_SWA_UNITS; u += C.G) swa_unit_mfma(C, l, u);
}
__device__ __forceinline__ void mix_c3_phase(Ctx& C, int l) {
    for (int u = C.bid; u < N_SSD_CU; u += C.G) ssd_c3_unit(C, l, u);
    for (int u = C.bid; u < N_GLA_CU; u += C.G) gla_c3_unit(C, l, u);
}

__device__ __forceinline__ void act_fixup_phase(Ctx& C, int l) {
    bf16* ACT = (bf16*)(C.ws + WS_ACT); const float* HTG = (const float*)(C.ws + WS_HTG); const float* HTU = (const float*)(C.ws + WS_HTU); const float* HBG = (const float*)(C.ws + WS_HBG);
    const float* cw = C.in[I_FFN_CONV_W] + (size_t)l * 3 * DFF; const float* cb = C.in[I_FFN_CONV_B] + (size_t)l * DFF;
    constexpr int NC4 = DFF / 4, NIT = (M / 64) * 2 * NC4;
    for (int it = C.bid * NTHR + C.tid; it < NIT; it += C.G * NTHR) {
        const int c4 = it % NC4, ri = it / NC4, i = ri & 1, blk = ri >> 1, c0 = 4 * c4; const bool first = (blk % (SEQ / 64)) == 0;
        const f32x4 z4 = (f32x4){0.f, 0.f, 0.f, 0.f};
        const f32x4 g0 = *(const GAS f32x4*)(HTG + ((size_t)blk * 2 + i) * DFF + c0), up = *(const GAS f32x4*)(HTU + ((size_t)blk * 2 + i) * DFF + c0);
        const f32x4 pb1 = first ? z4 : *(const GAS f32x4*)(HBG + ((size_t)(blk - 1) * 2 + 1) * DFF + c0), pb0 = first ? z4 : *(const GAS f32x4*)(HBG + ((size_t)(blk - 1) * 2 + 0) * DFF + c0);
        const f32x4 g1 = i ? *(const GAS f32x4*)(HTG + ((size_t)blk * 2 + 0) * DFF + c0) : pb1, g2 = i ? pb1 : pb0;
        const f32x4 w0 = *(const GAS f32x4*)(cw + c0), w1 = *(const GAS f32x4*)(cw + DFF + c0), w2 = *(const GAS f32x4*)(cw + 2 * DFF + c0), bb = *(const GAS f32x4*)(cb + c0);
        f32x4 o;
#pragma unroll
        for (int e = 0; e < 4; ++e) { const float gc = bb[e] + w0[e] * g2[e] + w1[e] * g1[e] + w2[e] * g0[e]; o[e] = silu_f(gc) * up[e]; }
        v2u ow; ow.x = pk2(o.x, o.y); ow.y = pk2(o.z, o.w); *(GAS v2u*)(ACT + (size_t)(64 * blk + i) * DFF + c0) = ow;
    }
}

constexpr int PH_PER_LAYER = 11, PH_FINAL = DEPTH * PH_PER_LAYER, N_PHASES = PH_FINAL + 1;
#ifndef WGM_DOWN
#define WGM_DOWN 4
#endif
#ifndef MK_ONE_LAUNCH
#define MK_ONE_LAUNCH 1
#endif
__global__ void __launch_bounds__(NTHR, 2) fwd_kernel(Args args) {
    extern __shared__ __attribute__((aligned(16))) unsigned char lds[];
    Ctx C;
    C.lds = (LAS unsigned char*)lds;
    C.tid = threadIdx.x; C.lane = C.tid & 63; C.wave = __builtin_amdgcn_readfirstlane(C.tid >> 6);
    C.G = gridDim.x; C.bid = blockIdx.x;
    C.in = args.in; C.out = args.out; C.ws = args.ws;
    volatile LAS unsigned* MISC = (volatile LAS unsigned*)(C.lds + MISC_OFF);
    for (int u = C.tid; u < (LDS_BYTES - MISC_OFF) / 4; u += NTHR) ((LAS unsigned*)(C.lds + MISC_OFF))[u] = 0u;
    __syncthreads();
    gu32* ctl = (gu32*)(args.ws + WS_CTL);
    XcdBarrier bar = xcd_barrier_post((unsigned*)(ctl + CW_BAR) + args.li * XCD_BAR_WORDS, MISC + 8);
    const int lo = args.ph_lo, hi = args.ph_hi;
#define IN(k) (lo <= (k) && (k) < hi)
#define SEAM(k) do { if (IN(k) && IN((k) + 1)) xcd_barrier(bar); } while (0)
    float* xres = args.out;
    bf16* H = (bf16*)(args.ws + WS_H);
#define LAYER_BODY(l) do { \
        const int pb = l * PH_PER_LAYER; \
        const float* xin = (l == 0) ? args.in[I_X] : (const float*)xres; \
        if (IN(pb + 0)) { convert_weights(C, l); rmsnorm_phase(C, xin, args.in[I_ATTN_NORM] + (size_t)l * DM, H); } \
        SEAM(pb + 0); \
        if (IN(pb + 1)) { \
            pg8::Gemm g{H, (const bf16*)(args.ws + WS_WIN), M, DINP, DM}; pg8::StaticOrder S; S.init(M, DINP, C.G, C.bid); \
            pg8::EpiProjConv E{(bf16*)(args.ws + WS_PROJ), DINP, (bf16*)(args.ws + WS_XBC), args.in[I_SSD_CONV_W] + (size_t)l * 4 * SSD_CD, args.in[I_SSD_CONV_B] + (size_t)l * SSD_CD, (float*)(args.ws + WS_XHT), (float*)(args.ws + WS_XHB)}; \
            pg8::gemm_phase<pg8::EpiProjConv, pg8::StaticOrder, true, true>(C.lds, g, S, E); \
        } \
        SEAM(pb + 1); \
        if (IN(pb + 2)) prep_phase(C, l); \
        SEAM(pb + 2); \
        if (IN(pb + 3)) mix_c1_phase(C, l); \
        SEAM(pb + 3); \
        if (IN(pb + 4)) scan_phase(C); \
        SEAM(pb + 4); \
        if (IN(pb + 5)) mix_c3_phase(C, l); \
        SEAM(pb + 5); \
        if (IN(pb + 6)) { \
            pg8::Gemm g{(const bf16*)(args.ws + WS_Y), (const bf16*)(args.ws + WS_WOUT), M, DM, DM}; pg8::StaticOrder S; S.init(M, DM, C.G, C.bid); \
            pg8::EpiRes E{xin, xres, DM}; \
            pg8::gemm_phase<pg8::EpiRes, pg8::StaticOrder, true, true>(C.lds, g, S, E); \
        } \
        SEAM(pb + 6); \
        if (IN(pb + 7)) rmsnorm_phase(C, xres, args.in[I_FFN_NORM] + (size_t)l * DM, H); \
        SEAM(pb + 7); \
        if (IN(pb + 8)) { \
            pg8::Gemm g{H, (const bf16*)(args.ws + WS_WGU), M, DGU, DM}; pg8::StaticOrder S; S.init(M, DGU, C.G, C.bid); \
            pg8::EpiGateUp E{(bf16*)(args.ws + WS_ACT), args.in[I_FFN_CONV_W] + (size_t)l * 3 * DFF, args.in[I_FFN_CONV_B] + (size_t)l * DFF, (float*)(args.ws + WS_HTG), (float*)(args.ws + WS_HTU), (float*)(args.ws + WS_HBG), DFF}; \
            pg8::gemm_phase<pg8::EpiGateUp, pg8::StaticOrder, true, true>(C.lds, g, S, E); \
        } \
        SEAM(pb + 8); \
        if (IN(pb + 9)) act_fixup_phase(C, l); \
        SEAM(pb + 9); \
        if (IN(pb + 10)) { \
            pg8::Gemm g{(const bf16*)(args.ws + WS_ACT), (const bf16*)(args.ws + WS_WDN), M, DM, DFF}; pg8::StaticOrder S; S.init(M, DM, C.G, C.bid, WGM_DOWN); \
            pg8::EpiRes E{xres, xres, DM}; \
            pg8::gemm_phase<pg8::EpiRes, pg8::StaticOrder, true, true>(C.lds, g, S, E); \
        } \
        SEAM(pb + 10); \
     \
    } while (0)
    LAYER_BODY(0);
    LAYER_BODY(1);
#undef LAYER_BODY
    if (IN(PH_FINAL)) final_norm_phase(C, xres, args.in[I_FINAL_NORM]);
#undef IN
#undef SEAM
}

extern "C" void kernel_launch(void* const* d_in, const int* in_sizes, int n_in, void* d_out, int out_size, void* d_ws, size_t ws_size, hipStream_t stream) {
    static int grid = 0;
    if (grid == 0) {
        if (n_in != N_IN || out_size != M * DM || ws_size < WS_END) { fprintf(stderr, "kernel_launch: unexpected shapes (n_in %d, out %d, ws %zu < %zu)\n", n_in, out_size, ws_size, (size_t)WS_END); grid = -1; return; }
        int dev = 0, cus = 0, per_cu = 0;
        if (hipGetDevice(&dev) != hipSuccess || hipDeviceGetAttribute(&cus, hipDeviceAttributeMultiprocessorCount, dev) != hipSuccess) { grid = -1; return; }
        if (hipFuncSetAttribute((const void*)fwd_kernel, hipFuncAttributeMaxDynamicSharedMemorySize, LDS_BYTES) != hipSuccess) { fprintf(stderr, "kernel_launch: hipFuncSetAttribute failed\n"); grid = -1; return; }
        if (hipOccupancyMaxActiveBlocksPerMultiprocessor(&per_cu, (const void*)fwd_kernel, NTHR, LDS_BYTES) != hipSuccess || per_cu < 1) { fprintf(stderr, "kernel_launch: occupancy query says %d\n", per_cu); (void)hipGetLastError(); grid = -1; return; }
        grid = cus;
    }
    if (grid < 0) return;
    if (hipMemsetAsync((char*)d_ws + WS_CTL, 0, CTL_ZERO_BYTES, stream) != hipSuccess) return;
    Args a{};
    for (int i = 0; i < N_IN; ++i) a.in[i] = (const float*)d_in[i];
    a.out = (float*)d_out; a.ws = (unsigned char*)d_ws; a.pad = 0;
#if MK_ONE_LAUNCH
    a.ph_lo = 0; a.ph_hi = N_PHASES; a.li = 0;
    hipLaunchKernelGGL(fwd_kernel, dim3(grid), dim3(NTHR), LDS_BYTES, stream, a);
#else
    for (int p = 0; p < N_PHASES; ++p) { a.ph_lo = p; a.ph_hi = p + 1; a.li = p;
        hipLaunchKernelGGL(fwd_kernel, dim3(grid), dim3(NTHR), LDS_BYTES, stream, a); }
#endif
}
```

```cpp
#include <hip/hip_runtime.h>
#include <cstdio>
#include <cstdint>
namespace pg8 {
#define PG8_LAS __attribute__((address_space(3)))
typedef unsigned short bf16_t;
typedef short bf16x8 __attribute__((ext_vector_type(8)));
typedef float f32x4 __attribute__((ext_vector_type(4)));
typedef unsigned u32x4 __attribute__((ext_vector_type(4)));
constexpr int BM = 256, BK = 64, HALF = 128, HTB = HALF * BK * 2  , STAGE_BYTES = 8 * HTB, NXCD = 8, WGM = 8;

__host__ __device__ __forceinline__ int lds_byte(int r, int c) { const int st = (r >> 4) * 2 + (c >> 5), rr = r & 15, cc = c & 31, ob = rr * 64 + cc * 2; return st * 1024 + (ob ^ (((ob >> 9) & 1) << 5)); }
__host__ __device__ __forceinline__ void stage_rc(int b, int& R, int& C) { const int st = b / 1024, sb = b % 1024, swz = sb ^ (((sb >> 9) & 1) << 5); R = (st >> 1) * 16 + swz / 64; C = (st & 1) * 32 + (swz % 64) / 2; }
__host__ __device__ __forceinline__ int perm32(int rho) { const int n = rho >> 4, i = rho & 15; return 8 * (i >> 2) + 4 * n + (i & 3); }

struct Unit { int pm, pn; };
struct Gemm { const bf16_t* A; const bf16_t* Bt; int M, N, K; };

struct StaticOrder {
    int nM, nN, nwg, G, c, wgm;
    __host__ __device__ void init(int M, int N, int G_, int c_, int wgm_ = WGM) { nM = M / BM; nN = N / BM; nwg = nM * nN; G = G_; c = c_; wgm = wgm_; }
    __host__ __device__ bool next(int i, Unit& u) const {
        const long L = (long)i * G + c; if (L >= nwg) return false;
        int wgid = (int)L; { const int q = nwg / NXCD, r = nwg % NXCD, xcd = wgid % NXCD, off = wgid / NXCD; wgid = (xcd < r ? xcd * (q + 1) : r * (q + 1) + (xcd - r) * q) + off; }
        const int nig = wgm * nN, gid = wgid / nig, fm = gid * wgm, gsz = (nM - fm) < wgm ? (nM - fm) : wgm;
        u.pm = fm + ((wgid % nig) % gsz); u.pn = (wgid % nig) / gsz; return true;
    }
    __device__ __forceinline__ void a_ready(const Unit&) const {}
    __device__ __forceinline__ void done(const Unit&) const {}
};

typedef float f32x2c __attribute__((ext_vector_type(2)));
typedef __bf16 bf16x2c __attribute__((ext_vector_type(2)));
__device__ __forceinline__ unsigned cvt_pk_bf16(float lo, float hi) { const f32x2c v = {lo, hi}; return __builtin_bit_cast(unsigned, __builtin_convertvector(v, bf16x2c)); }

struct EpiBf16 {
    static constexpr bool PERM = true, AFTER_DRAIN = false;
    bf16_t* O; int ldc;
    __device__ __forceinline__ void operator()(const f32x4 (&acc)[2][2][4][2], const Unit& u, int wr, int wc, int fr, int fq) const {
        const int row0 = u.pm * BM + wr * 64 + fr; const int col0 = u.pn * BM + wc * 32 + 8 * fq;
#pragma unroll
        for (int ai = 0; ai < 2; ++ai)
#pragma unroll
            for (int m = 0; m < 4; ++m) { bf16_t* rowp = O + (size_t)(row0 + ai * HALF + m * 16) * ldc + col0;
#pragma unroll
                for (int bj = 0; bj < 2; ++bj) { const f32x4 v0 = acc[ai][bj][m][0], v1 = acc[ai][bj][m][1];
                    u32x4 w; w.x = cvt_pk_bf16(v0[0], v0[1]); w.y = cvt_pk_bf16(v0[2], v0[3]); w.z = cvt_pk_bf16(v1[0], v1[1]); w.w = cvt_pk_bf16(v1[2], v1[3]);
                    *(u32x4*)(rowp + bj * HALF) = w; } }
    }
};
template <int CTRL> __device__ __forceinline__ float dpp_old(float old, float v) { return __int_as_float(__builtin_amdgcn_update_dpp(__float_as_int(old), __float_as_int(v), CTRL, 0xf, 0xf, false)); }
struct EpiGateUp {
    static constexpr bool PERM = true, AFTER_DRAIN = false;
    bf16_t* ACT; const float* cw; const float* cb; float* HTG; float* HTU; float* HBG; int dff;
    __device__ __forceinline__ void operator()(const f32x4 (&acc)[2][2][4][2], const Unit& u, int wr, int wc, int fr, int fq) const {
        const int j0 = u.pn * 128 + wc * 32 + 8 * fq;
        float w0[8], w1[8], w2[8], bb[8];
#pragma unroll
        for (int h = 0; h < 2; ++h) { const f32x4 a = *(const f32x4*)(cw + j0 + 4 * h), b = *(const f32x4*)(cw + dff + j0 + 4 * h), c = *(const f32x4*)(cw + 2 * dff + j0 + 4 * h), d = *(const f32x4*)(cb + j0 + 4 * h);
#pragma unroll
            for (int e = 0; e < 4; ++e) { w0[4 * h + e] = a[e]; w1[4 * h + e] = b[e]; w2[4 * h + e] = c[e]; bb[4 * h + e] = d[e]; } }
#pragma unroll
        for (int ai = 0; ai < 2; ++ai) {
            const int rowb = u.pm * BM + ai * HALF + wr * 64; const size_t blk = (size_t)(rowb >> 6);
#pragma unroll
            for (int m = 0; m < 4; ++m) {
                const int row = rowb + 16 * m + fr; float o[8];
#pragma unroll
                for (int n = 0; n < 2; ++n)
#pragma unroll
                    for (int e = 0; e < 4; ++e) { const int k = 4 * n + e; const float g0 = acc[ai][0][m][n][e], up = acc[ai][1][m][n][e]; const float gp = m > 0 ? acc[ai][0][m > 0 ? m - 1 : 0][n][e] : 0.f;
                        const float g1 = dpp_old<0x111>(dpp_old<0x121>(0.f, gp), g0), g2 = dpp_old<0x112>(dpp_old<0x122>(0.f, gp), g0);
                        const float gc = bb[k] + w0[k] * g2 + w1[k] * g1 + w2[k] * g0; o[k] = gc * __builtin_amdgcn_rcpf(1.f + __expf(-gc)) * up; }
                u32x4 w; w.x = cvt_pk_bf16(o[0], o[1]); w.y = cvt_pk_bf16(o[2], o[3]); w.z = cvt_pk_bf16(o[4], o[5]); w.w = cvt_pk_bf16(o[6], o[7]);
                if (!(m == 0 && fr < 2)) __builtin_nontemporal_store(w, (u32x4*)(ACT + (size_t)row * dff + j0));
                if (m == 0 && fr < 2) { float* pg = HTG + (blk * 2 + fr) * dff + j0; float* pu = HTU + (blk * 2 + fr) * dff + j0;
                    *(f32x4*)pg = acc[ai][0][0][0]; *(f32x4*)(pg + 4) = acc[ai][0][0][1]; *(f32x4*)pu = acc[ai][1][0][0]; *(f32x4*)(pu + 4) = acc[ai][1][0][1]; }
                if (m == 3 && fr >= 14) { float* pg = HBG + (blk * 2 + (fr - 14)) * dff + j0; *(f32x4*)pg = acc[ai][0][3][0]; *(f32x4*)(pg + 4) = acc[ai][0][3][1]; }
            }
        }
    }
};
struct EpiProjConv {
    static constexpr bool PERM = true, AFTER_DRAIN = false;
    bf16_t* O; int ldc; bf16_t* XBC; const float* cw; const float* cb; float* HT; float* HB;
    __device__ __forceinline__ void operator()(const f32x4 (&acc)[2][2][4][2], const Unit& u, int wr, int wc, int fr, int fq) const {
        if (u.pn < 8 || u.pn >= 24) {
            const int row0 = u.pm * BM + wr * 64 + fr; const int col0 = u.pn * BM + wc * 32 + 8 * fq;
#pragma unroll
            for (int ai = 0; ai < 2; ++ai)
#pragma unroll
                for (int m = 0; m < 4; ++m) { bf16_t* rowp = O + (size_t)(row0 + ai * HALF + m * 16) * ldc + col0;
#pragma unroll
                    for (int bj = 0; bj < 2; ++bj) { const f32x4 v0 = acc[ai][bj][m][0], v1 = acc[ai][bj][m][1];
                        u32x4 w; w.x = cvt_pk_bf16(v0[0], v0[1]); w.y = cvt_pk_bf16(v0[2], v0[3]); w.z = cvt_pk_bf16(v1[0], v1[1]); w.w = cvt_pk_bf16(v1[2], v1[3]);
                        __builtin_nontemporal_store(w, (u32x4*)(rowp + bj * HALF)); } }
            return;
        }
#pragma unroll
        for (int bj = 0; bj < 2; ++bj) {
            const int c0 = (u.pn - 8) * BM + bj * HALF + wc * 32 + 8 * fq;
            float wv[4][8], bb[8];
#pragma unroll
            for (int h = 0; h < 2; ++h) { const f32x4 d = *(const f32x4*)(cb + c0 + 4 * h);
#pragma unroll
                for (int e = 0; e < 4; ++e) bb[4 * h + e] = d[e];
#pragma unroll
                for (int i = 0; i < 4; ++i) { const f32x4 a = *(const f32x4*)(cw + i * 4096 + c0 + 4 * h);
#pragma unroll
                    for (int e = 0; e < 4; ++e) wv[i][4 * h + e] = a[e]; } }
#pragma unroll
            for (int ai = 0; ai < 2; ++ai) {
                const int rowb = u.pm * BM + ai * HALF + wr * 64; const size_t blk = (size_t)(rowb >> 6);
#pragma unroll
                for (int m = 0; m < 4; ++m) {
                    const int row = rowb + 16 * m + fr; float o[8];
#pragma unroll
                    for (int n = 0; n < 2; ++n)
#pragma unroll
                        for (int e = 0; e < 4; ++e) { const int k = 4 * n + e; const float x0 = acc[ai][bj][m][n][e]; const float xp = m > 0 ? acc[ai][bj][m > 0 ? m - 1 : 0][n][e] : 0.f;
                            const float x1 = dpp_old<0x111>(dpp_old<0x121>(0.f, xp), x0), x2 = dpp_old<0x112>(dpp_old<0x122>(0.f, xp), x0), x3 = dpp_old<0x113>(dpp_old<0x123>(0.f, xp), x0);
                            const float a = bb[k] + wv[0][k] * x3 + wv[1][k] * x2 + wv[2][k] * x1 + wv[3][k] * x0; o[k] = a * __builtin_amdgcn_rcpf(1.f + __expf(-a)); }
                    u32x4 w; w.x = cvt_pk_bf16(o[0], o[1]); w.y = cvt_pk_bf16(o[2], o[3]); w.z = cvt_pk_bf16(o[4], o[5]); w.w = cvt_pk_bf16(o[6], o[7]);
                    if (!(m == 0 && fr < 3)) __builtin_nontemporal_store(w, (u32x4*)(XBC + (size_t)row * 4096 + c0));
                    if (m == 0 && fr < 3) { float* p = HT + (blk * 3 + fr) * 4096 + c0; *(f32x4*)p = acc[ai][bj][0][0]; *(f32x4*)(p + 4) = acc[ai][bj][0][1]; }
                    if (m == 3 && fr >= 13) { float* p = HB + (blk * 3 + (fr - 13)) * 4096 + c0; *(f32x4*)p = acc[ai][bj][3][0]; *(f32x4*)(p + 4) = acc[ai][bj][3][1]; }
                }
            }
        }
    }
};
struct EpiRes {
    static constexpr bool PERM = false, AFTER_DRAIN = false;
    const float* base; float* out; int ldc;
    __device__ __forceinline__ void operator()(const f32x4 (&acc)[2][2][4][2], const Unit& u, int wr, int wc, int fr, int fq) const {
        const int row0 = u.pm * BM + wr * 64 + fr, col0 = u.pn * BM + wc * 32 + 4 * fq;
#pragma unroll
        for (int ai = 0; ai < 2; ++ai)
#pragma unroll
            for (int m = 0; m < 4; ++m) { const size_t off = (size_t)(row0 + ai * HALF + m * 16) * ldc + col0;
#pragma unroll
                for (int bj = 0; bj < 2; ++bj)
#pragma unroll
                    for (int n = 0; n < 2; ++n) { const f32x4 bs = *(const f32x4*)(base + off + bj * HALF + n * 16); *(f32x4*)(out + off + bj * HALF + n * 16) = bs + acc[ai][bj][m][n]; } }
    }
};
template <class Epi, class Sched, bool ALIGN_EPI = false, bool SP2 = false>
__device__ __forceinline__ void gemm_phase(PG8_LAS unsigned char* lds, const Gemm g, const Sched& S, const Epi& E) {
    const int tid = threadIdx.x, wid = __builtin_amdgcn_readfirstlane(tid >> 6), lane = tid & 63, wr = wid >> 2, wc = wid & 3, fr = lane & 15, fq = lane >> 4;
    const int K = g.K, nt = K / BK;
    unsigned voffA[2], voffB[2];
#pragma unroll
    for (int i = 0; i < 2; ++i) { int R, C; stage_rc(tid * 16 + i * 8192, R, C); const int Rb = Epi::PERM ? ((R & ~31) + perm32(R & 31)) : R;
        voffA[i] = (unsigned)(R * K + C) * 2u; voffB[i] = (unsigned)(Rb * K + C) * 2u; }
    const size_t kstep = (size_t)(BK * 2);
    const size_t hstep = (size_t)HALF * K * 2;
    const size_t tstep = 2 * hstep;
    const unsigned ldsw = (unsigned)wid * 1024u;
    const int aoff = lds_byte(wr * 64 + fr, fq * 8), boff = lds_byte(wc * 32 + fr, fq * 8);
#define PG8_SA(b, h) (((b) * 2 + (h)) * HTB)
#define PG8_SB(b, h) ((4 + (b) * 2 + (h)) * HTB)
#define PG8_STAGE(bufoff, gbase, voff) do { _Pragma("unroll") for (int _i = 0; _i < 2; ++_i) \
        __builtin_amdgcn_global_load_lds((const unsigned*)((const char*)(gbase) + (voff)[_i]), (PG8_LAS unsigned*)(lds + (bufoff) + ldsw + _i * 8192), 16, 0, 0); } while (0)
#define PG8_LDA(dst, b, h) do { _Pragma("unroll") for (int m = 0; m < 4; ++m) _Pragma("unroll") for (int k = 0; k < 2; ++k) dst[m][k] = *(const PG8_LAS bf16x8*)(lds + PG8_SA(b, h) + aoff + m * 2048 + k * 1024); } while (0)
#define PG8_LDB(dst, b, h) do { _Pragma("unroll") for (int n = 0; n < 2; ++n) _Pragma("unroll") for (int k = 0; k < 2; ++k) dst[n][k] = *(const PG8_LAS bf16x8*)(lds + PG8_SB(b, h) + boff + n * 2048 + k * 1024); } while (0)
#define PG8_MMA(ai, bj, At, Bt) do { __builtin_amdgcn_s_setprio(1); _Pragma("unroll") for (int m = 0; m < 4; ++m) _Pragma("unroll") for (int n = 0; n < 2; ++n) _Pragma("unroll") for (int k = 0; k < 2; ++k) \
        acc[ai][bj][m][n] = __builtin_amdgcn_mfma_f32_16x16x32_bf16(Bt[n][k], At[m][k], acc[ai][bj][m][n], 0, 0, 0); __builtin_amdgcn_s_setprio(0); } while (0)
#define PG8_WAIT_V(n) asm volatile("s_waitcnt vmcnt(" #n ")" ::: "memory")
#define PG8_WAIT_L(n) asm volatile("s_waitcnt lgkmcnt(" #n ")" ::: "memory")
#define PG8_BAR __builtin_amdgcn_s_barrier()
#define PG8_SCHED __builtin_amdgcn_sched_barrier(0)
    Unit cur, nxt; int ui = 0;
    if (!S.next(0, cur)) return;
    f32x4 acc[2][2][4][2];
#pragma unroll
    for (int a = 0; a < 2; ++a)
#pragma unroll
        for (int b = 0; b < 2; ++b)
#pragma unroll
            for (int m = 0; m < 4; ++m)
#pragma unroll
                for (int n = 0; n < 2; ++n) acc[a][b][m][n] = (f32x4){0.f, 0.f, 0.f, 0.f};
    bf16x8 At[4][2], B0[2][2], B1[2][2];
    const char* cA = (const char*)g.A + (size_t)cur.pm * tstep; const char* cB = (const char*)g.Bt + (size_t)cur.pn * tstep;
    S.a_ready(cur);
    if constexpr (SP2) {
        PG8_STAGE(PG8_SB(0, 0), cB, voffB); PG8_STAGE(PG8_SB(0, 1), cB + hstep, voffB); PG8_STAGE(PG8_SA(0, 0), cA, voffA); PG8_STAGE(PG8_SA(0, 1), cA + hstep, voffA);
        if (wr == 1) PG8_BAR;
        PG8_WAIT_V(2); PG8_BAR;
        PG8_STAGE(PG8_SB(1, 0), cB + kstep, voffB); PG8_STAGE(PG8_SA(1, 0), cA + kstep, voffA); PG8_STAGE(PG8_SB(1, 1), cB + hstep + kstep, voffB);
        PG8_WAIT_V(6); PG8_BAR;
    } else {
        PG8_STAGE(PG8_SB(0, 0), cB, voffB); PG8_STAGE(PG8_SA(0, 0), cA, voffA); PG8_STAGE(PG8_SB(0, 1), cB + hstep, voffB); PG8_STAGE(PG8_SA(0, 1), cA + hstep, voffA);
        if (wr == 1) PG8_BAR;
        PG8_WAIT_V(4); PG8_BAR;
        PG8_STAGE(PG8_SB(1, 0), cB + kstep, voffB); PG8_STAGE(PG8_SA(1, 0), cA + kstep, voffA); PG8_STAGE(PG8_SB(1, 1), cB + hstep + kstep, voffB);
        PG8_WAIT_V(6); PG8_BAR;
    }
    for (;;) {
        const bool has_next = S.next(ui + 1, nxt);
        const char* nA = has_next ? (const char*)g.A + (size_t)nxt.pm * tstep : cA; const char* nB = has_next ? (const char*)g.Bt + (size_t)nxt.pn * tstep : cB;
        for (int t = 0; t < nt; t += 2) {
            const bool last = (t == nt - 2);
            const char* a1 = cA + (size_t)(t + 1) * kstep;
            const char* a2 = last ? nA : cA + (size_t)(t + 2) * kstep; const char* b2 = last ? nB : cB + (size_t)(t + 2) * kstep;
            const char* a3 = a2 + kstep; const char* b3 = b2 + kstep;
            if (last && has_next) S.a_ready(nxt);
            if constexpr (SP2) {
            PG8_LDB(B0, 0, 0); PG8_LDB(B1, 0, 1); PG8_SCHED; PG8_LDA(At, 0, 0); PG8_STAGE(PG8_SA(1, 1), a1 + hstep, voffA);
            PG8_WAIT_V(8); PG8_WAIT_L(0); PG8_BAR; PG8_MMA(0, 0, At, B0); PG8_MMA(0, 1, At, B1); PG8_BAR; PG8_SCHED;
            PG8_LDA(At, 0, 1); PG8_STAGE(PG8_SB(0, 0), b2, voffB); PG8_STAGE(PG8_SB(0, 1), b2 + hstep, voffB); PG8_STAGE(PG8_SA(0, 0), a2, voffA);
            PG8_WAIT_V(8); PG8_WAIT_L(0); PG8_BAR; PG8_MMA(1, 0, At, B0); PG8_MMA(1, 1, At, B1); PG8_BAR; PG8_SCHED;
            PG8_LDB(B0, 1, 0); PG8_LDB(B1, 1, 1); PG8_SCHED; PG8_LDA(At, 1, 0); PG8_STAGE(PG8_SA(0, 1), a2 + hstep, voffA);
            PG8_WAIT_V(8); PG8_WAIT_L(0); PG8_BAR; PG8_MMA(0, 0, At, B0); PG8_MMA(0, 1, At, B1); PG8_BAR; PG8_SCHED;
            PG8_LDA(At, 1, 1); PG8_STAGE(PG8_SB(1, 0), b3, voffB); PG8_STAGE(PG8_SB(1, 1), b3 + hstep, voffB); PG8_STAGE(PG8_SA(1, 0), a3, voffA);
            PG8_WAIT_V(8); PG8_WAIT_L(0); PG8_BAR; PG8_MMA(1, 0, At, B0); PG8_MMA(1, 1, At, B1); PG8_BAR; PG8_SCHED;
            } else {
            PG8_LDB(B0, 0, 0); PG8_SCHED; PG8_LDA(At, 0, 0); PG8_STAGE(PG8_SA(1, 1), a1 + hstep, voffA);
            PG8_WAIT_L(8); PG8_BAR; PG8_WAIT_L(0); PG8_MMA(0, 0, At, B0); PG8_BAR; PG8_SCHED;
            PG8_LDB(B1, 0, 1); PG8_STAGE(PG8_SB(0, 0), b2, voffB);
            PG8_BAR; PG8_WAIT_L(0); PG8_MMA(0, 1, At, B1); PG8_BAR;
            PG8_LDA(At, 0, 1); PG8_STAGE(PG8_SA(0, 0), a2, voffA);
            PG8_BAR; PG8_WAIT_L(0); PG8_MMA(1, 0, At, B0); PG8_BAR; PG8_SCHED;
            PG8_STAGE(PG8_SB(0, 1), b2 + hstep, voffB);
            PG8_WAIT_V(6); PG8_BAR; PG8_MMA(1, 1, At, B1); PG8_BAR;
            PG8_LDB(B0, 1, 0); PG8_SCHED; PG8_LDA(At, 1, 0); PG8_STAGE(PG8_SA(0, 1), a2 + hstep, voffA);
            PG8_WAIT_L(8); PG8_BAR; PG8_WAIT_L(0); PG8_MMA(0, 0, At, B0); PG8_BAR; PG8_SCHED;
            PG8_LDB(B1, 1, 1); PG8_STAGE(PG8_SB(1, 0), b3, voffB);
            PG8_BAR; PG8_WAIT_L(0); PG8_MMA(0, 1, At, B1); PG8_BAR;
            PG8_LDA(At, 1, 1); PG8_STAGE(PG8_SA(1, 0), a3, voffA);
            PG8_BAR; PG8_WAIT_L(0); PG8_MMA(1, 0, At, B0); PG8_BAR; PG8_SCHED;
            PG8_STAGE(PG8_SB(1, 1), b3 + hstep, voffB);
            PG8_WAIT_V(6); PG8_BAR; PG8_MMA(1, 1, At, B1); PG8_BAR;
            }
        }
        if constexpr (ALIGN_EPI) { if (wr == 0) PG8_BAR; }
        if constexpr (!Epi::AFTER_DRAIN) { E(acc, cur, wr, wc, fr, fq); S.done(cur); }
        if (!has_next) break;
#pragma unroll
        for (int a = 0; a < 2; ++a)
#pragma unroll
            for (int b = 0; b < 2; ++b)
#pragma unroll
                for (int m = 0; m < 4; ++m)
#pragma unroll
                    for (int n = 0; n < 2; ++n) acc[a][b][m][n] = (f32x4){0.f, 0.f, 0.f, 0.f};
        cur = nxt; cA = nA; cB = nB; ++ui;
        if constexpr (ALIGN_EPI) { if (wr == 1) PG8_BAR; }
    }
    PG8_WAIT_V(0);
    if constexpr (!ALIGN_EPI) { if (wr == 0) PG8_BAR; }
    PG8_BAR;
    if constexpr (Epi::AFTER_DRAIN) { E.fused(acc, cur, wr, wc, fr, fq, lds, wid, lane); S.done(cur); }
#undef PG8_SA
#undef PG8_SB
#undef PG8_STAGE
#undef PG8_LDA
#undef PG8_LDB
#undef PG8_MMA
#undef PG8_WAIT_V
#undef PG8_WAIT_L
#undef PG8_BAR
#undef PG8_SCHED
}
}

constexpr int NWAVES = 8, NTHR = NWAVES * 64;
constexpr int BATCH = 2, SEQ = 8192, M = BATCH * SEQ, DM = 4096, DEPTH = 2;
constexpr int SSD_W = 2048, SSD_H = 32, SSD_CD = 4096;
constexpr int SWA_W = 1024, SWA_H = 16;
constexpr int GLA_W = 1024, GLA_KT = 512;
constexpr int DFF = 11008, DIN = 10800, DINP = 11008, DGU = 2 * DFF;
constexpr float EPS = 1e-6f;
constexpr int C_Z = 0, C_XBC = 2048, C_DT = 6144, C_SQ = 6176, C_SK = 7200, C_SV = 7456, C_GQ = 7712, C_GK = 8224, C_GV = 8736, C_GG = 9760, C_GLR = 10784;
enum { I_X = 0, I_ATTN_NORM, I_W_IN, I_SSD_CONV_W, I_SSD_CONV_B, I_SSD_DT_BIAS, I_SSD_A_LOG, I_SSD_D, I_SSD_NORM, I_SWA_SINKS, I_SWA_NORM, I_GLA_W_GATE, I_GLA_B_GATE, I_GLA_NORM,
       I_W_OUT, I_FFN_NORM, I_W_GATE, I_W_UP, I_FFN_CONV_W, I_FFN_CONV_B, I_W_DOWN, I_REL_BIAS, I_FINAL_NORM, N_IN };

constexpr size_t MiB = 1u << 20;
constexpr size_t WS_CTL = 0, CTL_BYTES = 1 * MiB;
constexpr size_t WS_WIN = 1 * MiB;
constexpr size_t WS_WOUT = 87 * MiB;
constexpr size_t WS_WGU = 119 * MiB;
constexpr size_t WS_WDN = 291 * MiB;
constexpr size_t WS_H = 377 * MiB;
constexpr size_t WS_R = 505 * MiB;
constexpr size_t WS_PROJ = WS_R;
constexpr size_t WS_XBC = WS_R + 344 * MiB;
constexpr size_t WS_QD = WS_R + 472 * MiB;
constexpr size_t WS_KI = WS_R + 488 * MiB;
constexpr size_t WS_DT = WS_R + 520 * MiB;
constexpr size_t WS_ACS = WS_R + 522 * MiB;
constexpr size_t WS_DEC = WS_R + 524 * MiB;
constexpr size_t WS_GDEC = WS_R + 525 * MiB;
constexpr size_t WS_ST = WS_R + 528 * MiB;
constexpr size_t WS_PV = WS_R + 656 * MiB;
constexpr size_t WS_GST = WS_R + 720 * MiB;
constexpr size_t WS_GPV = WS_R + 848 * MiB;
constexpr size_t WS_OSWA = WS_R + 912 * MiB;
constexpr size_t WS_Y = WS_R + 976 * MiB;
constexpr size_t WS_ACT = WS_R + 688 * MiB;
constexpr size_t WS_HTG = WS_R + 1032 * MiB, WS_HTU = WS_R + 1054 * MiB, WS_HBG = WS_R + 1076 * MiB;
constexpr size_t WS_XHT = WS_R + 504 * MiB, WS_XHB = WS_R + 1104 * MiB;
constexpr size_t WS_END = WS_R + 1120 * MiB;
static_assert(DEPTH == 2 && (size_t)DINP * DM * 2 == 86 * MiB && (size_t)DGU * DM * 2 == 172 * MiB && (size_t)M * DINP * 2 == 344 * MiB , "ws map");
constexpr int CW_BAR = 4096;

constexpr int RING_BYTES = 131072;
constexpr int MISC_OFF = 147456 - 256;
constexpr int LDS_BYTES = 147456;

#define GAS __attribute__((address_space(1)))
#define LAS __attribute__((address_space(3)))
typedef unsigned short bf16;
typedef unsigned v4u __attribute__((ext_vector_type(4)));
typedef unsigned v2u __attribute__((ext_vector_type(2)));
typedef float f32x4 __attribute__((ext_vector_type(4)));
typedef GAS unsigned gu32;
#define RLX_AGENT __ATOMIC_RELAXED, __HIP_MEMORY_SCOPE_AGENT
#define LDS_WAIT() asm volatile("s_waitcnt lgkmcnt(0)" ::: "memory")
__device__ __forceinline__ unsigned f2bf(float f) { unsigned u = __builtin_bit_cast(unsigned, f); return (u + 0x7fffu + ((u >> 16) & 1u)) >> 16; }
__device__ __forceinline__ unsigned pk2(float lo, float hi) { return pg8::cvt_pk_bf16(lo, hi); }
__device__ __forceinline__ float bflo(unsigned w) { return __uint_as_float(w << 16); }
__device__ __forceinline__ float bfhi(unsigned w) { return __uint_as_float(w & 0xffff0000u); }
__device__ __forceinline__ float bf1(bf16 h) { return __uint_as_float((unsigned)h << 16); }
__device__ __forceinline__ float silu_f(float x) { return x * __builtin_amdgcn_rcpf(1.f + __expf(-x)); }
__device__ __forceinline__ float wave_sum(float v) {
#pragma unroll
    for (int o = 1; o < 64; o <<= 1) v += __shfl_xor(v, o);
    return v;
}
template <int CTRL> __device__ __forceinline__ float dpp_f(float v) { return __int_as_float(__builtin_amdgcn_update_dpp(0, __float_as_int(v), CTRL, 0xf, 0xf, false)); }
__device__ __forceinline__ float row16_sum(float v) { v += dpp_f<0xB1>(v); v += dpp_f<0x4E>(v); v += dpp_f<0x124>(v); v += dpp_f<0x128>(v); return v; }
__device__ __forceinline__ float pair_sum(float v) { return v + dpp_f<0xB1>(v); }
#define XB_TMO      128
#define XB_XCNT(j)  (256  + 64 * (j))
#define XB_XSUB(j)  (1280 + 64 * (j))
#define XB_XGEN(j)  (2304 + 64 * (j))
#define XB_TOP      3328
#define XB_TOPGEN   3392
#define XCD_BAR_WORDS 3456
#define XB_SPIN_CAP (1u << 18)

__device__ __forceinline__ unsigned xb_ld(unsigned* p)              { return __hip_atomic_load(p, __ATOMIC_RELAXED, __HIP_MEMORY_SCOPE_AGENT); }
__device__ __forceinline__ unsigned xb_add(unsigned* p, unsigned v) { return __hip_atomic_fetch_add(p, v, __ATOMIC_RELAXED, __HIP_MEMORY_SCOPE_AGENT); }
__device__ __forceinline__ unsigned xb_xcc_id() { return (unsigned)__builtin_amdgcn_s_getreg((3 << 11) | 20) & 0xFu; }
#define XB_SPIN(cond, bar) do { unsigned _sp = 0; while (cond) { __builtin_amdgcn_s_sleep(1); \
    if ((++_sp & 255u) == 0u) { if (xb_ld(&(bar)[XB_TMO])) break; if (_sp > XB_SPIN_CAP) { atomicAdd(&(bar)[XB_TMO], 1u); break; } } } } while (0)

struct XcdBarrier {
    unsigned* bar; unsigned x;
    volatile LAS unsigned* st;
};

__device__ __forceinline__ XcdBarrier xcd_barrier_post(unsigned* bar, volatile LAS unsigned* st) {
    XcdBarrier b; b.bar = bar; b.x = xb_xcc_id(); b.st = st;
    if (threadIdx.x == 0) (void)xb_add(&bar[XB_XCNT(b.x)], 1u);
    return b;
}
__device__ __forceinline__ void xcd_barrier_complete(unsigned* bar, unsigned x, unsigned& nloc, unsigned& nx) {
    const unsigned G = gridDim.x * gridDim.y * gridDim.z;
    unsigned sum, cnt, mine, sp = 0u;
    for (;;) {
        sum = 0u; cnt = 0u; mine = 0u;
#pragma unroll
        for (unsigned j = 0; j < 16; ++j) { const unsigned c = xb_ld(&bar[XB_XCNT(j)]); sum += c; cnt += (c > 0u) ? 1u : 0u; mine = (j == x) ? c : mine; }
        if (sum == G) break;
        __builtin_amdgcn_s_sleep(1);
        if ((++sp & 255u) == 0u) { if (xb_ld(&bar[XB_TMO])) break; if (sp > XB_SPIN_CAP) { atomicAdd(&bar[XB_TMO], 1u); break; } }
    }
    nloc = mine > 0u ? mine : 1u; nx = cnt > 0u ? cnt : 1u;
}

__device__ __forceinline__ void xcd_barrier(const XcdBarrier& b) {
    asm volatile("s_waitcnt vmcnt(0)" ::: "memory");
    __syncthreads();
    if (threadIdx.x == 0) {
        unsigned* bar = b.bar;
        __builtin_amdgcn_s_waitcnt(0);
        unsigned nloc = b.st[0], nx = b.st[1];
        if (nloc == 0u) { xcd_barrier_complete(bar, b.x, nloc, nx); b.st[0] = nloc; b.st[1] = nx; }
        const unsigned old = xb_add(&bar[XB_XSUB(b.x)], 1u);
        const unsigned gen = old / nloc;
        if (old + 1u == (gen + 1u) * nloc) {
            __builtin_amdgcn_fence(__ATOMIC_RELEASE, "agent");
            asm volatile("s_waitcnt vmcnt(0)" ::: "memory");
            const unsigned og = xb_add(&bar[XB_TOP], 1u);
            const unsigned tg = og / nx;
            if (og + 1u == (tg + 1u) * nx) xb_add(&bar[XB_TOPGEN], 1u);
            else XB_SPIN(xb_ld(&bar[XB_TOPGEN]) == tg, bar);
            __builtin_amdgcn_fence(__ATOMIC_ACQUIRE, "agent");
            xb_add(&bar[XB_XGEN(b.x)], 1u);
            asm volatile("s_waitcnt vmcnt(0)" ::: "memory");
        } else {
            XB_SPIN(xb_ld(&bar[XB_XGEN(b.x)]) == gen, bar);
            __builtin_amdgcn_fence(__ATOMIC_ACQUIRE, "agent");
            asm volatile("s_waitcnt vmcnt(0)" ::: "memory");
        }
    }
    __syncthreads();
}

struct Args { const float* in[N_IN]; float* out; unsigned char* ws; int ph_lo, ph_hi, li, pad; };
struct Ctx {
    LAS unsigned char* lds;
    int tid, lane, wave, G, bid;
    const float* const* in; float* out; unsigned char* ws;
};
__device__ const unsigned char T5_BUCKET[128] = {0, 1, 2, 3, 4, 5, 6, 7, 8, 9, 10, 11, 12, 13, 14, 15, 16, 16, 16, 17, 17, 18, 18, 18, 19, 19, 19, 20, 20, 20, 20, 21, 21, 21, 21, 22, 22, 22, 22, 22, 23, 23, 23, 23, 23, 23, 24, 24, 24, 24, 24, 24, 25, 25, 25, 25, 25, 25, 25, 26, 26, 26, 26, 26, 26, 26, 26, 27, 27, 27, 27, 27, 27, 27, 27, 27, 27, 28, 28, 28, 28, 28, 28, 28, 28, 28, 28, 29, 29, 29, 29, 29, 29, 29, 29, 29, 29, 29, 29, 30, 30, 30, 30, 30, 30, 30, 30, 30, 30, 30, 30, 30, 30, 31, 31, 31, 31, 31, 31, 31, 31, 31, 31, 31, 31, 31, 31, 31};

struct TItem { const float* src; bf16* dst; int N, K, nvalid; };
constexpr int CV_NITEMS = 32 * 86 * 3 + 32 * 32 + 86 * 32;
__device__ __forceinline__ TItem titem_decode(Ctx& C, int l, int it) {
    constexpr int I_IN = 32 * 86, I_OUT = 32 * 32, I_G = 32 * 86;
    TItem t; int r = it, kb, nb;
    if (r < I_IN) { kb = r / 86; nb = r % 86; t.N = DIN; t.K = DM; t.src = C.in[I_W_IN] + (size_t)l * DM * DIN; t.dst = (bf16*)(C.ws + WS_WIN) + (size_t)(128 * nb) * DM; }
    else if ((r -= I_IN) < I_OUT) { kb = r / 32; nb = r % 32; t.N = DM; t.K = DM; t.src = C.in[I_W_OUT] + (size_t)l * DM * DM; t.dst = (bf16*)(C.ws + WS_WOUT) + (size_t)(128 * nb) * DM; }
    else if ((r -= I_OUT) < I_G) { kb = r / 86; nb = r % 86; t.N = DFF; t.K = DM; t.src = C.in[I_W_GATE] + (size_t)l * DM * DFF; t.dst = (bf16*)(C.ws + WS_WGU) + (size_t)(256 * nb) * DM; }
    else if ((r -= I_G) < I_G) { kb = r / 86; nb = r % 86; t.N = DFF; t.K = DM; t.src = C.in[I_W_UP] + (size_t)l * DM * DFF; t.dst = (bf16*)(C.ws + WS_WGU) + (size_t)(256 * nb + 128) * DM; }
    else { r -= I_G; kb = r / 32; nb = r % 32; t.N = DM; t.K = DFF; t.src = C.in[I_W_DOWN] + (size_t)l * DFF * DM; t.dst = (bf16*)(C.ws + WS_WDN) + (size_t)(128 * nb) * DFF; }
    t.src += (size_t)(128 * kb) * t.N + 128 * nb; t.dst += 128 * kb;
    const int rem = t.N - 128 * nb; t.nvalid = rem >= 128 ? 128 : (rem > 0 ? rem : 0);
    return t;
}
__device__ __forceinline__ void titem_load(const TItem& t, f32x4 (&v)[8], int wave, int lane) {
    const bool nv = 4 * (lane & 31) < t.nvalid; const float* p = t.src + (size_t)(16 * wave + 2 * (lane >> 5)) * t.N + 4 * (lane & 31);
#pragma unroll
    for (int i = 0; i < 4; ++i) { v[2 * i] = nv ? *(const GAS f32x4*)(p + (size_t)(4 * i) * t.N) : (f32x4){0.f, 0.f, 0.f, 0.f}; v[2 * i + 1] = nv ? *(const GAS f32x4*)(p + (size_t)(4 * i + 1) * t.N) : (f32x4){0.f, 0.f, 0.f, 0.f}; }
}
__device__ __forceinline__ void titem_store(const TItem& t, const f32x4 (&v)[8], LAS unsigned* T, int tid, int wave, int lane) {
    __syncthreads();
    { const int kd = 8 * wave + (lane >> 5);
#pragma unroll
      for (int i = 0; i < 4; ++i)
#pragma unroll
          for (int e = 0; e < 4; ++e) T[(4 * (lane & 31) + e) * 65 + ((kd + 2 * i) ^ ((lane & 31) >> 3))] = pg8::cvt_pk_bf16(v[2 * i][e], v[2 * i + 1][e]); }
    __syncthreads();
    const int ch = tid & 15;
#pragma unroll
    for (int ps = 0; ps < 4; ++ps) { const int n = 32 * ps + (tid >> 4); const LAS unsigned* s = T + n * 65 + 4 * ch;
        v4u o; o.x = s[0 ^ ps]; o.y = s[1 ^ ps]; o.z = s[2 ^ ps]; o.w = s[3 ^ ps];
        *(GAS v4u*)(t.dst + (size_t)n * t.K + 8 * ch) = o; }
}
__device__ __forceinline__ void convert_weights(Ctx& C, int l) {
    LAS unsigned* T = (LAS unsigned*)C.lds;
    int it = C.bid; if (it >= CV_NITEMS) return;
    TItem cur = titem_decode(C, l, it); f32x4 va[8], vb[8];
    titem_load(cur, va, C.wave, C.lane);
    for (;;) {
        int nx = it + C.G; TItem tn = cur; const bool hn = nx < CV_NITEMS;
        if (hn) { tn = titem_decode(C, l, nx); titem_load(tn, vb, C.wave, C.lane); }
        titem_store(cur, va, T, C.tid, C.wave, C.lane);
        if (!hn) break;
        nx += C.G; const bool hn2 = nx < CV_NITEMS; TItem t2 = tn;
        if (hn2) { t2 = titem_decode(C, l, nx); titem_load(t2, va, C.wave, C.lane); }
        titem_store(tn, vb, T, C.tid, C.wave, C.lane);
        if (!hn2) break;
        cur = t2; it = nx;
    }
    __syncthreads();
}
__device__ __forceinline__ float row_ssq(const f32x4 (&v)[16]) { float ss = 0.f;
#pragma unroll
    for (int j = 0; j < 16; ++j) ss += (v[j].x * v[j].x + v[j].y * v[j].y) + (v[j].z * v[j].z + v[j].w * v[j].w);
    return ss; }
__device__ __forceinline__ void rmsnorm_phase(Ctx& C, const float* X, const float* w, bf16* H) {
    const int gw = C.bid * NWAVES + C.wave, NGW = C.G * NWAVES, lane = C.lane;
    const GAS f32x4* wr = (const GAS f32x4*)w + lane;
    for (int m = gw; m < M; m += 2 * NGW) {
        const int m2 = m + NGW; const bool h2 = m2 < M;
        const GAS f32x4* x0 = (const GAS f32x4*)(X + (size_t)m * DM) + lane; const GAS f32x4* x1 = (const GAS f32x4*)(X + (size_t)(h2 ? m2 : m) * DM) + lane;
        f32x4 v0[16], v1[16];
#pragma unroll
        for (int j = 0; j < 16; ++j) v0[j] = x0[64 * j];
#pragma unroll
        for (int j = 0; j < 16; ++j) v1[j] = x1[64 * j];
        const float r0 = 1.f / sqrtf(wave_sum(row_ssq(v0)) * (1.f / DM) + EPS), r1 = 1.f / sqrtf(wave_sum(row_ssq(v1)) * (1.f / DM) + EPS);
        GAS v2u* o0 = (GAS v2u*)(H + (size_t)m * DM) + lane; GAS v2u* o1 = (GAS v2u*)(H + (size_t)m2 * DM) + lane;
#pragma unroll
        for (int j = 0; j < 16; ++j) { const f32x4 g = wr[64 * j]; v2u o; o.x = pk2(v0[j].x * r0 * g.x, v0[j].y * r0 * g.y); o.y = pk2(v0[j].z * r0 * g.z, v0[j].w * r0 * g.w); o0[64 * j] = o;
            if (h2) { v2u p; p.x = pk2(v1[j].x * r1 * g.x, v1[j].y * r1 * g.y); p.y = pk2(v1[j].z * r1 * g.z, v1[j].w * r1 * g.w); o1[64 * j] = p; } }
    }
}
__device__ __forceinline__ void final_norm_phase(Ctx& C, float* X, const float* w) {
    const int gw = C.bid * NWAVES + C.wave, NGW = C.G * NWAVES, lane = C.lane;
    const GAS f32x4* wr = (const GAS f32x4*)w + lane;
    for (int m = gw; m < M; m += 2 * NGW) {
        const int m2 = m + NGW; const bool h2 = m2 < M;
        GAS f32x4* x0 = (GAS f32x4*)(X + (size_t)m * DM) + lane; GAS f32x4* x1 = (GAS f32x4*)(X + (size_t)(h2 ? m2 : m) * DM) + lane;
        f32x4 v0[16], v1[16];
#pragma unroll
        for (int j = 0; j < 16; ++j) v0[j] = x0[64 * j];
#pragma unroll
        for (int j = 0; j < 16; ++j) v1[j] = x1[64 * j];
        const float r0 = 1.f / sqrtf(wave_sum(row_ssq(v0)) * (1.f / DM) + EPS), r1 = 1.f / sqrtf(wave_sum(row_ssq(v1)) * (1.f / DM) + EPS);
#pragma unroll
        for (int j = 0; j < 16; ++j) { const f32x4 g = wr[64 * j]; x0[64 * j] = v0[j] * r0 * g; if (h2) x1[64 * j] = v1[j] * r1 * g; }
    }
}

typedef short bf16x8 __attribute__((ext_vector_type(8)));
typedef short s16x4 __attribute__((ext_vector_type(4)));
__device__ __forceinline__ f32x4 mfma16(bf16x8 a, bf16x8 b, f32x4 c) { return __builtin_amdgcn_mfma_f32_16x16x32_bf16(a, b, c, 0, 0, 0); }
__device__ __forceinline__ bf16x8 pack8(f32x4 lo, f32x4 hi) { v4u w; w.x = pg8::cvt_pk_bf16(lo.x, lo.y); w.y = pg8::cvt_pk_bf16(lo.z, lo.w); w.z = pg8::cvt_pk_bf16(hi.x, hi.y); w.w = pg8::cvt_pk_bf16(hi.z, hi.w); return __builtin_bit_cast(bf16x8, w); }
__device__ __forceinline__ bf16x8 gfrag(const bf16* Mx, size_t ld, int row0, int k0, int lane) { return *(const GAS bf16x8*)(Mx + (size_t)(row0 + (lane & 15)) * ld + k0 + 8 * (lane >> 4)); }
__device__ __forceinline__ bf16x8 trfrag(const LAS unsigned char* img, int stride, int r0, int r1, int col0, int lane) {
    const int q = (lane & 15) >> 2, p = lane & 3;
    const s16x4 a = __builtin_amdgcn_ds_read_tr16_b64_v4i16((LAS s16x4*)(img + (r0 + q) * stride + (col0 + 4 * p) * 2));
    const s16x4 b = __builtin_amdgcn_ds_read_tr16_b64_v4i16((LAS s16x4*)(img + (r1 + q) * stride + (col0 + 4 * p) * 2));
    return __builtin_shufflevector(a, b, 0, 1, 2, 3, 4, 5, 6, 7);
}
__device__ __forceinline__ float xsum4(float v) { v += __shfl_xor(v, 16); v += __shfl_xor(v, 32); return v; }
__device__ __forceinline__ float xmax4(float v) { v = fmaxf(v, __shfl_xor(v, 16)); v = fmaxf(v, __shfl_xor(v, 32)); return v; }

constexpr int SWA_VSTRIDE = 144;
constexpr int SWA_V_BYTES = 192 * SWA_VSTRIDE;
__device__ __forceinline__ void swa_unit_mfma(Ctx& C, int l, int unit) {
    const int b = unit >> 7, qb = unit & 127, q0 = qb * 64;
    const int tid = C.tid, lane = C.lane, w = C.wave, c = lane & 15, hq = lane >> 4;
    LAS unsigned char* Vimg = C.lds;
    LAS float* tb = (LAS float*)(C.lds + 30720);
    LAS float* ssqx = (LAS float*)(C.lds + 30720 + 12288);
    const bf16* PROJ = (const bf16*)(C.ws + WS_PROJ); float* OSWA = (float*)(C.ws + WS_OSWA); bf16* Y = (bf16*)(C.ws + WS_Y);
    const bf16* Pb = PROJ + (size_t)b * SEQ * DINP;
    __syncthreads();
    for (int i = tid; i < 16 * 192; i += NTHR) { const int hd = i / 192, x = i % 192, dist = x - 32; tb[i] = (dist >= 0 && dist < 128) ? C.in[I_REL_BIAS][T5_BUCKET[dist] * SWA_H + hd] : 0.f; }
    if (tid < 16 * 9) *(LAS v4u*)(Vimg + (192 + tid / 9) * SWA_VSTRIDE + 16 * (tid % 9)) = (v4u){0u, 0u, 0u, 0u};
    const int g = w >> 1, qhalf = w & 1;
    float ssq0 = 0.f, ssq1 = 0.f;
    for (int kvh = 0; kvh < 4; ++kvh) {
        const int head = kvh * 4 + g;
        __syncthreads();
#pragma unroll
        for (int it = 0; it < 3; ++it) { const int idx = tid + NTHR * it, j = idx >> 3, cg = idx & 7; int s = q0 - 128 + j; s = s < 0 ? 0 : s;
            const v4u v = *(const GAS v4u*)(Pb + (size_t)s * DINP + C_SV + kvh * 64 + 8 * cg); *(LAS v4u*)(Vimg + j * SWA_VSTRIDE + 16 * cg) = v; }
        __syncthreads();
        const float sink = C.in[I_SWA_SINKS][l * SWA_H + head];
#pragma nounroll
        for (int qt = 0; qt < 2; ++qt) {
            const int j0 = 32 * qhalf + 16 * qt;
            const bf16x8 qf0 = gfrag(Pb + C_SQ + head * 64, DINP, q0 + j0, 0, lane), qf1 = gfrag(Pb + C_SQ + head * 64, DINP, q0 + j0, 32, lane);
            f32x4 sacc[10];
#pragma unroll
            for (int kt = 0; kt < 10; ++kt) {
                int srow = q0 - 128 + j0 + 16 * kt + c; srow = srow < 0 ? 0 : srow; srow = srow > q0 + 63 ? q0 + 63 : srow;
                const bf16* kp = Pb + (size_t)srow * DINP + C_SK + kvh * 64 + 8 * hq;
                const bf16x8 k0 = *(const GAS bf16x8*)kp, k1 = *(const GAS bf16x8*)(kp + 32);
                f32x4 a = (f32x4){0.f, 0.f, 0.f, 0.f}; a = mfma16(k0, qf0, a); a = mfma16(k1, qf1, a); sacc[kt] = a;
            }
            float mx = sink;
#pragma unroll
            for (int kt = 0; kt < 10; ++kt)
#pragma unroll
                for (int r = 0; r < 4; ++r) { const int dist = c + 128 - 16 * kt - 4 * hq - r; const int s = q0 - 128 + j0 + 16 * kt + 4 * hq + r;
                    const bool valid = (dist >= 0) && (dist < 128) && (s >= 0);
                    const float sc = valid ? sacc[kt][r] * 0.125f + tb[head * 192 + dist + 32] : -1e30f;
                    sacc[kt][r] = sc; mx = fmaxf(mx, sc); }
            mx = xmax4(mx); float sum = 0.f;
#pragma unroll
            for (int kt = 0; kt < 10; ++kt)
#pragma unroll
                for (int r = 0; r < 4; ++r) { const float p = __expf(sacc[kt][r] - mx); sacc[kt][r] = p; sum += p; }
            sum = xsum4(sum); const float inv = 1.f / (sum + __expf(sink - mx));
            f32x4 oacc[4];
#pragma unroll
            for (int dt = 0; dt < 4; ++dt) oacc[dt] = (f32x4){0.f, 0.f, 0.f, 0.f};
#pragma unroll
            for (int ks = 0; ks < 5; ++ks) { const bf16x8 pf = pack8(sacc[2 * ks], sacc[2 * ks + 1]);
#pragma unroll
                for (int dt = 0; dt < 4; ++dt) oacc[dt] = mfma16(trfrag(Vimg, SWA_VSTRIDE, j0 + 32 * ks + 4 * hq, j0 + 32 * ks + 16 + 4 * hq, 16 * dt, lane), pf, oacc[dt]); }
            float sq = 0.f; float* op = OSWA + (size_t)(b * SEQ + q0 + j0 + c) * SWA_W + head * 64 + 4 * hq;
#pragma unroll
            for (int dt = 0; dt < 4; ++dt) { const f32x4 o = oacc[dt] * inv; sq += (o.x * o.x + o.y * o.y) + (o.z * o.z + o.w * o.w); *(GAS f32x4*)(op + 16 * dt) = o; }
            if (qt == 0) ssq0 += sq; else ssq1 += sq;
        }
    }
    ssq0 = xsum4(ssq0); ssq1 = xsum4(ssq1);
    if (hq == 0) { ssqx[w * 32 + c] = ssq0; ssqx[w * 32 + 16 + c] = ssq1; }
    asm volatile("s_waitcnt vmcnt(0)" ::: "memory");
    __syncthreads();
    const float* swa_norm = C.in[I_SWA_NORM] + (size_t)l * SWA_W;
#pragma nounroll
    for (int qt = 0; qt < 2; ++qt) { const int qi = 16 * qt + c;
        const float tot = ssqx[(qhalf + 0) * 32 + qi] + ssqx[(qhalf + 2) * 32 + qi] + ssqx[(qhalf + 4) * 32 + qi] + ssqx[(qhalf + 6) * 32 + qi];
        const float rstd = 1.f / sqrtf(tot * (1.f / 1024.f) + EPS);
        const size_t row = (size_t)(b * SEQ + q0 + 32 * qhalf + qi);
#pragma unroll
        for (int kvh = 0; kvh < 4; ++kvh)
#pragma unroll
            for (int dt = 0; dt < 4; ++dt) { const int col = (kvh * 4 + g) * 64 + 16 * dt + 4 * hq; const f32x4 o = *(const GAS f32x4*)(OSWA + row * SWA_W + col); const f32x4 gn = *(const GAS f32x4*)(swa_norm + col);
                v2u ow; ow.x = pk2(o.x * rstd * gn.x, o.y * rstd * gn.y); ow.y = pk2(o.z * rstd * gn.z, o.w * rstd * gn.w); *(GAS v2u*)(Y + row * DM + 2048 + col) = ow; } }
}

constexpr int N_SWA_UNITS = BATCH * (SEQ / 64);

constexpr int SSD_L = 128, SSD_NC = SEQ / SSD_L, GLA_L = 64, GLA_NC = SEQ / GLA_L;
constexpr int N_SSD_CU = BATCH * SSD_NC * 8, N_GLA_CU = BATCH * GLA_NC * 4;
constexpr int XI_STRIDE = 528, BI_STRIDE = 272;

__device__ __forceinline__ void prep_phase(Ctx& C, int l) {
    const bf16* PROJ = (const bf16*)(C.ws + WS_PROJ); bf16* XBC = (bf16*)(C.ws + WS_XBC);
    const int tid = C.tid, lane = C.lane;
    { const int gw0 = C.bid * NWAVES + C.wave;
      for (int gw = gw0; gw < BATCH * SSD_NC * 16; gw += C.G * NWAVES) if ((gw & 15) == 0 && lane < SSD_H) {
          const int bc = gw >> 4; const size_t row0 = (size_t)bc * SSD_L;
          float* DT = (float*)(C.ws + WS_DT); float* ACS = (float*)(C.ws + WS_ACS); float* DEC = (float*)(C.ws + WS_DEC);
          const float dtb = C.in[I_SSD_DT_BIAS][l * SSD_H + lane], Ah = -expf(C.in[I_SSD_A_LOG][l * SSD_H + lane]);
          float cs = 0.f;
#pragma unroll 8
          for (int s = 0; s < SSD_L; ++s) { const float xr = bf1(PROJ[(row0 + s) * DINP + C_DT + lane]) + dtb; const float dt = xr > 20.f ? xr : log1pf(expf(xr)); cs += dt * Ah;
              DT[(row0 + s) * SSD_H + lane] = dt; ACS[(row0 + s) * SSD_H + lane] = cs; }
          DEC[bc * SSD_H + lane] = expf(cs);
      } }
    { const float* conv_w = C.in[I_SSD_CONV_W] + (size_t)l * 4 * SSD_CD; const float* conv_b = C.in[I_SSD_CONV_B] + (size_t)l * SSD_CD;
      const float* HT = (const float*)(C.ws + WS_XHT); const float* HB = (const float*)(C.ws + WS_XHB);
      constexpr int NIT = (M / 64) * 3 * 1024;
      for (int it = C.bid * NTHR + tid; it < NIT; it += C.G * NTHR) {
          const int c4 = it & 1023, ri = it >> 10, i = ri % 3, blk = ri / 3, c0 = 4 * c4; const bool first = (blk % (SEQ / 64)) == 0;
          f32x4 sq[6]; const f32x4 z4 = (f32x4){0.f, 0.f, 0.f, 0.f};
#pragma unroll
          for (int j = 0; j < 3; ++j) { sq[j] = first ? z4 : *(const GAS f32x4*)(HB + ((size_t)(blk - 1) * 3 + j) * 4096 + c0); sq[3 + j] = *(const GAS f32x4*)(HT + ((size_t)blk * 3 + j) * 4096 + c0); }
          const f32x4 x3 = i == 0 ? sq[0] : (i == 1 ? sq[1] : sq[2]), x2 = i == 0 ? sq[1] : (i == 1 ? sq[2] : sq[3]), x1 = i == 0 ? sq[2] : (i == 1 ? sq[3] : sq[4]), x0 = i == 0 ? sq[3] : (i == 1 ? sq[4] : sq[5]);
          const f32x4 w0 = *(const GAS f32x4*)(conv_w + c0), w1 = *(const GAS f32x4*)(conv_w + 4096 + c0), w2 = *(const GAS f32x4*)(conv_w + 2 * 4096 + c0), w3 = *(const GAS f32x4*)(conv_w + 3 * 4096 + c0), bb = *(const GAS f32x4*)(conv_b + c0);
          f32x4 o;
#pragma unroll
          for (int e = 0; e < 4; ++e) o[e] = silu_f(bb[e] + w0[e] * x3[e] + w1[e] * x2[e] + w2[e] * x1[e] + w3[e] * x0[e]);
          v2u ow; ow.x = pk2(o.x, o.y); ow.y = pk2(o.z, o.w); *(GAS v2u*)(XBC + (size_t)(64 * blk + i) * SSD_CD + c0) = ow;
      } }
    { LAS float* glr = (LAS float*)C.lds;
      bf16* QD = (bf16*)(C.ws + WS_QD); bf16* KI = (bf16*)(C.ws + WS_KI); float* GDEC = (float*)(C.ws + WS_GDEC);
      const float* w_gate = C.in[I_GLA_W_GATE] + (size_t)l * 16 * GLA_KT; const float bgv = C.in[I_GLA_B_GATE][l * GLA_KT + tid];
      float wg[16];
#pragma unroll
      for (int r = 0; r < 16; ++r) wg[r] = w_gate[r * GLA_KT + tid];
      for (int ck = C.bid; ck < BATCH * GLA_NC; ck += C.G) {
          const size_t row0 = (size_t)ck * GLA_L;
          __syncthreads();
          if (tid < 128) { const int t = tid >> 1, hf = tid & 1; const v4u r = *(const GAS v4u*)(PROJ + (row0 + t) * DINP + C_GLR + 8 * hf);
              *(LAS f32x4*)(glr + t * 16 + 8 * hf) = (f32x4){bflo(r.x), bfhi(r.x), bflo(r.y), bfhi(r.y)}; *(LAS f32x4*)(glr + t * 16 + 8 * hf + 4) = (f32x4){bflo(r.z), bfhi(r.z), bflo(r.w), bfhi(r.w)}; }
          __syncthreads();
          float cum = 0.f;
#pragma unroll 8
          for (int t = 0; t < GLA_L; ++t) {
              const float qv = bf1(PROJ[(row0 + t) * DINP + C_GQ + tid]), kv = bf1(PROJ[(row0 + t) * DINP + C_GK + tid]);
              float z = bgv;
#pragma unroll
              for (int r4 = 0; r4 < 4; ++r4) { const f32x4 gv = *(const LAS f32x4*)(glr + t * 16 + 4 * r4); z += gv.x * wg[4 * r4] + gv.y * wg[4 * r4 + 1] + gv.z * wg[4 * r4 + 2] + gv.w * wg[4 * r4 + 3]; }
              const float ls = fminf(z, 0.f) - __logf(1.f + __expf(-fabsf(z))); cum += ls * 0.0625f;
              QD[(row0 + t) * GLA_KT + tid] = (bf16)f2bf(qv * 0.08838834764831845f * __expf(cum)); KI[(row0 + t) * GLA_KT + tid] = (bf16)f2bf(kv * __expf(-cum));
          }
          GDEC[(size_t)ck * GLA_KT + tid] = __expf(cum);
      } }
}

__device__ __forceinline__ void gla_c1_unit(Ctx& C, int unit) {
    const int h = unit & 3, ck = unit >> 2; const size_t row0 = (size_t)ck * GLA_L;
    const int tid = C.tid, lane = C.lane, w = C.wave, c = lane & 15, hq = lane >> 4;
    LAS unsigned char* KEimg = C.lds; LAS unsigned char* Vimg = C.lds + 64 * BI_STRIDE;
    const bf16* PROJ = (const bf16*)(C.ws + WS_PROJ); const bf16* KI = (const bf16*)(C.ws + WS_KI); const float* GDEC = (const float*)(C.ws + WS_GDEC); bf16* GST = (bf16*)(C.ws + WS_GST);
    __syncthreads();
    { const int cg = tid & 15; const f32x4 d0 = *(const GAS f32x4*)(GDEC + (size_t)ck * GLA_KT + h * 128 + 8 * cg), d1 = *(const GAS f32x4*)(GDEC + (size_t)ck * GLA_KT + h * 128 + 8 * cg + 4);
#pragma unroll
      for (int it = 0; it < 2; ++it) { const int t = (tid + NTHR * it) >> 4; const v4u r = *(const GAS v4u*)(KI + (row0 + t) * GLA_KT + h * 128 + 8 * cg);
          v4u o; o.x = pk2(bflo(r.x) * d0.x, bfhi(r.x) * d0.y); o.y = pk2(bflo(r.y) * d0.z, bfhi(r.y) * d0.w); o.z = pk2(bflo(r.z) * d1.x, bfhi(r.z) * d1.y); o.w = pk2(bflo(r.w) * d1.z, bfhi(r.w) * d1.w);
          *(LAS v4u*)(KEimg + t * BI_STRIDE + 16 * cg) = o; } }
#pragma unroll
    for (int it = 0; it < 4; ++it) { const int idx = tid + NTHR * it, t = idx >> 5, cg = idx & 31; *(LAS v4u*)(Vimg + t * XI_STRIDE + 16 * cg) = *(const GAS v4u*)(PROJ + (row0 + t) * DINP + C_GV + h * 256 + 8 * cg); }
    __syncthreads();
    f32x4 acc[16];
#pragma unroll
    for (int nt = 0; nt < 16; ++nt) acc[nt] = (f32x4){0.f, 0.f, 0.f, 0.f};
#pragma unroll
    for (int ks = 0; ks < 2; ++ks) { const bf16x8 af = trfrag(KEimg, BI_STRIDE, 32 * ks + 8 * hq, 32 * ks + 8 * hq + 4, 16 * w, lane);
#pragma unroll
        for (int nt = 0; nt < 16; ++nt) acc[nt] = mfma16(af, trfrag(Vimg, XI_STRIDE, 32 * ks + 8 * hq, 32 * ks + 8 * hq + 4, 16 * nt, lane), acc[nt]); }
    bf16* gp = GST + (size_t)unit * 32768 + 16 * w + 4 * hq;
#pragma unroll
    for (int nt = 0; nt < 16; ++nt) { v2u o; o.x = pk2(acc[nt].x, acc[nt].y); o.y = pk2(acc[nt].z, acc[nt].w); *(GAS v2u*)(gp + (size_t)(16 * nt + c) * 128) = o; }
}

__device__ __forceinline__ void scan_phase(Ctx& C) {
    const bf16* GST = (const bf16*)(C.ws + WS_GST); bf16* GPV = (bf16*)(C.ws + WS_GPV); const float* GDEC = (const float*)(C.ws + WS_GDEC);
    const bf16* ST = (const bf16*)(C.ws + WS_ST); bf16* PV = (bf16*)(C.ws + WS_PV); const float* DEC = (const float*)(C.ws + WS_DEC);
    constexpr int N_G = BATCH * 4 * 256 * 32, N_S = BATCH * SSD_H * 64 * 32;
    for (int it = C.bid * NTHR + C.tid; it < N_G + N_S; it += C.G * NTHR) {
        if (it < N_S) {
            const int n4 = it & 31, p = (it >> 5) & 63, h = (it >> 11) & 31, b = it >> 16;
            f32x4 run = (f32x4){0.f, 0.f, 0.f, 0.f};
#pragma unroll 8
            for (int c = 0; c < SSD_NC; ++c) { const size_t u = (size_t)(b * SSD_NC + c) * SSD_H + h; const size_t off = u * 8192 + p * 128 + 4 * n4;
                const v2u xr = *(const GAS v2u*)(ST + off); const f32x4 x = (f32x4){bflo(xr.x), bfhi(xr.x), bflo(xr.y), bfhi(xr.y)}; const float d = DEC[u];
                v2u o; o.x = pk2(run.x, run.y); o.y = pk2(run.z, run.w); *(GAS v2u*)(PV + off) = o;
                run = run * d + x; }
        } else {
            const int i2 = it - N_S; const int k4 = i2 & 31, v = (i2 >> 5) & 255, h = (i2 >> 13) & 3, b = i2 >> 15;
            f32x4 run = (f32x4){0.f, 0.f, 0.f, 0.f};
#pragma unroll 8
            for (int c = 0; c < GLA_NC; ++c) { const size_t ck = (size_t)(b * GLA_NC + c); const size_t off = (ck * 4 + h) * 32768 + v * 128 + 4 * k4;
                const v2u xr = *(const GAS v2u*)(GST + off); const f32x4 x = (f32x4){bflo(xr.x), bfhi(xr.x), bflo(xr.y), bfhi(xr.y)}; const f32x4 d = *(const GAS f32x4*)(GDEC + ck * GLA_KT + h * 128 + 4 * k4);
                v2u o; o.x = pk2(run.x, run.y); o.y = pk2(run.z, run.w); *(GAS v2u*)(GPV + off) = o;
                run = run * d + x; }
        }
    }
}

constexpr int GC3_GP_OFF = 64 * XI_STRIDE, GC3_XCH_OFF = GC3_GP_OFF + 256 * BI_STRIDE;
__device__ __forceinline__ void gla_c3_unit(Ctx& C, int l, int unit) {
    const int h = unit & 3, ck = unit >> 2; const size_t row0 = (size_t)ck * GLA_L;
    const int tid = C.tid, lane = C.lane, w = C.wave, c = lane & 15, hq = lane >> 4;
    LAS unsigned char* Vimg = C.lds; LAS unsigned char* GPimg = C.lds + GC3_GP_OFF; LAS float* xch = (LAS float*)(C.lds + GC3_XCH_OFF);
    const bf16* PROJ = (const bf16*)(C.ws + WS_PROJ); const bf16* QD = (const bf16*)(C.ws + WS_QD); const bf16* KI = (const bf16*)(C.ws + WS_KI); const bf16* GPV = (const bf16*)(C.ws + WS_GPV); bf16* Y = (bf16*)(C.ws + WS_Y);
    const int lt = w >> 1, vh = w & 1; const size_t row = row0 + 16 * lt + c;
    __syncthreads();
    { const bf16* gpv = GPV + (size_t)unit * 32768;
      v4u tv[4], tg[8];
#pragma unroll
      for (int it = 0; it < 4; ++it) { const int idx = tid + NTHR * it, t = idx >> 5, cg = idx & 31; tv[it] = *(const GAS v4u*)(PROJ + (row0 + t) * DINP + C_GV + h * 256 + 8 * cg); }
#pragma unroll
      for (int it = 0; it < 8; ++it) { const int idx = tid + NTHR * it; tg[it] = *(const GAS v4u*)(gpv + (size_t)idx * 8); }
#pragma unroll
      for (int it = 0; it < 4; ++it) { const int idx = tid + NTHR * it, t = idx >> 5, cg = idx & 31; *(LAS v4u*)(Vimg + t * XI_STRIDE + 16 * cg) = tv[it]; }
#pragma unroll
      for (int it = 0; it < 8; ++it) { const int idx = tid + NTHR * it, v = idx >> 4, cg = idx & 15; *(LAS v4u*)(GPimg + v * BI_STRIDE + 16 * cg) = tg[it]; } }
    bf16x8 qf[4];
#pragma unroll
    for (int ks = 0; ks < 4; ++ks) qf[ks] = gfrag(QD + row0 * GLA_KT + h * 128, GLA_KT, 16 * lt, 32 * ks, lane);
    v2u ggv[8];
#pragma unroll
    for (int vt = 0; vt < 8; ++vt) ggv[vt] = *(const GAS v2u*)(PROJ + row * DINP + C_GG + h * 256 + 16 * (8 * vh + vt) + 4 * hq);
    f32x4 att[4];
#pragma unroll
    for (int st = 0; st < 4; ++st) { f32x4 a = (f32x4){0.f, 0.f, 0.f, 0.f};
        if (st <= lt) {
#pragma unroll
            for (int ks = 0; ks < 4; ++ks) a = mfma16(gfrag(KI + row0 * GLA_KT + h * 128, GLA_KT, 16 * st, 32 * ks, lane), qf[ks], a);
#pragma unroll
            for (int r = 0; r < 4; ++r) if (16 * st + 4 * hq + r > 16 * lt + c) a[r] = 0.f;
        }
        att[st] = a; }
    __syncthreads();
    f32x4 oacc[8];
#pragma unroll
    for (int vt = 0; vt < 8; ++vt) oacc[vt] = (f32x4){0.f, 0.f, 0.f, 0.f};
#pragma unroll
    for (int ks = 0; ks < 4; ++ks)
#pragma unroll
        for (int vt = 0; vt < 8; ++vt) oacc[vt] = mfma16(*(const LAS bf16x8*)(GPimg + (16 * (8 * vh + vt) + c) * BI_STRIDE + (32 * ks + 8 * hq) * 2), qf[ks], oacc[vt]);
#pragma unroll
    for (int ks2 = 0; ks2 < 2; ++ks2) { const bf16x8 pf = pack8(att[2 * ks2], att[2 * ks2 + 1]);
#pragma unroll
        for (int vt = 0; vt < 8; ++vt) oacc[vt] = mfma16(trfrag(Vimg, XI_STRIDE, 32 * ks2 + 4 * hq, 32 * ks2 + 16 + 4 * hq, 16 * (8 * vh + vt), lane), pf, oacc[vt]); }
    float ssq = 0.f;
#pragma unroll
    for (int vt = 0; vt < 8; ++vt) ssq += (oacc[vt].x * oacc[vt].x + oacc[vt].y * oacc[vt].y) + (oacc[vt].z * oacc[vt].z + oacc[vt].w * oacc[vt].w);
    ssq = xsum4(ssq);
    if (hq == 0) xch[w * 16 + c] = ssq;
    __syncthreads();
    const float rstd = 1.f / sqrtf((xch[w * 16 + c] + xch[(w ^ 1) * 16 + c]) * (1.f / 256.f) + EPS);
    const float* gla_norm = C.in[I_GLA_NORM] + (size_t)l * 256;
#pragma unroll
    for (int vt = 0; vt < 8; ++vt) { const int v0 = 16 * (8 * vh + vt) + 4 * hq; const f32x4 gn = *(const GAS f32x4*)(gla_norm + v0); const v2u gg = ggv[vt];
        const f32x4 o = oacc[vt]; v2u ow; ow.x = pk2(o.x * rstd * gn.x * silu_f(bflo(gg.x)), o.y * rstd * gn.y * silu_f(bfhi(gg.x))); ow.y = pk2(o.z * rstd * gn.z * silu_f(bflo(gg.y)), o.w * rstd * gn.w * silu_f(bfhi(gg.y)));
        *(GAS v2u*)(Y + row * DM + 3072 + h * 256 + v0) = ow; }
}

__device__ __forceinline__ void ssd_c1_unit(Ctx& C, int unit) {
    const int g = unit & 7, bc = unit >> 3; const size_t row0 = (size_t)bc * SSD_L;
    const int tid = C.tid, lane = C.lane, w = C.wave, c = lane & 15, hq = lane >> 4;
    LAS float* acs = (LAS float*)C.lds; LAS float* dts = acs + 512;
    LAS unsigned char* XWimg = C.lds + 4096; LAS unsigned char* Bimg = C.lds + 4096 + 128 * XI_STRIDE;
    const bf16* XBC = (const bf16*)(C.ws + WS_XBC); const float* DT = (const float*)(C.ws + WS_DT); const float* ACS = (const float*)(C.ws + WS_ACS); bf16* ST = (bf16*)(C.ws + WS_ST);
    __syncthreads();
    { const int t = tid >> 2, hh = tid & 3; acs[hh * 128 + t] = ACS[(row0 + t) * SSD_H + 4 * g + hh]; dts[hh * 128 + t] = DT[(row0 + t) * SSD_H + 4 * g + hh]; }
    __syncthreads();
#pragma unroll
    for (int it = 0; it < 8; ++it) { const int idx = tid + NTHR * it, t = idx >> 5, cg = idx & 31, hh = cg >> 3; const float wgt = __expf(acs[hh * 128 + 127] - acs[hh * 128 + t]) * dts[hh * 128 + t];
        const v4u r = *(const GAS v4u*)(XBC + (row0 + t) * SSD_CD + g * 256 + 8 * cg);
        v4u o; o.x = pk2(bflo(r.x) * wgt, bfhi(r.x) * wgt); o.y = pk2(bflo(r.y) * wgt, bfhi(r.y) * wgt); o.z = pk2(bflo(r.z) * wgt, bfhi(r.z) * wgt); o.w = pk2(bflo(r.w) * wgt, bfhi(r.w) * wgt);
        *(LAS v4u*)(XWimg + t * XI_STRIDE + 16 * cg) = o; }
#pragma unroll
    for (int it = 0; it < 4; ++it) { const int idx = tid + NTHR * it, t = idx >> 4, cg = idx & 15; *(LAS v4u*)(Bimg + t * BI_STRIDE + 16 * cg) = *(const GAS v4u*)(XBC + (row0 + t) * SSD_CD + 2048 + g * 128 + 8 * cg); }
    __syncthreads();
    const int hh = w >> 1, ph = w & 1;
    f32x4 acc[8][2];
#pragma unroll
    for (int mt = 0; mt < 8; ++mt) { acc[mt][0] = (f32x4){0.f, 0.f, 0.f, 0.f}; acc[mt][1] = (f32x4){0.f, 0.f, 0.f, 0.f}; }
#pragma unroll
    for (int ks = 0; ks < 4; ++ks) { const int r0 = 32 * ks + 8 * hq;
        const bf16x8 x0 = trfrag(XWimg, XI_STRIDE, r0, r0 + 4, hh * 64 + 32 * ph, lane), x1 = trfrag(XWimg, XI_STRIDE, r0, r0 + 4, hh * 64 + 32 * ph + 16, lane);
#pragma unroll
        for (int mt = 0; mt < 8; ++mt) { const bf16x8 bf = trfrag(Bimg, BI_STRIDE, r0, r0 + 4, 16 * mt, lane); acc[mt][0] = mfma16(bf, x0, acc[mt][0]); acc[mt][1] = mfma16(bf, x1, acc[mt][1]); } }
    bf16* sp = ST + ((size_t)bc * SSD_H + 4 * g + hh) * 8192 + 4 * hq;
#pragma unroll
    for (int mt = 0; mt < 8; ++mt)
#pragma unroll
        for (int pt = 0; pt < 2; ++pt) { v2u o; o.x = pk2(acc[mt][pt].x, acc[mt][pt].y); o.y = pk2(acc[mt][pt].z, acc[mt][pt].w); *(GAS v2u*)(sp + (size_t)(32 * ph + 16 * pt + c) * 128 + 16 * mt) = o; }
}

constexpr int SC3_X_OFF = 4096, SC3_PV_OFF = SC3_X_OFF + 128 * XI_STRIDE, SC3_PV_HEAD = 64 * BI_STRIDE;
static_assert(SC3_PV_OFF + 4 * SC3_PV_HEAD <= MISC_OFF && GC3_XCH_OFF + 512 <= MISC_OFF, "mixer LDS maps");
__device__ __forceinline__ void ssd_c3_unit(Ctx& C, int l, int unit) {
    const int g = unit & 7, bc = unit >> 3; const size_t row0 = (size_t)bc * SSD_L;
    const int tid = C.tid, lane = C.lane, w = C.wave, c = lane & 15, hq = lane >> 4;
    LAS float* acs = (LAS float*)C.lds; LAS float* dts = acs + 512;
    LAS unsigned char* Ximg = C.lds + SC3_X_OFF; LAS unsigned char* PVimg = C.lds + SC3_PV_OFF;
    const bf16* PROJ = (const bf16*)(C.ws + WS_PROJ); const bf16* XBC = (const bf16*)(C.ws + WS_XBC); const float* DT = (const float*)(C.ws + WS_DT); const float* ACS = (const float*)(C.ws + WS_ACS);
    const bf16* PV = (const bf16*)(C.ws + WS_PV); bf16* Y = (bf16*)(C.ws + WS_Y);
    const int tl = 16 * w + c; const size_t row = row0 + tl;
    __syncthreads();
    { const int t = tid >> 2, hh = tid & 3; const float a0 = ACS[(row0 + t) * SSD_H + 4 * g + hh], d0 = DT[(row0 + t) * SSD_H + 4 * g + hh];
      const bf16* pvb = PV + ((size_t)bc * SSD_H + 4 * g) * 8192;
      v4u tx[8], tp[8];
#pragma unroll
      for (int it = 0; it < 8; ++it) { const int idx = tid + NTHR * it, t2 = idx >> 5, cg = idx & 31; tx[it] = *(const GAS v4u*)(XBC + (row0 + t2) * SSD_CD + g * 256 + 8 * cg); }
#pragma unroll
      for (int it = 0; it < 8; ++it) { const int idx = tid + NTHR * it; tp[it] = *(const GAS v4u*)(pvb + (size_t)idx * 8); }
      acs[(tid & 3) * 128 + (tid >> 2)] = a0; dts[(tid & 3) * 128 + (tid >> 2)] = d0;
#pragma unroll
      for (int it = 0; it < 8; ++it) { const int idx = tid + NTHR * it, t2 = idx >> 5, cg = idx & 31; *(LAS v4u*)(Ximg + t2 * XI_STRIDE + 16 * cg) = tx[it]; }
#pragma unroll
      for (int it = 0; it < 8; ++it) { const int idx = tid + NTHR * it, pr = idx >> 4, cg = idx & 15; *(LAS v4u*)(PVimg + pr * BI_STRIDE + 16 * cg) = tp[it]; } }
    bf16x8 cf[4];
#pragma unroll
    for (int ks = 0; ks < 4; ++ks) cf[ks] = gfrag(XBC + row0 * SSD_CD + 3072 + g * 128, SSD_CD, 16 * w, 32 * ks, lane);
    f32x4 cb[8];
#pragma unroll
    for (int st = 0; st < 8; ++st) { f32x4 a = (f32x4){0.f, 0.f, 0.f, 0.f};
        if (st <= w) {
#pragma unroll
            for (int ks = 0; ks < 4; ++ks) a = mfma16(gfrag(XBC + row0 * SSD_CD + 2048 + g * 128, SSD_CD, 16 * st, 32 * ks, lane), cf[ks], a);
        }
        cb[st] = a; }
    __syncthreads();
    v2u yk[4][4];
    float ssq = 0.f;
#pragma unroll
    for (int hh = 0; hh < 4; ++hh) {
        v2u zz[4];
#pragma unroll
        for (int pt = 0; pt < 4; ++pt) zz[pt] = *(const GAS v2u*)(PROJ + row * DINP + C_Z + g * 256 + hh * 64 + 16 * pt + 4 * hq);
        const float acs_l = acs[hh * 128 + tl], el = __expf(acs_l);
        f32x4 ya[4];
#pragma unroll
        for (int pt = 0; pt < 4; ++pt) ya[pt] = (f32x4){0.f, 0.f, 0.f, 0.f};
#pragma unroll
        for (int ks = 0; ks < 4; ++ks)
#pragma unroll
            for (int pt = 0; pt < 4; ++pt) ya[pt] = mfma16(*(const LAS bf16x8*)(PVimg + (hh * 64 + 16 * pt + c) * BI_STRIDE + (32 * ks + 8 * hq) * 2), cf[ks], ya[pt]);
#pragma unroll
        for (int pt = 0; pt < 4; ++pt) ya[pt] = ya[pt] * el;
#pragma unroll
        for (int ks2 = 0; ks2 < 4; ++ks2) {
            if (2 * ks2 <= w) {
                f32x4 lm[2];
#pragma unroll
                for (int t2 = 0; t2 < 2; ++t2) { const int s0 = 32 * ks2 + 16 * t2 + 4 * hq; const f32x4 as4 = *(const LAS f32x4*)(acs + hh * 128 + s0), dt4 = *(const LAS f32x4*)(dts + hh * 128 + s0);
#pragma unroll
                    for (int r = 0; r < 4; ++r) { const float d = fminf(acs_l - as4[r], 0.f); lm[t2][r] = (s0 + r <= tl) ? cb[2 * ks2 + t2][r] * __expf(d) * dt4[r] : 0.f; } }
                const bf16x8 pf = pack8(lm[0], lm[1]);
#pragma unroll
                for (int pt = 0; pt < 4; ++pt) ya[pt] = mfma16(trfrag(Ximg, XI_STRIDE, 32 * ks2 + 4 * hq, 32 * ks2 + 16 + 4 * hq, hh * 64 + 16 * pt, lane), pf, ya[pt]);
            }
        }
        const float Dh = C.in[I_SSD_D][l * SSD_H + 4 * g + hh];
#pragma unroll
        for (int pt = 0; pt < 4; ++pt) { const int col = hh * 64 + 16 * pt + 4 * hq; const v2u xw = *(const LAS v2u*)(Ximg + tl * XI_STRIDE + col * 2); const v2u z2 = zz[pt];
            f32x4 v; v.x = (ya[pt].x + Dh * bflo(xw.x)) * silu_f(bflo(z2.x)); v.y = (ya[pt].y + Dh * bfhi(xw.x)) * silu_f(bfhi(z2.x)); v.z = (ya[pt].z + Dh * bflo(xw.y)) * silu_f(bflo(z2.y)); v.w = (ya[pt].w + Dh * bfhi(xw.y)) * silu_f(bfhi(z2.y));
            { v2u pk; pk.x = pk2(v.x, v.y); pk.y = pk2(v.z, v.w); yk[hh][pt] = pk; } ssq += (v.x * v.x + v.y * v.y) + (v.z * v.z + v.w * v.w); }
    }
    ssq = xsum4(ssq);
    const float rstd = 1.f / sqrtf(ssq * (1.f / 256.f) + EPS);
    const float* ssd_norm = C.in[I_SSD_NORM] + (size_t)l * SSD_W + g * 256;
#pragma unroll
    for (int hh = 0; hh < 4; ++hh)
#pragma unroll
        for (int pt = 0; pt < 4; ++pt) { const int col = hh * 64 + 16 * pt + 4 * hq; const f32x4 gn = *(const GAS f32x4*)(ssd_norm + col); const f32x4 v = (f32x4){bflo(yk[hh][pt].x), bfhi(yk[hh][pt].x), bflo(yk[hh][pt].y), bfhi(yk[hh][pt].y)};
            v2u ow; ow.x = pk2(v.x * rstd * gn.x, v.y * rstd * gn.y); ow.y = pk2(v.z * rstd * gn.z, v.w * rstd * gn.w); *(GAS v2u*)(Y + row * DM + g * 256 + col) = ow; }
}

__device__ __forceinline__ void mix_c1_phase(Ctx& C, int l) {
    for (int u = C.bid; u < N_SSD_CU; u += C.G) ssd_c1_unit(C, u);
    for (int u = C.bid; u < N_GLA_CU; u += C.G) gla_c1_unit(C, u);
    for (int u = C.bid; u < N_SWA_UNITS; u += C.G) swa_unit_mfma(C, l, u);
}
__device__ __forceinline__ void mix_c3_phase(Ctx& C, int l) {
    for (int u = C.bid; u < N_SSD_CU; u += C.G) ssd_c3_unit(C, l, u);
    for (int u = C.bid; u < N_GLA_CU; u += C.G) gla_c3_unit(C, l, u);
}

__device__ __forceinline__ void act_fixup_phase(Ctx& C, int l) {
    bf16* ACT = (bf16*)(C.ws + WS_ACT); const float* HTG = (const float*)(C.ws + WS_HTG); const float* HTU = (const float*)(C.ws + WS_HTU); const float* HBG = (const float*)(C.ws + WS_HBG);
    const float* cw = C.in[I_FFN_CONV_W] + (size_t)l * 3 * DFF; const float* cb = C.in[I_FFN_CONV_B] + (size_t)l * DFF;
    constexpr int NC4 = DFF / 4, NIT = (M / 64) * 2 * NC4;
    for (int it = C.bid * NTHR + C.tid; it < NIT; it += C.G * NTHR) {
        const int c4 = it % NC4, ri = it / NC4, i = ri & 1, blk = ri >> 1, c0 = 4 * c4; const bool first = (blk % (SEQ / 64)) == 0;
        const f32x4 z4 = (f32x4){0.f, 0.f, 0.f, 0.f};
        const f32x4 g0 = *(const GAS f32x4*)(HTG + ((size_t)blk * 2 + i) * DFF + c0), up = *(const GAS f32x4*)(HTU + ((size_t)blk * 2 + i) * DFF + c0);
        const f32x4 pb1 = first ? z4 : *(const GAS f32x4*)(HBG + ((size_t)(blk - 1) * 2 + 1) * DFF + c0), pb0 = first ? z4 : *(const GAS f32x4*)(HBG + ((size_t)(blk - 1) * 2 + 0) * DFF + c0);
        const f32x4 g1 = i ? *(const GAS f32x4*)(HTG + ((size_t)blk * 2 + 0) * DFF + c0) : pb1, g2 = i ? pb1 : pb0;
        const f32x4 w0 = *(const GAS f32x4*)(cw + c0), w1 = *(const GAS f32x4*)(cw + DFF + c0), w2 = *(const GAS f32x4*)(cw + 2 * DFF + c0), bb = *(const GAS f32x4*)(cb + c0);
        f32x4 o;
#pragma unroll
        for (int e = 0; e < 4; ++e) { const float gc = bb[e] + w0[e] * g2[e] + w1[e] * g1[e] + w2[e] * g0[e]; o[e] = silu_f(gc) * up[e]; }
        v2u ow; ow.x = pk2(o.x, o.y); ow.y = pk2(o.z, o.w); *(GAS v2u*)(ACT + (size_t)(64 * blk + i) * DFF + c0) = ow;
    }
}

constexpr int PH_PER_LAYER = 11, PH_FINAL = DEPTH * PH_PER_LAYER, N_PHASES = PH_FINAL + 1;
#ifndef WGM_DOWN
#define WGM_DOWN 4
#endif
#ifndef MK_ONE_LAUNCH
#define MK_ONE_LAUNCH 1
#endif
__global__ void __launch_bounds__(NTHR, 2) fwd_kernel(Args args) {
    extern __shared__ __attribute__((aligned(16))) unsigned char lds[];
    Ctx C;
    C.lds = (LAS unsigned char*)lds;
    C.tid = threadIdx.x; C.lane = C.tid & 63; C.wave = __builtin_amdgcn_readfirstlane(C.tid >> 6);
    C.G = gridDim.x; C.bid = blockIdx.x;
    C.in = args.in; C.out = args.out; C.ws = args.ws;
    volatile LAS unsigned* MISC = (volatile LAS unsigned*)(C.lds + MISC_OFF);
    for (int u = C.tid; u < (LDS_BYTES - MISC_OFF) / 4; u += NTHR) ((LAS unsigned*)(C.lds + MISC_OFF))[u] = 0u;
    __syncthreads();
    gu32* ctl = (gu32*)(args.ws + WS_CTL);
    XcdBarrier bar = xcd_barrier_post((unsigned*)(ctl + CW_BAR) + args.li * XCD_BAR_WORDS, MISC + 8);
    const int lo = args.ph_lo, hi = args.ph_hi;
#define IN(k) (lo <= (k) && (k) < hi)
#define SEAM(k) do { if (IN(k) && IN((k) + 1)) xcd_barrier(bar); } while (0)
    float* xres = args.out;
    bf16* H = (bf16*)(args.ws + WS_H);
#define LAYER_BODY(l) do { \
        const int pb = l * PH_PER_LAYER; \
        const float* xin = (l == 0) ? args.in[I_X] : (const float*)xres; \
        if (IN(pb + 0)) { convert_weights(C, l); rmsnorm_phase(C, xin, args.in[I_ATTN_NORM] + (size_t)l * DM, H); } \
        SEAM(pb + 0); \
        if (IN(pb + 1)) { \
            pg8::Gemm g{H, (const bf16*)(args.ws + WS_WIN), M, DINP, DM}; pg8::StaticOrder S; S.init(M, DINP, C.G, C.bid); \
            pg8::EpiProjConv E{(bf16*)(args.ws + WS_PROJ), DINP, (bf16*)(args.ws + WS_XBC), args.in[I_SSD_CONV_W] + (size_t)l * 4 * SSD_CD, args.in[I_SSD_CONV_B] + (size_t)l * SSD_CD, (float*)(args.ws + WS_XHT), (float*)(args.ws + WS_XHB)}; \
            pg8::gemm_phase<pg8::EpiProjConv, pg8::StaticOrder, true, true>(C.lds, g, S, E); \
        } \
        SEAM(pb + 1); \
        if (IN(pb + 2)) prep_phase(C, l); \
        SEAM(pb + 2); \
        if (IN(pb + 3)) mix_c1_phase(C, l); \
        SEAM(pb + 3); \
        if (IN(pb + 4)) scan_phase(C); \
        SEAM(pb + 4); \
        if (IN(pb + 5)) mix_c3_phase(C, l); \
        SEAM(pb + 5); \
        if (IN(pb + 6)) { \
            pg8::Gemm g{(const bf16*)(args.ws + WS_Y), (const bf16*)(args.ws + WS_WOUT), M, DM, DM}; pg8::StaticOrder S; S.init(M, DM, C.G, C.bid); \
            pg8::EpiRes E{xin, xres, DM}; \
            pg8::gemm_phase<pg8::EpiRes, pg8::StaticOrder, true, true>(C.lds, g, S, E); \
        } \
        SEAM(pb + 6); \
        if (IN(pb + 7)) rmsnorm_phase(C, xres, args.in[I_FFN_NORM] + (size_t)l * DM, H); \
        SEAM(pb + 7); \
        if (IN(pb + 8)) { \
            pg8::Gemm g{H, (const bf16*)(args.ws + WS_WGU), M, DGU, DM}; pg8::StaticOrder S; S.init(M, DGU, C.G, C.bid); \
            pg8::EpiGateUp E{(bf16*)(args.ws + WS_ACT), args.in[I_FFN_CONV_W] + (size_t)l * 3 * DFF, args.in[I_FFN_CONV_B] + (size_t)l * DFF, (float*)(args.ws + WS_HTG), (float*)(args.ws + WS_HTU), (float*)(args.ws + WS_HBG), DFF}; \
            pg8::gemm_phase<pg8::EpiGateUp, pg8::StaticOrder, true, true>(C.lds, g, S, E); \
        } \
        SEAM(pb + 8); \
        if (IN(pb + 9)) act_fixup_phase(C, l); \
        SEAM(pb + 9); \
        if (IN(pb + 10)) { \
            pg8::Gemm g{(const bf16*)(args.ws + WS_ACT), (const bf16*)(args.ws + WS_WDN), M, DM, DFF}; pg8::StaticOrder S; S.init(M, DM, C.G, C.bid, WGM_DOWN); \
            pg8::EpiRes E{xres, xres, DM}; \
            pg8::gemm_phase<pg8::EpiRes, pg8::StaticOrder, true, true>(C.lds, g, S, E); \
        } \
        SEAM(pb + 10); \
     \
    } while (0)
    LAYER_BODY(0);
    LAYER_BODY(1);
#undef LAYER_BODY
    if (IN(PH_FINAL)) final_norm_phase(C, xres, args.in[I_FINAL_NORM]);
#undef IN
#undef SEAM
}

extern "C" void kernel_launch(void* const* d_in, const int* in_sizes, int n_in, void* d_out, int out_size, void* d_ws, size_t ws_size, hipStream_t stream) {
    static int grid = 0;
    if (grid == 0) {
        if (n_in != N_IN || out_size != M * DM || ws_size < WS_END) { fprintf(stderr, "kernel_launch: unexpected shapes (n_in %d, out %d, ws %zu < %zu)\n", n_in, out_size, ws_size, (size_t)WS_END); grid = -1; return; }
        int dev = 0, cus = 0, per_cu = 0;
        if (hipGetDevice(&dev) != hipSuccess || hipDeviceGetAttribute(&cus, hipDeviceAttributeMultiprocessorCount, dev) != hipSuccess) { grid = -1; return; }
        if (hipFuncSetAttribute((const void*)fwd_kernel, hipFuncAttributeMaxDynamicSharedMemorySize, LDS_BYTES) != hipSuccess) { fprintf(stderr, "kernel_launch: hipFuncSetAttribute failed\n"); grid = -1; return; }
        if (hipOccupancyMaxActiveBlocksPerMultiprocessor(&per_cu, (const void*)fwd_kernel, NTHR, LDS_BYTES) != hipSuccess || per_cu < 1) { fprintf(stderr, "kernel_launch: occupancy query says %d\n", per_cu); (void)hipGetLastError(); grid = -1; return; }
        grid = cus;
    }
    if (grid < 0) return;
    constexpr size_t kZero = (size_t)(CW_BAR + (MK_ONE_LAUNCH ? 1 : N_PHASES) * XCD_BAR_WORDS) * sizeof(unsigned);
    static_assert(kZero <= CTL_BYTES, "control region");
    if (hipMemsetAsync((char*)d_ws + WS_CTL, 0, kZero, stream) != hipSuccess) return;
    Args a{};
    for (int i = 0; i < N_IN; ++i) a.in[i] = (const float*)d_in[i];
    a.out = (float*)d_out; a.ws = (unsigned char*)d_ws; a.pad = 0;
#if MK_ONE_LAUNCH
    a.ph_lo = 0; a.ph_hi = N_PHASES; a.li = 0;
    hipLaunchKernelGGL(fwd_kernel, dim3(grid), dim3(NTHR), LDS_BYTES, stream, a);
#else
    for (int p = 0; p < N_PHASES; ++p) { a.ph_lo = p; a.ph_hi = p + 1; a.li = p;
        hipLaunchKernelGGL(fwd_kernel, dim3(grid), dim3(NTHR), LDS_BYTES, stream, a); }
#endif
}
```

```cpp
#include <hip/hip_runtime.h>
#include <cstdio>
#include <cstdint>
namespace pg8 {
#define PG8_LAS __attribute__((address_space(3)))
typedef unsigned short bf16_t;
typedef short bf16x8 __attribute__((ext_vector_type(8)));
typedef float f32x4 __attribute__((ext_vector_type(4)));
typedef unsigned u32x4 __attribute__((ext_vector_type(4)));
constexpr int BM = 256, BK = 64, HALF = 128, HTB = HALF * BK * 2  , STAGE_BYTES = 8 * HTB, NXCD = 8, WGM = 8;

__host__ __device__ __forceinline__ int lds_byte(int r, int c) { const int st = (r >> 4) * 2 + (c >> 5), rr = r & 15, cc = c & 31, ob = rr * 64 + cc * 2; return st * 1024 + (ob ^ (((ob >> 9) & 1) << 5)); }
__host__ __device__ __forceinline__ void stage_rc(int b, int& R, int& C) { const int st = b / 1024, sb = b % 1024, swz = sb ^ (((sb >> 9) & 1) << 5); R = (st >> 1) * 16 + swz / 64; C = (st & 1) * 32 + (swz % 64) / 2; }
__host__ __device__ __forceinline__ int perm32(int rho) { const int n = rho >> 4, i = rho & 15; return 8 * (i >> 2) + 4 * n + (i & 3); }

struct Unit { int pm, pn; };
struct Gemm { const bf16_t* A; const bf16_t* Bt; int M, N, K; };

struct StaticOrder {
    int nM, nN, nwg, G, c, wgm;
    __host__ __device__ void init(int M, int N, int G_, int c_, int wgm_ = WGM) { nM = M / BM; nN = N / BM; nwg = nM * nN; G = G_; c = c_; wgm = wgm_; }
    __host__ __device__ bool next(int i, Unit& u) const {
        const long L = (long)i * G + c; if (L >= nwg) return false;
        int wgid = (int)L; { const int q = nwg / NXCD, r = nwg % NXCD, xcd = wgid % NXCD, off = wgid / NXCD; wgid = (xcd < r ? xcd * (q + 1) : r * (q + 1) + (xcd - r) * q) + off; }
        const int nig = wgm * nN, gid = wgid / nig, fm = gid * wgm, gsz = (nM - fm) < wgm ? (nM - fm) : wgm;
        u.pm = fm + ((wgid % nig) % gsz); u.pn = (wgid % nig) / gsz; return true;
    }
    __device__ __forceinline__ void a_ready(const Unit&) const {}
    __device__ __forceinline__ void done(const Unit&) const {}
};

typedef float f32x2c __attribute__((ext_vector_type(2)));
typedef __bf16 bf16x2c __attribute__((ext_vector_type(2)));
__device__ __forceinline__ unsigned cvt_pk_bf16(float lo, float hi) { const f32x2c v = {lo, hi}; return __builtin_bit_cast(unsigned, __builtin_convertvector(v, bf16x2c)); }

struct EpiBf16 {
    static constexpr bool PERM = true, AFTER_DRAIN = false;
    bf16_t* O; int ldc;
    __device__ __forceinline__ void operator()(const f32x4 (&acc)[2][2][4][2], const Unit& u, int wr, int wc, int fr, int fq) const {
        const int row0 = u.pm * BM + wr * 64 + fr; const int col0 = u.pn * BM + wc * 32 + 8 * fq;
#pragma unroll
        for (int ai = 0; ai < 2; ++ai)
#pragma unroll
            for (int m = 0; m < 4; ++m) { bf16_t* rowp = O + (size_t)(row0 + ai * HALF + m * 16) * ldc + col0;
#pragma unroll
                for (int bj = 0; bj < 2; ++bj) { const f32x4 v0 = acc[ai][bj][m][0], v1 = acc[ai][bj][m][1];
                    u32x4 w; w.x = cvt_pk_bf16(v0[0], v0[1]); w.y = cvt_pk_bf16(v0[2], v0[3]); w.z = cvt_pk_bf16(v1[0], v1[1]); w.w = cvt_pk_bf16(v1[2], v1[3]);
                    *(u32x4*)(rowp + bj * HALF) = w; } }
    }
};
template <int CTRL> __device__ __forceinline__ float dpp_old(float old, float v) { return __int_as_float(__builtin_amdgcn_update_dpp(__float_as_int(old), __float_as_int(v), CTRL, 0xf, 0xf, false)); }
struct EpiGateUp {
    static constexpr bool PERM = true, AFTER_DRAIN = false;
    bf16_t* ACT; const float* cw; const float* cb; float* HTG; float* HTU; float* HBG; int dff;
    __device__ __forceinline__ void operator()(const f32x4 (&acc)[2][2][4][2], const Unit& u, int wr, int wc, int fr, int fq) const {
        const int j0 = u.pn * 128 + wc * 32 + 8 * fq;
        float w0[8], w1[8], w2[8], bb[8];
#pragma unroll
        for (int h = 0; h < 2; ++h) { const f32x4 a = *(const f32x4*)(cw + j0 + 4 * h), b = *(const f32x4*)(cw + dff + j0 + 4 * h), c = *(const f32x4*)(cw + 2 * dff + j0 + 4 * h), d = *(const f32x4*)(cb + j0 + 4 * h);
#pragma unroll
            for (int e = 0; e < 4; ++e) { w0[4 * h + e] = a[e]; w1[4 * h + e] = b[e]; w2[4 * h + e] = c[e]; bb[4 * h + e] = d[e]; } }
#pragma unroll
        for (int ai = 0; ai < 2; ++ai) {
            const int rowb = u.pm * BM + ai * HALF + wr * 64; const size_t blk = (size_t)(rowb >> 6);
#pragma unroll
            for (int m = 0; m < 4; ++m) {
                const int row = rowb + 16 * m + fr; float o[8];
#pragma unroll
                for (int n = 0; n < 2; ++n)
#pragma unroll
                    for (int e = 0; e < 4; ++e) { const int k = 4 * n + e; const float g0 = acc[ai][0][m][n][e], up = acc[ai][1][m][n][e]; const float gp = m > 0 ? acc[ai][0][m > 0 ? m - 1 : 0][n][e] : 0.f;
                        const float g1 = dpp_old<0x111>(dpp_old<0x121>(0.f, gp), g0), g2 = dpp_old<0x112>(dpp_old<0x122>(0.f, gp), g0);
                        const float gc = bb[k] + w0[k] * g2 + w1[k] * g1 + w2[k] * g0; o[k] = gc * __builtin_amdgcn_rcpf(1.f + __expf(-gc)) * up; }
                u32x4 w; w.x = cvt_pk_bf16(o[0], o[1]); w.y = cvt_pk_bf16(o[2], o[3]); w.z = cvt_pk_bf16(o[4], o[5]); w.w = cvt_pk_bf16(o[6], o[7]);
                if (!(m == 0 && fr < 2)) __builtin_nontemporal_store(w, (u32x4*)(ACT + (size_t)row * dff + j0));
                if (m == 0 && fr < 2) { float* pg = HTG + (blk * 2 + fr) * dff + j0; float* pu = HTU + (blk * 2 + fr) * dff + j0;
                    *(f32x4*)pg = acc[ai][0][0][0]; *(f32x4*)(pg + 4) = acc[ai][0][0][1]; *(f32x4*)pu = acc[ai][1][0][0]; *(f32x4*)(pu + 4) = acc[ai][1][0][1]; }
                if (m == 3 && fr >= 14) { float* pg = HBG + (blk * 2 + (fr - 14)) * dff + j0; *(f32x4*)pg = acc[ai][0][3][0]; *(f32x4*)(pg + 4) = acc[ai][0][3][1]; }
            }
        }
    }
};
struct EpiProjConv {
    static constexpr bool PERM = true, AFTER_DRAIN = false;
    bf16_t* O; int ldc; bf16_t* XBC; const float* cw; const float* cb; float* HT; float* HB;
    __device__ __forceinline__ void operator()(const f32x4 (&acc)[2][2][4][2], const Unit& u, int wr, int wc, int fr, int fq) const {
        if (u.pn < 8 || u.pn >= 24) {
            const int row0 = u.pm * BM + wr * 64 + fr; const int col0 = u.pn * BM + wc * 32 + 8 * fq;
#pragma unroll
            for (int ai = 0; ai < 2; ++ai)
#pragma unroll
                for (int m = 0; m < 4; ++m) { bf16_t* rowp = O + (size_t)(row0 + ai * HALF + m * 16) * ldc + col0;
#pragma unroll
                    for (int bj = 0; bj < 2; ++bj) { const f32x4 v0 = acc[ai][bj][m][0], v1 = acc[ai][bj][m][1];
                        u32x4 w; w.x = cvt_pk_bf16(v0[0], v0[1]); w.y = cvt_pk_bf16(v0[2], v0[3]); w.z = cvt_pk_bf16(v1[0], v1[1]); w.w = cvt_pk_bf16(v1[2], v1[3]);
                        __builtin_nontemporal_store(w, (u32x4*)(rowp + bj * HALF)); } }
            return;
        }
#pragma unroll
        for (int bj = 0; bj < 2; ++bj) {
            const int c0 = (u.pn - 8) * BM + bj * HALF + wc * 32 + 8 * fq;
            float wv[4][8], bb[8];
#pragma unroll
            for (int h = 0; h < 2; ++h) { const f32x4 d = *(const f32x4*)(cb + c0 + 4 * h);
#pragma unroll
                for (int e = 0; e < 4; ++e) bb[4 * h + e] = d[e];
#pragma unroll
                for (int i = 0; i < 4; ++i) { const f32x4 a = *(const f32x4*)(cw + i * 4096 + c0 + 4 * h);
#pragma unroll
                    for (int e = 0; e < 4; ++e) wv[i][4 * h + e] = a[e]; } }
#pragma unroll
            for (int ai = 0; ai < 2; ++ai) {
                const int rowb = u.pm * BM + ai * HALF + wr * 64; const size_t blk = (size_t)(rowb >> 6);
#pragma unroll
                for (int m = 0; m < 4; ++m) {
                    const int row = rowb + 16 * m + fr; float o[8];
#pragma unroll
                    for (int n = 0; n < 2; ++n)
#pragma unroll
                        for (int e = 0; e < 4; ++e) { const int k = 4 * n + e; const float x0 = acc[ai][bj][m][n][e]; const float xp = m > 0 ? acc[ai][bj][m > 0 ? m - 1 : 0][n][e] : 0.f;
                            const float x1 = dpp_old<0x111>(dpp_old<0x121>(0.f, xp), x0), x2 = dpp_old<0x112>(dpp_old<0x122>(0.f, xp), x0), x3 = dpp_old<0x113>(dpp_old<0x123>(0.f, xp), x0);
                            const float a = bb[k] + wv[0][k] * x3 + wv[1][k] * x2 + wv[2][k] * x1 + wv[3][k] * x0; o[k] = a * __builtin_amdgcn_rcpf(1.f + __expf(-a)); }
                    u32x4 w; w.x = cvt_pk_bf16(o[0], o[1]); w.y = cvt_pk_bf16(o[2], o[3]); w.z = cvt_pk_bf16(o[4], o[5]); w.w = cvt_pk_bf16(o[6], o[7]);
                    if (!(m == 0 && fr < 3)) __builtin_nontemporal_store(w, (u32x4*)(XBC + (size_t)row * 4096 + c0));
                    if (m == 0 && fr < 3) { float* p = HT + (blk * 3 + fr) * 4096 + c0; *(f32x4*)p = acc[ai][bj][0][0]; *(f32x4*)(p + 4) = acc[ai][bj][0][1]; }
                    if (m == 3 && fr >= 13) { float* p = HB + (blk * 3 + (fr - 13)) * 4096 + c0; *(f32x4*)p = acc[ai][bj][3][0]; *(f32x4*)(p + 4) = acc[ai][bj][3][1]; }
                }
            }
        }
    }
};
struct EpiRes {
    static constexpr bool PERM = false, AFTER_DRAIN = false;
    const float* base; float* out; int ldc;
    __device__ __forceinline__ void operator()(const f32x4 (&acc)[2][2][4][2], const Unit& u, int wr, int wc, int fr, int fq) const {
        const int row0 = u.pm * BM + wr * 64 + fr, col0 = u.pn * BM + wc * 32 + 4 * fq;
#pragma unroll
        for (int ai = 0; ai < 2; ++ai)
#pragma unroll
            for (int m = 0; m < 4; ++m) { const size_t off = (size_t)(row0 + ai * HALF + m * 16) * ldc + col0;
#pragma unroll
                for (int bj = 0; bj < 2; ++bj)
#pragma unroll
                    for (int n = 0; n < 2; ++n) { const f32x4 bs = *(const f32x4*)(base + off + bj * HALF + n * 16); *(f32x4*)(out + off + bj * HALF + n * 16) = bs + acc[ai][bj][m][n]; } }
    }
};
template <class Epi, class Sched, bool ALIGN_EPI = false, bool SP2 = false>
__device__ __forceinline__ void gemm_phase(PG8_LAS unsigned char* lds, const Gemm g, const Sched& S, const Epi& E) {
    const int tid = threadIdx.x, wid = __builtin_amdgcn_readfirstlane(tid >> 6), lane = tid & 63, wr = wid >> 2, wc = wid & 3, fr = lane & 15, fq = lane >> 4;
    const int K = g.K, nt = K / BK;
    unsigned voffA[2], voffB[2];
#pragma unroll
    for (int i = 0; i < 2; ++i) { int R, C; stage_rc(tid * 16 + i * 8192, R, C); const int Rb = Epi::PERM ? ((R & ~31) + perm32(R & 31)) : R;
        voffA[i] = (unsigned)(R * K + C) * 2u; voffB[i] = (unsigned)(Rb * K + C) * 2u; }
    const size_t kstep = (size_t)(BK * 2);
    const size_t hstep = (size_t)HALF * K * 2;
    const size_t tstep = 2 * hstep;
    const unsigned ldsw = (unsigned)wid * 1024u;
    const int aoff = lds_byte(wr * 64 + fr, fq * 8), boff = lds_byte(wc * 32 + fr, fq * 8);
#define PG8_SA(b, h) (((b) * 2 + (h)) * HTB)
#define PG8_SB(b, h) ((4 + (b) * 2 + (h)) * HTB)
#define PG8_STAGE(bufoff, gbase, voff) do { _Pragma("unroll") for (int _i = 0; _i < 2; ++_i) \
        __builtin_amdgcn_global_load_lds((const unsigned*)((const char*)(gbase) + (voff)[_i]), (PG8_LAS unsigned*)(lds + (bufoff) + ldsw + _i * 8192), 16, 0, 0); } while (0)
#define PG8_LDA(dst, b, h) do { _Pragma("unroll") for (int m = 0; m < 4; ++m) _Pragma("unroll") for (int k = 0; k < 2; ++k) dst[m][k] = *(const PG8_LAS bf16x8*)(lds + PG8_SA(b, h) + aoff + m * 2048 + k * 1024); } while (0)
#define PG8_LDB(dst, b, h) do { _Pragma("unroll") for (int n = 0; n < 2; ++n) _Pragma("unroll") for (int k = 0; k < 2; ++k) dst[n][k] = *(const PG8_LAS bf16x8*)(lds + PG8_SB(b, h) + boff + n * 2048 + k * 1024); } while (0)
#define PG8_MMA(ai, bj, At, Bt) do { __builtin_amdgcn_s_setprio(1); _Pragma("unroll") for (int m = 0; m < 4; ++m) _Pragma("unroll") for (int n = 0; n < 2; ++n) _Pragma("unroll") for (int k = 0; k < 2; ++k) \
        acc[ai][bj][m][n] = __builtin_amdgcn_mfma_f32_16x16x32_bf16(Bt[n][k], At[m][k], acc[ai][bj][m][n], 0, 0, 0); __builtin_amdgcn_s_setprio(0); } while (0)
#define PG8_WAIT_V(n) asm volatile("s_waitcnt vmcnt(" #n ")" ::: "memory")
#define PG8_WAIT_L(n) asm volatile("s_waitcnt lgkmcnt(" #n ")" ::: "memory")
#define PG8_BAR __builtin_amdgcn_s_barrier()
#define PG8_SCHED __builtin_amdgcn_sched_barrier(0)
    Unit cur, nxt; int ui = 0;
    if (!S.next(0, cur)) return;
    f32x4 acc[2][2][4][2];
#pragma unroll
    for (int a = 0; a < 2; ++a)
#pragma unroll
        for (int b = 0; b < 2; ++b)
#pragma unroll
            for (int m = 0; m < 4; ++m)
#pragma unroll
                for (int n = 0; n < 2; ++n) acc[a][b][m][n] = (f32x4){0.f, 0.f, 0.f, 0.f};
    bf16x8 At[4][2], B0[2][2], B1[2][2];
    const char* cA = (const char*)g.A + (size_t)cur.pm * tstep; const char* cB = (const char*)g.Bt + (size_t)cur.pn * tstep;
    S.a_ready(cur);
    if constexpr (SP2) {
        PG8_STAGE(PG8_SB(0, 0), cB, voffB); PG8_STAGE(PG8_SB(0, 1), cB + hstep, voffB); PG8_STAGE(PG8_SA(0, 0), cA, voffA); PG8_STAGE(PG8_SA(0, 1), cA + hstep, voffA);
        if (wr == 1) PG8_BAR;
        PG8_WAIT_V(2); PG8_BAR;
        PG8_STAGE(PG8_SB(1, 0), cB + kstep, voffB); PG8_STAGE(PG8_SA(1, 0), cA + kstep, voffA); PG8_STAGE(PG8_SB(1, 1), cB + hstep + kstep, voffB);
        PG8_WAIT_V(6); PG8_BAR;
    } else {
        PG8_STAGE(PG8_SB(0, 0), cB, voffB); PG8_STAGE(PG8_SA(0, 0), cA, voffA); PG8_STAGE(PG8_SB(0, 1), cB + hstep, voffB); PG8_STAGE(PG8_SA(0, 1), cA + hstep, voffA);
        if (wr == 1) PG8_BAR;
        PG8_WAIT_V(4); PG8_BAR;
        PG8_STAGE(PG8_SB(1, 0), cB + kstep, voffB); PG8_STAGE(PG8_SA(1, 0), cA + kstep, voffA); PG8_STAGE(PG8_SB(1, 1), cB + hstep + kstep, voffB);
        PG8_WAIT_V(6); PG8_BAR;
    }
    for (;;) {
        const bool has_next = S.next(ui + 1, nxt);
        const char* nA = has_next ? (const char*)g.A + (size_t)nxt.pm * tstep : cA; const char* nB = has_next ? (const char*)g.Bt + (size_t)nxt.pn * tstep : cB;
        for (int t = 0; t < nt; t += 2) {
            const bool last = (t == nt - 2);
            const char* a1 = cA + (size_t)(t + 1) * kstep;
            const char* a2 = last ? nA : cA + (size_t)(t + 2) * kstep; const char* b2 = last ? nB : cB + (size_t)(t + 2) * kstep;
            const char* a3 = a2 + kstep; const char* b3 = b2 + kstep;
            if (last && has_next) S.a_ready(nxt);
            if constexpr (SP2) {
            PG8_LDB(B0, 0, 0); PG8_LDB(B1, 0, 1); PG8_SCHED; PG8_LDA(At, 0, 0); PG8_STAGE(PG8_SA(1, 1), a1 + hstep, voffA);
            PG8_WAIT_V(8); PG8_WAIT_L(0); PG8_BAR; PG8_MMA(0, 0, At, B0); PG8_MMA(0, 1, At, B1); PG8_BAR; PG8_SCHED;
            PG8_LDA(At, 0, 1); PG8_STAGE(PG8_SB(0, 0), b2, voffB); PG8_STAGE(PG8_SB(0, 1), b2 + hstep, voffB); PG8_STAGE(PG8_SA(0, 0), a2, voffA);
            PG8_WAIT_V(8); PG8_WAIT_L(0); PG8_BAR; PG8_MMA(1, 0, At, B0); PG8_MMA(1, 1, At, B1); PG8_BAR; PG8_SCHED;
            PG8_LDB(B0, 1, 0); PG8_LDB(B1, 1, 1); PG8_SCHED; PG8_LDA(At, 1, 0); PG8_STAGE(PG8_SA(0, 1), a2 + hstep, voffA);
            PG8_WAIT_V(8); PG8_WAIT_L(0); PG8_BAR; PG8_MMA(0, 0, At, B0); PG8_MMA(0, 1, At, B1); PG8_BAR; PG8_SCHED;
            PG8_LDA(At, 1, 1); PG8_STAGE(PG8_SB(1, 0), b3, voffB); PG8_STAGE(PG8_SB(1, 1), b3 + hstep, voffB); PG8_STAGE(PG8_SA(1, 0), a3, voffA);
            PG8_WAIT_V(8); PG8_WAIT_L(0); PG8_BAR; PG8_MMA(1, 0, At, B0); PG8_MMA(1, 1, At, B1); PG8_BAR; PG8_SCHED;
            } else {
            PG8_LDB(B0, 0, 0); PG8_SCHED; PG8_LDA(At, 0, 0); PG8_STAGE(PG8_SA(1, 1), a1 + hstep, voffA);
            PG8_WAIT_L(8); PG8_BAR; PG8_WAIT_L(0); PG8_MMA(0, 0, At, B0); PG8_BAR; PG8_SCHED;
            PG8_LDB(B1, 0, 1); PG8_STAGE(PG8_SB(0, 0), b2, voffB);
            PG8_BAR; PG8_WAIT_L(0); PG8_MMA(0, 1, At, B1); PG8_BAR;
            PG8_LDA(At, 0, 1); PG8_STAGE(PG8_SA(0, 0), a2, voffA);
            PG8_BAR; PG8_WAIT_L(0); PG8_MMA(1, 0, At, B0); PG8_BAR; PG8_SCHED;
            PG8_STAGE(PG8_SB(0, 1), b2 + hstep, voffB);
            PG8_WAIT_V(6); PG8_BAR; PG8_MMA(1, 1, At, B1); PG8_BAR;
            PG8_LDB(B0, 1, 0); PG8_SCHED; PG8_LDA(At, 1, 0); PG8_STAGE(PG8_SA(0, 1), a2 + hstep, voffA);
            PG8_WAIT_L(8); PG8_BAR; PG8_WAIT_L(0); PG8_MMA(0, 0, At, B0); PG8_BAR; PG8_SCHED;
            PG8_LDB(B1, 1, 1); PG8_STAGE(PG8_SB(1, 0), b3, voffB);
            PG8_BAR; PG8_WAIT_L(0); PG8_MMA(0, 1, At, B1); PG8_BAR;
            PG8_LDA(At, 1, 1); PG8_STAGE(PG8_SA(1, 0), a3, voffA);
            PG8_BAR; PG8_WAIT_L(0); PG8_MMA(1, 0, At, B0); PG8_BAR; PG8_SCHED;
            PG8_STAGE(PG8_SB(1, 1), b3 + hstep, voffB);
            PG8_WAIT_V(6); PG8_BAR; PG8_MMA(1, 1, At, B1); PG8_BAR;
            }
        }
        if constexpr (ALIGN_EPI) { if (wr == 0) PG8_BAR; }
        if constexpr (!Epi::AFTER_DRAIN) { E(acc, cur, wr, wc, fr, fq); S.done(cur); }
        if (!has_next) break;
#pragma unroll
        for (int a = 0; a < 2; ++a)
#pragma unroll
            for (int b = 0; b < 2; ++b)
#pragma unroll
                for (int m = 0; m < 4; ++m)
#pragma unroll
                    for (int n = 0; n < 2; ++n) acc[a][b][m][n] = (f32x4){0.f, 0.f, 0.f, 0.f};
        cur = nxt; cA = nA; cB = nB; ++ui;
        if constexpr (ALIGN_EPI) { if (wr == 1) PG8_BAR; }
    }
    PG8_WAIT_V(0);
    if constexpr (!ALIGN_EPI) { if (wr == 0) PG8_BAR; }
    PG8_BAR;
    if constexpr (Epi::AFTER_DRAIN) { E.fused(acc, cur, wr, wc, fr, fq, lds, wid, lane); S.done(cur); }
#undef PG8_SA
#undef PG8_SB
#undef PG8_STAGE
#undef PG8_LDA
#undef PG8_LDB
#undef PG8_MMA
#undef PG8_WAIT_V
#undef PG8_WAIT_L
#undef PG8_BAR
#undef PG8_SCHED
}
}

constexpr int NWAVES = 8, NTHR = NWAVES * 64;
constexpr int BATCH = 2, SEQ = 8192, M = BATCH * SEQ, DM = 4096, DEPTH = 2;
constexpr int SSD_W = 2048, SSD_H = 32, SSD_CD = 4096;
constexpr int SWA_W = 1024, SWA_H = 16;
constexpr int GLA_W = 1024, GLA_KT = 512;
constexpr int DFF = 11008, DIN = 10800, DINP = 11008, DGU = 2 * DFF;
constexpr float EPS = 1e-6f;
constexpr int C_Z = 0, C_XBC = 2048, C_DT = 6144, C_SQ = 6176, C_SK = 7200, C_SV = 7456, C_GQ = 7712, C_GK = 8224, C_GV = 8736, C_GG = 9760, C_GLR = 10784;
enum { I_X = 0, I_ATTN_NORM, I_W_IN, I_SSD_CONV_W, I_SSD_CONV_B, I_SSD_DT_BIAS, I_SSD_A_LOG, I_SSD_D, I_SSD_NORM, I_SWA_SINKS, I_SWA_NORM, I_GLA_W_GATE, I_GLA_B_GATE, I_GLA_NORM,
       I_W_OUT, I_FFN_NORM, I_W_GATE, I_W_UP, I_FFN_CONV_W, I_FFN_CONV_B, I_W_DOWN, I_REL_BIAS, I_FINAL_NORM, N_IN };

constexpr size_t MiB = 1u << 20;
constexpr size_t WS_CTL = 0, CTL_BYTES = 1 * MiB;
constexpr size_t WS_WIN = 1 * MiB;
constexpr size_t WS_WOUT = 87 * MiB;
constexpr size_t WS_WGU = 119 * MiB;
constexpr size_t WS_WDN = 291 * MiB;
constexpr size_t WS_H = 377 * MiB;
constexpr size_t WS_R = 505 * MiB;
constexpr size_t WS_PROJ = WS_R;
constexpr size_t WS_XBC = WS_R + 344 * MiB;
constexpr size_t WS_QD = WS_R + 472 * MiB;
constexpr size_t WS_KI = WS_R + 488 * MiB;
constexpr size_t WS_DT = WS_R + 520 * MiB;
constexpr size_t WS_ACS = WS_R + 522 * MiB;
constexpr size_t WS_DEC = WS_R + 524 * MiB;
constexpr size_t WS_GDEC = WS_R + 525 * MiB;
constexpr size_t WS_ST = WS_R + 528 * MiB;
constexpr size_t WS_PV = WS_R + 656 * MiB;
constexpr size_t WS_GST = WS_R + 720 * MiB;
constexpr size_t WS_GPV = WS_R + 848 * MiB;
constexpr size_t WS_OSWA = WS_R + 912 * MiB;
constexpr size_t WS_Y = WS_R + 976 * MiB;
constexpr size_t WS_ACT = WS_R + 688 * MiB;
constexpr size_t WS_HTG = WS_R + 1032 * MiB, WS_HTU = WS_R + 1054 * MiB, WS_HBG = WS_R + 1076 * MiB;
constexpr size_t WS_XHT = WS_R + 504 * MiB, WS_XHB = WS_R + 1104 * MiB;
constexpr size_t WS_END = WS_R + 1120 * MiB;
static_assert(DEPTH == 2 && (size_t)DINP * DM * 2 == 86 * MiB && (size_t)DGU * DM * 2 == 172 * MiB && (size_t)M * DINP * 2 == 344 * MiB , "ws map");
constexpr int CW_BAR = 4096;

constexpr int RING_BYTES = 131072;
constexpr int MISC_OFF = 147456 - 256;
constexpr int LDS_BYTES = 147456;

#define GAS __attribute__((address_space(1)))
#define LAS __attribute__((address_space(3)))
typedef unsigned short bf16;
typedef unsigned v4u __attribute__((ext_vector_type(4)));
typedef unsigned v2u __attribute__((ext_vector_type(2)));
typedef float f32x4 __attribute__((ext_vector_type(4)));
typedef GAS unsigned gu32;
typedef float f32x2c __attribute__((ext_vector_type(2)));
#define RLX_AGENT __ATOMIC_RELAXED, __HIP_MEMORY_SCOPE_AGENT
#define LDS_WAIT() asm volatile("s_waitcnt lgkmcnt(0)" ::: "memory")
__device__ __forceinline__ unsigned f2bf(float f) { unsigned u = __builtin_bit_cast(unsigned, f); return (u + 0x7fffu + ((u >> 16) & 1u)) >> 16; }
__device__ __forceinline__ unsigned pk2(float lo, float hi) { return pg8::cvt_pk_bf16(lo, hi); }
__device__ __forceinline__ float bflo(unsigned w) { return __uint_as_float(w << 16); }
__device__ __forceinline__ float bfhi(unsigned w) { return __uint_as_float(w & 0xffff0000u); }
__device__ __forceinline__ float bf1(bf16 h) { return __uint_as_float((unsigned)h << 16); }
__device__ __forceinline__ float silu_f(float x) { return x * __builtin_amdgcn_rcpf(1.f + __expf(-x)); }
__device__ __forceinline__ float wave_sum(float v) {
#pragma unroll
    for (int o = 1; o < 64; o <<= 1) v += __shfl_xor(v, o);
    return v;
}
template <int CTRL> __device__ __forceinline__ float dpp_f(float v) { return __int_as_float(__builtin_amdgcn_update_dpp(0, __float_as_int(v), CTRL, 0xf, 0xf, false)); }
__device__ __forceinline__ float row16_sum(float v) { v += dpp_f<0xB1>(v); v += dpp_f<0x4E>(v); v += dpp_f<0x124>(v); v += dpp_f<0x128>(v); return v; }
__device__ __forceinline__ float pair_sum(float v) { return v + dpp_f<0xB1>(v); }
#define XB_TMO      128
#define XB_XCNT(j)  (256  + 64 * (j))
#define XB_XSUB(j)  (1280 + 64 * (j))
#define XB_XGEN(j)  (2304 + 64 * (j))
#define XB_TOP      3328
#define XB_TOPGEN   3392
#define XCD_BAR_WORDS 3456
#define XB_SPIN_CAP (1u << 18)

__device__ __forceinline__ unsigned xb_ld(unsigned* p)              { return __hip_atomic_load(p, __ATOMIC_RELAXED, __HIP_MEMORY_SCOPE_AGENT); }
__device__ __forceinline__ unsigned xb_add(unsigned* p, unsigned v) { return __hip_atomic_fetch_add(p, v, __ATOMIC_RELAXED, __HIP_MEMORY_SCOPE_AGENT); }
__device__ __forceinline__ unsigned xb_xcc_id() { return (unsigned)__builtin_amdgcn_s_getreg((3 << 11) | 20) & 0xFu; }
#define XB_SPIN(cond, bar) do { unsigned _sp = 0; while (cond) { __builtin_amdgcn_s_sleep(1); \
    if ((++_sp & 255u) == 0u) { if (xb_ld(&(bar)[XB_TMO])) break; if (_sp > XB_SPIN_CAP) { atomicAdd(&(bar)[XB_TMO], 1u); break; } } } } while (0)

struct XcdBarrier {
    unsigned* bar; unsigned x;
    volatile LAS unsigned* st;
};

__device__ __forceinline__ XcdBarrier xcd_barrier_post(unsigned* bar, volatile LAS unsigned* st) {
    XcdBarrier b; b.bar = bar; b.x = xb_xcc_id(); b.st = st;
    if (threadIdx.x == 0) (void)xb_add(&bar[XB_XCNT(b.x)], 1u);
    return b;
}
__device__ __forceinline__ void xcd_barrier_complete(unsigned* bar, unsigned x, unsigned& nloc, unsigned& nx) {
    const unsigned G = gridDim.x * gridDim.y * gridDim.z;
    unsigned sum, cnt, mine, sp = 0u;
    for (;;) {
        sum = 0u; cnt = 0u; mine = 0u;
#pragma unroll
        for (unsigned j = 0; j < 16; ++j) { const unsigned c = xb_ld(&bar[XB_XCNT(j)]); sum += c; cnt += (c > 0u) ? 1u : 0u; mine = (j == x) ? c : mine; }
        if (sum == G) break;
        __builtin_amdgcn_s_sleep(1);
        if ((++sp & 255u) == 0u) { if (xb_ld(&bar[XB_TMO])) break; if (sp > XB_SPIN_CAP) { atomicAdd(&bar[XB_TMO], 1u); break; } }
    }
    nloc = mine > 0u ? mine : 1u; nx = cnt > 0u ? cnt : 1u;
}

__device__ __forceinline__ void xcd_barrier(const XcdBarrier& b) {
    asm volatile("s_waitcnt vmcnt(0)" ::: "memory");
    __syncthreads();
    if (threadIdx.x == 0) {
        unsigned* bar = b.bar;
        __builtin_amdgcn_s_waitcnt(0);
        unsigned nloc = b.st[0], nx = b.st[1];
        if (nloc == 0u) { xcd_barrier_complete(bar, b.x, nloc, nx); b.st[0] = nloc; b.st[1] = nx; }
        const unsigned old = xb_add(&bar[XB_XSUB(b.x)], 1u);
        const unsigned gen = old / nloc;
        if (old + 1u == (gen + 1u) * nloc) {
            __builtin_amdgcn_fence(__ATOMIC_RELEASE, "agent");
            asm volatile("s_waitcnt vmcnt(0)" ::: "memory");
            const unsigned og = xb_add(&bar[XB_TOP], 1u);
            const unsigned tg = og / nx;
            if (og + 1u == (tg + 1u) * nx) xb_add(&bar[XB_TOPGEN], 1u);
            else XB_SPIN(xb_ld(&bar[XB_TOPGEN]) == tg, bar);
            __builtin_amdgcn_fence(__ATOMIC_ACQUIRE, "agent");
            xb_add(&bar[XB_XGEN(b.x)], 1u);
            asm volatile("s_waitcnt vmcnt(0)" ::: "memory");
        } else {
            XB_SPIN(xb_ld(&bar[XB_XGEN(b.x)]) == gen, bar);
            __builtin_amdgcn_fence(__ATOMIC_ACQUIRE, "agent");
            asm volatile("s_waitcnt vmcnt(0)" ::: "memory");
        }
    }
    __syncthreads();
}

struct Args { const float* in[N_IN]; float* out; unsigned char* ws; int ph_lo, ph_hi, li, pad; };
struct Ctx {
    LAS unsigned char* lds;
    int tid, lane, wave, G, bid;
    const float* const* in; float* out; unsigned char* ws;
};
__device__ const unsigned char T5_BUCKET[128] = {0, 1, 2, 3, 4, 5, 6, 7, 8, 9, 10, 11, 12, 13, 14, 15, 16, 16, 16, 17, 17, 18, 18, 18, 19, 19, 19, 20, 20, 20, 20, 21, 21, 21, 21, 22, 22, 22, 22, 22, 23, 23, 23, 23, 23, 23, 24, 24, 24, 24, 24, 24, 25, 25, 25, 25, 25, 25, 25, 26, 26, 26, 26, 26, 26, 26, 26, 27, 27, 27, 27, 27, 27, 27, 27, 27, 27, 28, 28, 28, 28, 28, 28, 28, 28, 28, 28, 29, 29, 29, 29, 29, 29, 29, 29, 29, 29, 29, 29, 30, 30, 30, 30, 30, 30, 30, 30, 30, 30, 30, 30, 30, 30, 31, 31, 31, 31, 31, 31, 31, 31, 31, 31, 31, 31, 31, 31, 31};

struct TItem { const float* src; bf16* dst; int N, K, nvalid; };
constexpr int CV_NITEMS = 32 * 86 * 3 + 32 * 32 + 86 * 32;
__device__ __forceinline__ TItem titem_decode(Ctx& C, int l, int it) {
    constexpr int I_IN = 32 * 86, I_OUT = 32 * 32, I_G = 32 * 86;
    TItem t; int r = it, kb, nb;
    if (r < I_IN) { kb = r / 86; nb = r % 86; t.N = DIN; t.K = DM; t.src = C.in[I_W_IN] + (size_t)l * DM * DIN; t.dst = (bf16*)(C.ws + WS_WIN) + (size_t)(128 * nb) * DM; }
    else if ((r -= I_IN) < I_OUT) { kb = r / 32; nb = r % 32; t.N = DM; t.K = DM; t.src = C.in[I_W_OUT] + (size_t)l * DM * DM; t.dst = (bf16*)(C.ws + WS_WOUT) + (size_t)(128 * nb) * DM; }
    else if ((r -= I_OUT) < I_G) { kb = r / 86; nb = r % 86; t.N = DFF; t.K = DM; t.src = C.in[I_W_GATE] + (size_t)l * DM * DFF; t.dst = (bf16*)(C.ws + WS_WGU) + (size_t)(256 * nb) * DM; }
    else if ((r -= I_G) < I_G) { kb = r / 86; nb = r % 86; t.N = DFF; t.K = DM; t.src = C.in[I_W_UP] + (size_t)l * DM * DFF; t.dst = (bf16*)(C.ws + WS_WGU) + (size_t)(256 * nb + 128) * DM; }
    else { r -= I_G; kb = r / 32; nb = r % 32; t.N = DM; t.K = DFF; t.src = C.in[I_W_DOWN] + (size_t)l * DFF * DM; t.dst = (bf16*)(C.ws + WS_WDN) + (size_t)(128 * nb) * DFF; }
    t.src += (size_t)(128 * kb) * t.N + 128 * nb; t.dst += 128 * kb;
    const int rem = t.N - 128 * nb; t.nvalid = rem >= 128 ? 128 : (rem > 0 ? rem : 0);
    return t;
}
__device__ __forceinline__ void titem_load(const TItem& t, f32x4 (&v)[8], int wave, int lane) {
    const bool nv = 4 * (lane & 31) < t.nvalid; const float* p = t.src + (size_t)(16 * wave + 2 * (lane >> 5)) * t.N + 4 * (lane & 31);
#pragma unroll
    for (int i = 0; i < 4; ++i) { v[2 * i] = nv ? *(const GAS f32x4*)(p + (size_t)(4 * i) * t.N) : (f32x4){0.f, 0.f, 0.f, 0.f}; v[2 * i + 1] = nv ? *(const GAS f32x4*)(p + (size_t)(4 * i + 1) * t.N) : (f32x4){0.f, 0.f, 0.f, 0.f}; }
}
__device__ __forceinline__ void titem_store(const TItem& t, const f32x4 (&v)[8], LAS unsigned* T, int tid, int wave, int lane) {
    __syncthreads();
    { const int kd = 8 * wave + (lane >> 5);
#pragma unroll
      for (int i = 0; i < 4; ++i)
#pragma unroll
          for (int e = 0; e < 4; ++e) T[(4 * (lane & 31) + e) * 65 + ((kd + 2 * i) ^ ((lane & 31) >> 3))] = pg8::cvt_pk_bf16(v[2 * i][e], v[2 * i + 1][e]); }
    __syncthreads();
    const int ch = tid & 15;
#pragma unroll
    for (int ps = 0; ps < 4; ++ps) { const int n = 32 * ps + (tid >> 4); const LAS unsigned* s = T + n * 65 + 4 * ch;
        v4u o; o.x = s[0 ^ ps]; o.y = s[1 ^ ps]; o.z = s[2 ^ ps]; o.w = s[3 ^ ps];
        *(GAS v4u*)(t.dst + (size_t)n * t.K + 8 * ch) = o; }
}
__device__ __forceinline__ void convert_weights(Ctx& C, int l) {
    LAS unsigned* T = (LAS unsigned*)C.lds;
    int it = C.bid; if (it >= CV_NITEMS) return;
    TItem cur = titem_decode(C, l, it); f32x4 va[8], vb[8];
    titem_load(cur, va, C.wave, C.lane);
    for (;;) {
        int nx = it + C.G; TItem tn = cur; const bool hn = nx < CV_NITEMS;
        if (hn) { tn = titem_decode(C, l, nx); titem_load(tn, vb, C.wave, C.lane); }
        titem_store(cur, va, T, C.tid, C.wave, C.lane);
        if (!hn) break;
        nx += C.G; const bool hn2 = nx < CV_NITEMS; TItem t2 = tn;
        if (hn2) { t2 = titem_decode(C, l, nx); titem_load(t2, va, C.wave, C.lane); }
        titem_store(tn, vb, T, C.tid, C.wave, C.lane);
        if (!hn2) break;
        cur = t2; it = nx;
    }
    __syncthreads();
}
__device__ __forceinline__ float row_ssq(const f32x4 (&v)[16]) { float ss = 0.f;
#pragma unroll
    for (int j = 0; j < 16; ++j) ss += (v[j].x * v[j].x + v[j].y * v[j].y) + (v[j].z * v[j].z + v[j].w * v[j].w);
    return ss; }
__device__ __forceinline__ void rmsnorm_phase(Ctx& C, const float* X, const float* w, bf16* H) {
    const int gw = C.bid * NWAVES + C.wave, NGW = C.G * NWAVES, lane = C.lane;
    const GAS f32x4* wr = (const GAS f32x4*)w + lane;
    for (int m = gw; m < M; m += 2 * NGW) {
        const int m2 = m + NGW; const bool h2 = m2 < M;
        const GAS f32x4* x0 = (const GAS f32x4*)(X + (size_t)m * DM) + lane; const GAS f32x4* x1 = (const GAS f32x4*)(X + (size_t)(h2 ? m2 : m) * DM) + lane;
        f32x4 v0[16], v1[16];
#pragma unroll
        for (int j = 0; j < 16; ++j) v0[j] = x0[64 * j];
#pragma unroll
        for (int j = 0; j < 16; ++j) v1[j] = x1[64 * j];
        const float r0 = 1.f / sqrtf(wave_sum(row_ssq(v0)) * (1.f / DM) + EPS), r1 = 1.f / sqrtf(wave_sum(row_ssq(v1)) * (1.f / DM) + EPS);
        GAS v2u* o0 = (GAS v2u*)(H + (size_t)m * DM) + lane; GAS v2u* o1 = (GAS v2u*)(H + (size_t)m2 * DM) + lane;
#pragma unroll
        for (int j = 0; j < 16; ++j) { const f32x4 g = wr[64 * j]; v2u o; o.x = pk2(v0[j].x * r0 * g.x, v0[j].y * r0 * g.y); o.y = pk2(v0[j].z * r0 * g.z, v0[j].w * r0 * g.w); o0[64 * j] = o;
            if (h2) { v2u p; p.x = pk2(v1[j].x * r1 * g.x, v1[j].y * r1 * g.y); p.y = pk2(v1[j].z * r1 * g.z, v1[j].w * r1 * g.w); o1[64 * j] = p; } }
    }
}
__device__ __forceinline__ void final_norm_phase(Ctx& C, float* X, const float* w) {
    const int gw = C.bid * NWAVES + C.wave, NGW = C.G * NWAVES, lane = C.lane;
    const GAS f32x4* wr = (const GAS f32x4*)w + lane;
    for (int m = gw; m < M; m += 2 * NGW) {
        const int m2 = m + NGW; const bool h2 = m2 < M;
        GAS f32x4* x0 = (GAS f32x4*)(X + (size_t)m * DM) + lane; GAS f32x4* x1 = (GAS f32x4*)(X + (size_t)(h2 ? m2 : m) * DM) + lane;
        f32x4 v0[16], v1[16];
#pragma unroll
        for (int j = 0; j < 16; ++j) v0[j] = x0[64 * j];
#pragma unroll
        for (int j = 0; j < 16; ++j) v1[j] = x1[64 * j];
        const float r0 = 1.f / sqrtf(wave_sum(row_ssq(v0)) * (1.f / DM) + EPS), r1 = 1.f / sqrtf(wave_sum(row_ssq(v1)) * (1.f / DM) + EPS);
#pragma unroll
        for (int j = 0; j < 16; ++j) { const f32x4 g = wr[64 * j]; x0[64 * j] = v0[j] * r0 * g; if (h2) x1[64 * j] = v1[j] * r1 * g; }
    }
}

typedef short bf16x8 __attribute__((ext_vector_type(8)));
typedef short s16x4 __attribute__((ext_vector_type(4)));
__device__ __forceinline__ f32x4 mfma16(bf16x8 a, bf16x8 b, f32x4 c) { return __builtin_amdgcn_mfma_f32_16x16x32_bf16(a, b, c, 0, 0, 0); }
__device__ __forceinline__ bf16x8 pack8(f32x4 lo, f32x4 hi) { v4u w; w.x = pg8::cvt_pk_bf16(lo.x, lo.y); w.y = pg8::cvt_pk_bf16(lo.z, lo.w); w.z = pg8::cvt_pk_bf16(hi.x, hi.y); w.w = pg8::cvt_pk_bf16(hi.z, hi.w); return __builtin_bit_cast(bf16x8, w); }
__device__ __forceinline__ bf16x8 gfrag(const bf16* Mx, size_t ld, int row0, int k0, int lane) { return *(const GAS bf16x8*)(Mx + (size_t)(row0 + (lane & 15)) * ld + k0 + 8 * (lane >> 4)); }
__device__ __forceinline__ bf16x8 trfrag(const LAS unsigned char* img, int stride, int r0, int r1, int col0, int lane) {
    const int q = (lane & 15) >> 2, p = lane & 3;
    const s16x4 a = __builtin_amdgcn_ds_read_tr16_b64_v4i16((LAS s16x4*)(img + (r0 + q) * stride + (col0 + 4 * p) * 2));
    const s16x4 b = __builtin_amdgcn_ds_read_tr16_b64_v4i16((LAS s16x4*)(img + (r1 + q) * stride + (col0 + 4 * p) * 2));
    return __builtin_shufflevector(a, b, 0, 1, 2, 3, 4, 5, 6, 7);
}
__device__ __forceinline__ float xsum4(float v) { v += __shfl_xor(v, 16); v += __shfl_xor(v, 32); return v; }
__device__ __forceinline__ float xmax4(float v) { v = fmaxf(v, __shfl_xor(v, 16)); v = fmaxf(v, __shfl_xor(v, 32)); return v; }

constexpr int SWA_VSTRIDE = 144;
constexpr int SWA_V_BYTES = 192 * SWA_VSTRIDE;
__device__ __forceinline__ void swa_unit_mfma(Ctx& C, int l, int unit) {
    const int b = unit >> 7, qb = unit & 127, q0 = qb * 64;
    const int tid = C.tid, lane = C.lane, w = C.wave, c = lane & 15, hq = lane >> 4;
    LAS unsigned char* Vimg = C.lds;
    LAS float* tb = (LAS float*)(C.lds + 30720);
    LAS float* ssqx = (LAS float*)(C.lds + 30720 + 12288);
    const bf16* PROJ = (const bf16*)(C.ws + WS_PROJ); float* OSWA = (float*)(C.ws + WS_OSWA); bf16* Y = (bf16*)(C.ws + WS_Y);
    const bf16* Pb = PROJ + (size_t)b * SEQ * DINP;
    __syncthreads();
    for (int i = tid; i < 16 * 192; i += NTHR) { const int hd = i / 192, x = i % 192, dist = x - 32; tb[i] = (dist >= 0 && dist < 128) ? C.in[I_REL_BIAS][T5_BUCKET[dist] * SWA_H + hd] : 0.f; }
    if (tid < 16 * 9) *(LAS v4u*)(Vimg + (192 + tid / 9) * SWA_VSTRIDE + 16 * (tid % 9)) = (v4u){0u, 0u, 0u, 0u};
    const int g = w >> 1, qhalf = w & 1;
    float ssq0 = 0.f, ssq1 = 0.f;
    for (int kvh = 0; kvh < 4; ++kvh) {
        const int head = kvh * 4 + g;
        __syncthreads();
#pragma unroll
        for (int it = 0; it < 3; ++it) { const int idx = tid + NTHR * it, j = idx >> 3, cg = idx & 7; int s = q0 - 128 + j; s = s < 0 ? 0 : s;
            const v4u v = *(const GAS v4u*)(Pb + (size_t)s * DINP + C_SV + kvh * 64 + 8 * cg); *(LAS v4u*)(Vimg + j * SWA_VSTRIDE + 16 * cg) = v; }
        __syncthreads();
        const float sink = C.in[I_SWA_SINKS][l * SWA_H + head];
#pragma nounroll
        for (int qt = 0; qt < 2; ++qt) {
            const int j0 = 32 * qhalf + 16 * qt;
            const bf16x8 qf0 = gfrag(Pb + C_SQ + head * 64, DINP, q0 + j0, 0, lane), qf1 = gfrag(Pb + C_SQ + head * 64, DINP, q0 + j0, 32, lane);
            f32x4 sacc[10];
#pragma unroll
            for (int kt = 0; kt < 10; ++kt) {
                int srow = q0 - 128 + j0 + 16 * kt + c; srow = srow < 0 ? 0 : srow; srow = srow > q0 + 63 ? q0 + 63 : srow;
                const bf16* kp = Pb + (size_t)srow * DINP + C_SK + kvh * 64 + 8 * hq;
                const bf16x8 k0 = *(const GAS bf16x8*)kp, k1 = *(const GAS bf16x8*)(kp + 32);
                f32x4 a = (f32x4){0.f, 0.f, 0.f, 0.f}; a = mfma16(k0, qf0, a); a = mfma16(k1, qf1, a); sacc[kt] = a;
            }
            float mx = sink;
#pragma unroll
            for (int kt = 0; kt < 10; ++kt)
#pragma unroll
                for (int r = 0; r < 4; ++r) { const int dist = c + 128 - 16 * kt - 4 * hq - r; const int s = q0 - 128 + j0 + 16 * kt + 4 * hq + r;
                    const bool valid = (dist >= 0) && (dist < 128) && (s >= 0);
                    const float sc = valid ? sacc[kt][r] * 0.125f + tb[head * 192 + dist + 32] : -1e30f;
                    sacc[kt][r] = sc; mx = fmaxf(mx, sc); }
            mx = xmax4(mx); float sum = 0.f;
#pragma unroll
            for (int kt = 0; kt < 10; ++kt)
#pragma unroll
                for (int r = 0; r < 4; ++r) { const float p = __expf(sacc[kt][r] - mx); sacc[kt][r] = p; sum += p; }
            sum = xsum4(sum); const float inv = 1.f / (sum + __expf(sink - mx));
            f32x4 oacc[4];
#pragma unroll
            for (int dt = 0; dt < 4; ++dt) oacc[dt] = (f32x4){0.f, 0.f, 0.f, 0.f};
#pragma unroll
            for (int ks = 0; ks < 5; ++ks) { const bf16x8 pf = pack8(sacc[2 * ks], sacc[2 * ks + 1]);
#pragma unroll
                for (int dt = 0; dt < 4; ++dt) oacc[dt] = mfma16(trfrag(Vimg, SWA_VSTRIDE, j0 + 32 * ks + 4 * hq, j0 + 32 * ks + 16 + 4 * hq, 16 * dt, lane), pf, oacc[dt]); }
            float sq = 0.f; float* op = OSWA + (size_t)(b * SEQ + q0 + j0 + c) * SWA_W + head * 64 + 4 * hq;
#pragma unroll
            for (int dt = 0; dt < 4; ++dt) { const f32x4 o = oacc[dt] * inv; sq += (o.x * o.x + o.y * o.y) + (o.z * o.z + o.w * o.w); *(GAS f32x4*)(op + 16 * dt) = o; }
            if (qt == 0) ssq0 += sq; else ssq1 += sq;
        }
    }
    ssq0 = xsum4(ssq0); ssq1 = xsum4(ssq1);
    if (hq == 0) { ssqx[w * 32 + c] = ssq0; ssqx[w * 32 + 16 + c] = ssq1; }
    asm volatile("s_waitcnt vmcnt(0)" ::: "memory");
    __syncthreads();
    const float* swa_norm = C.in[I_SWA_NORM] + (size_t)l * SWA_W;
#pragma nounroll
    for (int qt = 0; qt < 2; ++qt) { const int qi = 16 * qt + c;
        const float tot = ssqx[(qhalf + 0) * 32 + qi] + ssqx[(qhalf + 2) * 32 + qi] + ssqx[(qhalf + 4) * 32 + qi] + ssqx[(qhalf + 6) * 32 + qi];
        const float rstd = 1.f / sqrtf(tot * (1.f / 1024.f) + EPS);
        const size_t row = (size_t)(b * SEQ + q0 + 32 * qhalf + qi);
#pragma unroll
        for (int kvh = 0; kvh < 4; ++kvh)
#pragma unroll
            for (int dt = 0; dt < 4; ++dt) { const int col = (kvh * 4 + g) * 64 + 16 * dt + 4 * hq; const f32x4 o = *(const GAS f32x4*)(OSWA + row * SWA_W + col); const f32x4 gn = *(const GAS f32x4*)(swa_norm + col);
                v2u ow; ow.x = pk2(o.x * rstd * gn.x, o.y * rstd * gn.y); ow.y = pk2(o.z * rstd * gn.z, o.w * rstd * gn.w); *(GAS v2u*)(Y + row * DM + 2048 + col) = ow; } }
}

constexpr int N_SWA_UNITS = BATCH * (SEQ / 64);

constexpr int SSD_L = 128, SSD_NC = SEQ / SSD_L, GLA_L = 64, GLA_NC = SEQ / GLA_L;
constexpr int N_SSD_CU = BATCH * SSD_NC * 8, N_GLA_CU = BATCH * GLA_NC * 4;
constexpr int XI_STRIDE = 528, BI_STRIDE = 272;

__device__ __forceinline__ void prep_phase(Ctx& C, int l) {
    const bf16* PROJ = (const bf16*)(C.ws + WS_PROJ); bf16* XBC = (bf16*)(C.ws + WS_XBC);
    const int tid = C.tid, lane = C.lane;
    { const int gw0 = C.bid * NWAVES + C.wave;
      float* DT = (float*)(C.ws + WS_DT); float* ACS = (float*)(C.ws + WS_ACS); float* DEC = (float*)(C.ws + WS_DEC);
      for (int item = gw0; item < BATCH * SSD_NC * SSD_H; item += C.G * NWAVES) {
          const int h = item & 31, bc = item >> 5; const size_t r0 = (size_t)bc * SSD_L + 2 * lane;
          const float dtb = C.in[I_SSD_DT_BIAS][l * SSD_H + h], Ah = -expf(C.in[I_SSD_A_LOG][l * SSD_H + h]);
          const float x0 = bf1(PROJ[r0 * DINP + C_DT + h]) + dtb, x1 = bf1(PROJ[(r0 + 1) * DINP + C_DT + h]) + dtb;
          const float d0 = x0 > 20.f ? x0 : log1pf(expf(x0)), d1 = x1 > 20.f ? x1 : log1pf(expf(x1));
          const float a0 = d0 * Ah, a1 = d1 * Ah;
          float incl = a0 + a1;
#pragma unroll
          for (int o = 1; o < 64; o <<= 1) { const float t = __shfl_up(incl, o); if (lane >= o) incl += t; }
          const float c1 = incl, c0 = incl - a1;
          DT[r0 * SSD_H + h] = d0; DT[(r0 + 1) * SSD_H + h] = d1; ACS[r0 * SSD_H + h] = c0; ACS[(r0 + 1) * SSD_H + h] = c1;
          if (lane == 63) DEC[bc * SSD_H + h] = expf(c1);
      } }
    { const float* conv_w = C.in[I_SSD_CONV_W] + (size_t)l * 4 * SSD_CD; const float* conv_b = C.in[I_SSD_CONV_B] + (size_t)l * SSD_CD;
      const float* HT = (const float*)(C.ws + WS_XHT); const float* HB = (const float*)(C.ws + WS_XHB);
      constexpr int NIT = (M / 64) * 3 * 1024;
      for (int it = C.bid * NTHR + tid; it < NIT; it += C.G * NTHR) {
          const int c4 = it & 1023, ri = it >> 10, i = ri % 3, blk = ri / 3, c0 = 4 * c4; const bool first = (blk % (SEQ / 64)) == 0;
          f32x4 sq[6]; const f32x4 z4 = (f32x4){0.f, 0.f, 0.f, 0.f};
#pragma unroll
          for (int j = 0; j < 3; ++j) { sq[j] = first ? z4 : *(const GAS f32x4*)(HB + ((size_t)(blk - 1) * 3 + j) * 4096 + c0); sq[3 + j] = *(const GAS f32x4*)(HT + ((size_t)blk * 3 + j) * 4096 + c0); }
          const f32x4 x3 = i == 0 ? sq[0] : (i == 1 ? sq[1] : sq[2]), x2 = i == 0 ? sq[1] : (i == 1 ? sq[2] : sq[3]), x1 = i == 0 ? sq[2] : (i == 1 ? sq[3] : sq[4]), x0 = i == 0 ? sq[3] : (i == 1 ? sq[4] : sq[5]);
          const f32x4 w0 = *(const GAS f32x4*)(conv_w + c0), w1 = *(const GAS f32x4*)(conv_w + 4096 + c0), w2 = *(const GAS f32x4*)(conv_w + 2 * 4096 + c0), w3 = *(const GAS f32x4*)(conv_w + 3 * 4096 + c0), bb = *(const GAS f32x4*)(conv_b + c0);
          f32x4 o;
#pragma unroll
          for (int e = 0; e < 4; ++e) o[e] = silu_f(bb[e] + w0[e] * x3[e] + w1[e] * x2[e] + w2[e] * x1[e] + w3[e] * x0[e]);
          v2u ow; ow.x = pk2(o.x, o.y); ow.y = pk2(o.z, o.w); *(GAS v2u*)(XBC + (size_t)(64 * blk + i) * SSD_CD + c0) = ow;
      } }
    { LAS float* glr = (LAS float*)C.lds;
      bf16* QD = (bf16*)(C.ws + WS_QD); bf16* KI = (bf16*)(C.ws + WS_KI); float* GDEC = (float*)(C.ws + WS_GDEC);
      const float* w_gate = C.in[I_GLA_W_GATE] + (size_t)l * 16 * GLA_KT; const float bgv = C.in[I_GLA_B_GATE][l * GLA_KT + tid];
      float wg[16];
#pragma unroll
      for (int r = 0; r < 16; ++r) wg[r] = w_gate[r * GLA_KT + tid];
      for (int ck = C.bid; ck < BATCH * GLA_NC; ck += C.G) {
          const size_t row0 = (size_t)ck * GLA_L;
          __syncthreads();
          if (tid < 128) { const int t = tid >> 1, hf = tid & 1; const v4u r = *(const GAS v4u*)(PROJ + (row0 + t) * DINP + C_GLR + 8 * hf);
              *(LAS f32x4*)(glr + t * 16 + 8 * hf) = (f32x4){bflo(r.x), bfhi(r.x), bflo(r.y), bfhi(r.y)}; *(LAS f32x4*)(glr + t * 16 + 8 * hf + 4) = (f32x4){bflo(r.z), bfhi(r.z), bflo(r.w), bfhi(r.w)}; }
          __syncthreads();
          float cum = 0.f;
#pragma unroll 8
          for (int t = 0; t < GLA_L; ++t) {
              const float qv = bf1(PROJ[(row0 + t) * DINP + C_GQ + tid]), kv = bf1(PROJ[(row0 + t) * DINP + C_GK + tid]);
              float z = bgv;
#pragma unroll
              for (int r4 = 0; r4 < 4; ++r4) { const f32x4 gv = *(const LAS f32x4*)(glr + t * 16 + 4 * r4); z += gv.x * wg[4 * r4] + gv.y * wg[4 * r4 + 1] + gv.z * wg[4 * r4 + 2] + gv.w * wg[4 * r4 + 3]; }
              const float ls = fminf(z, 0.f) - __logf(1.f + __expf(-fabsf(z))); cum += ls * 0.0625f;
              QD[(row0 + t) * GLA_KT + tid] = (bf16)f2bf(qv * 0.08838834764831845f * __expf(cum)); KI[(row0 + t) * GLA_KT + tid] = (bf16)f2bf(kv * __expf(-cum));
          }
          GDEC[(size_t)ck * GLA_KT + tid] = __expf(cum);
      } }
}

__device__ __forceinline__ void gla_c1_unit(Ctx& C, int unit) {
    const int h = unit & 3, ck = unit >> 2; const size_t row0 = (size_t)ck * GLA_L;
    const int tid = C.tid, lane = C.lane, w = C.wave, c = lane & 15, hq = lane >> 4;
    LAS unsigned char* KEimg = C.lds; LAS unsigned char* Vimg = C.lds + 64 * BI_STRIDE;
    const bf16* PROJ = (const bf16*)(C.ws + WS_PROJ); const bf16* KI = (const bf16*)(C.ws + WS_KI); const float* GDEC = (const float*)(C.ws + WS_GDEC); bf16* GST = (bf16*)(C.ws + WS_GST);
    __syncthreads();
    { const int cg = tid & 15; const f32x4 d0 = *(const GAS f32x4*)(GDEC + (size_t)ck * GLA_KT + h * 128 + 8 * cg), d1 = *(const GAS f32x4*)(GDEC + (size_t)ck * GLA_KT + h * 128 + 8 * cg + 4);
#pragma unroll
      for (int it = 0; it < 2; ++it) { const int t = (tid + NTHR * it) >> 4; const v4u r = *(const GAS v4u*)(KI + (row0 + t) * GLA_KT + h * 128 + 8 * cg);
          v4u o; o.x = pk2(bflo(r.x) * d0.x, bfhi(r.x) * d0.y); o.y = pk2(bflo(r.y) * d0.z, bfhi(r.y) * d0.w); o.z = pk2(bflo(r.z) * d1.x, bfhi(r.z) * d1.y); o.w = pk2(bflo(r.w) * d1.z, bfhi(r.w) * d1.w);
          *(LAS v4u*)(KEimg + t * BI_STRIDE + 16 * cg) = o; } }
#pragma unroll
    for (int it = 0; it < 4; ++it) { const int idx = tid + NTHR * it, t = idx >> 5, cg = idx & 31; *(LAS v4u*)(Vimg + t * XI_STRIDE + 16 * cg) = *(const GAS v4u*)(PROJ + (row0 + t) * DINP + C_GV + h * 256 + 8 * cg); }
    __syncthreads();
    f32x4 acc[16];
#pragma unroll
    for (int nt = 0; nt < 16; ++nt) acc[nt] = (f32x4){0.f, 0.f, 0.f, 0.f};
#pragma unroll
    for (int ks = 0; ks < 2; ++ks) { const bf16x8 af = trfrag(KEimg, BI_STRIDE, 32 * ks + 8 * hq, 32 * ks + 8 * hq + 4, 16 * w, lane);
#pragma unroll
        for (int nt = 0; nt < 16; ++nt) acc[nt] = mfma16(af, trfrag(Vimg, XI_STRIDE, 32 * ks + 8 * hq, 32 * ks + 8 * hq + 4, 16 * nt, lane), acc[nt]); }
    bf16* gp = GST + (size_t)unit * 32768 + 16 * w + 4 * hq;
#pragma unroll
    for (int nt = 0; nt < 16; ++nt) { v2u o; o.x = pk2(acc[nt].x, acc[nt].y); o.y = pk2(acc[nt].z, acc[nt].w); *(GAS v2u*)(gp + (size_t)(16 * nt + c) * 128) = o; }
}

__device__ __forceinline__ void scan_phase(Ctx& C) {
    const bf16* GST = (const bf16*)(C.ws + WS_GST); bf16* GPV = (bf16*)(C.ws + WS_GPV); const float* GDEC = (const float*)(C.ws + WS_GDEC);
    const bf16* ST = (const bf16*)(C.ws + WS_ST); bf16* PV = (bf16*)(C.ws + WS_PV); const float* DEC = (const float*)(C.ws + WS_DEC);
    constexpr int N_G = BATCH * 4 * 256 * 64, N_S = BATCH * SSD_H * 64 * 32;
    for (int it = C.bid * NTHR + C.tid; it < N_S; it += C.G * NTHR) {
        const int n4 = it & 31, p = (it >> 5) & 63, h = (it >> 11) & 31, b = it >> 16;
        f32x4 run = (f32x4){0.f, 0.f, 0.f, 0.f};
#pragma unroll 8
        for (int c = 0; c < SSD_NC; ++c) { const size_t u = (size_t)(b * SSD_NC + c) * SSD_H + h; const size_t off = u * 8192 + p * 128 + 4 * n4;
            const v2u xr = *(const GAS v2u*)(ST + off); const f32x4 x = (f32x4){bflo(xr.x), bfhi(xr.x), bflo(xr.y), bfhi(xr.y)}; const float d = DEC[u];
            v2u o; o.x = pk2(run.x, run.y); o.y = pk2(run.z, run.w); *(GAS v2u*)(PV + off) = o;
            run = run * d + x; }
    }
    for (int it = C.bid * NTHR + C.tid; it < N_G; it += C.G * NTHR) {
        const int k2 = it & 63, v = (it >> 6) & 255, h = (it >> 14) & 3, b = it >> 16;
        float r0 = 0.f, r1 = 0.f;
#pragma unroll 8
        for (int c = 0; c < GLA_NC; ++c) { const size_t ck = (size_t)(b * GLA_NC + c); const size_t off = (ck * 4 + h) * 32768 + v * 128 + 2 * k2;
            const unsigned xr = *(const GAS unsigned*)(GST + off); const f32x2c d = *(const GAS f32x2c*)(GDEC + ck * GLA_KT + h * 128 + 2 * k2);
            *(GAS unsigned*)(GPV + off) = pk2(r0, r1);
            r0 = r0 * d.x + bflo(xr); r1 = r1 * d.y + bfhi(xr); }
    }
}

constexpr int GC3_GP_OFF = 64 * XI_STRIDE, GC3_XCH_OFF = GC3_GP_OFF + 256 * BI_STRIDE;
__device__ __forceinline__ void gla_c3_unit(Ctx& C, int l, int unit) {
    const int h = unit & 3, ck = unit >> 2; const size_t row0 = (size_t)ck * GLA_L;
    const int tid = C.tid, lane = C.lane, w = C.wave, c = lane & 15, hq = lane >> 4;
    LAS unsigned char* Vimg = C.lds; LAS unsigned char* GPimg = C.lds + GC3_GP_OFF; LAS float* xch = (LAS float*)(C.lds + GC3_XCH_OFF);
    const bf16* PROJ = (const bf16*)(C.ws + WS_PROJ); const bf16* QD = (const bf16*)(C.ws + WS_QD); const bf16* KI = (const bf16*)(C.ws + WS_KI); const bf16* GPV = (const bf16*)(C.ws + WS_GPV); bf16* Y = (bf16*)(C.ws + WS_Y);
    const int lt = w >> 1, vh = w & 1; const size_t row = row0 + 16 * lt + c;
    __syncthreads();
    { const bf16* gpv = GPV + (size_t)unit * 32768;
      v4u tv[4], tg[8];
#pragma unroll
      for (int it = 0; it < 4; ++it) { const int idx = tid + NTHR * it, t = idx >> 5, cg = idx & 31; tv[it] = *(const GAS v4u*)(PROJ + (row0 + t) * DINP + C_GV + h * 256 + 8 * cg); }
#pragma unroll
      for (int it = 0; it < 8; ++it) { const int idx = tid + NTHR * it; tg[it] = *(const GAS v4u*)(gpv + (size_t)idx * 8); }
#pragma unroll
      for (int it = 0; it < 4; ++it) { const int idx = tid + NTHR * it, t = idx >> 5, cg = idx & 31; *(LAS v4u*)(Vimg + t * XI_STRIDE + 16 * cg) = tv[it]; }
#pragma unroll
      for (int it = 0; it < 8; ++it) { const int idx = tid + NTHR * it, v = idx >> 4, cg = idx & 15; *(LAS v4u*)(GPimg + v * BI_STRIDE + 16 * cg) = tg[it]; } }
    bf16x8 qf[4];
#pragma unroll
    for (int ks = 0; ks < 4; ++ks) qf[ks] = gfrag(QD + row0 * GLA_KT + h * 128, GLA_KT, 16 * lt, 32 * ks, lane);
    v2u ggv[8];
#pragma unroll
    for (int vt = 0; vt < 8; ++vt) ggv[vt] = *(const GAS v2u*)(PROJ + row * DINP + C_GG + h * 256 + 16 * (8 * vh + vt) + 4 * hq);
    f32x4 att[4];
#pragma unroll
    for (int st = 0; st < 4; ++st) { f32x4 a = (f32x4){0.f, 0.f, 0.f, 0.f};
        if (st <= lt) {
#pragma unroll
            for (int ks = 0; ks < 4; ++ks) a = mfma16(gfrag(KI + row0 * GLA_KT + h * 128, GLA_KT, 16 * st, 32 * ks, lane), qf[ks], a);
#pragma unroll
            for (int r = 0; r < 4; ++r) if (16 * st + 4 * hq + r > 16 * lt + c) a[r] = 0.f;
        }
        att[st] = a; }
    __syncthreads();
    f32x4 oacc[8];
#pragma unroll
    for (int vt = 0; vt < 8; ++vt) oacc[vt] = (f32x4){0.f, 0.f, 0.f, 0.f};
#pragma unroll
    for (int ks = 0; ks < 4; ++ks)
#pragma unroll
        for (int vt = 0; vt < 8; ++vt) oacc[vt] = mfma16(*(const LAS bf16x8*)(GPimg + (16 * (8 * vh + vt) + c) * BI_STRIDE + (32 * ks + 8 * hq) * 2), qf[ks], oacc[vt]);
#pragma unroll
    for (int ks2 = 0; ks2 < 2; ++ks2) { const bf16x8 pf = pack8(att[2 * ks2], att[2 * ks2 + 1]);
#pragma unroll
        for (int vt = 0; vt < 8; ++vt) oacc[vt] = mfma16(trfrag(Vimg, XI_STRIDE, 32 * ks2 + 4 * hq, 32 * ks2 + 16 + 4 * hq, 16 * (8 * vh + vt), lane), pf, oacc[vt]); }
    float ssq = 0.f;
#pragma unroll
    for (int vt = 0; vt < 8; ++vt) ssq += (oacc[vt].x * oacc[vt].x + oacc[vt].y * oacc[vt].y) + (oacc[vt].z * oacc[vt].z + oacc[vt].w * oacc[vt].w);
    ssq = xsum4(ssq);
    if (hq == 0) xch[w * 16 + c] = ssq;
    __syncthreads();
    const float rstd = 1.f / sqrtf((xch[w * 16 + c] + xch[(w ^ 1) * 16 + c]) * (1.f / 256.f) + EPS);
    const float* gla_norm = C.in[I_GLA_NORM] + (size_t)l * 256;
#pragma unroll
    for (int vt = 0; vt < 8; ++vt) { const int v0 = 16 * (8 * vh + vt) + 4 * hq; const f32x4 gn = *(const GAS f32x4*)(gla_norm + v0); const v2u gg = ggv[vt];
        const f32x4 o = oacc[vt]; v2u ow; ow.x = pk2(o.x * rstd * gn.x * silu_f(bflo(gg.x)), o.y * rstd * gn.y * silu_f(bfhi(gg.x))); ow.y = pk2(o.z * rstd * gn.z * silu_f(bflo(gg.y)), o.w * rstd * gn.w * silu_f(bfhi(gg.y)));
        *(GAS v2u*)(Y + row * DM + 3072 + h * 256 + v0) = ow; }
}

__device__ __forceinline__ void ssd_c1_unit(Ctx& C, int unit) {
    const int g = unit & 7, bc = unit >> 3; const size_t row0 = (size_t)bc * SSD_L;
    const int tid = C.tid, lane = C.lane, w = C.wave, c = lane & 15, hq = lane >> 4;
    LAS float* acs = (LAS float*)C.lds; LAS float* dts = acs + 512;
    LAS unsigned char* XWimg = C.lds + 4096; LAS unsigned char* Bimg = C.lds + 4096 + 128 * XI_STRIDE;
    const bf16* XBC = (const bf16*)(C.ws + WS_XBC); const float* DT = (const float*)(C.ws + WS_DT); const float* ACS = (const float*)(C.ws + WS_ACS); bf16* ST = (bf16*)(C.ws + WS_ST);
    __syncthreads();
    { const int t = tid >> 2, hh = tid & 3; acs[hh * 128 + t] = ACS[(row0 + t) * SSD_H + 4 * g + hh]; dts[hh * 128 + t] = DT[(row0 + t) * SSD_H + 4 * g + hh]; }
    __syncthreads();
#pragma unroll
    for (int it = 0; it < 8; ++it) { const int idx = tid + NTHR * it, t = idx >> 5, cg = idx & 31, hh = cg >> 3; const float wgt = __expf(acs[hh * 128 + 127] - acs[hh * 128 + t]) * dts[hh * 128 + t];
        const v4u r = *(const GAS v4u*)(XBC + (row0 + t) * SSD_CD + g * 256 + 8 * cg);
        v4u o; o.x = pk2(bflo(r.x) * wgt, bfhi(r.x) * wgt); o.y = pk2(bflo(r.y) * wgt, bfhi(r.y) * wgt); o.z = pk2(bflo(r.z) * wgt, bfhi(r.z) * wgt); o.w = pk2(bflo(r.w) * wgt, bfhi(r.w) * wgt);
        *(LAS v4u*)(XWimg + t * XI_STRIDE + 16 * cg) = o; }
#pragma unroll
    for (int it = 0; it < 4; ++it) { const int idx = tid + NTHR * it, t = idx >> 4, cg = idx & 15; *(LAS v4u*)(Bimg + t * BI_STRIDE + 16 * cg) = *(const GAS v4u*)(XBC + (row0 + t) * SSD_CD + 2048 + g * 128 + 8 * cg); }
    __syncthreads();
    const int hh = w >> 1, ph = w & 1;
    f32x4 acc[8][2];
#pragma unroll
    for (int mt = 0; mt < 8; ++mt) { acc[mt][0] = (f32x4){0.f, 0.f, 0.f, 0.f}; acc[mt][1] = (f32x4){0.f, 0.f, 0.f, 0.f}; }
#pragma unroll
    for (int ks = 0; ks < 4; ++ks) { const int r0 = 32 * ks + 8 * hq;
        const bf16x8 x0 = trfrag(XWimg, XI_STRIDE, r0, r0 + 4, hh * 64 + 32 * ph, lane), x1 = trfrag(XWimg, XI_STRIDE, r0, r0 + 4, hh * 64 + 32 * ph + 16, lane);
#pragma unroll
        for (int mt = 0; mt < 8; ++mt) { const bf16x8 bf = trfrag(Bimg, BI_STRIDE, r0, r0 + 4, 16 * mt, lane); acc[mt][0] = mfma16(bf, x0, acc[mt][0]); acc[mt][1] = mfma16(bf, x1, acc[mt][1]); } }
    bf16* sp = ST + ((size_t)bc * SSD_H + 4 * g + hh) * 8192 + 4 * hq;
#pragma unroll
    for (int mt = 0; mt < 8; ++mt)
#pragma unroll
        for (int pt = 0; pt < 2; ++pt) { v2u o; o.x = pk2(acc[mt][pt].x, acc[mt][pt].y); o.y = pk2(acc[mt][pt].z, acc[mt][pt].w); *(GAS v2u*)(sp + (size_t)(32 * ph + 16 * pt + c) * 128 + 16 * mt) = o; }
}

constexpr int SC3_X_OFF = 4096, SC3_PV_OFF = SC3_X_OFF + 128 * XI_STRIDE, SC3_PV_HEAD = 64 * BI_STRIDE;
static_assert(SC3_PV_OFF + 4 * SC3_PV_HEAD <= MISC_OFF && GC3_XCH_OFF + 512 <= MISC_OFF, "mixer LDS maps");
__device__ __forceinline__ void ssd_c3_unit(Ctx& C, int l, int unit) {
    const int g = unit & 7, bc = unit >> 3; const size_t row0 = (size_t)bc * SSD_L;
    const int tid = C.tid, lane = C.lane, w = C.wave, c = lane & 15, hq = lane >> 4;
    LAS float* acs = (LAS float*)C.lds; LAS float* dts = acs + 512;
    LAS unsigned char* Ximg = C.lds + SC3_X_OFF; LAS unsigned char* PVimg = C.lds + SC3_PV_OFF;
    const bf16* PROJ = (const bf16*)(C.ws + WS_PROJ); const bf16* XBC = (const bf16*)(C.ws + WS_XBC); const float* DT = (const float*)(C.ws + WS_DT); const float* ACS = (const float*)(C.ws + WS_ACS);
    const bf16* PV = (const bf16*)(C.ws + WS_PV); bf16* Y = (bf16*)(C.ws + WS_Y);
    const int tl = 16 * w + c; const size_t row = row0 + tl;
    __syncthreads();
    { const int t = tid >> 2, hh = tid & 3; const float a0 = ACS[(row0 + t) * SSD_H + 4 * g + hh], d0 = DT[(row0 + t) * SSD_H + 4 * g + hh];
      const bf16* pvb = PV + ((size_t)bc * SSD_H + 4 * g) * 8192;
      v4u tx[8], tp[8];
#pragma unroll
      for (int it = 0; it < 8; ++it) { const int idx = tid + NTHR * it, t2 = idx >> 5, cg = idx & 31; tx[it] = *(const GAS v4u*)(XBC + (row0 + t2) * SSD_CD + g * 256 + 8 * cg); }
#pragma unroll
      for (int it = 0; it < 8; ++it) { const int idx = tid + NTHR * it; tp[it] = *(const GAS v4u*)(pvb + (size_t)idx * 8); }
      acs[(tid & 3) * 128 + (tid >> 2)] = a0; dts[(tid & 3) * 128 + (tid >> 2)] = d0;
#pragma unroll
      for (int it = 0; it < 8; ++it) { const int idx = tid + NTHR * it, t2 = idx >> 5, cg = idx & 31; *(LAS v4u*)(Ximg + t2 * XI_STRIDE + 16 * cg) = tx[it]; }
#pragma unroll
      for (int it = 0; it < 8; ++it) { const int idx = tid + NTHR * it, pr = idx >> 4, cg = idx & 15; *(LAS v4u*)(PVimg + pr * BI_STRIDE + 16 * cg) = tp[it]; } }
    bf16x8 cf[4];
#pragma unroll
    for (int ks = 0; ks < 4; ++ks) cf[ks] = gfrag(XBC + row0 * SSD_CD + 3072 + g * 128, SSD_CD, 16 * w, 32 * ks, lane);
    f32x4 cb[8];
#pragma unroll
    for (int st = 0; st < 8; ++st) { f32x4 a = (f32x4){0.f, 0.f, 0.f, 0.f};
        if (st <= w) {
#pragma unroll
            for (int ks = 0; ks < 4; ++ks) a = mfma16(gfrag(XBC + row0 * SSD_CD + 2048 + g * 128, SSD_CD, 16 * st, 32 * ks, lane), cf[ks], a);
        }
        cb[st] = a; }
    __syncthreads();
    v2u yk[4][4];
    float ssq = 0.f;
#pragma unroll
    for (int hh = 0; hh < 4; ++hh) {
        v2u zz[4];
#pragma unroll
        for (int pt = 0; pt < 4; ++pt) zz[pt] = *(const GAS v2u*)(PROJ + row * DINP + C_Z + g * 256 + hh * 64 + 16 * pt + 4 * hq);
        const float acs_l = acs[hh * 128 + tl], el = __expf(acs_l);
        f32x4 ya[4];
#pragma unroll
        for (int pt = 0; pt < 4; ++pt) ya[pt] = (f32x4){0.f, 0.f, 0.f, 0.f};
#pragma unroll
        for (int ks = 0; ks < 4; ++ks)
#pragma unroll
            for (int pt = 0; pt < 4; ++pt) ya[pt] = mfma16(*(const LAS bf16x8*)(PVimg + (hh * 64 + 16 * pt + c) * BI_STRIDE + (32 * ks + 8 * hq) * 2), cf[ks], ya[pt]);
#pragma unroll
        for (int pt = 0; pt < 4; ++pt) ya[pt] = ya[pt] * el;
#pragma unroll
        for (int ks2 = 0; ks2 < 4; ++ks2) {
            if (2 * ks2 <= w) {
                f32x4 lm[2];
#pragma unroll
                for (int t2 = 0; t2 < 2; ++t2) { const int s0 = 32 * ks2 + 16 * t2 + 4 * hq; const f32x4 as4 = *(const LAS f32x4*)(acs + hh * 128 + s0), dt4 = *(const LAS f32x4*)(dts + hh * 128 + s0);
#pragma unroll
                    for (int r = 0; r < 4; ++r) { const float d = fminf(acs_l - as4[r], 0.f); lm[t2][r] = (s0 + r <= tl) ? cb[2 * ks2 + t2][r] * __expf(d) * dt4[r] : 0.f; } }
                const bf16x8 pf = pack8(lm[0], lm[1]);
#pragma unroll
                for (int pt = 0; pt < 4; ++pt) ya[pt] = mfma16(trfrag(Ximg, XI_STRIDE, 32 * ks2 + 4 * hq, 32 * ks2 + 16 + 4 * hq, hh * 64 + 16 * pt, lane), pf, ya[pt]);
            }
        }
        const float Dh = C.in[I_SSD_D][l * SSD_H + 4 * g + hh];
#pragma unroll
        for (int pt = 0; pt < 4; ++pt) { const int col = hh * 64 + 16 * pt + 4 * hq; const v2u xw = *(const LAS v2u*)(Ximg + tl * XI_STRIDE + col * 2); const v2u z2 = zz[pt];
            f32x4 v; v.x = (ya[pt].x + Dh * bflo(xw.x)) * silu_f(bflo(z2.x)); v.y = (ya[pt].y + Dh * bfhi(xw.x)) * silu_f(bfhi(z2.x)); v.z = (ya[pt].z + Dh * bflo(xw.y)) * silu_f(bflo(z2.y)); v.w = (ya[pt].w + Dh * bfhi(xw.y)) * silu_f(bfhi(z2.y));
            { v2u pk; pk.x = pk2(v.x, v.y); pk.y = pk2(v.z, v.w); yk[hh][pt] = pk; } ssq += (v.x * v.x + v.y * v.y) + (v.z * v.z + v.w * v.w); }
    }
    ssq = xsum4(ssq);
    const float rstd = 1.f / sqrtf(ssq * (1.f / 256.f) + EPS);
    const float* ssd_norm = C.in[I_SSD_NORM] + (size_t)l * SSD_W + g * 256;
#pragma unroll
    for (int hh = 0; hh < 4; ++hh)
#pragma unroll
        for (int pt = 0; pt < 4; ++pt) { const int col = hh * 64 + 16 * pt + 4 * hq; const f32x4 gn = *(const GAS f32x4*)(ssd_norm + col); const f32x4 v = (f32x4){bflo(yk[hh][pt].x), bfhi(yk[hh][pt].x), bflo(yk[hh][pt].y), bfhi(yk[hh][pt].y)};
            v2u ow; ow.x = pk2(v.x * rstd * gn.x, v.y * rstd * gn.y); ow.y = pk2(v.z * rstd * gn.z, v.w * rstd * gn.w); *(GAS v2u*)(Y + row * DM + g * 256 + col) = ow; }
}

__device__ __forceinline__ void mix_c1_phase(Ctx& C, int l) {
    for (int u = C.bid; u < N_SSD_CU; u += C.G) ssd_c1_unit(C, u);
    for (int u = C.bid; u < N_GLA_CU; u += C.G) gla_c1_unit(C, u);
    for (int u = C.bid; u < N_SWA_UNITS; u += C.G) swa_unit_mfma(C, l, u);
}
__device__ __forceinline__ void mix_c3_phase(Ctx& C, int l) {
    for (int u = C.bid; u < N_SSD_CU; u += C.G) ssd_c3_unit(C, l, u);
    for (int u = C.bid; u < N_GLA_CU; u += C.G) gla_c3_unit(C, l, u);
}

__device__ __forceinline__ void act_fixup_phase(Ctx& C, int l) {
    bf16* ACT = (bf16*)(C.ws + WS_ACT); const float* HTG = (const float*)(C.ws + WS_HTG); const float* HTU = (const float*)(C.ws + WS_HTU); const float* HBG = (const float*)(C.ws + WS_HBG);
    const float* cw = C.in[I_FFN_CONV_W] + (size_t)l * 3 * DFF; const float* cb = C.in[I_FFN_CONV_B] + (size_t)l * DFF;
    constexpr int NC4 = DFF / 4, NIT = (M / 64) * 2 * NC4;
    for (int it = C.bid * NTHR + C.tid; it < NIT; it += C.G * NTHR) {
        const int c4 = it % NC4, ri = it / NC4, i = ri & 1, blk = ri >> 1, c0 = 4 * c4; const bool first = (blk % (SEQ / 64)) == 0;
        const f32x4 z4 = (f32x4){0.f, 0.f, 0.f, 0.f};
        const f32x4 g0 = *(const GAS f32x4*)(HTG + ((size_t)blk * 2 + i) * DFF + c0), up = *(const GAS f32x4*)(HTU + ((size_t)blk * 2 + i) * DFF + c0);
        const f32x4 pb1 = first ? z4 : *(const GAS f32x4*)(HBG + ((size_t)(blk - 1) * 2 + 1) * DFF + c0), pb0 = first ? z4 : *(const GAS f32x4*)(HBG + ((size_t)(blk - 1) * 2 + 0) * DFF + c0);
        const f32x4 g1 = i ? *(const GAS f32x4*)(HTG + ((size_t)blk * 2 + 0) * DFF + c0) : pb1, g2 = i ? pb1 : pb0;
        const f32x4 w0 = *(const GAS f32x4*)(cw + c0), w1 = *(const GAS f32x4*)(cw + DFF + c0), w2 = *(const GAS f32x4*)(cw + 2 * DFF + c0), bb = *(const GAS f32x4*)(cb + c0);
        f32x4 o;
#pragma unroll
        for (int e = 0; e < 4; ++e) { const float gc = bb[e] + w0[e] * g2[e] + w1[e] * g1[e] + w2[e] * g0[e]; o[e] = silu_f(gc) * up[e]; }
        v2u ow; ow.x = pk2(o.x, o.y); ow.y = pk2(o.z, o.w); *(GAS v2u*)(ACT + (size_t)(64 * blk + i) * DFF + c0) = ow;
    }
}

constexpr int PH_PER_LAYER = 11, PH_FINAL = DEPTH * PH_PER_LAYER, N_PHASES = PH_FINAL + 1;
#ifndef WGM_DOWN
#define WGM_DOWN 4
#endif
#ifndef MK_ONE_LAUNCH
#define MK_ONE_LAUNCH 1
#endif
__global__ void __launch_bounds__(NTHR, 2) fwd_kernel(Args args) {
    extern __shared__ __attribute__((aligned(16))) unsigned char lds[];
    Ctx C;
    C.lds = (LAS unsigned char*)lds;
    C.tid = threadIdx.x; C.lane = C.tid & 63; C.wave = __builtin_amdgcn_readfirstlane(C.tid >> 6);
    C.G = gridDim.x; C.bid = blockIdx.x;
    C.in = args.in; C.out = args.out; C.ws = args.ws;
    volatile LAS unsigned* MISC = (volatile LAS unsigned*)(C.lds + MISC_OFF);
    for (int u = C.tid; u < (LDS_BYTES - MISC_OFF) / 4; u += NTHR) ((LAS unsigned*)(C.lds + MISC_OFF))[u] = 0u;
    __syncthreads();
    gu32* ctl = (gu32*)(args.ws + WS_CTL);
    XcdBarrier bar = xcd_barrier_post((unsigned*)(ctl + CW_BAR) + args.li * XCD_BAR_WORDS, MISC + 8);
    const int lo = args.ph_lo, hi = args.ph_hi;
#define IN(k) (lo <= (k) && (k) < hi)
#define SEAM(k) do { if (IN(k) && IN((k) + 1)) xcd_barrier(bar); } while (0)
    float* xres = args.out;
    bf16* H = (bf16*)(args.ws + WS_H);
#define LAYER_BODY(l) do { \
        const int pb = l * PH_PER_LAYER; \
        const float* xin = (l == 0) ? args.in[I_X] : (const float*)xres; \
        if (IN(pb + 0)) { convert_weights(C, l); rmsnorm_phase(C, xin, args.in[I_ATTN_NORM] + (size_t)l * DM, H); } \
        SEAM(pb + 0); \
        if (IN(pb + 1)) { \
            pg8::Gemm g{H, (const bf16*)(args.ws + WS_WIN), M, DINP, DM}; pg8::StaticOrder S; S.init(M, DINP, C.G, C.bid); \
            pg8::EpiProjConv E{(bf16*)(args.ws + WS_PROJ), DINP, (bf16*)(args.ws + WS_XBC), args.in[I_SSD_CONV_W] + (size_t)l * 4 * SSD_CD, args.in[I_SSD_CONV_B] + (size_t)l * SSD_CD, (float*)(args.ws + WS_XHT), (float*)(args.ws + WS_XHB)}; \
            pg8::gemm_phase<pg8::EpiProjConv, pg8::StaticOrder, true, true>(C.lds, g, S, E); \
        } \
        SEAM(pb + 1); \
        if (IN(pb + 2)) prep_phase(C, l); \
        SEAM(pb + 2); \
        if (IN(pb + 3)) mix_c1_phase(C, l); \
        SEAM(pb + 3); \
        if (IN(pb + 4)) scan_phase(C); \
        SEAM(pb + 4); \
        if (IN(pb + 5)) mix_c3_phase(C, l); \
        SEAM(pb + 5); \
        if (IN(pb + 6)) { \
            pg8::Gemm g{(const bf16*)(args.ws + WS_Y), (const bf16*)(args.ws + WS_WOUT), M, DM, DM}; pg8::StaticOrder S; S.init(M, DM, C.G, C.bid); \
            pg8::EpiRes E{xin, xres, DM}; \
            pg8::gemm_phase<pg8::EpiRes, pg8::StaticOrder, true, true>(C.lds, g, S, E); \
        } \
        SEAM(pb + 6); \
        if (IN(pb + 7)) rmsnorm_phase(C, xres, args.in[I_FFN_NORM] + (size_t)l * DM, H); \
        SEAM(pb + 7); \
        if (IN(pb + 8)) { \
            pg8::Gemm g{H, (const bf16*)(args.ws + WS_WGU), M, DGU, DM}; pg8::StaticOrder S; S.init(M, DGU, C.G, C.bid); \
            pg8::EpiGateUp E{(bf16*)(args.ws + WS_ACT), args.in[I_FFN_CONV_W] + (size_t)l * 3 * DFF, args.in[I_FFN_CONV_B] + (size_t)l * DFF, (float*)(args.ws + WS_HTG), (float*)(args.ws + WS_HTU), (float*)(args.ws + WS_HBG), DFF}; \
            pg8::gemm_phase<pg8::EpiGateUp, pg8::StaticOrder, true, true>(C.lds, g, S, E); \
        } \
        SEAM(pb + 8); \
        if (IN(pb + 9)) act_fixup_phase(C, l); \
        SEAM(pb + 9); \
        if (IN(pb + 10)) { \
            pg8::Gemm g{(const bf16*)(args.ws + WS_ACT), (const bf16*)(args.ws + WS_WDN), M, DM, DFF}; pg8::StaticOrder S; S.init(M, DM, C.G, C.bid, WGM_DOWN); \
            pg8::EpiRes E{xres, xres, DM}; \
            pg8::gemm_phase<pg8::EpiRes, pg8::StaticOrder, true, true>(C.lds, g, S, E); \
        } \
        SEAM(pb + 10); \
     \
    } while (0)
    LAYER_BODY(0);
    LAYER_BODY(1);
#undef LAYER_BODY
    if (IN(PH_FINAL)) final_norm_phase(C, xres, args.in[I_FINAL_NORM]);
#undef IN
#undef SEAM
}

extern "C" void kernel_launch(void* const* d_in, const int* in_sizes, int n_in, void* d_out, int out_size, void* d_ws, size_t ws_size, hipStream_t stream) {
    static int grid = 0;
    if (grid == 0) {
        if (n_in != N_IN || out_size != M * DM || ws_size < WS_END) { fprintf(stderr, "kernel_launch: unexpected shapes (n_in %d, out %d, ws %zu < %zu)\n", n_in, out_size, ws_size, (size_t)WS_END); grid = -1; return; }
        int dev = 0, cus = 0, per_cu = 0;
        if (hipGetDevice(&dev) != hipSuccess || hipDeviceGetAttribute(&cus, hipDeviceAttributeMultiprocessorCount, dev) != hipSuccess) { grid = -1; return; }
        if (hipFuncSetAttribute((const void*)fwd_kernel, hipFuncAttributeMaxDynamicSharedMemorySize, LDS_BYTES) != hipSuccess) { fprintf(stderr, "kernel_launch: hipFuncSetAttribute failed\n"); grid = -1; return; }
        if (hipOccupancyMaxActiveBlocksPerMultiprocessor(&per_cu, (const void*)fwd_kernel, NTHR, LDS_BYTES) != hipSuccess || per_cu < 1) { fprintf(stderr, "kernel_launch: occupancy query says %d\n", per_cu); (void)hipGetLastError(); grid = -1; return; }
        grid = cus;
    }
    if (grid < 0) return;
    constexpr size_t kZero = (size_t)(CW_BAR + (MK_ONE_LAUNCH ? 1 : N_PHASES) * XCD_BAR_WORDS) * sizeof(unsigned);
    static_assert(kZero <= CTL_BYTES, "control region");
    if (hipMemsetAsync((char*)d_ws + WS_CTL, 0, kZero, stream) != hipSuccess) return;
    Args a{};
    for (int i = 0; i < N_IN; ++i) a.in[i] = (const float*)d_in[i];
    a.out = (float*)d_out; a.ws = (unsigned char*)d_ws; a.pad = 0;
#if MK_ONE_LAUNCH
    a.ph_lo = 0; a.ph_hi = N_PHASES; a.li = 0;
    hipLaunchKernelGGL(fwd_kernel, dim3(grid), dim3(NTHR), LDS_BYTES, stream, a);
#else
    for (int p = 0; p < N_PHASES; ++p) { a.ph_lo = p; a.ph_hi = p + 1; a.li = p;
        hipLaunchKernelGGL(fwd_kernel, dim3(grid), dim3(NTHR), LDS_BYTES, stream, a); }
#endif
}
```

```cpp
#include <hip/hip_runtime.h>
#include <cstdio>
#include <cstdint>
namespace pg8 {
#define PG8_LAS __attribute__((address_space(3)))
typedef unsigned short bf16_t;
typedef short bf16x8 __attribute__((ext_vector_type(8)));
typedef float f32x4 __attribute__((ext_vector_type(4)));
typedef unsigned u32x4 __attribute__((ext_vector_type(4)));
constexpr int BM = 256, BK = 64, HALF = 128, HTB = HALF * BK * 2  , STAGE_BYTES = 8 * HTB, NXCD = 8, WGM = 8;

__host__ __device__ __forceinline__ int lds_byte(int r, int c) { const int st = (r >> 4) * 2 + (c >> 5), rr = r & 15, cc = c & 31, ob = rr * 64 + cc * 2; return st * 1024 + (ob ^ (((ob >> 9) & 1) << 5)); }
__host__ __device__ __forceinline__ void stage_rc(int b, int& R, int& C) { const int st = b / 1024, sb = b % 1024, swz = sb ^ (((sb >> 9) & 1) << 5); R = (st >> 1) * 16 + swz / 64; C = (st & 1) * 32 + (swz % 64) / 2; }
__host__ __device__ __forceinline__ int perm32(int rho) { const int n = rho >> 4, i = rho & 15; return 8 * (i >> 2) + 4 * n + (i & 3); }

struct Unit { int pm, pn; };
struct Gemm { const bf16_t* A; const bf16_t* Bt; int M, N, K; };

struct StaticOrder {
    int nM, nN, nwg, G, c, wgm;
    __host__ __device__ void init(int M, int N, int G_, int c_, int wgm_ = WGM) { nM = M / BM; nN = N / BM; nwg = nM * nN; G = G_; c = c_; wgm = wgm_; }
    __host__ __device__ bool next(int i, Unit& u) const {
        const long L = (long)i * G + c; if (L >= nwg) return false;
        int wgid = (int)L; { const int q = nwg / NXCD, r = nwg % NXCD, xcd = wgid % NXCD, off = wgid / NXCD; wgid = (xcd < r ? xcd * (q + 1) : r * (q + 1) + (xcd - r) * q) + off; }
        const int nig = wgm * nN, gid = wgid / nig, fm = gid * wgm, gsz = (nM - fm) < wgm ? (nM - fm) : wgm;
        u.pm = fm + ((wgid % nig) % gsz); u.pn = (wgid % nig) / gsz; return true;
    }
    __device__ __forceinline__ void a_ready(const Unit&) const {}
    __device__ __forceinline__ void done(const Unit&) const {}
};

typedef float f32x2c __attribute__((ext_vector_type(2)));
typedef __bf16 bf16x2c __attribute__((ext_vector_type(2)));
__device__ __forceinline__ unsigned cvt_pk_bf16(float lo, float hi) { const f32x2c v = {lo, hi}; return __builtin_bit_cast(unsigned, __builtin_convertvector(v, bf16x2c)); }

struct EpiBf16 {
    static constexpr bool PERM = true, AFTER_DRAIN = false;
    bf16_t* O; int ldc;
    __device__ __forceinline__ void operator()(const f32x4 (&acc)[2][2][4][2], const Unit& u, int wr, int wc, int fr, int fq) const {
        const int row0 = u.pm * BM + wr * 64 + fr; const int col0 = u.pn * BM + wc * 32 + 8 * fq;
#pragma unroll
        for (int ai = 0; ai < 2; ++ai)
#pragma unroll
            for (int m = 0; m < 4; ++m) { bf16_t* rowp = O + (size_t)(row0 + ai * HALF + m * 16) * ldc + col0;
#pragma unroll
                for (int bj = 0; bj < 2; ++bj) { const f32x4 v0 = acc[ai][bj][m][0], v1 = acc[ai][bj][m][1];
                    u32x4 w; w.x = cvt_pk_bf16(v0[0], v0[1]); w.y = cvt_pk_bf16(v0[2], v0[3]); w.z = cvt_pk_bf16(v1[0], v1[1]); w.w = cvt_pk_bf16(v1[2], v1[3]);
                    *(u32x4*)(rowp + bj * HALF) = w; } }
    }
};
template <int CTRL> __device__ __forceinline__ float dpp_old(float old, float v) { return __int_as_float(__builtin_amdgcn_update_dpp(__float_as_int(old), __float_as_int(v), CTRL, 0xf, 0xf, false)); }
template <int CTRL> __device__ __forceinline__ float dpp_ror(float v) { return __int_as_float(__builtin_amdgcn_mov_dpp(__float_as_int(v), CTRL, 0xf, 0xf, true)); }
struct EpiGateUp {
    static constexpr bool PERM = true, AFTER_DRAIN = false;
    bf16_t* ACT; const float* cw; const float* cb; float* HTG; float* HTU; float* HBG; int dff;
    __device__ __forceinline__ void operator()(const f32x4 (&acc)[2][2][4][2], const Unit& u, int wr, int wc, int fr, int fq) const {
        const int j0 = u.pn * 128 + wc * 32 + 8 * fq;
        float w0[8], w1[8], w2[8], bb[8];
#pragma unroll
        for (int h = 0; h < 2; ++h) { const f32x4 a = *(const f32x4*)(cw + j0 + 4 * h), b = *(const f32x4*)(cw + dff + j0 + 4 * h), c = *(const f32x4*)(cw + 2 * dff + j0 + 4 * h), d = *(const f32x4*)(cb + j0 + 4 * h);
#pragma unroll
            for (int e = 0; e < 4; ++e) { w0[4 * h + e] = a[e]; w1[4 * h + e] = b[e]; w2[4 * h + e] = c[e]; bb[4 * h + e] = d[e]; } }
#pragma unroll
        for (int ai = 0; ai < 2; ++ai) {
            const int rowb = u.pm * BM + ai * HALF + wr * 64; const size_t blk = (size_t)(rowb >> 6);
#pragma unroll
            for (int m = 0; m < 4; ++m) {
                const int row = rowb + 16 * m + fr; float o[8];
#pragma unroll
                for (int n = 0; n < 2; ++n)
#pragma unroll
                    for (int e = 0; e < 4; ++e) { const int k = 4 * n + e; const float g0 = acc[ai][0][m][n][e], up = acc[ai][1][m][n][e]; const float gp = acc[ai][0][m > 0 ? m - 1 : 0][n][e];
                        const float g1 = dpp_ror<0x121>(m > 0 && fr == 15 ? gp : g0), g2 = dpp_ror<0x122>(m > 0 && fr >= 14 ? gp : g0);
                        const float gc = bb[k] + w0[k] * g2 + w1[k] * g1 + w2[k] * g0; o[k] = gc * __builtin_amdgcn_rcpf(1.f + __expf(-gc)) * up; }
                u32x4 w; w.x = cvt_pk_bf16(o[0], o[1]); w.y = cvt_pk_bf16(o[2], o[3]); w.z = cvt_pk_bf16(o[4], o[5]); w.w = cvt_pk_bf16(o[6], o[7]);
                if (!(m == 0 && fr < 2)) __builtin_nontemporal_store(w, (u32x4*)(ACT + (size_t)row * dff + j0));
                if (m == 0 && fr < 2) { float* pg = HTG + (blk * 2 + fr) * dff + j0; float* pu = HTU + (blk * 2 + fr) * dff + j0;
                    *(f32x4*)pg = acc[ai][0][0][0]; *(f32x4*)(pg + 4) = acc[ai][0][0][1]; *(f32x4*)pu = acc[ai][1][0][0]; *(f32x4*)(pu + 4) = acc[ai][1][0][1]; }
                if (m == 3 && fr >= 14) { float* pg = HBG + (blk * 2 + (fr - 14)) * dff + j0; *(f32x4*)pg = acc[ai][0][3][0]; *(f32x4*)(pg + 4) = acc[ai][0][3][1]; }
            }
        }
    }
};
struct EpiProjConv {
    static constexpr bool PERM = true, AFTER_DRAIN = false;
    bf16_t* O; int ldc; bf16_t* XBC; const float* cw; const float* cb; float* HT; float* HB;
    __device__ __forceinline__ void operator()(const f32x4 (&acc)[2][2][4][2], const Unit& u, int wr, int wc, int fr, int fq) const {
        if (u.pn < 8 || u.pn >= 24) {
            const int row0 = u.pm * BM + wr * 64 + fr; const int col0 = u.pn * BM + wc * 32 + 8 * fq;
#pragma unroll
            for (int ai = 0; ai < 2; ++ai)
#pragma unroll
                for (int m = 0; m < 4; ++m) { bf16_t* rowp = O + (size_t)(row0 + ai * HALF + m * 16) * ldc + col0;
#pragma unroll
                    for (int bj = 0; bj < 2; ++bj) { const f32x4 v0 = acc[ai][bj][m][0], v1 = acc[ai][bj][m][1];
                        u32x4 w; w.x = cvt_pk_bf16(v0[0], v0[1]); w.y = cvt_pk_bf16(v0[2], v0[3]); w.z = cvt_pk_bf16(v1[0], v1[1]); w.w = cvt_pk_bf16(v1[2], v1[3]);
                        __builtin_nontemporal_store(w, (u32x4*)(rowp + bj * HALF)); } }
            return;
        }
#pragma unroll
        for (int bj = 0; bj < 2; ++bj) {
            const int c0 = (u.pn - 8) * BM + bj * HALF + wc * 32 + 8 * fq;
            float wv[4][8], bb[8];
#pragma unroll
            for (int h = 0; h < 2; ++h) { const f32x4 d = *(const f32x4*)(cb + c0 + 4 * h);
#pragma unroll
                for (int e = 0; e < 4; ++e) bb[4 * h + e] = d[e];
#pragma unroll
                for (int i = 0; i < 4; ++i) { const f32x4 a = *(const f32x4*)(cw + i * 4096 + c0 + 4 * h);
#pragma unroll
                    for (int e = 0; e < 4; ++e) wv[i][4 * h + e] = a[e]; } }
#pragma unroll
            for (int ai = 0; ai < 2; ++ai) {
                const int rowb = u.pm * BM + ai * HALF + wr * 64; const size_t blk = (size_t)(rowb >> 6);
#pragma unroll
                for (int m = 0; m < 4; ++m) {
                    const int row = rowb + 16 * m + fr; float o[8];
#pragma unroll
                    for (int n = 0; n < 2; ++n)
#pragma unroll
                        for (int e = 0; e < 4; ++e) { const int k = 4 * n + e; const float x0 = acc[ai][bj][m][n][e]; const float xp = acc[ai][bj][m > 0 ? m - 1 : 0][n][e];
                            const float x1 = dpp_ror<0x121>(m > 0 && fr == 15 ? xp : x0), x2 = dpp_ror<0x122>(m > 0 && fr >= 14 ? xp : x0), x3 = dpp_ror<0x123>(m > 0 && fr >= 13 ? xp : x0);
                            const float a = bb[k] + wv[0][k] * x3 + wv[1][k] * x2 + wv[2][k] * x1 + wv[3][k] * x0; o[k] = a * __builtin_amdgcn_rcpf(1.f + __expf(-a)); }
                    u32x4 w; w.x = cvt_pk_bf16(o[0], o[1]); w.y = cvt_pk_bf16(o[2], o[3]); w.z = cvt_pk_bf16(o[4], o[5]); w.w = cvt_pk_bf16(o[6], o[7]);
                    if (!(m == 0 && fr < 3)) __builtin_nontemporal_store(w, (u32x4*)(XBC + (size_t)row * 4096 + c0));
                    if (m == 0 && fr < 3) { float* p = HT + (blk * 3 + fr) * 4096 + c0; *(f32x4*)p = acc[ai][bj][0][0]; *(f32x4*)(p + 4) = acc[ai][bj][0][1]; }
                    if (m == 3 && fr >= 13) { float* p = HB + (blk * 3 + (fr - 13)) * 4096 + c0; *(f32x4*)p = acc[ai][bj][3][0]; *(f32x4*)(p + 4) = acc[ai][bj][3][1]; }
                }
            }
        }
    }
};
struct EpiRes {
    static constexpr bool PERM = false, AFTER_DRAIN = false;
    const float* base; float* out; int ldc;
    __device__ __forceinline__ void operator()(const f32x4 (&acc)[2][2][4][2], const Unit& u, int wr, int wc, int fr, int fq) const {
        const int row0 = u.pm * BM + wr * 64 + fr, col0 = u.pn * BM + wc * 32 + 4 * fq;
#pragma unroll
        for (int ai = 0; ai < 2; ++ai)
#pragma unroll
            for (int m = 0; m < 4; ++m) { const size_t off = (size_t)(row0 + ai * HALF + m * 16) * ldc + col0;
#pragma unroll
                for (int bj = 0; bj < 2; ++bj)
#pragma unroll
                    for (int n = 0; n < 2; ++n) { const f32x4 bs = *(const f32x4*)(base + off + bj * HALF + n * 16); *(f32x4*)(out + off + bj * HALF + n * 16) = bs + acc[ai][bj][m][n]; } }
    }
};
template <bool BASE_F32> struct EpiResB {
    static constexpr bool PERM = true, AFTER_DRAIN = false;
    const void* base; bf16_t* out; int ldc;
    __device__ __forceinline__ void operator()(const f32x4 (&acc)[2][2][4][2], const Unit& u, int wr, int wc, int fr, int fq) const {
        const int row0 = u.pm * BM + wr * 64 + fr, col0 = u.pn * BM + wc * 32 + 8 * fq;
#pragma unroll
        for (int ai = 0; ai < 2; ++ai)
#pragma unroll
            for (int m = 0; m < 4; ++m) { const size_t off = (size_t)(row0 + ai * HALF + m * 16) * ldc + col0;
#pragma unroll
                for (int bj = 0; bj < 2; ++bj) { f32x4 b0, b1;
                    if (BASE_F32) { const float* bp = (const float*)base + off + bj * HALF; b0 = *(const f32x4*)bp; b1 = *(const f32x4*)(bp + 4); }
                    else { const u32x4 w = *(const u32x4*)((const bf16_t*)base + off + bj * HALF);
                        b0 = (f32x4){__uint_as_float(w.x << 16), __uint_as_float(w.x & 0xffff0000u), __uint_as_float(w.y << 16), __uint_as_float(w.y & 0xffff0000u)};
                        b1 = (f32x4){__uint_as_float(w.z << 16), __uint_as_float(w.z & 0xffff0000u), __uint_as_float(w.w << 16), __uint_as_float(w.w & 0xffff0000u)}; }
                    const f32x4 o0 = b0 + acc[ai][bj][m][0], o1 = b1 + acc[ai][bj][m][1];
                    u32x4 ow; ow.x = cvt_pk_bf16(o0[0], o0[1]); ow.y = cvt_pk_bf16(o0[2], o0[3]); ow.z = cvt_pk_bf16(o1[0], o1[1]); ow.w = cvt_pk_bf16(o1[2], o1[3]);
                    *(u32x4*)(out + off + bj * HALF) = ow; } }
    }
};
template <class Epi, class Sched, bool ALIGN_EPI = false, bool SP2 = false>
__device__ __forceinline__ void gemm_phase(PG8_LAS unsigned char* lds, const Gemm g, const Sched& S, const Epi& E) {
    const int tid = threadIdx.x, wid = __builtin_amdgcn_readfirstlane(tid >> 6), lane = tid & 63, wr = wid >> 2, wc = wid & 3, fr = lane & 15, fq = lane >> 4;
    const int K = g.K, nt = K / BK;
    unsigned voffA[2], voffB[2];
#pragma unroll
    for (int i = 0; i < 2; ++i) { int R, C; stage_rc(tid * 16 + i * 8192, R, C); const int Rb = Epi::PERM ? ((R & ~31) + perm32(R & 31)) : R;
        voffA[i] = (unsigned)(R * K + C) * 2u; voffB[i] = (unsigned)(Rb * K + C) * 2u; }
    const size_t kstep = (size_t)(BK * 2);
    const size_t hstep = (size_t)HALF * K * 2;
    const size_t tstep = 2 * hstep;
    const unsigned ldsw = (unsigned)wid * 1024u;
    const int aoff = lds_byte(wr * 64 + fr, fq * 8), boff = lds_byte(wc * 32 + fr, fq * 8);
#define PG8_SA(b, h) (((b) * 2 + (h)) * HTB)
#define PG8_SB(b, h) ((4 + (b) * 2 + (h)) * HTB)
#define PG8_STAGE(bufoff, gbase, voff) do { _Pragma("unroll") for (int _i = 0; _i < 2; ++_i) \
        __builtin_amdgcn_global_load_lds((const unsigned*)((const char*)(gbase) + (voff)[_i]), (PG8_LAS unsigned*)(lds + (bufoff) + ldsw + _i * 8192), 16, 0, 0); } while (0)
#define PG8_LDA(dst, b, h) do { _Pragma("unroll") for (int m = 0; m < 4; ++m) _Pragma("unroll") for (int k = 0; k < 2; ++k) dst[m][k] = *(const PG8_LAS bf16x8*)(lds + PG8_SA(b, h) + aoff + m * 2048 + k * 1024); } while (0)
#define PG8_LDB(dst, b, h) do { _Pragma("unroll") for (int n = 0; n < 2; ++n) _Pragma("unroll") for (int k = 0; k < 2; ++k) dst[n][k] = *(const PG8_LAS bf16x8*)(lds + PG8_SB(b, h) + boff + n * 2048 + k * 1024); } while (0)
#define PG8_MMA(ai, bj, At, Bt) do { __builtin_amdgcn_s_setprio(1); _Pragma("unroll") for (int m = 0; m < 4; ++m) _Pragma("unroll") for (int n = 0; n < 2; ++n) _Pragma("unroll") for (int k = 0; k < 2; ++k) \
        acc[ai][bj][m][n] = __builtin_amdgcn_mfma_f32_16x16x32_bf16(Bt[n][k], At[m][k], acc[ai][bj][m][n], 0, 0, 0); __builtin_amdgcn_s_setprio(0); } while (0)
#define PG8_WAIT_V(n) asm volatile("s_waitcnt vmcnt(" #n ")" ::: "memory")
#define PG8_WAIT_L(n) asm volatile("s_waitcnt lgkmcnt(" #n ")" ::: "memory")
#define PG8_BAR __builtin_amdgcn_s_barrier()
#define PG8_SCHED __builtin_amdgcn_sched_barrier(0)
    Unit cur, nxt; int ui = 0;
    if (!S.next(0, cur)) return;
    f32x4 acc[2][2][4][2];
#pragma unroll
    for (int a = 0; a < 2; ++a)
#pragma unroll
        for (int b = 0; b < 2; ++b)
#pragma unroll
            for (int m = 0; m < 4; ++m)
#pragma unroll
                for (int n = 0; n < 2; ++n) acc[a][b][m][n] = (f32x4){0.f, 0.f, 0.f, 0.f};
    bf16x8 At[4][2], B0[2][2], B1[2][2];
    const char* cA = (const char*)g.A + (size_t)cur.pm * tstep; const char* cB = (const char*)g.Bt + (size_t)cur.pn * tstep;
    S.a_ready(cur);
    if constexpr (SP2) {
        PG8_STAGE(PG8_SB(0, 0), cB, voffB); PG8_STAGE(PG8_SB(0, 1), cB + hstep, voffB); PG8_STAGE(PG8_SA(0, 0), cA, voffA); PG8_STAGE(PG8_SA(0, 1), cA + hstep, voffA);
        if (wr == 1) PG8_BAR;
        PG8_WAIT_V(2); PG8_BAR;
        PG8_STAGE(PG8_SB(1, 0), cB + kstep, voffB); PG8_STAGE(PG8_SA(1, 0), cA + kstep, voffA); PG8_STAGE(PG8_SB(1, 1), cB + hstep + kstep, voffB);
        PG8_WAIT_V(6); PG8_BAR;
    } else {
        PG8_STAGE(PG8_SB(0, 0), cB, voffB); PG8_STAGE(PG8_SA(0, 0), cA, voffA); PG8_STAGE(PG8_SB(0, 1), cB + hstep, voffB); PG8_STAGE(PG8_SA(0, 1), cA + hstep, voffA);
        if (wr == 1) PG8_BAR;
        PG8_WAIT_V(4); PG8_BAR;
        PG8_STAGE(PG8_SB(1, 0), cB + kstep, voffB); PG8_STAGE(PG8_SA(1, 0), cA + kstep, voffA); PG8_STAGE(PG8_SB(1, 1), cB + hstep + kstep, voffB);
        PG8_WAIT_V(6); PG8_BAR;
    }
    for (;;) {
        const bool has_next = S.next(ui + 1, nxt);
        const char* nA = has_next ? (const char*)g.A + (size_t)nxt.pm * tstep : cA; const char* nB = has_next ? (const char*)g.Bt + (size_t)nxt.pn * tstep : cB;
        for (int t = 0; t < nt; t += 2) {
            const bool last = (t == nt - 2);
            const char* a1 = cA + (size_t)(t + 1) * kstep;
            const char* a2 = last ? nA : cA + (size_t)(t + 2) * kstep; const char* b2 = last ? nB : cB + (size_t)(t + 2) * kstep;
            const char* a3 = a2 + kstep; const char* b3 = b2 + kstep;
            if (last && has_next) S.a_ready(nxt);
            if constexpr (SP2) {
            PG8_LDB(B0, 0, 0); PG8_LDB(B1, 0, 1); PG8_SCHED; PG8_LDA(At, 0, 0); PG8_STAGE(PG8_SA(1, 1), a1 + hstep, voffA);
            PG8_WAIT_V(8); PG8_WAIT_L(0); PG8_BAR; PG8_MMA(0, 0, At, B0); PG8_MMA(0, 1, At, B1); PG8_BAR; PG8_SCHED;
            PG8_LDA(At, 0, 1); PG8_STAGE(PG8_SB(0, 0), b2, voffB); PG8_STAGE(PG8_SB(0, 1), b2 + hstep, voffB); PG8_STAGE(PG8_SA(0, 0), a2, voffA);
            PG8_WAIT_V(8); PG8_WAIT_L(0); PG8_BAR; PG8_MMA(1, 0, At, B0); PG8_MMA(1, 1, At, B1); PG8_BAR; PG8_SCHED;
            PG8_LDB(B0, 1, 0); PG8_LDB(B1, 1, 1); PG8_SCHED; PG8_LDA(At, 1, 0); PG8_STAGE(PG8_SA(0, 1), a2 + hstep, voffA);
            PG8_WAIT_V(8); PG8_WAIT_L(0); PG8_BAR; PG8_MMA(0, 0, At, B0); PG8_MMA(0, 1, At, B1); PG8_BAR; PG8_SCHED;
            PG8_LDA(At, 1, 1); PG8_STAGE(PG8_SB(1, 0), b3, voffB); PG8_STAGE(PG8_SB(1, 1), b3 + hstep, voffB); PG8_STAGE(PG8_SA(1, 0), a3, voffA);
            PG8_WAIT_V(8); PG8_WAIT_L(0); PG8_BAR; PG8_MMA(1, 0, At, B0); PG8_MMA(1, 1, At, B1); PG8_BAR; PG8_SCHED;
            } else {
            PG8_LDB(B0, 0, 0); PG8_SCHED; PG8_LDA(At, 0, 0); PG8_STAGE(PG8_SA(1, 1), a1 + hstep, voffA);
            PG8_WAIT_L(8); PG8_BAR; PG8_WAIT_L(0); PG8_MMA(0, 0, At, B0); PG8_BAR; PG8_SCHED;
            PG8_LDB(B1, 0, 1); PG8_STAGE(PG8_SB(0, 0), b2, voffB);
            PG8_BAR; PG8_WAIT_L(0); PG8_MMA(0, 1, At, B1); PG8_BAR;
            PG8_LDA(At, 0, 1); PG8_STAGE(PG8_SA(0, 0), a2, voffA);
            PG8_BAR; PG8_WAIT_L(0); PG8_MMA(1, 0, At, B0); PG8_BAR; PG8_SCHED;
            PG8_STAGE(PG8_SB(0, 1), b2 + hstep, voffB);
            PG8_WAIT_V(6); PG8_BAR; PG8_MMA(1, 1, At, B1); PG8_BAR;
            PG8_LDB(B0, 1, 0); PG8_SCHED; PG8_LDA(At, 1, 0); PG8_STAGE(PG8_SA(0, 1), a2 + hstep, voffA);
            PG8_WAIT_L(8); PG8_BAR; PG8_WAIT_L(0); PG8_MMA(0, 0, At, B0); PG8_BAR; PG8_SCHED;
            PG8_LDB(B1, 1, 1); PG8_STAGE(PG8_SB(1, 0), b3, voffB);
            PG8_BAR; PG8_WAIT_L(0); PG8_MMA(0, 1, At, B1); PG8_BAR;
            PG8_LDA(At, 1, 1); PG8_STAGE(PG8_SA(1, 0), a3, voffA);
            PG8_BAR; PG8_WAIT_L(0); PG8_MMA(1, 0, At, B0); PG8_BAR; PG8_SCHED;
            PG8_STAGE(PG8_SB(1, 1), b3 + hstep, voffB);
            PG8_WAIT_V(6); PG8_BAR; PG8_MMA(1, 1, At, B1); PG8_BAR;
            }
        }
        if constexpr (ALIGN_EPI) { if (wr == 0) PG8_BAR; }
        if constexpr (!Epi::AFTER_DRAIN) { E(acc, cur, wr, wc, fr, fq); S.done(cur); }
        if (!has_next) break;
#pragma unroll
        for (int a = 0; a < 2; ++a)
#pragma unroll
            for (int b = 0; b < 2; ++b)
#pragma unroll
                for (int m = 0; m < 4; ++m)
#pragma unroll
                    for (int n = 0; n < 2; ++n) acc[a][b][m][n] = (f32x4){0.f, 0.f, 0.f, 0.f};
        cur = nxt; cA = nA; cB = nB; ++ui;
        if constexpr (ALIGN_EPI) { if (wr == 1) PG8_BAR; }
    }
    PG8_WAIT_V(0);
    if constexpr (!ALIGN_EPI) { if (wr == 0) PG8_BAR; }
    PG8_BAR;
    if constexpr (Epi::AFTER_DRAIN) { E.fused(acc, cur, wr, wc, fr, fq, lds, wid, lane); S.done(cur); }
#undef PG8_SA
#undef PG8_SB
#undef PG8_STAGE
#undef PG8_LDA
#undef PG8_LDB
#undef PG8_MMA
#undef PG8_WAIT_V
#undef PG8_WAIT_L
#undef PG8_BAR
#undef PG8_SCHED
}
}

constexpr int NWAVES = 8, NTHR = NWAVES * 64;
constexpr int BATCH = 2, SEQ = 8192, M = BATCH * SEQ, DM = 4096, DEPTH = 2;
constexpr int SSD_W = 2048, SSD_H = 32, SSD_CD = 4096;
constexpr int SWA_W = 1024, SWA_H = 16;
constexpr int GLA_W = 1024, GLA_KT = 512;
constexpr int DFF = 11008, DIN = 10800, DINP = 11008, DGU = 2 * DFF;
constexpr float EPS = 1e-6f;
constexpr int C_Z = 0, C_XBC = 2048, C_DT = 6144, C_SQ = 6176, C_SK = 7200, C_SV = 7456, C_GQ = 7712, C_GK = 8224, C_GV = 8736, C_GG = 9760, C_GLR = 10784;
enum { I_X = 0, I_ATTN_NORM, I_W_IN, I_SSD_CONV_W, I_SSD_CONV_B, I_SSD_DT_BIAS, I_SSD_A_LOG, I_SSD_D, I_SSD_NORM, I_SWA_SINKS, I_SWA_NORM, I_GLA_W_GATE, I_GLA_B_GATE, I_GLA_NORM,
       I_W_OUT, I_FFN_NORM, I_W_GATE, I_W_UP, I_FFN_CONV_W, I_FFN_CONV_B, I_W_DOWN, I_REL_BIAS, I_FINAL_NORM, N_IN };

constexpr size_t MiB = 1u << 20;
constexpr size_t WS_CTL = 0, CTL_BYTES = 1 * MiB;
constexpr size_t WS_WIN = 1 * MiB;
constexpr size_t WS_WOUT = 87 * MiB;
constexpr size_t WS_WGU = 119 * MiB;
constexpr size_t WS_WDN = 291 * MiB;
constexpr size_t WS_H = 377 * MiB;
constexpr size_t WS_R = 505 * MiB;
constexpr size_t WS_PROJ = WS_R;
constexpr size_t WS_XBC = WS_R + 344 * MiB;
constexpr size_t WS_QD = WS_R + 472 * MiB;
constexpr size_t WS_KI = WS_R + 488 * MiB;
constexpr size_t WS_DT = WS_R + 520 * MiB;
constexpr size_t WS_ACS = WS_R + 522 * MiB;
constexpr size_t WS_DEC = WS_R + 524 * MiB;
constexpr size_t WS_GDEC = WS_R + 525 * MiB;
constexpr size_t WS_ST = WS_R + 528 * MiB;
constexpr size_t WS_PV = WS_R + 592 * MiB;
constexpr size_t WS_GST = WS_R + 656 * MiB;
constexpr size_t WS_GPV = WS_R + 720 * MiB;
constexpr size_t WS_OSWA = WS_R + 784 * MiB;
constexpr size_t WS_Y = WS_R + 816 * MiB;
constexpr size_t WS_XHT = WS_R + 504 * MiB, WS_XHB = WS_R + 944 * MiB;
constexpr size_t WS_XB = WS_R + 956 * MiB;
constexpr size_t WS_ACT = WS_R;
constexpr size_t WS_HTG = WS_R + 344 * MiB, WS_HTU = WS_R + 366 * MiB, WS_HBG = WS_R + 388 * MiB;
constexpr size_t WS_END = WS_R + 1084 * MiB;
static_assert(DEPTH == 2 && (size_t)DINP * DM * 2 == 86 * MiB && (size_t)DGU * DM * 2 == 172 * MiB && (size_t)M * DINP * 2 == 344 * MiB , "ws map");
constexpr int CW_BAR = 4096;

constexpr int RING_BYTES = 131072;
constexpr int MISC_OFF = 147456 - 256;
constexpr int LDS_BYTES = 147456;

#define GAS __attribute__((address_space(1)))
#define LAS __attribute__((address_space(3)))
typedef unsigned short bf16;
typedef unsigned v4u __attribute__((ext_vector_type(4)));
typedef unsigned v2u __attribute__((ext_vector_type(2)));
typedef float f32x4 __attribute__((ext_vector_type(4)));
typedef GAS unsigned gu32;
typedef float f32x2c __attribute__((ext_vector_type(2)));
#define RLX_AGENT __ATOMIC_RELAXED, __HIP_MEMORY_SCOPE_AGENT
#define LDS_WAIT() asm volatile("s_waitcnt lgkmcnt(0)" ::: "memory")
__device__ __forceinline__ unsigned f2bf(float f) { unsigned u = __builtin_bit_cast(unsigned, f); return (u + 0x7fffu + ((u >> 16) & 1u)) >> 16; }
__device__ __forceinline__ unsigned pk2(float lo, float hi) { return pg8::cvt_pk_bf16(lo, hi); }
__device__ __forceinline__ float bflo(unsigned w) { return __uint_as_float(w << 16); }
__device__ __forceinline__ float bfhi(unsigned w) { return __uint_as_float(w & 0xffff0000u); }
__device__ __forceinline__ float bf1(bf16 h) { return __uint_as_float((unsigned)h << 16); }
__device__ __forceinline__ float silu_f(float x) { return x * __builtin_amdgcn_rcpf(1.f + __expf(-x)); }
__device__ __forceinline__ float wave_sum(float v) {
#pragma unroll
    for (int o = 1; o < 64; o <<= 1) v += __shfl_xor(v, o);
    return v;
}
template <int CTRL> __device__ __forceinline__ float dpp_f(float v) { return __int_as_float(__builtin_amdgcn_update_dpp(0, __float_as_int(v), CTRL, 0xf, 0xf, false)); }
__device__ __forceinline__ float row16_sum(float v) { v += dpp_f<0xB1>(v); v += dpp_f<0x4E>(v); v += dpp_f<0x124>(v); v += dpp_f<0x128>(v); return v; }
__device__ __forceinline__ float pair_sum(float v) { return v + dpp_f<0xB1>(v); }
#define XB_TMO      128
#define XB_XCNT(j)  (256  + 64 * (j))
#define XB_XSUB(j)  (1280 + 64 * (j))
#define XB_XGEN(j)  (2304 + 64 * (j))
#define XB_TOP      3328
#define XB_TOPGEN   3392
#define XCD_BAR_WORDS 3456
#define XB_SPIN_CAP (1u << 18)

__device__ __forceinline__ unsigned xb_ld(unsigned* p)              { return __hip_atomic_load(p, __ATOMIC_RELAXED, __HIP_MEMORY_SCOPE_AGENT); }
__device__ __forceinline__ unsigned xb_add(unsigned* p, unsigned v) { return __hip_atomic_fetch_add(p, v, __ATOMIC_RELAXED, __HIP_MEMORY_SCOPE_AGENT); }
__device__ __forceinline__ unsigned xb_xcc_id() { return (unsigned)__builtin_amdgcn_s_getreg((3 << 11) | 20) & 0xFu; }
#define XB_SPIN(cond, bar) do { unsigned _sp = 0; while (cond) { __builtin_amdgcn_s_sleep(1); \
    if ((++_sp & 255u) == 0u) { if (xb_ld(&(bar)[XB_TMO])) break; if (_sp > XB_SPIN_CAP) { atomicAdd(&(bar)[XB_TMO], 1u); break; } } } } while (0)

struct XcdBarrier {
    unsigned* bar; unsigned x;
    volatile LAS unsigned* st;
};

__device__ __forceinline__ XcdBarrier xcd_barrier_post(unsigned* bar, volatile LAS unsigned* st) {
    XcdBarrier b; b.bar = bar; b.x = xb_xcc_id(); b.st = st;
    if (threadIdx.x == 0) (void)xb_add(&bar[XB_XCNT(b.x)], 1u);
    return b;
}
__device__ __forceinline__ void xcd_barrier_complete(unsigned* bar, unsigned x, unsigned& nloc, unsigned& nx) {
    const unsigned G = gridDim.x * gridDim.y * gridDim.z;
    unsigned sum, cnt, mine, sp = 0u;
    for (;;) {
        sum = 0u; cnt = 0u; mine = 0u;
#pragma unroll
        for (unsigned j = 0; j < 16; ++j) { const unsigned c = xb_ld(&bar[XB_XCNT(j)]); sum += c; cnt += (c > 0u) ? 1u : 0u; mine = (j == x) ? c : mine; }
        if (sum == G) break;
        __builtin_amdgcn_s_sleep(1);
        if ((++sp & 255u) == 0u) { if (xb_ld(&bar[XB_TMO])) break; if (sp > XB_SPIN_CAP) { atomicAdd(&bar[XB_TMO], 1u); break; } }
    }
    nloc = mine > 0u ? mine : 1u; nx = cnt > 0u ? cnt : 1u;
}

__device__ __forceinline__ void xcd_barrier(const XcdBarrier& b) {
    asm volatile("s_waitcnt vmcnt(0)" ::: "memory");
    __syncthreads();
    if (threadIdx.x == 0) {
        unsigned* bar = b.bar;
        __builtin_amdgcn_s_waitcnt(0);
        unsigned nloc = b.st[0], nx = b.st[1];
        if (nloc == 0u) { xcd_barrier_complete(bar, b.x, nloc, nx); b.st[0] = nloc; b.st[1] = nx; }
        const unsigned old = xb_add(&bar[XB_XSUB(b.x)], 1u);
        const unsigned gen = old / nloc;
        if (old + 1u == (gen + 1u) * nloc) {
            __builtin_amdgcn_fence(__ATOMIC_RELEASE, "agent");
            asm volatile("s_waitcnt vmcnt(0)" ::: "memory");
            const unsigned og = xb_add(&bar[XB_TOP], 1u);
            const unsigned tg = og / nx;
            if (og + 1u == (tg + 1u) * nx) xb_add(&bar[XB_TOPGEN], 1u);
            else XB_SPIN(xb_ld(&bar[XB_TOPGEN]) == tg, bar);
            __builtin_amdgcn_fence(__ATOMIC_ACQUIRE, "agent");
            xb_add(&bar[XB_XGEN(b.x)], 1u);
            asm volatile("s_waitcnt vmcnt(0)" ::: "memory");
        } else {
            XB_SPIN(xb_ld(&bar[XB_XGEN(b.x)]) == gen, bar);
            __builtin_amdgcn_fence(__ATOMIC_ACQUIRE, "agent");
            asm volatile("s_waitcnt vmcnt(0)" ::: "memory");
        }
    }
    __syncthreads();
}

struct Args { const float* in[N_IN]; float* out; unsigned char* ws; int ph_lo, ph_hi, li, pad; };
struct Ctx {
    LAS unsigned char* lds;
    int tid, lane, wave, G, bid;
    const float* const* in; float* out; unsigned char* ws;
};
__device__ const unsigned char T5_BUCKET[128] = {0, 1, 2, 3, 4, 5, 6, 7, 8, 9, 10, 11, 12, 13, 14, 15, 16, 16, 16, 17, 17, 18, 18, 18, 19, 19, 19, 20, 20, 20, 20, 21, 21, 21, 21, 22, 22, 22, 22, 22, 23, 23, 23, 23, 23, 23, 24, 24, 24, 24, 24, 24, 25, 25, 25, 25, 25, 25, 25, 26, 26, 26, 26, 26, 26, 26, 26, 27, 27, 27, 27, 27, 27, 27, 27, 27, 27, 28, 28, 28, 28, 28, 28, 28, 28, 28, 28, 29, 29, 29, 29, 29, 29, 29, 29, 29, 29, 29, 29, 30, 30, 30, 30, 30, 30, 30, 30, 30, 30, 30, 30, 30, 30, 31, 31, 31, 31, 31, 31, 31, 31, 31, 31, 31, 31, 31, 31, 31};

struct TItem { const float* src; bf16* dst; int N, K, nvalid; };
constexpr int CV_NITEMS = 32 * 86 * 3 + 32 * 32 + 86 * 32;
__device__ __forceinline__ TItem titem_decode(Ctx& C, int l, int it) {
    constexpr int I_IN = 32 * 86, I_OUT = 32 * 32, I_G = 32 * 86;
    TItem t; int r = it, kb, nb;
    if (r < I_IN) { kb = r / 86; nb = r % 86; t.N = DIN; t.K = DM; t.src = C.in[I_W_IN] + (size_t)l * DM * DIN; t.dst = (bf16*)(C.ws + WS_WIN) + (size_t)(128 * nb) * DM; }
    else if ((r -= I_IN) < I_OUT) { kb = r / 32; nb = r % 32; t.N = DM; t.K = DM; t.src = C.in[I_W_OUT] + (size_t)l * DM * DM; t.dst = (bf16*)(C.ws + WS_WOUT) + (size_t)(128 * nb) * DM; }
    else if ((r -= I_OUT) < I_G) { kb = r / 86; nb = r % 86; t.N = DFF; t.K = DM; t.src = C.in[I_W_GATE] + (size_t)l * DM * DFF; t.dst = (bf16*)(C.ws + WS_WGU) + (size_t)(256 * nb) * DM; }
    else if ((r -= I_G) < I_G) { kb = r / 86; nb = r % 86; t.N = DFF; t.K = DM; t.src = C.in[I_W_UP] + (size_t)l * DM * DFF; t.dst = (bf16*)(C.ws + WS_WGU) + (size_t)(256 * nb + 128) * DM; }
    else { r -= I_G; kb = r / 32; nb = r % 32; t.N = DM; t.K = DFF; t.src = C.in[I_W_DOWN] + (size_t)l * DFF * DM; t.dst = (bf16*)(C.ws + WS_WDN) + (size_t)(128 * nb) * DFF; }
    t.src += (size_t)(128 * kb) * t.N + 128 * nb; t.dst += 128 * kb;
    const int rem = t.N - 128 * nb; t.nvalid = rem >= 128 ? 128 : (rem > 0 ? rem : 0);
    return t;
}
__device__ __forceinline__ void titem_load(const TItem& t, f32x4 (&v)[8], int wave, int lane) {
    const bool nv = 4 * (lane & 31) < t.nvalid; const float* p = t.src + (size_t)(16 * wave + 2 * (lane >> 5)) * t.N + 4 * (lane & 31);
#pragma unroll
    for (int i = 0; i < 4; ++i) { v[2 * i] = nv ? *(const GAS f32x4*)(p + (size_t)(4 * i) * t.N) : (f32x4){0.f, 0.f, 0.f, 0.f}; v[2 * i + 1] = nv ? *(const GAS f32x4*)(p + (size_t)(4 * i + 1) * t.N) : (f32x4){0.f, 0.f, 0.f, 0.f}; }
}
__device__ __forceinline__ void titem_store(const TItem& t, const f32x4 (&v)[8], LAS unsigned* T, int tid, int wave, int lane) {
    __syncthreads();
    { const int kd = 8 * wave + (lane >> 5);
#pragma unroll
      for (int i = 0; i < 4; ++i)
#pragma unroll
          for (int e = 0; e < 4; ++e) T[(4 * (lane & 31) + e) * 65 + ((kd + 2 * i) ^ ((lane & 31) >> 3))] = pg8::cvt_pk_bf16(v[2 * i][e], v[2 * i + 1][e]); }
    __syncthreads();
    const int ch = tid & 15;
#pragma unroll
    for (int ps = 0; ps < 4; ++ps) { const int n = 32 * ps + (tid >> 4); const LAS unsigned* s = T + n * 65 + 4 * ch;
        v4u o; o.x = s[0 ^ ps]; o.y = s[1 ^ ps]; o.z = s[2 ^ ps]; o.w = s[3 ^ ps];
        *(GAS v4u*)(t.dst + (size_t)n * t.K + 8 * ch) = o; }
}
__device__ __forceinline__ void convert_weights(Ctx& C, int l, int lo, int hi) {
    LAS unsigned* T = (LAS unsigned*)C.lds;
    int it = lo + C.bid;
    if (it < hi) {
        TItem cur = titem_decode(C, l, it); f32x4 va[8], vb[8];
        titem_load(cur, va, C.wave, C.lane);
        for (;;) {
            int nx = it + C.G; TItem tn = cur; const bool hn = nx < hi;
            if (hn) { tn = titem_decode(C, l, nx); titem_load(tn, vb, C.wave, C.lane); }
            titem_store(cur, va, T, C.tid, C.wave, C.lane);
            if (!hn) break;
            nx += C.G; const bool hn2 = nx < hi; TItem t2 = tn;
            if (hn2) { t2 = titem_decode(C, l, nx); titem_load(t2, va, C.wave, C.lane); }
            titem_store(tn, vb, T, C.tid, C.wave, C.lane);
            if (!hn2) break;
            cur = t2; it = nx;
        }
    }
    __syncthreads();
}
constexpr int CV_DN_LO = CV_NITEMS - 86 * 32, CV_UP_LO = CV_DN_LO - 32 * 86, CV_A_ITEMS = CV_UP_LO;
__device__ __forceinline__ float row_ssq(const f32x4 (&v)[16]) { float ss = 0.f;
#pragma unroll
    for (int j = 0; j < 16; ++j) ss += (v[j].x * v[j].x + v[j].y * v[j].y) + (v[j].z * v[j].z + v[j].w * v[j].w);
    return ss; }
__device__ __forceinline__ void rmsnorm_phase(Ctx& C, const float* X, const float* w, bf16* H) {
    const int gw = C.bid * NWAVES + C.wave, NGW = C.G * NWAVES, lane = C.lane;
    const GAS f32x4* wr = (const GAS f32x4*)w + lane;
    for (int m = gw; m < M; m += 2 * NGW) {
        const int m2 = m + NGW; const bool h2 = m2 < M;
        const GAS f32x4* x0 = (const GAS f32x4*)(X + (size_t)m * DM) + lane; const GAS f32x4* x1 = (const GAS f32x4*)(X + (size_t)(h2 ? m2 : m) * DM) + lane;
        f32x4 v0[16], v1[16];
#pragma unroll
        for (int j = 0; j < 16; ++j) v0[j] = x0[64 * j];
#pragma unroll
        for (int j = 0; j < 16; ++j) v1[j] = x1[64 * j];
        const float r0 = 1.f / sqrtf(wave_sum(row_ssq(v0)) * (1.f / DM) + EPS), r1 = 1.f / sqrtf(wave_sum(row_ssq(v1)) * (1.f / DM) + EPS);
        GAS v2u* o0 = (GAS v2u*)(H + (size_t)m * DM) + lane; GAS v2u* o1 = (GAS v2u*)(H + (size_t)m2 * DM) + lane;
#pragma unroll
        for (int j = 0; j < 16; ++j) { const f32x4 g = wr[64 * j]; v2u o; o.x = pk2(v0[j].x * r0 * g.x, v0[j].y * r0 * g.y); o.y = pk2(v0[j].z * r0 * g.z, v0[j].w * r0 * g.w); o0[64 * j] = o;
            if (h2) { v2u p; p.x = pk2(v1[j].x * r1 * g.x, v1[j].y * r1 * g.y); p.y = pk2(v1[j].z * r1 * g.z, v1[j].w * r1 * g.w); o1[64 * j] = p; } }
    }
}
__device__ __forceinline__ float row_ssq8(const v4u (&v)[8]) { float ss = 0.f;
#pragma unroll
    for (int j = 0; j < 8; ++j) { const float a0 = bflo(v[j].x), a1 = bfhi(v[j].x), a2 = bflo(v[j].y), a3 = bfhi(v[j].y), a4 = bflo(v[j].z), a5 = bfhi(v[j].z), a6 = bflo(v[j].w), a7 = bfhi(v[j].w);
        ss += ((a0 * a0 + a1 * a1) + (a2 * a2 + a3 * a3)) + ((a4 * a4 + a5 * a5) + (a6 * a6 + a7 * a7)); }
    return ss; }
__device__ __forceinline__ void rmsnorm_phase_b(Ctx& C, const bf16* X, const float* w, bf16* H) {
    const int gw = C.bid * NWAVES + C.wave, NGW = C.G * NWAVES, lane = C.lane;
    for (int m = gw; m < M; m += 2 * NGW) {
        const int m2 = m + NGW; const bool h2 = m2 < M;
        const GAS v4u* x0 = (const GAS v4u*)(X + (size_t)m * DM) + lane; const GAS v4u* x1 = (const GAS v4u*)(X + (size_t)(h2 ? m2 : m) * DM) + lane;
        v4u v0[8], v1[8];
#pragma unroll
        for (int j = 0; j < 8; ++j) v0[j] = x0[64 * j];
#pragma unroll
        for (int j = 0; j < 8; ++j) v1[j] = x1[64 * j];
        const float r0 = 1.f / sqrtf(wave_sum(row_ssq8(v0)) * (1.f / DM) + EPS), r1 = 1.f / sqrtf(wave_sum(row_ssq8(v1)) * (1.f / DM) + EPS);
        GAS v4u* o0 = (GAS v4u*)(H + (size_t)m * DM) + lane; GAS v4u* o1 = (GAS v4u*)(H + (size_t)m2 * DM) + lane;
#pragma unroll
        for (int j = 0; j < 8; ++j) { const f32x4 g0 = *(const GAS f32x4*)(w + 512 * j + 8 * lane), g1 = *(const GAS f32x4*)(w + 512 * j + 8 * lane + 4);
            { const v4u x = v0[j]; v4u o; o.x = pk2(bflo(x.x) * r0 * g0.x, bfhi(x.x) * r0 * g0.y); o.y = pk2(bflo(x.y) * r0 * g0.z, bfhi(x.y) * r0 * g0.w); o.z = pk2(bflo(x.z) * r0 * g1.x, bfhi(x.z) * r0 * g1.y); o.w = pk2(bflo(x.w) * r0 * g1.z, bfhi(x.w) * r0 * g1.w); o0[64 * j] = o; }
            if (h2) { const v4u x = v1[j]; v4u o; o.x = pk2(bflo(x.x) * r1 * g0.x, bfhi(x.x) * r1 * g0.y); o.y = pk2(bflo(x.y) * r1 * g0.z, bfhi(x.y) * r1 * g0.w); o.z = pk2(bflo(x.z) * r1 * g1.x, bfhi(x.z) * r1 * g1.y); o.w = pk2(bflo(x.w) * r1 * g1.z, bfhi(x.w) * r1 * g1.w); o1[64 * j] = o; } }
    }
}
__device__ __forceinline__ void final_norm_phase(Ctx& C, const bf16* X, const float* w, float* OUT) {
    const int gw = C.bid * NWAVES + C.wave, NGW = C.G * NWAVES, lane = C.lane;
    for (int m = gw; m < M; m += 2 * NGW) {
        const int m2 = m + NGW; const bool h2 = m2 < M;
        const GAS v4u* x0 = (const GAS v4u*)(X + (size_t)m * DM) + lane; const GAS v4u* x1 = (const GAS v4u*)(X + (size_t)(h2 ? m2 : m) * DM) + lane;
        v4u v0[8], v1[8];
#pragma unroll
        for (int j = 0; j < 8; ++j) v0[j] = x0[64 * j];
#pragma unroll
        for (int j = 0; j < 8; ++j) v1[j] = x1[64 * j];
        const float r0 = 1.f / sqrtf(wave_sum(row_ssq8(v0)) * (1.f / DM) + EPS), r1 = 1.f / sqrtf(wave_sum(row_ssq8(v1)) * (1.f / DM) + EPS);
        float* o0 = OUT + (size_t)m * DM + 8 * lane; float* o1 = OUT + (size_t)m2 * DM + 8 * lane;
#pragma unroll
        for (int j = 0; j < 8; ++j) { const f32x4 g0 = *(const GAS f32x4*)(w + 512 * j + 8 * lane), g1 = *(const GAS f32x4*)(w + 512 * j + 8 * lane + 4);
            { const v4u x = v0[j]; *(GAS f32x4*)(o0 + 512 * j) = (f32x4){bflo(x.x) * r0 * g0.x, bfhi(x.x) * r0 * g0.y, bflo(x.y) * r0 * g0.z, bfhi(x.y) * r0 * g0.w}; *(GAS f32x4*)(o0 + 512 * j + 4) = (f32x4){bflo(x.z) * r0 * g1.x, bfhi(x.z) * r0 * g1.y, bflo(x.w) * r0 * g1.z, bfhi(x.w) * r0 * g1.w}; }
            if (h2) { const v4u x = v1[j]; *(GAS f32x4*)(o1 + 512 * j) = (f32x4){bflo(x.x) * r1 * g0.x, bfhi(x.x) * r1 * g0.y, bflo(x.y) * r1 * g0.z, bfhi(x.y) * r1 * g0.w}; *(GAS f32x4*)(o1 + 512 * j + 4) = (f32x4){bflo(x.z) * r1 * g1.x, bfhi(x.z) * r1 * g1.y, bflo(x.w) * r1 * g1.z, bfhi(x.w) * r1 * g1.w}; } }
    }
}

typedef short bf16x8 __attribute__((ext_vector_type(8)));
typedef short s16x4 __attribute__((ext_vector_type(4)));
__device__ __forceinline__ f32x4 mfma16(bf16x8 a, bf16x8 b, f32x4 c) { return __builtin_amdgcn_mfma_f32_16x16x32_bf16(a, b, c, 0, 0, 0); }
__device__ __forceinline__ bf16x8 pack8(f32x4 lo, f32x4 hi) { v4u w; w.x = pg8::cvt_pk_bf16(lo.x, lo.y); w.y = pg8::cvt_pk_bf16(lo.z, lo.w); w.z = pg8::cvt_pk_bf16(hi.x, hi.y); w.w = pg8::cvt_pk_bf16(hi.z, hi.w); return __builtin_bit_cast(bf16x8, w); }
__device__ __forceinline__ bf16x8 gfrag(const bf16* Mx, size_t ld, int row0, int k0, int lane) { return *(const GAS bf16x8*)(Mx + (size_t)(row0 + (lane & 15)) * ld + k0 + 8 * (lane >> 4)); }
__device__ __forceinline__ bf16x8 trfrag(const LAS unsigned char* img, int stride, int r0, int r1, int col0, int lane) {
    const int q = (lane & 15) >> 2, p = lane & 3;
    const s16x4 a = __builtin_amdgcn_ds_read_tr16_b64_v4i16((LAS s16x4*)(img + (r0 + q) * stride + (col0 + 4 * p) * 2));
    const s16x4 b = __builtin_amdgcn_ds_read_tr16_b64_v4i16((LAS s16x4*)(img + (r1 + q) * stride + (col0 + 4 * p) * 2));
    return __builtin_shufflevector(a, b, 0, 1, 2, 3, 4, 5, 6, 7);
}
__device__ __forceinline__ float xsum4(float v) { v += __shfl_xor(v, 16); v += __shfl_xor(v, 32); return v; }
__device__ __forceinline__ float xmax4(float v) { v = fmaxf(v, __shfl_xor(v, 16)); v = fmaxf(v, __shfl_xor(v, 32)); return v; }

constexpr int SWA_QSTRIDE = 528;
constexpr int SWA_VSTRIDE = 144;
constexpr int SWA_V_BYTES = 192 * SWA_VSTRIDE;
__device__ __forceinline__ void swa_unit_mfma(Ctx& C, int l, int unit) {
    const int b = unit >> 7, qb = unit & 127, q0 = qb * 64;
    const int tid = C.tid, lane = C.lane, w = C.wave, c = lane & 15, hq = lane >> 4;
    LAS unsigned char* Vimg = C.lds;
    LAS unsigned char* Kimg = C.lds + 30720;
    LAS float* tb = (LAS float*)(C.lds + 61440);
    LAS float* ssqx = (LAS float*)(C.lds + 61440 + 12288);
    LAS unsigned char* Qimg = C.lds + 75776;
    const bf16* PROJ = (const bf16*)(C.ws + WS_PROJ); bf16* OSWA = (bf16*)(C.ws + WS_OSWA); bf16* Y = (bf16*)(C.ws + WS_Y);
    const bf16* Pb = PROJ + (size_t)b * SEQ * DINP;
    __syncthreads();
    for (int i = tid; i < 16 * 192; i += NTHR) { const int hd = i / 192, x = i % 192, dist = x - 32; tb[i] = (dist >= 0 && dist < 128) ? C.in[I_REL_BIAS][T5_BUCKET[dist] * SWA_H + hd] : 0.f; }
    if (tid < 16 * 9) { *(LAS v4u*)(Vimg + (192 + tid / 9) * SWA_VSTRIDE + 16 * (tid % 9)) = (v4u){0u, 0u, 0u, 0u}; *(LAS v4u*)(Kimg + (192 + tid / 9) * SWA_VSTRIDE + 16 * (tid % 9)) = (v4u){0u, 0u, 0u, 0u}; }
    const int g = w >> 1, qhalf = w & 1;
    float ssq0 = 0.f, ssq1 = 0.f;
    for (int kvh = 0; kvh < 4; ++kvh) {
        const int head = kvh * 4 + g;
        __syncthreads();
        { v4u tv[3], tk[3], tq[4];
#pragma unroll
          for (int it = 0; it < 4; ++it) { const int idx = tid + NTHR * it, t = idx >> 5, cg = idx & 31; tq[it] = __builtin_nontemporal_load((const GAS v4u*)(Pb + (size_t)(q0 + t) * DINP + C_SQ + kvh * 256 + 8 * cg)); }
#pragma unroll
          for (int it = 0; it < 3; ++it) { const int idx = tid + NTHR * it, j = idx >> 3, cg = idx & 7; int s = q0 - 128 + j; s = s < 0 ? 0 : s;
              tv[it] = __builtin_nontemporal_load((const GAS v4u*)(Pb + (size_t)s * DINP + C_SV + kvh * 64 + 8 * cg)); tk[it] = __builtin_nontemporal_load((const GAS v4u*)(Pb + (size_t)s * DINP + C_SK + kvh * 64 + 8 * cg)); }
#pragma unroll
          for (int it = 0; it < 3; ++it) { const int idx = tid + NTHR * it, j = idx >> 3, cg = idx & 7; *(LAS v4u*)(Vimg + j * SWA_VSTRIDE + 16 * cg) = tv[it]; *(LAS v4u*)(Kimg + j * SWA_VSTRIDE + 16 * cg) = tk[it]; }
#pragma unroll
          for (int it = 0; it < 4; ++it) { const int idx = tid + NTHR * it, t = idx >> 5, cg = idx & 31; *(LAS v4u*)(Qimg + t * SWA_QSTRIDE + 16 * cg) = tq[it]; } }
        __syncthreads();
        const float sink = C.in[I_SWA_SINKS][l * SWA_H + head];
#pragma nounroll
        for (int qt = 0; qt < 2; ++qt) {
            const int j0 = 32 * qhalf + 16 * qt;
            const LAS unsigned char* qp = Qimg + (j0 + c) * SWA_QSTRIDE + (g * 64 + 8 * hq) * 2;
            const bf16x8 qf0 = *(const LAS bf16x8*)qp, qf1 = *(const LAS bf16x8*)(qp + 64);
            f32x4 sacc[10];
#pragma unroll
            for (int kt = 0; kt < 10; ++kt) {
                const LAS unsigned char* kp = Kimg + (j0 + 16 * kt + c) * SWA_VSTRIDE + 16 * hq;
                const bf16x8 k0 = *(const LAS bf16x8*)kp, k1 = *(const LAS bf16x8*)(kp + 64);
                f32x4 a = (f32x4){0.f, 0.f, 0.f, 0.f}; a = mfma16(k0, qf0, a); a = mfma16(k1, qf1, a); sacc[kt] = a;
            }
            float mx = sink;
#pragma unroll
            for (int kt = 0; kt < 10; ++kt)
#pragma unroll
                for (int r = 0; r < 4; ++r) { const int dist = c + 128 - 16 * kt - 4 * hq - r; const int s = q0 - 128 + j0 + 16 * kt + 4 * hq + r;
                    const bool valid = (dist >= 0) && (dist < 128) && (s >= 0);
                    const float sc = valid ? sacc[kt][r] * 0.125f + tb[head * 192 + dist + 32] : -1e30f;
                    sacc[kt][r] = sc; mx = fmaxf(mx, sc); }
            mx = xmax4(mx); float sum = 0.f;
#pragma unroll
            for (int kt = 0; kt < 10; ++kt)
#pragma unroll
                for (int r = 0; r < 4; ++r) { const float p = __expf(sacc[kt][r] - mx); sacc[kt][r] = p; sum += p; }
            sum = xsum4(sum); const float inv = 1.f / (sum + __expf(sink - mx));
            f32x4 oacc[4];
#pragma unroll
            for (int dt = 0; dt < 4; ++dt) oacc[dt] = (f32x4){0.f, 0.f, 0.f, 0.f};
#pragma unroll
            for (int ks = 0; ks < 5; ++ks) { const bf16x8 pf = pack8(sacc[2 * ks], sacc[2 * ks + 1]);
#pragma unroll
                for (int dt = 0; dt < 4; ++dt) oacc[dt] = mfma16(trfrag(Vimg, SWA_VSTRIDE, j0 + 32 * ks + 4 * hq, j0 + 32 * ks + 16 + 4 * hq, 16 * dt, lane), pf, oacc[dt]); }
            float sq = 0.f; bf16* op = OSWA + (size_t)(b * SEQ + q0 + j0 + c) * SWA_W + head * 64 + 4 * hq;
#pragma unroll
            for (int dt = 0; dt < 4; ++dt) { const f32x4 o = oacc[dt] * inv; v2u pk; pk.x = pk2(o.x, o.y); pk.y = pk2(o.z, o.w);
                const float r0 = bflo(pk.x), r1 = bfhi(pk.x), r2 = bflo(pk.y), r3 = bfhi(pk.y); sq += (r0 * r0 + r1 * r1) + (r2 * r2 + r3 * r3); *(GAS v2u*)(op + 16 * dt) = pk; }
            if (qt == 0) ssq0 += sq; else ssq1 += sq;
        }
    }
    ssq0 = xsum4(ssq0); ssq1 = xsum4(ssq1);
    if (hq == 0) { ssqx[w * 32 + c] = ssq0; ssqx[w * 32 + 16 + c] = ssq1; }
    asm volatile("s_waitcnt vmcnt(0)" ::: "memory");
    __syncthreads();
    const float* swa_norm = C.in[I_SWA_NORM] + (size_t)l * SWA_W;
#pragma nounroll
    for (int qt = 0; qt < 2; ++qt) { const int qi = 16 * qt + c;
        const float tot = ssqx[(qhalf + 0) * 32 + qi] + ssqx[(qhalf + 2) * 32 + qi] + ssqx[(qhalf + 4) * 32 + qi] + ssqx[(qhalf + 6) * 32 + qi];
        const float rstd = 1.f / sqrtf(tot * (1.f / 1024.f) + EPS);
        const size_t row = (size_t)(b * SEQ + q0 + 32 * qhalf + qi);
#pragma unroll
        for (int kvh = 0; kvh < 4; ++kvh)
#pragma unroll
            for (int dt = 0; dt < 4; ++dt) { const int col = (kvh * 4 + g) * 64 + 16 * dt + 4 * hq; const v2u pk = *(const GAS v2u*)(OSWA + row * SWA_W + col); const f32x4 o = (f32x4){bflo(pk.x), bfhi(pk.x), bflo(pk.y), bfhi(pk.y)}; const f32x4 gn = *(const GAS f32x4*)(swa_norm + col);
                v2u ow; ow.x = pk2(o.x * rstd * gn.x, o.y * rstd * gn.y); ow.y = pk2(o.z * rstd * gn.z, o.w * rstd * gn.w); *(GAS v2u*)(Y + row * DM + 2048 + col) = ow; } }
}

constexpr int N_SWA_UNITS = BATCH * (SEQ / 64);

constexpr int SSD_L = 128, SSD_NC = SEQ / SSD_L, GLA_L = 64, GLA_NC = SEQ / GLA_L;
constexpr int N_SSD_CU = BATCH * SSD_NC * 8, N_GLA_CU = BATCH * GLA_NC * 4;
constexpr int XI_STRIDE = 528, BI_STRIDE = 272;

__device__ __forceinline__ void prep_phase(Ctx& C, int l) {
    const bf16* PROJ = (const bf16*)(C.ws + WS_PROJ); bf16* XBC = (bf16*)(C.ws + WS_XBC);
    const int tid = C.tid, lane = C.lane;
    { const int gw0 = C.bid * NWAVES + C.wave;
      float* DT = (float*)(C.ws + WS_DT); float* ACS = (float*)(C.ws + WS_ACS); float* DEC = (float*)(C.ws + WS_DEC);
      for (int item = gw0; item < BATCH * SSD_NC * SSD_H; item += C.G * NWAVES) {
          const int h = item & 31, bc = item >> 5; const size_t r0 = (size_t)bc * SSD_L + 2 * lane;
          const float dtb = C.in[I_SSD_DT_BIAS][l * SSD_H + h], Ah = -expf(C.in[I_SSD_A_LOG][l * SSD_H + h]);
          const float x0 = bf1(PROJ[r0 * DINP + C_DT + h]) + dtb, x1 = bf1(PROJ[(r0 + 1) * DINP + C_DT + h]) + dtb;
          const float d0 = x0 > 20.f ? x0 : log1pf(expf(x0)), d1 = x1 > 20.f ? x1 : log1pf(expf(x1));
          const float a0 = d0 * Ah, a1 = d1 * Ah;
          float incl = a0 + a1;
#pragma unroll
          for (int o = 1; o < 64; o <<= 1) { const float t = __shfl_up(incl, o); if (lane >= o) incl += t; }
          const float c1 = incl, c0 = incl - a1;
          DT[r0 * SSD_H + h] = d0; DT[(r0 + 1) * SSD_H + h] = d1; ACS[r0 * SSD_H + h] = c0; ACS[(r0 + 1) * SSD_H + h] = c1;
          if (lane == 63) DEC[bc * SSD_H + h] = expf(c1);
      } }
    { const float* conv_w = C.in[I_SSD_CONV_W] + (size_t)l * 4 * SSD_CD; const float* conv_b = C.in[I_SSD_CONV_B] + (size_t)l * SSD_CD;
      const float* HT = (const float*)(C.ws + WS_XHT); const float* HB = (const float*)(C.ws + WS_XHB);
      constexpr int NIT = (M / 64) * 3 * 1024;
      for (int it = C.bid * NTHR + tid; it < NIT; it += C.G * NTHR) {
          const int c4 = it & 1023, ri = it >> 10, i = ri % 3, blk = ri / 3, c0 = 4 * c4; const bool first = (blk % (SEQ / 64)) == 0;
          f32x4 sq[6]; const f32x4 z4 = (f32x4){0.f, 0.f, 0.f, 0.f};
#pragma unroll
          for (int j = 0; j < 3; ++j) { sq[j] = first ? z4 : *(const GAS f32x4*)(HB + ((size_t)(blk - 1) * 3 + j) * 4096 + c0); sq[3 + j] = *(const GAS f32x4*)(HT + ((size_t)blk * 3 + j) * 4096 + c0); }
          const f32x4 x3 = i == 0 ? sq[0] : (i == 1 ? sq[1] : sq[2]), x2 = i == 0 ? sq[1] : (i == 1 ? sq[2] : sq[3]), x1 = i == 0 ? sq[2] : (i == 1 ? sq[3] : sq[4]), x0 = i == 0 ? sq[3] : (i == 1 ? sq[4] : sq[5]);
          const f32x4 w0 = *(const GAS f32x4*)(conv_w + c0), w1 = *(const GAS f32x4*)(conv_w + 4096 + c0), w2 = *(const GAS f32x4*)(conv_w + 2 * 4096 + c0), w3 = *(const GAS f32x4*)(conv_w + 3 * 4096 + c0), bb = *(const GAS f32x4*)(conv_b + c0);
          f32x4 o;
#pragma unroll
          for (int e = 0; e < 4; ++e) o[e] = silu_f(bb[e] + w0[e] * x3[e] + w1[e] * x2[e] + w2[e] * x1[e] + w3[e] * x0[e]);
          v2u ow; ow.x = pk2(o.x, o.y); ow.y = pk2(o.z, o.w); *(GAS v2u*)(XBC + (size_t)(64 * blk + i) * SSD_CD + c0) = ow;
      } }
    { LAS float* glr = (LAS float*)C.lds;
      LAS float* segtot = glr + 1024;
      bf16* QD = (bf16*)(C.ws + WS_QD); bf16* KI = (bf16*)(C.ws + WS_KI); float* GDEC = (float*)(C.ws + WS_GDEC);
      const float* w_gate = C.in[I_GLA_W_GATE] + (size_t)l * 16 * GLA_KT; const int seg = tid >> 7, c0 = 4 * (tid & 127);
      for (int ck = C.bid; ck < BATCH * GLA_NC; ck += C.G) {
          const size_t row0 = (size_t)ck * GLA_L;
          __syncthreads();
          if (tid < 128) { const int t = tid >> 1, hf = tid & 1; const v4u r = *(const GAS v4u*)(PROJ + (row0 + t) * DINP + C_GLR + 8 * hf);
              *(LAS f32x4*)(glr + t * 16 + 8 * hf) = (f32x4){bflo(r.x), bfhi(r.x), bflo(r.y), bfhi(r.y)}; *(LAS f32x4*)(glr + t * 16 + 8 * hf + 4) = (f32x4){bflo(r.z), bfhi(r.z), bflo(r.w), bfhi(r.w)}; }
          f32x4 cum[16];
          { f32x4 wg[16]; const f32x4 bg4 = *(const GAS f32x4*)(C.in[I_GLA_B_GATE] + l * GLA_KT + c0);
#pragma unroll
            for (int r = 0; r < 16; ++r) wg[r] = *(const GAS f32x4*)(w_gate + r * GLA_KT + c0);
            __syncthreads();
            f32x4 run = (f32x4){0.f, 0.f, 0.f, 0.f};
#pragma unroll
            for (int t = 0; t < 16; ++t) { f32x4 z = bg4;
#pragma unroll
                for (int r4 = 0; r4 < 4; ++r4) { const f32x4 gv = *(const LAS f32x4*)(glr + (16 * seg + t) * 16 + 4 * r4); z += wg[4 * r4] * gv.x + wg[4 * r4 + 1] * gv.y + wg[4 * r4 + 2] * gv.z + wg[4 * r4 + 3] * gv.w; }
#pragma unroll
                for (int e = 0; e < 4; ++e) { const float ls = fminf(z[e], 0.f) - __logf(1.f + __expf(-fabsf(z[e]))); run[e] += ls * 0.0625f; }
                cum[t] = run; }
            *(LAS f32x4*)(segtot + seg * 512 + c0) = run; }
          v2u rq[16], rk[16];
#pragma unroll
          for (int t = 0; t < 16; ++t) { rq[t] = *(const GAS v2u*)(PROJ + (row0 + 16 * seg + t) * DINP + C_GQ + c0); rk[t] = *(const GAS v2u*)(PROJ + (row0 + 16 * seg + t) * DINP + C_GK + c0); }
          __syncthreads();
          f32x4 off = (f32x4){0.f, 0.f, 0.f, 0.f}, tot = off;
#pragma unroll
          for (int sg = 0; sg < 4; ++sg) { const f32x4 v = *(const LAS f32x4*)(segtot + sg * 512 + c0); tot += v; if (sg < seg) off += v; }
#pragma unroll
          for (int t = 0; t < 16; ++t) { const f32x4 cc = cum[t] + off; const size_t o = (row0 + 16 * seg + t) * GLA_KT + c0;
              const float e0 = __expf(cc.x), e1 = __expf(cc.y), e2 = __expf(cc.z), e3 = __expf(cc.w), i0 = __expf(-cc.x), i1 = __expf(-cc.y), i2 = __expf(-cc.z), i3 = __expf(-cc.w);
              v2u oq, ok; oq.x = pk2(bflo(rq[t].x) * 0.08838834764831845f * e0, bfhi(rq[t].x) * 0.08838834764831845f * e1); oq.y = pk2(bflo(rq[t].y) * 0.08838834764831845f * e2, bfhi(rq[t].y) * 0.08838834764831845f * e3);
              ok.x = pk2(bflo(rk[t].x) * i0, bfhi(rk[t].x) * i1); ok.y = pk2(bflo(rk[t].y) * i2, bfhi(rk[t].y) * i3);
              *(GAS v2u*)(QD + o) = oq; *(GAS v2u*)(KI + o) = ok; }
          if (seg == 3) *(GAS f32x4*)(GDEC + (size_t)ck * GLA_KT + c0) = (f32x4){__expf(tot.x), __expf(tot.y), __expf(tot.z), __expf(tot.w)};
      } }
}

__device__ __forceinline__ void gla_c1_unit(Ctx& C, int unit) {
    const int h = unit & 3, ck = unit >> 2; const size_t row0 = (size_t)ck * GLA_L;
    const int tid = C.tid, lane = C.lane, w = C.wave, c = lane & 15, hq = lane >> 4;
    LAS unsigned char* KEimg = C.lds; LAS unsigned char* Vimg = C.lds + 64 * BI_STRIDE;
    const bf16* PROJ = (const bf16*)(C.ws + WS_PROJ); const bf16* KI = (const bf16*)(C.ws + WS_KI); const float* GDEC = (const float*)(C.ws + WS_GDEC); bf16* GST = (bf16*)(C.ws + WS_GST);
    __syncthreads();
    { const int cg = tid & 15; const f32x4 d0 = *(const GAS f32x4*)(GDEC + (size_t)ck * GLA_KT + h * 128 + 8 * cg), d1 = *(const GAS f32x4*)(GDEC + (size_t)ck * GLA_KT + h * 128 + 8 * cg + 4);
#pragma unroll
      for (int it = 0; it < 2; ++it) { const int t = (tid + NTHR * it) >> 4; const v4u r = __builtin_nontemporal_load((const GAS v4u*)(KI + (row0 + t) * GLA_KT + h * 128 + 8 * cg));
          v4u o; o.x = pk2(bflo(r.x) * d0.x, bfhi(r.x) * d0.y); o.y = pk2(bflo(r.y) * d0.z, bfhi(r.y) * d0.w); o.z = pk2(bflo(r.z) * d1.x, bfhi(r.z) * d1.y); o.w = pk2(bflo(r.w) * d1.z, bfhi(r.w) * d1.w);
          *(LAS v4u*)(KEimg + t * BI_STRIDE + 16 * cg) = o; } }
#pragma unroll
    for (int it = 0; it < 4; ++it) { const int idx = tid + NTHR * it, t = idx >> 5, cg = idx & 31; *(LAS v4u*)(Vimg + t * XI_STRIDE + 16 * cg) = __builtin_nontemporal_load((const GAS v4u*)(PROJ + (row0 + t) * DINP + C_GV + h * 256 + 8 * cg)); }
    __syncthreads();
    f32x4 acc[16];
#pragma unroll
    for (int nt = 0; nt < 16; ++nt) acc[nt] = (f32x4){0.f, 0.f, 0.f, 0.f};
#pragma unroll
    for (int ks = 0; ks < 2; ++ks) { const bf16x8 af = trfrag(KEimg, BI_STRIDE, 32 * ks + 8 * hq, 32 * ks + 8 * hq + 4, 16 * w, lane);
#pragma unroll
        for (int nt = 0; nt < 16; ++nt) acc[nt] = mfma16(af, trfrag(Vimg, XI_STRIDE, 32 * ks + 8 * hq, 32 * ks + 8 * hq + 4, 16 * nt, lane), acc[nt]); }
    bf16* gp = GST + (size_t)unit * 32768 + 16 * w + 4 * hq;
#pragma unroll
    for (int nt = 0; nt < 16; ++nt) { v2u o; o.x = pk2(acc[nt].x, acc[nt].y); o.y = pk2(acc[nt].z, acc[nt].w); *(GAS v2u*)(gp + (size_t)(16 * nt + c) * 128) = o; }
}

struct GlaC1Pre { v4u ki[2], vv[4]; f32x4 d0, d1; };
__device__ __forceinline__ void gla_c1_load(Ctx& C, int unit, GlaC1Pre& p) {
    const int h = unit & 3, ck = unit >> 2, tid = C.tid, cg = tid & 15; const size_t row0 = (size_t)ck * GLA_L;
    const bf16* PROJ = (const bf16*)(C.ws + WS_PROJ); const bf16* KI = (const bf16*)(C.ws + WS_KI); const float* GDEC = (const float*)(C.ws + WS_GDEC);
    p.d0 = *(const GAS f32x4*)(GDEC + (size_t)ck * GLA_KT + h * 128 + 8 * cg); p.d1 = *(const GAS f32x4*)(GDEC + (size_t)ck * GLA_KT + h * 128 + 8 * cg + 4);
#pragma unroll
    for (int it = 0; it < 2; ++it) { const int t = (tid + NTHR * it) >> 4; p.ki[it] = __builtin_nontemporal_load((const GAS v4u*)(KI + (row0 + t) * GLA_KT + h * 128 + 8 * cg)); }
#pragma unroll
    for (int it = 0; it < 4; ++it) { const int idx = tid + NTHR * it, t = idx >> 5, c2 = idx & 31; p.vv[it] = __builtin_nontemporal_load((const GAS v4u*)(PROJ + (row0 + t) * DINP + C_GV + h * 256 + 8 * c2)); }
}
__device__ __forceinline__ void gla_c1_stage(Ctx& C, const GlaC1Pre& p) {
    const int tid = C.tid, cg = tid & 15; LAS unsigned char* KEimg = C.lds; LAS unsigned char* Vimg = C.lds + 64 * BI_STRIDE;
#pragma unroll
    for (int it = 0; it < 2; ++it) { const int t = (tid + NTHR * it) >> 4; const v4u r = p.ki[it]; const f32x4 d0 = p.d0, d1 = p.d1;
        v4u o; o.x = pk2(bflo(r.x) * d0.x, bfhi(r.x) * d0.y); o.y = pk2(bflo(r.y) * d0.z, bfhi(r.y) * d0.w); o.z = pk2(bflo(r.z) * d1.x, bfhi(r.z) * d1.y); o.w = pk2(bflo(r.w) * d1.z, bfhi(r.w) * d1.w);
        *(LAS v4u*)(KEimg + t * BI_STRIDE + 16 * cg) = o; }
#pragma unroll
    for (int it = 0; it < 4; ++it) { const int idx = tid + NTHR * it, t = idx >> 5, c2 = idx & 31; *(LAS v4u*)(Vimg + t * XI_STRIDE + 16 * c2) = p.vv[it]; }
}
__device__ __forceinline__ void gla_c1_compute(Ctx& C, int unit) {
    const int lane = C.lane, w = C.wave, c = lane & 15, hq = lane >> 4;
    LAS unsigned char* KEimg = C.lds; LAS unsigned char* Vimg = C.lds + 64 * BI_STRIDE; bf16* GST = (bf16*)(C.ws + WS_GST);
    f32x4 acc[16];
#pragma unroll
    for (int nt = 0; nt < 16; ++nt) acc[nt] = (f32x4){0.f, 0.f, 0.f, 0.f};
#pragma unroll
    for (int ks = 0; ks < 2; ++ks) { const bf16x8 af = trfrag(KEimg, BI_STRIDE, 32 * ks + 8 * hq, 32 * ks + 8 * hq + 4, 16 * w, lane);
#pragma unroll
        for (int nt = 0; nt < 16; ++nt) acc[nt] = mfma16(af, trfrag(Vimg, XI_STRIDE, 32 * ks + 8 * hq, 32 * ks + 8 * hq + 4, 16 * nt, lane), acc[nt]); }
    bf16* gp = GST + (size_t)unit * 32768 + 16 * w + 4 * hq;
#pragma unroll
    for (int nt = 0; nt < 16; ++nt) { v2u o; o.x = pk2(acc[nt].x, acc[nt].y); o.y = pk2(acc[nt].z, acc[nt].w); *(GAS v2u*)(gp + (size_t)(16 * nt + c) * 128) = o; }
}

__device__ __forceinline__ void scan_phase(Ctx& C) {
    const bf16* GST = (const bf16*)(C.ws + WS_GST); bf16* GPV = (bf16*)(C.ws + WS_GPV); const float* GDEC = (const float*)(C.ws + WS_GDEC);
    const bf16* ST = (const bf16*)(C.ws + WS_ST); bf16* PV = (bf16*)(C.ws + WS_PV); const float* DEC = (const float*)(C.ws + WS_DEC);
    constexpr int N_S = BATCH * SSD_H * 64 * 16, N_G = BATCH * 4 * 256 * 32;
    for (int it = C.bid * NTHR + C.tid; it < N_S + N_G; it += C.G * NTHR) {
        if (it < N_S) {
            const int n8 = it & 15, p = (it >> 4) & 63, h = (it >> 10) & 31, b = it >> 15;
            const size_t base = ((size_t)(b * SSD_NC) * SSD_H + h) * 8192 + p * 128 + 8 * n8;
            const float* dp = DEC + (size_t)(b * SSD_NC) * SSD_H + h;
            f32x4 ra = (f32x4){0.f, 0.f, 0.f, 0.f}, rb = ra;
            v4u xa[8], xb[8]; float da[8], db[8];
#define SCAN_S_LOAD(X, D, c0) _Pragma("unroll") for (int j = 0; j < 8; ++j) { X[j] = __builtin_nontemporal_load((const GAS v4u*)(ST + base + (size_t)((c0) + j) * (SSD_H * 8192))); D[j] = dp[((c0) + j) * SSD_H]; }
#define SCAN_S_PROC(X, D, c0) _Pragma("unroll") for (int j = 0; j < 8; ++j) { v4u o; o.x = pk2(ra.x, ra.y); o.y = pk2(ra.z, ra.w); o.z = pk2(rb.x, rb.y); o.w = pk2(rb.z, rb.w); \
                *(GAS v4u*)(PV + base + (size_t)((c0) + j) * (SSD_H * 8192)) = o; \
                ra = ra * D[j] + (f32x4){bflo(X[j].x), bfhi(X[j].x), bflo(X[j].y), bfhi(X[j].y)}; rb = rb * D[j] + (f32x4){bflo(X[j].z), bfhi(X[j].z), bflo(X[j].w), bfhi(X[j].w)}; }
            SCAN_S_LOAD(xa, da, 0)
#pragma unroll 1
            for (int c0 = 0; c0 < SSD_NC; c0 += 16) {
                SCAN_S_LOAD(xb, db, c0 + 8)
                SCAN_S_PROC(xa, da, c0)
                if (c0 + 16 < SSD_NC) { SCAN_S_LOAD(xa, da, c0 + 16) }
                SCAN_S_PROC(xb, db, c0 + 8)
            }
#undef SCAN_S_LOAD
#undef SCAN_S_PROC
        } else {
            const int ig = it - N_S, k4 = ig & 31, v = (ig >> 5) & 255, h = (ig >> 13) & 3, b = ig >> 15;
            const size_t base = ((size_t)(b * GLA_NC) * 4 + h) * 32768 + v * 128 + 4 * k4;
            const float* dp = GDEC + (size_t)(b * GLA_NC) * GLA_KT + h * 128 + 4 * k4;
            f32x4 r = (f32x4){0.f, 0.f, 0.f, 0.f};
            v2u xa[8], xb[8]; f32x4 da[8], db[8];
#define SCAN_G_LOAD(X, D, c0) _Pragma("unroll") for (int j = 0; j < 8; ++j) { X[j] = __builtin_nontemporal_load((const GAS v2u*)(GST + base + (size_t)((c0) + j) * (4 * 32768))); D[j] = *(const GAS f32x4*)(dp + (size_t)((c0) + j) * GLA_KT); }
#define SCAN_G_PROC(X, D, c0) _Pragma("unroll") for (int j = 0; j < 8; ++j) { v2u o; o.x = pk2(r.x, r.y); o.y = pk2(r.z, r.w); *(GAS v2u*)(GPV + base + (size_t)((c0) + j) * (4 * 32768)) = o; \
                r = r * D[j] + (f32x4){bflo(X[j].x), bfhi(X[j].x), bflo(X[j].y), bfhi(X[j].y)}; }
            SCAN_G_LOAD(xa, da, 0)
#pragma unroll 1
            for (int c0 = 0; c0 < GLA_NC; c0 += 16) {
                SCAN_G_LOAD(xb, db, c0 + 8)
                SCAN_G_PROC(xa, da, c0)
                if (c0 + 16 < GLA_NC) { SCAN_G_LOAD(xa, da, c0 + 16) }
                SCAN_G_PROC(xb, db, c0 + 8)
            }
#undef SCAN_G_LOAD
#undef SCAN_G_PROC
        }
    }
}

constexpr int GC3_GP_OFF = 64 * XI_STRIDE, GC3_XCH_OFF = GC3_GP_OFF + 256 * BI_STRIDE;
__device__ __forceinline__ void gla_c3_unit(Ctx& C, int l, int unit) {
    const int h = unit & 3, ck = unit >> 2; const size_t row0 = (size_t)ck * GLA_L;
    const int tid = C.tid, lane = C.lane, w = C.wave, c = lane & 15, hq = lane >> 4;
    LAS unsigned char* Vimg = C.lds; LAS unsigned char* GPimg = C.lds + GC3_GP_OFF; LAS float* xch = (LAS float*)(C.lds + GC3_XCH_OFF);
    const bf16* PROJ = (const bf16*)(C.ws + WS_PROJ); const bf16* QD = (const bf16*)(C.ws + WS_QD); const bf16* KI = (const bf16*)(C.ws + WS_KI); const bf16* GPV = (const bf16*)(C.ws + WS_GPV); bf16* Y = (bf16*)(C.ws + WS_Y);
    const int lt = w >> 1, vh = w & 1; const size_t row = row0 + 16 * lt + c;
    __syncthreads();
    { const bf16* gpv = GPV + (size_t)unit * 32768;
      v4u tv[4], tg[8];
#pragma unroll
      for (int it = 0; it < 4; ++it) { const int idx = tid + NTHR * it, t = idx >> 5, cg = idx & 31; tv[it] = __builtin_nontemporal_load((const GAS v4u*)(PROJ + (row0 + t) * DINP + C_GV + h * 256 + 8 * cg)); }
#pragma unroll
      for (int it = 0; it < 8; ++it) { const int idx = tid + NTHR * it; tg[it] = __builtin_nontemporal_load((const GAS v4u*)(gpv + (size_t)idx * 8)); }
#pragma unroll
      for (int it = 0; it < 4; ++it) { const int idx = tid + NTHR * it, t = idx >> 5, cg = idx & 31; *(LAS v4u*)(Vimg + t * XI_STRIDE + 16 * cg) = tv[it]; }
#pragma unroll
      for (int it = 0; it < 8; ++it) { const int idx = tid + NTHR * it, v = idx >> 4, cg = idx & 15; *(LAS v4u*)(GPimg + v * BI_STRIDE + 16 * cg) = tg[it]; } }
    bf16x8 qf[4];
#pragma unroll
    for (int ks = 0; ks < 4; ++ks) qf[ks] = gfrag(QD + row0 * GLA_KT + h * 128, GLA_KT, 16 * lt, 32 * ks, lane);
    v2u ggv[8];
#pragma unroll
    for (int vt = 0; vt < 8; ++vt) ggv[vt] = __builtin_nontemporal_load((const GAS v2u*)(PROJ + row * DINP + C_GG + h * 256 + 16 * (8 * vh + vt) + 4 * hq));
    f32x4 att[4];
#pragma unroll
    for (int st = 0; st < 4; ++st) { f32x4 a = (f32x4){0.f, 0.f, 0.f, 0.f};
        if (st <= lt) {
#pragma unroll
            for (int ks = 0; ks < 4; ++ks) a = mfma16(gfrag(KI + row0 * GLA_KT + h * 128, GLA_KT, 16 * st, 32 * ks, lane), qf[ks], a);
#pragma unroll
            for (int r = 0; r < 4; ++r) if (16 * st + 4 * hq + r > 16 * lt + c) a[r] = 0.f;
        }
        att[st] = a; }
    __syncthreads();
    f32x4 oacc[8];
#pragma unroll
    for (int vt = 0; vt < 8; ++vt) oacc[vt] = (f32x4){0.f, 0.f, 0.f, 0.f};
#pragma unroll
    for (int ks = 0; ks < 4; ++ks)
#pragma unroll
        for (int vt = 0; vt < 8; ++vt) oacc[vt] = mfma16(*(const LAS bf16x8*)(GPimg + (16 * (8 * vh + vt) + c) * BI_STRIDE + (32 * ks + 8 * hq) * 2), qf[ks], oacc[vt]);
#pragma unroll
    for (int ks2 = 0; ks2 < 2; ++ks2) { const bf16x8 pf = pack8(att[2 * ks2], att[2 * ks2 + 1]);
#pragma unroll
        for (int vt = 0; vt < 8; ++vt) oacc[vt] = mfma16(trfrag(Vimg, XI_STRIDE, 32 * ks2 + 4 * hq, 32 * ks2 + 16 + 4 * hq, 16 * (8 * vh + vt), lane), pf, oacc[vt]); }
    float ssq = 0.f;
#pragma unroll
    for (int vt = 0; vt < 8; ++vt) ssq += (oacc[vt].x * oacc[vt].x + oacc[vt].y * oacc[vt].y) + (oacc[vt].z * oacc[vt].z + oacc[vt].w * oacc[vt].w);
    ssq = xsum4(ssq);
    if (hq == 0) xch[w * 16 + c] = ssq;
    __syncthreads();
    const float rstd = 1.f / sqrtf((xch[w * 16 + c] + xch[(w ^ 1) * 16 + c]) * (1.f / 256.f) + EPS);
    const float* gla_norm = C.in[I_GLA_NORM] + (size_t)l * 256;
#pragma unroll
    for (int vt = 0; vt < 8; ++vt) { const int v0 = 16 * (8 * vh + vt) + 4 * hq; const f32x4 gn = *(const GAS f32x4*)(gla_norm + v0); const v2u gg = ggv[vt];
        const f32x4 o = oacc[vt]; v2u ow; ow.x = pk2(o.x * rstd * gn.x * silu_f(bflo(gg.x)), o.y * rstd * gn.y * silu_f(bfhi(gg.x))); ow.y = pk2(o.z * rstd * gn.z * silu_f(bflo(gg.y)), o.w * rstd * gn.w * silu_f(bfhi(gg.y)));
        *(GAS v2u*)(Y + row * DM + 3072 + h * 256 + v0) = ow; }
}

__device__ __forceinline__ void ssd_c1_unit(Ctx& C, int unit) {
    const int g = unit & 7, bc = unit >> 3; const size_t row0 = (size_t)bc * SSD_L;
    const int tid = C.tid, lane = C.lane, w = C.wave, c = lane & 15, hq = lane >> 4;
    LAS float* acs = (LAS float*)C.lds; LAS float* dts = acs + 512;
    LAS unsigned char* XWimg = C.lds + 4096; LAS unsigned char* Bimg = C.lds + 4096 + 128 * XI_STRIDE;
    const bf16* XBC = (const bf16*)(C.ws + WS_XBC); const float* DT = (const float*)(C.ws + WS_DT); const float* ACS = (const float*)(C.ws + WS_ACS); bf16* ST = (bf16*)(C.ws + WS_ST);
    __syncthreads();
    { const int t = tid >> 2, hh = tid & 3; acs[hh * 128 + t] = ACS[(row0 + t) * SSD_H + 4 * g + hh]; dts[hh * 128 + t] = DT[(row0 + t) * SSD_H + 4 * g + hh]; }
    __syncthreads();
#pragma unroll
    for (int it = 0; it < 8; ++it) { const int idx = tid + NTHR * it, t = idx >> 5, cg = idx & 31, hh = cg >> 3; const float wgt = __expf(acs[hh * 128 + 127] - acs[hh * 128 + t]) * dts[hh * 128 + t];
        const v4u r = __builtin_nontemporal_load((const GAS v4u*)(XBC + (row0 + t) * SSD_CD + g * 256 + 8 * cg));
        v4u o; o.x = pk2(bflo(r.x) * wgt, bfhi(r.x) * wgt); o.y = pk2(bflo(r.y) * wgt, bfhi(r.y) * wgt); o.z = pk2(bflo(r.z) * wgt, bfhi(r.z) * wgt); o.w = pk2(bflo(r.w) * wgt, bfhi(r.w) * wgt);
        *(LAS v4u*)(XWimg + t * XI_STRIDE + 16 * cg) = o; }
#pragma unroll
    for (int it = 0; it < 4; ++it) { const int idx = tid + NTHR * it, t = idx >> 4, cg = idx & 15; *(LAS v4u*)(Bimg + t * BI_STRIDE + 16 * cg) = __builtin_nontemporal_load((const GAS v4u*)(XBC + (row0 + t) * SSD_CD + 2048 + g * 128 + 8 * cg)); }
    __syncthreads();
    const int hh = w >> 1, ph = w & 1;
    f32x4 acc[8][2];
#pragma unroll
    for (int mt = 0; mt < 8; ++mt) { acc[mt][0] = (f32x4){0.f, 0.f, 0.f, 0.f}; acc[mt][1] = (f32x4){0.f, 0.f, 0.f, 0.f}; }
#pragma unroll
    for (int ks = 0; ks < 4; ++ks) { const int r0 = 32 * ks + 8 * hq;
        const bf16x8 x0 = trfrag(XWimg, XI_STRIDE, r0, r0 + 4, hh * 64 + 32 * ph, lane), x1 = trfrag(XWimg, XI_STRIDE, r0, r0 + 4, hh * 64 + 32 * ph + 16, lane);
#pragma unroll
        for (int mt = 0; mt < 8; ++mt) { const bf16x8 bf = trfrag(Bimg, BI_STRIDE, r0, r0 + 4, 16 * mt, lane); acc[mt][0] = mfma16(bf, x0, acc[mt][0]); acc[mt][1] = mfma16(bf, x1, acc[mt][1]); } }
    bf16* sp = ST + ((size_t)bc * SSD_H + 4 * g + hh) * 8192 + 4 * hq;
#pragma unroll
    for (int mt = 0; mt < 8; ++mt)
#pragma unroll
        for (int pt = 0; pt < 2; ++pt) { v2u o; o.x = pk2(acc[mt][pt].x, acc[mt][pt].y); o.y = pk2(acc[mt][pt].z, acc[mt][pt].w); *(GAS v2u*)(sp + (size_t)(32 * ph + 16 * pt + c) * 128 + 16 * mt) = o; }
}

struct SsdC1Pre { v4u tx[8], tbv[4]; float ac[8], dc[8], alast; };
__device__ __forceinline__ void ssd_c1_load(Ctx& C, int unit, SsdC1Pre& p) {
    const int g = unit & 7, bc = unit >> 3, tid = C.tid; const size_t row0 = (size_t)bc * SSD_L;
    const bf16* XBC = (const bf16*)(C.ws + WS_XBC); const float* DT = (const float*)(C.ws + WS_DT); const float* ACS = (const float*)(C.ws + WS_ACS);
    const int cg = tid & 31, hh = cg >> 3;
    p.alast = ACS[(row0 + 127) * SSD_H + 4 * g + hh];
#pragma unroll
    for (int it = 0; it < 8; ++it) { const int t = (tid >> 5) + 16 * it; p.ac[it] = ACS[(row0 + t) * SSD_H + 4 * g + hh]; p.dc[it] = DT[(row0 + t) * SSD_H + 4 * g + hh];
        p.tx[it] = __builtin_nontemporal_load((const GAS v4u*)(XBC + (row0 + t) * SSD_CD + g * 256 + 8 * cg)); }
#pragma unroll
    for (int it = 0; it < 4; ++it) { const int idx = tid + NTHR * it, t = idx >> 4, c2 = idx & 15; p.tbv[it] = __builtin_nontemporal_load((const GAS v4u*)(XBC + (row0 + t) * SSD_CD + 2048 + g * 128 + 8 * c2)); }
}
__device__ __forceinline__ void ssd_c1_stage(Ctx& C, const SsdC1Pre& p) {
    const int tid = C.tid, cg = tid & 31; LAS unsigned char* XWimg = C.lds + 4096; LAS unsigned char* Bimg = C.lds + 4096 + 128 * XI_STRIDE;
#pragma unroll
    for (int it = 0; it < 8; ++it) { const int t = (tid >> 5) + 16 * it; const float wgt = __expf(p.alast - p.ac[it]) * p.dc[it]; const v4u r = p.tx[it];
        v4u o; o.x = pk2(bflo(r.x) * wgt, bfhi(r.x) * wgt); o.y = pk2(bflo(r.y) * wgt, bfhi(r.y) * wgt); o.z = pk2(bflo(r.z) * wgt, bfhi(r.z) * wgt); o.w = pk2(bflo(r.w) * wgt, bfhi(r.w) * wgt);
        *(LAS v4u*)(XWimg + t * XI_STRIDE + 16 * cg) = o; }
#pragma unroll
    for (int it = 0; it < 4; ++it) { const int idx = tid + NTHR * it, t = idx >> 4, c2 = idx & 15; *(LAS v4u*)(Bimg + t * BI_STRIDE + 16 * c2) = p.tbv[it]; }
}
__device__ __forceinline__ void ssd_c1_compute(Ctx& C, int unit) {
    const int g = unit & 7, bc = unit >> 3; const int lane = C.lane, w = C.wave, c = lane & 15, hq = lane >> 4;
    LAS unsigned char* XWimg = C.lds + 4096; LAS unsigned char* Bimg = C.lds + 4096 + 128 * XI_STRIDE; bf16* ST = (bf16*)(C.ws + WS_ST);
    const int hh = w >> 1, ph = w & 1;
    f32x4 acc[8][2];
#pragma unroll
    for (int mt = 0; mt < 8; ++mt) { acc[mt][0] = (f32x4){0.f, 0.f, 0.f, 0.f}; acc[mt][1] = (f32x4){0.f, 0.f, 0.f, 0.f}; }
#pragma unroll
    for (int ks = 0; ks < 4; ++ks) { const int r0 = 32 * ks + 8 * hq;
        const bf16x8 x0 = trfrag(XWimg, XI_STRIDE, r0, r0 + 4, hh * 64 + 32 * ph, lane), x1 = trfrag(XWimg, XI_STRIDE, r0, r0 + 4, hh * 64 + 32 * ph + 16, lane);
#pragma unroll
        for (int mt = 0; mt < 8; ++mt) { const bf16x8 bf = trfrag(Bimg, BI_STRIDE, r0, r0 + 4, 16 * mt, lane); acc[mt][0] = mfma16(bf, x0, acc[mt][0]); acc[mt][1] = mfma16(bf, x1, acc[mt][1]); } }
    bf16* sp = ST + ((size_t)bc * SSD_H + 4 * g + hh) * 8192 + 4 * hq;
#pragma unroll
    for (int mt = 0; mt < 8; ++mt)
#pragma unroll
        for (int pt = 0; pt < 2; ++pt) { v2u o; o.x = pk2(acc[mt][pt].x, acc[mt][pt].y); o.y = pk2(acc[mt][pt].z, acc[mt][pt].w); *(GAS v2u*)(sp + (size_t)(32 * ph + 16 * pt + c) * 128 + 16 * mt) = o; }
}

constexpr int SC3_X_OFF = 4096, SC3_PV_OFF = SC3_X_OFF + 128 * XI_STRIDE, SC3_PV_HEAD = 64 * BI_STRIDE;
static_assert(SC3_PV_OFF + 4 * SC3_PV_HEAD <= MISC_OFF && GC3_XCH_OFF + 512 <= MISC_OFF, "mixer LDS maps");
__device__ __forceinline__ void ssd_c3_unit(Ctx& C, int l, int unit) {
    const int g = unit & 7, bc = unit >> 3; const size_t row0 = (size_t)bc * SSD_L;
    const int tid = C.tid, lane = C.lane, w = C.wave, c = lane & 15, hq = lane >> 4;
    LAS float* acs = (LAS float*)C.lds; LAS float* dts = acs + 512;
    LAS unsigned char* Ximg = C.lds + SC3_X_OFF; LAS unsigned char* PVimg = C.lds + SC3_PV_OFF;
    const bf16* PROJ = (const bf16*)(C.ws + WS_PROJ); const bf16* XBC = (const bf16*)(C.ws + WS_XBC); const float* DT = (const float*)(C.ws + WS_DT); const float* ACS = (const float*)(C.ws + WS_ACS);
    const bf16* PV = (const bf16*)(C.ws + WS_PV); bf16* Y = (bf16*)(C.ws + WS_Y);
    const int tl = 16 * w + c; const size_t row = row0 + tl;
    __syncthreads();
    { const int t = tid >> 2, hh = tid & 3; const float a0 = ACS[(row0 + t) * SSD_H + 4 * g + hh], d0 = DT[(row0 + t) * SSD_H + 4 * g + hh];
      const bf16* pvb = PV + ((size_t)bc * SSD_H + 4 * g) * 8192;
      v4u tx[8], tp[8];
#pragma unroll
      for (int it = 0; it < 8; ++it) { const int idx = tid + NTHR * it, t2 = idx >> 5, cg = idx & 31; tx[it] = __builtin_nontemporal_load((const GAS v4u*)(XBC + (row0 + t2) * SSD_CD + g * 256 + 8 * cg)); }
#pragma unroll
      for (int it = 0; it < 8; ++it) { const int idx = tid + NTHR * it; tp[it] = __builtin_nontemporal_load((const GAS v4u*)(pvb + (size_t)idx * 8)); }
      acs[(tid & 3) * 128 + (tid >> 2)] = a0; dts[(tid & 3) * 128 + (tid >> 2)] = d0;
#pragma unroll
      for (int it = 0; it < 8; ++it) { const int idx = tid + NTHR * it, t2 = idx >> 5, cg = idx & 31; *(LAS v4u*)(Ximg + t2 * XI_STRIDE + 16 * cg) = tx[it]; }
#pragma unroll
      for (int it = 0; it < 8; ++it) { const int idx = tid + NTHR * it, pr = idx >> 4, cg = idx & 15; *(LAS v4u*)(PVimg + pr * BI_STRIDE + 16 * cg) = tp[it]; } }
    bf16x8 cf[4];
#pragma unroll
    for (int ks = 0; ks < 4; ++ks) cf[ks] = gfrag(XBC + row0 * SSD_CD + 3072 + g * 128, SSD_CD, 16 * w, 32 * ks, lane);
    f32x4 cb[8];
#pragma unroll
    for (int st = 0; st < 8; ++st) { f32x4 a = (f32x4){0.f, 0.f, 0.f, 0.f};
        if (st <= w) {
#pragma unroll
            for (int ks = 0; ks < 4; ++ks) a = mfma16(gfrag(XBC + row0 * SSD_CD + 2048 + g * 128, SSD_CD, 16 * st, 32 * ks, lane), cf[ks], a);
        }
        cb[st] = a; }
    __syncthreads();
    v2u yk[4][4];
    float ssq = 0.f;
#pragma unroll
    for (int hh = 0; hh < 4; ++hh) {
        v2u zz[4];
#pragma unroll
        for (int pt = 0; pt < 4; ++pt) zz[pt] = __builtin_nontemporal_load((const GAS v2u*)(PROJ + row * DINP + C_Z + g * 256 + hh * 64 + 16 * pt + 4 * hq));
        const float acs_l = acs[hh * 128 + tl], el = __expf(acs_l);
        f32x4 ya[4];
#pragma unroll
        for (int pt = 0; pt < 4; ++pt) ya[pt] = (f32x4){0.f, 0.f, 0.f, 0.f};
#pragma unroll
        for (int ks = 0; ks < 4; ++ks)
#pragma unroll
            for (int pt = 0; pt < 4; ++pt) ya[pt] = mfma16(*(const LAS bf16x8*)(PVimg + (hh * 64 + 16 * pt + c) * BI_STRIDE + (32 * ks + 8 * hq) * 2), cf[ks], ya[pt]);
#pragma unroll
        for (int pt = 0; pt < 4; ++pt) ya[pt] = ya[pt] * el;
#pragma unroll
        for (int ks2 = 0; ks2 < 4; ++ks2) {
            if (2 * ks2 <= w) {
                f32x4 lm[2];
#pragma unroll
                for (int t2 = 0; t2 < 2; ++t2) { const int s0 = 32 * ks2 + 16 * t2 + 4 * hq; const f32x4 as4 = *(const LAS f32x4*)(acs + hh * 128 + s0), dt4 = *(const LAS f32x4*)(dts + hh * 128 + s0);
#pragma unroll
                    for (int r = 0; r < 4; ++r) { const float d = fminf(acs_l - as4[r], 0.f); lm[t2][r] = (s0 + r <= tl) ? cb[2 * ks2 + t2][r] * __expf(d) * dt4[r] : 0.f; } }
                const bf16x8 pf = pack8(lm[0], lm[1]);
#pragma unroll
                for (int pt = 0; pt < 4; ++pt) ya[pt] = mfma16(trfrag(Ximg, XI_STRIDE, 32 * ks2 + 4 * hq, 32 * ks2 + 16 + 4 * hq, hh * 64 + 16 * pt, lane), pf, ya[pt]);
            }
        }
        const float Dh = C.in[I_SSD_D][l * SSD_H + 4 * g + hh];
#pragma unroll
        for (int pt = 0; pt < 4; ++pt) { const int col = hh * 64 + 16 * pt + 4 * hq; const v2u xw = *(const LAS v2u*)(Ximg + tl * XI_STRIDE + col * 2); const v2u z2 = zz[pt];
            f32x4 v; v.x = (ya[pt].x + Dh * bflo(xw.x)) * silu_f(bflo(z2.x)); v.y = (ya[pt].y + Dh * bfhi(xw.x)) * silu_f(bfhi(z2.x)); v.z = (ya[pt].z + Dh * bflo(xw.y)) * silu_f(bflo(z2.y)); v.w = (ya[pt].w + Dh * bfhi(xw.y)) * silu_f(bfhi(z2.y));
            { v2u pk; pk.x = pk2(v.x, v.y); pk.y = pk2(v.z, v.w); yk[hh][pt] = pk; } ssq += (v.x * v.x + v.y * v.y) + (v.z * v.z + v.w * v.w); }
    }
    ssq = xsum4(ssq);
    const float rstd = 1.f / sqrtf(ssq * (1.f / 256.f) + EPS);
    const float* ssd_norm = C.in[I_SSD_NORM] + (size_t)l * SSD_W + g * 256;
#pragma unroll
    for (int hh = 0; hh < 4; ++hh)
#pragma unroll
        for (int pt = 0; pt < 4; ++pt) { const int col = hh * 64 + 16 * pt + 4 * hq; const f32x4 gn = *(const GAS f32x4*)(ssd_norm + col); const f32x4 v = (f32x4){bflo(yk[hh][pt].x), bfhi(yk[hh][pt].x), bflo(yk[hh][pt].y), bfhi(yk[hh][pt].y)};
            v2u ow; ow.x = pk2(v.x * rstd * gn.x, v.y * rstd * gn.y); ow.y = pk2(v.z * rstd * gn.z, v.w * rstd * gn.w); *(GAS v2u*)(Y + row * DM + g * 256 + col) = ow; }
}

__device__ __forceinline__ void mix_c1_phase(Ctx& C, int l) {
    const bool swa_first = ((C.bid >> 3) & 1) != 0;
#pragma nounroll
    for (int pass = 0; pass < 2; ++pass) {
        if ((pass == 0) == swa_first) {
            for (int u = C.bid; u < N_SWA_UNITS; u += C.G) { int t_ = threadIdx.x; asm volatile("" : "+v"(t_)); C.tid = t_; C.lane = t_ & 63; swa_unit_mfma(C, l, u); }
        } else {
            { int u = C.bid; SsdC1Pre p; if (u < N_SSD_CU) ssd_c1_load(C, u, p);
              while (u < N_SSD_CU) { { int t_ = threadIdx.x; asm volatile("" : "+v"(t_)); C.tid = t_; C.lane = t_ & 63; } __syncthreads(); ssd_c1_stage(C, p); __syncthreads(); const int un = u + C.G; if (un < N_SSD_CU) ssd_c1_load(C, un, p); ssd_c1_compute(C, u); u = un; } }
            { int u = C.bid; GlaC1Pre p; if (u < N_GLA_CU) gla_c1_load(C, u, p);
              while (u < N_GLA_CU) { { int t_ = threadIdx.x; asm volatile("" : "+v"(t_)); C.tid = t_; C.lane = t_ & 63; } __syncthreads(); gla_c1_stage(C, p); __syncthreads(); const int un = u + C.G; if (un < N_GLA_CU) gla_c1_load(C, un, p); gla_c1_compute(C, u); u = un; } }
        }
        { int t_ = threadIdx.x; asm volatile("" : "+v"(t_)); C.tid = t_; C.lane = t_ & 63; } __syncthreads();
    }
}
__device__ __forceinline__ void mix_c3_phase(Ctx& C, int l) {
    for (int u = C.bid; u < N_SSD_CU; u += C.G) { int t_ = threadIdx.x; asm volatile("" : "+v"(t_)); C.tid = t_; C.lane = t_ & 63; ssd_c3_unit(C, l, u); }
    for (int u = C.bid; u < N_GLA_CU; u += C.G) { int t_ = threadIdx.x; asm volatile("" : "+v"(t_)); C.tid = t_; C.lane = t_ & 63; gla_c3_unit(C, l, u); }
}

__device__ __forceinline__ void act_fixup_phase(Ctx& C, int l) {
    bf16* ACT = (bf16*)(C.ws + WS_ACT); const float* HTG = (const float*)(C.ws + WS_HTG); const float* HTU = (const float*)(C.ws + WS_HTU); const float* HBG = (const float*)(C.ws + WS_HBG);
    const float* cw = C.in[I_FFN_CONV_W] + (size_t)l * 3 * DFF; const float* cb = C.in[I_FFN_CONV_B] + (size_t)l * DFF;
    constexpr int NC4 = DFF / 4, NIT = (M / 64) * 2 * NC4;
    for (int it = C.bid * NTHR + C.tid; it < NIT; it += C.G * NTHR) {
        const int c4 = it % NC4, ri = it / NC4, i = ri & 1, blk = ri >> 1, c0 = 4 * c4; const bool first = (blk % (SEQ / 64)) == 0;
        const f32x4 z4 = (f32x4){0.f, 0.f, 0.f, 0.f};
        const f32x4 g0 = *(const GAS f32x4*)(HTG + ((size_t)blk * 2 + i) * DFF + c0), up = *(const GAS f32x4*)(HTU + ((size_t)blk * 2 + i) * DFF + c0);
        const f32x4 pb1 = first ? z4 : *(const GAS f32x4*)(HBG + ((size_t)(blk - 1) * 2 + 1) * DFF + c0), pb0 = first ? z4 : *(const GAS f32x4*)(HBG + ((size_t)(blk - 1) * 2 + 0) * DFF + c0);
        const f32x4 g1 = i ? *(const GAS f32x4*)(HTG + ((size_t)blk * 2 + 0) * DFF + c0) : pb1, g2 = i ? pb1 : pb0;
        const f32x4 w0 = *(const GAS f32x4*)(cw + c0), w1 = *(const GAS f32x4*)(cw + DFF + c0), w2 = *(const GAS f32x4*)(cw + 2 * DFF + c0), bb = *(const GAS f32x4*)(cb + c0);
        f32x4 o;
#pragma unroll
        for (int e = 0; e < 4; ++e) { const float gc = bb[e] + w0[e] * g2[e] + w1[e] * g1[e] + w2[e] * g0[e]; o[e] = silu_f(gc) * up[e]; }
        v2u ow; ow.x = pk2(o.x, o.y); ow.y = pk2(o.z, o.w); *(GAS v2u*)(ACT + (size_t)(64 * blk + i) * DFF + c0) = ow;
    }
}

constexpr int PH_PER_LAYER = 11, PH_FINAL = DEPTH * PH_PER_LAYER, N_PHASES = PH_FINAL + 1;
#ifndef WGM_DOWN
#define WGM_DOWN 4
#endif
#ifndef MK_ONE_LAUNCH
#define MK_ONE_LAUNCH 1
#endif
__global__ void __launch_bounds__(NTHR, 2) fwd_kernel(Args args) {
    extern __shared__ __attribute__((aligned(16))) unsigned char lds[];
    Ctx C;
    C.lds = (LAS unsigned char*)lds;
    C.tid = threadIdx.x; C.lane = C.tid & 63; C.wave = __builtin_amdgcn_readfirstlane(C.tid >> 6);
    C.G = gridDim.x; C.bid = blockIdx.x;
    C.in = args.in; C.out = args.out; C.ws = args.ws;
    volatile LAS unsigned* MISC = (volatile LAS unsigned*)(C.lds + MISC_OFF);
    for (int u = C.tid; u < (LDS_BYTES - MISC_OFF) / 4; u += NTHR) ((LAS unsigned*)(C.lds + MISC_OFF))[u] = 0u;
    __syncthreads();
    gu32* ctl = (gu32*)(args.ws + WS_CTL);
    XcdBarrier bar = xcd_barrier_post((unsigned*)(ctl + CW_BAR) + args.li * XCD_BAR_WORDS, MISC + 8);
    const int lo = args.ph_lo, hi = args.ph_hi;
#define IN(k) (lo <= (k) && (k) < hi)
#define SEAM(k) do { if (IN(k) && IN((k) + 1)) xcd_barrier(bar); } while (0)
    bf16* xb = (bf16*)(args.ws + WS_XB);
    bf16* H = (bf16*)(args.ws + WS_H);
#define LAUNDER() do { int t_ = threadIdx.x; asm volatile("" : "+v"(t_)); C.tid = t_; C.lane = t_ & 63; } while (0)
#define LAYER_BODY(l) do { \
        const int pb = l * PH_PER_LAYER; \
        LAUNDER(); \
        if (IN(pb + 0)) { convert_weights(C, l, 0, CV_A_ITEMS); if (l == 0) rmsnorm_phase(C, args.in[I_X], args.in[I_ATTN_NORM] + (size_t)l * DM, H); else rmsnorm_phase_b(C, xb, args.in[I_ATTN_NORM] + (size_t)l * DM, H); } \
        SEAM(pb + 0); \
        LAUNDER(); \
        if (IN(pb + 1)) { \
            pg8::Gemm g{H, (const bf16*)(args.ws + WS_WIN), M, DINP, DM}; pg8::StaticOrder S; S.init(M, DINP, C.G, C.bid); \
            pg8::EpiProjConv E{(bf16*)(args.ws + WS_PROJ), DINP, (bf16*)(args.ws + WS_XBC), args.in[I_SSD_CONV_W] + (size_t)l * 4 * SSD_CD, args.in[I_SSD_CONV_B] + (size_t)l * SSD_CD, (float*)(args.ws + WS_XHT), (float*)(args.ws + WS_XHB)}; \
            pg8::gemm_phase<pg8::EpiProjConv, pg8::StaticOrder, true, true>(C.lds, g, S, E); \
        } \
        SEAM(pb + 1); \
        LAUNDER(); \
        if (IN(pb + 2)) {   \
            const bool cvf = ((C.bid >> 3) & 1) != 0; \
            _Pragma("nounroll") for (int pass = 0; pass < 2; ++pass) { if ((pass == 0) == cvf) convert_weights(C, l, CV_UP_LO, CV_DN_LO); else prep_phase(C, l); LAUNDER(); __syncthreads(); } } \
        SEAM(pb + 2); \
        LAUNDER(); \
        if (IN(pb + 3)) mix_c1_phase(C, l); \
        SEAM(pb + 3); \
        LAUNDER(); \
        if (IN(pb + 4)) scan_phase(C); \
        SEAM(pb + 4); \
        LAUNDER(); \
        if (IN(pb + 5)) mix_c3_phase(C, l); \
        SEAM(pb + 5); \
        LAUNDER(); \
        if (IN(pb + 6)) { \
            pg8::Gemm g{(const bf16*)(args.ws + WS_Y), (const bf16*)(args.ws + WS_WOUT), M, DM, DM}; pg8::StaticOrder S; S.init(M, DM, C.G, C.bid); \
            if constexpr ((l) == 0) { pg8::EpiResB<true> E{(const void*)args.in[I_X], xb, DM}; pg8::gemm_phase<pg8::EpiResB<true>, pg8::StaticOrder, true, true>(C.lds, g, S, E); } \
            else { pg8::EpiResB<false> E{(const void*)xb, xb, DM}; pg8::gemm_phase<pg8::EpiResB<false>, pg8::StaticOrder, true, true>(C.lds, g, S, E); } \
        } \
        SEAM(pb + 6); \
        LAUNDER(); \
        if (IN(pb + 7)) rmsnorm_phase_b(C, xb, args.in[I_FFN_NORM] + (size_t)l * DM, H); \
        SEAM(pb + 7); \
        LAUNDER(); \
        if (IN(pb + 8)) { \
            pg8::Gemm g{H, (const bf16*)(args.ws + WS_WGU), M, DGU, DM}; pg8::StaticOrder S; S.init(M, DGU, C.G, C.bid); \
            pg8::EpiGateUp E{(bf16*)(args.ws + WS_ACT), args.in[I_FFN_CONV_W] + (size_t)l * 3 * DFF, args.in[I_FFN_CONV_B] + (size_t)l * DFF, (float*)(args.ws + WS_HTG), (float*)(args.ws + WS_HTU), (float*)(args.ws + WS_HBG), DFF}; \
            pg8::gemm_phase<pg8::EpiGateUp, pg8::StaticOrder, true, true>(C.lds, g, S, E); \
        } \
        SEAM(pb + 8); \
        LAUNDER(); \
        if (IN(pb + 9)) { const bool cvf = ((C.bid >> 3) & 1) != 0; \
            _Pragma("nounroll") for (int pass = 0; pass < 2; ++pass) { if ((pass == 0) == cvf) convert_weights(C, l, CV_DN_LO, CV_NITEMS); else act_fixup_phase(C, l); LAUNDER(); __syncthreads(); } } \
        SEAM(pb + 9); \
        LAUNDER(); \
        if (IN(pb + 10)) { \
            pg8::Gemm g{(const bf16*)(args.ws + WS_ACT), (const bf16*)(args.ws + WS_WDN), M, DM, DFF}; pg8::StaticOrder S; S.init(M, DM, C.G, C.bid, WGM_DOWN); \
            pg8::EpiResB<false> E{(const void*)xb, xb, DM}; \
            pg8::gemm_phase<pg8::EpiResB<false>, pg8::StaticOrder, true, true>(C.lds, g, S, E); \
        } \
        SEAM(pb + 10); \
     \
    } while (0)
    LAYER_BODY(0);
    LAYER_BODY(1);
#undef LAYER_BODY
    LAUNDER();
    if (IN(PH_FINAL)) final_norm_phase(C, xb, args.in[I_FINAL_NORM], args.out);
#undef IN
#undef SEAM
}

extern "C" void kernel_launch(void* const* d_in, const int* in_sizes, int n_in, void* d_out, int out_size, void* d_ws, size_t ws_size, hipStream_t stream) {
    static int grid = 0;
    if (grid == 0) {
        if (n_in != N_IN || out_size != M * DM || ws_size < WS_END) { fprintf(stderr, "kernel_launch: unexpected shapes (n_in %d, out %d, ws %zu < %zu)\n", n_in, out_size, ws_size, (size_t)WS_END); grid = -1; return; }
        int dev = 0, cus = 0, per_cu = 0;
        if (hipGetDevice(&dev) != hipSuccess || hipDeviceGetAttribute(&cus, hipDeviceAttributeMultiprocessorCount, dev) != hipSuccess) { grid = -1; return; }
        if (hipFuncSetAttribute((const void*)fwd_kernel, hipFuncAttributeMaxDynamicSharedMemorySize, LDS_BYTES) != hipSuccess) { fprintf(stderr, "kernel_launch: hipFuncSetAttribute failed\n"); grid = -1; return; }
        if (hipOccupancyMaxActiveBlocksPerMultiprocessor(&per_cu, (const void*)fwd_kernel, NTHR, LDS_BYTES) != hipSuccess || per_cu < 1) { fprintf(stderr, "kernel_launch: occupancy query says %d\n", per_cu); (void)hipGetLastError(); grid = -1; return; }
        grid = cus;
    }
    if (grid < 0) return;
    constexpr size_t kZero = (size_t)(CW_BAR + (MK_ONE_LAUNCH ? 1 : N_PHASES) * XCD_BAR_WORDS) * sizeof(unsigned);
    static_assert(kZero <= CTL_BYTES, "control region");
    if (hipMemsetAsync((char*)d_ws + WS_CTL, 0, kZero, stream) != hipSuccess) return;
    Args a{};
    for (int i = 0; i < N_IN; ++i) a.in[i] = (const float*)d_in[i];
    a.out = (float*)d_out; a.ws = (unsigned char*)d_ws; a.pad = 0;
#if MK_ONE_LAUNCH
    a.ph_lo = 0; a.ph_hi = N_PHASES; a.li = 0;
    hipLaunchKernelGGL(fwd_kernel, dim3(grid), dim3(NTHR), LDS_BYTES, stream, a);
#else
    for (int p = 0; p < N_PHASES; ++p) { a.ph_lo = p; a.ph_hi = p + 1; a.li = p;
        hipLaunchKernelGGL(fwd_kernel, dim3(grid), dim3(NTHR), LDS_BYTES, stream, a); }
#endif
}
```

```cpp
#include <hip/hip_runtime.h>
#include <cstdio>
#include <cstdint>
namespace pg8 {
#define PG8_LAS __attribute__((address_space(3)))
typedef unsigned short bf16_t;
typedef short bf16x8 __attribute__((ext_vector_type(8)));
typedef float f32x4 __attribute__((ext_vector_type(4)));
typedef unsigned u32x4 __attribute__((ext_vector_type(4)));
constexpr int BM = 256, BK = 64, HALF = 128, HTB = HALF * BK * 2  , STAGE_BYTES = 8 * HTB, NXCD = 8, WGM = 8;

__host__ __device__ __forceinline__ int lds_byte(int r, int c) { const int st = (r >> 4) * 2 + (c >> 5), rr = r & 15, cc = c & 31, ob = rr * 64 + cc * 2; return st * 1024 + (ob ^ (((ob >> 9) & 1) << 5)); }
__host__ __device__ __forceinline__ void stage_rc(int b, int& R, int& C) { const int st = b / 1024, sb = b % 1024, swz = sb ^ (((sb >> 9) & 1) << 5); R = (st >> 1) * 16 + swz / 64; C = (st & 1) * 32 + (swz % 64) / 2; }
__host__ __device__ __forceinline__ int perm32(int rho) { const int n = rho >> 4, i = rho & 15; return 8 * (i >> 2) + 4 * n + (i & 3); }

struct Unit { int pm, pn; };
struct Gemm { const bf16_t* A; const bf16_t* Bt; int M, N, K; };

struct StaticOrder {
    int nM, nN, nwg, G, c, wgm;
    __host__ __device__ void init(int M, int N, int G_, int c_, int wgm_ = WGM) { nM = M / BM; nN = N / BM; nwg = nM * nN; G = G_; c = c_; wgm = wgm_; }
    __host__ __device__ bool next(int i, Unit& u) const {
        const long L = (long)i * G + c; if (L >= nwg) return false;
        int wgid = (int)L; { const int q = nwg / NXCD, r = nwg % NXCD, xcd = wgid % NXCD, off = wgid / NXCD; wgid = (xcd < r ? xcd * (q + 1) : r * (q + 1) + (xcd - r) * q) + off; }
        const int nig = wgm * nN, gid = wgid / nig, fm = gid * wgm, gsz = (nM - fm) < wgm ? (nM - fm) : wgm;
        u.pm = fm + ((wgid % nig) % gsz); u.pn = (wgid % nig) / gsz; return true;
    }
    __device__ __forceinline__ void a_ready(const Unit&) const {}
    __device__ __forceinline__ void done(const Unit&) const {}
};

typedef float f32x2c __attribute__((ext_vector_type(2)));
typedef __bf16 bf16x2c __attribute__((ext_vector_type(2)));
__device__ __forceinline__ unsigned cvt_pk_bf16(float lo, float hi) { const f32x2c v = {lo, hi}; return __builtin_bit_cast(unsigned, __builtin_convertvector(v, bf16x2c)); }

struct EpiBf16 {
    static constexpr bool PERM = true, AFTER_DRAIN = false;
    bf16_t* O; int ldc;
    __device__ __forceinline__ void operator()(const f32x4 (&acc)[2][2][4][2], const Unit& u, int wr, int wc, int fr, int fq) const {
        const int row0 = u.pm * BM + wr * 64 + fr; const int col0 = u.pn * BM + wc * 32 + 8 * fq;
#pragma unroll
        for (int ai = 0; ai < 2; ++ai)
#pragma unroll
            for (int m = 0; m < 4; ++m) { bf16_t* rowp = O + (size_t)(row0 + ai * HALF + m * 16) * ldc + col0;
#pragma unroll
                for (int bj = 0; bj < 2; ++bj) { const f32x4 v0 = acc[ai][bj][m][0], v1 = acc[ai][bj][m][1];
                    u32x4 w; w.x = cvt_pk_bf16(v0[0], v0[1]); w.y = cvt_pk_bf16(v0[2], v0[3]); w.z = cvt_pk_bf16(v1[0], v1[1]); w.w = cvt_pk_bf16(v1[2], v1[3]);
                    *(u32x4*)(rowp + bj * HALF) = w; } }
    }
};
template <int CTRL> __device__ __forceinline__ float dpp_old(float old, float v) { return __int_as_float(__builtin_amdgcn_update_dpp(__float_as_int(old), __float_as_int(v), CTRL, 0xf, 0xf, false)); }
template <int CTRL> __device__ __forceinline__ float dpp_ror(float v) { return __int_as_float(__builtin_amdgcn_mov_dpp(__float_as_int(v), CTRL, 0xf, 0xf, true)); }
struct EpiGateUp {
    static constexpr bool PERM = true, AFTER_DRAIN = false;
    bf16_t* ACT; const float* cw; const float* cb; float* HTG; float* HTU; float* HBG; int dff;
    __device__ __forceinline__ void operator()(const f32x4 (&acc)[2][2][4][2], const Unit& u, int wr, int wc, int fr, int fq) const {
        const int j0 = u.pn * 128 + wc * 32 + 8 * fq;
        float w0[8], w1[8], w2[8], bb[8];
#pragma unroll
        for (int h = 0; h < 2; ++h) { const f32x4 a = *(const f32x4*)(cw + j0 + 4 * h), b = *(const f32x4*)(cw + dff + j0 + 4 * h), c = *(const f32x4*)(cw + 2 * dff + j0 + 4 * h), d = *(const f32x4*)(cb + j0 + 4 * h);
#pragma unroll
            for (int e = 0; e < 4; ++e) { w0[4 * h + e] = a[e]; w1[4 * h + e] = b[e]; w2[4 * h + e] = c[e]; bb[4 * h + e] = d[e]; } }
#pragma unroll
        for (int ai = 0; ai < 2; ++ai) {
            const int rowb = u.pm * BM + ai * HALF + wr * 64; const size_t blk = (size_t)(rowb >> 6);
#pragma unroll
            for (int m = 0; m < 4; ++m) {
                const int row = rowb + 16 * m + fr; float o[8];
#pragma unroll
                for (int n = 0; n < 2; ++n)
#pragma unroll
                    for (int e = 0; e < 4; ++e) { const int k = 4 * n + e; const float g0 = acc[ai][0][m][n][e], up = acc[ai][1][m][n][e]; const float gp = acc[ai][0][m > 0 ? m - 1 : 0][n][e];
                        const float g1 = dpp_ror<0x121>(m > 0 && fr == 15 ? gp : g0), g2 = dpp_ror<0x122>(m > 0 && fr >= 14 ? gp : g0);
                        const float gc = bb[k] + w0[k] * g2 + w1[k] * g1 + w2[k] * g0; o[k] = gc * __builtin_amdgcn_rcpf(1.f + __expf(-gc)) * up; }
                u32x4 w; w.x = cvt_pk_bf16(o[0], o[1]); w.y = cvt_pk_bf16(o[2], o[3]); w.z = cvt_pk_bf16(o[4], o[5]); w.w = cvt_pk_bf16(o[6], o[7]);
                if (!(m == 0 && fr < 2)) __builtin_nontemporal_store(w, (u32x4*)(ACT + (size_t)row * dff + j0));
                if (m == 0 && fr < 2) { float* pg = HTG + (blk * 2 + fr) * dff + j0; float* pu = HTU + (blk * 2 + fr) * dff + j0;
                    *(f32x4*)pg = acc[ai][0][0][0]; *(f32x4*)(pg + 4) = acc[ai][0][0][1]; *(f32x4*)pu = acc[ai][1][0][0]; *(f32x4*)(pu + 4) = acc[ai][1][0][1]; }
                if (m == 3 && fr >= 14) { float* pg = HBG + (blk * 2 + (fr - 14)) * dff + j0; *(f32x4*)pg = acc[ai][0][3][0]; *(f32x4*)(pg + 4) = acc[ai][0][3][1]; }
            }
        }
    }
};
struct EpiProjConv {
    static constexpr bool PERM = true, AFTER_DRAIN = false;
    bf16_t* O; int ldc; bf16_t* XBC; const float* cw; const float* cb; float* HT; float* HB;
    __device__ __forceinline__ void operator()(const f32x4 (&acc)[2][2][4][2], const Unit& u, int wr, int wc, int fr, int fq) const {
        if (u.pn < 8 || u.pn >= 24) {
            const int row0 = u.pm * BM + wr * 64 + fr; const int col0 = u.pn * BM + wc * 32 + 8 * fq;
#pragma unroll
            for (int ai = 0; ai < 2; ++ai)
#pragma unroll
                for (int m = 0; m < 4; ++m) { bf16_t* rowp = O + (size_t)(row0 + ai * HALF + m * 16) * ldc + col0;
#pragma unroll
                    for (int bj = 0; bj < 2; ++bj) { const f32x4 v0 = acc[ai][bj][m][0], v1 = acc[ai][bj][m][1];
                        u32x4 w; w.x = cvt_pk_bf16(v0[0], v0[1]); w.y = cvt_pk_bf16(v0[2], v0[3]); w.z = cvt_pk_bf16(v1[0], v1[1]); w.w = cvt_pk_bf16(v1[2], v1[3]);
                        __builtin_nontemporal_store(w, (u32x4*)(rowp + bj * HALF)); } }
            return;
        }
#pragma unroll
        for (int bj = 0; bj < 2; ++bj) {
            const int c0 = (u.pn - 8) * BM + bj * HALF + wc * 32 + 8 * fq;
            float wv[4][8], bb[8];
#pragma unroll
            for (int h = 0; h < 2; ++h) { const f32x4 d = *(const f32x4*)(cb + c0 + 4 * h);
#pragma unroll
                for (int e = 0; e < 4; ++e) bb[4 * h + e] = d[e];
#pragma unroll
                for (int i = 0; i < 4; ++i) { const f32x4 a = *(const f32x4*)(cw + i * 4096 + c0 + 4 * h);
#pragma unroll
                    for (int e = 0; e < 4; ++e) wv[i][4 * h + e] = a[e]; } }
#pragma unroll
            for (int ai = 0; ai < 2; ++ai) {
                const int rowb = u.pm * BM + ai * HALF + wr * 64; const size_t blk = (size_t)(rowb >> 6);
#pragma unroll
                for (int m = 0; m < 4; ++m) {
                    const int row = rowb + 16 * m + fr; float o[8];
#pragma unroll
                    for (int n = 0; n < 2; ++n)
#pragma unroll
                        for (int e = 0; e < 4; ++e) { const int k = 4 * n + e; const float x0 = acc[ai][bj][m][n][e]; const float xp = acc[ai][bj][m > 0 ? m - 1 : 0][n][e];
                            const float x1 = dpp_ror<0x121>(m > 0 && fr == 15 ? xp : x0), x2 = dpp_ror<0x122>(m > 0 && fr >= 14 ? xp : x0), x3 = dpp_ror<0x123>(m > 0 && fr >= 13 ? xp : x0);
                            const float a = bb[k] + wv[0][k] * x3 + wv[1][k] * x2 + wv[2][k] * x1 + wv[3][k] * x0; o[k] = a * __builtin_amdgcn_rcpf(1.f + __expf(-a)); }
                    u32x4 w; w.x = cvt_pk_bf16(o[0], o[1]); w.y = cvt_pk_bf16(o[2], o[3]); w.z = cvt_pk_bf16(o[4], o[5]); w.w = cvt_pk_bf16(o[6], o[7]);
                    if (!(m == 0 && fr < 3)) __builtin_nontemporal_store(w, (u32x4*)(XBC + (size_t)row * 4096 + c0));
                    if (m == 0 && fr < 3) { float* p = HT + (blk * 3 + fr) * 4096 + c0; *(f32x4*)p = acc[ai][bj][0][0]; *(f32x4*)(p + 4) = acc[ai][bj][0][1]; }
                    if (m == 3 && fr >= 13) { float* p = HB + (blk * 3 + (fr - 13)) * 4096 + c0; *(f32x4*)p = acc[ai][bj][3][0]; *(f32x4*)(p + 4) = acc[ai][bj][3][1]; }
                }
            }
        }
    }
};
struct EpiRes {
    static constexpr bool PERM = false, AFTER_DRAIN = false;
    const float* base; float* out; int ldc;
    __device__ __forceinline__ void operator()(const f32x4 (&acc)[2][2][4][2], const Unit& u, int wr, int wc, int fr, int fq) const {
        const int row0 = u.pm * BM + wr * 64 + fr, col0 = u.pn * BM + wc * 32 + 4 * fq;
#pragma unroll
        for (int ai = 0; ai < 2; ++ai)
#pragma unroll
            for (int m = 0; m < 4; ++m) { const size_t off = (size_t)(row0 + ai * HALF + m * 16) * ldc + col0;
#pragma unroll
                for (int bj = 0; bj < 2; ++bj)
#pragma unroll
                    for (int n = 0; n < 2; ++n) { const f32x4 bs = *(const f32x4*)(base + off + bj * HALF + n * 16); *(f32x4*)(out + off + bj * HALF + n * 16) = bs + acc[ai][bj][m][n]; } }
    }
};
template <bool BASE_F32> struct EpiResB {
    static constexpr bool PERM = true, AFTER_DRAIN = false;
    const void* base; bf16_t* out; int ldc;
    __device__ __forceinline__ void operator()(const f32x4 (&acc)[2][2][4][2], const Unit& u, int wr, int wc, int fr, int fq) const {
        const int row0 = u.pm * BM + wr * 64 + fr, col0 = u.pn * BM + wc * 32 + 8 * fq;
#pragma unroll
        for (int ai = 0; ai < 2; ++ai)
#pragma unroll
            for (int m = 0; m < 4; ++m) { const size_t off = (size_t)(row0 + ai * HALF + m * 16) * ldc + col0;
#pragma unroll
                for (int bj = 0; bj < 2; ++bj) { f32x4 b0, b1;
                    if (BASE_F32) { const float* bp = (const float*)base + off + bj * HALF; b0 = *(const f32x4*)bp; b1 = *(const f32x4*)(bp + 4); }
                    else { const u32x4 w = *(const u32x4*)((const bf16_t*)base + off + bj * HALF);
                        b0 = (f32x4){__uint_as_float(w.x << 16), __uint_as_float(w.x & 0xffff0000u), __uint_as_float(w.y << 16), __uint_as_float(w.y & 0xffff0000u)};
                        b1 = (f32x4){__uint_as_float(w.z << 16), __uint_as_float(w.z & 0xffff0000u), __uint_as_float(w.w << 16), __uint_as_float(w.w & 0xffff0000u)}; }
                    const f32x4 o0 = b0 + acc[ai][bj][m][0], o1 = b1 + acc[ai][bj][m][1];
                    u32x4 ow; ow.x = cvt_pk_bf16(o0[0], o0[1]); ow.y = cvt_pk_bf16(o0[2], o0[3]); ow.z = cvt_pk_bf16(o1[0], o1[1]); ow.w = cvt_pk_bf16(o1[2], o1[3]);
                    *(u32x4*)(out + off + bj * HALF) = ow; } }
    }
};
template <class Epi, class Sched, bool ALIGN_EPI = false, bool SP2 = false>
__device__ __forceinline__ void gemm_phase(PG8_LAS unsigned char* lds, const Gemm g, const Sched& S, const Epi& E) {
    const int tid = threadIdx.x, wid = __builtin_amdgcn_readfirstlane(tid >> 6), lane = tid & 63, wr = wid >> 2, wc = wid & 3, fr = lane & 15, fq = lane >> 4;
    const int K = g.K, nt = K / BK;
    unsigned voffA[2], voffB[2];
#pragma unroll
    for (int i = 0; i < 2; ++i) { int R, C; stage_rc(tid * 16 + i * 8192, R, C); const int Rb = Epi::PERM ? ((R & ~31) + perm32(R & 31)) : R;
        voffA[i] = (unsigned)(R * K + C) * 2u; voffB[i] = (unsigned)(Rb * K + C) * 2u; }
    const size_t kstep = (size_t)(BK * 2);
    const size_t hstep = (size_t)HALF * K * 2;
    const size_t tstep = 2 * hstep;
    const unsigned ldsw = (unsigned)wid * 1024u;
    const int aoff = lds_byte(wr * 64 + fr, fq * 8), boff = lds_byte(wc * 32 + fr, fq * 8);
#define PG8_SA(b, h) (((b) * 2 + (h)) * HTB)
#define PG8_SB(b, h) ((4 + (b) * 2 + (h)) * HTB)
#define PG8_STAGE(bufoff, gbase, voff) do { _Pragma("unroll") for (int _i = 0; _i < 2; ++_i) \
        __builtin_amdgcn_global_load_lds((const unsigned*)((const char*)(gbase) + (voff)[_i]), (PG8_LAS unsigned*)(lds + (bufoff) + ldsw + _i * 8192), 16, 0, 0); } while (0)
#define PG8_LDA(dst, b, h) do { _Pragma("unroll") for (int m = 0; m < 4; ++m) _Pragma("unroll") for (int k = 0; k < 2; ++k) dst[m][k] = *(const PG8_LAS bf16x8*)(lds + PG8_SA(b, h) + aoff + m * 2048 + k * 1024); } while (0)
#define PG8_LDB(dst, b, h) do { _Pragma("unroll") for (int n = 0; n < 2; ++n) _Pragma("unroll") for (int k = 0; k < 2; ++k) dst[n][k] = *(const PG8_LAS bf16x8*)(lds + PG8_SB(b, h) + boff + n * 2048 + k * 1024); } while (0)
#define PG8_MMA(ai, bj, At, Bt) do { __builtin_amdgcn_s_setprio(1); _Pragma("unroll") for (int m = 0; m < 4; ++m) _Pragma("unroll") for (int n = 0; n < 2; ++n) _Pragma("unroll") for (int k = 0; k < 2; ++k) \
        acc[ai][bj][m][n] = __builtin_amdgcn_mfma_f32_16x16x32_bf16(Bt[n][k], At[m][k], acc[ai][bj][m][n], 0, 0, 0); __builtin_amdgcn_s_setprio(0); } while (0)
#define PG8_WAIT_V(n) asm volatile("s_waitcnt vmcnt(" #n ")" ::: "memory")
#define PG8_WAIT_L(n) asm volatile("s_waitcnt lgkmcnt(" #n ")" ::: "memory")
#define PG8_BAR __builtin_amdgcn_s_barrier()
#define PG8_SCHED __builtin_amdgcn_sched_barrier(0)
    Unit cur, nxt; int ui = 0;
    if (!S.next(0, cur)) return;
    f32x4 acc[2][2][4][2];
#pragma unroll
    for (int a = 0; a < 2; ++a)
#pragma unroll
        for (int b = 0; b < 2; ++b)
#pragma unroll
            for (int m = 0; m < 4; ++m)
#pragma unroll
                for (int n = 0; n < 2; ++n) acc[a][b][m][n] = (f32x4){0.f, 0.f, 0.f, 0.f};
    bf16x8 At[4][2], B0[2][2], B1[2][2];
    const char* cA = (const char*)g.A + (size_t)cur.pm * tstep; const char* cB = (const char*)g.Bt + (size_t)cur.pn * tstep;
    S.a_ready(cur);
    if constexpr (SP2) {
        PG8_STAGE(PG8_SB(0, 0), cB, voffB); PG8_STAGE(PG8_SB(0, 1), cB + hstep, voffB); PG8_STAGE(PG8_SA(0, 0), cA, voffA); PG8_STAGE(PG8_SA(0, 1), cA + hstep, voffA);
        if (wr == 1) PG8_BAR;
        PG8_WAIT_V(2); PG8_BAR;
        PG8_STAGE(PG8_SB(1, 0), cB + kstep, voffB); PG8_STAGE(PG8_SA(1, 0), cA + kstep, voffA); PG8_STAGE(PG8_SB(1, 1), cB + hstep + kstep, voffB);
        PG8_WAIT_V(6); PG8_BAR;
    } else {
        PG8_STAGE(PG8_SB(0, 0), cB, voffB); PG8_STAGE(PG8_SA(0, 0), cA, voffA); PG8_STAGE(PG8_SB(0, 1), cB + hstep, voffB); PG8_STAGE(PG8_SA(0, 1), cA + hstep, voffA);
        if (wr == 1) PG8_BAR;
        PG8_WAIT_V(4); PG8_BAR;
        PG8_STAGE(PG8_SB(1, 0), cB + kstep, voffB); PG8_STAGE(PG8_SA(1, 0), cA + kstep, voffA); PG8_STAGE(PG8_SB(1, 1), cB + hstep + kstep, voffB);
        PG8_WAIT_V(6); PG8_BAR;
    }
    for (;;) {
        const bool has_next = S.next(ui + 1, nxt);
        const char* nA = has_next ? (const char*)g.A + (size_t)nxt.pm * tstep : cA; const char* nB = has_next ? (const char*)g.Bt + (size_t)nxt.pn * tstep : cB;
        for (int t = 0; t < nt; t += 2) {
            const bool last = (t == nt - 2);
            const char* a1 = cA + (size_t)(t + 1) * kstep;
            const char* a2 = last ? nA : cA + (size_t)(t + 2) * kstep; const char* b2 = last ? nB : cB + (size_t)(t + 2) * kstep;
            const char* a3 = a2 + kstep; const char* b3 = b2 + kstep;
            if (last && has_next) S.a_ready(nxt);
            if constexpr (SP2) {
            PG8_LDB(B0, 0, 0); PG8_LDB(B1, 0, 1); PG8_SCHED; PG8_LDA(At, 0, 0); PG8_STAGE(PG8_SA(1, 1), a1 + hstep, voffA);
            PG8_WAIT_V(8); PG8_WAIT_L(0); PG8_BAR; PG8_MMA(0, 0, At, B0); PG8_MMA(0, 1, At, B1); PG8_BAR; PG8_SCHED;
            PG8_LDA(At, 0, 1); PG8_STAGE(PG8_SB(0, 0), b2, voffB); PG8_STAGE(PG8_SB(0, 1), b2 + hstep, voffB); PG8_STAGE(PG8_SA(0, 0), a2, voffA);
            PG8_WAIT_V(8); PG8_WAIT_L(0); PG8_BAR; PG8_MMA(1, 0, At, B0); PG8_MMA(1, 1, At, B1); PG8_BAR; PG8_SCHED;
            PG8_LDB(B0, 1, 0); PG8_LDB(B1, 1, 1); PG8_SCHED; PG8_LDA(At, 1, 0); PG8_STAGE(PG8_SA(0, 1), a2 + hstep, voffA);
            PG8_WAIT_V(8); PG8_WAIT_L(0); PG8_BAR; PG8_MMA(0, 0, At, B0); PG8_MMA(0, 1, At, B1); PG8_BAR; PG8_SCHED;
            PG8_LDA(At, 1, 1); PG8_STAGE(PG8_SB(1, 0), b3, voffB); PG8_STAGE(PG8_SB(1, 1), b3 + hstep, voffB); PG8_STAGE(PG8_SA(1, 0), a3, voffA);
            PG8_WAIT_V(8); PG8_WAIT_L(0); PG8_BAR; PG8_MMA(1, 0, At, B0); PG8_MMA(1, 1, At, B1); PG8_BAR; PG8_SCHED;
            } else {
            PG8_LDB(B0, 0, 0); PG8_SCHED; PG8_LDA(At, 0, 0); PG8_STAGE(PG8_SA(1, 1), a1 + hstep, voffA);
            PG8_WAIT_L(8); PG8_BAR; PG8_WAIT_L(0); PG8_MMA(0, 0, At, B0); PG8_BAR; PG8_SCHED;
            PG8_LDB(B1, 0, 1); PG8_STAGE(PG8_SB(0, 0), b2, voffB);
            PG8_BAR; PG8_WAIT_L(0); PG8_MMA(0, 1, At, B1); PG8_BAR;
            PG8_LDA(At, 0, 1); PG8_STAGE(PG8_SA(0, 0), a2, voffA);
            PG8_BAR; PG8_WAIT_L(0); PG8_MMA(1, 0, At, B0); PG8_BAR; PG8_SCHED;
            PG8_STAGE(PG8_SB(0, 1), b2 + hstep, voffB);
            PG8_WAIT_V(6); PG8_BAR; PG8_MMA(1, 1, At, B1); PG8_BAR;
            PG8_LDB(B0, 1, 0); PG8_SCHED; PG8_LDA(At, 1, 0); PG8_STAGE(PG8_SA(0, 1), a2 + hstep, voffA);
            PG8_WAIT_L(8); PG8_BAR; PG8_WAIT_L(0); PG8_MMA(0, 0, At, B0); PG8_BAR; PG8_SCHED;
            PG8_LDB(B1, 1, 1); PG8_STAGE(PG8_SB(1, 0), b3, voffB);
            PG8_BAR; PG8_WAIT_L(0); PG8_MMA(0, 1, At, B1); PG8_BAR;
            PG8_LDA(At, 1, 1); PG8_STAGE(PG8_SA(1, 0), a3, voffA);
            PG8_BAR; PG8_WAIT_L(0); PG8_MMA(1, 0, At, B0); PG8_BAR; PG8_SCHED;
            PG8_STAGE(PG8_SB(1, 1), b3 + hstep, voffB);
            PG8_WAIT_V(6); PG8_BAR; PG8_MMA(1, 1, At, B1); PG8_BAR;
            }
        }
        if constexpr (ALIGN_EPI) { if (wr == 0) PG8_BAR; }
        if constexpr (!Epi::AFTER_DRAIN) { E(acc, cur, wr, wc, fr, fq); S.done(cur); }
        if (!has_next) break;
#pragma unroll
        for (int a = 0; a < 2; ++a)
#pragma unroll
            for (int b = 0; b < 2; ++b)
#pragma unroll
                for (int m = 0; m < 4; ++m)
#pragma unroll
                    for (int n = 0; n < 2; ++n) acc[a][b][m][n] = (f32x4){0.f, 0.f, 0.f, 0.f};
        cur = nxt; cA = nA; cB = nB; ++ui;
        if constexpr (ALIGN_EPI) { if (wr == 1) PG8_BAR; }
    }
    PG8_WAIT_V(0);
    if constexpr (!ALIGN_EPI) { if (wr == 0) PG8_BAR; }
    PG8_BAR;
    if constexpr (Epi::AFTER_DRAIN) { E.fused(acc, cur, wr, wc, fr, fq, lds, wid, lane); S.done(cur); }
#undef PG8_SA
#undef PG8_SB
#undef PG8_STAGE
#undef PG8_LDA
#undef PG8_LDB
#undef PG8_MMA
#undef PG8_WAIT_V
#undef PG8_WAIT_L
#undef PG8_BAR
#undef PG8_SCHED
}
}

constexpr int NWAVES = 8, NTHR = NWAVES * 64;
constexpr int BATCH = 2, SEQ = 8192, M = BATCH * SEQ, DM = 4096, DEPTH = 2;
constexpr int SSD_W = 2048, SSD_H = 32, SSD_CD = 4096;
constexpr int SWA_W = 1024, SWA_H = 16;
constexpr int GLA_W = 1024, GLA_KT = 512;
constexpr int DFF = 11008, DIN = 10800, DINP = 11008, DGU = 2 * DFF;
constexpr float EPS = 1e-6f;
constexpr int C_Z = 0, C_XBC = 2048, C_DT = 6144, C_SQ = 6176, C_SK = 7200, C_SV = 7456, C_GQ = 7712, C_GK = 8224, C_GV = 8736, C_GG = 9760, C_GLR = 10784;
enum { I_X = 0, I_ATTN_NORM, I_W_IN, I_SSD_CONV_W, I_SSD_CONV_B, I_SSD_DT_BIAS, I_SSD_A_LOG, I_SSD_D, I_SSD_NORM, I_SWA_SINKS, I_SWA_NORM, I_GLA_W_GATE, I_GLA_B_GATE, I_GLA_NORM,
       I_W_OUT, I_FFN_NORM, I_W_GATE, I_W_UP, I_FFN_CONV_W, I_FFN_CONV_B, I_W_DOWN, I_REL_BIAS, I_FINAL_NORM, N_IN };

constexpr size_t MiB = 1u << 20;
constexpr size_t WS_CTL = 0, CTL_BYTES = 1 * MiB;
constexpr size_t WS_WIN = 1 * MiB;
constexpr size_t WS_WOUT = 87 * MiB;
constexpr size_t WS_WGU = 119 * MiB;
constexpr size_t WS_WDN = 291 * MiB;
constexpr size_t WS_H = 377 * MiB;
constexpr size_t WS_R = 505 * MiB;
constexpr size_t WS_PROJ = WS_R;
constexpr size_t WS_XBC = WS_R + 344 * MiB;
constexpr size_t WS_QD = WS_R + 472 * MiB;
constexpr size_t WS_KI = WS_R + 488 * MiB;
constexpr size_t WS_DT = WS_R + 520 * MiB;
constexpr size_t WS_ACS = WS_R + 522 * MiB;
constexpr size_t WS_DEC = WS_R + 524 * MiB;
constexpr size_t WS_GDEC = WS_R + 525 * MiB;
constexpr size_t WS_ST = WS_R + 528 * MiB;
constexpr size_t WS_PV = WS_R + 592 * MiB;
constexpr size_t WS_GST = WS_R + 656 * MiB;
constexpr size_t WS_GPV = WS_R + 720 * MiB;
constexpr size_t WS_OSWA = WS_R + 784 * MiB;
constexpr size_t WS_Y = WS_R + 816 * MiB;
constexpr size_t WS_XHT = WS_R + 504 * MiB, WS_XHB = WS_R + 944 * MiB;
constexpr size_t WS_XB = WS_R + 956 * MiB;
constexpr size_t WS_ACT = WS_R;
constexpr size_t WS_HTG = WS_R + 344 * MiB, WS_HTU = WS_R + 366 * MiB, WS_HBG = WS_R + 388 * MiB;
constexpr size_t WS_END = WS_R + 1084 * MiB;
static_assert(DEPTH == 2 && (size_t)DINP * DM * 2 == 86 * MiB && (size_t)DGU * DM * 2 == 172 * MiB && (size_t)M * DINP * 2 == 344 * MiB , "ws map");
constexpr int CW_BAR = 4096;

constexpr int RING_BYTES = 131072;
constexpr int MISC_OFF = 147456 - 256;
constexpr int LDS_BYTES = 147456;

#define GAS __attribute__((address_space(1)))
#define LAS __attribute__((address_space(3)))
typedef unsigned short bf16;
typedef unsigned v4u __attribute__((ext_vector_type(4)));
typedef unsigned v2u __attribute__((ext_vector_type(2)));
typedef float f32x4 __attribute__((ext_vector_type(4)));
typedef GAS unsigned gu32;
typedef float f32x2c __attribute__((ext_vector_type(2)));
#define RLX_AGENT __ATOMIC_RELAXED, __HIP_MEMORY_SCOPE_AGENT
#define LDS_WAIT() asm volatile("s_waitcnt lgkmcnt(0)" ::: "memory")
__device__ __forceinline__ unsigned f2bf(float f) { unsigned u = __builtin_bit_cast(unsigned, f); return (u + 0x7fffu + ((u >> 16) & 1u)) >> 16; }
__device__ __forceinline__ unsigned pk2(float lo, float hi) { return pg8::cvt_pk_bf16(lo, hi); }
__device__ __forceinline__ float bflo(unsigned w) { return __uint_as_float(w << 16); }
__device__ __forceinline__ float bfhi(unsigned w) { return __uint_as_float(w & 0xffff0000u); }
__device__ __forceinline__ float bf1(bf16 h) { return __uint_as_float((unsigned)h << 16); }
__device__ __forceinline__ float silu_f(float x) { return x * __builtin_amdgcn_rcpf(1.f + __expf(-x)); }
__device__ __forceinline__ float wave_sum(float v) {
#pragma unroll
    for (int o = 1; o < 64; o <<= 1) v += __shfl_xor(v, o);
    return v;
}
template <int CTRL> __device__ __forceinline__ float dpp_f(float v) { return __int_as_float(__builtin_amdgcn_update_dpp(0, __float_as_int(v), CTRL, 0xf, 0xf, false)); }
__device__ __forceinline__ float row16_sum(float v) { v += dpp_f<0xB1>(v); v += dpp_f<0x4E>(v); v += dpp_f<0x124>(v); v += dpp_f<0x128>(v); return v; }
__device__ __forceinline__ float pair_sum(float v) { return v + dpp_f<0xB1>(v); }
#define XB_TMO      128
#define XB_XCNT(j)  (256  + 64 * (j))
#define XB_XSUB(j)  (1280 + 64 * (j))
#define XB_XGEN(j)  (2304 + 64 * (j))
#define XB_TOP      3328
#define XB_TOPGEN   3392
#define XCD_BAR_WORDS 3456
#define XB_SPIN_CAP (1u << 18)

__device__ __forceinline__ unsigned xb_ld(unsigned* p)              { return __hip_atomic_load(p, __ATOMIC_RELAXED, __HIP_MEMORY_SCOPE_AGENT); }
__device__ __forceinline__ unsigned xb_add(unsigned* p, unsigned v) { return __hip_atomic_fetch_add(p, v, __ATOMIC_RELAXED, __HIP_MEMORY_SCOPE_AGENT); }
__device__ __forceinline__ unsigned xb_xcc_id() { return (unsigned)__builtin_amdgcn_s_getreg((3 << 11) | 20) & 0xFu; }
#define XB_SPIN(cond, bar) do { unsigned _sp = 0; while (cond) { __builtin_amdgcn_s_sleep(1); \
    if ((++_sp & 255u) == 0u) { if (xb_ld(&(bar)[XB_TMO])) break; if (_sp > XB_SPIN_CAP) { atomicAdd(&(bar)[XB_TMO], 1u); break; } } } } while (0)

struct XcdBarrier {
    unsigned* bar; unsigned x;
    volatile LAS unsigned* st;
};

__device__ __forceinline__ XcdBarrier xcd_barrier_post(unsigned* bar, volatile LAS unsigned* st) {
    XcdBarrier b; b.bar = bar; b.x = xb_xcc_id(); b.st = st;
    if (threadIdx.x == 0) (void)xb_add(&bar[XB_XCNT(b.x)], 1u);
    return b;
}
__device__ __forceinline__ void xcd_barrier_complete(unsigned* bar, unsigned x, unsigned& nloc, unsigned& nx) {
    const unsigned G = gridDim.x * gridDim.y * gridDim.z;
    unsigned sum, cnt, mine, sp = 0u;
    for (;;) {
        sum = 0u; cnt = 0u; mine = 0u;
#pragma unroll
        for (unsigned j = 0; j < 16; ++j) { const unsigned c = xb_ld(&bar[XB_XCNT(j)]); sum += c; cnt += (c > 0u) ? 1u : 0u; mine = (j == x) ? c : mine; }
        if (sum == G) break;
        __builtin_amdgcn_s_sleep(1);
        if ((++sp & 255u) == 0u) { if (xb_ld(&bar[XB_TMO])) break; if (sp > XB_SPIN_CAP) { atomicAdd(&bar[XB_TMO], 1u); break; } }
    }
    nloc = mine > 0u ? mine : 1u; nx = cnt > 0u ? cnt : 1u;
}

__device__ __forceinline__ void xcd_barrier(const XcdBarrier& b) {
    asm volatile("s_waitcnt vmcnt(0)" ::: "memory");
    __syncthreads();
    if (threadIdx.x == 0) {
        unsigned* bar = b.bar;
        __builtin_amdgcn_s_waitcnt(0);
        unsigned nloc = b.st[0], nx = b.st[1];
        if (nloc == 0u) { xcd_barrier_complete(bar, b.x, nloc, nx); b.st[0] = nloc; b.st[1] = nx; }
        const unsigned old = xb_add(&bar[XB_XSUB(b.x)], 1u);
        const unsigned gen = old / nloc;
        if (old + 1u == (gen + 1u) * nloc) {
            __builtin_amdgcn_fence(__ATOMIC_RELEASE, "agent");
            asm volatile("s_waitcnt vmcnt(0)" ::: "memory");
            const unsigned og = xb_add(&bar[XB_TOP], 1u);
            const unsigned tg = og / nx;
            if (og + 1u == (tg + 1u) * nx) xb_add(&bar[XB_TOPGEN], 1u);
            else XB_SPIN(xb_ld(&bar[XB_TOPGEN]) == tg, bar);
            __builtin_amdgcn_fence(__ATOMIC_ACQUIRE, "agent");
            xb_add(&bar[XB_XGEN(b.x)], 1u);
            asm volatile("s_waitcnt vmcnt(0)" ::: "memory");
        } else {
            XB_SPIN(xb_ld(&bar[XB_XGEN(b.x)]) == gen, bar);
            __builtin_amdgcn_fence(__ATOMIC_ACQUIRE, "agent");
            asm volatile("s_waitcnt vmcnt(0)" ::: "memory");
        }
    }
    __syncthreads();
}

__device__ __forceinline__ void xcd_barrier_arrive(const XcdBarrier& b) {
    asm volatile("s_waitcnt vmcnt(0)" ::: "memory");
    __syncthreads();
    if (threadIdx.x == 0) {
        unsigned* bar = b.bar;
        __builtin_amdgcn_s_waitcnt(0);
        unsigned nloc = b.st[0], nx = b.st[1];
        if (nloc == 0u) { xcd_barrier_complete(bar, b.x, nloc, nx); b.st[0] = nloc; b.st[1] = nx; }
        const unsigned old = xb_add(&bar[XB_XSUB(b.x)], 1u);
        const unsigned gen = old / nloc;
        unsigned role = 0u, tg = 0u;
        if (old + 1u == (gen + 1u) * nloc) {
            __builtin_amdgcn_fence(__ATOMIC_RELEASE, "agent");
            asm volatile("s_waitcnt vmcnt(0)" ::: "memory");
            const unsigned og = xb_add(&bar[XB_TOP], 1u);
            tg = og / nx;
            if (og + 1u == (tg + 1u) * nx) { xb_add(&bar[XB_TOPGEN], 1u); role = 2u; } else role = 1u;
        }
        b.st[2] = gen; b.st[3] = role; b.st[4] = tg;
    }
}
__device__ __forceinline__ void xcd_barrier_wait(const XcdBarrier& b) {
    if (threadIdx.x == 0) {
        unsigned* bar = b.bar;
        const unsigned gen = b.st[2], role = b.st[3], tg = b.st[4];
        if (role != 0u) {
            if (role == 1u) XB_SPIN(xb_ld(&bar[XB_TOPGEN]) == tg, bar);
            __builtin_amdgcn_fence(__ATOMIC_ACQUIRE, "agent");
            xb_add(&bar[XB_XGEN(b.x)], 1u);
            asm volatile("s_waitcnt vmcnt(0)" ::: "memory");
        } else {
            XB_SPIN(xb_ld(&bar[XB_XGEN(b.x)]) == gen, bar);
            __builtin_amdgcn_fence(__ATOMIC_ACQUIRE, "agent");
            asm volatile("s_waitcnt vmcnt(0)" ::: "memory");
        }
    }
    __syncthreads();
}

struct Args { const float* in[N_IN]; float* out; unsigned char* ws; int ph_lo, ph_hi, li, pad; };
struct Ctx {
    LAS unsigned char* lds;
    int tid, lane, wave, G, bid;
    const float* const* in; float* out; unsigned char* ws;
};
__device__ const unsigned char T5_BUCKET[128] = {0, 1, 2, 3, 4, 5, 6, 7, 8, 9, 10, 11, 12, 13, 14, 15, 16, 16, 16, 17, 17, 18, 18, 18, 19, 19, 19, 20, 20, 20, 20, 21, 21, 21, 21, 22, 22, 22, 22, 22, 23, 23, 23, 23, 23, 23, 24, 24, 24, 24, 24, 24, 25, 25, 25, 25, 25, 25, 25, 26, 26, 26, 26, 26, 26, 26, 26, 27, 27, 27, 27, 27, 27, 27, 27, 27, 27, 28, 28, 28, 28, 28, 28, 28, 28, 28, 28, 29, 29, 29, 29, 29, 29, 29, 29, 29, 29, 29, 29, 30, 30, 30, 30, 30, 30, 30, 30, 30, 30, 30, 30, 30, 30, 31, 31, 31, 31, 31, 31, 31, 31, 31, 31, 31, 31, 31, 31, 31};

struct TItem { const float* src; bf16* dst; int N, K, nvalid; };
constexpr int CV_NITEMS = 32 * 86 * 3 + 32 * 32 + 86 * 32;
__device__ __forceinline__ TItem titem_decode(Ctx& C, int l, int it) {
    constexpr int I_IN = 32 * 86, I_OUT = 32 * 32, I_G = 32 * 86;
    TItem t; int r = it, kb, nb;
    if (r < I_IN) { kb = r / 86; nb = r % 86; t.N = DIN; t.K = DM; t.src = C.in[I_W_IN] + (size_t)l * DM * DIN; t.dst = (bf16*)(C.ws + WS_WIN) + (size_t)(128 * nb) * DM; }
    else if ((r -= I_IN) < I_OUT) { kb = r / 32; nb = r % 32; t.N = DM; t.K = DM; t.src = C.in[I_W_OUT] + (size_t)l * DM * DM; t.dst = (bf16*)(C.ws + WS_WOUT) + (size_t)(128 * nb) * DM; }
    else if ((r -= I_OUT) < I_G) { kb = r / 86; nb = r % 86; t.N = DFF; t.K = DM; t.src = C.in[I_W_GATE] + (size_t)l * DM * DFF; t.dst = (bf16*)(C.ws + WS_WGU) + (size_t)(256 * nb) * DM; }
    else if ((r -= I_G) < I_G) { kb = r / 86; nb = r % 86; t.N = DFF; t.K = DM; t.src = C.in[I_W_UP] + (size_t)l * DM * DFF; t.dst = (bf16*)(C.ws + WS_WGU) + (size_t)(256 * nb + 128) * DM; }
    else { r -= I_G; kb = r / 32; nb = r % 32; t.N = DM; t.K = DFF; t.src = C.in[I_W_DOWN] + (size_t)l * DFF * DM; t.dst = (bf16*)(C.ws + WS_WDN) + (size_t)(128 * nb) * DFF; }
    t.src += (size_t)(128 * kb) * t.N + 128 * nb; t.dst += 128 * kb;
    const int rem = t.N - 128 * nb; t.nvalid = rem >= 128 ? 128 : (rem > 0 ? rem : 0);
    return t;
}
__device__ __forceinline__ void titem_load(const TItem& t, f32x4 (&v)[8], int wave, int lane) {
    const bool nv = 4 * (lane & 31) < t.nvalid; const float* p = t.src + (size_t)(16 * wave + 2 * (lane >> 5)) * t.N + 4 * (lane & 31);
#pragma unroll
    for (int i = 0; i < 4; ++i) { v[2 * i] = nv ? *(const GAS f32x4*)(p + (size_t)(4 * i) * t.N) : (f32x4){0.f, 0.f, 0.f, 0.f}; v[2 * i + 1] = nv ? *(const GAS f32x4*)(p + (size_t)(4 * i + 1) * t.N) : (f32x4){0.f, 0.f, 0.f, 0.f}; }
}
__device__ __forceinline__ void titem_store(const TItem& t, const f32x4 (&v)[8], LAS unsigned* T, int tid, int wave, int lane) {
    __syncthreads();
    { const int kd = 8 * wave + (lane >> 5);
#pragma unroll
      for (int i = 0; i < 4; ++i)
#pragma unroll
          for (int e = 0; e < 4; ++e) T[(4 * (lane & 31) + e) * 65 + ((kd + 2 * i) ^ ((lane & 31) >> 3))] = pg8::cvt_pk_bf16(v[2 * i][e], v[2 * i + 1][e]); }
    __syncthreads();
    const int ch = tid & 15;
#pragma unroll
    for (int ps = 0; ps < 4; ++ps) { const int n = 32 * ps + (tid >> 4); const LAS unsigned* s = T + n * 65 + 4 * ch;
        v4u o; o.x = s[0 ^ ps]; o.y = s[1 ^ ps]; o.z = s[2 ^ ps]; o.w = s[3 ^ ps];
        *(GAS v4u*)(t.dst + (size_t)n * t.K + 8 * ch) = o; }
}
__device__ __forceinline__ void convert_weights(Ctx& C, int l, int lo, int hi) {
    LAS unsigned* T = (LAS unsigned*)C.lds;
    int it = lo + C.bid;
    if (it < hi) {
        TItem cur = titem_decode(C, l, it); f32x4 va[8], vb[8];
        titem_load(cur, va, C.wave, C.lane);
        for (;;) {
            int nx = it + C.G; TItem tn = cur; const bool hn = nx < hi;
            if (hn) { tn = titem_decode(C, l, nx); titem_load(tn, vb, C.wave, C.lane); }
            titem_store(cur, va, T, C.tid, C.wave, C.lane);
            if (!hn) break;
            nx += C.G; const bool hn2 = nx < hi; TItem t2 = tn;
            if (hn2) { t2 = titem_decode(C, l, nx); titem_load(t2, va, C.wave, C.lane); }
            titem_store(tn, vb, T, C.tid, C.wave, C.lane);
            if (!hn2) break;
            cur = t2; it = nx;
        }
    }
    __syncthreads();
}
constexpr int CV_DN_LO = CV_NITEMS - 86 * 32, CV_UP_LO = CV_DN_LO - 32 * 86, CV_A_ITEMS = CV_UP_LO;
constexpr int SEAM_A1 = 9 * 256  , SEAM_B0 = 32 * 86  , SEAM_B1 = SEAM_B0 + 7 * 256  ;
__device__ __forceinline__ float row_ssq(const f32x4 (&v)[16]) { float ss = 0.f;
#pragma unroll
    for (int j = 0; j < 16; ++j) ss += (v[j].x * v[j].x + v[j].y * v[j].y) + (v[j].z * v[j].z + v[j].w * v[j].w);
    return ss; }
__device__ __forceinline__ void rmsnorm_phase(Ctx& C, const float* X, const float* w, bf16* H, bf16* XB) {
    const int gw = C.bid * NWAVES + C.wave, NGW = C.G * NWAVES, lane = C.lane;
    const GAS f32x4* wr = (const GAS f32x4*)w + lane;
    for (int m = gw; m < M; m += 2 * NGW) {
        const int m2 = m + NGW; const bool h2 = m2 < M;
        const GAS f32x4* x0 = (const GAS f32x4*)(X + (size_t)m * DM) + lane; const GAS f32x4* x1 = (const GAS f32x4*)(X + (size_t)(h2 ? m2 : m) * DM) + lane;
        f32x4 v0[16], v1[16];
#pragma unroll
        for (int j = 0; j < 16; ++j) v0[j] = x0[64 * j];
#pragma unroll
        for (int j = 0; j < 16; ++j) v1[j] = x1[64 * j];
        const float r0 = 1.f / sqrtf(wave_sum(row_ssq(v0)) * (1.f / DM) + EPS), r1 = 1.f / sqrtf(wave_sum(row_ssq(v1)) * (1.f / DM) + EPS);
        GAS v2u* o0 = (GAS v2u*)(H + (size_t)m * DM) + lane; GAS v2u* o1 = (GAS v2u*)(H + (size_t)m2 * DM) + lane;
#pragma unroll
        for (int j = 0; j < 16; ++j) { const f32x4 g = wr[64 * j]; v2u o; o.x = pk2(v0[j].x * r0 * g.x, v0[j].y * r0 * g.y); o.y = pk2(v0[j].z * r0 * g.z, v0[j].w * r0 * g.w); o0[64 * j] = o;
            if (h2) { v2u p; p.x = pk2(v1[j].x * r1 * g.x, v1[j].y * r1 * g.y); p.y = pk2(v1[j].z * r1 * g.z, v1[j].w * r1 * g.w); o1[64 * j] = p; } }
        GAS v2u* b0 = (GAS v2u*)(XB + (size_t)m * DM) + lane; GAS v2u* b1 = (GAS v2u*)(XB + (size_t)m2 * DM) + lane;
#pragma unroll
        for (int j = 0; j < 16; ++j) { v2u o; o.x = pk2(v0[j].x, v0[j].y); o.y = pk2(v0[j].z, v0[j].w); b0[64 * j] = o; if (h2) { v2u p; p.x = pk2(v1[j].x, v1[j].y); p.y = pk2(v1[j].z, v1[j].w); b1[64 * j] = p; } }
    }
}
__device__ __forceinline__ float row_ssq8(const v4u (&v)[8]) { float ss = 0.f;
#pragma unroll
    for (int j = 0; j < 8; ++j) { const float a0 = bflo(v[j].x), a1 = bfhi(v[j].x), a2 = bflo(v[j].y), a3 = bfhi(v[j].y), a4 = bflo(v[j].z), a5 = bfhi(v[j].z), a6 = bflo(v[j].w), a7 = bfhi(v[j].w);
        ss += ((a0 * a0 + a1 * a1) + (a2 * a2 + a3 * a3)) + ((a4 * a4 + a5 * a5) + (a6 * a6 + a7 * a7)); }
    return ss; }
__device__ __forceinline__ void rmsnorm_phase_b(Ctx& C, const bf16* X, const float* w, bf16* H) {
    const int gw = C.bid * NWAVES + C.wave, NGW = C.G * NWAVES, lane = C.lane;
    for (int m = gw; m < M; m += 2 * NGW) {
        const int m2 = m + NGW; const bool h2 = m2 < M;
        const GAS v4u* x0 = (const GAS v4u*)(X + (size_t)m * DM) + lane; const GAS v4u* x1 = (const GAS v4u*)(X + (size_t)(h2 ? m2 : m) * DM) + lane;
        v4u v0[8], v1[8];
#pragma unroll
        for (int j = 0; j < 8; ++j) v0[j] = x0[64 * j];
#pragma unroll
        for (int j = 0; j < 8; ++j) v1[j] = x1[64 * j];
        const float r0 = 1.f / sqrtf(wave_sum(row_ssq8(v0)) * (1.f / DM) + EPS), r1 = 1.f / sqrtf(wave_sum(row_ssq8(v1)) * (1.f / DM) + EPS);
        GAS v4u* o0 = (GAS v4u*)(H + (size_t)m * DM) + lane; GAS v4u* o1 = (GAS v4u*)(H + (size_t)m2 * DM) + lane;
#pragma unroll
        for (int j = 0; j < 8; ++j) { const f32x4 g0 = *(const GAS f32x4*)(w + 512 * j + 8 * lane), g1 = *(const GAS f32x4*)(w + 512 * j + 8 * lane + 4);
            { const v4u x = v0[j]; v4u o; o.x = pk2(bflo(x.x) * r0 * g0.x, bfhi(x.x) * r0 * g0.y); o.y = pk2(bflo(x.y) * r0 * g0.z, bfhi(x.y) * r0 * g0.w); o.z = pk2(bflo(x.z) * r0 * g1.x, bfhi(x.z) * r0 * g1.y); o.w = pk2(bflo(x.w) * r0 * g1.z, bfhi(x.w) * r0 * g1.w); o0[64 * j] = o; }
            if (h2) { const v4u x = v1[j]; v4u o; o.x = pk2(bflo(x.x) * r1 * g0.x, bfhi(x.x) * r1 * g0.y); o.y = pk2(bflo(x.y) * r1 * g0.z, bfhi(x.y) * r1 * g0.w); o.z = pk2(bflo(x.z) * r1 * g1.x, bfhi(x.z) * r1 * g1.y); o.w = pk2(bflo(x.w) * r1 * g1.z, bfhi(x.w) * r1 * g1.w); o1[64 * j] = o; } }
    }
}
__device__ __forceinline__ void final_norm_phase(Ctx& C, const bf16* X, const float* w, float* OUT) {
    const int gw = C.bid * NWAVES + C.wave, NGW = C.G * NWAVES, lane = C.lane;
    for (int m = gw; m < M; m += 2 * NGW) {
        const int m2 = m + NGW; const bool h2 = m2 < M;
        const GAS v4u* x0 = (const GAS v4u*)(X + (size_t)m * DM) + lane; const GAS v4u* x1 = (const GAS v4u*)(X + (size_t)(h2 ? m2 : m) * DM) + lane;
        v4u v0[8], v1[8];
#pragma unroll
        for (int j = 0; j < 8; ++j) v0[j] = x0[64 * j];
#pragma unroll
        for (int j = 0; j < 8; ++j) v1[j] = x1[64 * j];
        const float r0 = 1.f / sqrtf(wave_sum(row_ssq8(v0)) * (1.f / DM) + EPS), r1 = 1.f / sqrtf(wave_sum(row_ssq8(v1)) * (1.f / DM) + EPS);
        float* o0 = OUT + (size_t)m * DM + 8 * lane; float* o1 = OUT + (size_t)m2 * DM + 8 * lane;
#pragma unroll
        for (int j = 0; j < 8; ++j) { const f32x4 g0 = *(const GAS f32x4*)(w + 512 * j + 8 * lane), g1 = *(const GAS f32x4*)(w + 512 * j + 8 * lane + 4);
            { const v4u x = v0[j]; *(GAS f32x4*)(o0 + 512 * j) = (f32x4){bflo(x.x) * r0 * g0.x, bfhi(x.x) * r0 * g0.y, bflo(x.y) * r0 * g0.z, bfhi(x.y) * r0 * g0.w}; *(GAS f32x4*)(o0 + 512 * j + 4) = (f32x4){bflo(x.z) * r0 * g1.x, bfhi(x.z) * r0 * g1.y, bflo(x.w) * r0 * g1.z, bfhi(x.w) * r0 * g1.w}; }
            if (h2) { const v4u x = v1[j]; *(GAS f32x4*)(o1 + 512 * j) = (f32x4){bflo(x.x) * r1 * g0.x, bfhi(x.x) * r1 * g0.y, bflo(x.y) * r1 * g0.z, bfhi(x.y) * r1 * g0.w}; *(GAS f32x4*)(o1 + 512 * j + 4) = (f32x4){bflo(x.z) * r1 * g1.x, bfhi(x.z) * r1 * g1.y, bflo(x.w) * r1 * g1.z, bfhi(x.w) * r1 * g1.w}; } }
    }
}

typedef short bf16x8 __attribute__((ext_vector_type(8)));
typedef short s16x4 __attribute__((ext_vector_type(4)));
__device__ __forceinline__ f32x4 mfma16(bf16x8 a, bf16x8 b, f32x4 c) { return __builtin_amdgcn_mfma_f32_16x16x32_bf16(a, b, c, 0, 0, 0); }
__device__ __forceinline__ bf16x8 pack8(f32x4 lo, f32x4 hi) { v4u w; w.x = pg8::cvt_pk_bf16(lo.x, lo.y); w.y = pg8::cvt_pk_bf16(lo.z, lo.w); w.z = pg8::cvt_pk_bf16(hi.x, hi.y); w.w = pg8::cvt_pk_bf16(hi.z, hi.w); return __builtin_bit_cast(bf16x8, w); }
__device__ __forceinline__ bf16x8 gfrag(const bf16* Mx, size_t ld, int row0, int k0, int lane) { return *(const GAS bf16x8*)(Mx + (size_t)(row0 + (lane & 15)) * ld + k0 + 8 * (lane >> 4)); }
__device__ __forceinline__ bf16x8 trfrag(const LAS unsigned char* img, int stride, int r0, int r1, int col0, int lane) {
    const int q = (lane & 15) >> 2, p = lane & 3;
    const s16x4 a = __builtin_amdgcn_ds_read_tr16_b64_v4i16((LAS s16x4*)(img + (r0 + q) * stride + (col0 + 4 * p) * 2));
    const s16x4 b = __builtin_amdgcn_ds_read_tr16_b64_v4i16((LAS s16x4*)(img + (r1 + q) * stride + (col0 + 4 * p) * 2));
    return __builtin_shufflevector(a, b, 0, 1, 2, 3, 4, 5, 6, 7);
}
__device__ __forceinline__ float xsum4(float v) { v += __shfl_xor(v, 16); v += __shfl_xor(v, 32); return v; }
__device__ __forceinline__ float xmax4(float v) { v = fmaxf(v, __shfl_xor(v, 16)); v = fmaxf(v, __shfl_xor(v, 32)); return v; }

constexpr int SWA_QSTRIDE = 528;
constexpr int SWA_VSTRIDE = 144;
constexpr int SWA_V_BYTES = 192 * SWA_VSTRIDE;
__device__ __forceinline__ void swa_unit_mfma(Ctx& C, int l, int unit) {
    const int b = unit >> 7, qb = unit & 127, q0 = qb * 64;
    const int tid = C.tid, lane = C.lane, w = C.wave, c = lane & 15, hq = lane >> 4;
    LAS unsigned char* Vimg = C.lds;
    LAS unsigned char* Kimg = C.lds + 30720;
    LAS float* tb = (LAS float*)(C.lds + 61440);
    LAS float* ssqx = (LAS float*)(C.lds + 61440 + 12288);
    LAS unsigned char* Qimg = C.lds + 75776;
    const bf16* PROJ = (const bf16*)(C.ws + WS_PROJ); bf16* OSWA = (bf16*)(C.ws + WS_OSWA); bf16* Y = (bf16*)(C.ws + WS_Y);
    const bf16* Pb = PROJ + (size_t)b * SEQ * DINP;
    __syncthreads();
    for (int i = tid; i < 16 * 192; i += NTHR) { const int hd = i / 192, x = i % 192, dist = x - 32; tb[i] = (dist >= 0 && dist < 128) ? C.in[I_REL_BIAS][T5_BUCKET[dist] * SWA_H + hd] : 0.f; }
    if (tid < 16 * 9) { *(LAS v4u*)(Vimg + (192 + tid / 9) * SWA_VSTRIDE + 16 * (tid % 9)) = (v4u){0u, 0u, 0u, 0u}; *(LAS v4u*)(Kimg + (192 + tid / 9) * SWA_VSTRIDE + 16 * (tid % 9)) = (v4u){0u, 0u, 0u, 0u}; }
    const int g = w >> 1, qhalf = w & 1;
    float ssq0 = 0.f, ssq1 = 0.f;
    for (int kvh = 0; kvh < 4; ++kvh) {
        const int head = kvh * 4 + g;
        __syncthreads();
        { v4u tv[3], tk[3], tq[4];
#pragma unroll
          for (int it = 0; it < 4; ++it) { const int idx = tid + NTHR * it, t = idx >> 5, cg = idx & 31; tq[it] = __builtin_nontemporal_load((const GAS v4u*)(Pb + (size_t)(q0 + t) * DINP + C_SQ + kvh * 256 + 8 * cg)); }
#pragma unroll
          for (int it = 0; it < 3; ++it) { const int idx = tid + NTHR * it, j = idx >> 3, cg = idx & 7; int s = q0 - 128 + j; s = s < 0 ? 0 : s;
              tv[it] = __builtin_nontemporal_load((const GAS v4u*)(Pb + (size_t)s * DINP + C_SV + kvh * 64 + 8 * cg)); tk[it] = __builtin_nontemporal_load((const GAS v4u*)(Pb + (size_t)s * DINP + C_SK + kvh * 64 + 8 * cg)); }
#pragma unroll
          for (int it = 0; it < 3; ++it) { const int idx = tid + NTHR * it, j = idx >> 3, cg = idx & 7; *(LAS v4u*)(Vimg + j * SWA_VSTRIDE + 16 * cg) = tv[it]; *(LAS v4u*)(Kimg + j * SWA_VSTRIDE + 16 * cg) = tk[it]; }
#pragma unroll
          for (int it = 0; it < 4; ++it) { const int idx = tid + NTHR * it, t = idx >> 5, cg = idx & 31; *(LAS v4u*)(Qimg + t * SWA_QSTRIDE + 16 * cg) = tq[it]; } }
        __syncthreads();
        const float sink = C.in[I_SWA_SINKS][l * SWA_H + head];
#pragma nounroll
        for (int qt = 0; qt < 2; ++qt) {
            const int j0 = 32 * qhalf + 16 * qt;
            const LAS unsigned char* qp = Qimg + (j0 + c) * SWA_QSTRIDE + (g * 64 + 8 * hq) * 2;
            const bf16x8 qf0 = *(const LAS bf16x8*)qp, qf1 = *(const LAS bf16x8*)(qp + 64);
            f32x4 sacc[10];
#pragma unroll
            for (int kt = 0; kt < 10; ++kt) {
                const LAS unsigned char* kp = Kimg + (j0 + 16 * kt + c) * SWA_VSTRIDE + 16 * hq;
                const bf16x8 k0 = *(const LAS bf16x8*)kp, k1 = *(const LAS bf16x8*)(kp + 64);
                f32x4 a = (f32x4){0.f, 0.f, 0.f, 0.f}; a = mfma16(k0, qf0, a); a = mfma16(k1, qf1, a); sacc[kt] = a;
            }
            float mx = sink;
#pragma unroll
            for (int kt = 0; kt < 10; ++kt)
#pragma unroll
                for (int r = 0; r < 4; ++r) { const int dist = c + 128 - 16 * kt - 4 * hq - r; const int s = q0 - 128 + j0 + 16 * kt + 4 * hq + r;
                    const bool valid = (dist >= 0) && (dist < 128) && (s >= 0);
                    const float sc = valid ? sacc[kt][r] * 0.125f + tb[head * 192 + dist + 32] : -1e30f;
                    sacc[kt][r] = sc; mx = fmaxf(mx, sc); }
            mx = xmax4(mx); float sum = 0.f;
#pragma unroll
            for (int kt = 0; kt < 10; ++kt)
#pragma unroll
                for (int r = 0; r < 4; ++r) { const float p = __expf(sacc[kt][r] - mx); sacc[kt][r] = p; sum += p; }
            sum = xsum4(sum); const float inv = 1.f / (sum + __expf(sink - mx));
            f32x4 oacc[4];
#pragma unroll
            for (int dt = 0; dt < 4; ++dt) oacc[dt] = (f32x4){0.f, 0.f, 0.f, 0.f};
#pragma unroll
            for (int ks = 0; ks < 5; ++ks) { const bf16x8 pf = pack8(sacc[2 * ks], sacc[2 * ks + 1]);
#pragma unroll
                for (int dt = 0; dt < 4; ++dt) oacc[dt] = mfma16(trfrag(Vimg, SWA_VSTRIDE, j0 + 32 * ks + 4 * hq, j0 + 32 * ks + 16 + 4 * hq, 16 * dt, lane), pf, oacc[dt]); }
            float sq = 0.f; bf16* op = OSWA + (size_t)(b * SEQ + q0 + j0 + c) * SWA_W + head * 64 + 4 * hq;
#pragma unroll
            for (int dt = 0; dt < 4; ++dt) { const f32x4 o = oacc[dt] * inv; v2u pk; pk.x = pk2(o.x, o.y); pk.y = pk2(o.z, o.w);
                const float r0 = bflo(pk.x), r1 = bfhi(pk.x), r2 = bflo(pk.y), r3 = bfhi(pk.y); sq += (r0 * r0 + r1 * r1) + (r2 * r2 + r3 * r3); *(GAS v2u*)(op + 16 * dt) = pk; }
            if (qt == 0) ssq0 += sq; else ssq1 += sq;
        }
    }
    ssq0 = xsum4(ssq0); ssq1 = xsum4(ssq1);
    if (hq == 0) { ssqx[w * 32 + c] = ssq0; ssqx[w * 32 + 16 + c] = ssq1; }
    asm volatile("s_waitcnt vmcnt(0)" ::: "memory");
    __syncthreads();
    const float* swa_norm = C.in[I_SWA_NORM] + (size_t)l * SWA_W;
#pragma nounroll
    for (int qt = 0; qt < 2; ++qt) { const int qi = 16 * qt + c;
        const float tot = ssqx[(qhalf + 0) * 32 + qi] + ssqx[(qhalf + 2) * 32 + qi] + ssqx[(qhalf + 4) * 32 + qi] + ssqx[(qhalf + 6) * 32 + qi];
        const float rstd = 1.f / sqrtf(tot * (1.f / 1024.f) + EPS);
        const size_t row = (size_t)(b * SEQ + q0 + 32 * qhalf + qi);
#pragma unroll
        for (int kvh = 0; kvh < 4; ++kvh)
#pragma unroll
            for (int dt = 0; dt < 4; ++dt) { const int col = (kvh * 4 + g) * 64 + 16 * dt + 4 * hq; const v2u pk = *(const GAS v2u*)(OSWA + row * SWA_W + col); const f32x4 o = (f32x4){bflo(pk.x), bfhi(pk.x), bflo(pk.y), bfhi(pk.y)}; const f32x4 gn = *(const GAS f32x4*)(swa_norm + col);
                v2u ow; ow.x = pk2(o.x * rstd * gn.x, o.y * rstd * gn.y); ow.y = pk2(o.z * rstd * gn.z, o.w * rstd * gn.w); *(GAS v2u*)(Y + row * DM + 2048 + col) = ow; } }
}

constexpr int N_SWA_UNITS = BATCH * (SEQ / 64);

constexpr int SSD_L = 128, SSD_NC = SEQ / SSD_L, GLA_L = 64, GLA_NC = SEQ / GLA_L;
constexpr int N_SSD_CU = BATCH * SSD_NC * 8, N_GLA_CU = BATCH * GLA_NC * 4;
constexpr int XI_STRIDE = 528, BI_STRIDE = 272;

__device__ __forceinline__ void prep_phase(Ctx& C, int l) {
    const bf16* PROJ = (const bf16*)(C.ws + WS_PROJ); bf16* XBC = (bf16*)(C.ws + WS_XBC);
    const int tid = C.tid, lane = C.lane;
    { const int gw0 = C.bid * NWAVES + C.wave;
      float* DT = (float*)(C.ws + WS_DT); float* ACS = (float*)(C.ws + WS_ACS); float* DEC = (float*)(C.ws + WS_DEC);
      for (int item = gw0; item < BATCH * SSD_NC * SSD_H; item += C.G * NWAVES) {
          const int h = item & 31, bc = item >> 5; const size_t r0 = (size_t)bc * SSD_L + 2 * lane;
          const float dtb = C.in[I_SSD_DT_BIAS][l * SSD_H + h], Ah = -expf(C.in[I_SSD_A_LOG][l * SSD_H + h]);
          const float x0 = bf1(PROJ[r0 * DINP + C_DT + h]) + dtb, x1 = bf1(PROJ[(r0 + 1) * DINP + C_DT + h]) + dtb;
          const float d0 = x0 > 20.f ? x0 : log1pf(expf(x0)), d1 = x1 > 20.f ? x1 : log1pf(expf(x1));
          const float a0 = d0 * Ah, a1 = d1 * Ah;
          float incl = a0 + a1;
#pragma unroll
          for (int o = 1; o < 64; o <<= 1) { const float t = __shfl_up(incl, o); if (lane >= o) incl += t; }
          const float c1 = incl, c0 = incl - a1;
          DT[r0 * SSD_H + h] = d0; DT[(r0 + 1) * SSD_H + h] = d1; ACS[r0 * SSD_H + h] = c0; ACS[(r0 + 1) * SSD_H + h] = c1;
          if (lane == 63) DEC[bc * SSD_H + h] = expf(c1);
      } }
    { const float* conv_w = C.in[I_SSD_CONV_W] + (size_t)l * 4 * SSD_CD; const float* conv_b = C.in[I_SSD_CONV_B] + (size_t)l * SSD_CD;
      const float* HT = (const float*)(C.ws + WS_XHT); const float* HB = (const float*)(C.ws + WS_XHB);
      constexpr int NIT = (M / 64) * 3 * 1024;
      for (int it = C.bid * NTHR + tid; it < NIT; it += C.G * NTHR) {
          const int c4 = it & 1023, ri = it >> 10, i = ri % 3, blk = ri / 3, c0 = 4 * c4; const bool first = (blk % (SEQ / 64)) == 0;
          f32x4 sq[6]; const f32x4 z4 = (f32x4){0.f, 0.f, 0.f, 0.f};
#pragma unroll
          for (int j = 0; j < 3; ++j) { sq[j] = first ? z4 : *(const GAS f32x4*)(HB + ((size_t)(blk - 1) * 3 + j) * 4096 + c0); sq[3 + j] = *(const GAS f32x4*)(HT + ((size_t)blk * 3 + j) * 4096 + c0); }
          const f32x4 x3 = i == 0 ? sq[0] : (i == 1 ? sq[1] : sq[2]), x2 = i == 0 ? sq[1] : (i == 1 ? sq[2] : sq[3]), x1 = i == 0 ? sq[2] : (i == 1 ? sq[3] : sq[4]), x0 = i == 0 ? sq[3] : (i == 1 ? sq[4] : sq[5]);
          const f32x4 w0 = *(const GAS f32x4*)(conv_w + c0), w1 = *(const GAS f32x4*)(conv_w + 4096 + c0), w2 = *(const GAS f32x4*)(conv_w + 2 * 4096 + c0), w3 = *(const GAS f32x4*)(conv_w + 3 * 4096 + c0), bb = *(const GAS f32x4*)(conv_b + c0);
          f32x4 o;
#pragma unroll
          for (int e = 0; e < 4; ++e) o[e] = silu_f(bb[e] + w0[e] * x3[e] + w1[e] * x2[e] + w2[e] * x1[e] + w3[e] * x0[e]);
          v2u ow; ow.x = pk2(o.x, o.y); ow.y = pk2(o.z, o.w); *(GAS v2u*)(XBC + (size_t)(64 * blk + i) * SSD_CD + c0) = ow;
      } }
    { LAS float* glr = (LAS float*)C.lds;
      LAS float* segtot = glr + 1024;
      bf16* QD = (bf16*)(C.ws + WS_QD); bf16* KI = (bf16*)(C.ws + WS_KI); float* GDEC = (float*)(C.ws + WS_GDEC);
      const float* w_gate = C.in[I_GLA_W_GATE] + (size_t)l * 16 * GLA_KT; const int seg = tid >> 7, c0 = 4 * (tid & 127);
      for (int ck = C.bid; ck < BATCH * GLA_NC; ck += C.G) {
          const size_t row0 = (size_t)ck * GLA_L;
          __syncthreads();
          if (tid < 128) { const int t = tid >> 1, hf = tid & 1; const v4u r = *(const GAS v4u*)(PROJ + (row0 + t) * DINP + C_GLR + 8 * hf);
              *(LAS f32x4*)(glr + t * 16 + 8 * hf) = (f32x4){bflo(r.x), bfhi(r.x), bflo(r.y), bfhi(r.y)}; *(LAS f32x4*)(glr + t * 16 + 8 * hf + 4) = (f32x4){bflo(r.z), bfhi(r.z), bflo(r.w), bfhi(r.w)}; }
          f32x4 cum[16];
          { f32x4 wg[16]; const f32x4 bg4 = *(const GAS f32x4*)(C.in[I_GLA_B_GATE] + l * GLA_KT + c0);
#pragma unroll
            for (int r = 0; r < 16; ++r) wg[r] = *(const GAS f32x4*)(w_gate + r * GLA_KT + c0);
            __syncthreads();
            f32x4 run = (f32x4){0.f, 0.f, 0.f, 0.f};
#pragma unroll
            for (int t = 0; t < 16; ++t) { f32x4 z = bg4;
#pragma unroll
                for (int r4 = 0; r4 < 4; ++r4) { const f32x4 gv = *(const LAS f32x4*)(glr + (16 * seg + t) * 16 + 4 * r4); z += wg[4 * r4] * gv.x + wg[4 * r4 + 1] * gv.y + wg[4 * r4 + 2] * gv.z + wg[4 * r4 + 3] * gv.w; }
#pragma unroll
                for (int e = 0; e < 4; ++e) { const float ls = fminf(z[e], 0.f) - __logf(1.f + __expf(-fabsf(z[e]))); run[e] += ls * 0.0625f; }
                cum[t] = run; }
            *(LAS f32x4*)(segtot + seg * 512 + c0) = run; }
          v2u rq[16], rk[16];
#pragma unroll
          for (int t = 0; t < 16; ++t) { rq[t] = *(const GAS v2u*)(PROJ + (row0 + 16 * seg + t) * DINP + C_GQ + c0); rk[t] = *(const GAS v2u*)(PROJ + (row0 + 16 * seg + t) * DINP + C_GK + c0); }
          __syncthreads();
          f32x4 off = (f32x4){0.f, 0.f, 0.f, 0.f}, tot = off;
#pragma unroll
          for (int sg = 0; sg < 4; ++sg) { const f32x4 v = *(const LAS f32x4*)(segtot + sg * 512 + c0); tot += v; if (sg < seg) off += v; }
#pragma unroll
          for (int t = 0; t < 16; ++t) { const f32x4 cc = cum[t] + off; const size_t o = (row0 + 16 * seg + t) * GLA_KT + c0;
              const float e0 = __expf(cc.x), e1 = __expf(cc.y), e2 = __expf(cc.z), e3 = __expf(cc.w), i0 = __expf(-cc.x), i1 = __expf(-cc.y), i2 = __expf(-cc.z), i3 = __expf(-cc.w);
              v2u oq, ok; oq.x = pk2(bflo(rq[t].x) * 0.08838834764831845f * e0, bfhi(rq[t].x) * 0.08838834764831845f * e1); oq.y = pk2(bflo(rq[t].y) * 0.08838834764831845f * e2, bfhi(rq[t].y) * 0.08838834764831845f * e3);
              ok.x = pk2(bflo(rk[t].x) * i0, bfhi(rk[t].x) * i1); ok.y = pk2(bflo(rk[t].y) * i2, bfhi(rk[t].y) * i3);
              *(GAS v2u*)(QD + o) = oq; *(GAS v2u*)(KI + o) = ok; }
          if (seg == 3) *(GAS f32x4*)(GDEC + (size_t)ck * GLA_KT + c0) = (f32x4){__expf(tot.x), __expf(tot.y), __expf(tot.z), __expf(tot.w)};
      } }
}

__device__ __forceinline__ void gla_c1_unit(Ctx& C, int unit) {
    const int h = unit & 3, ck = unit >> 2; const size_t row0 = (size_t)ck * GLA_L;
    const int tid = C.tid, lane = C.lane, w = C.wave, c = lane & 15, hq = lane >> 4;
    LAS unsigned char* KEimg = C.lds; LAS unsigned char* Vimg = C.lds + 64 * BI_STRIDE;
    const bf16* PROJ = (const bf16*)(C.ws + WS_PROJ); const bf16* KI = (const bf16*)(C.ws + WS_KI); const float* GDEC = (const float*)(C.ws + WS_GDEC); bf16* GST = (bf16*)(C.ws + WS_GST);
    __syncthreads();
    { const int cg = tid & 15; const f32x4 d0 = *(const GAS f32x4*)(GDEC + (size_t)ck * GLA_KT + h * 128 + 8 * cg), d1 = *(const GAS f32x4*)(GDEC + (size_t)ck * GLA_KT + h * 128 + 8 * cg + 4);
#pragma unroll
      for (int it = 0; it < 2; ++it) { const int t = (tid + NTHR * it) >> 4; const v4u r = __builtin_nontemporal_load((const GAS v4u*)(KI + (row0 + t) * GLA_KT + h * 128 + 8 * cg));
          v4u o; o.x = pk2(bflo(r.x) * d0.x, bfhi(r.x) * d0.y); o.y = pk2(bflo(r.y) * d0.z, bfhi(r.y) * d0.w); o.z = pk2(bflo(r.z) * d1.x, bfhi(r.z) * d1.y); o.w = pk2(bflo(r.w) * d1.z, bfhi(r.w) * d1.w);
          *(LAS v4u*)(KEimg + t * BI_STRIDE + 16 * cg) = o; } }
#pragma unroll
    for (int it = 0; it < 4; ++it) { const int idx = tid + NTHR * it, t = idx >> 5, cg = idx & 31; *(LAS v4u*)(Vimg + t * XI_STRIDE + 16 * cg) = __builtin_nontemporal_load((const GAS v4u*)(PROJ + (row0 + t) * DINP + C_GV + h * 256 + 8 * cg)); }
    __syncthreads();
    f32x4 acc[16];
#pragma unroll
    for (int nt = 0; nt < 16; ++nt) acc[nt] = (f32x4){0.f, 0.f, 0.f, 0.f};
#pragma unroll
    for (int ks = 0; ks < 2; ++ks) { const bf16x8 af = trfrag(KEimg, BI_STRIDE, 32 * ks + 8 * hq, 32 * ks + 8 * hq + 4, 16 * w, lane);
#pragma unroll
        for (int nt = 0; nt < 16; ++nt) acc[nt] = mfma16(af, trfrag(Vimg, XI_STRIDE, 32 * ks + 8 * hq, 32 * ks + 8 * hq + 4, 16 * nt, lane), acc[nt]); }
    bf16* gp = GST + (size_t)unit * 32768 + 16 * w + 4 * hq;
#pragma unroll
    for (int nt = 0; nt < 16; ++nt) { v2u o; o.x = pk2(acc[nt].x, acc[nt].y); o.y = pk2(acc[nt].z, acc[nt].w); *(GAS v2u*)(gp + (size_t)(16 * nt + c) * 128) = o; }
}

struct GlaC1Pre { v4u ki[2], vv[4]; f32x4 d0, d1; };
__device__ __forceinline__ void gla_c1_load(Ctx& C, int unit, GlaC1Pre& p) {
    const int h = unit & 3, ck = unit >> 2, tid = C.tid, cg = tid & 15; const size_t row0 = (size_t)ck * GLA_L;
    const bf16* PROJ = (const bf16*)(C.ws + WS_PROJ); const bf16* KI = (const bf16*)(C.ws + WS_KI); const float* GDEC = (const float*)(C.ws + WS_GDEC);
    p.d0 = *(const GAS f32x4*)(GDEC + (size_t)ck * GLA_KT + h * 128 + 8 * cg); p.d1 = *(const GAS f32x4*)(GDEC + (size_t)ck * GLA_KT + h * 128 + 8 * cg + 4);
#pragma unroll
    for (int it = 0; it < 2; ++it) { const int t = (tid + NTHR * it) >> 4; p.ki[it] = __builtin_nontemporal_load((const GAS v4u*)(KI + (row0 + t) * GLA_KT + h * 128 + 8 * cg)); }
#pragma unroll
    for (int it = 0; it < 4; ++it) { const int idx = tid + NTHR * it, t = idx >> 5, c2 = idx & 31; p.vv[it] = __builtin_nontemporal_load((const GAS v4u*)(PROJ + (row0 + t) * DINP + C_GV + h * 256 + 8 * c2)); }
}
__device__ __forceinline__ void gla_c1_stage(Ctx& C, const GlaC1Pre& p) {
    const int tid = C.tid, cg = tid & 15; LAS unsigned char* KEimg = C.lds; LAS unsigned char* Vimg = C.lds + 64 * BI_STRIDE;
#pragma unroll
    for (int it = 0; it < 2; ++it) { const int t = (tid + NTHR * it) >> 4; const v4u r = p.ki[it]; const f32x4 d0 = p.d0, d1 = p.d1;
        v4u o; o.x = pk2(bflo(r.x) * d0.x, bfhi(r.x) * d0.y); o.y = pk2(bflo(r.y) * d0.z, bfhi(r.y) * d0.w); o.z = pk2(bflo(r.z) * d1.x, bfhi(r.z) * d1.y); o.w = pk2(bflo(r.w) * d1.z, bfhi(r.w) * d1.w);
        *(LAS v4u*)(KEimg + t * BI_STRIDE + 16 * cg) = o; }
#pragma unroll
    for (int it = 0; it < 4; ++it) { const int idx = tid + NTHR * it, t = idx >> 5, c2 = idx & 31; *(LAS v4u*)(Vimg + t * XI_STRIDE + 16 * c2) = p.vv[it]; }
}
__device__ __forceinline__ void gla_c1_compute(Ctx& C, int unit) {
    const int lane = C.lane, w = C.wave, c = lane & 15, hq = lane >> 4;
    LAS unsigned char* KEimg = C.lds; LAS unsigned char* Vimg = C.lds + 64 * BI_STRIDE; bf16* GST = (bf16*)(C.ws + WS_GST);
    f32x4 acc[16];
#pragma unroll
    for (int nt = 0; nt < 16; ++nt) acc[nt] = (f32x4){0.f, 0.f, 0.f, 0.f};
#pragma unroll
    for (int ks = 0; ks < 2; ++ks) { const bf16x8 af = trfrag(KEimg, BI_STRIDE, 32 * ks + 8 * hq, 32 * ks + 8 * hq + 4, 16 * w, lane);
#pragma unroll
        for (int nt = 0; nt < 16; ++nt) acc[nt] = mfma16(af, trfrag(Vimg, XI_STRIDE, 32 * ks + 8 * hq, 32 * ks + 8 * hq + 4, 16 * nt, lane), acc[nt]); }
    bf16* gp = GST + (size_t)unit * 32768 + 16 * w + 4 * hq;
#pragma unroll
    for (int nt = 0; nt < 16; ++nt) { v2u o; o.x = pk2(acc[nt].x, acc[nt].y); o.y = pk2(acc[nt].z, acc[nt].w); *(GAS v2u*)(gp + (size_t)(16 * nt + c) * 128) = o; }
}

__device__ __forceinline__ void scan_phase(Ctx& C) {
    const bf16* GST = (const bf16*)(C.ws + WS_GST); bf16* GPV = (bf16*)(C.ws + WS_GPV); const float* GDEC = (const float*)(C.ws + WS_GDEC);
    const bf16* ST = (const bf16*)(C.ws + WS_ST); bf16* PV = (bf16*)(C.ws + WS_PV); const float* DEC = (const float*)(C.ws + WS_DEC);
    constexpr int N_S = BATCH * SSD_H * 64 * 16, N_G = BATCH * 4 * 256 * 32;
    for (int it = C.bid * NTHR + C.tid; it < N_S + N_G; it += C.G * NTHR) {
        if (it < N_S) {
            const int n8 = it & 15, p = (it >> 4) & 63, h = (it >> 10) & 31, b = it >> 15;
            const size_t base = ((size_t)(b * SSD_NC) * SSD_H + h) * 8192 + p * 128 + 8 * n8;
            const float* dp = DEC + (size_t)(b * SSD_NC) * SSD_H + h;
            f32x4 ra = (f32x4){0.f, 0.f, 0.f, 0.f}, rb = ra;
            v4u xa[8], xb[8]; float da[8], db[8];
#define SCAN_S_LOAD(X, D, c0) _Pragma("unroll") for (int j = 0; j < 8; ++j) { X[j] = __builtin_nontemporal_load((const GAS v4u*)(ST + base + (size_t)((c0) + j) * (SSD_H * 8192))); D[j] = dp[((c0) + j) * SSD_H]; }
#define SCAN_S_PROC(X, D, c0) _Pragma("unroll") for (int j = 0; j < 8; ++j) { v4u o; o.x = pk2(ra.x, ra.y); o.y = pk2(ra.z, ra.w); o.z = pk2(rb.x, rb.y); o.w = pk2(rb.z, rb.w); \
                *(GAS v4u*)(PV + base + (size_t)((c0) + j) * (SSD_H * 8192)) = o; \
                ra = ra * D[j] + (f32x4){bflo(X[j].x), bfhi(X[j].x), bflo(X[j].y), bfhi(X[j].y)}; rb = rb * D[j] + (f32x4){bflo(X[j].z), bfhi(X[j].z), bflo(X[j].w), bfhi(X[j].w)}; }
            SCAN_S_LOAD(xa, da, 0)
#pragma unroll 1
            for (int c0 = 0; c0 < SSD_NC; c0 += 16) {
                SCAN_S_LOAD(xb, db, c0 + 8)
                SCAN_S_PROC(xa, da, c0)
                if (c0 + 16 < SSD_NC) { SCAN_S_LOAD(xa, da, c0 + 16) }
                SCAN_S_PROC(xb, db, c0 + 8)
            }
#undef SCAN_S_LOAD
#undef SCAN_S_PROC
        } else {
            const int ig = it - N_S, k4 = ig & 31, v = (ig >> 5) & 255, h = (ig >> 13) & 3, b = ig >> 15;
            const size_t base = ((size_t)(b * GLA_NC) * 4 + h) * 32768 + v * 128 + 4 * k4;
            const float* dp = GDEC + (size_t)(b * GLA_NC) * GLA_KT + h * 128 + 4 * k4;
            f32x4 r = (f32x4){0.f, 0.f, 0.f, 0.f};
            v2u xa[8], xb[8]; f32x4 da[8], db[8];
#define SCAN_G_LOAD(X, D, c0) _Pragma("unroll") for (int j = 0; j < 8; ++j) { X[j] = __builtin_nontemporal_load((const GAS v2u*)(GST + base + (size_t)((c0) + j) * (4 * 32768))); D[j] = *(const GAS f32x4*)(dp + (size_t)((c0) + j) * GLA_KT); }
#define SCAN_G_PROC(X, D, c0) _Pragma("unroll") for (int j = 0; j < 8; ++j) { v2u o; o.x = pk2(r.x, r.y); o.y = pk2(r.z, r.w); *(GAS v2u*)(GPV + base + (size_t)((c0) + j) * (4 * 32768)) = o; \
                r = r * D[j] + (f32x4){bflo(X[j].x), bfhi(X[j].x), bflo(X[j].y), bfhi(X[j].y)}; }
            SCAN_G_LOAD(xa, da, 0)
#pragma unroll 1
            for (int c0 = 0; c0 < GLA_NC; c0 += 16) {
                SCAN_G_LOAD(xb, db, c0 + 8)
                SCAN_G_PROC(xa, da, c0)
                if (c0 + 16 < GLA_NC) { SCAN_G_LOAD(xa, da, c0 + 16) }
                SCAN_G_PROC(xb, db, c0 + 8)
            }
#undef SCAN_G_LOAD
#undef SCAN_G_PROC
        }
    }
}

constexpr int GC3_GP_OFF = 64 * XI_STRIDE, GC3_XCH_OFF = GC3_GP_OFF + 256 * BI_STRIDE;
__device__ __forceinline__ void gla_c3_unit(Ctx& C, int l, int unit) {
    const int h = unit & 3, ck = unit >> 2; const size_t row0 = (size_t)ck * GLA_L;
    const int tid = C.tid, lane = C.lane, w = C.wave, c = lane & 15, hq = lane >> 4;
    LAS unsigned char* Vimg = C.lds; LAS unsigned char* GPimg = C.lds + GC3_GP_OFF; LAS float* xch = (LAS float*)(C.lds + GC3_XCH_OFF);
    const bf16* PROJ = (const bf16*)(C.ws + WS_PROJ); const bf16* QD = (const bf16*)(C.ws + WS_QD); const bf16* KI = (const bf16*)(C.ws + WS_KI); const bf16* GPV = (const bf16*)(C.ws + WS_GPV); bf16* Y = (bf16*)(C.ws + WS_Y);
    const int lt = w >> 1, vh = w & 1; const size_t row = row0 + 16 * lt + c;
    __syncthreads();
    { const bf16* gpv = GPV + (size_t)unit * 32768;
      v4u tv[4], tg[8];
#pragma unroll
      for (int it = 0; it < 4; ++it) { const int idx = tid + NTHR * it, t = idx >> 5, cg = idx & 31; tv[it] = __builtin_nontemporal_load((const GAS v4u*)(PROJ + (row0 + t) * DINP + C_GV + h * 256 + 8 * cg)); }
#pragma unroll
      for (int it = 0; it < 8; ++it) { const int idx = tid + NTHR * it; tg[it] = __builtin_nontemporal_load((const GAS v4u*)(gpv + (size_t)idx * 8)); }
#pragma unroll
      for (int it = 0; it < 4; ++it) { const int idx = tid + NTHR * it, t = idx >> 5, cg = idx & 31; *(LAS v4u*)(Vimg + t * XI_STRIDE + 16 * cg) = tv[it]; }
#pragma unroll
      for (int it = 0; it < 8; ++it) { const int idx = tid + NTHR * it, v = idx >> 4, cg = idx & 15; *(LAS v4u*)(GPimg + v * BI_STRIDE + 16 * cg) = tg[it]; } }
    bf16x8 qf[4];
#pragma unroll
    for (int ks = 0; ks < 4; ++ks) qf[ks] = gfrag(QD + row0 * GLA_KT + h * 128, GLA_KT, 16 * lt, 32 * ks, lane);
    v2u ggv[8];
#pragma unroll
    for (int vt = 0; vt < 8; ++vt) ggv[vt] = __builtin_nontemporal_load((const GAS v2u*)(PROJ + row * DINP + C_GG + h * 256 + 16 * (8 * vh + vt) + 4 * hq));
    f32x4 att[4];
#pragma unroll
    for (int st = 0; st < 4; ++st) { f32x4 a = (f32x4){0.f, 0.f, 0.f, 0.f};
        if (st <= lt) {
#pragma unroll
            for (int ks = 0; ks < 4; ++ks) a = mfma16(gfrag(KI + row0 * GLA_KT + h * 128, GLA_KT, 16 * st, 32 * ks, lane), qf[ks], a);
#pragma unroll
            for (int r = 0; r < 4; ++r) if (16 * st + 4 * hq + r > 16 * lt + c) a[r] = 0.f;
        }
        att[st] = a; }
    __syncthreads();
    f32x4 oacc[8];
#pragma unroll
    for (int vt = 0; vt < 8; ++vt) oacc[vt] = (f32x4){0.f, 0.f, 0.f, 0.f};
#pragma unroll
    for (int ks = 0; ks < 4; ++ks)
#pragma unroll
        for (int vt = 0; vt < 8; ++vt) oacc[vt] = mfma16(*(const LAS bf16x8*)(GPimg + (16 * (8 * vh + vt) + c) * BI_STRIDE + (32 * ks + 8 * hq) * 2), qf[ks], oacc[vt]);
#pragma unroll
    for (int ks2 = 0; ks2 < 2; ++ks2) { const bf16x8 pf = pack8(att[2 * ks2], att[2 * ks2 + 1]);
#pragma unroll
        for (int vt = 0; vt < 8; ++vt) oacc[vt] = mfma16(trfrag(Vimg, XI_STRIDE, 32 * ks2 + 4 * hq, 32 * ks2 + 16 + 4 * hq, 16 * (8 * vh + vt), lane), pf, oacc[vt]); }
    float ssq = 0.f;
#pragma unroll
    for (int vt = 0; vt < 8; ++vt) ssq += (oacc[vt].x * oacc[vt].x + oacc[vt].y * oacc[vt].y) + (oacc[vt].z * oacc[vt].z + oacc[vt].w * oacc[vt].w);
    ssq = xsum4(ssq);
    if (hq == 0) xch[w * 16 + c] = ssq;
    __syncthreads();
    const float rstd = 1.f / sqrtf((xch[w * 16 + c] + xch[(w ^ 1) * 16 + c]) * (1.f / 256.f) + EPS);
    const float* gla_norm = C.in[I_GLA_NORM] + (size_t)l * 256;
#pragma unroll
    for (int vt = 0; vt < 8; ++vt) { const int v0 = 16 * (8 * vh + vt) + 4 * hq; const f32x4 gn = *(const GAS f32x4*)(gla_norm + v0); const v2u gg = ggv[vt];
        const f32x4 o = oacc[vt]; v2u ow; ow.x = pk2(o.x * rstd * gn.x * silu_f(bflo(gg.x)), o.y * rstd * gn.y * silu_f(bfhi(gg.x))); ow.y = pk2(o.z * rstd * gn.z * silu_f(bflo(gg.y)), o.w * rstd * gn.w * silu_f(bfhi(gg.y)));
        *(GAS v2u*)(Y + row * DM + 3072 + h * 256 + v0) = ow; }
}

__device__ __forceinline__ void ssd_c1_unit(Ctx& C, int unit) {
    const int g = unit & 7, bc = unit >> 3; const size_t row0 = (size_t)bc * SSD_L;
    const int tid = C.tid, lane = C.lane, w = C.wave, c = lane & 15, hq = lane >> 4;
    LAS float* acs = (LAS float*)C.lds; LAS float* dts = acs + 512;
    LAS unsigned char* XWimg = C.lds + 4096; LAS unsigned char* Bimg = C.lds + 4096 + 128 * XI_STRIDE;
    const bf16* XBC = (const bf16*)(C.ws + WS_XBC); const float* DT = (const float*)(C.ws + WS_DT); const float* ACS = (const float*)(C.ws + WS_ACS); bf16* ST = (bf16*)(C.ws + WS_ST);
    __syncthreads();
    { const int t = tid >> 2, hh = tid & 3; acs[hh * 128 + t] = ACS[(row0 + t) * SSD_H + 4 * g + hh]; dts[hh * 128 + t] = DT[(row0 + t) * SSD_H + 4 * g + hh]; }
    __syncthreads();
#pragma unroll
    for (int it = 0; it < 8; ++it) { const int idx = tid + NTHR * it, t = idx >> 5, cg = idx & 31, hh = cg >> 3; const float wgt = __expf(acs[hh * 128 + 127] - acs[hh * 128 + t]) * dts[hh * 128 + t];
        const v4u r = __builtin_nontemporal_load((const GAS v4u*)(XBC + (row0 + t) * SSD_CD + g * 256 + 8 * cg));
        v4u o; o.x = pk2(bflo(r.x) * wgt, bfhi(r.x) * wgt); o.y = pk2(bflo(r.y) * wgt, bfhi(r.y) * wgt); o.z = pk2(bflo(r.z) * wgt, bfhi(r.z) * wgt); o.w = pk2(bflo(r.w) * wgt, bfhi(r.w) * wgt);
        *(LAS v4u*)(XWimg + t * XI_STRIDE + 16 * cg) = o; }
#pragma unroll
    for (int it = 0; it < 4; ++it) { const int idx = tid + NTHR * it, t = idx >> 4, cg = idx & 15; *(LAS v4u*)(Bimg + t * BI_STRIDE + 16 * cg) = __builtin_nontemporal_load((const GAS v4u*)(XBC + (row0 + t) * SSD_CD + 2048 + g * 128 + 8 * cg)); }
    __syncthreads();
    const int hh = w >> 1, ph = w & 1;
    f32x4 acc[8][2];
#pragma unroll
    for (int mt = 0; mt < 8; ++mt) { acc[mt][0] = (f32x4){0.f, 0.f, 0.f, 0.f}; acc[mt][1] = (f32x4){0.f, 0.f, 0.f, 0.f}; }
#pragma unroll
    for (int ks = 0; ks < 4; ++ks) { const int r0 = 32 * ks + 8 * hq;
        const bf16x8 x0 = trfrag(XWimg, XI_STRIDE, r0, r0 + 4, hh * 64 + 32 * ph, lane), x1 = trfrag(XWimg, XI_STRIDE, r0, r0 + 4, hh * 64 + 32 * ph + 16, lane);
#pragma unroll
        for (int mt = 0; mt < 8; ++mt) { const bf16x8 bf = trfrag(Bimg, BI_STRIDE, r0, r0 + 4, 16 * mt, lane); acc[mt][0] = mfma16(bf, x0, acc[mt][0]); acc[mt][1] = mfma16(bf, x1, acc[mt][1]); } }
    bf16* sp = ST + ((size_t)bc * SSD_H + 4 * g + hh) * 8192 + 4 * hq;
#pragma unroll
    for (int mt = 0; mt < 8; ++mt)
#pragma unroll
        for (int pt = 0; pt < 2; ++pt) { v2u o; o.x = pk2(acc[mt][pt].x, acc[mt][pt].y); o.y = pk2(acc[mt][pt].z, acc[mt][pt].w); *(GAS v2u*)(sp + (size_t)(32 * ph + 16 * pt + c) * 128 + 16 * mt) = o; }
}

struct SsdC1Pre { v4u tx[8], tbv[4]; float ac[8], dc[8], alast; };
__device__ __forceinline__ void ssd_c1_load(Ctx& C, int unit, SsdC1Pre& p) {
    const int g = unit & 7, bc = unit >> 3, tid = C.tid; const size_t row0 = (size_t)bc * SSD_L;
    const bf16* XBC = (const bf16*)(C.ws + WS_XBC); const float* DT = (const float*)(C.ws + WS_DT); const float* ACS = (const float*)(C.ws + WS_ACS);
    const int cg = tid & 31, hh = cg >> 3;
    p.alast = ACS[(row0 + 127) * SSD_H + 4 * g + hh];
#pragma unroll
    for (int it = 0; it < 8; ++it) { const int t = (tid >> 5) + 16 * it; p.ac[it] = ACS[(row0 + t) * SSD_H + 4 * g + hh]; p.dc[it] = DT[(row0 + t) * SSD_H + 4 * g + hh];
        p.tx[it] = __builtin_nontemporal_load((const GAS v4u*)(XBC + (row0 + t) * SSD_CD + g * 256 + 8 * cg)); }
#pragma unroll
    for (int it = 0; it < 4; ++it) { const int idx = tid + NTHR * it, t = idx >> 4, c2 = idx & 15; p.tbv[it] = __builtin_nontemporal_load((const GAS v4u*)(XBC + (row0 + t) * SSD_CD + 2048 + g * 128 + 8 * c2)); }
}
__device__ __forceinline__ void ssd_c1_stage(Ctx& C, const SsdC1Pre& p) {
    const int tid = C.tid, cg = tid & 31; LAS unsigned char* XWimg = C.lds + 4096; LAS unsigned char* Bimg = C.lds + 4096 + 128 * XI_STRIDE;
#pragma unroll
    for (int it = 0; it < 8; ++it) { const int t = (tid >> 5) + 16 * it; const float wgt = __expf(p.alast - p.ac[it]) * p.dc[it]; const v4u r = p.tx[it];
        v4u o; o.x = pk2(bflo(r.x) * wgt, bfhi(r.x) * wgt); o.y = pk2(bflo(r.y) * wgt, bfhi(r.y) * wgt); o.z = pk2(bflo(r.z) * wgt, bfhi(r.z) * wgt); o.w = pk2(bflo(r.w) * wgt, bfhi(r.w) * wgt);
        *(LAS v4u*)(XWimg + t * XI_STRIDE + 16 * cg) = o; }
#pragma unroll
    for (int it = 0; it < 4; ++it) { const int idx = tid + NTHR * it, t = idx >> 4, c2 = idx & 15; *(LAS v4u*)(Bimg + t * BI_STRIDE + 16 * c2) = p.tbv[it]; }
}
__device__ __forceinline__ void ssd_c1_compute(Ctx& C, int unit) {
    const int g = unit & 7, bc = unit >> 3; const int lane = C.lane, w = C.wave, c = lane & 15, hq = lane >> 4;
    LAS unsigned char* XWimg = C.lds + 4096; LAS unsigned char* Bimg = C.lds + 4096 + 128 * XI_STRIDE; bf16* ST = (bf16*)(C.ws + WS_ST);
    const int hh = w >> 1, ph = w & 1;
    f32x4 acc[8][2];
#pragma unroll
    for (int mt = 0; mt < 8; ++mt) { acc[mt][0] = (f32x4){0.f, 0.f, 0.f, 0.f}; acc[mt][1] = (f32x4){0.f, 0.f, 0.f, 0.f}; }
#pragma unroll
    for (int ks = 0; ks < 4; ++ks) { const int r0 = 32 * ks + 8 * hq;
        const bf16x8 x0 = trfrag(XWimg, XI_STRIDE, r0, r0 + 4, hh * 64 + 32 * ph, lane), x1 = trfrag(XWimg, XI_STRIDE, r0, r0 + 4, hh * 64 + 32 * ph + 16, lane);
#pragma unroll
        for (int mt = 0; mt < 8; ++mt) { const bf16x8 bf = trfrag(Bimg, BI_STRIDE, r0, r0 + 4, 16 * mt, lane); acc[mt][0] = mfma16(bf, x0, acc[mt][0]); acc[mt][1] = mfma16(bf, x1, acc[mt][1]); } }
    bf16* sp = ST + ((size_t)bc * SSD_H + 4 * g + hh) * 8192 + 4 * hq;
#pragma unroll
    for (int mt = 0; mt < 8; ++mt)
#pragma unroll
        for (int pt = 0; pt < 2; ++pt) { v2u o; o.x = pk2(acc[mt][pt].x, acc[mt][pt].y); o.y = pk2(acc[mt][pt].z, acc[mt][pt].w); *(GAS v2u*)(sp + (size_t)(32 * ph + 16 * pt + c) * 128 + 16 * mt) = o; }
}

constexpr int SC3_X_OFF = 4096, SC3_PV_OFF = SC3_X_OFF + 128 * XI_STRIDE, SC3_PV_HEAD = 64 * BI_STRIDE;
static_assert(SC3_PV_OFF + 4 * SC3_PV_HEAD <= MISC_OFF && GC3_XCH_OFF + 512 <= MISC_OFF, "mixer LDS maps");
__device__ __forceinline__ void ssd_c3_unit(Ctx& C, int l, int unit) {
    const int g = unit & 7, bc = unit >> 3; const size_t row0 = (size_t)bc * SSD_L;
    const int tid = C.tid, lane = C.lane, w = C.wave, c = lane & 15, hq = lane >> 4;
    LAS float* acs = (LAS float*)C.lds; LAS float* dts = acs + 512;
    LAS unsigned char* Ximg = C.lds + SC3_X_OFF; LAS unsigned char* PVimg = C.lds + SC3_PV_OFF;
    const bf16* PROJ = (const bf16*)(C.ws + WS_PROJ); const bf16* XBC = (const bf16*)(C.ws + WS_XBC); const float* DT = (const float*)(C.ws + WS_DT); const float* ACS = (const float*)(C.ws + WS_ACS);
    const bf16* PV = (const bf16*)(C.ws + WS_PV); bf16* Y = (bf16*)(C.ws + WS_Y);
    const int tl = 16 * w + c; const size_t row = row0 + tl;
    __syncthreads();
    { const int t = tid >> 2, hh = tid & 3; const float a0 = ACS[(row0 + t) * SSD_H + 4 * g + hh], d0 = DT[(row0 + t) * SSD_H + 4 * g + hh];
      const bf16* pvb = PV + ((size_t)bc * SSD_H + 4 * g) * 8192;
      v4u tx[8], tp[8];
#pragma unroll
      for (int it = 0; it < 8; ++it) { const int idx = tid + NTHR * it, t2 = idx >> 5, cg = idx & 31; tx[it] = __builtin_nontemporal_load((const GAS v4u*)(XBC + (row0 + t2) * SSD_CD + g * 256 + 8 * cg)); }
#pragma unroll
      for (int it = 0; it < 8; ++it) { const int idx = tid + NTHR * it; tp[it] = __builtin_nontemporal_load((const GAS v4u*)(pvb + (size_t)idx * 8)); }
      acs[(tid & 3) * 128 + (tid >> 2)] = a0; dts[(tid & 3) * 128 + (tid >> 2)] = d0;
#pragma unroll
      for (int it = 0; it < 8; ++it) { const int idx = tid + NTHR * it, t2 = idx >> 5, cg = idx & 31; *(LAS v4u*)(Ximg + t2 * XI_STRIDE + 16 * cg) = tx[it]; }
#pragma unroll
      for (int it = 0; it < 8; ++it) { const int idx = tid + NTHR * it, pr = idx >> 4, cg = idx & 15; *(LAS v4u*)(PVimg + pr * BI_STRIDE + 16 * cg) = tp[it]; } }
    bf16x8 cf[4];
#pragma unroll
    for (int ks = 0; ks < 4; ++ks) cf[ks] = gfrag(XBC + row0 * SSD_CD + 3072 + g * 128, SSD_CD, 16 * w, 32 * ks, lane);
    f32x4 cb[8];
#pragma unroll
    for (int st = 0; st < 8; ++st) { f32x4 a = (f32x4){0.f, 0.f, 0.f, 0.f};
        if (st <= w) {
#pragma unroll
            for (int ks = 0; ks < 4; ++ks) a = mfma16(gfrag(XBC + row0 * SSD_CD + 2048 + g * 128, SSD_CD, 16 * st, 32 * ks, lane), cf[ks], a);
        }
        cb[st] = a; }
    __syncthreads();
    v2u yk[4][4];
    float ssq = 0.f;
#pragma unroll
    for (int hh = 0; hh < 4; ++hh) {
        v2u zz[4];
#pragma unroll
        for (int pt = 0; pt < 4; ++pt) zz[pt] = __builtin_nontemporal_load((const GAS v2u*)(PROJ + row * DINP + C_Z + g * 256 + hh * 64 + 16 * pt + 4 * hq));
        const float acs_l = acs[hh * 128 + tl], el = __expf(acs_l);
        f32x4 ya[4];
#pragma unroll
        for (int pt = 0; pt < 4; ++pt) ya[pt] = (f32x4){0.f, 0.f, 0.f, 0.f};
#pragma unroll
        for (int ks = 0; ks < 4; ++ks)
#pragma unroll
            for (int pt = 0; pt < 4; ++pt) ya[pt] = mfma16(*(const LAS bf16x8*)(PVimg + (hh * 64 + 16 * pt + c) * BI_STRIDE + (32 * ks + 8 * hq) * 2), cf[ks], ya[pt]);
#pragma unroll
        for (int pt = 0; pt < 4; ++pt) ya[pt] = ya[pt] * el;
#pragma unroll
        for (int ks2 = 0; ks2 < 4; ++ks2) {
            if (2 * ks2 <= w) {
                f32x4 lm[2];
#pragma unroll
                for (int t2 = 0; t2 < 2; ++t2) { const int s0 = 32 * ks2 + 16 * t2 + 4 * hq; const f32x4 as4 = *(const LAS f32x4*)(acs + hh * 128 + s0), dt4 = *(const LAS f32x4*)(dts + hh * 128 + s0);
#pragma unroll
                    for (int r = 0; r < 4; ++r) { const float d = fminf(acs_l - as4[r], 0.f); lm[t2][r] = (s0 + r <= tl) ? cb[2 * ks2 + t2][r] * __expf(d) * dt4[r] : 0.f; } }
                const bf16x8 pf = pack8(lm[0], lm[1]);
#pragma unroll
                for (int pt = 0; pt < 4; ++pt) ya[pt] = mfma16(trfrag(Ximg, XI_STRIDE, 32 * ks2 + 4 * hq, 32 * ks2 + 16 + 4 * hq, hh * 64 + 16 * pt, lane), pf, ya[pt]);
            }
        }
        const float Dh = C.in[I_SSD_D][l * SSD_H + 4 * g + hh];
#pragma unroll
        for (int pt = 0; pt < 4; ++pt) { const int col = hh * 64 + 16 * pt + 4 * hq; const v2u xw = *(const LAS v2u*)(Ximg + tl * XI_STRIDE + col * 2); const v2u z2 = zz[pt];
            f32x4 v; v.x = (ya[pt].x + Dh * bflo(xw.x)) * silu_f(bflo(z2.x)); v.y = (ya[pt].y + Dh * bfhi(xw.x)) * silu_f(bfhi(z2.x)); v.z = (ya[pt].z + Dh * bflo(xw.y)) * silu_f(bflo(z2.y)); v.w = (ya[pt].w + Dh * bfhi(xw.y)) * silu_f(bfhi(z2.y));
            { v2u pk; pk.x = pk2(v.x, v.y); pk.y = pk2(v.z, v.w); yk[hh][pt] = pk; } ssq += (v.x * v.x + v.y * v.y) + (v.z * v.z + v.w * v.w); }
    }
    ssq = xsum4(ssq);
    const float rstd = 1.f / sqrtf(ssq * (1.f / 256.f) + EPS);
    const float* ssd_norm = C.in[I_SSD_NORM] + (size_t)l * SSD_W + g * 256;
#pragma unroll
    for (int hh = 0; hh < 4; ++hh)
#pragma unroll
        for (int pt = 0; pt < 4; ++pt) { const int col = hh * 64 + 16 * pt + 4 * hq; const f32x4 gn = *(const GAS f32x4*)(ssd_norm + col); const f32x4 v = (f32x4){bflo(yk[hh][pt].x), bfhi(yk[hh][pt].x), bflo(yk[hh][pt].y), bfhi(yk[hh][pt].y)};
            v2u ow; ow.x = pk2(v.x * rstd * gn.x, v.y * rstd * gn.y); ow.y = pk2(v.z * rstd * gn.z, v.w * rstd * gn.w); *(GAS v2u*)(Y + row * DM + g * 256 + col) = ow; }
}

__device__ __forceinline__ void mix_c1_phase(Ctx& C, int l) {
    const bool swa_first = ((C.bid >> 3) & 1) != 0;
#pragma nounroll
    for (int pass = 0; pass < 2; ++pass) {
        if ((pass == 0) == swa_first) {
            for (int u = C.bid; u < N_SWA_UNITS; u += C.G) { int t_ = threadIdx.x; asm volatile("" : "+v"(t_)); C.tid = t_; C.lane = t_ & 63; swa_unit_mfma(C, l, u); }
        } else {
            { int u = C.bid; SsdC1Pre p; if (u < N_SSD_CU) ssd_c1_load(C, u, p);
              while (u < N_SSD_CU) { { int t_ = threadIdx.x; asm volatile("" : "+v"(t_)); C.tid = t_; C.lane = t_ & 63; } __syncthreads(); ssd_c1_stage(C, p); __syncthreads(); const int un = u + C.G; if (un < N_SSD_CU) ssd_c1_load(C, un, p); ssd_c1_compute(C, u); u = un; } }
            { int u = C.bid; GlaC1Pre p; if (u < N_GLA_CU) gla_c1_load(C, u, p);
              while (u < N_GLA_CU) { { int t_ = threadIdx.x; asm volatile("" : "+v"(t_)); C.tid = t_; C.lane = t_ & 63; } __syncthreads(); gla_c1_stage(C, p); __syncthreads(); const int un = u + C.G; if (un < N_GLA_CU) gla_c1_load(C, un, p); gla_c1_compute(C, u); u = un; } }
        }
        { int t_ = threadIdx.x; asm volatile("" : "+v"(t_)); C.tid = t_; C.lane = t_ & 63; } __syncthreads();
    }
}
__device__ __forceinline__ void mix_c3_phase(Ctx& C, int l) {
    for (int u = C.bid; u < N_SSD_CU; u += C.G) { int t_ = threadIdx.x; asm volatile("" : "+v"(t_)); C.tid = t_; C.lane = t_ & 63; ssd_c3_unit(C, l, u); }
    for (int u = C.bid; u < N_GLA_CU; u += C.G) { int t_ = threadIdx.x; asm volatile("" : "+v"(t_)); C.tid = t_; C.lane = t_ & 63; gla_c3_unit(C, l, u); }
}

__device__ __forceinline__ void act_fixup_phase(Ctx& C, int l) {
    bf16* ACT = (bf16*)(C.ws + WS_ACT); const float* HTG = (const float*)(C.ws + WS_HTG); const float* HTU = (const float*)(C.ws + WS_HTU); const float* HBG = (const float*)(C.ws + WS_HBG);
    const float* cw = C.in[I_FFN_CONV_W] + (size_t)l * 3 * DFF; const float* cb = C.in[I_FFN_CONV_B] + (size_t)l * DFF;
    constexpr int NC4 = DFF / 4, NIT = (M / 64) * 2 * NC4;
    for (int it = C.bid * NTHR + C.tid; it < NIT; it += C.G * NTHR) {
        const int c4 = it % NC4, ri = it / NC4, i = ri & 1, blk = ri >> 1, c0 = 4 * c4; const bool first = (blk % (SEQ / 64)) == 0;
        const f32x4 z4 = (f32x4){0.f, 0.f, 0.f, 0.f};
        const f32x4 g0 = *(const GAS f32x4*)(HTG + ((size_t)blk * 2 + i) * DFF + c0), up = *(const GAS f32x4*)(HTU + ((size_t)blk * 2 + i) * DFF + c0);
        const f32x4 pb1 = first ? z4 : *(const GAS f32x4*)(HBG + ((size_t)(blk - 1) * 2 + 1) * DFF + c0), pb0 = first ? z4 : *(const GAS f32x4*)(HBG + ((size_t)(blk - 1) * 2 + 0) * DFF + c0);
        const f32x4 g1 = i ? *(const GAS f32x4*)(HTG + ((size_t)blk * 2 + 0) * DFF + c0) : pb1, g2 = i ? pb1 : pb0;
        const f32x4 w0 = *(const GAS f32x4*)(cw + c0), w1 = *(const GAS f32x4*)(cw + DFF + c0), w2 = *(const GAS f32x4*)(cw + 2 * DFF + c0), bb = *(const GAS f32x4*)(cb + c0);
        f32x4 o;
#pragma unroll
        for (int e = 0; e < 4; ++e) { const float gc = bb[e] + w0[e] * g2[e] + w1[e] * g1[e] + w2[e] * g0[e]; o[e] = silu_f(gc) * up[e]; }
        v2u ow; ow.x = pk2(o.x, o.y); ow.y = pk2(o.z, o.w); *(GAS v2u*)(ACT + (size_t)(64 * blk + i) * DFF + c0) = ow;
    }
}

constexpr int PH_PER_LAYER = 11, PH_FINAL = DEPTH * PH_PER_LAYER, N_PHASES = PH_FINAL + 1;
#ifndef WGM_DOWN
#define WGM_DOWN 4
#endif
#ifndef MK_ONE_LAUNCH
#define MK_ONE_LAUNCH 1
#endif
__global__ void __launch_bounds__(NTHR, 2) fwd_kernel(Args args) {
    extern __shared__ __attribute__((aligned(16))) unsigned char lds[];
    Ctx C;
    C.lds = (LAS unsigned char*)lds;
    C.tid = threadIdx.x; C.lane = C.tid & 63; C.wave = __builtin_amdgcn_readfirstlane(C.tid >> 6);
    C.G = gridDim.x; C.bid = blockIdx.x;
    C.in = args.in; C.out = args.out; C.ws = args.ws;
    volatile LAS unsigned* MISC = (volatile LAS unsigned*)(C.lds + MISC_OFF);
    for (int u = C.tid; u < (LDS_BYTES - MISC_OFF) / 4; u += NTHR) ((LAS unsigned*)(C.lds + MISC_OFF))[u] = 0u;
    __syncthreads();
    gu32* ctl = (gu32*)(args.ws + WS_CTL);
    XcdBarrier bar = xcd_barrier_post((unsigned*)(ctl + CW_BAR) + args.li * XCD_BAR_WORDS, MISC + 8);
    const int lo = args.ph_lo, hi = args.ph_hi;
#define IN(k) (lo <= (k) && (k) < hi)
    const bool seamfill = (lo == 0 && hi == N_PHASES);
#define SEAM_LO(k) ((k) <= 10 ? ((k) - 2) * 256 : SEAM_B0 + ((k) - 11) * 256)
#define SEAM(k) do { if (IN(k) && IN((k) + 1)) { \
        if (seamfill && (k) >= 2 && (k) <= 17) { xcd_barrier_arrive(bar); LAUNDER(); convert_weights(C, 1, SEAM_LO(k), SEAM_LO(k) + 256); xcd_barrier_wait(bar); } \
        else xcd_barrier(bar); } } while (0)
    bf16* xb = (bf16*)(args.ws + WS_XB);
    bf16* H = (bf16*)(args.ws + WS_H);
#define LAUNDER() do { int t_ = threadIdx.x; asm volatile("" : "+v"(t_)); C.tid = t_; C.lane = t_ & 63; } while (0)
#define LAYER_BODY(l) do { \
        const int pb = l * PH_PER_LAYER; \
        LAUNDER(); \
        if (IN(pb + 0)) { if (l == 1 && seamfill) { convert_weights(C, l, SEAM_A1, SEAM_B0); LAUNDER(); convert_weights(C, l, SEAM_B1, CV_A_ITEMS); } else convert_weights(C, l, 0, CV_A_ITEMS); LAUNDER(); if (l == 0) rmsnorm_phase(C, args.in[I_X], args.in[I_ATTN_NORM] + (size_t)l * DM, H, xb); else rmsnorm_phase_b(C, xb, args.in[I_ATTN_NORM] + (size_t)l * DM, H); } \
        SEAM(pb + 0); \
        LAUNDER(); \
        if (IN(pb + 1)) { \
            pg8::Gemm g{H, (const bf16*)(args.ws + WS_WIN), M, DINP, DM}; pg8::StaticOrder S; S.init(M, DINP, C.G, C.bid); \
            pg8::EpiProjConv E{(bf16*)(args.ws + WS_PROJ), DINP, (bf16*)(args.ws + WS_XBC), args.in[I_SSD_CONV_W] + (size_t)l * 4 * SSD_CD, args.in[I_SSD_CONV_B] + (size_t)l * SSD_CD, (float*)(args.ws + WS_XHT), (float*)(args.ws + WS_XHB)}; \
            pg8::gemm_phase<pg8::EpiProjConv, pg8::StaticOrder, true, true>(C.lds, g, S, E); \
        } \
        SEAM(pb + 1); \
        LAUNDER(); \
        if (IN(pb + 2)) {   \
            const bool cvf = ((C.bid >> 3) & 1) != 0; \
            _Pragma("nounroll") for (int pass = 0; pass < 2; ++pass) { if ((pass == 0) == cvf) convert_weights(C, l, CV_UP_LO, CV_DN_LO); else prep_phase(C, l); LAUNDER(); __syncthreads(); } } \
        SEAM(pb + 2); \
        LAUNDER(); \
        if (IN(pb + 3)) mix_c1_phase(C, l); \
        SEAM(pb + 3); \
        LAUNDER(); \
        if (IN(pb + 4)) scan_phase(C); \
        SEAM(pb + 4); \
        LAUNDER(); \
        if (IN(pb + 5)) mix_c3_phase(C, l); \
        SEAM(pb + 5); \
        LAUNDER(); \
        if (IN(pb + 6)) { \
            pg8::Gemm g{(const bf16*)(args.ws + WS_Y), (const bf16*)(args.ws + WS_WOUT), M, DM, DM}; pg8::StaticOrder S; S.init(M, DM, C.G, C.bid); \
            pg8::EpiResB<false> E{(const void*)xb, xb, DM}; \
            pg8::gemm_phase<pg8::EpiResB<false>, pg8::StaticOrder, true, true>(C.lds, g, S, E); \
        } \
        SEAM(pb + 6); \
        LAUNDER(); \
        if (IN(pb + 7)) rmsnorm_phase_b(C, xb, args.in[I_FFN_NORM] + (size_t)l * DM, H); \
        SEAM(pb + 7); \
        LAUNDER(); \
        if (IN(pb + 8)) { \
            pg8::Gemm g{H, (const bf16*)(args.ws + WS_WGU), M, DGU, DM}; pg8::StaticOrder S; S.init(M, DGU, C.G, C.bid); \
            pg8::EpiGateUp E{(bf16*)(args.ws + WS_ACT), args.in[I_FFN_CONV_W] + (size_t)l * 3 * DFF, args.in[I_FFN_CONV_B] + (size_t)l * DFF, (float*)(args.ws + WS_HTG), (float*)(args.ws + WS_HTU), (float*)(args.ws + WS_HBG), DFF}; \
            pg8::gemm_phase<pg8::EpiGateUp, pg8::StaticOrder, true, true>(C.lds, g, S, E); \
        } \
        SEAM(pb + 8); \
        LAUNDER(); \
        if (IN(pb + 9)) { const bool cvf = ((C.bid >> 3) & 1) != 0; \
            _Pragma("nounroll") for (int pass = 0; pass < 2; ++pass) { if ((pass == 0) == cvf) convert_weights(C, l, CV_DN_LO, CV_NITEMS); else act_fixup_phase(C, l); LAUNDER(); __syncthreads(); } } \
        SEAM(pb + 9); \
        LAUNDER(); \
        if (IN(pb + 10)) { \
            pg8::Gemm g{(const bf16*)(args.ws + WS_ACT), (const bf16*)(args.ws + WS_WDN), M, DM, DFF}; pg8::StaticOrder S; S.init(M, DM, C.G, C.bid, WGM_DOWN); \
            pg8::EpiResB<false> E{(const void*)xb, xb, DM}; \
            pg8::gemm_phase<pg8::EpiResB<false>, pg8::StaticOrder, true, true>(C.lds, g, S, E); \
        } \
        SEAM(pb + 10); \
     \
    } while (0)
    LAYER_BODY(0);
    LAYER_BODY(1);
#undef LAYER_BODY
    LAUNDER();
    if (IN(PH_FINAL)) final_norm_phase(C, xb, args.in[I_FINAL_NORM], args.out);
#undef IN
#undef SEAM
}

extern "C" void kernel_launch(void* const* d_in, const int* in_sizes, int n_in, void* d_out, int out_size, void* d_ws, size_t ws_size, hipStream_t stream) {
    static int grid = 0;
    if (grid == 0) {
        if (n_in != N_IN || out_size != M * DM || ws_size < WS_END) { fprintf(stderr, "kernel_launch: unexpected shapes (n_in %d, out %d, ws %zu < %zu)\n", n_in, out_size, ws_size, (size_t)WS_END); grid = -1; return; }
        int dev = 0, cus = 0, per_cu = 0;
        if (hipGetDevice(&dev) != hipSuccess || hipDeviceGetAttribute(&cus, hipDeviceAttributeMultiprocessorCount, dev) != hipSuccess) { grid = -1; return; }
        if (hipFuncSetAttribute((const void*)fwd_kernel, hipFuncAttributeMaxDynamicSharedMemorySize, LDS_BYTES) != hipSuccess) { fprintf(stderr, "kernel_launch: hipFuncSetAttribute failed\n"); grid = -1; return; }
        if (hipOccupancyMaxActiveBlocksPerMultiprocessor(&per_cu, (const void*)fwd_kernel, NTHR, LDS_BYTES) != hipSuccess || per_cu < 1) { fprintf(stderr, "kernel_launch: occupancy query says %d\n", per_cu); (void)hipGetLastError(); grid = -1; return; }
        grid = cus;
    }
    if (grid < 0) return;
    constexpr size_t kZero = (size_t)(CW_BAR + (MK_ONE_LAUNCH ? 1 : N_PHASES) * XCD_BAR_WORDS) * sizeof(unsigned);
    static_assert(kZero <= CTL_BYTES, "control region");
    if (hipMemsetAsync((char*)d_ws + WS_CTL, 0, kZero, stream) != hipSuccess) return;
    Args a{};
    for (int i = 0; i < N_IN; ++i) a.in[i] = (const float*)d_in[i];
    a.out = (float*)d_out; a.ws = (unsigned char*)d_ws; a.pad = 0;
#if MK_ONE_LAUNCH
    a.ph_lo = 0; a.ph_hi = N_PHASES; a.li = 0;
    hipLaunchKernelGGL(fwd_kernel, dim3(grid), dim3(NTHR), LDS_BYTES, stream, a);
#else
    for (int p = 0; p < N_PHASES; ++p) { a.ph_lo = p; a.ph_hi = p + 1; a.li = p;
        hipLaunchKernelGGL(fwd_kernel, dim3(grid), dim3(NTHR), LDS_BYTES, stream, a); }
#endif
}
```

```cpp
#include <hip/hip_runtime.h>
#include <cstdio>
#include <cstdint>
namespace pg8 {
#define PG8_LAS __attribute__((address_space(3)))
typedef unsigned short bf16_t;
typedef short bf16x8 __attribute__((ext_vector_type(8)));
typedef float f32x4 __attribute__((ext_vector_type(4)));
typedef unsigned u32x4 __attribute__((ext_vector_type(4)));
constexpr int BM = 256, BK = 64, HALF = 128, HTB = HALF * BK * 2  , STAGE_BYTES = 8 * HTB, NXCD = 8, WGM = 8;

__host__ __device__ __forceinline__ int lds_byte(int r, int c) { const int st = (r >> 4) * 2 + (c >> 5), rr = r & 15, cc = c & 31, ob = rr * 64 + cc * 2; return st * 1024 + (ob ^ (((ob >> 9) & 1) << 5)); }
__host__ __device__ __forceinline__ void stage_rc(int b, int& R, int& C) { const int st = b / 1024, sb = b % 1024, swz = sb ^ (((sb >> 9) & 1) << 5); R = (st >> 1) * 16 + swz / 64; C = (st & 1) * 32 + (swz % 64) / 2; }
__host__ __device__ __forceinline__ int perm32(int rho) { const int n = rho >> 4, i = rho & 15; return 8 * (i >> 2) + 4 * n + (i & 3); }

struct Unit { int pm, pn; };
struct Gemm { const bf16_t* A; const bf16_t* Bt; int M, N, K; };

struct StaticOrder {
    int nM, nN, nwg, G, c, wgm;
    __host__ __device__ void init(int M, int N, int G_, int c_, int wgm_ = WGM) { nM = M / BM; nN = N / BM; nwg = nM * nN; G = G_; c = c_; wgm = wgm_; }
    __host__ __device__ bool next(int i, Unit& u) const {
        const long L = (long)i * G + c; if (L >= nwg) return false;
        int wgid = (int)L; { const int q = nwg / NXCD, r = nwg % NXCD, xcd = wgid % NXCD, off = wgid / NXCD; wgid = (xcd < r ? xcd * (q + 1) : r * (q + 1) + (xcd - r) * q) + off; }
        const int nig = wgm * nN, gid = wgid / nig, fm = gid * wgm, gsz = (nM - fm) < wgm ? (nM - fm) : wgm;
        u.pm = fm + ((wgid % nig) % gsz); u.pn = (wgid % nig) / gsz; return true;
    }
    __device__ __forceinline__ void a_ready(const Unit&) const {}
    __device__ __forceinline__ void done(const Unit&) const {}
};

typedef float f32x2c __attribute__((ext_vector_type(2)));
typedef __bf16 bf16x2c __attribute__((ext_vector_type(2)));
__device__ __forceinline__ unsigned cvt_pk_bf16(float lo, float hi) { const f32x2c v = {lo, hi}; return __builtin_bit_cast(unsigned, __builtin_convertvector(v, bf16x2c)); }

struct EpiBf16 {
    static constexpr bool PERM = true, AFTER_DRAIN = false;
    bf16_t* O; int ldc;
    __device__ __forceinline__ void operator()(const f32x4 (&acc)[2][2][4][2], const Unit& u, int wr, int wc, int fr, int fq) const {
        const int row0 = u.pm * BM + wr * 64 + fr; const int col0 = u.pn * BM + wc * 32 + 8 * fq;
#pragma unroll
        for (int ai = 0; ai < 2; ++ai)
#pragma unroll
            for (int m = 0; m < 4; ++m) { bf16_t* rowp = O + (size_t)(row0 + ai * HALF + m * 16) * ldc + col0;
#pragma unroll
                for (int bj = 0; bj < 2; ++bj) { const f32x4 v0 = acc[ai][bj][m][0], v1 = acc[ai][bj][m][1];
                    u32x4 w; w.x = cvt_pk_bf16(v0[0], v0[1]); w.y = cvt_pk_bf16(v0[2], v0[3]); w.z = cvt_pk_bf16(v1[0], v1[1]); w.w = cvt_pk_bf16(v1[2], v1[3]);
                    *(u32x4*)(rowp + bj * HALF) = w; } }
    }
};
template <int CTRL> __device__ __forceinline__ float dpp_old(float old, float v) { return __int_as_float(__builtin_amdgcn_update_dpp(__float_as_int(old), __float_as_int(v), CTRL, 0xf, 0xf, false)); }
template <int CTRL> __device__ __forceinline__ float dpp_ror(float v) { return __int_as_float(__builtin_amdgcn_mov_dpp(__float_as_int(v), CTRL, 0xf, 0xf, true)); }
struct EpiGateUp {
    static constexpr bool PERM = true, AFTER_DRAIN = false;
    bf16_t* ACT; const float* cw; const float* cb; float* HTG; float* HTU; float* HBG; int dff;
    __device__ __forceinline__ void operator()(const f32x4 (&acc)[2][2][4][2], const Unit& u, int wr, int wc, int fr, int fq) const {
        const int j0 = u.pn * 128 + wc * 32 + 8 * fq;
        float w0[8], w1[8], w2[8], bb[8];
#pragma unroll
        for (int h = 0; h < 2; ++h) { const f32x4 a = *(const f32x4*)(cw + j0 + 4 * h), b = *(const f32x4*)(cw + dff + j0 + 4 * h), c = *(const f32x4*)(cw + 2 * dff + j0 + 4 * h), d = *(const f32x4*)(cb + j0 + 4 * h);
#pragma unroll
            for (int e = 0; e < 4; ++e) { w0[4 * h + e] = a[e]; w1[4 * h + e] = b[e]; w2[4 * h + e] = c[e]; bb[4 * h + e] = d[e]; } }
#pragma unroll
        for (int ai = 0; ai < 2; ++ai) {
            const int rowb = u.pm * BM + ai * HALF + wr * 64; const size_t blk = (size_t)(rowb >> 6);
#pragma unroll
            for (int m = 0; m < 4; ++m) {
                const int row = rowb + 16 * m + fr; float o[8];
#pragma unroll
                for (int n = 0; n < 2; ++n)
#pragma unroll
                    for (int e = 0; e < 4; ++e) { const int k = 4 * n + e; const float g0 = acc[ai][0][m][n][e], up = acc[ai][1][m][n][e]; const float gp = acc[ai][0][m > 0 ? m - 1 : 0][n][e];
                        const float g1 = dpp_ror<0x121>(m > 0 && fr == 15 ? gp : g0), g2 = dpp_ror<0x122>(m > 0 && fr >= 14 ? gp : g0);
                        const float gc = bb[k] + w0[k] * g2 + w1[k] * g1 + w2[k] * g0; o[k] = gc * __builtin_amdgcn_rcpf(1.f + __expf(-gc)) * up; }
                u32x4 w; w.x = cvt_pk_bf16(o[0], o[1]); w.y = cvt_pk_bf16(o[2], o[3]); w.z = cvt_pk_bf16(o[4], o[5]); w.w = cvt_pk_bf16(o[6], o[7]);
                if (!(m == 0 && fr < 2)) __builtin_nontemporal_store(w, (u32x4*)(ACT + (size_t)row * dff + j0));
                if (m == 0 && fr < 2) { float* pg = HTG + (blk * 2 + fr) * dff + j0; float* pu = HTU + (blk * 2 + fr) * dff + j0;
                    *(f32x4*)pg = acc[ai][0][0][0]; *(f32x4*)(pg + 4) = acc[ai][0][0][1]; *(f32x4*)pu = acc[ai][1][0][0]; *(f32x4*)(pu + 4) = acc[ai][1][0][1]; }
                if (m == 3 && fr >= 14) { float* pg = HBG + (blk * 2 + (fr - 14)) * dff + j0; *(f32x4*)pg = acc[ai][0][3][0]; *(f32x4*)(pg + 4) = acc[ai][0][3][1]; }
            }
        }
    }
};
struct EpiProjConv {
    static constexpr bool PERM = true, AFTER_DRAIN = false;
    bf16_t* O; int ldc; bf16_t* XBC; const float* cw; const float* cb; float* HT; float* HB;
    __device__ __forceinline__ void operator()(const f32x4 (&acc)[2][2][4][2], const Unit& u, int wr, int wc, int fr, int fq) const {
        if (u.pn < 8 || u.pn >= 24) {
            const int row0 = u.pm * BM + wr * 64 + fr; const int col0 = u.pn * BM + wc * 32 + 8 * fq;
#pragma unroll
            for (int ai = 0; ai < 2; ++ai)
#pragma unroll
                for (int m = 0; m < 4; ++m) { bf16_t* rowp = O + (size_t)(row0 + ai * HALF + m * 16) * ldc + col0;
#pragma unroll
                    for (int bj = 0; bj < 2; ++bj) { const f32x4 v0 = acc[ai][bj][m][0], v1 = acc[ai][bj][m][1];
                        u32x4 w; w.x = cvt_pk_bf16(v0[0], v0[1]); w.y = cvt_pk_bf16(v0[2], v0[3]); w.z = cvt_pk_bf16(v1[0], v1[1]); w.w = cvt_pk_bf16(v1[2], v1[3]);
                        __builtin_nontemporal_store(w, (u32x4*)(rowp + bj * HALF)); } }
            return;
        }
#pragma unroll
        for (int bj = 0; bj < 2; ++bj) {
            const int c0 = (u.pn - 8) * BM + bj * HALF + wc * 32 + 8 * fq;
            float wv[4][8], bb[8];
#pragma unroll
            for (int h = 0; h < 2; ++h) { const f32x4 d = *(const f32x4*)(cb + c0 + 4 * h);
#pragma unroll
                for (int e = 0; e < 4; ++e) bb[4 * h + e] = d[e];
#pragma unroll
                for (int i = 0; i < 4; ++i) { const f32x4 a = *(const f32x4*)(cw + i * 4096 + c0 + 4 * h);
#pragma unroll
                    for (int e = 0; e < 4; ++e) wv[i][4 * h + e] = a[e]; } }
#pragma unroll
            for (int ai = 0; ai < 2; ++ai) {
                const int rowb = u.pm * BM + ai * HALF + wr * 64; const size_t blk = (size_t)(rowb >> 6);
#pragma unroll
                for (int m = 0; m < 4; ++m) {
                    const int row = rowb + 16 * m + fr; float o[8];
#pragma unroll
                    for (int n = 0; n < 2; ++n)
#pragma unroll
                        for (int e = 0; e < 4; ++e) { const int k = 4 * n + e; const float x0 = acc[ai][bj][m][n][e]; const float xp = acc[ai][bj][m > 0 ? m - 1 : 0][n][e];
                            const float x1 = dpp_ror<0x121>(m > 0 && fr == 15 ? xp : x0), x2 = dpp_ror<0x122>(m > 0 && fr >= 14 ? xp : x0), x3 = dpp_ror<0x123>(m > 0 && fr >= 13 ? xp : x0);
                            const float a = bb[k] + wv[0][k] * x3 + wv[1][k] * x2 + wv[2][k] * x1 + wv[3][k] * x0; o[k] = a * __builtin_amdgcn_rcpf(1.f + __expf(-a)); }
                    u32x4 w; w.x = cvt_pk_bf16(o[0], o[1]); w.y = cvt_pk_bf16(o[2], o[3]); w.z = cvt_pk_bf16(o[4], o[5]); w.w = cvt_pk_bf16(o[6], o[7]);
                    if (!(m == 0 && fr < 3)) __builtin_nontemporal_store(w, (u32x4*)(XBC + (size_t)row * 4096 + c0));
                    if (m == 0 && fr < 3) { float* p = HT + (blk * 3 + fr) * 4096 + c0; *(f32x4*)p = acc[ai][bj][0][0]; *(f32x4*)(p + 4) = acc[ai][bj][0][1]; }
                    if (m == 3 && fr >= 13) { float* p = HB + (blk * 3 + (fr - 13)) * 4096 + c0; *(f32x4*)p = acc[ai][bj][3][0]; *(f32x4*)(p + 4) = acc[ai][bj][3][1]; }
                }
            }
        }
    }
};
struct EpiRes {
    static constexpr bool PERM = false, AFTER_DRAIN = false;
    const float* base; float* out; int ldc;
    __device__ __forceinline__ void operator()(const f32x4 (&acc)[2][2][4][2], const Unit& u, int wr, int wc, int fr, int fq) const {
        const int row0 = u.pm * BM + wr * 64 + fr, col0 = u.pn * BM + wc * 32 + 4 * fq;
#pragma unroll
        for (int ai = 0; ai < 2; ++ai)
#pragma unroll
            for (int m = 0; m < 4; ++m) { const size_t off = (size_t)(row0 + ai * HALF + m * 16) * ldc + col0;
#pragma unroll
                for (int bj = 0; bj < 2; ++bj)
#pragma unroll
                    for (int n = 0; n < 2; ++n) { const f32x4 bs = *(const f32x4*)(base + off + bj * HALF + n * 16); *(f32x4*)(out + off + bj * HALF + n * 16) = bs + acc[ai][bj][m][n]; } }
    }
};
template <bool BASE_F32> struct EpiResB {
    static constexpr bool PERM = true, AFTER_DRAIN = false;
    const void* base; bf16_t* out; int ldc;
    __device__ __forceinline__ void operator()(const f32x4 (&acc)[2][2][4][2], const Unit& u, int wr, int wc, int fr, int fq) const {
        const int row0 = u.pm * BM + wr * 64 + fr, col0 = u.pn * BM + wc * 32 + 8 * fq;
#pragma unroll
        for (int ai = 0; ai < 2; ++ai)
#pragma unroll
            for (int m = 0; m < 4; ++m) { const size_t off = (size_t)(row0 + ai * HALF + m * 16) * ldc + col0;
#pragma unroll
                for (int bj = 0; bj < 2; ++bj) { f32x4 b0, b1;
                    if (BASE_F32) { const float* bp = (const float*)base + off + bj * HALF; b0 = *(const f32x4*)bp; b1 = *(const f32x4*)(bp + 4); }
                    else { const u32x4 w = *(const u32x4*)((const bf16_t*)base + off + bj * HALF);
                        b0 = (f32x4){__uint_as_float(w.x << 16), __uint_as_float(w.x & 0xffff0000u), __uint_as_float(w.y << 16), __uint_as_float(w.y & 0xffff0000u)};
                        b1 = (f32x4){__uint_as_float(w.z << 16), __uint_as_float(w.z & 0xffff0000u), __uint_as_float(w.w << 16), __uint_as_float(w.w & 0xffff0000u)}; }
                    const f32x4 o0 = b0 + acc[ai][bj][m][0], o1 = b1 + acc[ai][bj][m][1];
                    u32x4 ow; ow.x = cvt_pk_bf16(o0[0], o0[1]); ow.y = cvt_pk_bf16(o0[2], o0[3]); ow.z = cvt_pk_bf16(o1[0], o1[1]); ow.w = cvt_pk_bf16(o1[2], o1[3]);
                    *(u32x4*)(out + off + bj * HALF) = ow; } }
    }
};
template <class Epi, class Sched, bool ALIGN_EPI = false, bool SP2 = false>
__device__ __forceinline__ void gemm_phase(PG8_LAS unsigned char* lds, const Gemm g, const Sched& S, const Epi& E) {
    const int tid = threadIdx.x, wid = __builtin_amdgcn_readfirstlane(tid >> 6), lane = tid & 63, wr = wid >> 2, wc = wid & 3, fr = lane & 15, fq = lane >> 4;
    const int K = g.K, nt = K / BK;
    unsigned voffA[2], voffB[2];
#pragma unroll
    for (int i = 0; i < 2; ++i) { int R, C; stage_rc(tid * 16 + i * 8192, R, C); const int Rb = Epi::PERM ? ((R & ~31) + perm32(R & 31)) : R;
        voffA[i] = (unsigned)(R * K + C) * 2u; voffB[i] = (unsigned)(Rb * K + C) * 2u; }
    const size_t kstep = (size_t)(BK * 2);
    const size_t hstep = (size_t)HALF * K * 2;
    const size_t tstep = 2 * hstep;
    const unsigned ldsw = (unsigned)wid * 1024u;
    const int aoff = lds_byte(wr * 64 + fr, fq * 8), boff = lds_byte(wc * 32 + fr, fq * 8);
#define PG8_SA(b, h) (((b) * 2 + (h)) * HTB)
#define PG8_SB(b, h) ((4 + (b) * 2 + (h)) * HTB)
#define PG8_STAGE(bufoff, gbase, voff) do { _Pragma("unroll") for (int _i = 0; _i < 2; ++_i) \
        __builtin_amdgcn_global_load_lds((const unsigned*)((const char*)(gbase) + (voff)[_i]), (PG8_LAS unsigned*)(lds + (bufoff) + ldsw + _i * 8192), 16, 0, 0); } while (0)
#define PG8_LDA(dst, b, h) do { _Pragma("unroll") for (int m = 0; m < 4; ++m) _Pragma("unroll") for (int k = 0; k < 2; ++k) dst[m][k] = *(const PG8_LAS bf16x8*)(lds + PG8_SA(b, h) + aoff + m * 2048 + k * 1024); } while (0)
#define PG8_LDB(dst, b, h) do { _Pragma("unroll") for (int n = 0; n < 2; ++n) _Pragma("unroll") for (int k = 0; k < 2; ++k) dst[n][k] = *(const PG8_LAS bf16x8*)(lds + PG8_SB(b, h) + boff + n * 2048 + k * 1024); } while (0)
#define PG8_MMA(ai, bj, At, Bt) do { __builtin_amdgcn_s_setprio(1); _Pragma("unroll") for (int m = 0; m < 4; ++m) _Pragma("unroll") for (int n = 0; n < 2; ++n) _Pragma("unroll") for (int k = 0; k < 2; ++k) \
        acc[ai][bj][m][n] = __builtin_amdgcn_mfma_f32_16x16x32_bf16(Bt[n][k], At[m][k], acc[ai][bj][m][n], 0, 0, 0); __builtin_amdgcn_s_setprio(0); } while (0)
#define PG8_WAIT_V(n) asm volatile("s_waitcnt vmcnt(" #n ")" ::: "memory")
#define PG8_WAIT_L(n) asm volatile("s_waitcnt lgkmcnt(" #n ")" ::: "memory")
#define PG8_BAR __builtin_amdgcn_s_barrier()
#define PG8_SCHED __builtin_amdgcn_sched_barrier(0)
    Unit cur, nxt; int ui = 0;
    if (!S.next(0, cur)) return;
    f32x4 acc[2][2][4][2];
#pragma unroll
    for (int a = 0; a < 2; ++a)
#pragma unroll
        for (int b = 0; b < 2; ++b)
#pragma unroll
            for (int m = 0; m < 4; ++m)
#pragma unroll
                for (int n = 0; n < 2; ++n) acc[a][b][m][n] = (f32x4){0.f, 0.f, 0.f, 0.f};
    bf16x8 At[4][2], B0[2][2], B1[2][2];
    const char* cA = (const char*)g.A + (size_t)cur.pm * tstep; const char* cB = (const char*)g.Bt + (size_t)cur.pn * tstep;
    S.a_ready(cur);
    if constexpr (SP2) {
        PG8_STAGE(PG8_SB(0, 0), cB, voffB); PG8_STAGE(PG8_SB(0, 1), cB + hstep, voffB); PG8_STAGE(PG8_SA(0, 0), cA, voffA); PG8_STAGE(PG8_SA(0, 1), cA + hstep, voffA);
        if (wr == 1) PG8_BAR;
        PG8_WAIT_V(2); PG8_BAR;
        PG8_STAGE(PG8_SB(1, 0), cB + kstep, voffB); PG8_STAGE(PG8_SA(1, 0), cA + kstep, voffA); PG8_STAGE(PG8_SB(1, 1), cB + hstep + kstep, voffB);
        PG8_WAIT_V(6); PG8_BAR;
    } else {
        PG8_STAGE(PG8_SB(0, 0), cB, voffB); PG8_STAGE(PG8_SA(0, 0), cA, voffA); PG8_STAGE(PG8_SB(0, 1), cB + hstep, voffB); PG8_STAGE(PG8_SA(0, 1), cA + hstep, voffA);
        if (wr == 1) PG8_BAR;
        PG8_WAIT_V(4); PG8_BAR;
        PG8_STAGE(PG8_SB(1, 0), cB + kstep, voffB); PG8_STAGE(PG8_SA(1, 0), cA + kstep, voffA); PG8_STAGE(PG8_SB(1, 1), cB + hstep + kstep, voffB);
        PG8_WAIT_V(6); PG8_BAR;
    }
    for (;;) {
        const bool has_next = S.next(ui + 1, nxt);
        const char* nA = has_next ? (const char*)g.A + (size_t)nxt.pm * tstep : cA; const char* nB = has_next ? (const char*)g.Bt + (size_t)nxt.pn * tstep : cB;
        for (int t = 0; t < nt; t += 2) {
            const bool last = (t == nt - 2);
            const char* a1 = cA + (size_t)(t + 1) * kstep;
            const char* a2 = last ? nA : cA + (size_t)(t + 2) * kstep; const char* b2 = last ? nB : cB + (size_t)(t + 2) * kstep;
            const char* a3 = a2 + kstep; const char* b3 = b2 + kstep;
            if (last && has_next) S.a_ready(nxt);
            if constexpr (SP2) {
            PG8_LDB(B0, 0, 0); PG8_LDB(B1, 0, 1); PG8_SCHED; PG8_LDA(At, 0, 0); PG8_STAGE(PG8_SA(1, 1), a1 + hstep, voffA);
            PG8_WAIT_V(8); PG8_WAIT_L(0); PG8_BAR; PG8_MMA(0, 0, At, B0); PG8_MMA(0, 1, At, B1); PG8_BAR; PG8_SCHED;
            PG8_LDA(At, 0, 1); PG8_STAGE(PG8_SB(0, 0), b2, voffB); PG8_STAGE(PG8_SB(0, 1), b2 + hstep, voffB); PG8_STAGE(PG8_SA(0, 0), a2, voffA);
            PG8_WAIT_V(8); PG8_WAIT_L(0); PG8_BAR; PG8_MMA(1, 0, At, B0); PG8_MMA(1, 1, At, B1); PG8_BAR; PG8_SCHED;
            PG8_LDB(B0, 1, 0); PG8_LDB(B1, 1, 1); PG8_SCHED; PG8_LDA(At, 1, 0); PG8_STAGE(PG8_SA(0, 1), a2 + hstep, voffA);
            PG8_WAIT_V(8); PG8_WAIT_L(0); PG8_BAR; PG8_MMA(0, 0, At, B0); PG8_MMA(0, 1, At, B1); PG8_BAR; PG8_SCHED;
            PG8_LDA(At, 1, 1); PG8_STAGE(PG8_SB(1, 0), b3, voffB); PG8_STAGE(PG8_SB(1, 1), b3 + hstep, voffB); PG8_STAGE(PG8_SA(1, 0), a3, voffA);
            PG8_WAIT_V(8); PG8_WAIT_L(0); PG8_BAR; PG8_MMA(1, 0, At, B0); PG8_MMA(1, 1, At, B1); PG8_BAR; PG8_SCHED;
            } else {
            PG8_LDB(B0, 0, 0); PG8_SCHED; PG8_LDA(At, 0, 0); PG8_STAGE(PG8_SA(1, 1), a1 + hstep, voffA);
            PG8_WAIT_L(8); PG8_BAR; PG8_WAIT_L(0); PG8_MMA(0, 0, At, B0); PG8_BAR; PG8_SCHED;
            PG8_LDB(B1, 0, 1); PG8_STAGE(PG8_SB(0, 0), b2, voffB);
            PG8_BAR; PG8_WAIT_L(0); PG8_MMA(0, 1, At, B1); PG8_BAR;
            PG8_LDA(At, 0, 1); PG8_STAGE(PG8_SA(0, 0), a2, voffA);
            PG8_BAR; PG8_WAIT_L(0); PG8_MMA(1, 0, At, B0); PG8_BAR; PG8_SCHED;
            PG8_STAGE(PG8_SB(0, 1), b2 + hstep, voffB);
            PG8_WAIT_V(6); PG8_BAR; PG8_MMA(1, 1, At, B1); PG8_BAR;
            PG8_LDB(B0, 1, 0); PG8_SCHED; PG8_LDA(At, 1, 0); PG8_STAGE(PG8_SA(0, 1), a2 + hstep, voffA);
            PG8_WAIT_L(8); PG8_BAR; PG8_WAIT_L(0); PG8_MMA(0, 0, At, B0); PG8_BAR; PG8_SCHED;
            PG8_LDB(B1, 1, 1); PG8_STAGE(PG8_SB(1, 0), b3, voffB);
            PG8_BAR; PG8_WAIT_L(0); PG8_MMA(0, 1, At, B1); PG8_BAR;
            PG8_LDA(At, 1, 1); PG8_STAGE(PG8_SA(1, 0), a3, voffA);
            PG8_BAR; PG8_WAIT_L(0); PG8_MMA(1, 0, At, B0); PG8_BAR; PG8_SCHED;
            PG8_STAGE(PG8_SB(1, 1), b3 + hstep, voffB);
            PG8_WAIT_V(6); PG8_BAR; PG8_MMA(1, 1, At, B1); PG8_BAR;
            }
        }
        if constexpr (ALIGN_EPI) { if (wr == 0) PG8_BAR; }
        if constexpr (!Epi::AFTER_DRAIN) { E(acc, cur, wr, wc, fr, fq); S.done(cur); }
        if (!has_next) break;
#pragma unroll
        for (int a = 0; a < 2; ++a)
#pragma unroll
            for (int b = 0; b < 2; ++b)
#pragma unroll
                for (int m = 0; m < 4; ++m)
#pragma unroll
                    for (int n = 0; n < 2; ++n) acc[a][b][m][n] = (f32x4){0.f, 0.f, 0.f, 0.f};
        cur = nxt; cA = nA; cB = nB; ++ui;
        if constexpr (ALIGN_EPI) { if (wr == 1) PG8_BAR; }
    }
    PG8_WAIT_V(0);
    if constexpr (!ALIGN_EPI) { if (wr == 0) PG8_BAR; }
    PG8_BAR;
    if constexpr (Epi::AFTER_DRAIN) { E.fused(acc, cur, wr, wc, fr, fq, lds, wid, lane); S.done(cur); }
#undef PG8_SA
#undef PG8_SB
#undef PG8_STAGE
#undef PG8_LDA
#undef PG8_LDB
#undef PG8_MMA
#undef PG8_WAIT_V
#undef PG8_WAIT_L
#undef PG8_BAR
#undef PG8_SCHED
}
}

constexpr int NWAVES = 8, NTHR = NWAVES * 64;
constexpr int BATCH = 2, SEQ = 8192, M = BATCH * SEQ, DM = 4096, DEPTH = 2;
constexpr int SSD_W = 2048, SSD_H = 32, SSD_CD = 4096;
constexpr int SWA_W = 1024, SWA_H = 16;
constexpr int GLA_W = 1024, GLA_KT = 512;
constexpr int DFF = 11008, DIN = 10800, DINP = 11008, DGU = 2 * DFF;
constexpr float EPS = 1e-6f;
constexpr int C_Z = 0, C_XBC = 2048, C_DT = 6144, C_SQ = 6176, C_SK = 7200, C_SV = 7456, C_GQ = 7712, C_GK = 8224, C_GV = 8736, C_GG = 9760, C_GLR = 10784;
enum { I_X = 0, I_ATTN_NORM, I_W_IN, I_SSD_CONV_W, I_SSD_CONV_B, I_SSD_DT_BIAS, I_SSD_A_LOG, I_SSD_D, I_SSD_NORM, I_SWA_SINKS, I_SWA_NORM, I_GLA_W_GATE, I_GLA_B_GATE, I_GLA_NORM,
       I_W_OUT, I_FFN_NORM, I_W_GATE, I_W_UP, I_FFN_CONV_W, I_FFN_CONV_B, I_W_DOWN, I_REL_BIAS, I_FINAL_NORM, N_IN };

constexpr size_t MiB = 1u << 20;
constexpr size_t WS_CTL = 0, CTL_BYTES = 1 * MiB;
constexpr size_t WS_WIN = 1 * MiB;
constexpr size_t WS_WOUT = 87 * MiB;
constexpr size_t WS_WGU = 119 * MiB;
constexpr size_t WS_WDN = 291 * MiB;
constexpr size_t WS_H = 377 * MiB;
constexpr size_t WS_R = 505 * MiB;
constexpr size_t WS_PROJ = WS_R;
constexpr size_t WS_XBC = WS_R + 344 * MiB;
constexpr size_t WS_QD = WS_R + 472 * MiB;
constexpr size_t WS_KI = WS_R + 488 * MiB;
constexpr size_t WS_DT = WS_R + 520 * MiB;
constexpr size_t WS_ACS = WS_R + 522 * MiB;
constexpr size_t WS_DEC = WS_R + 524 * MiB;
constexpr size_t WS_GDEC = WS_R + 525 * MiB;
constexpr size_t WS_ST = WS_R + 528 * MiB;
constexpr size_t WS_PV = WS_R + 592 * MiB;
constexpr size_t WS_GST = WS_R + 656 * MiB;
constexpr size_t WS_GPV = WS_R + 720 * MiB;
constexpr size_t WS_OSWA = WS_R + 784 * MiB;
constexpr size_t WS_Y = WS_R + 816 * MiB;
constexpr size_t WS_XHT = WS_R + 504 * MiB, WS_XHB = WS_R + 944 * MiB;
constexpr size_t WS_XB = WS_R + 956 * MiB;
constexpr size_t WS_ACT = WS_R;
constexpr size_t WS_HTG = WS_R + 344 * MiB, WS_HTU = WS_R + 366 * MiB, WS_HBG = WS_R + 388 * MiB;
constexpr size_t WS_END = WS_R + 1084 * MiB;
static_assert(DEPTH == 2 && (size_t)DINP * DM * 2 == 86 * MiB && (size_t)DGU * DM * 2 == 172 * MiB && (size_t)M * DINP * 2 == 344 * MiB , "ws map");
constexpr int CW_BAR = 4096;

constexpr int RING_BYTES = 131072;
constexpr int MISC_OFF = 147456 - 256;
constexpr int LDS_BYTES = 147456;

#define GAS __attribute__((address_space(1)))
#define LAS __attribute__((address_space(3)))
typedef unsigned short bf16;
typedef unsigned v4u __attribute__((ext_vector_type(4)));
typedef unsigned v2u __attribute__((ext_vector_type(2)));
typedef float f32x4 __attribute__((ext_vector_type(4)));
typedef GAS unsigned gu32;
typedef float f32x2c __attribute__((ext_vector_type(2)));
#define RLX_AGENT __ATOMIC_RELAXED, __HIP_MEMORY_SCOPE_AGENT
#define LDS_WAIT() asm volatile("s_waitcnt lgkmcnt(0)" ::: "memory")
__device__ __forceinline__ unsigned f2bf(float f) { unsigned u = __builtin_bit_cast(unsigned, f); return (u + 0x7fffu + ((u >> 16) & 1u)) >> 16; }
__device__ __forceinline__ unsigned pk2(float lo, float hi) { return pg8::cvt_pk_bf16(lo, hi); }
__device__ __forceinline__ float bflo(unsigned w) { return __uint_as_float(w << 16); }
__device__ __forceinline__ float bfhi(unsigned w) { return __uint_as_float(w & 0xffff0000u); }
__device__ __forceinline__ float bf1(bf16 h) { return __uint_as_float((unsigned)h << 16); }
__device__ __forceinline__ float silu_f(float x) { return x * __builtin_amdgcn_rcpf(1.f + __expf(-x)); }
__device__ __forceinline__ float wave_sum(float v) {
#pragma unroll
    for (int o = 1; o < 64; o <<= 1) v += __shfl_xor(v, o);
    return v;
}
template <int CTRL> __device__ __forceinline__ float dpp_f(float v) { return __int_as_float(__builtin_amdgcn_update_dpp(0, __float_as_int(v), CTRL, 0xf, 0xf, false)); }
__device__ __forceinline__ float row16_sum(float v) { v += dpp_f<0xB1>(v); v += dpp_f<0x4E>(v); v += dpp_f<0x124>(v); v += dpp_f<0x128>(v); return v; }
__device__ __forceinline__ float pair_sum(float v) { return v + dpp_f<0xB1>(v); }
#define XB_TMO      128
#define XB_XCNT(j)  (256  + 64 * (j))
#define XB_XSUB(j)  (1280 + 64 * (j))
#define XB_XGEN(j)  (2304 + 64 * (j))
#define XB_TOP      3328
#define XB_TOPGEN   3392
#define XCD_BAR_WORDS 3456
#define XB_SPIN_CAP (1u << 18)

__device__ __forceinline__ unsigned xb_ld(unsigned* p)              { return __hip_atomic_load(p, __ATOMIC_RELAXED, __HIP_MEMORY_SCOPE_AGENT); }
__device__ __forceinline__ unsigned xb_add(unsigned* p, unsigned v) { return __hip_atomic_fetch_add(p, v, __ATOMIC_RELAXED, __HIP_MEMORY_SCOPE_AGENT); }
__device__ __forceinline__ unsigned xb_xcc_id() { return (unsigned)__builtin_amdgcn_s_getreg((3 << 11) | 20) & 0xFu; }
#define XB_SPIN(cond, bar) do { unsigned _sp = 0; while (cond) { __builtin_amdgcn_s_sleep(1); \
    if ((++_sp & 255u) == 0u) { if (xb_ld(&(bar)[XB_TMO])) break; if (_sp > XB_SPIN_CAP) { atomicAdd(&(bar)[XB_TMO], 1u); break; } } } } while (0)

struct XcdBarrier {
    unsigned* bar; unsigned x;
    volatile LAS unsigned* st;
};

__device__ __forceinline__ XcdBarrier xcd_barrier_post(unsigned* bar, volatile LAS unsigned* st) {
    XcdBarrier b; b.bar = bar; b.x = xb_xcc_id(); b.st = st;
    if (threadIdx.x == 0) (void)xb_add(&bar[XB_XCNT(b.x)], 1u);
    return b;
}
__device__ __forceinline__ void xcd_barrier_complete(unsigned* bar, unsigned x, unsigned& nloc, unsigned& nx) {
    const unsigned G = gridDim.x * gridDim.y * gridDim.z;
    unsigned sum, cnt, mine, sp = 0u;
    for (;;) {
        sum = 0u; cnt = 0u; mine = 0u;
#pragma unroll
        for (unsigned j = 0; j < 16; ++j) { const unsigned c = xb_ld(&bar[XB_XCNT(j)]); sum += c; cnt += (c > 0u) ? 1u : 0u; mine = (j == x) ? c : mine; }
        if (sum == G) break;
        __builtin_amdgcn_s_sleep(1);
        if ((++sp & 255u) == 0u) { if (xb_ld(&bar[XB_TMO])) break; if (sp > XB_SPIN_CAP) { atomicAdd(&bar[XB_TMO], 1u); break; } }
    }
    nloc = mine > 0u ? mine : 1u; nx = cnt > 0u ? cnt : 1u;
}

__device__ __forceinline__ void xcd_barrier(const XcdBarrier& b) {
    asm volatile("s_waitcnt vmcnt(0)" ::: "memory");
    __syncthreads();
    if (threadIdx.x == 0) {
        unsigned* bar = b.bar;
        __builtin_amdgcn_s_waitcnt(0);
        unsigned nloc = b.st[0], nx = b.st[1];
        if (nloc == 0u) { xcd_barrier_complete(bar, b.x, nloc, nx); b.st[0] = nloc; b.st[1] = nx; }
        const unsigned old = xb_add(&bar[XB_XSUB(b.x)], 1u);
        const unsigned gen = old / nloc;
        if (old + 1u == (gen + 1u) * nloc) {
            __builtin_amdgcn_fence(__ATOMIC_RELEASE, "agent");
            asm volatile("s_waitcnt vmcnt(0)" ::: "memory");
            const unsigned og = xb_add(&bar[XB_TOP], 1u);
            const unsigned tg = og / nx;
            if (og + 1u == (tg + 1u) * nx) xb_add(&bar[XB_TOPGEN], 1u);
            else XB_SPIN(xb_ld(&bar[XB_TOPGEN]) == tg, bar);
            __builtin_amdgcn_fence(__ATOMIC_ACQUIRE, "agent");
            xb_add(&bar[XB_XGEN(b.x)], 1u);
            asm volatile("s_waitcnt vmcnt(0)" ::: "memory");
        } else {
            XB_SPIN(xb_ld(&bar[XB_XGEN(b.x)]) == gen, bar);
            __builtin_amdgcn_fence(__ATOMIC_ACQUIRE, "agent");
            asm volatile("s_waitcnt vmcnt(0)" ::: "memory");
        }
    }
    __syncthreads();
}

__device__ __forceinline__ void xcd_barrier_arrive(const XcdBarrier& b) {
    asm volatile("s_waitcnt vmcnt(0)" ::: "memory");
    __syncthreads();
    if (threadIdx.x == 0) {
        unsigned* bar = b.bar;
        __builtin_amdgcn_s_waitcnt(0);
        unsigned nloc = b.st[0], nx = b.st[1];
        if (nloc == 0u) { xcd_barrier_complete(bar, b.x, nloc, nx); b.st[0] = nloc; b.st[1] = nx; }
        const unsigned old = xb_add(&bar[XB_XSUB(b.x)], 1u);
        const unsigned gen = old / nloc;
        unsigned role = 0u, tg = 0u;
        if (old + 1u == (gen + 1u) * nloc) {
            __builtin_amdgcn_fence(__ATOMIC_RELEASE, "agent");
            asm volatile("s_waitcnt vmcnt(0)" ::: "memory");
            const unsigned og = xb_add(&bar[XB_TOP], 1u);
            tg = og / nx;
            if (og + 1u == (tg + 1u) * nx) { xb_add(&bar[XB_TOPGEN], 1u); role = 2u; } else role = 1u;
        }
        b.st[2] = gen; b.st[3] = role; b.st[4] = tg;
    }
}
__device__ __forceinline__ void xcd_barrier_wait(const XcdBarrier& b) {
    if (threadIdx.x == 0) {
        unsigned* bar = b.bar;
        const unsigned gen = b.st[2], role = b.st[3], tg = b.st[4];
        if (role != 0u) {
            if (role == 1u) XB_SPIN(xb_ld(&bar[XB_TOPGEN]) == tg, bar);
            __builtin_amdgcn_fence(__ATOMIC_ACQUIRE, "agent");
            xb_add(&bar[XB_XGEN(b.x)], 1u);
            asm volatile("s_waitcnt vmcnt(0)" ::: "memory");
        } else {
            XB_SPIN(xb_ld(&bar[XB_XGEN(b.x)]) == gen, bar);
            __builtin_amdgcn_fence(__ATOMIC_ACQUIRE, "agent");
            asm volatile("s_waitcnt vmcnt(0)" ::: "memory");
        }
    }
    __syncthreads();
}

struct Args { const float* in[N_IN]; float* out; unsigned char* ws; int ph_lo, ph_hi, li, pad; };
struct Ctx {
    LAS unsigned char* lds;
    int tid, lane, wave, G, bid;
    const float* const* in; float* out; unsigned char* ws;
};
__device__ const unsigned char T5_BUCKET[128] = {0, 1, 2, 3, 4, 5, 6, 7, 8, 9, 10, 11, 12, 13, 14, 15, 16, 16, 16, 17, 17, 18, 18, 18, 19, 19, 19, 20, 20, 20, 20, 21, 21, 21, 21, 22, 22, 22, 22, 22, 23, 23, 23, 23, 23, 23, 24, 24, 24, 24, 24, 24, 25, 25, 25, 25, 25, 25, 25, 26, 26, 26, 26, 26, 26, 26, 26, 27, 27, 27, 27, 27, 27, 27, 27, 27, 27, 28, 28, 28, 28, 28, 28, 28, 28, 28, 28, 29, 29, 29, 29, 29, 29, 29, 29, 29, 29, 29, 29, 30, 30, 30, 30, 30, 30, 30, 30, 30, 30, 30, 30, 30, 30, 31, 31, 31, 31, 31, 31, 31, 31, 31, 31, 31, 31, 31, 31, 31};

struct TItem { const float* src; bf16* dst; int N, K, nvalid; };
constexpr int CV_NITEMS = 32 * 86 * 3 + 32 * 32 + 86 * 32;
__device__ __forceinline__ TItem titem_decode(Ctx& C, int l, int it) {
    constexpr int I_IN = 32 * 86, I_OUT = 32 * 32, I_G = 32 * 86;
    TItem t; int r = it, kb, nb;
    if (r < I_IN) { kb = r / 86; nb = r % 86; t.N = DIN; t.K = DM; t.src = C.in[I_W_IN] + (size_t)l * DM * DIN; t.dst = (bf16*)(C.ws + WS_WIN) + (size_t)(128 * nb) * DM; }
    else if ((r -= I_IN) < I_OUT) { kb = r / 32; nb = r % 32; t.N = DM; t.K = DM; t.src = C.in[I_W_OUT] + (size_t)l * DM * DM; t.dst = (bf16*)(C.ws + WS_WOUT) + (size_t)(128 * nb) * DM; }
    else if ((r -= I_OUT) < I_G) { kb = r / 86; nb = r % 86; t.N = DFF; t.K = DM; t.src = C.in[I_W_GATE] + (size_t)l * DM * DFF; t.dst = (bf16*)(C.ws + WS_WGU) + (size_t)(256 * nb) * DM; }
    else if ((r -= I_G) < I_G) { kb = r / 86; nb = r % 86; t.N = DFF; t.K = DM; t.src = C.in[I_W_UP] + (size_t)l * DM * DFF; t.dst = (bf16*)(C.ws + WS_WGU) + (size_t)(256 * nb + 128) * DM; }
    else { r -= I_G; kb = r / 32; nb = r % 32; t.N = DM; t.K = DFF; t.src = C.in[I_W_DOWN] + (size_t)l * DFF * DM; t.dst = (bf16*)(C.ws + WS_WDN) + (size_t)(128 * nb) * DFF; }
    t.src += (size_t)(128 * kb) * t.N + 128 * nb; t.dst += 128 * kb;
    const int rem = t.N - 128 * nb; t.nvalid = rem >= 128 ? 128 : (rem > 0 ? rem : 0);
    return t;
}
__device__ __forceinline__ void titem_load(const TItem& t, f32x4 (&v)[8], int wave, int lane) {
    const bool nv = 4 * (lane & 31) < t.nvalid; const float* p = t.src + (size_t)(16 * wave + 2 * (lane >> 5)) * t.N + 4 * (lane & 31);
#pragma unroll
    for (int i = 0; i < 4; ++i) { v[2 * i] = nv ? *(const GAS f32x4*)(p + (size_t)(4 * i) * t.N) : (f32x4){0.f, 0.f, 0.f, 0.f}; v[2 * i + 1] = nv ? *(const GAS f32x4*)(p + (size_t)(4 * i + 1) * t.N) : (f32x4){0.f, 0.f, 0.f, 0.f}; }
}
__device__ __forceinline__ void titem_store(const TItem& t, const f32x4 (&v)[8], LAS unsigned* T, int tid, int wave, int lane) {
    __syncthreads();
    { const int kd = 8 * wave + (lane >> 5);
#pragma unroll
      for (int i = 0; i < 4; ++i)
#pragma unroll
          for (int e = 0; e < 4; ++e) T[(4 * (lane & 31) + e) * 65 + ((kd + 2 * i) ^ ((lane & 31) >> 3))] = pg8::cvt_pk_bf16(v[2 * i][e], v[2 * i + 1][e]); }
    __syncthreads();
    const int ch = tid & 15;
#pragma unroll
    for (int ps = 0; ps < 4; ++ps) { const int n = 32 * ps + (tid >> 4); const LAS unsigned* s = T + n * 65 + 4 * ch;
        v4u o; o.x = s[0 ^ ps]; o.y = s[1 ^ ps]; o.z = s[2 ^ ps]; o.w = s[3 ^ ps];
        *(GAS v4u*)(t.dst + (size_t)n * t.K + 8 * ch) = o; }
}
__device__ __forceinline__ void convert_weights(Ctx& C, int l, int lo, int hi) {
    LAS unsigned* T = (LAS unsigned*)C.lds;
    int it = lo + C.bid;
    if (it < hi) {
        TItem cur = titem_decode(C, l, it); f32x4 va[8], vb[8];
        titem_load(cur, va, C.wave, C.lane);
        for (;;) {
            int nx = it + C.G; TItem tn = cur; const bool hn = nx < hi;
            if (hn) { tn = titem_decode(C, l, nx); titem_load(tn, vb, C.wave, C.lane); }
            titem_store(cur, va, T, C.tid, C.wave, C.lane);
            if (!hn) break;
            nx += C.G; const bool hn2 = nx < hi; TItem t2 = tn;
            if (hn2) { t2 = titem_decode(C, l, nx); titem_load(t2, va, C.wave, C.lane); }
            titem_store(tn, vb, T, C.tid, C.wave, C.lane);
            if (!hn2) break;
            cur = t2; it = nx;
        }
    }
    __syncthreads();
}
constexpr int CV_DN_LO = CV_NITEMS - 86 * 32, CV_UP_LO = CV_DN_LO - 32 * 86, CV_A_ITEMS = CV_UP_LO;
constexpr int SEAM_A1 = 9 * 256  , SEAM_B0 = 32 * 86  , SEAM_B1 = SEAM_B0 + 7 * 256  ;
__device__ __forceinline__ float row_ssq(const f32x4 (&v)[16]) { float ss = 0.f;
#pragma unroll
    for (int j = 0; j < 16; ++j) ss += (v[j].x * v[j].x + v[j].y * v[j].y) + (v[j].z * v[j].z + v[j].w * v[j].w);
    return ss; }
__device__ __forceinline__ void rmsnorm_phase(Ctx& C, const float* X, const float* w, bf16* H, bf16* XB) {
    const int gw = C.bid * NWAVES + C.wave, NGW = C.G * NWAVES, lane = C.lane;
    const GAS f32x4* wr = (const GAS f32x4*)w + lane;
    for (int m = gw; m < M; m += 2 * NGW) {
        const int m2 = m + NGW; const bool h2 = m2 < M;
        const GAS f32x4* x0 = (const GAS f32x4*)(X + (size_t)m * DM) + lane; const GAS f32x4* x1 = (const GAS f32x4*)(X + (size_t)(h2 ? m2 : m) * DM) + lane;
        f32x4 v0[16], v1[16];
#pragma unroll
        for (int j = 0; j < 16; ++j) v0[j] = x0[64 * j];
#pragma unroll
        for (int j = 0; j < 16; ++j) v1[j] = x1[64 * j];
        const float r0 = 1.f / sqrtf(wave_sum(row_ssq(v0)) * (1.f / DM) + EPS), r1 = 1.f / sqrtf(wave_sum(row_ssq(v1)) * (1.f / DM) + EPS);
        GAS v2u* o0 = (GAS v2u*)(H + (size_t)m * DM) + lane; GAS v2u* o1 = (GAS v2u*)(H + (size_t)m2 * DM) + lane;
#pragma unroll
        for (int j = 0; j < 16; ++j) { const f32x4 g = wr[64 * j]; v2u o; o.x = pk2(v0[j].x * r0 * g.x, v0[j].y * r0 * g.y); o.y = pk2(v0[j].z * r0 * g.z, v0[j].w * r0 * g.w); o0[64 * j] = o;
            if (h2) { v2u p; p.x = pk2(v1[j].x * r1 * g.x, v1[j].y * r1 * g.y); p.y = pk2(v1[j].z * r1 * g.z, v1[j].w * r1 * g.w); o1[64 * j] = p; } }
        GAS v2u* b0 = (GAS v2u*)(XB + (size_t)m * DM) + lane; GAS v2u* b1 = (GAS v2u*)(XB + (size_t)m2 * DM) + lane;
#pragma unroll
        for (int j = 0; j < 16; ++j) { v2u o; o.x = pk2(v0[j].x, v0[j].y); o.y = pk2(v0[j].z, v0[j].w); b0[64 * j] = o; if (h2) { v2u p; p.x = pk2(v1[j].x, v1[j].y); p.y = pk2(v1[j].z, v1[j].w); b1[64 * j] = p; } }
    }
}
__device__ __forceinline__ float row_ssq8(const v4u (&v)[8]) { float ss = 0.f;
#pragma unroll
    for (int j = 0; j < 8; ++j) { const float a0 = bflo(v[j].x), a1 = bfhi(v[j].x), a2 = bflo(v[j].y), a3 = bfhi(v[j].y), a4 = bflo(v[j].z), a5 = bfhi(v[j].z), a6 = bflo(v[j].w), a7 = bfhi(v[j].w);
        ss += ((a0 * a0 + a1 * a1) + (a2 * a2 + a3 * a3)) + ((a4 * a4 + a5 * a5) + (a6 * a6 + a7 * a7)); }
    return ss; }
__device__ __forceinline__ void rmsnorm_phase_b(Ctx& C, const bf16* X, const float* w, bf16* H) {
    const int gw = C.bid * NWAVES + C.wave, NGW = C.G * NWAVES, lane = C.lane;
    for (int m = gw; m < M; m += 2 * NGW) {
        const int m2 = m + NGW; const bool h2 = m2 < M;
        const GAS v4u* x0 = (const GAS v4u*)(X + (size_t)m * DM) + lane; const GAS v4u* x1 = (const GAS v4u*)(X + (size_t)(h2 ? m2 : m) * DM) + lane;
        v4u v0[8], v1[8];
#pragma unroll
        for (int j = 0; j < 8; ++j) v0[j] = x0[64 * j];
#pragma unroll
        for (int j = 0; j < 8; ++j) v1[j] = x1[64 * j];
        const float r0 = 1.f / sqrtf(wave_sum(row_ssq8(v0)) * (1.f / DM) + EPS), r1 = 1.f / sqrtf(wave_sum(row_ssq8(v1)) * (1.f / DM) + EPS);
        GAS v4u* o0 = (GAS v4u*)(H + (size_t)m * DM) + lane; GAS v4u* o1 = (GAS v4u*)(H + (size_t)m2 * DM) + lane;
#pragma unroll
        for (int j = 0; j < 8; ++j) { const f32x4 g0 = *(const GAS f32x4*)(w + 512 * j + 8 * lane), g1 = *(const GAS f32x4*)(w + 512 * j + 8 * lane + 4);
            { const v4u x = v0[j]; v4u o; o.x = pk2(bflo(x.x) * r0 * g0.x, bfhi(x.x) * r0 * g0.y); o.y = pk2(bflo(x.y) * r0 * g0.z, bfhi(x.y) * r0 * g0.w); o.z = pk2(bflo(x.z) * r0 * g1.x, bfhi(x.z) * r0 * g1.y); o.w = pk2(bflo(x.w) * r0 * g1.z, bfhi(x.w) * r0 * g1.w); o0[64 * j] = o; }
            if (h2) { const v4u x = v1[j]; v4u o; o.x = pk2(bflo(x.x) * r1 * g0.x, bfhi(x.x) * r1 * g0.y); o.y = pk2(bflo(x.y) * r1 * g0.z, bfhi(x.y) * r1 * g0.w); o.z = pk2(bflo(x.z) * r1 * g1.x, bfhi(x.z) * r1 * g1.y); o.w = pk2(bflo(x.w) * r1 * g1.z, bfhi(x.w) * r1 * g1.w); o1[64 * j] = o; } }
    }
}
__device__ __forceinline__ void final_norm_phase(Ctx& C, const bf16* X, const float* w, float* OUT) {
    const int gw = C.bid * NWAVES + C.wave, NGW = C.G * NWAVES, lane = C.lane;
    for (int m = gw; m < M; m += 2 * NGW) {
        const int m2 = m + NGW; const bool h2 = m2 < M;
        const GAS v4u* x0 = (const GAS v4u*)(X + (size_t)m * DM) + lane; const GAS v4u* x1 = (const GAS v4u*)(X + (size_t)(h2 ? m2 : m) * DM) + lane;
        v4u v0[8], v1[8];
#pragma unroll
        for (int j = 0; j < 8; ++j) v0[j] = x0[64 * j];
#pragma unroll
        for (int j = 0; j < 8; ++j) v1[j] = x1[64 * j];
        const float r0 = 1.f / sqrtf(wave_sum(row_ssq8(v0)) * (1.f / DM) + EPS), r1 = 1.f / sqrtf(wave_sum(row_ssq8(v1)) * (1.f / DM) + EPS);
        float* o0 = OUT + (size_t)m * DM + 8 * lane; float* o1 = OUT + (size_t)m2 * DM + 8 * lane;
#pragma unroll
        for (int j = 0; j < 8; ++j) { const f32x4 g0 = *(const GAS f32x4*)(w + 512 * j + 8 * lane), g1 = *(const GAS f32x4*)(w + 512 * j + 8 * lane + 4);
            { const v4u x = v0[j]; *(GAS f32x4*)(o0 + 512 * j) = (f32x4){bflo(x.x) * r0 * g0.x, bfhi(x.x) * r0 * g0.y, bflo(x.y) * r0 * g0.z, bfhi(x.y) * r0 * g0.w}; *(GAS f32x4*)(o0 + 512 * j + 4) = (f32x4){bflo(x.z) * r0 * g1.x, bfhi(x.z) * r0 * g1.y, bflo(x.w) * r0 * g1.z, bfhi(x.w) * r0 * g1.w}; }
            if (h2) { const v4u x = v1[j]; *(GAS f32x4*)(o1 + 512 * j) = (f32x4){bflo(x.x) * r1 * g0.x, bfhi(x.x) * r1 * g0.y, bflo(x.y) * r1 * g0.z, bfhi(x.y) * r1 * g0.w}; *(GAS f32x4*)(o1 + 512 * j + 4) = (f32x4){bflo(x.z) * r1 * g1.x, bfhi(x.z) * r1 * g1.y, bflo(x.w) * r1 * g1.z, bfhi(x.w) * r1 * g1.w}; } }
    }
}

typedef short bf16x8 __attribute__((ext_vector_type(8)));
typedef short s16x4 __attribute__((ext_vector_type(4)));
__device__ __forceinline__ f32x4 mfma16(bf16x8 a, bf16x8 b, f32x4 c) { return __builtin_amdgcn_mfma_f32_16x16x32_bf16(a, b, c, 0, 0, 0); }
__device__ __forceinline__ bf16x8 pack8(f32x4 lo, f32x4 hi) { v4u w; w.x = pg8::cvt_pk_bf16(lo.x, lo.y); w.y = pg8::cvt_pk_bf16(lo.z, lo.w); w.z = pg8::cvt_pk_bf16(hi.x, hi.y); w.w = pg8::cvt_pk_bf16(hi.z, hi.w); return __builtin_bit_cast(bf16x8, w); }
__device__ __forceinline__ bf16x8 gfrag(const bf16* Mx, size_t ld, int row0, int k0, int lane) { return *(const GAS bf16x8*)(Mx + (size_t)(row0 + (lane & 15)) * ld + k0 + 8 * (lane >> 4)); }
__device__ __forceinline__ bf16x8 trfrag(const LAS unsigned char* img, int stride, int r0, int r1, int col0, int lane) {
    const int q = (lane & 15) >> 2, p = lane & 3;
    const s16x4 a = __builtin_amdgcn_ds_read_tr16_b64_v4i16((LAS s16x4*)(img + (r0 + q) * stride + (col0 + 4 * p) * 2));
    const s16x4 b = __builtin_amdgcn_ds_read_tr16_b64_v4i16((LAS s16x4*)(img + (r1 + q) * stride + (col0 + 4 * p) * 2));
    return __builtin_shufflevector(a, b, 0, 1, 2, 3, 4, 5, 6, 7);
}
__device__ __forceinline__ float xsum4(float v) { v += __shfl_xor(v, 16); v += __shfl_xor(v, 32); return v; }
__device__ __forceinline__ float xmax4(float v) { v = fmaxf(v, __shfl_xor(v, 16)); v = fmaxf(v, __shfl_xor(v, 32)); return v; }

constexpr int SWA_QSTRIDE = 528;
constexpr int SWA_VSTRIDE = 144;
constexpr int SWA_V_BYTES = 192 * SWA_VSTRIDE;
__device__ __forceinline__ void swa_unit_mfma(Ctx& C, int l, int unit) {
    const int b = unit >> 7, qb = unit & 127, q0 = qb * 64;
    const int tid = C.tid, lane = C.lane, w = C.wave, c = lane & 15, hq = lane >> 4;
    LAS unsigned char* Vimg = C.lds;
    LAS unsigned char* Kimg = C.lds + 30720;
    LAS float* tb = (LAS float*)(C.lds + 61440);
    LAS float* ssqx = (LAS float*)(C.lds + 61440 + 12288);
    LAS unsigned char* Qimg = C.lds + 75776;
    const bf16* PROJ = (const bf16*)(C.ws + WS_PROJ); bf16* OSWA = (bf16*)(C.ws + WS_OSWA); bf16* Y = (bf16*)(C.ws + WS_Y);
    const bf16* Pb = PROJ + (size_t)b * SEQ * DINP;
    __syncthreads();
    for (int i = tid; i < 16 * 192; i += NTHR) { const int hd = i / 192, x = i % 192, dist = x - 32; tb[i] = (dist >= 0 && dist < 128) ? C.in[I_REL_BIAS][T5_BUCKET[dist] * SWA_H + hd] : 0.f; }
    if (tid < 16 * 9) { *(LAS v4u*)(Vimg + (192 + tid / 9) * SWA_VSTRIDE + 16 * (tid % 9)) = (v4u){0u, 0u, 0u, 0u}; *(LAS v4u*)(Kimg + (192 + tid / 9) * SWA_VSTRIDE + 16 * (tid % 9)) = (v4u){0u, 0u, 0u, 0u}; }
    const int g = w >> 1, qhalf = w & 1;
    float ssq0 = 0.f, ssq1 = 0.f;
    for (int kvh = 0; kvh < 4; ++kvh) {
        const int head = kvh * 4 + g;
        __syncthreads();
        { v4u tv[3], tk[3], tq[4];
#pragma unroll
          for (int it = 0; it < 4; ++it) { const int idx = tid + NTHR * it, t = idx >> 5, cg = idx & 31; tq[it] = __builtin_nontemporal_load((const GAS v4u*)(Pb + (size_t)(q0 + t) * DINP + C_SQ + kvh * 256 + 8 * cg)); }
#pragma unroll
          for (int it = 0; it < 3; ++it) { const int idx = tid + NTHR * it, j = idx >> 3, cg = idx & 7; int s = q0 - 128 + j; s = s < 0 ? 0 : s;
              tv[it] = __builtin_nontemporal_load((const GAS v4u*)(Pb + (size_t)s * DINP + C_SV + kvh * 64 + 8 * cg)); tk[it] = __builtin_nontemporal_load((const GAS v4u*)(Pb + (size_t)s * DINP + C_SK + kvh * 64 + 8 * cg)); }
#pragma unroll
          for (int it = 0; it < 3; ++it) { const int idx = tid + NTHR * it, j = idx >> 3, cg = idx & 7; *(LAS v4u*)(Vimg + j * SWA_VSTRIDE + 16 * cg) = tv[it]; *(LAS v4u*)(Kimg + j * SWA_VSTRIDE + 16 * cg) = tk[it]; }
#pragma unroll
          for (int it = 0; it < 4; ++it) { const int idx = tid + NTHR * it, t = idx >> 5, cg = idx & 31; *(LAS v4u*)(Qimg + t * SWA_QSTRIDE + 16 * cg) = tq[it]; } }
        __syncthreads();
        const float sink = C.in[I_SWA_SINKS][l * SWA_H + head];
#pragma nounroll
        for (int qt = 0; qt < 2; ++qt) {
            const int j0 = 32 * qhalf + 16 * qt;
            const LAS unsigned char* qp = Qimg + (j0 + c) * SWA_QSTRIDE + (g * 64 + 8 * hq) * 2;
            const bf16x8 qf0 = *(const LAS bf16x8*)qp, qf1 = *(const LAS bf16x8*)(qp + 64);
            f32x4 sacc[10];
#pragma unroll
            for (int kt = 0; kt < 10; ++kt) {
                const LAS unsigned char* kp = Kimg + (j0 + 16 * kt + c) * SWA_VSTRIDE + 16 * hq;
                const bf16x8 k0 = *(const LAS bf16x8*)kp, k1 = *(const LAS bf16x8*)(kp + 64);
                f32x4 a = (f32x4){0.f, 0.f, 0.f, 0.f}; a = mfma16(k0, qf0, a); a = mfma16(k1, qf1, a); sacc[kt] = a;
            }
            float mx = sink;
#pragma unroll
            for (int kt = 0; kt < 10; ++kt)
#pragma unroll
                for (int r = 0; r < 4; ++r) { const int dist = c + 128 - 16 * kt - 4 * hq - r; const int s = q0 - 128 + j0 + 16 * kt + 4 * hq + r;
                    const bool valid = (dist >= 0) && (dist < 128) && (s >= 0);
                    const float sc = valid ? sacc[kt][r] * 0.125f + tb[head * 192 + dist + 32] : -1e30f;
                    sacc[kt][r] = sc; mx = fmaxf(mx, sc); }
            mx = xmax4(mx); float sum = 0.f;
#pragma unroll
            for (int kt = 0; kt < 10; ++kt)
#pragma unroll
                for (int r = 0; r < 4; ++r) { const float p = __expf(sacc[kt][r] - mx); sacc[kt][r] = p; sum += p; }
            sum = xsum4(sum); const float inv = 1.f / (sum + __expf(sink - mx));
            f32x4 oacc[4];
#pragma unroll
            for (int dt = 0; dt < 4; ++dt) oacc[dt] = (f32x4){0.f, 0.f, 0.f, 0.f};
#pragma unroll
            for (int ks = 0; ks < 5; ++ks) { const bf16x8 pf = pack8(sacc[2 * ks], sacc[2 * ks + 1]);
#pragma unroll
                for (int dt = 0; dt < 4; ++dt) oacc[dt] = mfma16(trfrag(Vimg, SWA_VSTRIDE, j0 + 32 * ks + 4 * hq, j0 + 32 * ks + 16 + 4 * hq, 16 * dt, lane), pf, oacc[dt]); }
            float sq = 0.f; bf16* op = OSWA + (size_t)(b * SEQ + q0 + j0 + c) * SWA_W + head * 64 + 4 * hq;
#pragma unroll
            for (int dt = 0; dt < 4; ++dt) { const f32x4 o = oacc[dt] * inv; v2u pk; pk.x = pk2(o.x, o.y); pk.y = pk2(o.z, o.w);
                const float r0 = bflo(pk.x), r1 = bfhi(pk.x), r2 = bflo(pk.y), r3 = bfhi(pk.y); sq += (r0 * r0 + r1 * r1) + (r2 * r2 + r3 * r3); *(GAS v2u*)(op + 16 * dt) = pk; }
            if (qt == 0) ssq0 += sq; else ssq1 += sq;
        }
    }
    ssq0 = xsum4(ssq0); ssq1 = xsum4(ssq1);
    if (hq == 0) { ssqx[w * 32 + c] = ssq0; ssqx[w * 32 + 16 + c] = ssq1; }
    asm volatile("s_waitcnt vmcnt(0)" ::: "memory");
    __syncthreads();
    const float* swa_norm = C.in[I_SWA_NORM] + (size_t)l * SWA_W;
#pragma nounroll
    for (int qt = 0; qt < 2; ++qt) { const int qi = 16 * qt + c;
        const float tot = ssqx[(qhalf + 0) * 32 + qi] + ssqx[(qhalf + 2) * 32 + qi] + ssqx[(qhalf + 4) * 32 + qi] + ssqx[(qhalf + 6) * 32 + qi];
        const float rstd = 1.f / sqrtf(tot * (1.f / 1024.f) + EPS);
        const size_t row = (size_t)(b * SEQ + q0 + 32 * qhalf + qi);
#pragma unroll
        for (int kvh = 0; kvh < 4; ++kvh)
#pragma unroll
            for (int dt = 0; dt < 4; ++dt) { const int col = (kvh * 4 + g) * 64 + 16 * dt + 4 * hq; const v2u pk = *(const GAS v2u*)(OSWA + row * SWA_W + col); const f32x4 o = (f32x4){bflo(pk.x), bfhi(pk.x), bflo(pk.y), bfhi(pk.y)}; const f32x4 gn = *(const GAS f32x4*)(swa_norm + col);
                v2u ow; ow.x = pk2(o.x * rstd * gn.x, o.y * rstd * gn.y); ow.y = pk2(o.z * rstd * gn.z, o.w * rstd * gn.w); *(GAS v2u*)(Y + row * DM + 2048 + col) = ow; } }
}

constexpr int N_SWA_UNITS = BATCH * (SEQ / 64);

constexpr int SSD_L = 128, SSD_NC = SEQ / SSD_L, GLA_L = 64, GLA_NC = SEQ / GLA_L;
constexpr int N_SSD_CU = BATCH * SSD_NC * 8, N_GLA_CU = BATCH * GLA_NC * 4;
constexpr int XI_STRIDE = 528, BI_STRIDE = 272;

__device__ __forceinline__ void prep_phase(Ctx& C, int l) {
    const bf16* PROJ = (const bf16*)(C.ws + WS_PROJ); bf16* XBC = (bf16*)(C.ws + WS_XBC);
    const int tid = C.tid, lane = C.lane;
    { const int gw0 = C.bid * NWAVES + C.wave;
      float* DT = (float*)(C.ws + WS_DT); float* ACS = (float*)(C.ws + WS_ACS); float* DEC = (float*)(C.ws + WS_DEC);
      for (int item = gw0; item < BATCH * SSD_NC * SSD_H; item += C.G * NWAVES) {
          const int h = item & 31, bc = item >> 5; const size_t r0 = (size_t)bc * SSD_L + 2 * lane;
          const float dtb = C.in[I_SSD_DT_BIAS][l * SSD_H + h], Ah = -expf(C.in[I_SSD_A_LOG][l * SSD_H + h]);
          const float x0 = bf1(PROJ[r0 * DINP + C_DT + h]) + dtb, x1 = bf1(PROJ[(r0 + 1) * DINP + C_DT + h]) + dtb;
          const float d0 = x0 > 20.f ? x0 : log1pf(expf(x0)), d1 = x1 > 20.f ? x1 : log1pf(expf(x1));
          const float a0 = d0 * Ah, a1 = d1 * Ah;
          float incl = a0 + a1;
#pragma unroll
          for (int o = 1; o < 64; o <<= 1) { const float t = __shfl_up(incl, o); if (lane >= o) incl += t; }
          const float c1 = incl, c0 = incl - a1;
          DT[r0 * SSD_H + h] = d0; DT[(r0 + 1) * SSD_H + h] = d1; ACS[r0 * SSD_H + h] = c0; ACS[(r0 + 1) * SSD_H + h] = c1;
          if (lane == 63) DEC[bc * SSD_H + h] = expf(c1);
      } }
    { const float* conv_w = C.in[I_SSD_CONV_W] + (size_t)l * 4 * SSD_CD; const float* conv_b = C.in[I_SSD_CONV_B] + (size_t)l * SSD_CD;
      const float* HT = (const float*)(C.ws + WS_XHT); const float* HB = (const float*)(C.ws + WS_XHB);
      constexpr int NIT = (M / 64) * 3 * 1024;
      for (int it = C.bid * NTHR + tid; it < NIT; it += C.G * NTHR) {
          const int c4 = it & 1023, ri = it >> 10, i = ri % 3, blk = ri / 3, c0 = 4 * c4; const bool first = (blk % (SEQ / 64)) == 0;
          f32x4 sq[6]; const f32x4 z4 = (f32x4){0.f, 0.f, 0.f, 0.f};
#pragma unroll
          for (int j = 0; j < 3; ++j) { sq[j] = first ? z4 : *(const GAS f32x4*)(HB + ((size_t)(blk - 1) * 3 + j) * 4096 + c0); sq[3 + j] = *(const GAS f32x4*)(HT + ((size_t)blk * 3 + j) * 4096 + c0); }
          const f32x4 x3 = i == 0 ? sq[0] : (i == 1 ? sq[1] : sq[2]), x2 = i == 0 ? sq[1] : (i == 1 ? sq[2] : sq[3]), x1 = i == 0 ? sq[2] : (i == 1 ? sq[3] : sq[4]), x0 = i == 0 ? sq[3] : (i == 1 ? sq[4] : sq[5]);
          const f32x4 w0 = *(const GAS f32x4*)(conv_w + c0), w1 = *(const GAS f32x4*)(conv_w + 4096 + c0), w2 = *(const GAS f32x4*)(conv_w + 2 * 4096 + c0), w3 = *(const GAS f32x4*)(conv_w + 3 * 4096 + c0), bb = *(const GAS f32x4*)(conv_b + c0);
          f32x4 o;
#pragma unroll
          for (int e = 0; e < 4; ++e) o[e] = silu_f(bb[e] + w0[e] * x3[e] + w1[e] * x2[e] + w2[e] * x1[e] + w3[e] * x0[e]);
          v2u ow; ow.x = pk2(o.x, o.y); ow.y = pk2(o.z, o.w); *(GAS v2u*)(XBC + (size_t)(64 * blk + i) * SSD_CD + c0) = ow;
      } }
    { LAS float* glr = (LAS float*)C.lds;
      LAS float* segtot = glr + 1024;
      bf16* QD = (bf16*)(C.ws + WS_QD); bf16* KI = (bf16*)(C.ws + WS_KI); float* GDEC = (float*)(C.ws + WS_GDEC);
      const float* w_gate = C.in[I_GLA_W_GATE] + (size_t)l * 16 * GLA_KT; const int seg = tid >> 7, c0 = 4 * (tid & 127);
      for (int ck = C.bid; ck < BATCH * GLA_NC; ck += C.G) {
          const size_t row0 = (size_t)ck * GLA_L;
          __syncthreads();
          if (tid < 128) { const int t = tid >> 1, hf = tid & 1; const v4u r = *(const GAS v4u*)(PROJ + (row0 + t) * DINP + C_GLR + 8 * hf);
              *(LAS f32x4*)(glr + t * 16 + 8 * hf) = (f32x4){bflo(r.x), bfhi(r.x), bflo(r.y), bfhi(r.y)}; *(LAS f32x4*)(glr + t * 16 + 8 * hf + 4) = (f32x4){bflo(r.z), bfhi(r.z), bflo(r.w), bfhi(r.w)}; }
          f32x4 cum[16];
          { f32x4 wg[16]; const f32x4 bg4 = *(const GAS f32x4*)(C.in[I_GLA_B_GATE] + l * GLA_KT + c0);
#pragma unroll
            for (int r = 0; r < 16; ++r) wg[r] = *(const GAS f32x4*)(w_gate + r * GLA_KT + c0);
            __syncthreads();
            f32x4 run = (f32x4){0.f, 0.f, 0.f, 0.f};
#pragma unroll
            for (int t = 0; t < 16; ++t) { f32x4 z = bg4;
#pragma unroll
                for (int r4 = 0; r4 < 4; ++r4) { const f32x4 gv = *(const LAS f32x4*)(glr + (16 * seg + t) * 16 + 4 * r4); z += wg[4 * r4] * gv.x + wg[4 * r4 + 1] * gv.y + wg[4 * r4 + 2] * gv.z + wg[4 * r4 + 3] * gv.w; }
#pragma unroll
                for (int e = 0; e < 4; ++e) { const float ls = fminf(z[e], 0.f) - __logf(1.f + __expf(-fabsf(z[e]))); run[e] += ls * 0.0625f; }
                cum[t] = run; }
            *(LAS f32x4*)(segtot + seg * 512 + c0) = run; }
          v2u rq[16], rk[16];
#pragma unroll
          for (int t = 0; t < 16; ++t) { rq[t] = *(const GAS v2u*)(PROJ + (row0 + 16 * seg + t) * DINP + C_GQ + c0); rk[t] = *(const GAS v2u*)(PROJ + (row0 + 16 * seg + t) * DINP + C_GK + c0); }
          __syncthreads();
          f32x4 off = (f32x4){0.f, 0.f, 0.f, 0.f}, tot = off;
#pragma unroll
          for (int sg = 0; sg < 4; ++sg) { const f32x4 v = *(const LAS f32x4*)(segtot + sg * 512 + c0); tot += v; if (sg < seg) off += v; }
#pragma unroll
          for (int t = 0; t < 16; ++t) { const f32x4 cc = cum[t] + off; const size_t o = (row0 + 16 * seg + t) * GLA_KT + c0;
              const float e0 = __expf(cc.x), e1 = __expf(cc.y), e2 = __expf(cc.z), e3 = __expf(cc.w), i0 = __expf(-cc.x), i1 = __expf(-cc.y), i2 = __expf(-cc.z), i3 = __expf(-cc.w);
              v2u oq, ok; oq.x = pk2(bflo(rq[t].x) * 0.08838834764831845f * e0, bfhi(rq[t].x) * 0.08838834764831845f * e1); oq.y = pk2(bflo(rq[t].y) * 0.08838834764831845f * e2, bfhi(rq[t].y) * 0.08838834764831845f * e3);
              ok.x = pk2(bflo(rk[t].x) * i0, bfhi(rk[t].x) * i1); ok.y = pk2(bflo(rk[t].y) * i2, bfhi(rk[t].y) * i3);
              *(GAS v2u*)(QD + o) = oq; *(GAS v2u*)(KI + o) = ok; }
          if (seg == 3) *(GAS f32x4*)(GDEC + (size_t)ck * GLA_KT + c0) = (f32x4){__expf(tot.x), __expf(tot.y), __expf(tot.z), __expf(tot.w)};
      } }
}

__device__ __forceinline__ void gla_c1_unit(Ctx& C, int unit) {
    const int h = unit & 3, ck = unit >> 2; const size_t row0 = (size_t)ck * GLA_L;
    const int tid = C.tid, lane = C.lane, w = C.wave, c = lane & 15, hq = lane >> 4;
    LAS unsigned char* KEimg = C.lds; LAS unsigned char* Vimg = C.lds + 64 * BI_STRIDE;
    const bf16* PROJ = (const bf16*)(C.ws + WS_PROJ); const bf16* KI = (const bf16*)(C.ws + WS_KI); const float* GDEC = (const float*)(C.ws + WS_GDEC); bf16* GST = (bf16*)(C.ws + WS_GST);
    __syncthreads();
    { const int cg = tid & 15; const f32x4 d0 = *(const GAS f32x4*)(GDEC + (size_t)ck * GLA_KT + h * 128 + 8 * cg), d1 = *(const GAS f32x4*)(GDEC + (size_t)ck * GLA_KT + h * 128 + 8 * cg + 4);
#pragma unroll
      for (int it = 0; it < 2; ++it) { const int t = (tid + NTHR * it) >> 4; const v4u r = __builtin_nontemporal_load((const GAS v4u*)(KI + (row0 + t) * GLA_KT + h * 128 + 8 * cg));
          v4u o; o.x = pk2(bflo(r.x) * d0.x, bfhi(r.x) * d0.y); o.y = pk2(bflo(r.y) * d0.z, bfhi(r.y) * d0.w); o.z = pk2(bflo(r.z) * d1.x, bfhi(r.z) * d1.y); o.w = pk2(bflo(r.w) * d1.z, bfhi(r.w) * d1.w);
          *(LAS v4u*)(KEimg + t * BI_STRIDE + 16 * cg) = o; } }
#pragma unroll
    for (int it = 0; it < 4; ++it) { const int idx = tid + NTHR * it, t = idx >> 5, cg = idx & 31; *(LAS v4u*)(Vimg + t * XI_STRIDE + 16 * cg) = __builtin_nontemporal_load((const GAS v4u*)(PROJ + (row0 + t) * DINP + C_GV + h * 256 + 8 * cg)); }
    __syncthreads();
    f32x4 acc[16];
#pragma unroll
    for (int nt = 0; nt < 16; ++nt) acc[nt] = (f32x4){0.f, 0.f, 0.f, 0.f};
#pragma unroll
    for (int ks = 0; ks < 2; ++ks) { const bf16x8 af = trfrag(KEimg, BI_STRIDE, 32 * ks + 8 * hq, 32 * ks + 8 * hq + 4, 16 * w, lane);
#pragma unroll
        for (int nt = 0; nt < 16; ++nt) acc[nt] = mfma16(af, trfrag(Vimg, XI_STRIDE, 32 * ks + 8 * hq, 32 * ks + 8 * hq + 4, 16 * nt, lane), acc[nt]); }
    bf16* gp = GST + (size_t)unit * 32768 + 16 * w + 4 * hq;
#pragma unroll
    for (int nt = 0; nt < 16; ++nt) { v2u o; o.x = pk2(acc[nt].x, acc[nt].y); o.y = pk2(acc[nt].z, acc[nt].w); *(GAS v2u*)(gp + (size_t)(16 * nt + c) * 128) = o; }
}

struct GlaC1Pre { v4u ki[2], vv[4]; f32x4 d0, d1; };
__device__ __forceinline__ void gla_c1_load(Ctx& C, int unit, GlaC1Pre& p) {
    const int h = unit & 3, ck = unit >> 2, tid = C.tid, cg = tid & 15; const size_t row0 = (size_t)ck * GLA_L;
    const bf16* PROJ = (const bf16*)(C.ws + WS_PROJ); const bf16* KI = (const bf16*)(C.ws + WS_KI); const float* GDEC = (const float*)(C.ws + WS_GDEC);
    p.d0 = *(const GAS f32x4*)(GDEC + (size_t)ck * GLA_KT + h * 128 + 8 * cg); p.d1 = *(const GAS f32x4*)(GDEC + (size_t)ck * GLA_KT + h * 128 + 8 * cg + 4);
#pragma unroll
    for (int it = 0; it < 2; ++it) { const int t = (tid + NTHR * it) >> 4; p.ki[it] = __builtin_nontemporal_load((const GAS v4u*)(KI + (row0 + t) * GLA_KT + h * 128 + 8 * cg)); }
#pragma unroll
    for (int it = 0; it < 4; ++it) { const int idx = tid + NTHR * it, t = idx >> 5, c2 = idx & 31; p.vv[it] = __builtin_nontemporal_load((const GAS v4u*)(PROJ + (row0 + t) * DINP + C_GV + h * 256 + 8 * c2)); }
}
__device__ __forceinline__ void gla_c1_stage(Ctx& C, const GlaC1Pre& p) {
    const int tid = C.tid, cg = tid & 15; LAS unsigned char* KEimg = C.lds; LAS unsigned char* Vimg = C.lds + 64 * BI_STRIDE;
#pragma unroll
    for (int it = 0; it < 2; ++it) { const int t = (tid + NTHR * it) >> 4; const v4u r = p.ki[it]; const f32x4 d0 = p.d0, d1 = p.d1;
        v4u o; o.x = pk2(bflo(r.x) * d0.x, bfhi(r.x) * d0.y); o.y = pk2(bflo(r.y) * d0.z, bfhi(r.y) * d0.w); o.z = pk2(bflo(r.z) * d1.x, bfhi(r.z) * d1.y); o.w = pk2(bflo(r.w) * d1.z, bfhi(r.w) * d1.w);
        *(LAS v4u*)(KEimg + t * BI_STRIDE + 16 * cg) = o; }
#pragma unroll
    for (int it = 0; it < 4; ++it) { const int idx = tid + NTHR * it, t = idx >> 5, c2 = idx & 31; *(LAS v4u*)(Vimg + t * XI_STRIDE + 16 * c2) = p.vv[it]; }
}
__device__ __forceinline__ void gla_c1_compute(Ctx& C, int unit) {
    const int lane = C.lane, w = C.wave, c = lane & 15, hq = lane >> 4;
    LAS unsigned char* KEimg = C.lds; LAS unsigned char* Vimg = C.lds + 64 * BI_STRIDE; bf16* GST = (bf16*)(C.ws + WS_GST);
    f32x4 acc[16];
#pragma unroll
    for (int nt = 0; nt < 16; ++nt) acc[nt] = (f32x4){0.f, 0.f, 0.f, 0.f};
#pragma unroll
    for (int ks = 0; ks < 2; ++ks) { const bf16x8 af = trfrag(KEimg, BI_STRIDE, 32 * ks + 8 * hq, 32 * ks + 8 * hq + 4, 16 * w, lane);
#pragma unroll
        for (int nt = 0; nt < 16; ++nt) acc[nt] = mfma16(af, trfrag(Vimg, XI_STRIDE, 32 * ks + 8 * hq, 32 * ks + 8 * hq + 4, 16 * nt, lane), acc[nt]); }
    bf16* gp = GST + (size_t)unit * 32768 + 16 * w + 4 * hq;
#pragma unroll
    for (int nt = 0; nt < 16; ++nt) { v2u o; o.x = pk2(acc[nt].x, acc[nt].y); o.y = pk2(acc[nt].z, acc[nt].w); *(GAS v2u*)(gp + (size_t)(16 * nt + c) * 128) = o; }
}

__device__ __forceinline__ void scan_phase(Ctx& C) {
    const bf16* GST = (const bf16*)(C.ws + WS_GST); bf16* GPV = (bf16*)(C.ws + WS_GPV); const float* GDEC = (const float*)(C.ws + WS_GDEC);
    const bf16* ST = (const bf16*)(C.ws + WS_ST); bf16* PV = (bf16*)(C.ws + WS_PV); const float* DEC = (const float*)(C.ws + WS_DEC);
    constexpr int N_S = BATCH * SSD_H * 64 * 16, N_G = BATCH * 4 * 256 * 32;
    for (int it = C.bid * NTHR + C.tid; it < N_S + N_G; it += C.G * NTHR) {
        if (it < N_S) {
            const int n8 = it & 15, p = (it >> 4) & 63, h = (it >> 10) & 31, b = it >> 15;
            const size_t base = ((size_t)(b * SSD_NC) * SSD_H + h) * 8192 + p * 128 + 8 * n8;
            const float* dp = DEC + (size_t)(b * SSD_NC) * SSD_H + h;
            f32x4 ra = (f32x4){0.f, 0.f, 0.f, 0.f}, rb = ra;
            v4u xa[8], xb[8]; float da[8], db[8];
#define SCAN_S_LOAD(X, D, c0) _Pragma("unroll") for (int j = 0; j < 8; ++j) { X[j] = __builtin_nontemporal_load((const GAS v4u*)(ST + base + (size_t)((c0) + j) * (SSD_H * 8192))); D[j] = dp[((c0) + j) * SSD_H]; }
#define SCAN_S_PROC(X, D, c0) _Pragma("unroll") for (int j = 0; j < 8; ++j) { v4u o; o.x = pk2(ra.x, ra.y); o.y = pk2(ra.z, ra.w); o.z = pk2(rb.x, rb.y); o.w = pk2(rb.z, rb.w); \
                *(GAS v4u*)(PV + base + (size_t)((c0) + j) * (SSD_H * 8192)) = o; \
                ra = ra * D[j] + (f32x4){bflo(X[j].x), bfhi(X[j].x), bflo(X[j].y), bfhi(X[j].y)}; rb = rb * D[j] + (f32x4){bflo(X[j].z), bfhi(X[j].z), bflo(X[j].w), bfhi(X[j].w)}; }
            SCAN_S_LOAD(xa, da, 0)
#pragma unroll 1
            for (int c0 = 0; c0 < SSD_NC; c0 += 16) {
                SCAN_S_LOAD(xb, db, c0 + 8)
                SCAN_S_PROC(xa, da, c0)
                if (c0 + 16 < SSD_NC) { SCAN_S_LOAD(xa, da, c0 + 16) }
                SCAN_S_PROC(xb, db, c0 + 8)
            }
#undef SCAN_S_LOAD
#undef SCAN_S_PROC
        } else {
            const int ig = it - N_S, k4 = ig & 31, v = (ig >> 5) & 255, h = (ig >> 13) & 3, b = ig >> 15;
            const size_t base = ((size_t)(b * GLA_NC) * 4 + h) * 32768 + v * 128 + 4 * k4;
            const float* dp = GDEC + (size_t)(b * GLA_NC) * GLA_KT + h * 128 + 4 * k4;
            f32x4 r = (f32x4){0.f, 0.f, 0.f, 0.f};
            v2u xa[8], xb[8]; f32x4 da[8], db[8];
#define SCAN_G_LOAD(X, D, c0) _Pragma("unroll") for (int j = 0; j < 8; ++j) { X[j] = __builtin_nontemporal_load((const GAS v2u*)(GST + base + (size_t)((c0) + j) * (4 * 32768))); D[j] = *(const GAS f32x4*)(dp + (size_t)((c0) + j) * GLA_KT); }
#define SCAN_G_PROC(X, D, c0) _Pragma("unroll") for (int j = 0; j < 8; ++j) { v2u o; o.x = pk2(r.x, r.y); o.y = pk2(r.z, r.w); *(GAS v2u*)(GPV + base + (size_t)((c0) + j) * (4 * 32768)) = o; \
                r = r * D[j] + (f32x4){bflo(X[j].x), bfhi(X[j].x), bflo(X[j].y), bfhi(X[j].y)}; }
            SCAN_G_LOAD(xa, da, 0)
#pragma unroll 1
            for (int c0 = 0; c0 < GLA_NC; c0 += 16) {
                SCAN_G_LOAD(xb, db, c0 + 8)
                SCAN_G_PROC(xa, da, c0)
                if (c0 + 16 < GLA_NC) { SCAN_G_LOAD(xa, da, c0 + 16) }
                SCAN_G_PROC(xb, db, c0 + 8)
            }
#undef SCAN_G_LOAD
#undef SCAN_G_PROC
        }
    }
}

constexpr int GC3_GP_OFF = 64 * XI_STRIDE, GC3_XCH_OFF = GC3_GP_OFF + 256 * BI_STRIDE;
__device__ __forceinline__ void gla_c3_unit(Ctx& C, int l, int unit) {
    const int h = unit & 3, ck = unit >> 2; const size_t row0 = (size_t)ck * GLA_L;
    const int tid = C.tid, lane = C.lane, w = C.wave, c = lane & 15, hq = lane >> 4;
    LAS unsigned char* Vimg = C.lds; LAS unsigned char* GPimg = C.lds + GC3_GP_OFF; LAS float* xch = (LAS float*)(C.lds + GC3_XCH_OFF);
    const bf16* PROJ = (const bf16*)(C.ws + WS_PROJ); const bf16* QD = (const bf16*)(C.ws + WS_QD); const bf16* KI = (const bf16*)(C.ws + WS_KI); const bf16* GPV = (const bf16*)(C.ws + WS_GPV); bf16* Y = (bf16*)(C.ws + WS_Y);
    const int lt = w >> 1, vh = w & 1; const size_t row = row0 + 16 * lt + c;
    __syncthreads();
    { const bf16* gpv = GPV + (size_t)unit * 32768;
      v4u tv[4], tg[8];
#pragma unroll
      for (int it = 0; it < 4; ++it) { const int idx = tid + NTHR * it, t = idx >> 5, cg = idx & 31; tv[it] = __builtin_nontemporal_load((const GAS v4u*)(PROJ + (row0 + t) * DINP + C_GV + h * 256 + 8 * cg)); }
#pragma unroll
      for (int it = 0; it < 8; ++it) { const int idx = tid + NTHR * it; tg[it] = __builtin_nontemporal_load((const GAS v4u*)(gpv + (size_t)idx * 8)); }
#pragma unroll
      for (int it = 0; it < 4; ++it) { const int idx = tid + NTHR * it, t = idx >> 5, cg = idx & 31; *(LAS v4u*)(Vimg + t * XI_STRIDE + 16 * cg) = tv[it]; }
#pragma unroll
      for (int it = 0; it < 8; ++it) { const int idx = tid + NTHR * it, v = idx >> 4, cg = idx & 15; *(LAS v4u*)(GPimg + v * BI_STRIDE + 16 * cg) = tg[it]; } }
    bf16x8 qf[4];
#pragma unroll
    for (int ks = 0; ks < 4; ++ks) qf[ks] = gfrag(QD + row0 * GLA_KT + h * 128, GLA_KT, 16 * lt, 32 * ks, lane);
    v2u ggv[8];
#pragma unroll
    for (int vt = 0; vt < 8; ++vt) ggv[vt] = __builtin_nontemporal_load((const GAS v2u*)(PROJ + row * DINP + C_GG + h * 256 + 16 * (8 * vh + vt) + 4 * hq));
    f32x4 att[4];
#pragma unroll
    for (int st = 0; st < 4; ++st) { f32x4 a = (f32x4){0.f, 0.f, 0.f, 0.f};
        if (st <= lt) {
#pragma unroll
            for (int ks = 0; ks < 4; ++ks) a = mfma16(gfrag(KI + row0 * GLA_KT + h * 128, GLA_KT, 16 * st, 32 * ks, lane), qf[ks], a);
#pragma unroll
            for (int r = 0; r < 4; ++r) if (16 * st + 4 * hq + r > 16 * lt + c) a[r] = 0.f;
        }
        att[st] = a; }
    __syncthreads();
    f32x4 oacc[8];
#pragma unroll
    for (int vt = 0; vt < 8; ++vt) oacc[vt] = (f32x4){0.f, 0.f, 0.f, 0.f};
#pragma unroll
    for (int ks = 0; ks < 4; ++ks)
#pragma unroll
        for (int vt = 0; vt < 8; ++vt) oacc[vt] = mfma16(*(const LAS bf16x8*)(GPimg + (16 * (8 * vh + vt) + c) * BI_STRIDE + (32 * ks + 8 * hq) * 2), qf[ks], oacc[vt]);
#pragma unroll
    for (int ks2 = 0; ks2 < 2; ++ks2) { const bf16x8 pf = pack8(att[2 * ks2], att[2 * ks2 + 1]);
#pragma unroll
        for (int vt = 0; vt < 8; ++vt) oacc[vt] = mfma16(trfrag(Vimg, XI_STRIDE, 32 * ks2 + 4 * hq, 32 * ks2 + 16 + 4 * hq, 16 * (8 * vh + vt), lane), pf, oacc[vt]); }
    float ssq = 0.f;
#pragma unroll
    for (int vt = 0; vt < 8; ++vt) ssq += (oacc[vt].x * oacc[vt].x + oacc[vt].y * oacc[vt].y) + (oacc[vt].z * oacc[vt].z + oacc[vt].w * oacc[vt].w);
    ssq = xsum4(ssq);
    if (hq == 0) xch[w * 16 + c] = ssq;
    __syncthreads();
    const float rstd = 1.f / sqrtf((xch[w * 16 + c] + xch[(w ^ 1) * 16 + c]) * (1.f / 256.f) + EPS);
    const float* gla_norm = C.in[I_GLA_NORM] + (size_t)l * 256;
#pragma unroll
    for (int vt = 0; vt < 8; ++vt) { const int v0 = 16 * (8 * vh + vt) + 4 * hq; const f32x4 gn = *(const GAS f32x4*)(gla_norm + v0); const v2u gg = ggv[vt];
        const f32x4 o = oacc[vt]; v2u ow; ow.x = pk2(o.x * rstd * gn.x * silu_f(bflo(gg.x)), o.y * rstd * gn.y * silu_f(bfhi(gg.x))); ow.y = pk2(o.z * rstd * gn.z * silu_f(bflo(gg.y)), o.w * rstd * gn.w * silu_f(bfhi(gg.y)));
        *(GAS v2u*)(Y + row * DM + 3072 + h * 256 + v0) = ow; }
}

__device__ __forceinline__ void ssd_c1_unit(Ctx& C, int unit) {
    const int g = unit & 7, bc = unit >> 3; const size_t row0 = (size_t)bc * SSD_L;
    const int tid = C.tid, lane = C.lane, w = C.wave, c = lane & 15, hq = lane >> 4;
    LAS float* acs = (LAS float*)C.lds; LAS float* dts = acs + 512;
    LAS unsigned char* XWimg = C.lds + 4096; LAS unsigned char* Bimg = C.lds + 4096 + 128 * XI_STRIDE;
    const bf16* XBC = (const bf16*)(C.ws + WS_XBC); const float* DT = (const float*)(C.ws + WS_DT); const float* ACS = (const float*)(C.ws + WS_ACS); bf16* ST = (bf16*)(C.ws + WS_ST);
    __syncthreads();
    { const int t = tid >> 2, hh = tid & 3; acs[hh * 128 + t] = ACS[(row0 + t) * SSD_H + 4 * g + hh]; dts[hh * 128 + t] = DT[(row0 + t) * SSD_H + 4 * g + hh]; }
    __syncthreads();
#pragma unroll
    for (int it = 0; it < 8; ++it) { const int idx = tid + NTHR * it, t = idx >> 5, cg = idx & 31, hh = cg >> 3; const float wgt = __expf(acs[hh * 128 + 127] - acs[hh * 128 + t]) * dts[hh * 128 + t];
        const v4u r = __builtin_nontemporal_load((const GAS v4u*)(XBC + (row0 + t) * SSD_CD + g * 256 + 8 * cg));
        v4u o; o.x = pk2(bflo(r.x) * wgt, bfhi(r.x) * wgt); o.y = pk2(bflo(r.y) * wgt, bfhi(r.y) * wgt); o.z = pk2(bflo(r.z) * wgt, bfhi(r.z) * wgt); o.w = pk2(bflo(r.w) * wgt, bfhi(r.w) * wgt);
        *(LAS v4u*)(XWimg + t * XI_STRIDE + 16 * cg) = o; }
#pragma unroll
    for (int it = 0; it < 4; ++it) { const int idx = tid + NTHR * it, t = idx >> 4, cg = idx & 15; *(LAS v4u*)(Bimg + t * BI_STRIDE + 16 * cg) = __builtin_nontemporal_load((const GAS v4u*)(XBC + (row0 + t) * SSD_CD + 2048 + g * 128 + 8 * cg)); }
    __syncthreads();
    const int hh = w >> 1, ph = w & 1;
    f32x4 acc[8][2];
#pragma unroll
    for (int mt = 0; mt < 8; ++mt) { acc[mt][0] = (f32x4){0.f, 0.f, 0.f, 0.f}; acc[mt][1] = (f32x4){0.f, 0.f, 0.f, 0.f}; }
#pragma unroll
    for (int ks = 0; ks < 4; ++ks) { const int r0 = 32 * ks + 8 * hq;
        const bf16x8 x0 = trfrag(XWimg, XI_STRIDE, r0, r0 + 4, hh * 64 + 32 * ph, lane), x1 = trfrag(XWimg, XI_STRIDE, r0, r0 + 4, hh * 64 + 32 * ph + 16, lane);
#pragma unroll
        for (int mt = 0; mt < 8; ++mt) { const bf16x8 bf = trfrag(Bimg, BI_STRIDE, r0, r0 + 4, 16 * mt, lane); acc[mt][0] = mfma16(bf, x0, acc[mt][0]); acc[mt][1] = mfma16(bf, x1, acc[mt][1]); } }
    bf16* sp = ST + ((size_t)bc * SSD_H + 4 * g + hh) * 8192 + 4 * hq;
#pragma unroll
    for (int mt = 0; mt < 8; ++mt)
#pragma unroll
        for (int pt = 0; pt < 2; ++pt) { v2u o; o.x = pk2(acc[mt][pt].x, acc[mt][pt].y); o.y = pk2(acc[mt][pt].z, acc[mt][pt].w); *(GAS v2u*)(sp + (size_t)(32 * ph + 16 * pt + c) * 128 + 16 * mt) = o; }
}

struct SsdC1Pre { v4u tx[8], tbv[4]; float ac[8], dc[8], alast; };
__device__ __forceinline__ void ssd_c1_load(Ctx& C, int unit, SsdC1Pre& p) {
    const int g = unit & 7, bc = unit >> 3, tid = C.tid; const size_t row0 = (size_t)bc * SSD_L;
    const bf16* XBC = (const bf16*)(C.ws + WS_XBC); const float* DT = (const float*)(C.ws + WS_DT); const float* ACS = (const float*)(C.ws + WS_ACS);
    const int cg = tid & 31, hh = cg >> 3;
    p.alast = ACS[(row0 + 127) * SSD_H + 4 * g + hh];
#pragma unroll
    for (int it = 0; it < 8; ++it) { const int t = (tid >> 5) + 16 * it; p.ac[it] = ACS[(row0 + t) * SSD_H + 4 * g + hh]; p.dc[it] = DT[(row0 + t) * SSD_H + 4 * g + hh];
        p.tx[it] = __builtin_nontemporal_load((const GAS v4u*)(XBC + (row0 + t) * SSD_CD + g * 256 + 8 * cg)); }
#pragma unroll
    for (int it = 0; it < 4; ++it) { const int idx = tid + NTHR * it, t = idx >> 4, c2 = idx & 15; p.tbv[it] = __builtin_nontemporal_load((const GAS v4u*)(XBC + (row0 + t) * SSD_CD + 2048 + g * 128 + 8 * c2)); }
}
__device__ __forceinline__ void ssd_c1_stage(Ctx& C, const SsdC1Pre& p) {
    const int tid = C.tid, cg = tid & 31; LAS unsigned char* XWimg = C.lds + 4096; LAS unsigned char* Bimg = C.lds + 4096 + 128 * XI_STRIDE;
#pragma unroll
    for (int it = 0; it < 8; ++it) { const int t = (tid >> 5) + 16 * it; const float wgt = __expf(p.alast - p.ac[it]) * p.dc[it]; const v4u r = p.tx[it];
        v4u o; o.x = pk2(bflo(r.x) * wgt, bfhi(r.x) * wgt); o.y = pk2(bflo(r.y) * wgt, bfhi(r.y) * wgt); o.z = pk2(bflo(r.z) * wgt, bfhi(r.z) * wgt); o.w = pk2(bflo(r.w) * wgt, bfhi(r.w) * wgt);
        *(LAS v4u*)(XWimg + t * XI_STRIDE + 16 * cg) = o; }
#pragma unroll
    for (int it = 0; it < 4; ++it) { const int idx = tid + NTHR * it, t = idx >> 4, c2 = idx & 15; *(LAS v4u*)(Bimg + t * BI_STRIDE + 16 * c2) = p.tbv[it]; }
}
__device__ __forceinline__ void ssd_c1_compute(Ctx& C, int unit) {
    const int g = unit & 7, bc = unit >> 3; const int lane = C.lane, w = C.wave, c = lane & 15, hq = lane >> 4;
    LAS unsigned char* XWimg = C.lds + 4096; LAS unsigned char* Bimg = C.lds + 4096 + 128 * XI_STRIDE; bf16* ST = (bf16*)(C.ws + WS_ST);
    const int hh = w >> 1, ph = w & 1;
    f32x4 acc[8][2];
#pragma unroll
    for (int mt = 0; mt < 8; ++mt) { acc[mt][0] = (f32x4){0.f, 0.f, 0.f, 0.f}; acc[mt][1] = (f32x4){0.f, 0.f, 0.f, 0.f}; }
#pragma unroll
    for (int ks = 0; ks < 4; ++ks) { const int r0 = 32 * ks + 8 * hq;
        const bf16x8 x0 = trfrag(XWimg, XI_STRIDE, r0, r0 + 4, hh * 64 + 32 * ph, lane), x1 = trfrag(XWimg, XI_STRIDE, r0, r0 + 4, hh * 64 + 32 * ph + 16, lane);
#pragma unroll
        for (int mt = 0; mt < 8; ++mt) { const bf16x8 bf = trfrag(Bimg, BI_STRIDE, r0, r0 + 4, 16 * mt, lane); acc[mt][0] = mfma16(bf, x0, acc[mt][0]); acc[mt][1] = mfma16(bf, x1, acc[mt][1]); } }
    bf16* sp = ST + ((size_t)bc * SSD_H + 4 * g + hh) * 8192 + 4 * hq;
#pragma unroll
    for (int mt = 0; mt < 8; ++mt)
#pragma unroll
        for (int pt = 0; pt < 2; ++pt) { v2u o; o.x = pk2(acc[mt][pt].x, acc[mt][pt].y); o.y = pk2(acc[mt][pt].z, acc[mt][pt].w); *(GAS v2u*)(sp + (size_t)(32 * ph + 16 * pt + c) * 128 + 16 * mt) = o; }
}

constexpr int SC3_X_OFF = 4096, SC3_PV_OFF = SC3_X_OFF + 128 * XI_STRIDE, SC3_PV_HEAD = 64 * BI_STRIDE;
static_assert(SC3_PV_OFF + 4 * SC3_PV_HEAD <= MISC_OFF && GC3_XCH_OFF + 512 <= MISC_OFF, "mixer LDS maps");
__device__ __forceinline__ void ssd_c3_unit(Ctx& C, int l, int unit) {
    const int g = unit & 7, bc = unit >> 3; const size_t row0 = (size_t)bc * SSD_L;
    const int tid = C.tid, lane = C.lane, w = C.wave, c = lane & 15, hq = lane >> 4;
    LAS float* acs = (LAS float*)C.lds; LAS float* dts = acs + 512;
    LAS unsigned char* Ximg = C.lds + SC3_X_OFF; LAS unsigned char* PVimg = C.lds + SC3_PV_OFF;
    const bf16* PROJ = (const bf16*)(C.ws + WS_PROJ); const bf16* XBC = (const bf16*)(C.ws + WS_XBC); const float* DT = (const float*)(C.ws + WS_DT); const float* ACS = (const float*)(C.ws + WS_ACS);
    const bf16* PV = (const bf16*)(C.ws + WS_PV); bf16* Y = (bf16*)(C.ws + WS_Y);
    const int tl = 16 * w + c; const size_t row = row0 + tl;
    __syncthreads();
    { const int t = tid >> 2, hh = tid & 3; const float a0 = ACS[(row0 + t) * SSD_H + 4 * g + hh], d0 = DT[(row0 + t) * SSD_H + 4 * g + hh];
      const bf16* pvb = PV + ((size_t)bc * SSD_H + 4 * g) * 8192;
      v4u tx[8], tp[8];
#pragma unroll
      for (int it = 0; it < 8; ++it) { const int idx = tid + NTHR * it, t2 = idx >> 5, cg = idx & 31; tx[it] = __builtin_nontemporal_load((const GAS v4u*)(XBC + (row0 + t2) * SSD_CD + g * 256 + 8 * cg)); }
#pragma unroll
      for (int it = 0; it < 8; ++it) { const int idx = tid + NTHR * it; tp[it] = __builtin_nontemporal_load((const GAS v4u*)(pvb + (size_t)idx * 8)); }
      acs[(tid & 3) * 128 + (tid >> 2)] = a0; dts[(tid & 3) * 128 + (tid >> 2)] = d0;
#pragma unroll
      for (int it = 0; it < 8; ++it) { const int idx = tid + NTHR * it, t2 = idx >> 5, cg = idx & 31; *(LAS v4u*)(Ximg + t2 * XI_STRIDE + 16 * cg) = tx[it]; }
#pragma unroll
      for (int it = 0; it < 8; ++it) { const int idx = tid + NTHR * it, pr = idx >> 4, cg = idx & 15; *(LAS v4u*)(PVimg + pr * BI_STRIDE + 16 * cg) = tp[it]; } }
    bf16x8 cf[4];
#pragma unroll
    for (int ks = 0; ks < 4; ++ks) cf[ks] = gfrag(XBC + row0 * SSD_CD + 3072 + g * 128, SSD_CD, 16 * w, 32 * ks, lane);
    f32x4 cb[8];
#pragma unroll
    for (int st = 0; st < 8; ++st) { f32x4 a = (f32x4){0.f, 0.f, 0.f, 0.f};
        if (st <= w) {
#pragma unroll
            for (int ks = 0; ks < 4; ++ks) a = mfma16(gfrag(XBC + row0 * SSD_CD + 2048 + g * 128, SSD_CD, 16 * st, 32 * ks, lane), cf[ks], a);
        }
        cb[st] = a; }
    __syncthreads();
    v2u yk[4][4];
    float ssq = 0.f;
#pragma unroll
    for (int hh = 0; hh < 4; ++hh) {
        v2u zz[4];
#pragma unroll
        for (int pt = 0; pt < 4; ++pt) zz[pt] = __builtin_nontemporal_load((const GAS v2u*)(PROJ + row * DINP + C_Z + g * 256 + hh * 64 + 16 * pt + 4 * hq));
        const float acs_l = acs[hh * 128 + tl], el = __expf(acs_l);
        f32x4 ya[4];
#pragma unroll
        for (int pt = 0; pt < 4; ++pt) ya[pt] = (f32x4){0.f, 0.f, 0.f, 0.f};
#pragma unroll
        for (int ks = 0; ks < 4; ++ks)
#pragma unroll
            for (int pt = 0; pt < 4; ++pt) ya[pt] = mfma16(*(const LAS bf16x8*)(PVimg + (hh * 64 + 16 * pt + c) * BI_STRIDE + (32 * ks + 8 * hq) * 2), cf[ks], ya[pt]);
#pragma unroll
        for (int pt = 0; pt < 4; ++pt) ya[pt] = ya[pt] * el;
#pragma unroll
        for (int ks2 = 0; ks2 < 4; ++ks2) {
            if (2 * ks2 <= w) {
                f32x4 lm[2];
#pragma unroll
                for (int t2 = 0; t2 < 2; ++t2) { const int s0 = 32 * ks2 + 16 * t2 + 4 * hq; const f32x4 as4 = *(const LAS f32x4*)(acs + hh * 128 + s0), dt4 = *(const LAS f32x4*)(dts + hh * 128 + s0);
#pragma unroll
                    for (int r = 0; r < 4; ++r) { const float d = fminf(acs_l - as4[r], 0.f); lm[t2][r] = (s0 + r <= tl) ? cb[2 * ks2 + t2][r] * __expf(d) * dt4[r] : 0.f; } }
                const bf16x8 pf = pack8(lm[0], lm[1]);
#pragma unroll
                for (int pt = 0; pt < 4; ++pt) ya[pt] = mfma16(trfrag(Ximg, XI_STRIDE, 32 * ks2 + 4 * hq, 32 * ks2 + 16 + 4 * hq, hh * 64 + 16 * pt, lane), pf, ya[pt]);
            }
        }
        const float Dh = C.in[I_SSD_D][l * SSD_H + 4 * g + hh];
#pragma unroll
        for (int pt = 0; pt < 4; ++pt) { const int col = hh * 64 + 16 * pt + 4 * hq; const v2u xw = *(const LAS v2u*)(Ximg + tl * XI_STRIDE + col * 2); const v2u z2 = zz[pt];
            f32x4 v; v.x = (ya[pt].x + Dh * bflo(xw.x)) * silu_f(bflo(z2.x)); v.y = (ya[pt].y + Dh * bfhi(xw.x)) * silu_f(bfhi(z2.x)); v.z = (ya[pt].z + Dh * bflo(xw.y)) * silu_f(bflo(z2.y)); v.w = (ya[pt].w + Dh * bfhi(xw.y)) * silu_f(bfhi(z2.y));
            { v2u pk; pk.x = pk2(v.x, v.y); pk.y = pk2(v.z, v.w); yk[hh][pt] = pk; } ssq += (v.x * v.x + v.y * v.y) + (v.z * v.z + v.w * v.w); }
    }
    ssq = xsum4(ssq);
    const float rstd = 1.f / sqrtf(ssq * (1.f / 256.f) + EPS);
    const float* ssd_norm = C.in[I_SSD_NORM] + (size_t)l * SSD_W + g * 256;
#pragma unroll
    for (int hh = 0; hh < 4; ++hh)
#pragma unroll
        for (int pt = 0; pt < 4; ++pt) { const int col = hh * 64 + 16 * pt + 4 * hq; const f32x4 gn = *(const GAS f32x4*)(ssd_norm + col); const f32x4 v = (f32x4){bflo(yk[hh][pt].x), bfhi(yk[hh][pt].x), bflo(yk[hh][pt].y), bfhi(yk[hh][pt].y)};
            v2u ow; ow.x = pk2(v.x * rstd * gn.x, v.y * rstd * gn.y); ow.y = pk2(v.z * rstd * gn.z, v.w * rstd * gn.w); *(GAS v2u*)(Y + row * DM + g * 256 + col) = ow; }
}

__device__ __forceinline__ void mix_c1_phase(Ctx& C, int l) {
    const bool swa_first = ((C.bid >> 3) & 1) != 0;
#pragma nounroll
    for (int pass = 0; pass < 2; ++pass) {
        if ((pass == 0) == swa_first) {
            for (int u = C.bid; u < N_SWA_UNITS; u += C.G) { int t_ = threadIdx.x; asm volatile("" : "+v"(t_)); C.tid = t_; C.lane = t_ & 63; swa_unit_mfma(C, l, u); }
        } else {
            { int u = C.bid; SsdC1Pre p; if (u < N_SSD_CU) ssd_c1_load(C, u, p);
              while (u < N_SSD_CU) { { int t_ = threadIdx.x; asm volatile("" : "+v"(t_)); C.tid = t_; C.lane = t_ & 63; } __syncthreads(); ssd_c1_stage(C, p); __syncthreads(); const int un = u + C.G; if (un < N_SSD_CU) ssd_c1_load(C, un, p); ssd_c1_compute(C, u); u = un; } }
            { int u = C.bid; GlaC1Pre p; if (u < N_GLA_CU) gla_c1_load(C, u, p);
              while (u < N_GLA_CU) { { int t_ = threadIdx.x; asm volatile("" : "+v"(t_)); C.tid = t_; C.lane = t_ & 63; } __syncthreads(); gla_c1_stage(C, p); __syncthreads(); const int un = u + C.G; if (un < N_GLA_CU) gla_c1_load(C, un, p); gla_c1_compute(C, u); u = un; } }
        }
        { int t_ = threadIdx.x; asm volatile("" : "+v"(t_)); C.tid = t_; C.lane = t_ & 63; } __syncthreads();
    }
}
__device__ __forceinline__ void mix_c3_phase(Ctx& C, int l) {
    for (int u = C.bid; u < N_SSD_CU; u += C.G) { int t_ = threadIdx.x; asm volatile("" : "+v"(t_)); C.tid = t_; C.lane = t_ & 63; ssd_c3_unit(C, l, u); }
    for (int u = C.bid; u < N_GLA_CU; u += C.G) { int t_ = threadIdx.x; asm volatile("" : "+v"(t_)); C.tid = t_; C.lane = t_ & 63; gla_c3_unit(C, l, u); }
}

__device__ __forceinline__ void act_fixup_phase(Ctx& C, int l) {
    bf16* ACT = (bf16*)(C.ws + WS_ACT); const float* HTG = (const float*)(C.ws + WS_HTG); const float* HTU = (const float*)(C.ws + WS_HTU); const float* HBG = (const float*)(C.ws + WS_HBG);
    const float* cw = C.in[I_FFN_CONV_W] + (size_t)l * 3 * DFF; const float* cb = C.in[I_FFN_CONV_B] + (size_t)l * DFF;
    constexpr int NC4 = DFF / 4, NIT = (M / 64) * 2 * NC4;
    for (int it = C.bid * NTHR + C.tid; it < NIT; it += C.G * NTHR) {
        const int c4 = it % NC4, ri = it / NC4, i = ri & 1, blk = ri >> 1, c0 = 4 * c4; const bool first = (blk % (SEQ / 64)) == 0;
        const f32x4 z4 = (f32x4){0.f, 0.f, 0.f, 0.f};
        const f32x4 g0 = *(const GAS f32x4*)(HTG + ((size_t)blk * 2 + i) * DFF + c0), up = *(const GAS f32x4*)(HTU + ((size_t)blk * 2 + i) * DFF + c0);
        const f32x4 pb1 = first ? z4 : *(const GAS f32x4*)(HBG + ((size_t)(blk - 1) * 2 + 1) * DFF + c0), pb0 = first ? z4 : *(const GAS f32x4*)(HBG + ((size_t)(blk - 1) * 2 + 0) * DFF + c0);
        const f32x4 g1 = i ? *(const GAS f32x4*)(HTG + ((size_t)blk * 2 + 0) * DFF + c0) : pb1, g2 = i ? pb1 : pb0;
        const f32x4 w0 = *(const GAS f32x4*)(cw + c0), w1 = *(const GAS f32x4*)(cw + DFF + c0), w2 = *(const GAS f32x4*)(cw + 2 * DFF + c0), bb = *(const GAS f32x4*)(cb + c0);
        f32x4 o;
#pragma unroll
        for (int e = 0; e < 4; ++e) { const float gc = bb[e] + w0[e] * g2[e] + w1[e] * g1[e] + w2[e] * g0[e]; o[e] = silu_f(gc) * up[e]; }
        v2u ow; ow.x = pk2(o.x, o.y); ow.y = pk2(o.z, o.w); *(GAS v2u*)(ACT + (size_t)(64 * blk + i) * DFF + c0) = ow;
    }
}

constexpr int PH_PER_LAYER = 11, PH_FINAL = DEPTH * PH_PER_LAYER, N_PHASES = PH_FINAL + 1;
#ifndef WGM_DOWN
#define WGM_DOWN 4
#endif
#ifndef MK_ONE_LAUNCH
#define MK_ONE_LAUNCH 1
#endif
__global__ void __launch_bounds__(NTHR, 2) fwd_kernel(Args args) {
    extern __shared__ __attribute__((aligned(16))) unsigned char lds[];
    Ctx C;
    C.lds = (LAS unsigned char*)lds;
    C.tid = threadIdx.x; C.lane = C.tid & 63; C.wave = __builtin_amdgcn_readfirstlane(C.tid >> 6);
    C.G = gridDim.x; C.bid = blockIdx.x;
    C.in = args.in; C.out = args.out; C.ws = args.ws;
    volatile LAS unsigned* MISC = (volatile LAS unsigned*)(C.lds + MISC_OFF);
    for (int u = C.tid; u < (LDS_BYTES - MISC_OFF) / 4; u += NTHR) ((LAS unsigned*)(C.lds + MISC_OFF))[u] = 0u;
    __syncthreads();
    gu32* ctl = (gu32*)(args.ws + WS_CTL);
    XcdBarrier bar = xcd_barrier_post((unsigned*)(ctl + CW_BAR) + args.li * XCD_BAR_WORDS, MISC + 8);
    const int lo = args.ph_lo, hi = args.ph_hi;
#define IN(k) (lo <= (k) && (k) < hi)
    const bool seamfill = (lo == 0 && hi == N_PHASES);
#define SEAM_LO(k) ((k) <= 10 ? ((k) - 2) * 256 : SEAM_B0 + ((k) - 11) * 256)
#define SEAM(k) do { if (IN(k) && IN((k) + 1)) { \
        if (seamfill && (k) >= 2 && (k) <= 17) { xcd_barrier_arrive(bar); __syncthreads(); const unsigned role_ = MISC[11]; LAUNDER(); \
              \
            if (role_ != 0u) { xcd_barrier_wait(bar); LAUNDER(); convert_weights(C, 1, SEAM_LO(k), SEAM_LO(k) + 256); } \
            else { convert_weights(C, 1, SEAM_LO(k), SEAM_LO(k) + 256); xcd_barrier_wait(bar); } } \
        else xcd_barrier(bar); } } while (0)
    bf16* xb = (bf16*)(args.ws + WS_XB);
    bf16* H = (bf16*)(args.ws + WS_H);
#define LAUNDER() do { int t_ = threadIdx.x; asm volatile("" : "+v"(t_)); C.tid = t_; C.lane = t_ & 63; } while (0)
#define LAYER_BODY(l) do { \
        const int pb = l * PH_PER_LAYER; \
        LAUNDER(); \
        if (IN(pb + 0)) { if (l == 1 && seamfill) { convert_weights(C, l, SEAM_A1, SEAM_B0); LAUNDER(); convert_weights(C, l, SEAM_B1, CV_A_ITEMS); } else convert_weights(C, l, 0, CV_A_ITEMS); LAUNDER(); if (l == 0) rmsnorm_phase(C, args.in[I_X], args.in[I_ATTN_NORM] + (size_t)l * DM, H, xb); else rmsnorm_phase_b(C, xb, args.in[I_ATTN_NORM] + (size_t)l * DM, H); } \
        SEAM(pb + 0); \
        LAUNDER(); \
        if (IN(pb + 1)) { \
            pg8::Gemm g{H, (const bf16*)(args.ws + WS_WIN), M, DINP, DM}; pg8::StaticOrder S; S.init(M, DINP, C.G, C.bid); \
            pg8::EpiProjConv E{(bf16*)(args.ws + WS_PROJ), DINP, (bf16*)(args.ws + WS_XBC), args.in[I_SSD_CONV_W] + (size_t)l * 4 * SSD_CD, args.in[I_SSD_CONV_B] + (size_t)l * SSD_CD, (float*)(args.ws + WS_XHT), (float*)(args.ws + WS_XHB)}; \
            pg8::gemm_phase<pg8::EpiProjConv, pg8::StaticOrder, true, true>(C.lds, g, S, E); \
        } \
        SEAM(pb + 1); \
        LAUNDER(); \
        if (IN(pb + 2)) {   \
            const bool cvf = ((C.bid >> 3) & 1) != 0; \
            _Pragma("nounroll") for (int pass = 0; pass < 2; ++pass) { if ((pass == 0) == cvf) convert_weights(C, l, CV_UP_LO, CV_DN_LO); else prep_phase(C, l); LAUNDER(); __syncthreads(); } } \
        SEAM(pb + 2); \
        LAUNDER(); \
        if (IN(pb + 3)) mix_c1_phase(C, l); \
        SEAM(pb + 3); \
        LAUNDER(); \
        if (IN(pb + 4)) scan_phase(C); \
        SEAM(pb + 4); \
        LAUNDER(); \
        if (IN(pb + 5)) mix_c3_phase(C, l); \
        SEAM(pb + 5); \
        LAUNDER(); \
        if (IN(pb + 6)) { \
            pg8::Gemm g{(const bf16*)(args.ws + WS_Y), (const bf16*)(args.ws + WS_WOUT), M, DM, DM}; pg8::StaticOrder S; S.init(M, DM, C.G, C.bid); \
            pg8::EpiResB<false> E{(const void*)xb, xb, DM}; \
            pg8::gemm_phase<pg8::EpiResB<false>, pg8::StaticOrder, true, true>(C.lds, g, S, E); \
        } \
        SEAM(pb + 6); \
        LAUNDER(); \
        if (IN(pb + 7)) rmsnorm_phase_b(C, xb, args.in[I_FFN_NORM] + (size_t)l * DM, H); \
        SEAM(pb + 7); \
        LAUNDER(); \
        if (IN(pb + 8)) { \
            pg8::Gemm g{H, (const bf16*)(args.ws + WS_WGU), M, DGU, DM}; pg8::StaticOrder S; S.init(M, DGU, C.G, C.bid); \
            pg8::EpiGateUp E{(bf16*)(args.ws + WS_ACT), args.in[I_FFN_CONV_W] + (size_t)l * 3 * DFF, args.in[I_FFN_CONV_B] + (size_t)l * DFF, (float*)(args.ws + WS_HTG), (float*)(args.ws + WS_HTU), (float*)(args.ws + WS_HBG), DFF}; \
            pg8::gemm_phase<pg8::EpiGateUp, pg8::StaticOrder, true, true>(C.lds, g, S, E); \
        } \
        SEAM(pb + 8); \
        LAUNDER(); \
        if (IN(pb + 9)) { const bool cvf = ((C.bid >> 3) & 1) != 0; \
            _Pragma("nounroll") for (int pass = 0; pass < 2; ++pass) { if ((pass == 0) == cvf) convert_weights(C, l, CV_DN_LO, CV_NITEMS); else act_fixup_phase(C, l); LAUNDER(); __syncthreads(); } } \
        SEAM(pb + 9); \
        LAUNDER(); \
        if (IN(pb + 10)) { \
            pg8::Gemm g{(const bf16*)(args.ws + WS_ACT), (const bf16*)(args.ws + WS_WDN), M, DM, DFF}; pg8::StaticOrder S; S.init(M, DM, C.G, C.bid, WGM_DOWN); \
            pg8::EpiResB<false> E{(const void*)xb, xb, DM}; \
            pg8::gemm_phase<pg8::EpiResB<false>, pg8::StaticOrder, true, true>(C.lds, g, S, E); \
        } \
        SEAM(pb + 10); \
     \
    } while (0)
    LAYER_BODY(0);
    LAYER_BODY(1);
#undef LAYER_BODY
    LAUNDER();
    if (IN(PH_FINAL)) final_norm_phase(C, xb, args.in[I_FINAL_NORM], args.out);
#undef IN
#undef SEAM
}

extern "C" void kernel_launch(void* const* d_in, const int* in_sizes, int n_in, void* d_out, int out_size, void* d_ws, size_t ws_size, hipStream_t stream) {
    static int grid = 0;
    if (grid == 0) {
        if (n_in != N_IN || out_size != M * DM || ws_size < WS_END) { fprintf(stderr, "kernel_launch: unexpected shapes (n_in %d, out %d, ws %zu < %zu)\n", n_in, out_size, ws_size, (size_t)WS_END); grid = -1; return; }
        int dev = 0, cus = 0, per_cu = 0;
        if (hipGetDevice(&dev) != hipSuccess || hipDeviceGetAttribute(&cus, hipDeviceAttributeMultiprocessorCount, dev) != hipSuccess) { grid = -1; return; }
        if (hipFuncSetAttribute((const void*)fwd_kernel, hipFuncAttributeMaxDynamicSharedMemorySize, LDS_BYTES) != hipSuccess) { fprintf(stderr, "kernel_launch: hipFuncSetAttribute failed\n"); grid = -1; return; }
        if (hipOccupancyMaxActiveBlocksPerMultiprocessor(&per_cu, (const void*)fwd_kernel, NTHR, LDS_BYTES) != hipSuccess || per_cu < 1) { fprintf(stderr, "kernel_launch: occupancy query says %d\n", per_cu); (void)hipGetLastError(); grid = -1; return; }
        grid = cus;
    }
    if (grid < 0) return;
    constexpr size_t kZero = (size_t)(CW_BAR + (MK_ONE_LAUNCH ? 1 : N_PHASES) * XCD_BAR_WORDS) * sizeof(unsigned);
    static_assert(kZero <= CTL_BYTES, "control region");
    if (hipMemsetAsync((char*)d_ws + WS_CTL, 0, kZero, stream) != hipSuccess) return;
    Args a{};
    for (int i = 0; i < N_IN; ++i) a.in[i] = (const float*)d_in[i];
    a.out = (float*)d_out; a.ws = (unsigned char*)d_ws; a.pad = 0;
#if MK_ONE_LAUNCH
    a.ph_lo = 0; a.ph_hi = N_PHASES; a.li = 0;
    hipLaunchKernelGGL(fwd_kernel, dim3(grid), dim3(NTHR), LDS_BYTES, stream, a);
#else
    for (int p = 0; p < N_PHASES; ++p) { a.ph_lo = p; a.ph_hi = p + 1; a.li = p;
        hipLaunchKernelGGL(fwd_kernel, dim3(grid), dim3(NTHR), LDS_BYTES, stream, a); }
#endif
}
```
